# Optimizing an MI355X kernel written in HIP

```python
import jax, jax.numpy as jnp
from jax import lax
import numpy as np

D_MODEL = 1024
BATCH = 8
SEQ = 2048
DEPTH = 1

MLA_HEADS = 8
QK_NOPE_DIM = 64
QK_ROPE_DIM = 32
QK_HEAD_DIM = QK_NOPE_DIM + QK_ROPE_DIM
V_HEAD_DIM = 64
Q_LORA_RANK = 384
KV_LORA_RANK = 256
ROPE_THETA = 10000.0
Q_BLOCK = 128
MLSTM_HEADS = 4
MLSTM_HEAD_DIM = 128
MLSTM_INNER = MLSTM_HEADS * MLSTM_HEAD_DIM
CONV_WIDTH = 4
CHUNK = 64
MIX_WIDTH = MLA_HEADS * V_HEAD_DIM + MLSTM_INNER
IN_WIDTHS = (Q_LORA_RANK, KV_LORA_RANK, QK_ROPE_DIM, MLSTM_INNER, MLSTM_INNER, MLSTM_INNER, MLSTM_HEADS, MLSTM_HEADS)
IN_DIM = Q_LORA_RANK + KV_LORA_RANK + QK_ROPE_DIM + 3 * MLSTM_INNER + 2 * MLSTM_HEADS
N_EXPERTS = 256
TOP_K = 8
N_GROUPS = 8
TOPK_GROUPS = 4
EXPERT_DIM = 256
SHARED_DIM = 256
ROUTED_SCALE = 2.5
MOE_BLOCK = 128
RMS_EPS = 1e-6

kernel_name = 'hybrid_mla_mlstm_moe_adaln'


def rms_norm(x, g, eps=RMS_EPS):
    xf = x.astype(jnp.float32)
    y = xf * lax.rsqrt(jnp.mean(xf * xf, axis=-1, keepdims=True) + eps)
    return (y * g.astype(jnp.float32)).astype(x.dtype)


def modulate(h, shift, scale):
    return h * (1 + scale[:, None, :]) + shift[:, None, :]


def rope(x, cos, sin):
    x1, x2 = jnp.split(x, 2, axis=-1)
    return jnp.concatenate([x1 * cos - x2 * sin, x1 * sin + x2 * cos], axis=-1)


def mla_group(cq, ckv, k_rope, cos, sin, g_cq, w_uq, g_ckv, w_ukv, g_qn, g_kn, g_out):
    B, S, _ = cq.shape
    q = (rms_norm(cq, g_cq) @ w_uq).reshape(B, S, MLA_HEADS, QK_HEAD_DIM)
    kv = (rms_norm(ckv, g_ckv) @ w_ukv).reshape(B, S, MLA_HEADS, QK_NOPE_DIM + V_HEAD_DIM)
    k_nope, v = kv[..., :QK_NOPE_DIM], kv[..., QK_NOPE_DIM:]
    k = jnp.concatenate([k_nope, jnp.broadcast_to(k_rope[:, :, None, :], (B, S, MLA_HEADS, QK_ROPE_DIM))], axis=-1)
    q = rms_norm(q, g_qn)
    k = rms_norm(k, g_kn)
    c4, s4 = cos[:, :, None, :], sin[:, :, None, :]
    q = jnp.concatenate([q[..., :QK_NOPE_DIM], rope(q[..., QK_NOPE_DIM:], c4, s4)], axis=-1)
    k = jnp.concatenate([k[..., :QK_NOPE_DIM], rope(k[..., QK_NOPE_DIM:], c4, s4)], axis=-1)
    scale = QK_HEAD_DIM ** -0.5
    n_blocks = S // Q_BLOCK
    q_blocks = q.reshape(B, n_blocks, Q_BLOCK, MLA_HEADS, QK_HEAD_DIM).transpose(1, 0, 2, 3, 4)
    key_pos = jnp.arange(S)

    def attend(args):
        qb, start = args
        s = jnp.einsum('bqhd,bkhd->bhqk', qb, k).astype(jnp.float32) * scale
        mask = (start + jnp.arange(Q_BLOCK))[:, None] >= key_pos[None, :]
        p = jax.nn.softmax(jnp.where(mask, s, -jnp.inf), axis=-1).astype(v.dtype)
        return jnp.einsum('bhqk,bkhd->bqhd', p, v)

    o = lax.map(attend, (q_blocks, jnp.arange(n_blocks) * Q_BLOCK))
    o = o.transpose(1, 0, 2, 3, 4).reshape(B, S, MLA_HEADS * V_HEAD_DIM)
    return rms_norm(o, g_out)


def mlstm_chunkwise(q, k, v, log_i, log_f):
    B, S, H, d = q.shape
    nc = S // CHUNK
    to_c4 = lambda t: t.reshape(B, nc, CHUNK, H, d).transpose(1, 0, 3, 2, 4)
    to_c3 = lambda t: t.reshape(B, nc, CHUNK, H).transpose(1, 0, 3, 2)
    tri = jnp.arange(CHUNK)[:, None] >= jnp.arange(CHUNK)[None, :]

    def step(carry, inp):
        C, n, m = carry
        qc, kc, vc, li, lf = inp
        b = jnp.cumsum(lf, axis=-1)
        dmat = jnp.where(tri, b[..., :, None] - b[..., None, :] + li[..., None, :], -jnp.inf)
        inter = b + m[..., None]
        mt = jnp.maximum(inter, jnp.max(dmat, axis=-1))
        w = jnp.exp(dmat - mt[..., None]) * jnp.einsum('bhtd,bhsd->bhts', qc, kc)
        decay = jnp.exp(inter - mt)
        num = decay[..., None] * jnp.einsum('bhed,bhtd->bhte', C, qc) + jnp.einsum('bhts,bhse->bhte', w, vc)
        den = decay * jnp.einsum('bhd,bhtd->bht', n, qc) + jnp.sum(w, axis=-1)
        h = num / jnp.maximum(jnp.abs(den), jnp.exp(-mt))[..., None]
        b_last = b[..., -1]
        g = b_last[..., None] - b + li
        m_new = jnp.maximum(b_last + m, jnp.max(g, axis=-1))
        a = jnp.exp(g - m_new[..., None])
        carry_decay = jnp.exp(b_last + m - m_new)
        C = carry_decay[..., None, None] * C + jnp.einsum('bhs,bhse,bhsd->bhed', a, vc, kc)
        n = carry_decay[..., None] * n + jnp.einsum('bhs,bhsd->bhd', a, kc)
        return (C, n, m_new), h

    init = (jnp.zeros((B, H, d, d), jnp.float32), jnp.zeros((B, H, d), jnp.float32), jnp.zeros((B, H), jnp.float32))
    _, hs = lax.scan(step, init, (to_c4(q), to_c4(k), to_c4(v), to_c3(log_i), to_c3(log_f)))
    return hs.transpose(1, 0, 3, 2, 4).reshape(B, S, H, d)


def mlstm_group(z, v, o_pre, i_pre, f_pre, conv_w, conv_b, w_mq, w_mk, b_igate, b_fgate, g_out):
    B, S, _ = z.shape
    zc = lax.conv_general_dilated(z, conv_w, window_strides=(1,), padding=[(CONV_WIDTH - 1, 0)],
                                  dimension_numbers=('NWC', 'WIO', 'NWC'),
                                  feature_group_count=MLSTM_INNER) + conv_b
    zc = jax.nn.silu(zc).reshape(B, S, MLSTM_HEADS, MLSTM_HEAD_DIM)
    q = jnp.einsum('bshd,hde->bshe', zc, w_mq)
    k = jnp.einsum('bshd,hde->bshe', zc, w_mk) * (MLSTM_HEAD_DIM ** -0.5)
    v = v.reshape(B, S, MLSTM_HEADS, MLSTM_HEAD_DIM)
    log_i = (i_pre + b_igate).astype(jnp.float32)
    log_f = jax.nn.log_sigmoid((f_pre + b_fgate).astype(jnp.float32))
    h = mlstm_chunkwise(q.astype(jnp.float32), k.astype(jnp.float32), v.astype(jnp.float32), log_i, log_f)
    h = rms_norm(h, g_out.reshape(MLSTM_HEADS, MLSTM_HEAD_DIM)).reshape(B, S, MLSTM_INNER)
    return (jax.nn.sigmoid(o_pre.astype(jnp.float32)) * h).astype(z.dtype)


def moe_ffn(h, w_router, router_bias, w_gate_exp, w_up_exp, w_down_exp, w_gate_sh, w_up_sh, w_down_sh):
    B, S, D = h.shape
    T = B * S
    hf = h.reshape(T, D)
    shared = (jax.nn.silu(hf @ w_gate_sh) * (hf @ w_up_sh)) @ w_down_sh
    scores = jax.nn.sigmoid((hf @ w_router).astype(jnp.float32))
    grouped = (scores + router_bias.astype(jnp.float32)).reshape(T, N_GROUPS, N_EXPERTS // N_GROUPS)
    group_score = jnp.sum(lax.top_k(grouped, 2)[0], axis=-1)
    _, top_groups = lax.top_k(group_score, TOPK_GROUPS)
    group_keep = jnp.any(top_groups[:, :, None] == jnp.arange(N_GROUPS)[None, None, :], axis=1)
    masked = jnp.where(group_keep[:, :, None], grouped, -jnp.inf).reshape(T, N_EXPERTS)
    _, expert_idx = lax.top_k(masked, TOP_K)
    gate_w = jnp.take_along_axis(scores, expert_idx, axis=-1)
    gate_w = gate_w / jnp.sum(gate_w, axis=-1, keepdims=True) * ROUTED_SCALE
    A = T * TOP_K
    n_blocks = -(-A // MOE_BLOCK) + N_EXPERTS
    flat_e = expert_idx.reshape(A)
    flat_tok = jnp.arange(A, dtype=jnp.int32) // TOP_K
    order = jnp.argsort(flat_e)
    sorted_e = flat_e[order]
    counts = jnp.bincount(flat_e, length=N_EXPERTS)
    starts = jnp.cumsum(counts) - counts
    padded = (counts + MOE_BLOCK - 1) // MOE_BLOCK * MOE_BLOCK
    padded_end = jnp.cumsum(padded)
    dest = (padded_end - padded)[sorted_e] + jnp.arange(A, dtype=jnp.int32) - starts[sorted_e]
    row_tok = jnp.zeros((n_blocks * MOE_BLOCK,), jnp.int32).at[dest].set(flat_tok[order])
    row_w = jnp.zeros((n_blocks * MOE_BLOCK,), jnp.float32).at[dest].set(gate_w.reshape(A)[order])
    block_e = jnp.minimum(jnp.searchsorted(padded_end, jnp.arange(n_blocks) * MOE_BLOCK, side='right'), N_EXPERTS - 1)

    def expert_block(acc, blk):
        tok, wt, e = blk
        xb = hf[tok]
        act = jax.nn.silu(xb @ w_gate_exp[e]) * (xb @ w_up_exp[e])
        y = (act @ w_down_exp[e]) * wt[:, None].astype(xb.dtype)
        return acc.at[tok].add(y), None

    routed, _ = lax.scan(expert_block, jnp.zeros_like(hf),
                         (row_tok.reshape(n_blocks, MOE_BLOCK), row_w.reshape(n_blocks, MOE_BLOCK), block_e))
    return (shared + routed).reshape(B, S, D)


def setup_inputs(seed: int = 0) -> dict:
    key = jax.random.key(seed)
    ks = iter(jax.random.split(key, 40))
    nrm = lambda shape, s: jax.random.normal(next(ks), shape, jnp.float32) * s
    gain = lambda shape: 1.0 + nrm(shape, 0.02)
    L = DEPTH
    x = nrm((BATCH, SEQ, D_MODEL), 1.0)
    c = nrm((BATCH, D_MODEL), 1.0)
    offsets = jax.random.randint(next(ks), (BATCH, 1), 0, 4096, dtype=jnp.int32)
    positions = offsets + jnp.arange(SEQ, dtype=jnp.int32)[None, :]
    return {
        'x': x, 'c': c, 'positions': positions,
        'w_ada': nrm((L, D_MODEL, 6 * D_MODEL), 0.5 * D_MODEL ** -0.5),
        'b_ada': nrm((L, 6 * D_MODEL), 0.02),
        'g_norm1': gain((L, D_MODEL)),
        'w_in': nrm((L, D_MODEL, IN_DIM), D_MODEL ** -0.5),
        'g_cq': gain((L, Q_LORA_RANK)),
        'w_uq': nrm((L, Q_LORA_RANK, MLA_HEADS * QK_HEAD_DIM), Q_LORA_RANK ** -0.5),
        'g_ckv': gain((L, KV_LORA_RANK)),
        'w_ukv': nrm((L, KV_LORA_RANK, MLA_HEADS * (QK_NOPE_DIM + V_HEAD_DIM)), KV_LORA_RANK ** -0.5),
        'g_qn': gain((L, QK_HEAD_DIM)),
        'g_kn': gain((L, QK_HEAD_DIM)),
        'g_attn_out': gain((L, MLA_HEADS * V_HEAD_DIM)),
        'conv_w': nrm((L, CONV_WIDTH, 1, MLSTM_INNER), CONV_WIDTH ** -0.5),
        'conv_b': nrm((L, MLSTM_INNER), 0.02),
        'w_mq': nrm((L, MLSTM_HEADS, MLSTM_HEAD_DIM, MLSTM_HEAD_DIM), MLSTM_HEAD_DIM ** -0.5),
        'w_mk': nrm((L, MLSTM_HEADS, MLSTM_HEAD_DIM, MLSTM_HEAD_DIM), MLSTM_HEAD_DIM ** -0.5),
        'b_igate': nrm((L, MLSTM_HEADS), 0.1),
        'b_fgate': 3.0 + nrm((L, MLSTM_HEADS), 0.1),
        'g_mlstm_out': gain((L, MLSTM_INNER)),
        'w_out': nrm((L, MIX_WIDTH, D_MODEL), MIX_WIDTH ** -0.5),
        'g_norm2': gain((L, D_MODEL)),
        'w_router': nrm((L, D_MODEL, N_EXPERTS), D_MODEL ** -0.5),
        'router_bias': nrm((L, N_EXPERTS), 0.01),
        'w_gate_exp': nrm((L, N_EXPERTS, D_MODEL, EXPERT_DIM), D_MODEL ** -0.5),
        'w_up_exp': nrm((L, N_EXPERTS, D_MODEL, EXPERT_DIM), D_MODEL ** -0.5),
        'w_down_exp': nrm((L, N_EXPERTS, EXPERT_DIM, D_MODEL), EXPERT_DIM ** -0.5),
        'w_gate_sh': nrm((L, D_MODEL, SHARED_DIM), D_MODEL ** -0.5),
        'w_up_sh': nrm((L, D_MODEL, SHARED_DIM), D_MODEL ** -0.5),
        'w_down_sh': nrm((L, SHARED_DIM, D_MODEL), SHARED_DIM ** -0.5),
    }


def reference(x, c, positions, w_ada, b_ada, g_norm1, w_in, g_cq, w_uq, g_ckv, w_ukv, g_qn, g_kn, g_attn_out,
              conv_w, conv_b, w_mq, w_mk, b_igate, b_fgate, g_mlstm_out, w_out, g_norm2, w_router, router_bias,
              w_gate_exp, w_up_exp, w_down_exp, w_gate_sh, w_up_sh, w_down_sh):
    inv_freq = ROPE_THETA ** (-jnp.arange(0, QK_ROPE_DIM, 2, dtype=jnp.float32) / QK_ROPE_DIM)
    ang = positions.astype(jnp.float32)[..., None] * inv_freq
    cos = jnp.cos(ang).astype(x.dtype)
    sin = jnp.sin(ang).astype(x.dtype)
    cond = jax.nn.silu(c)
    split_points = np.cumsum(IN_WIDTHS)[:-1].tolist()
    for l in range(DEPTH):
        ada = cond @ w_ada[l] + b_ada[l]
        sh1, sc1, gt1, sh2, sc2, gt2 = jnp.split(ada, 6, axis=-1)
        h = modulate(rms_norm(x, g_norm1[l]), sh1, sc1)
        proj = h @ w_in[l]
        cq, ckv, k_rope, z, mv, mo, mi, mf = jnp.split(proj, split_points, axis=-1)
        attn_o = mla_group(cq, ckv, k_rope, cos, sin, g_cq[l], w_uq[l], g_ckv[l], w_ukv[l], g_qn[l], g_kn[l], g_attn_out[l])
        mlstm_o = mlstm_group(z, mv, mo, mi, mf, conv_w[l], conv_b[l], w_mq[l], w_mk[l], b_igate[l], b_fgate[l], g_mlstm_out[l])
        mix = jnp.concatenate([attn_o, mlstm_o], axis=-1) @ w_out[l]
        x = x + gt1[:, None, :] * mix
        h2 = modulate(rms_norm(x, g_norm2[l]), sh2, sc2)
        ffn = moe_ffn(h2, w_router[l], router_bias[l], w_gate_exp[l], w_up_exp[l], w_down_exp[l],
                      w_gate_sh[l], w_up_sh[l], w_down_sh[l])
        x = x + gt2[:, None, :] * ffn
    return x
```

```cpp
#include <hip/hip_runtime.h>
#include <hip/hip_cooperative_groups.h>
#include <cstdio>
#include <cstdint>
namespace cg = cooperative_groups;
#ifndef DBG_STAGE
#define DBG_STAGE 0
#endif

#define LAS __attribute__((address_space(3)))
typedef unsigned short bf16_t;
typedef short bf16x8 __attribute__((ext_vector_type(8)));
typedef short bf16x4 __attribute__((ext_vector_type(4)));
typedef float f32x4 __attribute__((ext_vector_type(4)));
typedef float f32x2 __attribute__((ext_vector_type(2)));
typedef unsigned u32x4 __attribute__((ext_vector_type(4)));
typedef unsigned u32x2 __attribute__((ext_vector_type(2)));

constexpr int NT = 512, NWAVES = 8;
constexpr int LDS_BYTES = 128 * 1024;
constexpr int Bsz = 8, S = 2048, D = 1024, T = Bsz * S;
constexpr int H_MLA = 8, DQK = 96, DNOPE = 64, DROPE = 32, DV = 64, QLORA = 384, KVLORA = 256;
constexpr int H_ML = 4, DM = 128, MINNER = 512, CHUNK = 64, NCH = S / CHUNK;
constexpr int IN_DIM = 2216;
constexpr int OFF_CQ = 0, OFF_CKV = 384, OFF_KR = 640, OFF_Z = 672, OFF_MV = 1184, OFF_MO = 1696, OFF_GATE = 2208;
constexpr int NE = 256, TOPK = 8, EDIM = 256, SDIM = 256;
constexpr int CAP = T;
constexpr float RMS_EPS = 1e-6f;

constexpr size_t MiB = 1u << 20;
constexpr size_t WS_CTL = 0;
constexpr size_t CTL_BYTES = 32768;
constexpr size_t WS_ADA = 1 * MiB;
constexpr size_t WS_BC = 2 * MiB;
constexpr size_t WS_MLOC = WS_BC + 8192;
constexpr size_t WS_MPREV = WS_BC + 16384;
constexpr size_t WS_DN = 2 * MiB + 512 * 1024;
constexpr size_t WS_NPREV = 3 * MiB;
constexpr size_t WS_WIN = 4 * MiB;
constexpr size_t WS_WUQ = 9 * MiB;
constexpr size_t WS_WUKV = 10 * MiB;
constexpr size_t WS_WMQK = 11 * MiB;
constexpr size_t WS_WOUT = 12 * MiB;
constexpr size_t WS_WRGU = 14 * MiB;
constexpr size_t WS_WDSH = 16 * MiB;
constexpr size_t WS_WGU = 32 * MiB;
constexpr size_t WS_WD = 288 * MiB;
constexpr size_t RB = 416 * MiB;
constexpr size_t B_PROJ = RB;
constexpr size_t B_GRAW = RB + 70 * MiB;
constexpr size_t B_GL = RB + 71 * MiB;
constexpr size_t B_H1 = RB + 72 * MiB;
constexpr size_t B_CQN = RB + 104 * MiB;
constexpr size_t B_CKVN = RB + 116 * MiB;
constexpr size_t B_ZC = RB + 124 * MiB;
constexpr size_t B_QRAW = RB + 140 * MiB;
constexpr size_t B_KVRAW = RB + 164 * MiB;
constexpr size_t B_MQ = RB + 196 * MiB;
constexpr size_t B_MK = RB + 212 * MiB;
constexpr size_t B_Q = RB + 228 * MiB;
constexpr size_t B_K = RB + 252 * MiB;
constexpr size_t B_ORAW = RB + 276 * MiB;
constexpr size_t B_AO = RB + 292 * MiB;
constexpr size_t B_DC = RB + 324 * MiB;
constexpr size_t B_CPREV = RB + 388 * MiB;
constexpr size_t C_H2 = RB;
constexpr size_t C_LOGITS = RB + 32 * MiB;
constexpr size_t C_ACTSH = RB + 48 * MiB;
constexpr size_t C_SHOUT = RB + 56 * MiB;
constexpr size_t C_TOKE = RB + 88 * MiB;
constexpr size_t C_TOKW = RB + 89 * MiB;
constexpr size_t C_TOKPOS = RB + 90 * MiB;
constexpr size_t C_LISTTOK = RB + 92 * MiB;
constexpr size_t C_LISTW = RB + 108 * MiB;
constexpr size_t C_ACTE = RB + 124 * MiB;
constexpr size_t C_Y = RB + 188 * MiB;
constexpr size_t WS_END = RB + 444 * MiB;

struct Params {
    const float* in[31];
    float* out;
    unsigned char* ws;
};

typedef __bf16 bf16x2v __attribute__((ext_vector_type(2)));
__device__ __forceinline__ unsigned cvt_pk_bf16(float lo, float hi) { f32x2 v = {lo, hi}; bf16x2v b = __builtin_convertvector(v, bf16x2v); return __builtin_bit_cast(unsigned, b); }
__device__ __forceinline__ float bf2f(unsigned short b) { return __uint_as_float((unsigned)b << 16); }
__device__ __forceinline__ float bflo(unsigned u) { return __uint_as_float(u << 16); }
__device__ __forceinline__ float bfhi(unsigned u) { return __uint_as_float(u & 0xffff0000u); }
__device__ __forceinline__ float wave_sum(float v) {
#pragma unroll
    for (int o = 1; o < 64; o <<= 1) v += __shfl_xor(v, o);
    return v;
}
__device__ __forceinline__ float wave_max(float v) {
#pragma unroll
    for (int o = 1; o < 64; o <<= 1) v = fmaxf(v, __shfl_xor(v, o));
    return v;
}
__device__ __forceinline__ float sigmoidf_(float x) { return 1.f / (1.f + __expf(-x)); }
__device__ __forceinline__ float siluf_(float x) { return x / (1.f + __expf(-x)); }
#define MFMA16(a, b, c) __builtin_amdgcn_mfma_f32_16x16x32_bf16((a), (b), (c), 0, 0, 0)


#define XB_TMO      128
#define XB_XCNT(j)  (256  + 64 * (j))
#define XB_XSUB(j)  (1280 + 64 * (j))
#define XB_XGEN(j)  (2304 + 64 * (j))
#define XB_TOP      3328
#define XB_TOPGEN   3392
#define XCD_BAR_WORDS 3456
#define XB_SPIN_CAP (1u << 23)
__device__ __forceinline__ unsigned xb_ld(unsigned* p)              { return __hip_atomic_load(p, __ATOMIC_RELAXED, __HIP_MEMORY_SCOPE_AGENT); }
__device__ __forceinline__ unsigned xb_add(unsigned* p, unsigned v) { return __hip_atomic_fetch_add(p, v, __ATOMIC_RELAXED, __HIP_MEMORY_SCOPE_AGENT); }
__device__ __forceinline__ unsigned xb_xcc_id() { return (unsigned)__builtin_amdgcn_s_getreg((3 << 11) | 20) & 0xFu; }
#define XB_SPIN(cond, bar) do { unsigned _sp = 0; while (cond) { __builtin_amdgcn_s_sleep(1); \
    if ((++_sp & 255u) == 0u) { if (xb_ld(&(bar)[XB_TMO])) break; if (_sp > XB_SPIN_CAP) { atomicAdd(&(bar)[XB_TMO], 1u); break; } } } } while (0)
struct XcdBarrier { unsigned* bar; unsigned x; volatile LAS unsigned* st; };
__device__ __forceinline__ XcdBarrier xcd_barrier_post(unsigned* bar, volatile LAS unsigned* st) {
    XcdBarrier b; b.bar = bar; b.x = xb_xcc_id(); b.st = st;
    if (threadIdx.x == 0) (void)xb_add(&bar[XB_XCNT(b.x)], 1u);
    return b;
}
__device__ __forceinline__ void xcd_barrier_complete(unsigned* bar, unsigned x, unsigned& nloc, unsigned& nx) {
    const unsigned G = gridDim.x * gridDim.y * gridDim.z;
    unsigned sum, cnt, mine, sp = 0u;
    for (;;) {
        sum = 0u; cnt = 0u; mine = 0u;
#pragma unroll
        for (unsigned j = 0; j < 16; ++j) { const unsigned c = xb_ld(&bar[XB_XCNT(j)]); sum += c; cnt += (c > 0u) ? 1u : 0u; mine = (j == x) ? c : mine; }
        if (sum == G) break;
        __builtin_amdgcn_s_sleep(1);
        if ((++sp & 255u) == 0u) { if (xb_ld(&bar[XB_TMO])) break; if (sp > XB_SPIN_CAP) { atomicAdd(&bar[XB_TMO], 1u); break; } }
    }
    nloc = mine > 0u ? mine : 1u; nx = cnt > 0u ? cnt : 1u;
}
__device__ __forceinline__ void xcd_barrier(const XcdBarrier& b) {
    asm volatile("s_waitcnt vmcnt(0)" ::: "memory");
    __syncthreads();
    if (threadIdx.x == 0) {
        unsigned* bar = b.bar;
        __builtin_amdgcn_s_waitcnt(0);
        unsigned nloc = b.st[0], nx = b.st[1];
        if (nloc == 0u) { xcd_barrier_complete(bar, b.x, nloc, nx); b.st[0] = nloc; b.st[1] = nx; }
        const unsigned old = xb_add(&bar[XB_XSUB(b.x)], 1u);
        const unsigned gen = old / nloc;
        if (old + 1u == (gen + 1u) * nloc) {
            __builtin_amdgcn_fence(__ATOMIC_RELEASE, "agent");
            asm volatile("s_waitcnt vmcnt(0)" ::: "memory");
            const unsigned og = xb_add(&bar[XB_TOP], 1u);
            const unsigned tg = og / nx;
            if (og + 1u == (tg + 1u) * nx) xb_add(&bar[XB_TOPGEN], 1u);
            else XB_SPIN(xb_ld(&bar[XB_TOPGEN]) == tg, bar);
            __builtin_amdgcn_fence(__ATOMIC_ACQUIRE, "agent");
            xb_add(&bar[XB_XGEN(b.x)], 1u);
            asm volatile("s_waitcnt vmcnt(0)" ::: "memory");
        } else {
            XB_SPIN(xb_ld(&bar[XB_XGEN(b.x)]) == gen, bar);
            __builtin_amdgcn_fence(__ATOMIC_ACQUIRE, "agent");
            asm volatile("s_waitcnt vmcnt(0)" ::: "memory");
        }
    }
    __syncthreads();
}

template <int MAP>
__device__ __forceinline__ int map_row(int n) {
    if (MAP == 0) return n;
    if (MAP == 1) return ((n >> 4) << 5) + (n & 15);
    return ((n >> 4) << 5) + 16 + (n & 15);
}
template <int MAP>
__device__ __forceinline__ void conv_batch(const float* src, int nmat, int K, int N, bf16_t* dst, size_t dst_mat_stride, int row_off,
                                           LAS float* scr, int gw, int ngw, int lane) {
    const int nblk = (N + 31) / 32, kblk = K / 64, per = nblk * kblk;
    const int total = nmat * per;
    for (int it = gw; it < total; it += ngw) {
        const int mat = it / per, r = it - mat * per, kb = r / nblk, nb = r - kb * nblk, k0 = kb * 64, n0 = nb * 32;
        const float* W = src + (size_t)mat * K * N;
        bf16_t* WT = dst + (size_t)mat * dst_mat_stride;
        const int nn = n0 + (lane & 31);
        const bool nok = nn < N;
#pragma unroll 8
        for (int i = 0; i < 32; ++i) { const int kk = 2 * i + (lane >> 5); scr[kk * 33 + (lane & 31)] = nok ? W[(size_t)(k0 + kk) * N + nn] : 0.f; }
        asm volatile("s_waitcnt lgkmcnt(0)" ::: "memory");
        const int c = lane & 7;
#pragma unroll
        for (int j = 0; j < 4; ++j) {
            const int n = (lane >> 3) + 8 * j;
            const LAS float* s = scr + (8 * c) * 33 + n;
            u32x4 o; o.x = cvt_pk_bf16(s[0 * 33], s[1 * 33]); o.y = cvt_pk_bf16(s[2 * 33], s[3 * 33]); o.z = cvt_pk_bf16(s[4 * 33], s[5 * 33]); o.w = cvt_pk_bf16(s[6 * 33], s[7 * 33]);
            if (n0 + n < N) *(u32x4*)(WT + (size_t)(row_off + map_row<MAP>(n0 + n)) * K + k0 + 8 * c) = o;
        }
        asm volatile("s_waitcnt lgkmcnt(0)" ::: "memory");
    }
}

__device__ __forceinline__ void ada_unit(const Params& p, LAS unsigned char* lds, int u, int tid) {
    LAS float* cond = (LAS float*)lds;
    LAS float* red = (LAS float*)(lds + 32768);
    const float* c = p.in[1]; const float* w = p.in[3]; const float* bias = p.in[4];
    float* ada = (float*)(p.ws + WS_ADA);
    const int lane = tid & 63, wv = tid >> 6;
    for (int i = tid; i < 8 * 1024; i += NT) cond[i] = siluf_(c[i]);
    __syncthreads();
    float acc[8];
#pragma unroll
    for (int b = 0; b < 8; ++b) acc[b] = 0.f;
    const int col = u * 64 + lane;
#pragma unroll 4
    for (int k = wv * 128; k < wv * 128 + 128; ++k) {
        const float wv_ = w[(size_t)k * 6144 + col];
#pragma unroll
        for (int b = 0; b < 8; ++b) acc[b] += cond[b * 1024 + k] * wv_;
    }
#pragma unroll
    for (int b = 0; b < 8; ++b) red[(wv * 8 + b) * 64 + lane] = acc[b];
    __syncthreads();
    {
        const int b = tid >> 6;
        float s = 0.f;
#pragma unroll
        for (int w2 = 0; w2 < 8; ++w2) s += red[(w2 * 8 + b) * 64 + lane];
        ada[b * 6144 + col] = s + bias[col];
    }
    __syncthreads();
}

__device__ __forceinline__ void norm_mod_rows(const float* X, const float* g, const float* ada, int sh_off, int sc_off, bf16_t* Hout, int gw, int ngw, int lane) {
    for (int row = gw; row < T; row += ngw) {
        const int b = row / S;
        const f32x4* xr = (const f32x4*)(X + (size_t)row * D) + lane;
        f32x4 v[4]; float ss = 0.f;
#pragma unroll
        for (int j = 0; j < 4; ++j) { v[j] = xr[64 * j]; ss += v[j].x * v[j].x + v[j].y * v[j].y + v[j].z * v[j].z + v[j].w * v[j].w; }
        const float rinv = rsqrtf(wave_sum(ss) * (1.f / D) + RMS_EPS);
        u32x2* o = (u32x2*)(Hout + (size_t)row * D) + lane;
#pragma unroll
        for (int j = 0; j < 4; ++j) {
            const int k = 4 * (lane + 64 * j);
            const f32x4 gg = *(const f32x4*)(g + k), sc = *(const f32x4*)(ada + b * 6144 + sc_off + k), sh = *(const f32x4*)(ada + b * 6144 + sh_off + k);
            const f32x4 h = v[j] * rinv * gg * (1.f + sc) + sh;
            u32x2 w; w.x = cvt_pk_bf16(h.x, h.y); w.y = cvt_pk_bf16(h.z, h.w);
            o[64 * j] = w;
        }
    }
}

__device__ __forceinline__ void post_proj_rows(const Params& p, int gw, int ngw, int lane) {
    const bf16_t* proj = (const bf16_t*)(p.ws + B_PROJ);
    const float* graw = (const float*)(p.ws + B_GRAW);
    float* gl = (float*)(p.ws + B_GL);
    bf16_t* cqn = (bf16_t*)(p.ws + B_CQN); bf16_t* ckvn = (bf16_t*)(p.ws + B_CKVN); bf16_t* zc = (bf16_t*)(p.ws + B_ZC);
    const float* g_cq = p.in[7]; const float* g_ckv = p.in[9]; const float* conv_w = p.in[14]; const float* conv_b = p.in[15];
    const float* b_i = p.in[18]; const float* b_f = p.in[19];
    for (int row = gw; row < T; row += ngw) {
        const bf16_t* pr = proj + (size_t)row * IN_DIM;
        const int s = row % S;
        {
            const unsigned* q = (const unsigned*)(pr + OFF_CQ) + lane * 3;
            unsigned a0 = q[0], a1 = q[1], a2 = q[2];
            float f[6] = {bflo(a0), bfhi(a0), bflo(a1), bfhi(a1), bflo(a2), bfhi(a2)};
            float ss = 0.f;
#pragma unroll
            for (int j = 0; j < 6; ++j) ss += f[j] * f[j];
            const float rinv = rsqrtf(wave_sum(ss) * (1.f / QLORA) + RMS_EPS);
            const float* gq = g_cq + lane * 6;
            unsigned* o = (unsigned*)(cqn + (size_t)row * QLORA) + lane * 3;
            o[0] = cvt_pk_bf16(f[0] * rinv * gq[0], f[1] * rinv * gq[1]);
            o[1] = cvt_pk_bf16(f[2] * rinv * gq[2], f[3] * rinv * gq[3]);
            o[2] = cvt_pk_bf16(f[4] * rinv * gq[4], f[5] * rinv * gq[5]);
        }
        {
            const u32x2 a = *((const u32x2*)(pr + OFF_CKV) + lane);
            float f[4] = {bflo(a.x), bfhi(a.x), bflo(a.y), bfhi(a.y)};
            float ss = f[0] * f[0] + f[1] * f[1] + f[2] * f[2] + f[3] * f[3];
            const float rinv = rsqrtf(wave_sum(ss) * (1.f / KVLORA) + RMS_EPS);
            const float* gk = g_ckv + lane * 4;
            u32x2 w; w.x = cvt_pk_bf16(f[0] * rinv * gk[0], f[1] * rinv * gk[1]); w.y = cvt_pk_bf16(f[2] * rinv * gk[2], f[3] * rinv * gk[3]);
            *((u32x2*)(ckvn + (size_t)row * KVLORA) + lane) = w;
        }
        {
            const int c0 = lane * 8;
            float acc[8];
#pragma unroll
            for (int j = 0; j < 8; ++j) acc[j] = conv_b[c0 + j];
#pragma unroll
            for (int tap = 0; tap < 4; ++tap) {
                const int ds = tap - 3;
                if (s + ds >= 0) {
                    const u32x4 z = *(const u32x4*)(pr + (ptrdiff_t)ds * IN_DIM + OFF_Z + c0);
                    const float* cw = conv_w + tap * MINNER + c0;
                    acc[0] += bflo(z.x) * cw[0]; acc[1] += bfhi(z.x) * cw[1]; acc[2] += bflo(z.y) * cw[2]; acc[3] += bfhi(z.y) * cw[3];
                    acc[4] += bflo(z.z) * cw[4]; acc[5] += bfhi(z.z) * cw[5]; acc[6] += bflo(z.w) * cw[6]; acc[7] += bfhi(z.w) * cw[7];
                }
            }
            u32x4 o; o.x = cvt_pk_bf16(siluf_(acc[0]), siluf_(acc[1])); o.y = cvt_pk_bf16(siluf_(acc[2]), siluf_(acc[3]));
            o.z = cvt_pk_bf16(siluf_(acc[4]), siluf_(acc[5])); o.w = cvt_pk_bf16(siluf_(acc[6]), siluf_(acc[7]));
            *(u32x4*)(zc + (size_t)row * MINNER + c0) = o;
        }
        if (lane < 8) {
            const float gr = graw[(size_t)row * 8 + lane];
            float o;
            if (lane < 4) o = gr + b_i[lane];
            else { const float xx = gr + b_f[lane - 4]; o = fminf(xx, 0.f) - log1pf(__expf(-fabsf(xx))); }
            gl[(size_t)row * 8 + lane] = o;
        }
    }
}

__device__ __forceinline__ void qk_post_rows(const Params& p, int gw, int ngw, int lane) {
    const bf16_t* qraw = (const bf16_t*)(p.ws + B_QRAW); const bf16_t* kvraw = (const bf16_t*)(p.ws + B_KVRAW);
    const bf16_t* proj = (const bf16_t*)(p.ws + B_PROJ);
    bf16_t* Q = (bf16_t*)(p.ws + B_Q); bf16_t* Kb = (bf16_t*)(p.ws + B_K);
    const int* positions = (const int*)p.in[2];
    const float* g_qn = p.in[11]; const float* g_kn = p.in[12];
    const float qscale = 0.10206207261596575f * 1.4426950408889634f;
    for (int it = gw; it < T * 4; it += ngw) {
        const int row = it >> 2, hp = it & 3, h = hp * 2 + (lane >> 5), l = lane & 31;
        const int b = row / S, s = row % S;
        const float pos = (float)positions[row];
        const int i = l & 15;
        const float inv_freq = exp2f(-(float)(2 * i) * (13.287712379549449f / 32.f));
        const float ang = pos * inv_freq;
        float sn, cs; sincosf(ang, &sn, &cs);
        {
            const bf16_t* qr = qraw + (size_t)row * 768 + h * 96;
            float v0 = bf2f(qr[l]), v1 = bf2f(qr[l + 32]), v2 = bf2f(qr[l + 64]);
            float ss = v0 * v0 + v1 * v1 + v2 * v2;
#pragma unroll
            for (int o = 1; o < 32; o <<= 1) ss += __shfl_xor(ss, o);
            const float rinv = rsqrtf(ss * (1.f / 96.f) + RMS_EPS);
            v0 *= rinv * g_qn[l]; v1 *= rinv * g_qn[l + 32]; v2 *= rinv * g_qn[l + 64];
            const float other = __shfl_xor(v2, 16);
            const float r = (l < 16) ? (v2 * cs - other * sn) : (other * sn + v2 * cs);
            bf16_t* qo = Q + ((size_t)(b * H_MLA + h) * S + s) * 96;
            qo[l] = (bf16_t)(cvt_pk_bf16(v0 * qscale, 0.f) & 0xffff);
            qo[l + 32] = (bf16_t)(cvt_pk_bf16(v1 * qscale, 0.f) & 0xffff);
            qo[l + 64] = (bf16_t)(cvt_pk_bf16(r * qscale, 0.f) & 0xffff);
        }
        {
            const bf16_t* kr = kvraw + (size_t)row * 1024 + h * 128;
            float v0 = bf2f(kr[l]), v1 = bf2f(kr[l + 32]), v2 = bf2f(proj[(size_t)row * IN_DIM + OFF_KR + l]);
            float ss = v0 * v0 + v1 * v1 + v2 * v2;
#pragma unroll
            for (int o = 1; o < 32; o <<= 1) ss += __shfl_xor(ss, o);
            const float rinv = rsqrtf(ss * (1.f / 96.f) + RMS_EPS);
            v0 *= rinv * g_kn[l]; v1 *= rinv * g_kn[l + 32]; v2 *= rinv * g_kn[l + 64];
            const float other = __shfl_xor(v2, 16);
            const float r = (l < 16) ? (v2 * cs - other * sn) : (other * sn + v2 * cs);
            bf16_t* ko = Kb + ((size_t)(b * H_MLA + h) * S + s) * 96;
            ko[l] = (bf16_t)(cvt_pk_bf16(v0, 0.f) & 0xffff);
            ko[l + 32] = (bf16_t)(cvt_pk_bf16(v1, 0.f) & 0xffff);
            ko[l + 64] = (bf16_t)(cvt_pk_bf16(r, 0.f) & 0xffff);
        }
    }
}

__device__ __forceinline__ void attn_out_norm_rows(const Params& p, int gw, int ngw, int lane) {
    const bf16_t* oraw = (const bf16_t*)(p.ws + B_ORAW); bf16_t* ao = (bf16_t*)(p.ws + B_AO); const float* g = p.in[13];
    for (int row = gw; row < T; row += ngw) {
        const u32x4 a = *((const u32x4*)(oraw + (size_t)row * 512) + lane);
        float f[8] = {bflo(a.x), bfhi(a.x), bflo(a.y), bfhi(a.y), bflo(a.z), bfhi(a.z), bflo(a.w), bfhi(a.w)};
        float ss = 0.f;
#pragma unroll
        for (int j = 0; j < 8; ++j) ss += f[j] * f[j];
        const float rinv = rsqrtf(wave_sum(ss) * (1.f / 512.f) + RMS_EPS);
        const float* gg = g + lane * 8;
        u32x4 o; o.x = cvt_pk_bf16(f[0] * rinv * gg[0], f[1] * rinv * gg[1]); o.y = cvt_pk_bf16(f[2] * rinv * gg[2], f[3] * rinv * gg[3]);
        o.z = cvt_pk_bf16(f[4] * rinv * gg[4], f[5] * rinv * gg[5]); o.w = cvt_pk_bf16(f[6] * rinv * gg[6], f[7] * rinv * gg[7]);
        *((u32x4*)(ao + (size_t)row * 1024) + lane) = o;
    }
}

constexpr int GLD = 72;
constexpr int GEMM_LDS = 2 * 128 * GLD * 2;
template <class RowPtr, class Epi>
__device__ __forceinline__ void gemm_tile(LAS unsigned char* lds, const RowPtr& RP, const bf16_t* Bt, int ldb, int N, int K, int m0, int n0, const Epi& E) {
    LAS bf16_t* As = (LAS bf16_t*)lds;
    LAS bf16_t* Bs = As + 128 * GLD;
    const int tid = threadIdx.x, lane = tid & 63, wid = tid >> 6, wm = wid >> 2, wn = wid & 3;
    const int sr = tid >> 2, sk = (tid & 3) * 16;
    const bf16_t* ap = RP(m0 + sr);
    const bf16_t* bp = (n0 + sr < N) ? Bt + (size_t)(n0 + sr) * ldb : nullptr;
    f32x4 acc[4][2];
#pragma unroll
    for (int m = 0; m < 4; ++m)
#pragma unroll
        for (int n = 0; n < 2; ++n) acc[m][n] = (f32x4){0.f, 0.f, 0.f, 0.f};
    u32x4 ra0, ra1, rb0, rb1;
    const u32x4 z4 = (u32x4){0u, 0u, 0u, 0u};
    ra0 = ap ? *(const u32x4*)(ap + sk) : z4; ra1 = ap ? *(const u32x4*)(ap + sk + 8) : z4;
    rb0 = bp ? *(const u32x4*)(bp + sk) : z4; rb1 = bp ? *(const u32x4*)(bp + sk + 8) : z4;
    const int nk = K / 64;
    const int fr = lane & 15, fq = lane >> 4;
    for (int kt = 0; kt < nk; ++kt) {
        *(LAS u32x4*)(As + sr * GLD + sk) = ra0; *(LAS u32x4*)(As + sr * GLD + sk + 8) = ra1;
        *(LAS u32x4*)(Bs + sr * GLD + sk) = rb0; *(LAS u32x4*)(Bs + sr * GLD + sk + 8) = rb1;
        __syncthreads();
        if (kt + 1 < nk) {
            const int k0 = (kt + 1) * 64 + sk;
            ra0 = ap ? *(const u32x4*)(ap + k0) : z4; ra1 = ap ? *(const u32x4*)(ap + k0 + 8) : z4;
            rb0 = bp ? *(const u32x4*)(bp + k0) : z4; rb1 = bp ? *(const u32x4*)(bp + k0 + 8) : z4;
        }
#pragma unroll
        for (int ks = 0; ks < 2; ++ks) {
            bf16x8 af[4], bfr[2];
#pragma unroll
            for (int m = 0; m < 4; ++m) af[m] = *(const LAS bf16x8*)(As + (wm * 64 + m * 16 + fr) * GLD + ks * 32 + fq * 8);
#pragma unroll
            for (int n = 0; n < 2; ++n) bfr[n] = *(const LAS bf16x8*)(Bs + (wn * 32 + n * 16 + fr) * GLD + ks * 32 + fq * 8);
#pragma unroll
            for (int m = 0; m < 4; ++m)
#pragma unroll
                for (int n = 0; n < 2; ++n) acc[m][n] = MFMA16(bfr[n], af[m], acc[m][n]);
        }
        __syncthreads();
    }
    E(acc, m0 + wm * 64, n0 + wn * 32, lane);
}

struct RowDense { const bf16_t* A; int lda; __device__ __forceinline__ const bf16_t* operator()(int r) const { return A + (size_t)r * lda; } };

struct EpiProj {
    bf16_t* proj; float* graw;
    __device__ __forceinline__ void operator()(const f32x4 (&acc)[4][2], int rb, int cb, int lane) const {
        const int fr = lane & 15, fq = lane >> 4;
#pragma unroll
        for (int m = 0; m < 4; ++m)
#pragma unroll
            for (int n = 0; n < 2; ++n) {
                const int row = rb + m * 16 + fr, col = cb + n * 16 + 4 * fq; const f32x4 v = acc[m][n];
                if (col < OFF_GATE) { u32x2 w; w.x = cvt_pk_bf16(v.x, v.y); w.y = cvt_pk_bf16(v.z, v.w); *(u32x2*)(proj + (size_t)row * IN_DIM + col) = w; }
                else if (col < IN_DIM) *(f32x4*)(graw + (size_t)row * 8 + (col - OFF_GATE)) = v;
            }
    }
};
struct EpiBf16 {
    bf16_t* O; int ldc;
    __device__ __forceinline__ void operator()(const f32x4 (&acc)[4][2], int rb, int cb, int lane) const {
        const int fr = lane & 15, fq = lane >> 4;
#pragma unroll
        for (int m = 0; m < 4; ++m)
#pragma unroll
            for (int n = 0; n < 2; ++n) {
                const int row = rb + m * 16 + fr, col = cb + n * 16 + 4 * fq; const f32x4 v = acc[m][n];
                u32x2 w; w.x = cvt_pk_bf16(v.x, v.y); w.y = cvt_pk_bf16(v.z, v.w); *(u32x2*)(O + (size_t)row * ldc + col) = w;
            }
    }
};
struct EpiMqk {
    bf16_t* mq; bf16_t* mk; int h;
    __device__ __forceinline__ void operator()(const f32x4 (&acc)[4][2], int rb, int cb, int lane) const {
        const int fr = lane & 15, fq = lane >> 4;
#pragma unroll
        for (int m = 0; m < 4; ++m)
#pragma unroll
            for (int n = 0; n < 2; ++n) {
                const int row = rb + m * 16 + fr, col = cb + n * 16 + 4 * fq; f32x4 v = acc[m][n];
                bf16_t* dst = mq; int c = col;
                if (col >= 128) { dst = mk; c = col - 128; v = v * 0.08838834764831845f; }
                u32x2 w; w.x = cvt_pk_bf16(v.x, v.y); w.y = cvt_pk_bf16(v.z, v.w); *(u32x2*)(dst + (size_t)row * MINNER + h * DM + c) = w;
            }
    }
};
struct EpiResid {
    const float* X; const float* ada; int gt_off; float* out;
    __device__ __forceinline__ void operator()(const f32x4 (&acc)[4][2], int rb, int cb, int lane) const {
        const int fr = lane & 15, fq = lane >> 4;
#pragma unroll
        for (int m = 0; m < 4; ++m)
#pragma unroll
            for (int n = 0; n < 2; ++n) {
                const int row = rb + m * 16 + fr, col = cb + n * 16 + 4 * fq; const int b = row / S;
                const f32x4 g = *(const f32x4*)(ada + b * 6144 + gt_off + col);
                const f32x4 x = *(const f32x4*)(X + (size_t)row * D + col);
                *(f32x4*)(out + (size_t)row * D + col) = x + g * acc[m][n];
            }
    }
};
struct EpiRgu {
    float* logits; bf16_t* act;
    __device__ __forceinline__ void operator()(const f32x4 (&acc)[4][2], int rb, int cb, int lane) const {
        const int fr = lane & 15, fq = lane >> 4;
#pragma unroll
        for (int m = 0; m < 4; ++m) {
            const int row = rb + m * 16 + fr;
            if (cb < 256) {
#pragma unroll
                for (int n = 0; n < 2; ++n) *(f32x4*)(logits + (size_t)row * 256 + cb + n * 16 + 4 * fq) = acc[m][n];
            } else {
                const int j = (cb - 256) >> 5; const f32x4 g = acc[m][0], u = acc[m][1];
                u32x2 w; w.x = cvt_pk_bf16(siluf_(g.x) * u.x, siluf_(g.y) * u.y); w.y = cvt_pk_bf16(siluf_(g.z) * u.z, siluf_(g.w) * u.w);
                *(u32x2*)(act + (size_t)row * 256 + j * 16 + 4 * fq) = w;
            }
        }
    }
};
struct EpiExpAct {
    bf16_t* act; int slot0; int nvalid;
    __device__ __forceinline__ void operator()(const f32x4 (&acc)[4][2], int rb, int cb, int lane) const {
        const int fr = lane & 15, fq = lane >> 4;
#pragma unroll
        for (int m = 0; m < 4; ++m) {
            const int r = rb + m * 16 + fr;
            if (r < nvalid) {
                const int j = cb >> 5; const f32x4 g = acc[m][0], u = acc[m][1];
                u32x2 w; w.x = cvt_pk_bf16(siluf_(g.x) * u.x, siluf_(g.y) * u.y); w.y = cvt_pk_bf16(siluf_(g.z) * u.z, siluf_(g.w) * u.w);
                *(u32x2*)(act + (size_t)(slot0 + r) * 256 + j * 16 + 4 * fq) = w;
            }
        }
    }
};
struct EpiExpDown {
    bf16_t* y; const float* lw; int slot0; int nvalid;
    __device__ __forceinline__ void operator()(const f32x4 (&acc)[4][2], int rb, int cb, int lane) const {
        const int fr = lane & 15, fq = lane >> 4;
#pragma unroll
        for (int m = 0; m < 4; ++m) {
            const int r = rb + m * 16 + fr;
            if (r < nvalid) {
                const float wt = lw[r];
#pragma unroll
                for (int n = 0; n < 2; ++n) { const f32x4 v = acc[m][n] * wt; u32x2 w; w.x = cvt_pk_bf16(v.x, v.y); w.y = cvt_pk_bf16(v.z, v.w);
                    *(u32x2*)(y + (size_t)(slot0 + r) * 1024 + cb + n * 16 + 4 * fq) = w; }
            }
        }
    }
};
struct RowGather { const bf16_t* A; const int* idx; int nvalid; __device__ __forceinline__ const bf16_t* operator()(int r) const { return r < nvalid ? A + (size_t)idx[r] * D : nullptr; } };
struct RowSlots { const bf16_t* A; int nvalid; __device__ __forceinline__ const bf16_t* operator()(int r) const { return r < nvalid ? A + (size_t)r * EDIM : nullptr; } };

constexpr int AKLD = 104, AVLD = 72;
__device__ __forceinline__ void attn_unit(const Params& p, LAS unsigned char* lds, int bh, int qb) {
    LAS bf16_t* Ks = (LAS bf16_t*)lds;
    LAS bf16_t* Vt = Ks + 64 * AKLD;
    const bf16_t* Q = (const bf16_t*)(p.ws + B_Q) + (size_t)bh * S * 96;
    const bf16_t* Kg = (const bf16_t*)(p.ws + B_K) + (size_t)bh * S * 96;
    const int b = bh >> 3, h = bh & 7;
    const bf16_t* Vg = (const bf16_t*)(p.ws + B_KVRAW) + (size_t)b * S * 1024 + h * 128 + 64;
    bf16_t* O = (bf16_t*)(p.ws + B_ORAW) + (size_t)b * S * 512 + h * 64;
    const int tid = threadIdx.x, lane = tid & 63, wid = tid >> 6, fr = lane & 15, fq = lane >> 4;
    const int q0 = qb * 256, qw0 = q0 + wid * 32;
    bf16x8 qf[2][3];
#pragma unroll
    for (int nq = 0; nq < 2; ++nq)
#pragma unroll
        for (int ks = 0; ks < 3; ++ks) qf[nq][ks] = *(const bf16x8*)(Q + (size_t)(qw0 + nq * 16 + fr) * 96 + ks * 32 + fq * 8);
    f32x4 oacc[4][2];
#pragma unroll
    for (int d = 0; d < 4; ++d)
#pragma unroll
        for (int nq = 0; nq < 2; ++nq) oacc[d][nq] = (f32x4){0.f, 0.f, 0.f, 0.f};
    float mrun[2] = {-1e30f, -1e30f}, lrun[2] = {0.f, 0.f};
    const int ntiles = (q0 + 256) / 64;
    for (int kt = 0; kt < ntiles; ++kt) {
        const int k0 = kt * 64;
        for (int c = tid; c < 768; c += NT) { const int r = c / 12, cc = c - r * 12; *(LAS u32x4*)(Ks + r * AKLD + cc * 8) = *(const u32x4*)(Kg + (size_t)(k0 + r) * 96 + cc * 8); }
        {
            const int key = tid & 63, dc = tid >> 6;
            const u32x4 v = *(const u32x4*)(Vg + (size_t)(k0 + key) * 1024 + dc * 8);
            LAS bf16_t* vt = Vt + (dc * 8) * AVLD + key;
            vt[0 * AVLD] = (bf16_t)(v.x & 0xffff); vt[1 * AVLD] = (bf16_t)(v.x >> 16); vt[2 * AVLD] = (bf16_t)(v.y & 0xffff); vt[3 * AVLD] = (bf16_t)(v.y >> 16);
            vt[4 * AVLD] = (bf16_t)(v.z & 0xffff); vt[5 * AVLD] = (bf16_t)(v.z >> 16); vt[6 * AVLD] = (bf16_t)(v.w & 0xffff); vt[7 * AVLD] = (bf16_t)(v.w >> 16);
        }
        __syncthreads();
        if (k0 <= qw0 + 31) {
            f32x4 sacc[4][2];
#pragma unroll
            for (int t4 = 0; t4 < 4; ++t4)
#pragma unroll
                for (int nq = 0; nq < 2; ++nq) sacc[t4][nq] = (f32x4){0.f, 0.f, 0.f, 0.f};
#pragma unroll
            for (int ks = 0; ks < 3; ++ks)
#pragma unroll
                for (int t4 = 0; t4 < 4; ++t4) {
                    const bf16x8 kf = *(const LAS bf16x8*)(Ks + (t4 * 16 + fr) * AKLD + ks * 32 + fq * 8);
#pragma unroll
                    for (int nq = 0; nq < 2; ++nq) sacc[t4][nq] = MFMA16(kf, qf[nq][ks], sacc[t4][nq]);
                }
            const bool need_mask = (k0 + 63 > qw0);
#pragma unroll
            for (int nq = 0; nq < 2; ++nq) {
                const int qidx = qw0 + nq * 16 + fr;
                float mx = -1e30f;
#pragma unroll
                for (int t4 = 0; t4 < 4; ++t4)
#pragma unroll
                    for (int i = 0; i < 4; ++i) {
                        if (need_mask) { const int key = k0 + t4 * 16 + 4 * fq + i; if (key > qidx) sacc[t4][nq][i] = -1e30f; }
                        mx = fmaxf(mx, sacc[t4][nq][i]);
                    }
                mx = fmaxf(mx, __shfl_xor(mx, 16)); mx = fmaxf(mx, __shfl_xor(mx, 32));
                const float mnew = fmaxf(mrun[nq], mx);
                const float alpha = exp2f(mrun[nq] - mnew);
                mrun[nq] = mnew;
                float ls = 0.f;
#pragma unroll
                for (int t4 = 0; t4 < 4; ++t4)
#pragma unroll
                    for (int i = 0; i < 4; ++i) { const float pv = exp2f(sacc[t4][nq][i] - mnew); sacc[t4][nq][i] = pv; ls += pv; }
                lrun[nq] = lrun[nq] * alpha + ls;
#pragma unroll
                for (int d = 0; d < 4; ++d) oacc[d][nq] = oacc[d][nq] * alpha;
            }
#pragma unroll
            for (int s2 = 0; s2 < 2; ++s2) {
                bf16x8 pb[2];
#pragma unroll
                for (int nq = 0; nq < 2; ++nq) {
                    u32x4 w; w.x = cvt_pk_bf16(sacc[2 * s2][nq].x, sacc[2 * s2][nq].y); w.y = cvt_pk_bf16(sacc[2 * s2][nq].z, sacc[2 * s2][nq].w);
                    w.z = cvt_pk_bf16(sacc[2 * s2 + 1][nq].x, sacc[2 * s2 + 1][nq].y); w.w = cvt_pk_bf16(sacc[2 * s2 + 1][nq].z, sacc[2 * s2 + 1][nq].w);
                    pb[nq] = __builtin_bit_cast(bf16x8, w);
                }
#pragma unroll
                for (int d = 0; d < 4; ++d) {
                    const LAS bf16_t* vr = Vt + (d * 16 + fr) * AVLD + s2 * 32 + 4 * fq;
                    const u32x2 lo = *(const LAS u32x2*)vr, hi = *(const LAS u32x2*)(vr + 16);
                    const bf16x8 vf = __builtin_bit_cast(bf16x8, ((u32x4){lo.x, lo.y, hi.x, hi.y}));
#pragma unroll
                    for (int nq = 0; nq < 2; ++nq) oacc[d][nq] = MFMA16(vf, pb[nq], oacc[d][nq]);
                }
            }
        }
        __syncthreads();
    }
#pragma unroll
    for (int nq = 0; nq < 2; ++nq) {
        float l = lrun[nq]; l += __shfl_xor(l, 16); l += __shfl_xor(l, 32);
        const float inv = 1.f / l;
        const int qidx = qw0 + nq * 16 + fr;
#pragma unroll
        for (int d = 0; d < 4; ++d) { const f32x4 v = oacc[d][nq] * inv; u32x2 w; w.x = cvt_pk_bf16(v.x, v.y); w.y = cvt_pk_bf16(v.z, v.w);
            *(u32x2*)(O + (size_t)qidx * 512 + d * 16 + 4 * fq) = w; }
    }
}

constexpr int MTLD = 72;
__device__ __forceinline__ void mlstm_a_unit(const Params& p, LAS unsigned char* lds, int unit) {
    LAS bf16_t* kT = (LAS bf16_t*)lds;
    LAS bf16_t* vT = kT + 128 * MTLD;
    LAS float* av = (LAS float*)(vT + 128 * MTLD);
    const int bh = unit >> 5, c = unit & 31, b = bh >> 2, h = bh & 3;
    const int t0 = b * S + c * CHUNK;
    const float* gl = (const float*)(p.ws + B_GL);
    const bf16_t* mk = (const bf16_t*)(p.ws + B_MK); const bf16_t* proj = (const bf16_t*)(p.ws + B_PROJ);
    const int tid = threadIdx.x, lane = tid & 63, wid = tid >> 6, fr = lane & 15, fq = lane >> 4;
    if (wid == 0) {
        const float li = gl[(size_t)(t0 + lane) * 8 + h], lf = gl[(size_t)(t0 + lane) * 8 + 4 + h];
        float bs = lf;
#pragma unroll
        for (int o = 1; o < 64; o <<= 1) { const float t = __shfl_up(bs, o); if (lane >= o) bs += t; }
        const float Btot = __shfl(bs, 63);
        const float g = Btot - bs + li;
        const float ml = wave_max(g);
        av[lane] = __expf(g - ml);
        if (lane == 0) { ((float*)(p.ws + WS_BC))[unit] = Btot; ((float*)(p.ws + WS_MLOC))[unit] = ml; }
    }
    __syncthreads();
#pragma unroll
    for (int rep = 0; rep < 2; ++rep) {
        const int cidx = tid + rep * NT, s = cidx & 63, ch = cidx >> 6;
        const u32x4 kv = *(const u32x4*)(mk + (size_t)(t0 + s) * MINNER + h * DM + ch * 8);
        const u32x4 vv = *(const u32x4*)(proj + (size_t)(t0 + s) * IN_DIM + OFF_MV + h * DM + ch * 8);
        const float a = av[s];
        LAS bf16_t* kt = kT + (ch * 8) * MTLD + s; LAS bf16_t* vt = vT + (ch * 8) * MTLD + s;
        const unsigned kk[4] = {kv.x, kv.y, kv.z, kv.w}; const unsigned vw[4] = {vv.x, vv.y, vv.z, vv.w};
#pragma unroll
        for (int j = 0; j < 4; ++j) {
            kt[(2 * j) * MTLD] = (bf16_t)(kk[j] & 0xffff); kt[(2 * j + 1) * MTLD] = (bf16_t)(kk[j] >> 16);
            const unsigned sc = cvt_pk_bf16(bflo(vw[j]) * a, bfhi(vw[j]) * a);
            vt[(2 * j) * MTLD] = (bf16_t)(sc & 0xffff); vt[(2 * j + 1) * MTLD] = (bf16_t)(sc >> 16);
        }
    }
    __syncthreads();
    {
        const int we = wid >> 1, wd = wid & 1;
        f32x4 acc[2][4];
#pragma unroll
        for (int i = 0; i < 2; ++i)
#pragma unroll
            for (int j = 0; j < 4; ++j) acc[i][j] = (f32x4){0.f, 0.f, 0.f, 0.f};
#pragma unroll
        for (int ks = 0; ks < 2; ++ks) {
            bf16x8 vf[2], kf[4];
#pragma unroll
            for (int i = 0; i < 2; ++i) vf[i] = *(const LAS bf16x8*)(vT + (we * 32 + i * 16 + fr) * MTLD + ks * 32 + fq * 8);
#pragma unroll
            for (int j = 0; j < 4; ++j) kf[j] = *(const LAS bf16x8*)(kT + (wd * 64 + j * 16 + fr) * MTLD + ks * 32 + fq * 8);
#pragma unroll
            for (int i = 0; i < 2; ++i)
#pragma unroll
                for (int j = 0; j < 4; ++j) acc[i][j] = MFMA16(vf[i], kf[j], acc[i][j]);
        }
        float* dC = (float*)(p.ws + B_DC) + (size_t)unit * 16384;
#pragma unroll
        for (int i = 0; i < 2; ++i)
#pragma unroll
            for (int j = 0; j < 4; ++j)
#pragma unroll
                for (int r = 0; r < 4; ++r) dC[(we * 32 + i * 16 + 4 * fq + r) * 128 + wd * 64 + j * 16 + fr] = acc[i][j][r];
    }
    if (tid < 128) {
        float s = 0.f;
        for (int q = 0; q < 64; ++q) s += bf2f(kT[tid * MTLD + q]) * av[q];
        ((float*)(p.ws + WS_DN))[(size_t)unit * 128 + tid] = s;
    }
    __syncthreads();
}

__device__ __forceinline__ void mlstm_scan(const Params& p, int gtid, int ngt) {
    const float* Bc = (const float*)(p.ws + WS_BC); const float* ML = (const float*)(p.ws + WS_MLOC);
    float* mprev = (float*)(p.ws + WS_MPREV);
    const float* dC = (const float*)(p.ws + B_DC); bf16_t* Cp = (bf16_t*)(p.ws + B_CPREV);
    const float* dn = (const float*)(p.ws + WS_DN); float* np_ = (float*)(p.ws + WS_NPREV);
    constexpr int PER = 4096 + 32;
    for (int idx = gtid; idx < 32 * PER; idx += ngt) {
        const int bh = idx / PER, e4 = idx - bh * PER;
        float m = 0.f; f32x4 C = (f32x4){0.f, 0.f, 0.f, 0.f};
        for (int c = 0; c < NCH; ++c) {
            const int unit = bh * NCH + c;
            const float Bt = Bc[unit], ml = ML[unit];
            const float mnew = fmaxf(Bt + m, ml);
            const float fa = __expf(Bt + m - mnew), fb = __expf(ml - mnew);
            if (e4 < 4096) {
                u32x2 w; w.x = cvt_pk_bf16(C.x, C.y); w.y = cvt_pk_bf16(C.z, C.w);
                *(u32x2*)(Cp + (size_t)unit * 16384 + e4 * 4) = w;
                const f32x4 d = *(const f32x4*)(dC + (size_t)unit * 16384 + e4 * 4);
                C = C * fa + d * fb;
                if (e4 == 0) mprev[unit] = m;
            } else {
                const int n4 = e4 - 4096;
                *(f32x4*)(np_ + (size_t)unit * 128 + n4 * 4) = C;
                const f32x4 d = *(const f32x4*)(dn + (size_t)unit * 128 + n4 * 4);
                C = C * fa + d * fb;
            }
            m = mnew;
        }
    }
}

constexpr int MRLD = 136;
__device__ __forceinline__ void mlstm_c_unit(const Params& p, LAS unsigned char* lds, int unit) {
    LAS bf16_t* qs = (LAS bf16_t*)lds;
    LAS bf16_t* ks = qs + 64 * MRLD;
    LAS bf16_t* cs = ks + 64 * MRLD;
    LAS bf16_t* vT = cs + 128 * MRLD;
    LAS float* fv = (LAS float*)(vT + 128 * MTLD);
    LAS float* u_s = fv; LAS float* c_t = fv + 64; LAS float* dec = fv + 128; LAS float* emt = fv + 192; LAS float* ssq = fv + 256;
    const int bh = unit >> 5, c = unit & 31, b = bh >> 2, h = bh & 3;
    const int t0 = b * S + c * CHUNK;
    const float* gl = (const float*)(p.ws + B_GL);
    const bf16_t* mq = (const bf16_t*)(p.ws + B_MQ); const bf16_t* mk = (const bf16_t*)(p.ws + B_MK); const bf16_t* proj = (const bf16_t*)(p.ws + B_PROJ);
    const bf16_t* Cp = (const bf16_t*)(p.ws + B_CPREV) + (size_t)unit * 16384;
    const float* np_ = (const float*)(p.ws + WS_NPREV) + (size_t)unit * 128;
    const int tid = threadIdx.x, lane = tid & 63, wid = tid >> 6, fr = lane & 15, fq = lane >> 4;
    if (wid == 0) {
        const float li = gl[(size_t)(t0 + lane) * 8 + h], lf = gl[(size_t)(t0 + lane) * 8 + 4 + h];
        const float mp = ((const float*)(p.ws + WS_MPREV))[unit];
        float bs = lf;
#pragma unroll
        for (int o = 1; o < 64; o <<= 1) { const float t = __shfl_up(bs, o); if (lane >= o) bs += t; }
        const float u = li - bs;
        float pm = u;
#pragma unroll
        for (int o = 1; o < 64; o <<= 1) { const float t = __shfl_up(pm, o); if (lane >= o) pm = fmaxf(pm, t); }
        const float inter = bs + mp;
        const float mt = fmaxf(inter, bs + pm);
        u_s[lane] = u; c_t[lane] = bs - mt; dec[lane] = __expf(inter - mt); emt[lane] = __expf(-mt);
    }
#pragma unroll
    for (int rep = 0; rep < 2; ++rep) {
        const int cidx = tid + rep * NT, r = cidx >> 4, ch = cidx & 15;
        *(LAS u32x4*)(qs + r * MRLD + ch * 8) = *(const u32x4*)(mq + (size_t)(t0 + r) * MINNER + h * DM + ch * 8);
        *(LAS u32x4*)(ks + r * MRLD + ch * 8) = *(const u32x4*)(mk + (size_t)(t0 + r) * MINNER + h * DM + ch * 8);
    }
#pragma unroll
    for (int rep = 0; rep < 4; ++rep) {
        const int cidx = tid + rep * NT, r = cidx >> 4, ch = cidx & 15;
        *(LAS u32x4*)(cs + r * MRLD + ch * 8) = *(const u32x4*)(Cp + r * 128 + ch * 8);
    }
#pragma unroll
    for (int rep = 0; rep < 2; ++rep) {
        const int cidx = tid + rep * NT, s = cidx & 63, ch = cidx >> 6;
        const u32x4 vv = *(const u32x4*)(proj + (size_t)(t0 + s) * IN_DIM + OFF_MV + h * DM + ch * 8);
        LAS bf16_t* vt = vT + (ch * 8) * MTLD + s;
        const unsigned vw[4] = {vv.x, vv.y, vv.z, vv.w};
#pragma unroll
        for (int j = 0; j < 4; ++j) { vt[(2 * j) * MTLD] = (bf16_t)(vw[j] & 0xffff); vt[(2 * j + 1) * MTLD] = (bf16_t)(vw[j] >> 16); }
    }
    __syncthreads();
    const int tt = wid & 3, eh = wid >> 2;
    const int tl = tt * 16 + fr;
    bf16x8 qf[4];
#pragma unroll
    for (int k4 = 0; k4 < 4; ++k4) qf[k4] = *(const LAS bf16x8*)(qs + tl * MRLD + k4 * 32 + fq * 8);
    f32x4 sacc[4];
#pragma unroll
    for (int st = 0; st < 4; ++st) sacc[st] = (f32x4){0.f, 0.f, 0.f, 0.f};
#pragma unroll
    for (int k4 = 0; k4 < 4; ++k4)
#pragma unroll
        for (int st = 0; st < 4; ++st) {
            const bf16x8 kf = *(const LAS bf16x8*)(ks + (st * 16 + fr) * MRLD + k4 * 32 + fq * 8);
            sacc[st] = MFMA16(kf, qf[k4], sacc[st]);
        }
    const float ct = c_t[tl];
    float rs = 0.f;
#pragma unroll
    for (int st = 0; st < 4; ++st)
#pragma unroll
        for (int i = 0; i < 4; ++i) {
            const int s = st * 16 + 4 * fq + i;
            const float w = (s <= tl) ? __expf(ct + u_s[s]) * sacc[st][i] : 0.f;
            sacc[st][i] = w; rs += w;
        }
    rs += __shfl_xor(rs, 16); rs += __shfl_xor(rs, 32);
    float nq;
    {
        f32x4 na = (f32x4){0.f, 0.f, 0.f, 0.f};
#pragma unroll
        for (int k4 = 0; k4 < 4; ++k4) {
            u32x4 w = (u32x4){0u, 0u, 0u, 0u};
            if (fr == 0) { const float* nn = np_ + k4 * 32 + fq * 8; w.x = cvt_pk_bf16(nn[0], nn[1]); w.y = cvt_pk_bf16(nn[2], nn[3]); w.z = cvt_pk_bf16(nn[4], nn[5]); w.w = cvt_pk_bf16(nn[6], nn[7]); }
            na = MFMA16(__builtin_bit_cast(bf16x8, w), qf[k4], na);
        }
        nq = __shfl(na.x, fr);
    }
    f32x4 acc[4];
#pragma unroll
    for (int et = 0; et < 4; ++et) acc[et] = (f32x4){0.f, 0.f, 0.f, 0.f};
#pragma unroll
    for (int k4 = 0; k4 < 4; ++k4)
#pragma unroll
        for (int et = 0; et < 4; ++et) {
            const bf16x8 cf = *(const LAS bf16x8*)(cs + (eh * 64 + et * 16 + fr) * MRLD + k4 * 32 + fq * 8);
            acc[et] = MFMA16(cf, qf[k4], acc[et]);
        }
    const float dcy = dec[tl];
#pragma unroll
    for (int et = 0; et < 4; ++et) acc[et] = acc[et] * dcy;
#pragma unroll
    for (int s2 = 0; s2 < 2; ++s2) {
        u32x4 w; w.x = cvt_pk_bf16(sacc[2 * s2].x, sacc[2 * s2].y); w.y = cvt_pk_bf16(sacc[2 * s2].z, sacc[2 * s2].w);
        w.z = cvt_pk_bf16(sacc[2 * s2 + 1].x, sacc[2 * s2 + 1].y); w.w = cvt_pk_bf16(sacc[2 * s2 + 1].z, sacc[2 * s2 + 1].w);
        const bf16x8 pb = __builtin_bit_cast(bf16x8, w);
#pragma unroll
        for (int et = 0; et < 4; ++et) {
            const LAS bf16_t* vr = vT + (eh * 64 + et * 16 + fr) * MTLD + s2 * 32 + 4 * fq;
            const u32x2 lo = *(const LAS u32x2*)vr, hi = *(const LAS u32x2*)(vr + 16);
            acc[et] = MFMA16(__builtin_bit_cast(bf16x8, ((u32x4){lo.x, lo.y, hi.x, hi.y})), pb, acc[et]);
        }
    }
    const float den = dcy * nq + rs;
    const float hd = 1.f / fmaxf(fabsf(den), emt[tl]);
    float sq = 0.f;
#pragma unroll
    for (int et = 0; et < 4; ++et) { acc[et] = acc[et] * hd; sq += acc[et].x * acc[et].x + acc[et].y * acc[et].y + acc[et].z * acc[et].z + acc[et].w * acc[et].w; }
    sq += __shfl_xor(sq, 16); sq += __shfl_xor(sq, 32);
    if (fq == 0) ssq[eh * 64 + tl] = sq;
    __syncthreads();
    const float rinv = rsqrtf((ssq[tl] + ssq[64 + tl]) * (1.f / 128.f) + RMS_EPS);
    const float* gmo = p.in[20] + h * DM;
    bf16_t* ao = (bf16_t*)(p.ws + B_AO);
#pragma unroll
    for (int et = 0; et < 4; ++et) {
        const int e = eh * 64 + et * 16 + 4 * fq;
        const u32x2 op = *(const u32x2*)(proj + (size_t)(t0 + tl) * IN_DIM + OFF_MO + h * DM + e);
        const f32x4 g = *(const f32x4*)(gmo + e);
        const f32x4 v = acc[et] * rinv * g;
        u32x2 w; w.x = cvt_pk_bf16(v.x * sigmoidf_(bflo(op.x)), v.y * sigmoidf_(bfhi(op.x))); w.y = cvt_pk_bf16(v.z * sigmoidf_(bflo(op.y)), v.w * sigmoidf_(bfhi(op.y)));
        *(u32x2*)(ao + (size_t)(t0 + tl) * 1024 + 512 + h * DM + e) = w;
    }
    __syncthreads();
}

__device__ __forceinline__ void route_rows(const Params& p, int gw, int ngw, int lane) {
    const float* logits = (const float*)(p.ws + C_LOGITS); const float* rb = p.in[24];
    int* cnt = (int*)(p.ws + WS_CTL);
    int* tok_e = (int*)(p.ws + C_TOKE); float* tok_w = (float*)(p.ws + C_TOKW); int* tok_pos = (int*)(p.ws + C_TOKPOS);
    int* list_tok = (int*)(p.ws + C_LISTTOK); float* list_w = (float*)(p.ws + C_LISTW);
    const f32x4 bias = *(const f32x4*)(rb + lane * 4);
    const float NEG = -__builtin_inff();
    for (int row = gw; row < T; row += ngw) {
        const f32x4 lg = *(const f32x4*)(logits + (size_t)row * 256 + lane * 4);
        float sc[4] = {sigmoidf_(lg.x), sigmoidf_(lg.y), sigmoidf_(lg.z), sigmoidf_(lg.w)};
        float sb[4] = {sc[0] + bias.x, sc[1] + bias.y, sc[2] + bias.z, sc[3] + bias.w};
        float t1 = fmaxf(fmaxf(sb[0], sb[1]), fmaxf(sb[2], sb[3]));
        float t2;
        {
            const float a = fmaxf(sb[0], sb[1]), bmin = fminf(sb[0], sb[1]), c2 = fmaxf(sb[2], sb[3]), dmin = fminf(sb[2], sb[3]);
            t2 = fmaxf(fminf(a, c2), fmaxf(bmin, dmin));
        }
#pragma unroll
        for (int o = 1; o < 8; o <<= 1) {
            const float o1 = __shfl_xor(t1, o), o2 = __shfl_xor(t2, o);
            const float n1 = fmaxf(t1, o1), n2 = fmaxf(fminf(t1, o1), fmaxf(t2, o2));
            t1 = n1; t2 = n2;
        }
        const float gs = t1 + t2;
        const int myg = lane >> 3;
        int rank = 0;
#pragma unroll
        for (int g = 0; g < 8; ++g) { const float og = __shfl(gs, g * 8); rank += (og > gs || (og == gs && g < myg)) ? 1 : 0; }
        const bool keep = rank < 4;
        float cand[4];
#pragma unroll
        for (int j = 0; j < 4; ++j) cand[j] = keep ? sb[j] : NEG;
        float wsum = 0.f; float myw = 0.f; int mye = 0;
#pragma unroll
        for (int k = 0; k < TOPK; ++k) {
            float bv = cand[0]; int bi = 0;
#pragma unroll
            for (int j = 1; j < 4; ++j) if (cand[j] > bv) { bv = cand[j]; bi = j; }
            int gi = lane * 4 + bi; float gv = bv;
#pragma unroll
            for (int o = 1; o < 64; o <<= 1) {
                const float ov = __shfl_xor(gv, o); const int oi = __shfl_xor(gi, o);
                if (ov > gv || (ov == gv && oi < gi)) { gv = ov; gi = oi; }
            }
            const int wl = gi >> 2, wj = gi & 3;
            const float sj = (wj == 0) ? sc[0] : (wj == 1) ? sc[1] : (wj == 2) ? sc[2] : sc[3];
            const float sraw = __shfl(sj, wl);
            wsum += sraw;
            if (lane == k) { myw = sraw; mye = gi; }
            if (lane == wl) {
#pragma unroll
                for (int j = 0; j < 4; ++j) if (j == wj) cand[j] = NEG;
            }
        }
        if (lane < TOPK) {
            const float w = myw / wsum * 2.5f;
            const int pos = atomicAdd(&cnt[mye], 1);
            tok_e[(size_t)row * 8 + lane] = mye; tok_w[(size_t)row * 8 + lane] = w; tok_pos[(size_t)row * 8 + lane] = pos;
            list_tok[(size_t)mye * CAP + pos] = row; list_w[(size_t)mye * CAP + pos] = w;
        }
    }
}

__device__ __forceinline__ void expert_prefix(const Params& p, LAS int* base, LAS int* tstart, int tid) {
    const int* cnt = (const int*)(p.ws + WS_CTL);
    if (tid < 64) {
        int c[4], tl[4]; int s = 0, ts = 0;
#pragma unroll
        for (int j = 0; j < 4; ++j) { c[j] = __hip_atomic_load(cnt + tid * 4 + j, __ATOMIC_RELAXED, __HIP_MEMORY_SCOPE_AGENT); tl[j] = (c[j] + 127) >> 7; s += c[j]; ts += tl[j]; }
        int ps = s, pt = ts;
#pragma unroll
        for (int o = 1; o < 64; o <<= 1) { const int a = __shfl_up(ps, o), bb = __shfl_up(pt, o); if (tid >= o) { ps += a; pt += bb; } }
        int es = ps - s, et = pt - ts;
#pragma unroll
        for (int j = 0; j < 4; ++j) { base[tid * 4 + j] = es; tstart[tid * 4 + j] = et; es += c[j]; et += tl[j]; }
        if (tid == 63) tstart[256] = pt;
    }
    __syncthreads();
}

__device__ __forceinline__ void combine_rows(const Params& p, LAS int* base, int gw, int ngw, int lane) {
    const bf16_t* sh = (const bf16_t*)(p.ws + C_SHOUT); const bf16_t* y = (const bf16_t*)(p.ws + C_Y);
    const int* tok_e = (const int*)(p.ws + C_TOKE); const int* tok_pos = (const int*)(p.ws + C_TOKPOS);
    const float* ada = (const float*)(p.ws + WS_ADA);
    for (int row = gw; row < T; row += ngw) {
        const int b = row / S;
        float acc[2][8];
#pragma unroll
        for (int hf = 0; hf < 2; ++hf) {
            const u32x4 a = *(const u32x4*)(sh + (size_t)row * 1024 + hf * 512 + lane * 8);
            acc[hf][0] = bflo(a.x); acc[hf][1] = bfhi(a.x); acc[hf][2] = bflo(a.y); acc[hf][3] = bfhi(a.y); acc[hf][4] = bflo(a.z); acc[hf][5] = bfhi(a.z); acc[hf][6] = bflo(a.w); acc[hf][7] = bfhi(a.w);
        }
#pragma unroll
        for (int k = 0; k < TOPK; ++k) {
            const int e = tok_e[(size_t)row * 8 + k], pos = tok_pos[(size_t)row * 8 + k];
            const size_t slot = (size_t)(base[e] + pos);
#pragma unroll
            for (int hf = 0; hf < 2; ++hf) {
                const u32x4 a = *(const u32x4*)(y + slot * 1024 + hf * 512 + lane * 8);
                acc[hf][0] += bflo(a.x); acc[hf][1] += bfhi(a.x); acc[hf][2] += bflo(a.y); acc[hf][3] += bfhi(a.y); acc[hf][4] += bflo(a.z); acc[hf][5] += bfhi(a.z); acc[hf][6] += bflo(a.w); acc[hf][7] += bfhi(a.w);
            }
        }
#pragma unroll
        for (int hf = 0; hf < 2; ++hf) {
            const int col = hf * 512 + lane * 8;
            float* o = p.out + (size_t)row * D + col;
            const float* g = ada + b * 6144 + 5120 + col;
#pragma unroll
            for (int q4 = 0; q4 < 2; ++q4) {
                const f32x4 x = *(const f32x4*)(o + q4 * 4), gg = *(const f32x4*)(g + q4 * 4);
                f32x4 r; r.x = x.x + gg.x * acc[hf][q4 * 4 + 0]; r.y = x.y + gg.y * acc[hf][q4 * 4 + 1]; r.z = x.z + gg.z * acc[hf][q4 * 4 + 2]; r.w = x.w + gg.w * acc[hf][q4 * 4 + 3];
                *(f32x4*)(o + q4 * 4) = r;
            }
        }
    }
}

__global__ void __launch_bounds__(NT) fwd_kernel(Params p) {
    extern __shared__ __attribute__((aligned(16))) unsigned char lds_raw[];
    LAS unsigned char* lds = (LAS unsigned char*)lds_raw;
    cg::grid_group grid = cg::this_grid();
    const int tid = threadIdx.x, lane = tid & 63, wid = tid >> 6;
    const int G = gridDim.x, bid = blockIdx.x;
    const int gw = bid * NWAVES + wid, ngw = G * NWAVES;
    unsigned char* ws = p.ws;
    const float* ada = (const float*)(ws + WS_ADA);
    volatile LAS unsigned* bst = (volatile LAS unsigned*)(lds + LDS_BYTES - 64);
    if (tid < 2) bst[tid] = 0u;
    __syncthreads();
    const XcdBarrier xbar = xcd_barrier_post((unsigned*)(ws + WS_CTL + 4096), bst);
    grid.sync();

    for (int u = bid; u < 96; u += G) ada_unit(p, lds, u, tid);
    {
        LAS float* scr = (LAS float*)(lds + wid * 8448);
        conv_batch<0>(p.in[6], 1, 1024, IN_DIM, (bf16_t*)(ws + WS_WIN), 0, 0, scr, gw, ngw, lane);
        conv_batch<0>(p.in[8], 1, QLORA, 768, (bf16_t*)(ws + WS_WUQ), 0, 0, scr, gw, ngw, lane);
        conv_batch<0>(p.in[10], 1, KVLORA, 1024, (bf16_t*)(ws + WS_WUKV), 0, 0, scr, gw, ngw, lane);
        conv_batch<0>(p.in[16], 4, 128, 128, (bf16_t*)(ws + WS_WMQK), 256 * 128, 0, scr, gw, ngw, lane);
        conv_batch<0>(p.in[17], 4, 128, 128, (bf16_t*)(ws + WS_WMQK), 256 * 128, 128, scr, gw, ngw, lane);
        conv_batch<0>(p.in[21], 1, 1024, 1024, (bf16_t*)(ws + WS_WOUT), 0, 0, scr, gw, ngw, lane);
        conv_batch<0>(p.in[23], 1, 1024, 256, (bf16_t*)(ws + WS_WRGU), 0, 0, scr, gw, ngw, lane);
        conv_batch<1>(p.in[28], 1, 1024, 256, (bf16_t*)(ws + WS_WRGU), 0, 256, scr, gw, ngw, lane);
        conv_batch<2>(p.in[29], 1, 1024, 256, (bf16_t*)(ws + WS_WRGU), 0, 256, scr, gw, ngw, lane);
        conv_batch<0>(p.in[30], 1, 256, 1024, (bf16_t*)(ws + WS_WDSH), 0, 0, scr, gw, ngw, lane);
        conv_batch<1>(p.in[25], NE, 1024, 256, (bf16_t*)(ws + WS_WGU), (size_t)512 * 1024, 0, scr, gw, ngw, lane);
        conv_batch<2>(p.in[26], NE, 1024, 256, (bf16_t*)(ws + WS_WGU), (size_t)512 * 1024, 0, scr, gw, ngw, lane);
        conv_batch<0>(p.in[27], NE, 256, 1024, (bf16_t*)(ws + WS_WD), (size_t)1024 * 256, 0, scr, gw, ngw, lane);
    }
    xcd_barrier(xbar);
    norm_mod_rows(p.in[0], p.in[5], ada, 0, 1024, (bf16_t*)(ws + B_H1), gw, ngw, lane);
    xcd_barrier(xbar);
    {
        const RowDense RP{(const bf16_t*)(ws + B_H1), D};
        const EpiProj E{(bf16_t*)(ws + B_PROJ), (float*)(ws + B_GRAW)};
        constexpr int NTN = (IN_DIM + 127) / 128;
        for (int u = bid; u < (T / 128) * NTN; u += G) { const int tm = u / NTN, tn = u - tm * NTN; gemm_tile(lds, RP, (const bf16_t*)(ws + WS_WIN), 1024, IN_DIM, 1024, tm * 128, tn * 128, E); }
    }
    xcd_barrier(xbar);
    post_proj_rows(p, gw, ngw, lane);
    xcd_barrier(xbar);
#if DBG_STAGE == 1
    {   const int g = bid * NT + tid;
        if (g < 8192) { const int row = (int)(((long long)g * 977) % T), col = (g * 131) % 768;
            const bf16_t* a = (const bf16_t*)(ws + B_CQN) + (size_t)row * 384; const bf16_t* w = (const bf16_t*)(ws + WS_WUQ) + (size_t)col * 384;
            float acc = 0.f; for (int k = 0; k < 384; ++k) acc += bf2f(a[k]) * bf2f(w[k]);
            ((float*)(ws + WS_ADA + 512 * 1024))[g] = acc; } }
#endif
    {
        constexpr int U2 = (T / 128) * 6, U3 = (T / 128) * 8, U4 = (T / 128) * 2 * 4;
        for (int u = bid; u < U2 + U3 + U4; u += G) {
            if (u < U2) { const int tm = u / 6, tn = u % 6; const RowDense RP{(const bf16_t*)(ws + B_CQN), QLORA}; const EpiBf16 E{(bf16_t*)(ws + B_QRAW), 768};
                gemm_tile(lds, RP, (const bf16_t*)(ws + WS_WUQ), QLORA, 768, QLORA, tm * 128, tn * 128, E); }
            else if (u < U2 + U3) { const int v = u - U2, tm = v / 8, tn = v % 8; const RowDense RP{(const bf16_t*)(ws + B_CKVN), KVLORA}; const EpiBf16 E{(bf16_t*)(ws + B_KVRAW), 1024};
                gemm_tile(lds, RP, (const bf16_t*)(ws + WS_WUKV), KVLORA, 1024, KVLORA, tm * 128, tn * 128, E); }
            else { const int v = u - U2 - U3, tm = v / 8, r = v % 8, h = r >> 1, tn = r & 1; const RowDense RP{(const bf16_t*)(ws + B_ZC) + h * DM, MINNER};
                const EpiMqk E{(bf16_t*)(ws + B_MQ), (bf16_t*)(ws + B_MK), h};
                gemm_tile(lds, RP, (const bf16_t*)(ws + WS_WMQK) + (size_t)h * 256 * 128, 128, 256, 128, tm * 128, tn * 128, E); }
        }
    }
    xcd_barrier(xbar);
#if DBG_STAGE == 1
    {
        unsigned* flags2 = (unsigned*)(ws + WS_CTL + 2052);
        {
            const unsigned* q_ = (const unsigned*)(ws + B_QRAW); const size_t nw_ = (size_t)T * 768 * 2 / 4; bool bad_ = false;
            for (size_t i_ = (size_t)bid * NT + tid; i_ < nw_; i_ += (size_t)G * NT) { const unsigned u_ = q_[i_]; if (((u_ >> 7) & 0xffu) >= 141u || ((u_ >> 23) & 0xffu) >= 141u) bad_ = true; }
            if (bad_) atomicOr(flags2, 1u);
        }
        const int g = bid * NT + tid;
        if (g < 8192) {
            {   const int row = (int)(((long long)g * 977) % T), col = (g * 131) % OFF_GATE;
                const bf16_t* a = (const bf16_t*)(ws + B_H1) + (size_t)row * 1024; const bf16_t* w = (const bf16_t*)(ws + WS_WIN) + (size_t)col * 1024;
                float acc = 0.f; for (int k = 0; k < 1024; ++k) acc += bf2f(a[k]) * bf2f(w[k]);
                const float got = bf2f(((const bf16_t*)(ws + B_PROJ))[(size_t)row * IN_DIM + col]);
                if (!(fabsf(got - acc) <= 0.03f * fmaxf(1.f, fabsf(acc)))) atomicOr(flags2, 16u); }
            {   const int row = (int)(((long long)g * 977) % T), col = (g * 131) % 768;
                const bf16_t* a = (const bf16_t*)(ws + B_CQN) + (size_t)row * 384; const bf16_t* w = (const bf16_t*)(ws + WS_WUQ) + (size_t)col * 384;
                float acc = 0.f; for (int k = 0; k < 384; ++k) acc += bf2f(a[k]) * bf2f(w[k]);
                const float got = bf2f(((const bf16_t*)(ws + B_QRAW))[(size_t)row * 768 + col]);
                if (!(fabsf(got - acc) <= 0.03f * fmaxf(1.f, fabsf(acc)))) atomicOr(flags2, 4u);
                const float early = ((const float*)(ws + WS_ADA + 512 * 1024))[g]; if (!(fabsf(early - acc) <= 1e-3f * fmaxf(1.f, fabsf(acc)))) atomicOr(flags2, 2u); }
            {   const int row = (int)(((long long)g * 977) % T), col = (g * 131) % 1024;
                const bf16_t* a = (const bf16_t*)(ws + B_CKVN) + (size_t)row * 256; const bf16_t* w = (const bf16_t*)(ws + WS_WUKV) + (size_t)col * 256;
                float acc = 0.f; for (int k = 0; k < 256; ++k) acc += bf2f(a[k]) * bf2f(w[k]);
                const float got = bf2f(((const bf16_t*)(ws + B_KVRAW))[(size_t)row * 1024 + col]);
                if (!(fabsf(got - acc) <= 0.03f * fmaxf(1.f, fabsf(acc)))) atomicOr(flags2, 8u); }
        }
        xcd_barrier(xbar);
        const unsigned fl = __hip_atomic_load(flags2, __ATOMIC_RELAXED, __HIP_MEMORY_SCOPE_AGENT);
        const float val = __uint_as_float((unsigned)(127 + fl) << 23);
        for (size_t i = (size_t)bid * NT + tid; i < (size_t)T * D / 4; i += (size_t)G * NT) ((f32x4*)p.out)[i] = (f32x4){val, val, val, val};
        return;
    }
#endif
    qk_post_rows(p, gw, ngw, lane);
    xcd_barrier(xbar);
    for (int pr = bid; pr < 256; pr += G) { const int bh = pr & 63, j = pr >> 6; attn_unit(p, lds, bh, 7 - j); attn_unit(p, lds, bh, j); }
    for (int u = bid; u < 1024; u += G) mlstm_a_unit(p, lds, u);
    xcd_barrier(xbar);
    mlstm_scan(p, bid * NT + tid, G * NT);
    attn_out_norm_rows(p, gw, ngw, lane);
    xcd_barrier(xbar);
    for (int u = bid; u < 1024; u += G) mlstm_c_unit(p, lds, u);
    xcd_barrier(xbar);
    {
        const RowDense RP{(const bf16_t*)(ws + B_AO), 1024};
        const EpiResid E{p.in[0], ada, 2048, p.out};
        for (int u = bid; u < (T / 128) * 8; u += G) { const int tm = u >> 3, tn = u & 7; gemm_tile(lds, RP, (const bf16_t*)(ws + WS_WOUT), 1024, 1024, 1024, tm * 128, tn * 128, E); }
    }
    xcd_barrier(xbar);
#if DBG_STAGE == 1
    {
        unsigned* flags = (unsigned*)(ws + WS_CTL + 2048);
#define SCAN_BUF(K_, off_, nbytes_, isf32_) do { const unsigned* q_ = (const unsigned*)(ws + (off_)); const size_t nw_ = (size_t)(nbytes_) / 4; bool bad_ = false; \
        for (size_t i_ = (size_t)bid * NT + tid; i_ < nw_; i_ += (size_t)G * NT) { const unsigned u_ = q_[i_]; \
            if (isf32_) { if (((u_ >> 23) & 0xffu) >= 141u) bad_ = true; } else { if (((u_ >> 7) & 0xffu) >= 141u || ((u_ >> 23) & 0xffu) >= 141u) bad_ = true; } } \
        if (bad_) atomicOr(flags, 1u << (K_)); } while (0)
        SCAN_BUF(0, WS_ADA, 8 * 6144 * 4, true);
        SCAN_BUF(1, WS_WIN, (size_t)IN_DIM * 1024 * 2, false);
        SCAN_BUF(2, WS_WUQ, (size_t)768 * 384 * 2, false);
        SCAN_BUF(3, WS_WUKV, (size_t)1024 * 256 * 2, false);
        SCAN_BUF(4, WS_WMQK, (size_t)4 * 256 * 128 * 2, false);
        SCAN_BUF(5, WS_WOUT, (size_t)1024 * 1024 * 2, false);
        SCAN_BUF(6, B_H1, (size_t)T * 1024 * 2, false);
        SCAN_BUF(7, B_PROJ, (size_t)T * IN_DIM * 2, false);
        SCAN_BUF(8, B_GL, (size_t)T * 8 * 4, true);
        SCAN_BUF(9, B_CQN, (size_t)T * 384 * 2, false);
        SCAN_BUF(10, B_CKVN, (size_t)T * 256 * 2, false);
        SCAN_BUF(11, B_ZC, (size_t)T * 512 * 2, false);
        SCAN_BUF(12, B_QRAW, (size_t)T * 768 * 2, false);
        SCAN_BUF(13, B_KVRAW, (size_t)T * 1024 * 2, false);
        SCAN_BUF(14, B_MQ, (size_t)T * 512 * 2, false);
        SCAN_BUF(15, B_MK, (size_t)T * 512 * 2, false);
        SCAN_BUF(16, B_Q, (size_t)T * 768 * 2, false);
        SCAN_BUF(17, B_K, (size_t)T * 768 * 2, false);
        SCAN_BUF(18, B_ORAW, (size_t)T * 512 * 2, false);
        SCAN_BUF(19, B_DC, (size_t)1024 * 16384 * 4, true);
        SCAN_BUF(20, WS_BC, 3 * 8192, true);
        SCAN_BUF(21, WS_DN, 1024 * 128 * 4, true);
        SCAN_BUF(22, B_CPREV, (size_t)1024 * 16384 * 2, false);
        SCAN_BUF(23, WS_NPREV, 1024 * 128 * 4, true);
        SCAN_BUF(24, B_AO, (size_t)T * 1024 * 2, false);
        xcd_barrier(xbar);
        const unsigned fl = __hip_atomic_load(flags, __ATOMIC_RELAXED, __HIP_MEMORY_SCOPE_AGENT);
        if (fl) {
            const int k = __builtin_ctz(fl);
            const float val = __uint_as_float((unsigned)(127 + k) << 23);
            for (size_t i = (size_t)bid * NT + tid; i < (size_t)T * D / 4; i += (size_t)G * NT) ((f32x4*)p.out)[i] = (f32x4){val, val, val, val};
        } else {
            for (size_t i = (size_t)bid * NT + tid; i < (size_t)T * D / 4; i += (size_t)G * NT) {
                f32x4 v = ((f32x4*)p.out)[i];
                if (!(fabsf(v.x) < 1e30f)) v.x = 100.f; if (!(fabsf(v.y) < 1e30f)) v.y = 100.f; if (!(fabsf(v.z) < 1e30f)) v.z = 100.f; if (!(fabsf(v.w) < 1e30f)) v.w = 100.f;
                ((f32x4*)p.out)[i] = v;
            }
        }
        return;
    }
#endif
    norm_mod_rows(p.out, p.in[22], ada, 3072, 4096, (bf16_t*)(ws + C_H2), gw, ngw, lane);
    xcd_barrier(xbar);
    {
        const RowDense RP{(const bf16_t*)(ws + C_H2), 1024};
        const EpiRgu E{(float*)(ws + C_LOGITS), (bf16_t*)(ws + C_ACTSH)};
        for (int u = bid; u < (T / 128) * 6; u += G) { const int tm = u / 6, tn = u % 6; gemm_tile(lds, RP, (const bf16_t*)(ws + WS_WRGU), 1024, 768, 1024, tm * 128, tn * 128, E); }
    }
    xcd_barrier(xbar);
    route_rows(p, gw, ngw, lane);
    {
        const RowDense RP{(const bf16_t*)(ws + C_ACTSH), 256};
        const EpiBf16 E{(bf16_t*)(ws + C_SHOUT), 1024};
        for (int u = bid; u < (T / 128) * 8; u += G) { const int tm = u >> 3, tn = u & 7; gemm_tile(lds, RP, (const bf16_t*)(ws + WS_WDSH), 256, 1024, 256, tm * 128, tn * 128, E); }
    }
    xcd_barrier(xbar);
    LAS int* base = (LAS int*)(lds + 120 * 1024);
    LAS int* tstart = base + 256;
    expert_prefix(p, base, tstart, tid);
    {
        const int* cnt = (const int*)(ws + WS_CTL);
        const int ntile = tstart[256];
        for (int u = bid; u < ntile * 4; u += G) {
            const int tg = u >> 2, tn = u & 3;
            int lo = 0, hi = 255;
            while (lo < hi) { const int mid = (lo + hi + 1) >> 1; if (tstart[mid] <= tg) lo = mid; else hi = mid - 1; }
            const int e = lo, blk = tg - tstart[e], c = __hip_atomic_load(cnt + e, __ATOMIC_RELAXED, __HIP_MEMORY_SCOPE_AGENT);
            const int nvalid = min(128, c - blk * 128);
            const RowGather RP{(const bf16_t*)(ws + C_H2), (const int*)(ws + C_LISTTOK) + (size_t)e * CAP + blk * 128, nvalid};
            const EpiExpAct E{(bf16_t*)(ws + C_ACTE), base[e] + blk * 128, nvalid};
            gemm_tile(lds, RP, (const bf16_t*)(ws + WS_WGU) + (size_t)e * 512 * 1024, 1024, 512, 1024, 0, tn * 128, E);
        }
    }
    xcd_barrier(xbar);
    {
        const int* cnt = (const int*)(ws + WS_CTL);
        const int ntile = tstart[256];
        for (int u = bid; u < ntile * 8; u += G) {
            const int tg = u >> 3, tn = u & 7;
            int lo = 0, hi = 255;
            while (lo < hi) { const int mid = (lo + hi + 1) >> 1; if (tstart[mid] <= tg) lo = mid; else hi = mid - 1; }
            const int e = lo, blk = tg - tstart[e], c = __hip_atomic_load(cnt + e, __ATOMIC_RELAXED, __HIP_MEMORY_SCOPE_AGENT);
            const int nvalid = min(128, c - blk * 128);
            const int slot0 = base[e] + blk * 128;
            const RowSlots RP{(const bf16_t*)(ws + C_ACTE) + (size_t)slot0 * EDIM, nvalid};
            const EpiExpDown E{(bf16_t*)(ws + C_Y), (const float*)(ws + C_LISTW) + (size_t)e * CAP + blk * 128, slot0, nvalid};
            gemm_tile(lds, RP, (const bf16_t*)(ws + WS_WD) + (size_t)e * 1024 * 256, 256, 1024, 256, 0, tn * 128, E);
        }
    }
    xcd_barrier(xbar);
    combine_rows(p, base, gw, ngw, lane);
}

extern "C" void kernel_launch(void* const* d_in, const int* in_sizes, int n_in,
                              void* d_out, int out_size, void* d_ws, size_t ws_size,
                              hipStream_t stream) {
    static int grid_blocks = 0;
    if (!grid_blocks) {
        if (n_in != 31 || out_size != T * D || ws_size < WS_END) { fprintf(stderr, "kernel_launch: unexpected shapes n_in=%d out=%d ws=%zu (need %zu)\n", n_in, out_size, ws_size, (size_t)WS_END); grid_blocks = -1; return; }
        int dev = 0, cus = 0, per_cu = 0;
        (void)hipGetDevice(&dev);
        (void)hipDeviceGetAttribute(&cus, hipDeviceAttributeMultiprocessorCount, dev);
        (void)hipFuncSetAttribute((const void*)fwd_kernel, hipFuncAttributeMaxDynamicSharedMemorySize, LDS_BYTES);
        (void)hipOccupancyMaxActiveBlocksPerMultiprocessor(&per_cu, (const void*)fwd_kernel, NT, LDS_BYTES);
        if (per_cu < 1) per_cu = 1;
        grid_blocks = cus * per_cu;
        fprintf(stderr, "kernel_launch: cus=%d per_cu=%d grid=%d ws=%zu\n", cus, per_cu, grid_blocks, ws_size);
    }
    if (grid_blocks < 0) return;
    (void)hipMemsetAsync((char*)d_ws + WS_CTL, 0, CTL_BYTES, stream);
    Params p{};
    for (int i = 0; i < 31; ++i) p.in[i] = (const float*)d_in[i];
    p.out = (float*)d_out; p.ws = (unsigned char*)d_ws;
    void* args[] = {&p};
    hipError_t e = hipLaunchCooperativeKernel((const void*)fwd_kernel, dim3(grid_blocks), dim3(NT), args, LDS_BYTES, stream);
    if (e != hipSuccess) fprintf(stderr, "cooperative launch failed: %s (grid %d)\n", hipGetErrorString(e), grid_blocks);
}
```

```cpp
#include <hip/hip_runtime.h>
#include <hip/hip_cooperative_groups.h>
#include <cstdio>
#include <cstdint>
namespace cg = cooperative_groups;
#ifndef DBG_STAGE
#define DBG_STAGE 0
#endif
#define TS_A0 0
#define TS_A1 1
#define TS_B0 2
#define TS_B1 3

#define LAS __attribute__((address_space(3)))
typedef unsigned short bf16_t;
typedef short bf16x8 __attribute__((ext_vector_type(8)));
typedef short bf16x4 __attribute__((ext_vector_type(4)));
typedef float f32x4 __attribute__((ext_vector_type(4)));
typedef float f32x2 __attribute__((ext_vector_type(2)));
typedef unsigned u32x4 __attribute__((ext_vector_type(4)));
typedef unsigned u32x2 __attribute__((ext_vector_type(2)));

constexpr int NT = 512, NWAVES = 8;
constexpr int LDS_BYTES = 128 * 1024;
constexpr int Bsz = 8, S = 2048, D = 1024, T = Bsz * S;
constexpr int H_MLA = 8, DQK = 96, DNOPE = 64, DROPE = 32, DV = 64, QLORA = 384, KVLORA = 256;
constexpr int H_ML = 4, DM = 128, MINNER = 512, CHUNK = 64, NCH = S / CHUNK;
constexpr int IN_DIM = 2216;
constexpr int OFF_CQ = 0, OFF_CKV = 384, OFF_KR = 640, OFF_Z = 672, OFF_MV = 1184, OFF_MO = 1696, OFF_GATE = 2208;
constexpr int NE = 256, TOPK = 8, EDIM = 256, SDIM = 256;
constexpr int CAP = T;
constexpr float RMS_EPS = 1e-6f;

constexpr size_t MiB = 1u << 20;
constexpr size_t WS_CTL = 0;
constexpr size_t CTL_BYTES = 32768;
constexpr size_t WS_ADA = 1 * MiB;
constexpr size_t WS_BC = 2 * MiB;
constexpr size_t WS_MLOC = WS_BC + 8192;
constexpr size_t WS_MPREV = WS_BC + 16384;
constexpr size_t WS_DN = 2 * MiB + 512 * 1024;
constexpr size_t WS_NPREV = 3 * MiB;
constexpr size_t WS_WIN = 4 * MiB;
constexpr size_t WS_WUQ = 9 * MiB;
constexpr size_t WS_WUKV = 10 * MiB;
constexpr size_t WS_WMQK = 11 * MiB;
constexpr size_t WS_WOUT = 12 * MiB;
constexpr size_t WS_WRGU = 14 * MiB;
constexpr size_t WS_WDSH = 16 * MiB;
constexpr size_t WS_WGU = 32 * MiB;
constexpr size_t WS_WD = 288 * MiB;
constexpr size_t RB = 416 * MiB;
constexpr size_t B_PROJ = RB;
constexpr size_t B_GRAW = RB + 70 * MiB;
constexpr size_t B_GL = RB + 71 * MiB;
constexpr size_t B_H1 = RB + 72 * MiB;
constexpr size_t B_CQN = RB + 104 * MiB;
constexpr size_t B_CKVN = RB + 116 * MiB;
constexpr size_t B_ZC = RB + 124 * MiB;
constexpr size_t B_QRAW = RB + 140 * MiB;
constexpr size_t B_KVRAW = RB + 164 * MiB;
constexpr size_t B_MQ = RB + 196 * MiB;
constexpr size_t B_MK = RB + 212 * MiB;
constexpr size_t B_Q = RB + 228 * MiB;
constexpr size_t B_K = RB + 252 * MiB;
constexpr size_t B_ORAW = RB + 276 * MiB;
constexpr size_t B_AO = RB + 292 * MiB;
constexpr size_t B_DC = RB + 324 * MiB;
constexpr size_t B_CPREV = RB + 388 * MiB;
constexpr size_t C_H2 = RB;
constexpr size_t C_LOGITS = RB + 32 * MiB;
constexpr size_t C_ACTSH = RB + 48 * MiB;
constexpr size_t C_SHOUT = RB + 56 * MiB;
constexpr size_t C_TOKE = RB + 88 * MiB;
constexpr size_t C_TOKW = RB + 89 * MiB;
constexpr size_t C_TOKPOS = RB + 90 * MiB;
constexpr size_t C_LISTTOK = RB + 92 * MiB;
constexpr size_t C_LISTW = RB + 108 * MiB;
constexpr size_t C_ACTE = RB + 124 * MiB;
constexpr size_t C_Y = RB + 188 * MiB;
constexpr size_t WS_END = RB + 444 * MiB;

struct Params {
    const float* in[31];
    float* out;
    unsigned char* ws;
};

typedef __bf16 bf16x2v __attribute__((ext_vector_type(2)));
__device__ __forceinline__ unsigned cvt_pk_bf16(float lo, float hi) { f32x2 v = {lo, hi}; bf16x2v b = __builtin_convertvector(v, bf16x2v); return __builtin_bit_cast(unsigned, b); }
__device__ __forceinline__ float bf2f(unsigned short b) { return __uint_as_float((unsigned)b << 16); }
__device__ __forceinline__ float bflo(unsigned u) { return __uint_as_float(u << 16); }
__device__ __forceinline__ float bfhi(unsigned u) { return __uint_as_float(u & 0xffff0000u); }
__device__ __forceinline__ float wave_sum(float v) {
#pragma unroll
    for (int o = 1; o < 64; o <<= 1) v += __shfl_xor(v, o);
    return v;
}
__device__ __forceinline__ float wave_max(float v) {
#pragma unroll
    for (int o = 1; o < 64; o <<= 1) v = fmaxf(v, __shfl_xor(v, o));
    return v;
}
__device__ __forceinline__ float sigmoidf_(float x) { return 1.f / (1.f + __expf(-x)); }
__device__ __forceinline__ float siluf_(float x) { return x / (1.f + __expf(-x)); }
#define MFMA16(a, b, c) __builtin_amdgcn_mfma_f32_16x16x32_bf16((a), (b), (c), 0, 0, 0)


#define XB_TMO      128
#define XB_XCNT(j)  (256  + 64 * (j))
#define XB_XSUB(j)  (1280 + 64 * (j))
#define XB_XGEN(j)  (2304 + 64 * (j))
#define XB_TOP      3328
#define XB_TOPGEN   3392
#define XCD_BAR_WORDS 3456
#define XB_SPIN_CAP (1u << 23)
__device__ __forceinline__ unsigned xb_ld(unsigned* p)              { return __hip_atomic_load(p, __ATOMIC_RELAXED, __HIP_MEMORY_SCOPE_AGENT); }
__device__ __forceinline__ unsigned xb_add(unsigned* p, unsigned v) { return __hip_atomic_fetch_add(p, v, __ATOMIC_RELAXED, __HIP_MEMORY_SCOPE_AGENT); }
__device__ __forceinline__ unsigned xb_xcc_id() { return (unsigned)__builtin_amdgcn_s_getreg((3 << 11) | 20) & 0xFu; }
#define XB_SPIN(cond, bar) do { unsigned _sp = 0; while (cond) { __builtin_amdgcn_s_sleep(1); \
    if ((++_sp & 255u) == 0u) { if (xb_ld(&(bar)[XB_TMO])) break; if (_sp > XB_SPIN_CAP) { atomicAdd(&(bar)[XB_TMO], 1u); break; } } } } while (0)
struct XcdBarrier { unsigned* bar; unsigned x; volatile LAS unsigned* st; };
__device__ __forceinline__ XcdBarrier xcd_barrier_post(unsigned* bar, volatile LAS unsigned* st) {
    XcdBarrier b; b.bar = bar; b.x = xb_xcc_id(); b.st = st;
    if (threadIdx.x == 0) (void)xb_add(&bar[XB_XCNT(b.x)], 1u);
    return b;
}
__device__ __forceinline__ void xcd_barrier_complete(unsigned* bar, unsigned x, unsigned& nloc, unsigned& nx) {
    const unsigned G = gridDim.x * gridDim.y * gridDim.z;
    unsigned sum, cnt, mine, sp = 0u;
    for (;;) {
        sum = 0u; cnt = 0u; mine = 0u;
#pragma unroll
        for (unsigned j = 0; j < 16; ++j) { const unsigned c = xb_ld(&bar[XB_XCNT(j)]); sum += c; cnt += (c > 0u) ? 1u : 0u; mine = (j == x) ? c : mine; }
        if (sum == G) break;
        __builtin_amdgcn_s_sleep(1);
        if ((++sp & 255u) == 0u) { if (xb_ld(&bar[XB_TMO])) break; if (sp > XB_SPIN_CAP) { atomicAdd(&bar[XB_TMO], 1u); break; } }
    }
    nloc = mine > 0u ? mine : 1u; nx = cnt > 0u ? cnt : 1u;
}
__device__ __forceinline__ void xcd_barrier(const XcdBarrier& b) {
    asm volatile("s_waitcnt vmcnt(0)" ::: "memory");
    __syncthreads();
    if (threadIdx.x == 0) {
        unsigned* bar = b.bar;
        __builtin_amdgcn_s_waitcnt(0);
        unsigned nloc = b.st[0], nx = b.st[1];
        if (nloc == 0u) { xcd_barrier_complete(bar, b.x, nloc, nx); b.st[0] = nloc; b.st[1] = nx; }
        const unsigned old = xb_add(&bar[XB_XSUB(b.x)], 1u);
        const unsigned gen = old / nloc;
        if (old + 1u == (gen + 1u) * nloc) {
            __builtin_amdgcn_fence(__ATOMIC_RELEASE, "agent");
            asm volatile("s_waitcnt vmcnt(0)" ::: "memory");
            const unsigned og = xb_add(&bar[XB_TOP], 1u);
            const unsigned tg = og / nx;
            if (og + 1u == (tg + 1u) * nx) xb_add(&bar[XB_TOPGEN], 1u);
            else XB_SPIN(xb_ld(&bar[XB_TOPGEN]) == tg, bar);
            __builtin_amdgcn_fence(__ATOMIC_ACQUIRE, "agent");
            xb_add(&bar[XB_XGEN(b.x)], 1u);
            asm volatile("s_waitcnt vmcnt(0)" ::: "memory");
        } else {
            XB_SPIN(xb_ld(&bar[XB_XGEN(b.x)]) == gen, bar);
            __builtin_amdgcn_fence(__ATOMIC_ACQUIRE, "agent");
            asm volatile("s_waitcnt vmcnt(0)" ::: "memory");
        }
    }
    __syncthreads();
}

template <int MAP>
__device__ __forceinline__ int map_row(int n) {
    if (MAP == 0) return n;
    if (MAP == 1) return ((n >> 4) << 5) + (n & 15);
    return ((n >> 4) << 5) + 16 + (n & 15);
}
template <int MAP>
__device__ __forceinline__ void conv_batch(const float* src, int nmat, int K, int N, bf16_t* dst, size_t dst_mat_stride, int row_off,
                                           LAS float* scr, int gw, int ngw, int lane) {
    const int nblk = (N + 31) / 32, kblk = K / 64, per = nblk * kblk;
    const int total = nmat * per;
    for (int it = gw; it < total; it += ngw) {
        const int mat = it / per, r = it - mat * per, kb = r / nblk, nb = r - kb * nblk, k0 = kb * 64, n0 = nb * 32;
        const float* W = src + (size_t)mat * K * N;
        bf16_t* WT = dst + (size_t)mat * dst_mat_stride;
        const int nn = n0 + (lane & 31);
        const bool nok = nn < N;
#pragma unroll 8
        for (int i = 0; i < 32; ++i) { const int kk = 2 * i + (lane >> 5); scr[kk * 33 + (lane & 31)] = nok ? W[(size_t)(k0 + kk) * N + nn] : 0.f; }
        asm volatile("s_waitcnt lgkmcnt(0)" ::: "memory");
        const int c = lane & 7;
#pragma unroll
        for (int j = 0; j < 4; ++j) {
            const int n = (lane >> 3) + 8 * j;
            const LAS float* s = scr + (8 * c) * 33 + n;
            u32x4 o; o.x = cvt_pk_bf16(s[0 * 33], s[1 * 33]); o.y = cvt_pk_bf16(s[2 * 33], s[3 * 33]); o.z = cvt_pk_bf16(s[4 * 33], s[5 * 33]); o.w = cvt_pk_bf16(s[6 * 33], s[7 * 33]);
            if (n0 + n < N) *(u32x4*)(WT + (size_t)(row_off + map_row<MAP>(n0 + n)) * K + k0 + 8 * c) = o;
        }
        asm volatile("s_waitcnt lgkmcnt(0)" ::: "memory");
    }
}

__device__ __forceinline__ void ada_unit(const Params& p, LAS unsigned char* lds, int u, int tid) {
    LAS float* cond = (LAS float*)lds;
    LAS float* red = (LAS float*)(lds + 32768);
    const float* c = p.in[1]; const float* w = p.in[3]; const float* bias = p.in[4];
    float* ada = (float*)(p.ws + WS_ADA);
    const int lane = tid & 63, wv = tid >> 6;
    for (int i = tid; i < 8 * 1024; i += NT) cond[i] = siluf_(c[i]);
    __syncthreads();
    float acc[8];
#pragma unroll
    for (int b = 0; b < 8; ++b) acc[b] = 0.f;
    const int col = u * 64 + lane;
#pragma unroll 4
    for (int k = wv * 128; k < wv * 128 + 128; ++k) {
        const float wv_ = w[(size_t)k * 6144 + col];
#pragma unroll
        for (int b = 0; b < 8; ++b) acc[b] += cond[b * 1024 + k] * wv_;
    }
#pragma unroll
    for (int b = 0; b < 8; ++b) red[(wv * 8 + b) * 64 + lane] = acc[b];
    __syncthreads();
    {
        const int b = tid >> 6;
        float s = 0.f;
#pragma unroll
        for (int w2 = 0; w2 < 8; ++w2) s += red[(w2 * 8 + b) * 64 + lane];
        ada[b * 6144 + col] = s + bias[col];
    }
    __syncthreads();
}

__device__ __forceinline__ void norm_mod_rows(const float* X, const float* g, const float* ada, int sh_off, int sc_off, bf16_t* Hout, int gw, int ngw, int lane) {
    for (int row = gw; row < T; row += ngw) {
        const int b = row / S;
        const f32x4* xr = (const f32x4*)(X + (size_t)row * D) + lane;
        f32x4 v[4]; float ss = 0.f;
#pragma unroll
        for (int j = 0; j < 4; ++j) { v[j] = xr[64 * j]; ss += v[j].x * v[j].x + v[j].y * v[j].y + v[j].z * v[j].z + v[j].w * v[j].w; }
        const float rinv = rsqrtf(wave_sum(ss) * (1.f / D) + RMS_EPS);
        u32x2* o = (u32x2*)(Hout + (size_t)row * D) + lane;
#pragma unroll
        for (int j = 0; j < 4; ++j) {
            const int k = 4 * (lane + 64 * j);
            const f32x4 gg = *(const f32x4*)(g + k), sc = *(const f32x4*)(ada + b * 6144 + sc_off + k), sh = *(const f32x4*)(ada + b * 6144 + sh_off + k);
            const f32x4 h = v[j] * rinv * gg * (1.f + sc) + sh;
            u32x2 w; w.x = cvt_pk_bf16(h.x, h.y); w.y = cvt_pk_bf16(h.z, h.w);
            o[64 * j] = w;
        }
    }
}

__device__ __forceinline__ void post_proj_rows(const Params& p, int gw, int ngw, int lane) {
    const bf16_t* proj = (const bf16_t*)(p.ws + B_PROJ);
    const float* graw = (const float*)(p.ws + B_GRAW);
    float* gl = (float*)(p.ws + B_GL);
    bf16_t* cqn = (bf16_t*)(p.ws + B_CQN); bf16_t* ckvn = (bf16_t*)(p.ws + B_CKVN); bf16_t* zc = (bf16_t*)(p.ws + B_ZC);
    const float* g_cq = p.in[7]; const float* g_ckv = p.in[9]; const float* conv_w = p.in[14]; const float* conv_b = p.in[15];
    const float* b_i = p.in[18]; const float* b_f = p.in[19];
    for (int row = gw; row < T; row += ngw) {
        const bf16_t* pr = proj + (size_t)row * IN_DIM;
        const int s = row % S;
        {
            const unsigned* q = (const unsigned*)(pr + OFF_CQ) + lane * 3;
            unsigned a0 = q[0], a1 = q[1], a2 = q[2];
            float f[6] = {bflo(a0), bfhi(a0), bflo(a1), bfhi(a1), bflo(a2), bfhi(a2)};
            float ss = 0.f;
#pragma unroll
            for (int j = 0; j < 6; ++j) ss += f[j] * f[j];
            const float rinv = rsqrtf(wave_sum(ss) * (1.f / QLORA) + RMS_EPS);
            const float* gq = g_cq + lane * 6;
            unsigned* o = (unsigned*)(cqn + (size_t)row * QLORA) + lane * 3;
            o[0] = cvt_pk_bf16(f[0] * rinv * gq[0], f[1] * rinv * gq[1]);
            o[1] = cvt_pk_bf16(f[2] * rinv * gq[2], f[3] * rinv * gq[3]);
            o[2] = cvt_pk_bf16(f[4] * rinv * gq[4], f[5] * rinv * gq[5]);
        }
        {
            const u32x2 a = *((const u32x2*)(pr + OFF_CKV) + lane);
            float f[4] = {bflo(a.x), bfhi(a.x), bflo(a.y), bfhi(a.y)};
            float ss = f[0] * f[0] + f[1] * f[1] + f[2] * f[2] + f[3] * f[3];
            const float rinv = rsqrtf(wave_sum(ss) * (1.f / KVLORA) + RMS_EPS);
            const float* gk = g_ckv + lane * 4;
            u32x2 w; w.x = cvt_pk_bf16(f[0] * rinv * gk[0], f[1] * rinv * gk[1]); w.y = cvt_pk_bf16(f[2] * rinv * gk[2], f[3] * rinv * gk[3]);
            *((u32x2*)(ckvn + (size_t)row * KVLORA) + lane) = w;
        }
        {
            const int c0 = lane * 8;
            float acc[8];
#pragma unroll
            for (int j = 0; j < 8; ++j) acc[j] = conv_b[c0 + j];
#pragma unroll
            for (int tap = 0; tap < 4; ++tap) {
                const int ds = tap - 3;
                if (s + ds >= 0) {
                    const u32x4 z = *(const u32x4*)(pr + (ptrdiff_t)ds * IN_DIM + OFF_Z + c0);
                    const float* cw = conv_w + tap * MINNER + c0;
                    acc[0] += bflo(z.x) * cw[0]; acc[1] += bfhi(z.x) * cw[1]; acc[2] += bflo(z.y) * cw[2]; acc[3] += bfhi(z.y) * cw[3];
                    acc[4] += bflo(z.z) * cw[4]; acc[5] += bfhi(z.z) * cw[5]; acc[6] += bflo(z.w) * cw[6]; acc[7] += bfhi(z.w) * cw[7];
                }
            }
            u32x4 o; o.x = cvt_pk_bf16(siluf_(acc[0]), siluf_(acc[1])); o.y = cvt_pk_bf16(siluf_(acc[2]), siluf_(acc[3]));
            o.z = cvt_pk_bf16(siluf_(acc[4]), siluf_(acc[5])); o.w = cvt_pk_bf16(siluf_(acc[6]), siluf_(acc[7]));
            *(u32x4*)(zc + (size_t)row * MINNER + c0) = o;
        }
        if (lane < 8) {
            const float gr = graw[(size_t)row * 8 + lane];
            float o;
            if (lane < 4) o = gr + b_i[lane];
            else { const float xx = gr + b_f[lane - 4]; o = fminf(xx, 0.f) - log1pf(__expf(-fabsf(xx))); }
            gl[(size_t)row * 8 + lane] = o;
        }
    }
}

__device__ __forceinline__ void qk_post_rows(const Params& p, int gw, int ngw, int lane) {
    const bf16_t* qraw = (const bf16_t*)(p.ws + B_QRAW); const bf16_t* kvraw = (const bf16_t*)(p.ws + B_KVRAW);
    const bf16_t* proj = (const bf16_t*)(p.ws + B_PROJ);
    bf16_t* Q = (bf16_t*)(p.ws + B_Q); bf16_t* Kb = (bf16_t*)(p.ws + B_K);
    const int* positions = (const int*)p.in[2];
    const float* g_qn = p.in[11]; const float* g_kn = p.in[12];
    const float qscale = 0.10206207261596575f * 1.4426950408889634f;
    for (int it = gw; it < T * 4; it += ngw) {
        const int row = it >> 2, hp = it & 3, h = hp * 2 + (lane >> 5), l = lane & 31;
        const int b = row / S, s = row % S;
        const float pos = (float)positions[row];
        const int i = l & 15;
        const float inv_freq = exp2f(-(float)(2 * i) * (13.287712379549449f / 32.f));
        const float ang = pos * inv_freq;
        float sn, cs; sincosf(ang, &sn, &cs);
        {
            const bf16_t* qr = qraw + (size_t)row * 768 + h * 96;
            float v0 = bf2f(qr[l]), v1 = bf2f(qr[l + 32]), v2 = bf2f(qr[l + 64]);
            float ss = v0 * v0 + v1 * v1 + v2 * v2;
#pragma unroll
            for (int o = 1; o < 32; o <<= 1) ss += __shfl_xor(ss, o);
            const float rinv = rsqrtf(ss * (1.f / 96.f) + RMS_EPS);
            v0 *= rinv * g_qn[l]; v1 *= rinv * g_qn[l + 32]; v2 *= rinv * g_qn[l + 64];
            const float other = __shfl_xor(v2, 16);
            const float r = (l < 16) ? (v2 * cs - other * sn) : (other * sn + v2 * cs);
            bf16_t* qo = Q + ((size_t)(b * H_MLA + h) * S + s) * 96;
            qo[l] = (bf16_t)(cvt_pk_bf16(v0 * qscale, 0.f) & 0xffff);
            qo[l + 32] = (bf16_t)(cvt_pk_bf16(v1 * qscale, 0.f) & 0xffff);
            qo[l + 64] = (bf16_t)(cvt_pk_bf16(r * qscale, 0.f) & 0xffff);
        }
        {
            const bf16_t* kr = kvraw + (size_t)row * 1024 + h * 128;
            float v0 = bf2f(kr[l]), v1 = bf2f(kr[l + 32]), v2 = bf2f(proj[(size_t)row * IN_DIM + OFF_KR + l]);
            float ss = v0 * v0 + v1 * v1 + v2 * v2;
#pragma unroll
            for (int o = 1; o < 32; o <<= 1) ss += __shfl_xor(ss, o);
            const float rinv = rsqrtf(ss * (1.f / 96.f) + RMS_EPS);
            v0 *= rinv * g_kn[l]; v1 *= rinv * g_kn[l + 32]; v2 *= rinv * g_kn[l + 64];
            const float other = __shfl_xor(v2, 16);
            const float r = (l < 16) ? (v2 * cs - other * sn) : (other * sn + v2 * cs);
            bf16_t* ko = Kb + ((size_t)(b * H_MLA + h) * S + s) * 96;
            ko[l] = (bf16_t)(cvt_pk_bf16(v0, 0.f) & 0xffff);
            ko[l + 32] = (bf16_t)(cvt_pk_bf16(v1, 0.f) & 0xffff);
            ko[l + 64] = (bf16_t)(cvt_pk_bf16(r, 0.f) & 0xffff);
        }
    }
}

__device__ __forceinline__ void attn_out_norm_rows(const Params& p, int gw, int ngw, int lane) {
    const bf16_t* oraw = (const bf16_t*)(p.ws + B_ORAW); bf16_t* ao = (bf16_t*)(p.ws + B_AO); const float* g = p.in[13];
    for (int row = gw; row < T; row += ngw) {
        const u32x4 a = *((const u32x4*)(oraw + (size_t)row * 512) + lane);
        float f[8] = {bflo(a.x), bfhi(a.x), bflo(a.y), bfhi(a.y), bflo(a.z), bfhi(a.z), bflo(a.w), bfhi(a.w)};
        float ss = 0.f;
#pragma unroll
        for (int j = 0; j < 8; ++j) ss += f[j] * f[j];
        const float rinv = rsqrtf(wave_sum(ss) * (1.f / 512.f) + RMS_EPS);
        const float* gg = g + lane * 8;
        u32x4 o; o.x = cvt_pk_bf16(f[0] * rinv * gg[0], f[1] * rinv * gg[1]); o.y = cvt_pk_bf16(f[2] * rinv * gg[2], f[3] * rinv * gg[3]);
        o.z = cvt_pk_bf16(f[4] * rinv * gg[4], f[5] * rinv * gg[5]); o.w = cvt_pk_bf16(f[6] * rinv * gg[6], f[7] * rinv * gg[7]);
        *((u32x4*)(ao + (size_t)row * 1024) + lane) = o;
    }
}

constexpr int GLD = 72;
constexpr int G2_AS = 256 * GLD * 2;
constexpr int G2_BS = 128 * GLD * 2;
constexpr int G2_STAGE = G2_AS + G2_BS;
template <class RowPtr, class ColPtr, class Epi>
__device__ __forceinline__ void gemm2_tile(LAS unsigned char* lds, const RowPtr& RP, const ColPtr& CP, int ldk, int K, int m0, int n0, const Epi& E) {
    const int tid = threadIdx.x, lane = tid & 63, wid = tid >> 6, wm = wid >> 1, wn = wid & 1;
    const int fr = lane & 15, fq = lane >> 4;
    const int ar = tid >> 1, ak = (tid & 1) * 32;
    const int bn = tid & 127, bk = (tid >> 7) * 16;
    const bf16_t* ap = RP(m0 + ar);
    const float* bp = CP(n0 + bn);
    f32x4 acc[4][4];
#pragma unroll
    for (int m = 0; m < 4; ++m)
#pragma unroll
        for (int n = 0; n < 4; ++n) acc[m][n] = (f32x4){0.f, 0.f, 0.f, 0.f};
    u32x4 ra[4]; float rb[16];
    const u32x4 z4 = (u32x4){0u, 0u, 0u, 0u};
    const int nk = K / 64;
#define G2_LOAD(kt_) do { const int k0_ = (kt_) * 64; \
        _Pragma("unroll") for (int j_ = 0; j_ < 4; ++j_) ra[j_] = ap ? *(const u32x4*)(ap + k0_ + ak + j_ * 8) : z4; \
        _Pragma("unroll") for (int j_ = 0; j_ < 16; ++j_) rb[j_] = bp ? bp[(size_t)(k0_ + bk + j_) * ldk] : 0.f; } while (0)
#define G2_STORE(buf_) do { LAS bf16_t* As_ = (LAS bf16_t*)(lds + (buf_) * G2_STAGE); LAS bf16_t* Bs_ = (LAS bf16_t*)(lds + (buf_) * G2_STAGE + G2_AS); \
        _Pragma("unroll") for (int j_ = 0; j_ < 4; ++j_) *(LAS u32x4*)(As_ + ar * GLD + ak + j_ * 8) = ra[j_]; \
        u32x4 w0_, w1_; w0_.x = cvt_pk_bf16(rb[0], rb[1]); w0_.y = cvt_pk_bf16(rb[2], rb[3]); w0_.z = cvt_pk_bf16(rb[4], rb[5]); w0_.w = cvt_pk_bf16(rb[6], rb[7]); \
        w1_.x = cvt_pk_bf16(rb[8], rb[9]); w1_.y = cvt_pk_bf16(rb[10], rb[11]); w1_.z = cvt_pk_bf16(rb[12], rb[13]); w1_.w = cvt_pk_bf16(rb[14], rb[15]); \
        *(LAS u32x4*)(Bs_ + bn * GLD + bk) = w0_; *(LAS u32x4*)(Bs_ + bn * GLD + bk + 8) = w1_; } while (0)
#define G2_COMPUTE(buf_, ks_) do { const LAS bf16_t* As_ = (const LAS bf16_t*)(lds + (buf_) * G2_STAGE); const LAS bf16_t* Bs_ = (const LAS bf16_t*)(lds + (buf_) * G2_STAGE + G2_AS); \
        bf16x8 af_[4], bf_[4]; \
        _Pragma("unroll") for (int m_ = 0; m_ < 4; ++m_) af_[m_] = *(const LAS bf16x8*)(As_ + (wm * 64 + m_ * 16 + fr) * GLD + (ks_) * 32 + fq * 8); \
        _Pragma("unroll") for (int n_ = 0; n_ < 4; ++n_) bf_[n_] = *(const LAS bf16x8*)(Bs_ + (wn * 64 + n_ * 16 + fr) * GLD + (ks_) * 32 + fq * 8); \
        _Pragma("unroll") for (int m_ = 0; m_ < 4; ++m_) _Pragma("unroll") for (int n_ = 0; n_ < 4; ++n_) acc[m_][n_] = MFMA16(bf_[n_], af_[m_], acc[m_][n_]); } while (0)
    G2_LOAD(0);
    G2_STORE(0);
    if (nk > 1) G2_LOAD(1);
    __syncthreads();
    for (int kt = 0; kt < nk; ++kt) {
        const int cur = kt & 1;
        G2_COMPUTE(cur, 0);
        if (kt + 1 < nk) { G2_STORE(cur ^ 1); if (kt + 2 < nk) G2_LOAD(kt + 2); }
        G2_COMPUTE(cur, 1);
        __syncthreads();
    }
#undef G2_LOAD
#undef G2_STORE
#undef G2_COMPUTE
    E(acc, m0 + wm * 64, n0 + wn * 64, lane);
}

struct RowDense { const bf16_t* A; int lda; __device__ __forceinline__ const bf16_t* operator()(int r) const { return A + (size_t)r * lda; } };
struct RowGather { const bf16_t* A; const int* idx; int nvalid; __device__ __forceinline__ const bf16_t* operator()(int r) const { return r < nvalid ? A + (size_t)idx[r] * D : nullptr; } };
struct RowSlots { const bf16_t* A; int nvalid; __device__ __forceinline__ const bf16_t* operator()(int r) const { return r < nvalid ? A + (size_t)r * EDIM : nullptr; } };
struct ColDense { const float* W; int N; __device__ __forceinline__ const float* operator()(int c) const { return c < N ? W + c : nullptr; } };
struct ColMqk { const float* q; ptrdiff_t dk; __device__ __forceinline__ const float* operator()(int c) const { return q + ((c < 128) ? (ptrdiff_t)c : dk + (c - 128)); } };
struct ColGU { const float* g; ptrdiff_t du; __device__ __forceinline__ const float* operator()(int c) const { const int j = c >> 5, w = c & 31; return g + (((w & 16) ? du : (ptrdiff_t)0) + j * 16 + (w & 15)); } };
struct ColRgu { const float* r; ptrdiff_t dg; ptrdiff_t du; __device__ __forceinline__ const float* operator()(int c) const {
    const int cc = c - 256, j = cc >> 5, w = cc & 31; const ptrdiff_t off = (c < 256) ? (ptrdiff_t)c : (((w & 16) ? du : dg) + j * 16 + (w & 15)); return r + off; } };

__device__ __forceinline__ u32x2 pack4(const f32x4 v) { u32x2 w; w.x = cvt_pk_bf16(v.x, v.y); w.y = cvt_pk_bf16(v.z, v.w); return w; }
__device__ __forceinline__ u32x2 pack_swiglu(const f32x4 g, const f32x4 u) { u32x2 w; w.x = cvt_pk_bf16(siluf_(g.x) * u.x, siluf_(g.y) * u.y); w.y = cvt_pk_bf16(siluf_(g.z) * u.z, siluf_(g.w) * u.w); return w; }
struct EpiProj {
    bf16_t* proj; float* graw;
    __device__ __forceinline__ void operator()(const f32x4 (&acc)[4][4], int rb, int cb, int lane) const {
        const int fr = lane & 15, fq = lane >> 4;
#pragma unroll
        for (int m = 0; m < 4; ++m)
#pragma unroll
            for (int n = 0; n < 4; ++n) {
                const int row = rb + m * 16 + fr, col = cb + n * 16 + 4 * fq;
                if (col < OFF_GATE) *(u32x2*)(proj + (size_t)row * IN_DIM + col) = pack4(acc[m][n]);
                else if (col < IN_DIM) *(f32x4*)(graw + (size_t)row * 8 + (col - OFF_GATE)) = acc[m][n];
            }
    }
};
struct EpiBf16 {
    bf16_t* O; int ldc;
    __device__ __forceinline__ void operator()(const f32x4 (&acc)[4][4], int rb, int cb, int lane) const {
        const int fr = lane & 15, fq = lane >> 4;
#pragma unroll
        for (int m = 0; m < 4; ++m)
#pragma unroll
            for (int n = 0; n < 4; ++n) *(u32x2*)(O + (size_t)(rb + m * 16 + fr) * ldc + cb + n * 16 + 4 * fq) = pack4(acc[m][n]);
    }
};
struct EpiMqk {
    bf16_t* mq; bf16_t* mk; int h;
    __device__ __forceinline__ void operator()(const f32x4 (&acc)[4][4], int rb, int cb, int lane) const {
        const int fr = lane & 15, fq = lane >> 4;
#pragma unroll
        for (int m = 0; m < 4; ++m)
#pragma unroll
            for (int n = 0; n < 4; ++n) {
                const int row = rb + m * 16 + fr, col = cb + n * 16 + 4 * fq; f32x4 v = acc[m][n];
                bf16_t* dst = mq; int c = col;
                if (col >= 128) { dst = mk; c = col - 128; v = v * 0.08838834764831845f; }
                *(u32x2*)(dst + (size_t)row * MINNER + h * DM + c) = pack4(v);
            }
    }
};
struct EpiResid {
    const float* X; const float* ada; int gt_off; float* out;
    __device__ __forceinline__ void operator()(const f32x4 (&acc)[4][4], int rb, int cb, int lane) const {
        const int fr = lane & 15, fq = lane >> 4;
#pragma unroll
        for (int m = 0; m < 4; ++m)
#pragma unroll
            for (int n = 0; n < 4; ++n) {
                const int row = rb + m * 16 + fr, col = cb + n * 16 + 4 * fq; const int b = row / S;
                const f32x4 g = *(const f32x4*)(ada + b * 6144 + gt_off + col);
                const f32x4 x = *(const f32x4*)(X + (size_t)row * D + col);
                *(f32x4*)(out + (size_t)row * D + col) = x + g * acc[m][n];
            }
    }
};
struct EpiRgu {
    float* logits; bf16_t* act;
    __device__ __forceinline__ void operator()(const f32x4 (&acc)[4][4], int rb, int cb, int lane) const {
        const int fr = lane & 15, fq = lane >> 4;
#pragma unroll
        for (int m = 0; m < 4; ++m) {
            const int row = rb + m * 16 + fr;
            if (cb < 256) {
#pragma unroll
                for (int n = 0; n < 4; ++n) *(f32x4*)(logits + (size_t)row * 256 + cb + n * 16 + 4 * fq) = acc[m][n];
            } else {
                const int j0 = (cb - 256) >> 5;
#pragma unroll
                for (int pp = 0; pp < 2; ++pp) *(u32x2*)(act + (size_t)row * 256 + (j0 + pp) * 16 + 4 * fq) = pack_swiglu(acc[m][2 * pp], acc[m][2 * pp + 1]);
            }
        }
    }
};
struct EpiExpAct {
    bf16_t* act; int slot0; int nvalid;
    __device__ __forceinline__ void operator()(const f32x4 (&acc)[4][4], int rb, int cb, int lane) const {
        const int fr = lane & 15, fq = lane >> 4;
#pragma unroll
        for (int m = 0; m < 4; ++m) {
            const int r = rb + m * 16 + fr;
            if (r < nvalid) {
                const int j0 = cb >> 5;
#pragma unroll
                for (int pp = 0; pp < 2; ++pp) *(u32x2*)(act + (size_t)(slot0 + r) * 256 + (j0 + pp) * 16 + 4 * fq) = pack_swiglu(acc[m][2 * pp], acc[m][2 * pp + 1]);
            }
        }
    }
};
struct EpiExpDown {
    bf16_t* y; const float* lw; int slot0; int nvalid;
    __device__ __forceinline__ void operator()(const f32x4 (&acc)[4][4], int rb, int cb, int lane) const {
        const int fr = lane & 15, fq = lane >> 4;
#pragma unroll
        for (int m = 0; m < 4; ++m) {
            const int r = rb + m * 16 + fr;
            if (r < nvalid) {
                const float wt = lw[r];
#pragma unroll
                for (int n = 0; n < 4; ++n) *(u32x2*)(y + (size_t)(slot0 + r) * 1024 + cb + n * 16 + 4 * fq) = pack4(acc[m][n] * wt);
            }
        }
    }
};

constexpr int AKLD = 104, AVLD = 72;
__device__ __forceinline__ void attn_unit(const Params& p, LAS unsigned char* lds, int bh, int qb) {
    LAS bf16_t* Ks = (LAS bf16_t*)lds;
    LAS bf16_t* Vt = Ks + 64 * AKLD;
    const bf16_t* Q = (const bf16_t*)(p.ws + B_Q) + (size_t)bh * S * 96;
    const bf16_t* Kg = (const bf16_t*)(p.ws + B_K) + (size_t)bh * S * 96;
    const int b = bh >> 3, h = bh & 7;
    const bf16_t* Vg = (const bf16_t*)(p.ws + B_KVRAW) + (size_t)b * S * 1024 + h * 128 + 64;
    bf16_t* O = (bf16_t*)(p.ws + B_ORAW) + (size_t)b * S * 512 + h * 64;
    const int tid = threadIdx.x, lane = tid & 63, wid = tid >> 6, fr = lane & 15, fq = lane >> 4;
    const int q0 = qb * 256, qw0 = q0 + wid * 32;
    bf16x8 qf[2][3];
#pragma unroll
    for (int nq = 0; nq < 2; ++nq)
#pragma unroll
        for (int ks = 0; ks < 3; ++ks) qf[nq][ks] = *(const bf16x8*)(Q + (size_t)(qw0 + nq * 16 + fr) * 96 + ks * 32 + fq * 8);
    f32x4 oacc[4][2];
#pragma unroll
    for (int d = 0; d < 4; ++d)
#pragma unroll
        for (int nq = 0; nq < 2; ++nq) oacc[d][nq] = (f32x4){0.f, 0.f, 0.f, 0.f};
    float mrun[2] = {-1e30f, -1e30f}, lrun[2] = {0.f, 0.f};
    const int ntiles = (q0 + 256) / 64;
    for (int kt = 0; kt < ntiles; ++kt) {
        const int k0 = kt * 64;
        for (int c = tid; c < 768; c += NT) { const int r = c / 12, cc = c - r * 12; *(LAS u32x4*)(Ks + r * AKLD + cc * 8) = *(const u32x4*)(Kg + (size_t)(k0 + r) * 96 + cc * 8); }
        {
            const int key = tid & 63, dc = tid >> 6;
            const u32x4 v = *(const u32x4*)(Vg + (size_t)(k0 + key) * 1024 + dc * 8);
            LAS bf16_t* vt = Vt + (dc * 8) * AVLD + key;
            vt[0 * AVLD] = (bf16_t)(v.x & 0xffff); vt[1 * AVLD] = (bf16_t)(v.x >> 16); vt[2 * AVLD] = (bf16_t)(v.y & 0xffff); vt[3 * AVLD] = (bf16_t)(v.y >> 16);
            vt[4 * AVLD] = (bf16_t)(v.z & 0xffff); vt[5 * AVLD] = (bf16_t)(v.z >> 16); vt[6 * AVLD] = (bf16_t)(v.w & 0xffff); vt[7 * AVLD] = (bf16_t)(v.w >> 16);
        }
        __syncthreads();
        if (k0 <= qw0 + 31) {
            f32x4 sacc[4][2];
#pragma unroll
            for (int t4 = 0; t4 < 4; ++t4)
#pragma unroll
                for (int nq = 0; nq < 2; ++nq) sacc[t4][nq] = (f32x4){0.f, 0.f, 0.f, 0.f};
#pragma unroll
            for (int ks = 0; ks < 3; ++ks)
#pragma unroll
                for (int t4 = 0; t4 < 4; ++t4) {
                    const bf16x8 kf = *(const LAS bf16x8*)(Ks + (t4 * 16 + fr) * AKLD + ks * 32 + fq * 8);
#pragma unroll
                    for (int nq = 0; nq < 2; ++nq) sacc[t4][nq] = MFMA16(kf, qf[nq][ks], sacc[t4][nq]);
                }
            const bool need_mask = (k0 + 63 > qw0);
#pragma unroll
            for (int nq = 0; nq < 2; ++nq) {
                const int qidx = qw0 + nq * 16 + fr;
                float mx = -1e30f;
#pragma unroll
                for (int t4 = 0; t4 < 4; ++t4)
#pragma unroll
                    for (int i = 0; i < 4; ++i) {
                        if (need_mask) { const int key = k0 + t4 * 16 + 4 * fq + i; if (key > qidx) sacc[t4][nq][i] = -1e30f; }
                        mx = fmaxf(mx, sacc[t4][nq][i]);
                    }
                mx = fmaxf(mx, __shfl_xor(mx, 16)); mx = fmaxf(mx, __shfl_xor(mx, 32));
                const float mnew = fmaxf(mrun[nq], mx);
                const float alpha = exp2f(mrun[nq] - mnew);
                mrun[nq] = mnew;
                float ls = 0.f;
#pragma unroll
                for (int t4 = 0; t4 < 4; ++t4)
#pragma unroll
                    for (int i = 0; i < 4; ++i) { const float pv = exp2f(sacc[t4][nq][i] - mnew); sacc[t4][nq][i] = pv; ls += pv; }
                lrun[nq] = lrun[nq] * alpha + ls;
#pragma unroll
                for (int d = 0; d < 4; ++d) oacc[d][nq] = oacc[d][nq] * alpha;
            }
#pragma unroll
            for (int s2 = 0; s2 < 2; ++s2) {
                bf16x8 pb[2];
#pragma unroll
                for (int nq = 0; nq < 2; ++nq) {
                    u32x4 w; w.x = cvt_pk_bf16(sacc[2 * s2][nq].x, sacc[2 * s2][nq].y); w.y = cvt_pk_bf16(sacc[2 * s2][nq].z, sacc[2 * s2][nq].w);
                    w.z = cvt_pk_bf16(sacc[2 * s2 + 1][nq].x, sacc[2 * s2 + 1][nq].y); w.w = cvt_pk_bf16(sacc[2 * s2 + 1][nq].z, sacc[2 * s2 + 1][nq].w);
                    pb[nq] = __builtin_bit_cast(bf16x8, w);
                }
#pragma unroll
                for (int d = 0; d < 4; ++d) {
                    const LAS bf16_t* vr = Vt + (d * 16 + fr) * AVLD + s2 * 32 + 4 * fq;
                    const u32x2 lo = *(const LAS u32x2*)vr, hi = *(const LAS u32x2*)(vr + 16);
                    const bf16x8 vf = __builtin_bit_cast(bf16x8, ((u32x4){lo.x, lo.y, hi.x, hi.y}));
#pragma unroll
                    for (int nq = 0; nq < 2; ++nq) oacc[d][nq] = MFMA16(vf, pb[nq], oacc[d][nq]);
                }
            }
        }
        __syncthreads();
    }
#pragma unroll
    for (int nq = 0; nq < 2; ++nq) {
        float l = lrun[nq]; l += __shfl_xor(l, 16); l += __shfl_xor(l, 32);
        const float inv = 1.f / l;
        const int qidx = qw0 + nq * 16 + fr;
#pragma unroll
        for (int d = 0; d < 4; ++d) { const f32x4 v = oacc[d][nq] * inv; u32x2 w; w.x = cvt_pk_bf16(v.x, v.y); w.y = cvt_pk_bf16(v.z, v.w);
            *(u32x2*)(O + (size_t)qidx * 512 + d * 16 + 4 * fq) = w; }
    }
}

constexpr int MTLD = 72;
__device__ __forceinline__ void mlstm_a_unit(const Params& p, LAS unsigned char* lds, int unit) {
    LAS bf16_t* kT = (LAS bf16_t*)lds;
    LAS bf16_t* vT = kT + 128 * MTLD;
    LAS float* av = (LAS float*)(vT + 128 * MTLD);
    const int bh = unit >> 5, c = unit & 31, b = bh >> 2, h = bh & 3;
    const int t0 = b * S + c * CHUNK;
    const float* gl = (const float*)(p.ws + B_GL);
    const bf16_t* mk = (const bf16_t*)(p.ws + B_MK); const bf16_t* proj = (const bf16_t*)(p.ws + B_PROJ);
    const int tid = threadIdx.x, lane = tid & 63, wid = tid >> 6, fr = lane & 15, fq = lane >> 4;
    if (wid == 0) {
        const float li = gl[(size_t)(t0 + lane) * 8 + h], lf = gl[(size_t)(t0 + lane) * 8 + 4 + h];
        float bs = lf;
#pragma unroll
        for (int o = 1; o < 64; o <<= 1) { const float t = __shfl_up(bs, o); if (lane >= o) bs += t; }
        const float Btot = __shfl(bs, 63);
        const float g = Btot - bs + li;
        const float ml = wave_max(g);
        av[lane] = __expf(g - ml);
        if (lane == 0) { ((float*)(p.ws + WS_BC))[unit] = Btot; ((float*)(p.ws + WS_MLOC))[unit] = ml; }
    }
    __syncthreads();
#pragma unroll
    for (int rep = 0; rep < 2; ++rep) {
        const int cidx = tid + rep * NT, s = cidx & 63, ch = cidx >> 6;
        const u32x4 kv = *(const u32x4*)(mk + (size_t)(t0 + s) * MINNER + h * DM + ch * 8);
        const u32x4 vv = *(const u32x4*)(proj + (size_t)(t0 + s) * IN_DIM + OFF_MV + h * DM + ch * 8);
        const float a = av[s];
        LAS bf16_t* kt = kT + (ch * 8) * MTLD + s; LAS bf16_t* vt = vT + (ch * 8) * MTLD + s;
        const unsigned kk[4] = {kv.x, kv.y, kv.z, kv.w}; const unsigned vw[4] = {vv.x, vv.y, vv.z, vv.w};
#pragma unroll
        for (int j = 0; j < 4; ++j) {
            kt[(2 * j) * MTLD] = (bf16_t)(kk[j] & 0xffff); kt[(2 * j + 1) * MTLD] = (bf16_t)(kk[j] >> 16);
            const unsigned sc = cvt_pk_bf16(bflo(vw[j]) * a, bfhi(vw[j]) * a);
            vt[(2 * j) * MTLD] = (bf16_t)(sc & 0xffff); vt[(2 * j + 1) * MTLD] = (bf16_t)(sc >> 16);
        }
    }
    __syncthreads();
    {
        const int we = wid >> 1, wd = wid & 1;
        f32x4 acc[2][4];
#pragma unroll
        for (int i = 0; i < 2; ++i)
#pragma unroll
            for (int j = 0; j < 4; ++j) acc[i][j] = (f32x4){0.f, 0.f, 0.f, 0.f};
#pragma unroll
        for (int ks = 0; ks < 2; ++ks) {
            bf16x8 vf[2], kf[4];
#pragma unroll
            for (int i = 0; i < 2; ++i) vf[i] = *(const LAS bf16x8*)(vT + (we * 32 + i * 16 + fr) * MTLD + ks * 32 + fq * 8);
#pragma unroll
            for (int j = 0; j < 4; ++j) kf[j] = *(const LAS bf16x8*)(kT + (wd * 64 + j * 16 + fr) * MTLD + ks * 32 + fq * 8);
#pragma unroll
            for (int i = 0; i < 2; ++i)
#pragma unroll
                for (int j = 0; j < 4; ++j) acc[i][j] = MFMA16(vf[i], kf[j], acc[i][j]);
        }
        float* dC = (float*)(p.ws + B_DC) + (size_t)unit * 16384;
#pragma unroll
        for (int i = 0; i < 2; ++i)
#pragma unroll
            for (int j = 0; j < 4; ++j)
#pragma unroll
                for (int r = 0; r < 4; ++r) dC[(we * 32 + i * 16 + 4 * fq + r) * 128 + wd * 64 + j * 16 + fr] = acc[i][j][r];
    }
    if (tid < 128) {
        float s = 0.f;
        for (int q = 0; q < 64; ++q) s += bf2f(kT[tid * MTLD + q]) * av[q];
        ((float*)(p.ws + WS_DN))[(size_t)unit * 128 + tid] = s;
    }
    __syncthreads();
}

__device__ __forceinline__ void mlstm_scan(const Params& p, int gtid, int ngt) {
    const float* Bc = (const float*)(p.ws + WS_BC); const float* ML = (const float*)(p.ws + WS_MLOC);
    float* mprev = (float*)(p.ws + WS_MPREV);
    const float* dC = (const float*)(p.ws + B_DC); bf16_t* Cp = (bf16_t*)(p.ws + B_CPREV);
    const float* dn = (const float*)(p.ws + WS_DN); float* np_ = (float*)(p.ws + WS_NPREV);
    constexpr int PER = 4096 + 32;
    for (int idx = gtid; idx < 32 * PER; idx += ngt) {
        const int bh = idx / PER, e4 = idx - bh * PER;
        float m = 0.f; f32x4 C = (f32x4){0.f, 0.f, 0.f, 0.f};
        for (int c = 0; c < NCH; ++c) {
            const int unit = bh * NCH + c;
            const float Bt = Bc[unit], ml = ML[unit];
            const float mnew = fmaxf(Bt + m, ml);
            const float fa = __expf(Bt + m - mnew), fb = __expf(ml - mnew);
            if (e4 < 4096) {
                u32x2 w; w.x = cvt_pk_bf16(C.x, C.y); w.y = cvt_pk_bf16(C.z, C.w);
                *(u32x2*)(Cp + (size_t)unit * 16384 + e4 * 4) = w;
                const f32x4 d = *(const f32x4*)(dC + (size_t)unit * 16384 + e4 * 4);
                C = C * fa + d * fb;
                if (e4 == 0) mprev[unit] = m;
            } else {
                const int n4 = e4 - 4096;
                *(f32x4*)(np_ + (size_t)unit * 128 + n4 * 4) = C;
                const f32x4 d = *(const f32x4*)(dn + (size_t)unit * 128 + n4 * 4);
                C = C * fa + d * fb;
            }
            m = mnew;
        }
    }
}

constexpr int MRLD = 136;
__device__ __forceinline__ void mlstm_c_unit(const Params& p, LAS unsigned char* lds, int unit) {
    LAS bf16_t* qs = (LAS bf16_t*)lds;
    LAS bf16_t* ks = qs + 64 * MRLD;
    LAS bf16_t* cs = ks + 64 * MRLD;
    LAS bf16_t* vT = cs + 128 * MRLD;
    LAS float* fv = (LAS float*)(vT + 128 * MTLD);
    LAS float* u_s = fv; LAS float* c_t = fv + 64; LAS float* dec = fv + 128; LAS float* emt = fv + 192; LAS float* ssq = fv + 256;
    const int bh = unit >> 5, c = unit & 31, b = bh >> 2, h = bh & 3;
    const int t0 = b * S + c * CHUNK;
    const float* gl = (const float*)(p.ws + B_GL);
    const bf16_t* mq = (const bf16_t*)(p.ws + B_MQ); const bf16_t* mk = (const bf16_t*)(p.ws + B_MK); const bf16_t* proj = (const bf16_t*)(p.ws + B_PROJ);
    const bf16_t* Cp = (const bf16_t*)(p.ws + B_CPREV) + (size_t)unit * 16384;
    const float* np_ = (const float*)(p.ws + WS_NPREV) + (size_t)unit * 128;
    const int tid = threadIdx.x, lane = tid & 63, wid = tid >> 6, fr = lane & 15, fq = lane >> 4;
    if (wid == 0) {
        const float li = gl[(size_t)(t0 + lane) * 8 + h], lf = gl[(size_t)(t0 + lane) * 8 + 4 + h];
        const float mp = ((const float*)(p.ws + WS_MPREV))[unit];
        float bs = lf;
#pragma unroll
        for (int o = 1; o < 64; o <<= 1) { const float t = __shfl_up(bs, o); if (lane >= o) bs += t; }
        const float u = li - bs;
        float pm = u;
#pragma unroll
        for (int o = 1; o < 64; o <<= 1) { const float t = __shfl_up(pm, o); if (lane >= o) pm = fmaxf(pm, t); }
        const float inter = bs + mp;
        const float mt = fmaxf(inter, bs + pm);
        u_s[lane] = u; c_t[lane] = bs - mt; dec[lane] = __expf(inter - mt); emt[lane] = __expf(-mt);
    }
#pragma unroll
    for (int rep = 0; rep < 2; ++rep) {
        const int cidx = tid + rep * NT, r = cidx >> 4, ch = cidx & 15;
        *(LAS u32x4*)(qs + r * MRLD + ch * 8) = *(const u32x4*)(mq + (size_t)(t0 + r) * MINNER + h * DM + ch * 8);
        *(LAS u32x4*)(ks + r * MRLD + ch * 8) = *(const u32x4*)(mk + (size_t)(t0 + r) * MINNER + h * DM + ch * 8);
    }
#pragma unroll
    for (int rep = 0; rep < 4; ++rep) {
        const int cidx = tid + rep * NT, r = cidx >> 4, ch = cidx & 15;
        *(LAS u32x4*)(cs + r * MRLD + ch * 8) = *(const u32x4*)(Cp + r * 128 + ch * 8);
    }
#pragma unroll
    for (int rep = 0; rep < 2; ++rep) {
        const int cidx = tid + rep * NT, s = cidx & 63, ch = cidx >> 6;
        const u32x4 vv = *(const u32x4*)(proj + (size_t)(t0 + s) * IN_DIM + OFF_MV + h * DM + ch * 8);
        LAS bf16_t* vt = vT + (ch * 8) * MTLD + s;
        const unsigned vw[4] = {vv.x, vv.y, vv.z, vv.w};
#pragma unroll
        for (int j = 0; j < 4; ++j) { vt[(2 * j) * MTLD] = (bf16_t)(vw[j] & 0xffff); vt[(2 * j + 1) * MTLD] = (bf16_t)(vw[j] >> 16); }
    }
    __syncthreads();
    const int tt = wid & 3, eh = wid >> 2;
    const int tl = tt * 16 + fr;
    bf16x8 qf[4];
#pragma unroll
    for (int k4 = 0; k4 < 4; ++k4) qf[k4] = *(const LAS bf16x8*)(qs + tl * MRLD + k4 * 32 + fq * 8);
    f32x4 sacc[4];
#pragma unroll
    for (int st = 0; st < 4; ++st) sacc[st] = (f32x4){0.f, 0.f, 0.f, 0.f};
#pragma unroll
    for (int k4 = 0; k4 < 4; ++k4)
#pragma unroll
        for (int st = 0; st < 4; ++st) {
            const bf16x8 kf = *(const LAS bf16x8*)(ks + (st * 16 + fr) * MRLD + k4 * 32 + fq * 8);
            sacc[st] = MFMA16(kf, qf[k4], sacc[st]);
        }
    const float ct = c_t[tl];
    float rs = 0.f;
#pragma unroll
    for (int st = 0; st < 4; ++st)
#pragma unroll
        for (int i = 0; i < 4; ++i) {
            const int s = st * 16 + 4 * fq + i;
            const float w = (s <= tl) ? __expf(ct + u_s[s]) * sacc[st][i] : 0.f;
            sacc[st][i] = w; rs += w;
        }
    rs += __shfl_xor(rs, 16); rs += __shfl_xor(rs, 32);
    float nq;
    {
        f32x4 na = (f32x4){0.f, 0.f, 0.f, 0.f};
#pragma unroll
        for (int k4 = 0; k4 < 4; ++k4) {
            u32x4 w = (u32x4){0u, 0u, 0u, 0u};
            if (fr == 0) { const float* nn = np_ + k4 * 32 + fq * 8; w.x = cvt_pk_bf16(nn[0], nn[1]); w.y = cvt_pk_bf16(nn[2], nn[3]); w.z = cvt_pk_bf16(nn[4], nn[5]); w.w = cvt_pk_bf16(nn[6], nn[7]); }
            na = MFMA16(__builtin_bit_cast(bf16x8, w), qf[k4], na);
        }
        nq = __shfl(na.x, fr);
    }
    f32x4 acc[4];
#pragma unroll
    for (int et = 0; et < 4; ++et) acc[et] = (f32x4){0.f, 0.f, 0.f, 0.f};
#pragma unroll
    for (int k4 = 0; k4 < 4; ++k4)
#pragma unroll
        for (int et = 0; et < 4; ++et) {
            const bf16x8 cf = *(const LAS bf16x8*)(cs + (eh * 64 + et * 16 + fr) * MRLD + k4 * 32 + fq * 8);
            acc[et] = MFMA16(cf, qf[k4], acc[et]);
        }
    const float dcy = dec[tl];
#pragma unroll
    for (int et = 0; et < 4; ++et) acc[et] = acc[et] * dcy;
#pragma unroll
    for (int s2 = 0; s2 < 2; ++s2) {
        u32x4 w; w.x = cvt_pk_bf16(sacc[2 * s2].x, sacc[2 * s2].y); w.y = cvt_pk_bf16(sacc[2 * s2].z, sacc[2 * s2].w);
        w.z = cvt_pk_bf16(sacc[2 * s2 + 1].x, sacc[2 * s2 + 1].y); w.w = cvt_pk_bf16(sacc[2 * s2 + 1].z, sacc[2 * s2 + 1].w);
        const bf16x8 pb = __builtin_bit_cast(bf16x8, w);
#pragma unroll
        for (int et = 0; et < 4; ++et) {
            const LAS bf16_t* vr = vT + (eh * 64 + et * 16 + fr) * MTLD + s2 * 32 + 4 * fq;
            const u32x2 lo = *(const LAS u32x2*)vr, hi = *(const LAS u32x2*)(vr + 16);
            acc[et] = MFMA16(__builtin_bit_cast(bf16x8, ((u32x4){lo.x, lo.y, hi.x, hi.y})), pb, acc[et]);
        }
    }
    const float den = dcy * nq + rs;
    const float hd = 1.f / fmaxf(fabsf(den), emt[tl]);
    float sq = 0.f;
#pragma unroll
    for (int et = 0; et < 4; ++et) { acc[et] = acc[et] * hd; sq += acc[et].x * acc[et].x + acc[et].y * acc[et].y + acc[et].z * acc[et].z + acc[et].w * acc[et].w; }
    sq += __shfl_xor(sq, 16); sq += __shfl_xor(sq, 32);
    if (fq == 0) ssq[eh * 64 + tl] = sq;
    __syncthreads();
    const float rinv = rsqrtf((ssq[tl] + ssq[64 + tl]) * (1.f / 128.f) + RMS_EPS);
    const float* gmo = p.in[20] + h * DM;
    bf16_t* ao = (bf16_t*)(p.ws + B_AO);
#pragma unroll
    for (int et = 0; et < 4; ++et) {
        const int e = eh * 64 + et * 16 + 4 * fq;
        const u32x2 op = *(const u32x2*)(proj + (size_t)(t0 + tl) * IN_DIM + OFF_MO + h * DM + e);
        const f32x4 g = *(const f32x4*)(gmo + e);
        const f32x4 v = acc[et] * rinv * g;
        u32x2 w; w.x = cvt_pk_bf16(v.x * sigmoidf_(bflo(op.x)), v.y * sigmoidf_(bfhi(op.x))); w.y = cvt_pk_bf16(v.z * sigmoidf_(bflo(op.y)), v.w * sigmoidf_(bfhi(op.y)));
        *(u32x2*)(ao + (size_t)(t0 + tl) * 1024 + 512 + h * DM + e) = w;
    }
    __syncthreads();
}

__device__ __forceinline__ void route_rows(const Params& p, int gw, int ngw, int lane) {
    const float* logits = (const float*)(p.ws + C_LOGITS); const float* rb = p.in[24];
    int* cnt = (int*)(p.ws + WS_CTL);
    int* tok_e = (int*)(p.ws + C_TOKE); float* tok_w = (float*)(p.ws + C_TOKW); int* tok_pos = (int*)(p.ws + C_TOKPOS);
    int* list_tok = (int*)(p.ws + C_LISTTOK); float* list_w = (float*)(p.ws + C_LISTW);
    const f32x4 bias = *(const f32x4*)(rb + lane * 4);
    const float NEG = -__builtin_inff();
    for (int row = gw; row < T; row += ngw) {
        const f32x4 lg = *(const f32x4*)(logits + (size_t)row * 256 + lane * 4);
        float sc[4] = {sigmoidf_(lg.x), sigmoidf_(lg.y), sigmoidf_(lg.z), sigmoidf_(lg.w)};
        float sb[4] = {sc[0] + bias.x, sc[1] + bias.y, sc[2] + bias.z, sc[3] + bias.w};
        float t1 = fmaxf(fmaxf(sb[0], sb[1]), fmaxf(sb[2], sb[3]));
        float t2;
        {
            const float a = fmaxf(sb[0], sb[1]), bmin = fminf(sb[0], sb[1]), c2 = fmaxf(sb[2], sb[3]), dmin = fminf(sb[2], sb[3]);
            t2 = fmaxf(fminf(a, c2), fmaxf(bmin, dmin));
        }
#pragma unroll
        for (int o = 1; o < 8; o <<= 1) {
            const float o1 = __shfl_xor(t1, o), o2 = __shfl_xor(t2, o);
            const float n1 = fmaxf(t1, o1), n2 = fmaxf(fminf(t1, o1), fmaxf(t2, o2));
            t1 = n1; t2 = n2;
        }
        const float gs = t1 + t2;
        const int myg = lane >> 3;
        int rank = 0;
#pragma unroll
        for (int g = 0; g < 8; ++g) { const float og = __shfl(gs, g * 8); rank += (og > gs || (og == gs && g < myg)) ? 1 : 0; }
        const bool keep = rank < 4;
        float cand[4];
#pragma unroll
        for (int j = 0; j < 4; ++j) cand[j] = keep ? sb[j] : NEG;
        float wsum = 0.f; float myw = 0.f; int mye = 0;
#pragma unroll
        for (int k = 0; k < TOPK; ++k) {
            float bv = cand[0]; int bi = 0;
#pragma unroll
            for (int j = 1; j < 4; ++j) if (cand[j] > bv) { bv = cand[j]; bi = j; }
            int gi = lane * 4 + bi; float gv = bv;
#pragma unroll
            for (int o = 1; o < 64; o <<= 1) {
                const float ov = __shfl_xor(gv, o); const int oi = __shfl_xor(gi, o);
                if (ov > gv || (ov == gv && oi < gi)) { gv = ov; gi = oi; }
            }
            const int wl = gi >> 2, wj = gi & 3;
            const float sj = (wj == 0) ? sc[0] : (wj == 1) ? sc[1] : (wj == 2) ? sc[2] : sc[3];
            const float sraw = __shfl(sj, wl);
            wsum += sraw;
            if (lane == k) { myw = sraw; mye = gi; }
            if (lane == wl) {
#pragma unroll
                for (int j = 0; j < 4; ++j) if (j == wj) cand[j] = NEG;
            }
        }
        if (lane < TOPK) {
            const float w = myw / wsum * 2.5f;
            const int pos = atomicAdd(&cnt[mye], 1);
            tok_e[(size_t)row * 8 + lane] = mye; tok_w[(size_t)row * 8 + lane] = w; tok_pos[(size_t)row * 8 + lane] = pos;
            list_tok[(size_t)mye * CAP + pos] = row; list_w[(size_t)mye * CAP + pos] = w;
        }
    }
}

__device__ __forceinline__ void expert_prefix(const Params& p, LAS int* base, LAS int* tstart, int tid) {
    const int* cnt = (const int*)(p.ws + WS_CTL);
    if (tid < 64) {
        int c[4], tl[4]; int s = 0, ts = 0;
#pragma unroll
        for (int j = 0; j < 4; ++j) { c[j] = __hip_atomic_load(cnt + tid * 4 + j, __ATOMIC_RELAXED, __HIP_MEMORY_SCOPE_AGENT); tl[j] = (c[j] + 255) >> 8; s += c[j]; ts += tl[j]; }
        int ps = s, pt = ts;
#pragma unroll
        for (int o = 1; o < 64; o <<= 1) { const int a = __shfl_up(ps, o), bb = __shfl_up(pt, o); if (tid >= o) { ps += a; pt += bb; } }
        int es = ps - s, et = pt - ts;
#pragma unroll
        for (int j = 0; j < 4; ++j) { base[tid * 4 + j] = es; tstart[tid * 4 + j] = et; es += c[j]; et += tl[j]; }
        if (tid == 63) tstart[256] = pt;
    }
    __syncthreads();
}

__device__ __forceinline__ void combine_rows(const Params& p, LAS int* base, int gw, int ngw, int lane) {
    const bf16_t* sh = (const bf16_t*)(p.ws + C_SHOUT); const bf16_t* y = (const bf16_t*)(p.ws + C_Y);
    const int* tok_e = (const int*)(p.ws + C_TOKE); const int* tok_pos = (const int*)(p.ws + C_TOKPOS);
    const float* ada = (const float*)(p.ws + WS_ADA);
    for (int row = gw; row < T; row += ngw) {
        const int b = row / S;
        float acc[2][8];
#pragma unroll
        for (int hf = 0; hf < 2; ++hf) {
            const u32x4 a = *(const u32x4*)(sh + (size_t)row * 1024 + hf * 512 + lane * 8);
            acc[hf][0] = bflo(a.x); acc[hf][1] = bfhi(a.x); acc[hf][2] = bflo(a.y); acc[hf][3] = bfhi(a.y); acc[hf][4] = bflo(a.z); acc[hf][5] = bfhi(a.z); acc[hf][6] = bflo(a.w); acc[hf][7] = bfhi(a.w);
        }
#pragma unroll
        for (int k = 0; k < TOPK; ++k) {
            const int e = tok_e[(size_t)row * 8 + k], pos = tok_pos[(size_t)row * 8 + k];
            const size_t slot = (size_t)(base[e] + pos);
#pragma unroll
            for (int hf = 0; hf < 2; ++hf) {
                const u32x4 a = *(const u32x4*)(y + slot * 1024 + hf * 512 + lane * 8);
                acc[hf][0] += bflo(a.x); acc[hf][1] += bfhi(a.x); acc[hf][2] += bflo(a.y); acc[hf][3] += bfhi(a.y); acc[hf][4] += bflo(a.z); acc[hf][5] += bfhi(a.z); acc[hf][6] += bflo(a.w); acc[hf][7] += bfhi(a.w);
            }
        }
#pragma unroll
        for (int hf = 0; hf < 2; ++hf) {
            const int col = hf * 512 + lane * 8;
            float* o = p.out + (size_t)row * D + col;
            const float* g = ada + b * 6144 + 5120 + col;
#pragma unroll
            for (int q4 = 0; q4 < 2; ++q4) {
                const f32x4 x = *(const f32x4*)(o + q4 * 4), gg = *(const f32x4*)(g + q4 * 4);
                f32x4 r; r.x = x.x + gg.x * acc[hf][q4 * 4 + 0]; r.y = x.y + gg.y * acc[hf][q4 * 4 + 1]; r.z = x.z + gg.z * acc[hf][q4 * 4 + 2]; r.w = x.w + gg.w * acc[hf][q4 * 4 + 3];
                *(f32x4*)(o + q4 * 4) = r;
            }
        }
    }
}

__global__ void __launch_bounds__(NT) fwd_kernel(Params p) {
    extern __shared__ __attribute__((aligned(16))) unsigned char lds_raw[];
    LAS unsigned char* lds = (LAS unsigned char*)lds_raw;
    cg::grid_group grid = cg::this_grid();
    const int tid = threadIdx.x, lane = tid & 63, wid = tid >> 6;
    const int G = gridDim.x, bid = blockIdx.x;
    const int gw = bid * NWAVES + wid, ngw = G * NWAVES;
    unsigned char* ws = p.ws;
    const float* ada = (const float*)(ws + WS_ADA);
    volatile LAS unsigned* bst = (volatile LAS unsigned*)(lds + LDS_BYTES - 64);
    if (tid < 2) bst[tid] = 0u;
    __syncthreads();
    const XcdBarrier xbar = xcd_barrier_post((unsigned*)(ws + WS_CTL + 4096), bst);
    int ts_n = 0;
#if DBG_STAGE == 2
#define TSTAMP() do { if (bid == 0 && tid == 0) ((unsigned long long*)(ws + WS_CTL + 16384 + 8192))[ts_n] = __builtin_amdgcn_s_memrealtime(); ++ts_n; } while (0)
#else
#define TSTAMP() do { } while (0)
#endif
    grid.sync();
    TSTAMP();

    for (int u = bid; u < 96; u += G) ada_unit(p, lds, u, tid);
    xcd_barrier(xbar); TSTAMP();
    norm_mod_rows(p.in[0], p.in[5], ada, 0, 1024, (bf16_t*)(ws + B_H1), gw, ngw, lane);
    xcd_barrier(xbar); TSTAMP();
    {
        const RowDense RP{(const bf16_t*)(ws + B_H1), D};
        const ColDense CP{p.in[6], IN_DIM};
        const EpiProj E{(bf16_t*)(ws + B_PROJ), (float*)(ws + B_GRAW)};
        constexpr int NTN = (IN_DIM + 127) / 128;
        for (int u = bid; u < (T / 256) * NTN; u += G) { const int tm = u / NTN, tn = u - tm * NTN; gemm2_tile(lds, RP, CP, IN_DIM, 1024, tm * 256, tn * 128, E); }
    }
    xcd_barrier(xbar); TSTAMP();
    post_proj_rows(p, gw, ngw, lane);
    xcd_barrier(xbar); TSTAMP();
    {
        constexpr int U2 = (T / 256) * 6, U3 = (T / 256) * 8, U4 = (T / 256) * 2 * 4;
        for (int u = bid; u < U2 + U3 + U4; u += G) {
            if (u < U2) { const int tm = u / 6, tn = u % 6; const RowDense RP{(const bf16_t*)(ws + B_CQN), QLORA}; const ColDense CP{p.in[8], 768}; const EpiBf16 E{(bf16_t*)(ws + B_QRAW), 768};
                gemm2_tile(lds, RP, CP, 768, QLORA, tm * 256, tn * 128, E); }
            else if (u < U2 + U3) { const int v = u - U2, tm = v / 8, tn = v % 8; const RowDense RP{(const bf16_t*)(ws + B_CKVN), KVLORA}; const ColDense CP{p.in[10], 1024}; const EpiBf16 E{(bf16_t*)(ws + B_KVRAW), 1024};
                gemm2_tile(lds, RP, CP, 1024, KVLORA, tm * 256, tn * 128, E); }
            else { const int v = u - U2 - U3, tm = v / 8, r = v % 8, h = r >> 1, tn = r & 1; const RowDense RP{(const bf16_t*)(ws + B_ZC) + h * DM, MINNER};
                const ColMqk CP{p.in[16] + (size_t)h * DM * DM, (p.in[17] + (size_t)h * DM * DM) - (p.in[16] + (size_t)h * DM * DM)};
                const EpiMqk E{(bf16_t*)(ws + B_MQ), (bf16_t*)(ws + B_MK), h};
                gemm2_tile(lds, RP, CP, DM, DM, tm * 256, tn * 128, E); }
        }
    }
    xcd_barrier(xbar); TSTAMP();
    qk_post_rows(p, gw, ngw, lane);
    xcd_barrier(xbar); TSTAMP();
    for (int pr = bid; pr < 256; pr += G) { const int bh = pr & 63, j = pr >> 6; attn_unit(p, lds, bh, 7 - j); attn_unit(p, lds, bh, j); }
    for (int u = bid; u < 1024; u += G) mlstm_a_unit(p, lds, u);
    xcd_barrier(xbar); TSTAMP();
    mlstm_scan(p, bid * NT + tid, G * NT);
    attn_out_norm_rows(p, gw, ngw, lane);
    xcd_barrier(xbar); TSTAMP();
    for (int u = bid; u < 1024; u += G) mlstm_c_unit(p, lds, u);
    xcd_barrier(xbar); TSTAMP();
    {
        const RowDense RP{(const bf16_t*)(ws + B_AO), 1024};
        const ColDense CP{p.in[21], 1024};
        const EpiResid E{p.in[0], ada, 2048, p.out};
        for (int u = bid; u < (T / 256) * 8; u += G) { const int tm = u >> 3, tn = u & 7; gemm2_tile(lds, RP, CP, 1024, 1024, tm * 256, tn * 128, E); }
    }
    xcd_barrier(xbar); TSTAMP();
    norm_mod_rows(p.out, p.in[22], ada, 3072, 4096, (bf16_t*)(ws + C_H2), gw, ngw, lane);
    xcd_barrier(xbar); TSTAMP();
    {
        const RowDense RP{(const bf16_t*)(ws + C_H2), 1024};
        const ColRgu CP{p.in[23], p.in[28] - p.in[23], p.in[29] - p.in[23]};
        const EpiRgu E{(float*)(ws + C_LOGITS), (bf16_t*)(ws + C_ACTSH)};
        for (int u = bid; u < (T / 256) * 6; u += G) { const int tm = u / 6, tn = u % 6; gemm2_tile(lds, RP, CP, 256, 1024, tm * 256, tn * 128, E); }
    }
    xcd_barrier(xbar); TSTAMP();
    route_rows(p, gw, ngw, lane);
    {
        const RowDense RP{(const bf16_t*)(ws + C_ACTSH), 256};
        const ColDense CP{p.in[30], 1024};
        const EpiBf16 E{(bf16_t*)(ws + C_SHOUT), 1024};
        for (int u = bid; u < (T / 256) * 8; u += G) { const int tm = u >> 3, tn = u & 7; gemm2_tile(lds, RP, CP, 1024, 256, tm * 256, tn * 128, E); }
    }
    xcd_barrier(xbar); TSTAMP();
    LAS int* base = (LAS int*)(lds + 120 * 1024);
    LAS int* tstart = base + 256;
    expert_prefix(p, base, tstart, tid);
    {
        const int* cnt = (const int*)(ws + WS_CTL);
        const int ntile = tstart[256];
        for (int u = bid; u < ntile * 4; u += G) {
            const int tg = u >> 2, tn = u & 3;
            int lo = 0, hi = 255;
            while (lo < hi) { const int mid = (lo + hi + 1) >> 1; if (tstart[mid] <= tg) lo = mid; else hi = mid - 1; }
            const int e = lo, blk = tg - tstart[e], c = __hip_atomic_load(cnt + e, __ATOMIC_RELAXED, __HIP_MEMORY_SCOPE_AGENT);
            const int nvalid = min(256, c - blk * 256);
            const RowGather RP{(const bf16_t*)(ws + C_H2), (const int*)(ws + C_LISTTOK) + (size_t)e * CAP + blk * 256, nvalid};
            const ColGU CP{p.in[25] + (size_t)e * 1024 * 256, p.in[26] - p.in[25]};
            const EpiExpAct E{(bf16_t*)(ws + C_ACTE), base[e] + blk * 256, nvalid};
            gemm2_tile(lds, RP, CP, 256, 1024, 0, tn * 128, E);
        }
    }
    xcd_barrier(xbar); TSTAMP();
    {
        const int* cnt = (const int*)(ws + WS_CTL);
        const int ntile = tstart[256];
        for (int u = bid; u < ntile * 8; u += G) {
            const int tg = u >> 3, tn = u & 7;
            int lo = 0, hi = 255;
            while (lo < hi) { const int mid = (lo + hi + 1) >> 1; if (tstart[mid] <= tg) lo = mid; else hi = mid - 1; }
            const int e = lo, blk = tg - tstart[e], c = __hip_atomic_load(cnt + e, __ATOMIC_RELAXED, __HIP_MEMORY_SCOPE_AGENT);
            const int nvalid = min(256, c - blk * 256);
            const int slot0 = base[e] + blk * 256;
            const RowSlots RP{(const bf16_t*)(ws + C_ACTE) + (size_t)slot0 * EDIM, nvalid};
            const ColDense CP{p.in[27] + (size_t)e * 256 * 1024, 1024};
            const EpiExpDown E{(bf16_t*)(ws + C_Y), (const float*)(ws + C_LISTW) + (size_t)e * CAP + blk * 256, slot0, nvalid};
            gemm2_tile(lds, RP, CP, 1024, 256, 0, tn * 128, E);
        }
    }
    xcd_barrier(xbar); TSTAMP();
    combine_rows(p, base, gw, ngw, lane);
#if DBG_STAGE == 2
    xcd_barrier(xbar); TSTAMP();
    xcd_barrier(xbar);
    {
        const unsigned long long* ts = (const unsigned long long*)(ws + WS_CTL + 16384 + 8192);
        const float A = (float)(long long)(ts[TS_A1] - ts[TS_A0]) * 0.01f, Bv = (float)(long long)(ts[TS_B1] - ts[TS_B0]) * 0.01f;
        for (size_t i = (size_t)bid * NT + tid; i < (size_t)T * D / 4; i += (size_t)G * NT) ((f32x4*)p.out)[i] = (f32x4){A, A, A, A};
        asm volatile("s_waitcnt vmcnt(0)" ::: "memory");
        if (bid == 0 && tid == 0) p.out[0] = 100.f * Bv;
    }
#endif
}

extern "C" void kernel_launch(void* const* d_in, const int* in_sizes, int n_in,
                              void* d_out, int out_size, void* d_ws, size_t ws_size,
                              hipStream_t stream) {
    static int grid_blocks = 0;
    if (!grid_blocks) {
        if (n_in != 31 || out_size != T * D || ws_size < WS_END) { fprintf(stderr, "kernel_launch: unexpected shapes n_in=%d out=%d ws=%zu (need %zu)\n", n_in, out_size, ws_size, (size_t)WS_END); grid_blocks = -1; return; }
        int dev = 0, cus = 0, per_cu = 0;
        (void)hipGetDevice(&dev);
        (void)hipDeviceGetAttribute(&cus, hipDeviceAttributeMultiprocessorCount, dev);
        (void)hipFuncSetAttribute((const void*)fwd_kernel, hipFuncAttributeMaxDynamicSharedMemorySize, LDS_BYTES);
        (void)hipOccupancyMaxActiveBlocksPerMultiprocessor(&per_cu, (const void*)fwd_kernel, NT, LDS_BYTES);
        if (per_cu < 1) per_cu = 1;
        grid_blocks = cus * per_cu;
        fprintf(stderr, "kernel_launch: cus=%d per_cu=%d grid=%d ws=%zu\n", cus, per_cu, grid_blocks, ws_size);
    }
    if (grid_blocks < 0) return;
    (void)hipMemsetAsync((char*)d_ws + WS_CTL, 0, CTL_BYTES, stream);
    Params p{};
    for (int i = 0; i < 31; ++i) p.in[i] = (const float*)d_in[i];
    p.out = (float*)d_out; p.ws = (unsigned char*)d_ws;
    void* args[] = {&p};
    hipError_t e = hipLaunchCooperativeKernel((const void*)fwd_kernel, dim3(grid_blocks), dim3(NT), args, LDS_BYTES, stream);
    if (e != hipSuccess) fprintf(stderr, "cooperative launch failed: %s (grid %d)\n", hipGetErrorString(e), grid_blocks);
}
```

```cpp
#include <hip/hip_runtime.h>
#include <hip/hip_cooperative_groups.h>
#include <cstdio>
#include <cstdint>
namespace cg = cooperative_groups;
#ifndef DBG_STAGE
#define DBG_STAGE 0
#endif
#define TS_A0 3
#define TS_A1 4
#define TS_B0 2
#define TS_B1 3

#define LAS __attribute__((address_space(3)))
typedef unsigned short bf16_t;
typedef short bf16x8 __attribute__((ext_vector_type(8)));
typedef short bf16x4 __attribute__((ext_vector_type(4)));
typedef float f32x4 __attribute__((ext_vector_type(4)));
typedef float f32x2 __attribute__((ext_vector_type(2)));
typedef unsigned u32x4 __attribute__((ext_vector_type(4)));
typedef unsigned u32x2 __attribute__((ext_vector_type(2)));

constexpr int NT = 512, NWAVES = 8;
constexpr int LDS_BYTES = 128 * 1024;
constexpr int Bsz = 8, S = 2048, D = 1024, T = Bsz * S;
constexpr int H_MLA = 8, DQK = 96, DNOPE = 64, DROPE = 32, DV = 64, QLORA = 384, KVLORA = 256;
constexpr int H_ML = 4, DM = 128, MINNER = 512, CHUNK = 64, NCH = S / CHUNK;
constexpr int IN_DIM = 2216;
constexpr int OFF_CQ = 0, OFF_CKV = 384, OFF_KR = 640, OFF_Z = 672, OFF_MV = 1184, OFF_MO = 1696, OFF_GATE = 2208;
constexpr int NE = 256, TOPK = 8, EDIM = 256, SDIM = 256;
constexpr int CAP = T;
constexpr float RMS_EPS = 1e-6f;

constexpr size_t MiB = 1u << 20;
constexpr size_t WS_CTL = 0;
constexpr size_t CTL_BYTES = 32768;
constexpr size_t WS_ADA = 1 * MiB;
constexpr size_t WS_BC = 2 * MiB;
constexpr size_t WS_MLOC = WS_BC + 8192;
constexpr size_t WS_MPREV = WS_BC + 16384;
constexpr size_t WS_DN = 2 * MiB + 512 * 1024;
constexpr size_t WS_NPREV = 3 * MiB;
constexpr size_t WS_WIN = 4 * MiB;
constexpr size_t WS_WUQ = 9 * MiB;
constexpr size_t WS_WUKV = 10 * MiB;
constexpr size_t WS_WMQK = 11 * MiB;
constexpr size_t WS_WOUT = 12 * MiB;
constexpr size_t WS_WRGU = 14 * MiB;
constexpr size_t WS_WDSH = 16 * MiB;
constexpr size_t WS_WGU = 32 * MiB;
constexpr size_t WS_WD = 288 * MiB;
constexpr size_t RB = 416 * MiB;
constexpr size_t B_PROJ = RB;
constexpr size_t B_GRAW = RB + 70 * MiB;
constexpr size_t B_GL = RB + 71 * MiB;
constexpr size_t B_H1 = RB + 72 * MiB;
constexpr size_t B_CQN = RB + 104 * MiB;
constexpr size_t B_CKVN = RB + 116 * MiB;
constexpr size_t B_ZC = RB + 124 * MiB;
constexpr size_t B_QRAW = RB + 140 * MiB;
constexpr size_t B_KVRAW = RB + 164 * MiB;
constexpr size_t B_MQ = RB + 196 * MiB;
constexpr size_t B_MK = RB + 212 * MiB;
constexpr size_t B_Q = RB + 228 * MiB;
constexpr size_t B_K = RB + 252 * MiB;
constexpr size_t B_ORAW = RB + 276 * MiB;
constexpr size_t B_AO = RB + 292 * MiB;
constexpr size_t B_DC = RB + 324 * MiB;
constexpr size_t B_CPREV = RB + 388 * MiB;
constexpr size_t C_H2 = RB;
constexpr size_t C_LOGITS = RB + 32 * MiB;
constexpr size_t C_ACTSH = RB + 48 * MiB;
constexpr size_t C_SHOUT = RB + 56 * MiB;
constexpr size_t C_TOKE = RB + 88 * MiB;
constexpr size_t C_TOKW = RB + 89 * MiB;
constexpr size_t C_TOKPOS = RB + 90 * MiB;
constexpr size_t C_LISTTOK = RB + 92 * MiB;
constexpr size_t C_LISTW = RB + 108 * MiB;
constexpr size_t C_ACTE = RB + 124 * MiB;
constexpr size_t C_Y = RB + 188 * MiB;
constexpr size_t WS_END = RB + 444 * MiB;

struct Params {
    const float* in[31];
    float* out;
    unsigned char* ws;
};

typedef __bf16 bf16x2v __attribute__((ext_vector_type(2)));
__device__ __forceinline__ unsigned cvt_pk_bf16(float lo, float hi) { f32x2 v = {lo, hi}; bf16x2v b = __builtin_convertvector(v, bf16x2v); return __builtin_bit_cast(unsigned, b); }
__device__ __forceinline__ float bf2f(unsigned short b) { return __uint_as_float((unsigned)b << 16); }
__device__ __forceinline__ float bflo(unsigned u) { return __uint_as_float(u << 16); }
__device__ __forceinline__ float bfhi(unsigned u) { return __uint_as_float(u & 0xffff0000u); }
__device__ __forceinline__ float wave_sum(float v) {
#pragma unroll
    for (int o = 1; o < 64; o <<= 1) v += __shfl_xor(v, o);
    return v;
}
__device__ __forceinline__ float wave_max(float v) {
#pragma unroll
    for (int o = 1; o < 64; o <<= 1) v = fmaxf(v, __shfl_xor(v, o));
    return v;
}
__device__ __forceinline__ float sigmoidf_(float x) { return 1.f / (1.f + __expf(-x)); }
__device__ __forceinline__ float siluf_(float x) { return x / (1.f + __expf(-x)); }
#define MFMA16(a, b, c) __builtin_amdgcn_mfma_f32_16x16x32_bf16((a), (b), (c), 0, 0, 0)


#define XB_TMO      128
#define XB_XCNT(j)  (256  + 64 * (j))
#define XB_XSUB(j)  (1280 + 64 * (j))
#define XB_XGEN(j)  (2304 + 64 * (j))
#define XB_TOP      3328
#define XB_TOPGEN   3392
#define XCD_BAR_WORDS 3456
#define XB_SPIN_CAP (1u << 23)
__device__ __forceinline__ unsigned xb_ld(unsigned* p)              { return __hip_atomic_load(p, __ATOMIC_RELAXED, __HIP_MEMORY_SCOPE_AGENT); }
__device__ __forceinline__ unsigned xb_add(unsigned* p, unsigned v) { return __hip_atomic_fetch_add(p, v, __ATOMIC_RELAXED, __HIP_MEMORY_SCOPE_AGENT); }
__device__ __forceinline__ unsigned xb_xcc_id() { return (unsigned)__builtin_amdgcn_s_getreg((3 << 11) | 20) & 0xFu; }
#define XB_SPIN(cond, bar) do { unsigned _sp = 0; while (cond) { __builtin_amdgcn_s_sleep(1); \
    if ((++_sp & 255u) == 0u) { if (xb_ld(&(bar)[XB_TMO])) break; if (_sp > XB_SPIN_CAP) { atomicAdd(&(bar)[XB_TMO], 1u); break; } } } } while (0)
struct XcdBarrier { unsigned* bar; unsigned x; volatile LAS unsigned* st; };
__device__ __forceinline__ XcdBarrier xcd_barrier_post(unsigned* bar, volatile LAS unsigned* st) {
    XcdBarrier b; b.bar = bar; b.x = xb_xcc_id(); b.st = st;
    if (threadIdx.x == 0) (void)xb_add(&bar[XB_XCNT(b.x)], 1u);
    return b;
}
__device__ __forceinline__ void xcd_barrier_complete(unsigned* bar, unsigned x, unsigned& nloc, unsigned& nx) {
    const unsigned G = gridDim.x * gridDim.y * gridDim.z;
    unsigned sum, cnt, mine, sp = 0u;
    for (;;) {
        sum = 0u; cnt = 0u; mine = 0u;
#pragma unroll
        for (unsigned j = 0; j < 16; ++j) { const unsigned c = xb_ld(&bar[XB_XCNT(j)]); sum += c; cnt += (c > 0u) ? 1u : 0u; mine = (j == x) ? c : mine; }
        if (sum == G) break;
        __builtin_amdgcn_s_sleep(1);
        if ((++sp & 255u) == 0u) { if (xb_ld(&bar[XB_TMO])) break; if (sp > XB_SPIN_CAP) { atomicAdd(&bar[XB_TMO], 1u); break; } }
    }
    nloc = mine > 0u ? mine : 1u; nx = cnt > 0u ? cnt : 1u;
}
__device__ __forceinline__ void xcd_barrier(const XcdBarrier& b) {
    asm volatile("s_waitcnt vmcnt(0)" ::: "memory");
    __syncthreads();
    if (threadIdx.x == 0) {
        unsigned* bar = b.bar;
        __builtin_amdgcn_s_waitcnt(0);
        unsigned nloc = b.st[0], nx = b.st[1];
        if (nloc == 0u) { xcd_barrier_complete(bar, b.x, nloc, nx); b.st[0] = nloc; b.st[1] = nx; }
        const unsigned old = xb_add(&bar[XB_XSUB(b.x)], 1u);
        const unsigned gen = old / nloc;
        if (old + 1u == (gen + 1u) * nloc) {
            __builtin_amdgcn_fence(__ATOMIC_RELEASE, "agent");
            asm volatile("s_waitcnt vmcnt(0)" ::: "memory");
            const unsigned og = xb_add(&bar[XB_TOP], 1u);
            const unsigned tg = og / nx;
            if (og + 1u == (tg + 1u) * nx) xb_add(&bar[XB_TOPGEN], 1u);
            else XB_SPIN(xb_ld(&bar[XB_TOPGEN]) == tg, bar);
            __builtin_amdgcn_fence(__ATOMIC_ACQUIRE, "agent");
            xb_add(&bar[XB_XGEN(b.x)], 1u);
            asm volatile("s_waitcnt vmcnt(0)" ::: "memory");
        } else {
            XB_SPIN(xb_ld(&bar[XB_XGEN(b.x)]) == gen, bar);
            __builtin_amdgcn_fence(__ATOMIC_ACQUIRE, "agent");
            asm volatile("s_waitcnt vmcnt(0)" ::: "memory");
        }
    }
    __syncthreads();
}

template <int MAP>
__device__ __forceinline__ int map_row(int n) {
    if (MAP == 0) return n;
    if (MAP == 1) return ((n >> 4) << 5) + (n & 15);
    return ((n >> 4) << 5) + 16 + (n & 15);
}
template <int MAP>
__device__ __forceinline__ void conv_batch(const float* src, int nmat, int K, int N, bf16_t* dst, size_t dst_mat_stride, int row_off,
                                           LAS float* scr, int gw, int ngw, int lane) {
    const int nblk = (N + 31) / 32, kblk = K / 64, per = nblk * kblk;
    const int total = nmat * per;
    for (int it = gw; it < total; it += ngw) {
        const int mat = it / per, r = it - mat * per, kb = r / nblk, nb = r - kb * nblk, k0 = kb * 64, n0 = nb * 32;
        const float* W = src + (size_t)mat * K * N;
        bf16_t* WT = dst + (size_t)mat * dst_mat_stride;
        const int nn = n0 + (lane & 31);
        const bool nok = nn < N;
#pragma unroll 8
        for (int i = 0; i < 32; ++i) { const int kk = 2 * i + (lane >> 5); scr[kk * 33 + (lane & 31)] = nok ? W[(size_t)(k0 + kk) * N + nn] : 0.f; }
        asm volatile("s_waitcnt lgkmcnt(0)" ::: "memory");
        const int c = lane & 7;
#pragma unroll
        for (int j = 0; j < 4; ++j) {
            const int n = (lane >> 3) + 8 * j;
            const LAS float* s = scr + (8 * c) * 33 + n;
            u32x4 o; o.x = cvt_pk_bf16(s[0 * 33], s[1 * 33]); o.y = cvt_pk_bf16(s[2 * 33], s[3 * 33]); o.z = cvt_pk_bf16(s[4 * 33], s[5 * 33]); o.w = cvt_pk_bf16(s[6 * 33], s[7 * 33]);
            if (n0 + n < N) *(u32x4*)(WT + (size_t)(row_off + map_row<MAP>(n0 + n)) * K + k0 + 8 * c) = o;
        }
        asm volatile("s_waitcnt lgkmcnt(0)" ::: "memory");
    }
}

__device__ __forceinline__ void ada_unit(const Params& p, LAS unsigned char* lds, int u, int tid) {
    LAS float* cond = (LAS float*)lds;
    LAS float* red = (LAS float*)(lds + 32768);
    const float* c = p.in[1]; const float* w = p.in[3]; const float* bias = p.in[4];
    float* ada = (float*)(p.ws + WS_ADA);
    const int lane = tid & 63, wv = tid >> 6;
    for (int i = tid; i < 8 * 1024; i += NT) cond[i] = siluf_(c[i]);
    __syncthreads();
    float acc[8];
#pragma unroll
    for (int b = 0; b < 8; ++b) acc[b] = 0.f;
    const int col = u * 64 + lane;
#pragma unroll 4
    for (int k = wv * 128; k < wv * 128 + 128; ++k) {
        const float wv_ = w[(size_t)k * 6144 + col];
#pragma unroll
        for (int b = 0; b < 8; ++b) acc[b] += cond[b * 1024 + k] * wv_;
    }
#pragma unroll
    for (int b = 0; b < 8; ++b) red[(wv * 8 + b) * 64 + lane] = acc[b];
    __syncthreads();
    {
        const int b = tid >> 6;
        float s = 0.f;
#pragma unroll
        for (int w2 = 0; w2 < 8; ++w2) s += red[(w2 * 8 + b) * 64 + lane];
        ada[b * 6144 + col] = s + bias[col];
    }
    __syncthreads();
}

__device__ __forceinline__ void norm_mod_rows(const float* X, const float* g, const float* ada, int sh_off, int sc_off, bf16_t* Hout, int gw, int ngw, int lane) {
    for (int row = gw; row < T; row += ngw) {
        const int b = row / S;
        const f32x4* xr = (const f32x4*)(X + (size_t)row * D) + lane;
        f32x4 v[4]; float ss = 0.f;
#pragma unroll
        for (int j = 0; j < 4; ++j) { v[j] = xr[64 * j]; ss += v[j].x * v[j].x + v[j].y * v[j].y + v[j].z * v[j].z + v[j].w * v[j].w; }
        const float rinv = rsqrtf(wave_sum(ss) * (1.f / D) + RMS_EPS);
        u32x2* o = (u32x2*)(Hout + (size_t)row * D) + lane;
#pragma unroll
        for (int j = 0; j < 4; ++j) {
            const int k = 4 * (lane + 64 * j);
            const f32x4 gg = *(const f32x4*)(g + k), sc = *(const f32x4*)(ada + b * 6144 + sc_off + k), sh = *(const f32x4*)(ada + b * 6144 + sh_off + k);
            const f32x4 h = v[j] * rinv * gg * (1.f + sc) + sh;
            u32x2 w; w.x = cvt_pk_bf16(h.x, h.y); w.y = cvt_pk_bf16(h.z, h.w);
            o[64 * j] = w;
        }
    }
}

__device__ __forceinline__ void post_proj_rows(const Params& p, int gw, int ngw, int lane) {
    const bf16_t* proj = (const bf16_t*)(p.ws + B_PROJ);
    const float* graw = (const float*)(p.ws + B_GRAW);
    float* gl = (float*)(p.ws + B_GL);
    bf16_t* cqn = (bf16_t*)(p.ws + B_CQN); bf16_t* ckvn = (bf16_t*)(p.ws + B_CKVN); bf16_t* zc = (bf16_t*)(p.ws + B_ZC);
    const float* g_cq = p.in[7]; const float* g_ckv = p.in[9]; const float* conv_w = p.in[14]; const float* conv_b = p.in[15];
    const float* b_i = p.in[18]; const float* b_f = p.in[19];
    for (int row = gw; row < T; row += ngw) {
        const bf16_t* pr = proj + (size_t)row * IN_DIM;
        const int s = row % S;
        {
            const unsigned* q = (const unsigned*)(pr + OFF_CQ) + lane * 3;
            unsigned a0 = q[0], a1 = q[1], a2 = q[2];
            float f[6] = {bflo(a0), bfhi(a0), bflo(a1), bfhi(a1), bflo(a2), bfhi(a2)};
            float ss = 0.f;
#pragma unroll
            for (int j = 0; j < 6; ++j) ss += f[j] * f[j];
            const float rinv = rsqrtf(wave_sum(ss) * (1.f / QLORA) + RMS_EPS);
            const float* gq = g_cq + lane * 6;
            unsigned* o = (unsigned*)(cqn + (size_t)row * QLORA) + lane * 3;
            o[0] = cvt_pk_bf16(f[0] * rinv * gq[0], f[1] * rinv * gq[1]);
            o[1] = cvt_pk_bf16(f[2] * rinv * gq[2], f[3] * rinv * gq[3]);
            o[2] = cvt_pk_bf16(f[4] * rinv * gq[4], f[5] * rinv * gq[5]);
        }
        {
            const u32x2 a = *((const u32x2*)(pr + OFF_CKV) + lane);
            float f[4] = {bflo(a.x), bfhi(a.x), bflo(a.y), bfhi(a.y)};
            float ss = f[0] * f[0] + f[1] * f[1] + f[2] * f[2] + f[3] * f[3];
            const float rinv = rsqrtf(wave_sum(ss) * (1.f / KVLORA) + RMS_EPS);
            const float* gk = g_ckv + lane * 4;
            u32x2 w; w.x = cvt_pk_bf16(f[0] * rinv * gk[0], f[1] * rinv * gk[1]); w.y = cvt_pk_bf16(f[2] * rinv * gk[2], f[3] * rinv * gk[3]);
            *((u32x2*)(ckvn + (size_t)row * KVLORA) + lane) = w;
        }
        {
            const int c0 = lane * 8;
            float acc[8];
#pragma unroll
            for (int j = 0; j < 8; ++j) acc[j] = conv_b[c0 + j];
#pragma unroll
            for (int tap = 0; tap < 4; ++tap) {
                const int ds = tap - 3;
                if (s + ds >= 0) {
                    const u32x4 z = *(const u32x4*)(pr + (ptrdiff_t)ds * IN_DIM + OFF_Z + c0);
                    const float* cw = conv_w + tap * MINNER + c0;
                    acc[0] += bflo(z.x) * cw[0]; acc[1] += bfhi(z.x) * cw[1]; acc[2] += bflo(z.y) * cw[2]; acc[3] += bfhi(z.y) * cw[3];
                    acc[4] += bflo(z.z) * cw[4]; acc[5] += bfhi(z.z) * cw[5]; acc[6] += bflo(z.w) * cw[6]; acc[7] += bfhi(z.w) * cw[7];
                }
            }
            u32x4 o; o.x = cvt_pk_bf16(siluf_(acc[0]), siluf_(acc[1])); o.y = cvt_pk_bf16(siluf_(acc[2]), siluf_(acc[3]));
            o.z = cvt_pk_bf16(siluf_(acc[4]), siluf_(acc[5])); o.w = cvt_pk_bf16(siluf_(acc[6]), siluf_(acc[7]));
            *(u32x4*)(zc + (size_t)row * MINNER + c0) = o;
        }
        if (lane < 8) {
            const float gr = graw[(size_t)row * 8 + lane];
            float o;
            if (lane < 4) o = gr + b_i[lane];
            else { const float xx = gr + b_f[lane - 4]; o = fminf(xx, 0.f) - log1pf(__expf(-fabsf(xx))); }
            gl[(size_t)row * 8 + lane] = o;
        }
    }
}

__device__ __forceinline__ void qk_post_rows(const Params& p, int gw, int ngw, int lane) {
    const bf16_t* qraw = (const bf16_t*)(p.ws + B_QRAW); const bf16_t* kvraw = (const bf16_t*)(p.ws + B_KVRAW);
    const bf16_t* proj = (const bf16_t*)(p.ws + B_PROJ);
    bf16_t* Q = (bf16_t*)(p.ws + B_Q); bf16_t* Kb = (bf16_t*)(p.ws + B_K);
    const int* positions = (const int*)p.in[2];
    const float* g_qn = p.in[11]; const float* g_kn = p.in[12];
    const float qscale = 0.10206207261596575f * 1.4426950408889634f;
    for (int it = gw; it < T * 4; it += ngw) {
        const int row = it >> 2, hp = it & 3, h = hp * 2 + (lane >> 5), l = lane & 31;
        const int b = row / S, s = row % S;
        const float pos = (float)positions[row];
        const int i = l & 15;
        const float inv_freq = exp2f(-(float)(2 * i) * (13.287712379549449f / 32.f));
        const float ang = pos * inv_freq;
        float sn, cs; sincosf(ang, &sn, &cs);
        {
            const bf16_t* qr = qraw + (size_t)row * 768 + h * 96;
            float v0 = bf2f(qr[l]), v1 = bf2f(qr[l + 32]), v2 = bf2f(qr[l + 64]);
            float ss = v0 * v0 + v1 * v1 + v2 * v2;
#pragma unroll
            for (int o = 1; o < 32; o <<= 1) ss += __shfl_xor(ss, o);
            const float rinv = rsqrtf(ss * (1.f / 96.f) + RMS_EPS);
            v0 *= rinv * g_qn[l]; v1 *= rinv * g_qn[l + 32]; v2 *= rinv * g_qn[l + 64];
            const float other = __shfl_xor(v2, 16);
            const float r = (l < 16) ? (v2 * cs - other * sn) : (other * sn + v2 * cs);
            bf16_t* qo = Q + ((size_t)(b * H_MLA + h) * S + s) * 96;
            qo[l] = (bf16_t)(cvt_pk_bf16(v0 * qscale, 0.f) & 0xffff);
            qo[l + 32] = (bf16_t)(cvt_pk_bf16(v1 * qscale, 0.f) & 0xffff);
            qo[l + 64] = (bf16_t)(cvt_pk_bf16(r * qscale, 0.f) & 0xffff);
        }
        {
            const bf16_t* kr = kvraw + (size_t)row * 1024 + h * 128;
            float v0 = bf2f(kr[l]), v1 = bf2f(kr[l + 32]), v2 = bf2f(proj[(size_t)row * IN_DIM + OFF_KR + l]);
            float ss = v0 * v0 + v1 * v1 + v2 * v2;
#pragma unroll
            for (int o = 1; o < 32; o <<= 1) ss += __shfl_xor(ss, o);
            const float rinv = rsqrtf(ss * (1.f / 96.f) + RMS_EPS);
            v0 *= rinv * g_kn[l]; v1 *= rinv * g_kn[l + 32]; v2 *= rinv * g_kn[l + 64];
            const float other = __shfl_xor(v2, 16);
            const float r = (l < 16) ? (v2 * cs - other * sn) : (other * sn + v2 * cs);
            bf16_t* ko = Kb + ((size_t)(b * H_MLA + h) * S + s) * 96;
            ko[l] = (bf16_t)(cvt_pk_bf16(v0, 0.f) & 0xffff);
            ko[l + 32] = (bf16_t)(cvt_pk_bf16(v1, 0.f) & 0xffff);
            ko[l + 64] = (bf16_t)(cvt_pk_bf16(r, 0.f) & 0xffff);
        }
    }
}

__device__ __forceinline__ void attn_out_norm_rows(const Params& p, int gw, int ngw, int lane) {
    const bf16_t* oraw = (const bf16_t*)(p.ws + B_ORAW); bf16_t* ao = (bf16_t*)(p.ws + B_AO); const float* g = p.in[13];
    for (int row = gw; row < T; row += ngw) {
        const u32x4 a = *((const u32x4*)(oraw + (size_t)row * 512) + lane);
        float f[8] = {bflo(a.x), bfhi(a.x), bflo(a.y), bfhi(a.y), bflo(a.z), bfhi(a.z), bflo(a.w), bfhi(a.w)};
        float ss = 0.f;
#pragma unroll
        for (int j = 0; j < 8; ++j) ss += f[j] * f[j];
        const float rinv = rsqrtf(wave_sum(ss) * (1.f / 512.f) + RMS_EPS);
        const float* gg = g + lane * 8;
        u32x4 o; o.x = cvt_pk_bf16(f[0] * rinv * gg[0], f[1] * rinv * gg[1]); o.y = cvt_pk_bf16(f[2] * rinv * gg[2], f[3] * rinv * gg[3]);
        o.z = cvt_pk_bf16(f[4] * rinv * gg[4], f[5] * rinv * gg[5]); o.w = cvt_pk_bf16(f[6] * rinv * gg[6], f[7] * rinv * gg[7]);
        *((u32x4*)(ao + (size_t)row * 1024) + lane) = o;
    }
}

constexpr int GLD = 80;
constexpr int G2_AS = 256 * GLD * 2;
constexpr int G2_BS = 128 * GLD * 2;
constexpr int G2_STAGE = G2_AS + G2_BS;
template <class RowPtr, class ColPtr, class Epi>
__device__ __forceinline__ void gemm2_tile(LAS unsigned char* lds, const RowPtr& RP, const ColPtr& CP, int ldk, int K, int m0, int n0, const Epi& E, int mvalid = 256) {
    const int tid = threadIdx.x, lane = tid & 63, wid = tid >> 6, half = wid >> 2, wm = (wid >> 1) & 1, wn = wid & 1;
    const int fr = lane & 15, fq = lane >> 4;
    const int ht = tid & 255;
    const int ac = (ht & 7) * 8, ar0 = half * 128 + (ht >> 3);
    const int bn = half * 64 + (ht & 63), bk = (ht >> 6) * 16;
    const bf16_t* ap0 = RP(m0 + ar0); const bf16_t* ap1 = RP(m0 + ar0 + 32); const bf16_t* ap2 = RP(m0 + ar0 + 64); const bf16_t* ap3 = RP(m0 + ar0 + 96);
    const float* bp = CP(n0 + bn);
    f32x4 acc[4][4];
#pragma unroll
    for (int m = 0; m < 4; ++m)
#pragma unroll
        for (int n = 0; n < 4; ++n) acc[m][n] = (f32x4){0.f, 0.f, 0.f, 0.f};
    u32x4 ra[4]; float rb[16];
    const u32x4 z4 = (u32x4){0u, 0u, 0u, 0u};
    const int nk = K / 64;
#define G2_LOAD(kt_) do { const int k0_ = (kt_) * 64; \
        ra[0] = ap0 ? *(const u32x4*)(ap0 + k0_ + ac) : z4; ra[1] = ap1 ? *(const u32x4*)(ap1 + k0_ + ac) : z4; \
        ra[2] = ap2 ? *(const u32x4*)(ap2 + k0_ + ac) : z4; ra[3] = ap3 ? *(const u32x4*)(ap3 + k0_ + ac) : z4; \
        if (bp) { _Pragma("unroll") for (int j_ = 0; j_ < 16; ++j_) rb[j_] = bp[(size_t)(k0_ + bk + j_) * ldk]; } \
        else { _Pragma("unroll") for (int j_ = 0; j_ < 16; ++j_) rb[j_] = 0.f; } } while (0)
#define G2_STORE(buf_) do { LAS bf16_t* As_ = (LAS bf16_t*)(lds + (buf_) * G2_STAGE); LAS bf16_t* Bs_ = (LAS bf16_t*)(lds + (buf_) * G2_STAGE + G2_AS); \
        _Pragma("unroll") for (int j_ = 0; j_ < 4; ++j_) *(LAS u32x4*)(As_ + (ar0 + 32 * j_) * GLD + ac) = ra[j_]; \
        u32x4 w0_, w1_; w0_.x = cvt_pk_bf16(rb[0], rb[1]); w0_.y = cvt_pk_bf16(rb[2], rb[3]); w0_.z = cvt_pk_bf16(rb[4], rb[5]); w0_.w = cvt_pk_bf16(rb[6], rb[7]); \
        w1_.x = cvt_pk_bf16(rb[8], rb[9]); w1_.y = cvt_pk_bf16(rb[10], rb[11]); w1_.z = cvt_pk_bf16(rb[12], rb[13]); w1_.w = cvt_pk_bf16(rb[14], rb[15]); \
        *(LAS u32x4*)(Bs_ + bn * GLD + bk) = w0_; *(LAS u32x4*)(Bs_ + bn * GLD + bk + 8) = w1_; } while (0)
#define G2_COMPUTE(buf_) do { const LAS bf16_t* As_ = (const LAS bf16_t*)(lds + (buf_) * G2_STAGE); const LAS bf16_t* Bs_ = (const LAS bf16_t*)(lds + (buf_) * G2_STAGE + G2_AS); \
        _Pragma("unroll") for (int ks_ = 0; ks_ < 2; ++ks_) { bf16x8 af_[4], bf_[4]; \
        _Pragma("unroll") for (int m_ = 0; m_ < 4; ++m_) af_[m_] = *(const LAS bf16x8*)(As_ + (half * 128 + wm * 64 + m_ * 16 + fr) * GLD + ks_ * 32 + fq * 8); \
        _Pragma("unroll") for (int n_ = 0; n_ < 4; ++n_) bf_[n_] = *(const LAS bf16x8*)(Bs_ + (wn * 64 + n_ * 16 + fr) * GLD + ks_ * 32 + fq * 8); \
        _Pragma("unroll") for (int m_ = 0; m_ < 4; ++m_) _Pragma("unroll") for (int n_ = 0; n_ < 4; ++n_) acc[m_][n_] = MFMA16(bf_[n_], af_[m_], acc[m_][n_]); } } while (0)
    G2_LOAD(0);
    G2_STORE(0);
    if (nk > 1) G2_LOAD(1);
    __syncthreads();
    for (int kt = 0; kt < nk; ++kt) {
        const int cur = kt & 1;
        if (half == 0) { G2_COMPUTE(cur); }
        else if (kt + 1 < nk) { G2_STORE(cur ^ 1); if (kt + 2 < nk) G2_LOAD(kt + 2); }
        __syncthreads();
        if (half == 1) { if (mvalid > 128) { G2_COMPUTE(cur); } }
        else if (kt + 1 < nk) { G2_STORE(cur ^ 1); if (kt + 2 < nk) G2_LOAD(kt + 2); }
        __syncthreads();
    }
#undef G2_LOAD
#undef G2_STORE
#undef G2_COMPUTE
    E(acc, m0 + half * 128 + wm * 64, n0 + wn * 64, lane);
}

struct RowDense { const bf16_t* A; int lda; __device__ __forceinline__ const bf16_t* operator()(int r) const { return A + (size_t)r * lda; } };
struct RowGather { const bf16_t* A; const int* idx; int nvalid; __device__ __forceinline__ const bf16_t* operator()(int r) const { return r < nvalid ? A + (size_t)idx[r] * D : nullptr; } };
struct RowSlots { const bf16_t* A; int nvalid; __device__ __forceinline__ const bf16_t* operator()(int r) const { return r < nvalid ? A + (size_t)r * EDIM : nullptr; } };
struct ColDense { const float* W; int N; __device__ __forceinline__ const float* operator()(int c) const { return c < N ? W + c : nullptr; } };
struct ColMqk { const float* q; ptrdiff_t dk; __device__ __forceinline__ const float* operator()(int c) const { return q + ((c < 128) ? (ptrdiff_t)c : dk + (c - 128)); } };
struct ColGU { const float* g; ptrdiff_t du; __device__ __forceinline__ const float* operator()(int c) const { const int j = c >> 5, w = c & 31; return g + (((w & 16) ? du : (ptrdiff_t)0) + j * 16 + (w & 15)); } };
struct ColRgu { const float* r; ptrdiff_t dg; ptrdiff_t du; __device__ __forceinline__ const float* operator()(int c) const {
    const int cc = c - 256, j = cc >> 5, w = cc & 31; const ptrdiff_t off = (c < 256) ? (ptrdiff_t)c : (((w & 16) ? du : dg) + j * 16 + (w & 15)); return r + off; } };

__device__ __forceinline__ u32x2 pack4(const f32x4 v) { u32x2 w; w.x = cvt_pk_bf16(v.x, v.y); w.y = cvt_pk_bf16(v.z, v.w); return w; }
__device__ __forceinline__ u32x2 pack_swiglu(const f32x4 g, const f32x4 u) { u32x2 w; w.x = cvt_pk_bf16(siluf_(g.x) * u.x, siluf_(g.y) * u.y); w.y = cvt_pk_bf16(siluf_(g.z) * u.z, siluf_(g.w) * u.w); return w; }
struct EpiProj {
    bf16_t* proj; float* graw;
    __device__ __forceinline__ void operator()(const f32x4 (&acc)[4][4], int rb, int cb, int lane) const {
        const int fr = lane & 15, fq = lane >> 4;
#pragma unroll
        for (int m = 0; m < 4; ++m)
#pragma unroll
            for (int n = 0; n < 4; ++n) {
                const int row = rb + m * 16 + fr, col = cb + n * 16 + 4 * fq;
                if (col < OFF_GATE) *(u32x2*)(proj + (size_t)row * IN_DIM + col) = pack4(acc[m][n]);
                else if (col < IN_DIM) *(f32x4*)(graw + (size_t)row * 8 + (col - OFF_GATE)) = acc[m][n];
            }
    }
};
struct EpiBf16 {
    bf16_t* O; int ldc;
    __device__ __forceinline__ void operator()(const f32x4 (&acc)[4][4], int rb, int cb, int lane) const {
        const int fr = lane & 15, fq = lane >> 4;
#pragma unroll
        for (int m = 0; m < 4; ++m)
#pragma unroll
            for (int n = 0; n < 4; ++n) *(u32x2*)(O + (size_t)(rb + m * 16 + fr) * ldc + cb + n * 16 + 4 * fq) = pack4(acc[m][n]);
    }
};
struct EpiMqk {
    bf16_t* mq; bf16_t* mk; int h;
    __device__ __forceinline__ void operator()(const f32x4 (&acc)[4][4], int rb, int cb, int lane) const {
        const int fr = lane & 15, fq = lane >> 4;
#pragma unroll
        for (int m = 0; m < 4; ++m)
#pragma unroll
            for (int n = 0; n < 4; ++n) {
                const int row = rb + m * 16 + fr, col = cb + n * 16 + 4 * fq; f32x4 v = acc[m][n];
                bf16_t* dst = mq; int c = col;
                if (col >= 128) { dst = mk; c = col - 128; v = v * 0.08838834764831845f; }
                *(u32x2*)(dst + (size_t)row * MINNER + h * DM + c) = pack4(v);
            }
    }
};
struct EpiResid {
    const float* X; const float* ada; int gt_off; float* out;
    __device__ __forceinline__ void operator()(const f32x4 (&acc)[4][4], int rb, int cb, int lane) const {
        const int fr = lane & 15, fq = lane >> 4;
#pragma unroll
        for (int m = 0; m < 4; ++m)
#pragma unroll
            for (int n = 0; n < 4; ++n) {
                const int row = rb + m * 16 + fr, col = cb + n * 16 + 4 * fq; const int b = row / S;
                const f32x4 g = *(const f32x4*)(ada + b * 6144 + gt_off + col);
                const f32x4 x = *(const f32x4*)(X + (size_t)row * D + col);
                *(f32x4*)(out + (size_t)row * D + col) = x + g * acc[m][n];
            }
    }
};
struct EpiRgu {
    float* logits; bf16_t* act;
    __device__ __forceinline__ void operator()(const f32x4 (&acc)[4][4], int rb, int cb, int lane) const {
        const int fr = lane & 15, fq = lane >> 4;
#pragma unroll
        for (int m = 0; m < 4; ++m) {
            const int row = rb + m * 16 + fr;
            if (cb < 256) {
#pragma unroll
                for (int n = 0; n < 4; ++n) *(f32x4*)(logits + (size_t)row * 256 + cb + n * 16 + 4 * fq) = acc[m][n];
            } else {
                const int j0 = (cb - 256) >> 5;
#pragma unroll
                for (int pp = 0; pp < 2; ++pp) *(u32x2*)(act + (size_t)row * 256 + (j0 + pp) * 16 + 4 * fq) = pack_swiglu(acc[m][2 * pp], acc[m][2 * pp + 1]);
            }
        }
    }
};
struct EpiExpAct {
    bf16_t* act; int slot0; int nvalid;
    __device__ __forceinline__ void operator()(const f32x4 (&acc)[4][4], int rb, int cb, int lane) const {
        const int fr = lane & 15, fq = lane >> 4;
#pragma unroll
        for (int m = 0; m < 4; ++m) {
            const int r = rb + m * 16 + fr;
            if (r < nvalid) {
                const int j0 = cb >> 5;
#pragma unroll
                for (int pp = 0; pp < 2; ++pp) *(u32x2*)(act + (size_t)(slot0 + r) * 256 + (j0 + pp) * 16 + 4 * fq) = pack_swiglu(acc[m][2 * pp], acc[m][2 * pp + 1]);
            }
        }
    }
};
struct EpiExpDown {
    bf16_t* y; const float* lw; int slot0; int nvalid;
    __device__ __forceinline__ void operator()(const f32x4 (&acc)[4][4], int rb, int cb, int lane) const {
        const int fr = lane & 15, fq = lane >> 4;
#pragma unroll
        for (int m = 0; m < 4; ++m) {
            const int r = rb + m * 16 + fr;
            if (r < nvalid) {
                const float wt = lw[r];
#pragma unroll
                for (int n = 0; n < 4; ++n) *(u32x2*)(y + (size_t)(slot0 + r) * 1024 + cb + n * 16 + 4 * fq) = pack4(acc[m][n] * wt);
            }
        }
    }
};

constexpr int AKLD = 104, AVLD = 72;
__device__ __forceinline__ void attn_unit(const Params& p, LAS unsigned char* lds, int bh, int qb) {
    LAS bf16_t* Ks = (LAS bf16_t*)lds;
    LAS bf16_t* Vt = Ks + 64 * AKLD;
    const bf16_t* Q = (const bf16_t*)(p.ws + B_Q) + (size_t)bh * S * 96;
    const bf16_t* Kg = (const bf16_t*)(p.ws + B_K) + (size_t)bh * S * 96;
    const int b = bh >> 3, h = bh & 7;
    const bf16_t* Vg = (const bf16_t*)(p.ws + B_KVRAW) + (size_t)b * S * 1024 + h * 128 + 64;
    bf16_t* O = (bf16_t*)(p.ws + B_ORAW) + (size_t)b * S * 512 + h * 64;
    const int tid = threadIdx.x, lane = tid & 63, wid = tid >> 6, fr = lane & 15, fq = lane >> 4;
    const int q0 = qb * 256, qw0 = q0 + wid * 32;
    bf16x8 qf[2][3];
#pragma unroll
    for (int nq = 0; nq < 2; ++nq)
#pragma unroll
        for (int ks = 0; ks < 3; ++ks) qf[nq][ks] = *(const bf16x8*)(Q + (size_t)(qw0 + nq * 16 + fr) * 96 + ks * 32 + fq * 8);
    f32x4 oacc[4][2];
#pragma unroll
    for (int d = 0; d < 4; ++d)
#pragma unroll
        for (int nq = 0; nq < 2; ++nq) oacc[d][nq] = (f32x4){0.f, 0.f, 0.f, 0.f};
    float mrun[2] = {-1e30f, -1e30f}, lrun[2] = {0.f, 0.f};
    const int ntiles = (q0 + 256) / 64;
    for (int kt = 0; kt < ntiles; ++kt) {
        const int k0 = kt * 64;
        for (int c = tid; c < 768; c += NT) { const int r = c / 12, cc = c - r * 12; *(LAS u32x4*)(Ks + r * AKLD + cc * 8) = *(const u32x4*)(Kg + (size_t)(k0 + r) * 96 + cc * 8); }
        {
            const int key = tid & 63, dc = tid >> 6;
            const u32x4 v = *(const u32x4*)(Vg + (size_t)(k0 + key) * 1024 + dc * 8);
            LAS bf16_t* vt = Vt + (dc * 8) * AVLD + key;
            vt[0 * AVLD] = (bf16_t)(v.x & 0xffff); vt[1 * AVLD] = (bf16_t)(v.x >> 16); vt[2 * AVLD] = (bf16_t)(v.y & 0xffff); vt[3 * AVLD] = (bf16_t)(v.y >> 16);
            vt[4 * AVLD] = (bf16_t)(v.z & 0xffff); vt[5 * AVLD] = (bf16_t)(v.z >> 16); vt[6 * AVLD] = (bf16_t)(v.w & 0xffff); vt[7 * AVLD] = (bf16_t)(v.w >> 16);
        }
        __syncthreads();
        if (k0 <= qw0 + 31) {
            f32x4 sacc[4][2];
#pragma unroll
            for (int t4 = 0; t4 < 4; ++t4)
#pragma unroll
                for (int nq = 0; nq < 2; ++nq) sacc[t4][nq] = (f32x4){0.f, 0.f, 0.f, 0.f};
#pragma unroll
            for (int ks = 0; ks < 3; ++ks)
#pragma unroll
                for (int t4 = 0; t4 < 4; ++t4) {
                    const bf16x8 kf = *(const LAS bf16x8*)(Ks + (t4 * 16 + fr) * AKLD + ks * 32 + fq * 8);
#pragma unroll
                    for (int nq = 0; nq < 2; ++nq) sacc[t4][nq] = MFMA16(kf, qf[nq][ks], sacc[t4][nq]);
                }
            const bool need_mask = (k0 + 63 > qw0);
#pragma unroll
            for (int nq = 0; nq < 2; ++nq) {
                const int qidx = qw0 + nq * 16 + fr;
                float mx = -1e30f;
#pragma unroll
                for (int t4 = 0; t4 < 4; ++t4)
#pragma unroll
                    for (int i = 0; i < 4; ++i) {
                        if (need_mask) { const int key = k0 + t4 * 16 + 4 * fq + i; if (key > qidx) sacc[t4][nq][i] = -1e30f; }
                        mx = fmaxf(mx, sacc[t4][nq][i]);
                    }
                mx = fmaxf(mx, __shfl_xor(mx, 16)); mx = fmaxf(mx, __shfl_xor(mx, 32));
                const float mnew = fmaxf(mrun[nq], mx);
                const float alpha = exp2f(mrun[nq] - mnew);
                mrun[nq] = mnew;
                float ls = 0.f;
#pragma unroll
                for (int t4 = 0; t4 < 4; ++t4)
#pragma unroll
                    for (int i = 0; i < 4; ++i) { const float pv = exp2f(sacc[t4][nq][i] - mnew); sacc[t4][nq][i] = pv; ls += pv; }
                lrun[nq] = lrun[nq] * alpha + ls;
#pragma unroll
                for (int d = 0; d < 4; ++d) oacc[d][nq] = oacc[d][nq] * alpha;
            }
#pragma unroll
            for (int s2 = 0; s2 < 2; ++s2) {
                bf16x8 pb[2];
#pragma unroll
                for (int nq = 0; nq < 2; ++nq) {
                    u32x4 w; w.x = cvt_pk_bf16(sacc[2 * s2][nq].x, sacc[2 * s2][nq].y); w.y = cvt_pk_bf16(sacc[2 * s2][nq].z, sacc[2 * s2][nq].w);
                    w.z = cvt_pk_bf16(sacc[2 * s2 + 1][nq].x, sacc[2 * s2 + 1][nq].y); w.w = cvt_pk_bf16(sacc[2 * s2 + 1][nq].z, sacc[2 * s2 + 1][nq].w);
                    pb[nq] = __builtin_bit_cast(bf16x8, w);
                }
#pragma unroll
                for (int d = 0; d < 4; ++d) {
                    const LAS bf16_t* vr = Vt + (d * 16 + fr) * AVLD + s2 * 32 + 4 * fq;
                    const u32x2 lo = *(const LAS u32x2*)vr, hi = *(const LAS u32x2*)(vr + 16);
                    const bf16x8 vf = __builtin_bit_cast(bf16x8, ((u32x4){lo.x, lo.y, hi.x, hi.y}));
#pragma unroll
                    for (int nq = 0; nq < 2; ++nq) oacc[d][nq] = MFMA16(vf, pb[nq], oacc[d][nq]);
                }
            }
        }
        __syncthreads();
    }
#pragma unroll
    for (int nq = 0; nq < 2; ++nq) {
        float l = lrun[nq]; l += __shfl_xor(l, 16); l += __shfl_xor(l, 32);
        const float inv = 1.f / l;
        const int qidx = qw0 + nq * 16 + fr;
#pragma unroll
        for (int d = 0; d < 4; ++d) { const f32x4 v = oacc[d][nq] * inv; u32x2 w; w.x = cvt_pk_bf16(v.x, v.y); w.y = cvt_pk_bf16(v.z, v.w);
            *(u32x2*)(O + (size_t)qidx * 512 + d * 16 + 4 * fq) = w; }
    }
}

constexpr int MTLD = 72;
__device__ __forceinline__ void mlstm_a_unit(const Params& p, LAS unsigned char* lds, int unit) {
    LAS bf16_t* kT = (LAS bf16_t*)lds;
    LAS bf16_t* vT = kT + 128 * MTLD;
    LAS float* av = (LAS float*)(vT + 128 * MTLD);
    const int bh = unit >> 5, c = unit & 31, b = bh >> 2, h = bh & 3;
    const int t0 = b * S + c * CHUNK;
    const float* gl = (const float*)(p.ws + B_GL);
    const bf16_t* mk = (const bf16_t*)(p.ws + B_MK); const bf16_t* proj = (const bf16_t*)(p.ws + B_PROJ);
    const int tid = threadIdx.x, lane = tid & 63, wid = tid >> 6, fr = lane & 15, fq = lane >> 4;
    if (wid == 0) {
        const float li = gl[(size_t)(t0 + lane) * 8 + h], lf = gl[(size_t)(t0 + lane) * 8 + 4 + h];
        float bs = lf;
#pragma unroll
        for (int o = 1; o < 64; o <<= 1) { const float t = __shfl_up(bs, o); if (lane >= o) bs += t; }
        const float Btot = __shfl(bs, 63);
        const float g = Btot - bs + li;
        const float ml = wave_max(g);
        av[lane] = __expf(g - ml);
        if (lane == 0) { ((float*)(p.ws + WS_BC))[unit] = Btot; ((float*)(p.ws + WS_MLOC))[unit] = ml; }
    }
    __syncthreads();
#pragma unroll
    for (int rep = 0; rep < 2; ++rep) {
        const int cidx = tid + rep * NT, s = cidx & 63, ch = cidx >> 6;
        const u32x4 kv = *(const u32x4*)(mk + (size_t)(t0 + s) * MINNER + h * DM + ch * 8);
        const u32x4 vv = *(const u32x4*)(proj + (size_t)(t0 + s) * IN_DIM + OFF_MV + h * DM + ch * 8);
        const float a = av[s];
        LAS bf16_t* kt = kT + (ch * 8) * MTLD + s; LAS bf16_t* vt = vT + (ch * 8) * MTLD + s;
        const unsigned kk[4] = {kv.x, kv.y, kv.z, kv.w}; const unsigned vw[4] = {vv.x, vv.y, vv.z, vv.w};
#pragma unroll
        for (int j = 0; j < 4; ++j) {
            kt[(2 * j) * MTLD] = (bf16_t)(kk[j] & 0xffff); kt[(2 * j + 1) * MTLD] = (bf16_t)(kk[j] >> 16);
            const unsigned sc = cvt_pk_bf16(bflo(vw[j]) * a, bfhi(vw[j]) * a);
            vt[(2 * j) * MTLD] = (bf16_t)(sc & 0xffff); vt[(2 * j + 1) * MTLD] = (bf16_t)(sc >> 16);
        }
    }
    __syncthreads();
    {
        const int we = wid >> 1, wd = wid & 1;
        f32x4 acc[2][4];
#pragma unroll
        for (int i = 0; i < 2; ++i)
#pragma unroll
            for (int j = 0; j < 4; ++j) acc[i][j] = (f32x4){0.f, 0.f, 0.f, 0.f};
#pragma unroll
        for (int ks = 0; ks < 2; ++ks) {
            bf16x8 vf[2], kf[4];
#pragma unroll
            for (int i = 0; i < 2; ++i) vf[i] = *(const LAS bf16x8*)(vT + (we * 32 + i * 16 + fr) * MTLD + ks * 32 + fq * 8);
#pragma unroll
            for (int j = 0; j < 4; ++j) kf[j] = *(const LAS bf16x8*)(kT + (wd * 64 + j * 16 + fr) * MTLD + ks * 32 + fq * 8);
#pragma unroll
            for (int i = 0; i < 2; ++i)
#pragma unroll
                for (int j = 0; j < 4; ++j) acc[i][j] = MFMA16(vf[i], kf[j], acc[i][j]);
        }
        float* dC = (float*)(p.ws + B_DC) + (size_t)unit * 16384;
#pragma unroll
        for (int i = 0; i < 2; ++i)
#pragma unroll
            for (int j = 0; j < 4; ++j)
#pragma unroll
                for (int r = 0; r < 4; ++r) dC[(we * 32 + i * 16 + 4 * fq + r) * 128 + wd * 64 + j * 16 + fr] = acc[i][j][r];
    }
    if (tid < 128) {
        float s = 0.f;
        for (int q = 0; q < 64; ++q) s += bf2f(kT[tid * MTLD + q]) * av[q];
        ((float*)(p.ws + WS_DN))[(size_t)unit * 128 + tid] = s;
    }
    __syncthreads();
}

__device__ __forceinline__ void mlstm_scan(const Params& p, int gtid, int ngt) {
    const float* Bc = (const float*)(p.ws + WS_BC); const float* ML = (const float*)(p.ws + WS_MLOC);
    float* mprev = (float*)(p.ws + WS_MPREV);
    const float* dC = (const float*)(p.ws + B_DC); bf16_t* Cp = (bf16_t*)(p.ws + B_CPREV);
    const float* dn = (const float*)(p.ws + WS_DN); float* np_ = (float*)(p.ws + WS_NPREV);
    constexpr int PER = 4096 + 32;
    for (int idx = gtid; idx < 32 * PER; idx += ngt) {
        const int bh = idx / PER, e4 = idx - bh * PER;
        float m = 0.f; f32x4 C = (f32x4){0.f, 0.f, 0.f, 0.f};
        for (int c = 0; c < NCH; ++c) {
            const int unit = bh * NCH + c;
            const float Bt = Bc[unit], ml = ML[unit];
            const float mnew = fmaxf(Bt + m, ml);
            const float fa = __expf(Bt + m - mnew), fb = __expf(ml - mnew);
            if (e4 < 4096) {
                u32x2 w; w.x = cvt_pk_bf16(C.x, C.y); w.y = cvt_pk_bf16(C.z, C.w);
                *(u32x2*)(Cp + (size_t)unit * 16384 + e4 * 4) = w;
                const f32x4 d = *(const f32x4*)(dC + (size_t)unit * 16384 + e4 * 4);
                C = C * fa + d * fb;
                if (e4 == 0) mprev[unit] = m;
            } else {
                const int n4 = e4 - 4096;
                *(f32x4*)(np_ + (size_t)unit * 128 + n4 * 4) = C;
                const f32x4 d = *(const f32x4*)(dn + (size_t)unit * 128 + n4 * 4);
                C = C * fa + d * fb;
            }
            m = mnew;
        }
    }
}

constexpr int MRLD = 136;
__device__ __forceinline__ void mlstm_c_unit(const Params& p, LAS unsigned char* lds, int unit) {
    LAS bf16_t* qs = (LAS bf16_t*)lds;
    LAS bf16_t* ks = qs + 64 * MRLD;
    LAS bf16_t* cs = ks + 64 * MRLD;
    LAS bf16_t* vT = cs + 128 * MRLD;
    LAS float* fv = (LAS float*)(vT + 128 * MTLD);
    LAS float* u_s = fv; LAS float* c_t = fv + 64; LAS float* dec = fv + 128; LAS float* emt = fv + 192; LAS float* ssq = fv + 256;
    const int bh = unit >> 5, c = unit & 31, b = bh >> 2, h = bh & 3;
    const int t0 = b * S + c * CHUNK;
    const float* gl = (const float*)(p.ws + B_GL);
    const bf16_t* mq = (const bf16_t*)(p.ws + B_MQ); const bf16_t* mk = (const bf16_t*)(p.ws + B_MK); const bf16_t* proj = (const bf16_t*)(p.ws + B_PROJ);
    const bf16_t* Cp = (const bf16_t*)(p.ws + B_CPREV) + (size_t)unit * 16384;
    const float* np_ = (const float*)(p.ws + WS_NPREV) + (size_t)unit * 128;
    const int tid = threadIdx.x, lane = tid & 63, wid = tid >> 6, fr = lane & 15, fq = lane >> 4;
    if (wid == 0) {
        const float li = gl[(size_t)(t0 + lane) * 8 + h], lf = gl[(size_t)(t0 + lane) * 8 + 4 + h];
        const float mp = ((const float*)(p.ws + WS_MPREV))[unit];
        float bs = lf;
#pragma unroll
        for (int o = 1; o < 64; o <<= 1) { const float t = __shfl_up(bs, o); if (lane >= o) bs += t; }
        const float u = li - bs;
        float pm = u;
#pragma unroll
        for (int o = 1; o < 64; o <<= 1) { const float t = __shfl_up(pm, o); if (lane >= o) pm = fmaxf(pm, t); }
        const float inter = bs + mp;
        const float mt = fmaxf(inter, bs + pm);
        u_s[lane] = u; c_t[lane] = bs - mt; dec[lane] = __expf(inter - mt); emt[lane] = __expf(-mt);
    }
#pragma unroll
    for (int rep = 0; rep < 2; ++rep) {
        const int cidx = tid + rep * NT, r = cidx >> 4, ch = cidx & 15;
        *(LAS u32x4*)(qs + r * MRLD + ch * 8) = *(const u32x4*)(mq + (size_t)(t0 + r) * MINNER + h * DM + ch * 8);
        *(LAS u32x4*)(ks + r * MRLD + ch * 8) = *(const u32x4*)(mk + (size_t)(t0 + r) * MINNER + h * DM + ch * 8);
    }
#pragma unroll
    for (int rep = 0; rep < 4; ++rep) {
        const int cidx = tid + rep * NT, r = cidx >> 4, ch = cidx & 15;
        *(LAS u32x4*)(cs + r * MRLD + ch * 8) = *(const u32x4*)(Cp + r * 128 + ch * 8);
    }
#pragma unroll
    for (int rep = 0; rep < 2; ++rep) {
        const int cidx = tid + rep * NT, s = cidx & 63, ch = cidx >> 6;
        const u32x4 vv = *(const u32x4*)(proj + (size_t)(t0 + s) * IN_DIM + OFF_MV + h * DM + ch * 8);
        LAS bf16_t* vt = vT + (ch * 8) * MTLD + s;
        const unsigned vw[4] = {vv.x, vv.y, vv.z, vv.w};
#pragma unroll
        for (int j = 0; j < 4; ++j) { vt[(2 * j) * MTLD] = (bf16_t)(vw[j] & 0xffff); vt[(2 * j + 1) * MTLD] = (bf16_t)(vw[j] >> 16); }
    }
    __syncthreads();
    const int tt = wid & 3, eh = wid >> 2;
    const int tl = tt * 16 + fr;
    bf16x8 qf[4];
#pragma unroll
    for (int k4 = 0; k4 < 4; ++k4) qf[k4] = *(const LAS bf16x8*)(qs + tl * MRLD + k4 * 32 + fq * 8);
    f32x4 sacc[4];
#pragma unroll
    for (int st = 0; st < 4; ++st) sacc[st] = (f32x4){0.f, 0.f, 0.f, 0.f};
#pragma unroll
    for (int k4 = 0; k4 < 4; ++k4)
#pragma unroll
        for (int st = 0; st < 4; ++st) {
            const bf16x8 kf = *(const LAS bf16x8*)(ks + (st * 16 + fr) * MRLD + k4 * 32 + fq * 8);
            sacc[st] = MFMA16(kf, qf[k4], sacc[st]);
        }
    const float ct = c_t[tl];
    float rs = 0.f;
#pragma unroll
    for (int st = 0; st < 4; ++st)
#pragma unroll
        for (int i = 0; i < 4; ++i) {
            const int s = st * 16 + 4 * fq + i;
            const float w = (s <= tl) ? __expf(ct + u_s[s]) * sacc[st][i] : 0.f;
            sacc[st][i] = w; rs += w;
        }
    rs += __shfl_xor(rs, 16); rs += __shfl_xor(rs, 32);
    float nq;
    {
        f32x4 na = (f32x4){0.f, 0.f, 0.f, 0.f};
#pragma unroll
        for (int k4 = 0; k4 < 4; ++k4) {
            u32x4 w = (u32x4){0u, 0u, 0u, 0u};
            if (fr == 0) { const float* nn = np_ + k4 * 32 + fq * 8; w.x = cvt_pk_bf16(nn[0], nn[1]); w.y = cvt_pk_bf16(nn[2], nn[3]); w.z = cvt_pk_bf16(nn[4], nn[5]); w.w = cvt_pk_bf16(nn[6], nn[7]); }
            na = MFMA16(__builtin_bit_cast(bf16x8, w), qf[k4], na);
        }
        nq = __shfl(na.x, fr);
    }
    f32x4 acc[4];
#pragma unroll
    for (int et = 0; et < 4; ++et) acc[et] = (f32x4){0.f, 0.f, 0.f, 0.f};
#pragma unroll
    for (int k4 = 0; k4 < 4; ++k4)
#pragma unroll
        for (int et = 0; et < 4; ++et) {
            const bf16x8 cf = *(const LAS bf16x8*)(cs + (eh * 64 + et * 16 + fr) * MRLD + k4 * 32 + fq * 8);
            acc[et] = MFMA16(cf, qf[k4], acc[et]);
        }
    const float dcy = dec[tl];
#pragma unroll
    for (int et = 0; et < 4; ++et) acc[et] = acc[et] * dcy;
#pragma unroll
    for (int s2 = 0; s2 < 2; ++s2) {
        u32x4 w; w.x = cvt_pk_bf16(sacc[2 * s2].x, sacc[2 * s2].y); w.y = cvt_pk_bf16(sacc[2 * s2].z, sacc[2 * s2].w);
        w.z = cvt_pk_bf16(sacc[2 * s2 + 1].x, sacc[2 * s2 + 1].y); w.w = cvt_pk_bf16(sacc[2 * s2 + 1].z, sacc[2 * s2 + 1].w);
        const bf16x8 pb = __builtin_bit_cast(bf16x8, w);
#pragma unroll
        for (int et = 0; et < 4; ++et) {
            const LAS bf16_t* vr = vT + (eh * 64 + et * 16 + fr) * MTLD + s2 * 32 + 4 * fq;
            const u32x2 lo = *(const LAS u32x2*)vr, hi = *(const LAS u32x2*)(vr + 16);
            acc[et] = MFMA16(__builtin_bit_cast(bf16x8, ((u32x4){lo.x, lo.y, hi.x, hi.y})), pb, acc[et]);
        }
    }
    const float den = dcy * nq + rs;
    const float hd = 1.f / fmaxf(fabsf(den), emt[tl]);
    float sq = 0.f;
#pragma unroll
    for (int et = 0; et < 4; ++et) { acc[et] = acc[et] * hd; sq += acc[et].x * acc[et].x + acc[et].y * acc[et].y + acc[et].z * acc[et].z + acc[et].w * acc[et].w; }
    sq += __shfl_xor(sq, 16); sq += __shfl_xor(sq, 32);
    if (fq == 0) ssq[eh * 64 + tl] = sq;
    __syncthreads();
    const float rinv = rsqrtf((ssq[tl] + ssq[64 + tl]) * (1.f / 128.f) + RMS_EPS);
    const float* gmo = p.in[20] + h * DM;
    bf16_t* ao = (bf16_t*)(p.ws + B_AO);
#pragma unroll
    for (int et = 0; et < 4; ++et) {
        const int e = eh * 64 + et * 16 + 4 * fq;
        const u32x2 op = *(const u32x2*)(proj + (size_t)(t0 + tl) * IN_DIM + OFF_MO + h * DM + e);
        const f32x4 g = *(const f32x4*)(gmo + e);
        const f32x4 v = acc[et] * rinv * g;
        u32x2 w; w.x = cvt_pk_bf16(v.x * sigmoidf_(bflo(op.x)), v.y * sigmoidf_(bfhi(op.x))); w.y = cvt_pk_bf16(v.z * sigmoidf_(bflo(op.y)), v.w * sigmoidf_(bfhi(op.y)));
        *(u32x2*)(ao + (size_t)(t0 + tl) * 1024 + 512 + h * DM + e) = w;
    }
    __syncthreads();
}

__device__ __forceinline__ void route_rows(const Params& p, int gw, int ngw, int lane) {
    const float* logits = (const float*)(p.ws + C_LOGITS); const float* rb = p.in[24];
    int* cnt = (int*)(p.ws + WS_CTL);
    int* tok_e = (int*)(p.ws + C_TOKE); float* tok_w = (float*)(p.ws + C_TOKW); int* tok_pos = (int*)(p.ws + C_TOKPOS);
    int* list_tok = (int*)(p.ws + C_LISTTOK); float* list_w = (float*)(p.ws + C_LISTW);
    const f32x4 bias = *(const f32x4*)(rb + lane * 4);
    const float NEG = -__builtin_inff();
    for (int row = gw; row < T; row += ngw) {
        const f32x4 lg = *(const f32x4*)(logits + (size_t)row * 256 + lane * 4);
        float sc[4] = {sigmoidf_(lg.x), sigmoidf_(lg.y), sigmoidf_(lg.z), sigmoidf_(lg.w)};
        float sb[4] = {sc[0] + bias.x, sc[1] + bias.y, sc[2] + bias.z, sc[3] + bias.w};
        float t1 = fmaxf(fmaxf(sb[0], sb[1]), fmaxf(sb[2], sb[3]));
        float t2;
        {
            const float a = fmaxf(sb[0], sb[1]), bmin = fminf(sb[0], sb[1]), c2 = fmaxf(sb[2], sb[3]), dmin = fminf(sb[2], sb[3]);
            t2 = fmaxf(fminf(a, c2), fmaxf(bmin, dmin));
        }
#pragma unroll
        for (int o = 1; o < 8; o <<= 1) {
            const float o1 = __shfl_xor(t1, o), o2 = __shfl_xor(t2, o);
            const float n1 = fmaxf(t1, o1), n2 = fmaxf(fminf(t1, o1), fmaxf(t2, o2));
            t1 = n1; t2 = n2;
        }
        const float gs = t1 + t2;
        const int myg = lane >> 3;
        int rank = 0;
#pragma unroll
        for (int g = 0; g < 8; ++g) { const float og = __shfl(gs, g * 8); rank += (og > gs || (og == gs && g < myg)) ? 1 : 0; }
        const bool keep = rank < 4;
        float cand[4];
#pragma unroll
        for (int j = 0; j < 4; ++j) cand[j] = keep ? sb[j] : NEG;
        float wsum = 0.f; float myw = 0.f; int mye = 0;
#pragma unroll
        for (int k = 0; k < TOPK; ++k) {
            float bv = cand[0]; int bi = 0;
#pragma unroll
            for (int j = 1; j < 4; ++j) if (cand[j] > bv) { bv = cand[j]; bi = j; }
            int gi = lane * 4 + bi; float gv = bv;
#pragma unroll
            for (int o = 1; o < 64; o <<= 1) {
                const float ov = __shfl_xor(gv, o); const int oi = __shfl_xor(gi, o);
                if (ov > gv || (ov == gv && oi < gi)) { gv = ov; gi = oi; }
            }
            const int wl = gi >> 2, wj = gi & 3;
            const float sj = (wj == 0) ? sc[0] : (wj == 1) ? sc[1] : (wj == 2) ? sc[2] : sc[3];
            const float sraw = __shfl(sj, wl);
            wsum += sraw;
            if (lane == k) { myw = sraw; mye = gi; }
            if (lane == wl) {
#pragma unroll
                for (int j = 0; j < 4; ++j) if (j == wj) cand[j] = NEG;
            }
        }
        if (lane < TOPK) {
            const float w = myw / wsum * 2.5f;
            const int pos = atomicAdd(&cnt[mye], 1);
            tok_e[(size_t)row * 8 + lane] = mye; tok_w[(size_t)row * 8 + lane] = w; tok_pos[(size_t)row * 8 + lane] = pos;
            list_tok[(size_t)mye * CAP + pos] = row; list_w[(size_t)mye * CAP + pos] = w;
        }
    }
}

__device__ __forceinline__ void expert_prefix(const Params& p, LAS int* base, LAS int* tsx, int tid, int x, int ngrp) {
    const int* cnt = (const int*)(p.ws + WS_CTL);
    const int nper = NE / ngrp;
    if (tid < 64) {
        int c[4]; int s = 0;
#pragma unroll
        for (int j = 0; j < 4; ++j) { c[j] = __hip_atomic_load(cnt + tid * 4 + j, __ATOMIC_RELAXED, __HIP_MEMORY_SCOPE_AGENT); s += c[j]; }
        int ps = s;
#pragma unroll
        for (int o = 1; o < 64; o <<= 1) { const int a = __shfl_up(ps, o); if (tid >= o) ps += a; }
        int es = ps - s;
#pragma unroll
        for (int j = 0; j < 4; ++j) { base[tid * 4 + j] = es; es += c[j]; }
        int run = 0;
        for (int r0 = 0; r0 < nper; r0 += 64) {
            const int i = r0 + tid;
            int tl = 0;
            if (i < nper) tl = (__hip_atomic_load(cnt + x + ngrp * i, __ATOMIC_RELAXED, __HIP_MEMORY_SCOPE_AGENT) + 255) >> 8;
            int pt = tl;
#pragma unroll
            for (int o = 1; o < 64; o <<= 1) { const int a = __shfl_up(pt, o); if (tid >= o) pt += a; }
            if (i < nper) tsx[i] = run + pt - tl;
            run += __shfl(pt, 63);
        }
        if (tid == 0) tsx[nper] = run;
    }
    __syncthreads();
}

__device__ __forceinline__ void combine_rows(const Params& p, LAS int* base, int gw, int ngw, int lane) {
    const bf16_t* sh = (const bf16_t*)(p.ws + C_SHOUT); const bf16_t* y = (const bf16_t*)(p.ws + C_Y);
    const int* tok_e = (const int*)(p.ws + C_TOKE); const int* tok_pos = (const int*)(p.ws + C_TOKPOS);
    const float* ada = (const float*)(p.ws + WS_ADA);
    for (int row = gw; row < T; row += ngw) {
        const int b = row / S;
        float acc[2][8];
#pragma unroll
        for (int hf = 0; hf < 2; ++hf) {
            const u32x4 a = *(const u32x4*)(sh + (size_t)row * 1024 + hf * 512 + lane * 8);
            acc[hf][0] = bflo(a.x); acc[hf][1] = bfhi(a.x); acc[hf][2] = bflo(a.y); acc[hf][3] = bfhi(a.y); acc[hf][4] = bflo(a.z); acc[hf][5] = bfhi(a.z); acc[hf][6] = bflo(a.w); acc[hf][7] = bfhi(a.w);
        }
#pragma unroll
        for (int k = 0; k < TOPK; ++k) {
            const int e = tok_e[(size_t)row * 8 + k], pos = tok_pos[(size_t)row * 8 + k];
            const size_t slot = (size_t)(base[e] + pos);
#pragma unroll
            for (int hf = 0; hf < 2; ++hf) {
                const u32x4 a = *(const u32x4*)(y + slot * 1024 + hf * 512 + lane * 8);
                acc[hf][0] += bflo(a.x); acc[hf][1] += bfhi(a.x); acc[hf][2] += bflo(a.y); acc[hf][3] += bfhi(a.y); acc[hf][4] += bflo(a.z); acc[hf][5] += bfhi(a.z); acc[hf][6] += bflo(a.w); acc[hf][7] += bfhi(a.w);
            }
        }
#pragma unroll
        for (int hf = 0; hf < 2; ++hf) {
            const int col = hf * 512 + lane * 8;
            float* o = p.out + (size_t)row * D + col;
            const float* g = ada + b * 6144 + 5120 + col;
#pragma unroll
            for (int q4 = 0; q4 < 2; ++q4) {
                const f32x4 x = *(const f32x4*)(o + q4 * 4), gg = *(const f32x4*)(g + q4 * 4);
                f32x4 r; r.x = x.x + gg.x * acc[hf][q4 * 4 + 0]; r.y = x.y + gg.y * acc[hf][q4 * 4 + 1]; r.z = x.z + gg.z * acc[hf][q4 * 4 + 2]; r.w = x.w + gg.w * acc[hf][q4 * 4 + 3];
                *(f32x4*)(o + q4 * 4) = r;
            }
        }
    }
}

__device__ __forceinline__ int xcd_remap(int L, int nwg) { const int q = nwg >> 3, r = nwg & 7, x = L & 7, off = L >> 3; return (x < r ? x * (q + 1) : r * (q + 1) + (x - r) * q) + off; }
__global__ void __launch_bounds__(NT) fwd_kernel(Params p) {
    extern __shared__ __attribute__((aligned(16))) unsigned char lds_raw[];
    LAS unsigned char* lds = (LAS unsigned char*)lds_raw;
    const int tid = threadIdx.x, lane = tid & 63, wid = tid >> 6;
    const int G = gridDim.x, bid = blockIdx.x;
    const int gw = bid * NWAVES + wid, ngw = G * NWAVES;
    unsigned char* ws = p.ws;
    const float* ada = (const float*)(ws + WS_ADA);
    volatile LAS unsigned* bst = (volatile LAS unsigned*)(lds + LDS_BYTES - 64);
    if (tid < 2) bst[tid] = 0u;
    __syncthreads();
    const XcdBarrier xbar = xcd_barrier_post((unsigned*)(ws + WS_CTL + 4096), bst);
    int ts_n = 0;
#if DBG_STAGE == 2
#define TSTAMP() do { if (bid == 0 && tid == 0) ((unsigned long long*)(ws + WS_CTL + 16384 + 8192))[ts_n] = __builtin_amdgcn_s_memrealtime(); ++ts_n; } while (0)
#else
#define TSTAMP() do { } while (0)
#endif
    TSTAMP();

    for (int u = bid; u < 96; u += G) ada_unit(p, lds, u, tid);
    xcd_barrier(xbar); TSTAMP();
    norm_mod_rows(p.in[0], p.in[5], ada, 0, 1024, (bf16_t*)(ws + B_H1), gw, ngw, lane);
    xcd_barrier(xbar); TSTAMP();
    {
        const RowDense RP{(const bf16_t*)(ws + B_H1), D};
        const ColDense CP{p.in[6], IN_DIM};
        const EpiProj E{(bf16_t*)(ws + B_PROJ), (float*)(ws + B_GRAW)};
        constexpr int NTN = (IN_DIM + 127) / 128;
        for (int L = bid; L < (T / 256) * NTN; L += G) { const int u = xcd_remap(L, (T / 256) * NTN), tm = u / NTN, tn = u - tm * NTN; gemm2_tile(lds, RP, CP, IN_DIM, 1024, tm * 256, tn * 128, E); }
    }
    xcd_barrier(xbar); TSTAMP();
    post_proj_rows(p, gw, ngw, lane);
    xcd_barrier(xbar); TSTAMP();
    {
        constexpr int U2 = (T / 256) * 6, U3 = (T / 256) * 8, U4 = (T / 256) * 2 * 4;
        for (int L = bid; L < U2 + U3 + U4; L += G) {
            const int u = (L < U2) ? xcd_remap(L, U2) : (L < U2 + U3) ? U2 + xcd_remap(L - U2, U3) : U2 + U3 + xcd_remap(L - U2 - U3, U4);
            if (u < U2) { const int tm = u / 6, tn = u % 6; const RowDense RP{(const bf16_t*)(ws + B_CQN), QLORA}; const ColDense CP{p.in[8], 768}; const EpiBf16 E{(bf16_t*)(ws + B_QRAW), 768};
                gemm2_tile(lds, RP, CP, 768, QLORA, tm * 256, tn * 128, E); }
            else if (u < U2 + U3) { const int v = u - U2, tm = v / 8, tn = v % 8; const RowDense RP{(const bf16_t*)(ws + B_CKVN), KVLORA}; const ColDense CP{p.in[10], 1024}; const EpiBf16 E{(bf16_t*)(ws + B_KVRAW), 1024};
                gemm2_tile(lds, RP, CP, 1024, KVLORA, tm * 256, tn * 128, E); }
            else { const int v = u - U2 - U3, tm = v / 8, r = v % 8, h = r >> 1, tn = r & 1; const RowDense RP{(const bf16_t*)(ws + B_ZC) + h * DM, MINNER};
                const ColMqk CP{p.in[16] + (size_t)h * DM * DM, (p.in[17] + (size_t)h * DM * DM) - (p.in[16] + (size_t)h * DM * DM)};
                const EpiMqk E{(bf16_t*)(ws + B_MQ), (bf16_t*)(ws + B_MK), h};
                gemm2_tile(lds, RP, CP, DM, DM, tm * 256, tn * 128, E); }
        }
    }
    xcd_barrier(xbar); TSTAMP();
    qk_post_rows(p, gw, ngw, lane);
    xcd_barrier(xbar); TSTAMP();
    for (int pr = bid; pr < 256; pr += G) { const int bh = pr & 63, j = pr >> 6; attn_unit(p, lds, bh, 7 - j); attn_unit(p, lds, bh, j); }
    for (int u = bid; u < 1024; u += G) mlstm_a_unit(p, lds, u);
    xcd_barrier(xbar); TSTAMP();
    mlstm_scan(p, bid * NT + tid, G * NT);
    attn_out_norm_rows(p, gw, ngw, lane);
    xcd_barrier(xbar); TSTAMP();
    for (int u = bid; u < 1024; u += G) mlstm_c_unit(p, lds, u);
    xcd_barrier(xbar); TSTAMP();
    {
        const RowDense RP{(const bf16_t*)(ws + B_AO), 1024};
        const ColDense CP{p.in[21], 1024};
        const EpiResid E{p.in[0], ada, 2048, p.out};
        for (int L = bid; L < (T / 256) * 8; L += G) { const int u = xcd_remap(L, (T / 256) * 8), tm = u >> 3, tn = u & 7; gemm2_tile(lds, RP, CP, 1024, 1024, tm * 256, tn * 128, E); }
    }
    xcd_barrier(xbar); TSTAMP();
    norm_mod_rows(p.out, p.in[22], ada, 3072, 4096, (bf16_t*)(ws + C_H2), gw, ngw, lane);
    xcd_barrier(xbar); TSTAMP();
    {
        const RowDense RP{(const bf16_t*)(ws + C_H2), 1024};
        const ColRgu CP{p.in[23], p.in[28] - p.in[23], p.in[29] - p.in[23]};
        const EpiRgu E{(float*)(ws + C_LOGITS), (bf16_t*)(ws + C_ACTSH)};
        for (int L = bid; L < (T / 256) * 6; L += G) { const int u = xcd_remap(L, (T / 256) * 6), tm = u / 6, tn = u % 6; gemm2_tile(lds, RP, CP, 256, 1024, tm * 256, tn * 128, E); }
    }
    xcd_barrier(xbar); TSTAMP();
    route_rows(p, gw, ngw, lane);
    {
        const RowDense RP{(const bf16_t*)(ws + C_ACTSH), 256};
        const ColDense CP{p.in[30], 1024};
        const EpiBf16 E{(bf16_t*)(ws + C_SHOUT), 1024};
        for (int L = bid; L < (T / 256) * 8; L += G) { const int u = xcd_remap(L, (T / 256) * 8), tm = u >> 3, tn = u & 7; gemm2_tile(lds, RP, CP, 1024, 256, tm * 256, tn * 128, E); }
    }
    xcd_barrier(xbar); TSTAMP();
    LAS int* base = (LAS int*)(lds + 124 * 1024);
    LAS int* tsx = base + 256;
    const int ngrp = (G % 8 == 0) ? 8 : 1, gx = bid % ngrp, gidx = bid / ngrp, gper = G / ngrp, nexp = NE / ngrp;
    expert_prefix(p, base, tsx, tid, gx, ngrp);
    {
        const int* cnt = (const int*)(ws + WS_CTL);
        const int ntile = tsx[nexp];
        for (int u = gidx; u < ntile * 4; u += gper) {
            const int tg = u >> 2, tn = u & 3;
            int lo = 0, hi = nexp - 1;
            while (lo < hi) { const int mid = (lo + hi + 1) >> 1; if (tsx[mid] <= tg) lo = mid; else hi = mid - 1; }
            const int e = gx + ngrp * lo, blk = tg - tsx[lo], c = __hip_atomic_load(cnt + e, __ATOMIC_RELAXED, __HIP_MEMORY_SCOPE_AGENT);
            const int nvalid = min(256, c - blk * 256);
            const RowGather RP{(const bf16_t*)(ws + C_H2), (const int*)(ws + C_LISTTOK) + (size_t)e * CAP + blk * 256, nvalid};
            const ColGU CP{p.in[25] + (size_t)e * 1024 * 256, p.in[26] - p.in[25]};
            const EpiExpAct E{(bf16_t*)(ws + C_ACTE), base[e] + blk * 256, nvalid};
            gemm2_tile(lds, RP, CP, 256, 1024, 0, tn * 128, E, nvalid);
        }
    }
    xcd_barrier(xbar); TSTAMP();
    {
        const int* cnt = (const int*)(ws + WS_CTL);
        const int ntile = tsx[nexp];
        for (int u = gidx; u < ntile * 8; u += gper) {
            const int tg = u >> 3, tn = u & 7;
            int lo = 0, hi = nexp - 1;
            while (lo < hi) { const int mid = (lo + hi + 1) >> 1; if (tsx[mid] <= tg) lo = mid; else hi = mid - 1; }
            const int e = gx + ngrp * lo, blk = tg - tsx[lo], c = __hip_atomic_load(cnt + e, __ATOMIC_RELAXED, __HIP_MEMORY_SCOPE_AGENT);
            const int nvalid = min(256, c - blk * 256);
            const int slot0 = base[e] + blk * 256;
            const RowSlots RP{(const bf16_t*)(ws + C_ACTE) + (size_t)slot0 * EDIM, nvalid};
            const ColDense CP{p.in[27] + (size_t)e * 256 * 1024, 1024};
            const EpiExpDown E{(bf16_t*)(ws + C_Y), (const float*)(ws + C_LISTW) + (size_t)e * CAP + blk * 256, slot0, nvalid};
            gemm2_tile(lds, RP, CP, 1024, 256, 0, tn * 128, E, nvalid);
        }
    }
    xcd_barrier(xbar); TSTAMP();
    combine_rows(p, base, gw, ngw, lane);
#if DBG_STAGE == 2
    xcd_barrier(xbar); TSTAMP();
    xcd_barrier(xbar);
    {
        const unsigned long long* ts = (const unsigned long long*)(ws + WS_CTL + 16384 + 8192);
        const float tus = (float)(long long)(ts[TS_A1] - ts[TS_A0]) * 0.01f;
        const float cadd = sqrtf(2.5e-3f * tus * (1.f / 500.f));
        for (size_t i = (size_t)bid * NT + tid; i < (size_t)T * D / 4; i += (size_t)G * NT) { f32x4 v = ((f32x4*)p.out)[i]; v = v + cadd; ((f32x4*)p.out)[i] = v; }
    }
#endif
}

extern "C" void kernel_launch(void* const* d_in, const int* in_sizes, int n_in,
                              void* d_out, int out_size, void* d_ws, size_t ws_size,
                              hipStream_t stream) {
    static int grid_blocks = 0;
    if (!grid_blocks) {
        if (n_in != 31 || out_size != T * D || ws_size < WS_END) { fprintf(stderr, "kernel_launch: unexpected shapes n_in=%d out=%d ws=%zu (need %zu)\n", n_in, out_size, ws_size, (size_t)WS_END); grid_blocks = -1; return; }
        int dev = 0, cus = 0, per_cu = 0;
        (void)hipGetDevice(&dev);
        (void)hipDeviceGetAttribute(&cus, hipDeviceAttributeMultiprocessorCount, dev);
        (void)hipFuncSetAttribute((const void*)fwd_kernel, hipFuncAttributeMaxDynamicSharedMemorySize, LDS_BYTES);
        (void)hipOccupancyMaxActiveBlocksPerMultiprocessor(&per_cu, (const void*)fwd_kernel, NT, LDS_BYTES);
        if (per_cu < 1) per_cu = 1;
        grid_blocks = cus * per_cu;
        fprintf(stderr, "kernel_launch: cus=%d per_cu=%d grid=%d ws=%zu\n", cus, per_cu, grid_blocks, ws_size);
    }
    if (grid_blocks < 0) return;
    (void)hipMemsetAsync((char*)d_ws + WS_CTL, 0, CTL_BYTES, stream);
    Params p{};
    for (int i = 0; i < 31; ++i) p.in[i] = (const float*)d_in[i];
    p.out = (float*)d_out; p.ws = (unsigned char*)d_ws;
    void* args[] = {&p};
    hipError_t e = hipLaunchCooperativeKernel((const void*)fwd_kernel, dim3(grid_blocks), dim3(NT), args, LDS_BYTES, stream);
    if (e != hipSuccess) fprintf(stderr, "cooperative launch failed: %s (grid %d)\n", hipGetErrorString(e), grid_blocks);
}
```

```cpp
#include <hip/hip_runtime.h>
#include <hip/hip_cooperative_groups.h>
#include <cstdio>
#include <cstdint>
namespace cg = cooperative_groups;
#ifndef DBG_STAGE
#define DBG_STAGE 0
#endif
#define TS_A0 0
#define TS_A1 1
#define TS_B0 2
#define TS_B1 3

#define LAS __attribute__((address_space(3)))
typedef unsigned short bf16_t;
typedef short bf16x8 __attribute__((ext_vector_type(8)));
typedef short bf16x4 __attribute__((ext_vector_type(4)));
typedef float f32x4 __attribute__((ext_vector_type(4)));
typedef float f32x2 __attribute__((ext_vector_type(2)));
typedef unsigned u32x4 __attribute__((ext_vector_type(4)));
typedef unsigned u32x2 __attribute__((ext_vector_type(2)));

constexpr int NT = 512, NWAVES = 8;
constexpr int LDS_BYTES = 144 * 1024;
constexpr int Bsz = 8, S = 2048, D = 1024, T = Bsz * S;
constexpr int H_MLA = 8, DQK = 96, DNOPE = 64, DROPE = 32, DV = 64, QLORA = 384, KVLORA = 256;
constexpr int H_ML = 4, DM = 128, MINNER = 512, CHUNK = 64, NCH = S / CHUNK;
constexpr int IN_DIM = 2216;
constexpr int OFF_CQ = 0, OFF_CKV = 384, OFF_KR = 640, OFF_Z = 672, OFF_MV = 1184, OFF_MO = 1696, OFF_GATE = 2208;
constexpr int NE = 256, TOPK = 8, EDIM = 256, SDIM = 256;
constexpr int CAP = T;
constexpr float RMS_EPS = 1e-6f;

constexpr size_t MiB = 1u << 20;
constexpr size_t WS_CTL = 0;
constexpr size_t CTL_BYTES = 32768;
constexpr size_t WS_ADA = 1 * MiB;
constexpr size_t WS_BC = 2 * MiB;
constexpr size_t WS_MLOC = WS_BC + 8192;
constexpr size_t WS_MPREV = WS_BC + 16384;
constexpr size_t WS_DN = 2 * MiB + 512 * 1024;
constexpr size_t WS_NPREV = 3 * MiB;
constexpr size_t WS_WIN = 4 * MiB;
constexpr size_t WS_WUQ = 9 * MiB;
constexpr size_t WS_WUKV = 10 * MiB;
constexpr size_t WS_WMQK = 11 * MiB;
constexpr size_t WS_WOUT = 12 * MiB;
constexpr size_t WS_WRGU = 14 * MiB;
constexpr size_t WS_WDSH = 16 * MiB;
constexpr size_t WS_WGU = 32 * MiB;
constexpr size_t WS_WD = 288 * MiB;
constexpr size_t RB = 416 * MiB;
constexpr size_t B_PROJ = RB;
constexpr size_t B_GRAW = RB + 70 * MiB;
constexpr size_t B_GL = RB + 71 * MiB;
constexpr size_t B_H1 = RB + 72 * MiB;
constexpr size_t B_CQN = RB + 104 * MiB;
constexpr size_t B_CKVN = RB + 116 * MiB;
constexpr size_t B_ZC = RB + 124 * MiB;
constexpr size_t B_QRAW = RB + 140 * MiB;
constexpr size_t B_KVRAW = RB + 164 * MiB;
constexpr size_t B_MQ = RB + 196 * MiB;
constexpr size_t B_MK = RB + 212 * MiB;
constexpr size_t B_Q = RB + 228 * MiB;
constexpr size_t B_K = RB + 252 * MiB;
constexpr size_t B_ORAW = RB + 276 * MiB;
constexpr size_t B_AO = RB + 292 * MiB;
constexpr size_t B_DC = RB + 324 * MiB;
constexpr size_t B_CPREV = RB + 388 * MiB;
constexpr size_t C_H2 = RB;
constexpr size_t C_LOGITS = RB + 32 * MiB;
constexpr size_t C_ACTSH = RB + 48 * MiB;
constexpr size_t C_SHOUT = RB + 56 * MiB;
constexpr size_t C_TOKE = RB + 88 * MiB;
constexpr size_t C_TOKW = RB + 89 * MiB;
constexpr size_t C_TOKPOS = RB + 90 * MiB;
constexpr size_t C_LISTTOK = RB + 92 * MiB;
constexpr size_t C_LISTW = RB + 108 * MiB;
constexpr size_t C_ACTE = RB + 124 * MiB;
constexpr size_t C_Y = RB + 188 * MiB;
constexpr size_t WS_END = RB + 444 * MiB;

struct Params {
    const float* in[31];
    float* out;
    unsigned char* ws;
};

typedef __bf16 bf16x2v __attribute__((ext_vector_type(2)));
__device__ __forceinline__ unsigned cvt_pk_bf16(float lo, float hi) { f32x2 v = {lo, hi}; bf16x2v b = __builtin_convertvector(v, bf16x2v); return __builtin_bit_cast(unsigned, b); }
__device__ __forceinline__ float bf2f(unsigned short b) { return __uint_as_float((unsigned)b << 16); }
__device__ __forceinline__ float bflo(unsigned u) { return __uint_as_float(u << 16); }
__device__ __forceinline__ float bfhi(unsigned u) { return __uint_as_float(u & 0xffff0000u); }
__device__ __forceinline__ float wave_sum(float v) {
#pragma unroll
    for (int o = 1; o < 64; o <<= 1) v += __shfl_xor(v, o);
    return v;
}
__device__ __forceinline__ float wave_max(float v) {
#pragma unroll
    for (int o = 1; o < 64; o <<= 1) v = fmaxf(v, __shfl_xor(v, o));
    return v;
}
__device__ __forceinline__ float sigmoidf_(float x) { return 1.f / (1.f + __expf(-x)); }
__device__ __forceinline__ float siluf_(float x) { return x / (1.f + __expf(-x)); }
__device__ __forceinline__ int fresh_tid() { int t = threadIdx.x; asm volatile("" : "+v"(t)); return t; }
#define MFMA16(a, b, c) __builtin_amdgcn_mfma_f32_16x16x32_bf16((a), (b), (c), 0, 0, 0)


#define XB_TMO      128
#define XB_XCNT(j)  (256  + 64 * (j))
#define XB_XSUB(j)  (1280 + 64 * (j))
#define XB_XGEN(j)  (2304 + 64 * (j))
#define XB_TOP      3328
#define XB_TOPGEN   3392
#define XCD_BAR_WORDS 3456
#define XB_SPIN_CAP (1u << 23)
__device__ __forceinline__ unsigned xb_ld(unsigned* p)              { return __hip_atomic_load(p, __ATOMIC_RELAXED, __HIP_MEMORY_SCOPE_AGENT); }
__device__ __forceinline__ unsigned xb_add(unsigned* p, unsigned v) { return __hip_atomic_fetch_add(p, v, __ATOMIC_RELAXED, __HIP_MEMORY_SCOPE_AGENT); }
__device__ __forceinline__ unsigned xb_xcc_id() { return (unsigned)__builtin_amdgcn_s_getreg((3 << 11) | 20) & 0xFu; }
#define XB_SPIN(cond, bar) do { unsigned _sp = 0; while (cond) { __builtin_amdgcn_s_sleep(1); \
    if ((++_sp & 255u) == 0u) { if (xb_ld(&(bar)[XB_TMO])) break; if (_sp > XB_SPIN_CAP) { atomicAdd(&(bar)[XB_TMO], 1u); break; } } } } while (0)
struct XcdBarrier { unsigned* bar; unsigned x; volatile LAS unsigned* st; };
__device__ __forceinline__ XcdBarrier xcd_barrier_post(unsigned* bar, volatile LAS unsigned* st) {
    XcdBarrier b; b.bar = bar; b.x = xb_xcc_id(); b.st = st;
    if (threadIdx.x == 0) (void)xb_add(&bar[XB_XCNT(b.x)], 1u);
    return b;
}
__device__ __forceinline__ void xcd_barrier_complete(unsigned* bar, unsigned x, unsigned& nloc, unsigned& nx) {
    const unsigned G = gridDim.x * gridDim.y * gridDim.z;
    unsigned sum, cnt, mine, sp = 0u;
    for (;;) {
        sum = 0u; cnt = 0u; mine = 0u;
#pragma unroll
        for (unsigned j = 0; j < 16; ++j) { const unsigned c = xb_ld(&bar[XB_XCNT(j)]); sum += c; cnt += (c > 0u) ? 1u : 0u; mine = (j == x) ? c : mine; }
        if (sum == G) break;
        __builtin_amdgcn_s_sleep(1);
        if ((++sp & 255u) == 0u) { if (xb_ld(&bar[XB_TMO])) break; if (sp > XB_SPIN_CAP) { atomicAdd(&bar[XB_TMO], 1u); break; } }
    }
    nloc = mine > 0u ? mine : 1u; nx = cnt > 0u ? cnt : 1u;
}
__device__ __forceinline__ void xcd_barrier(const XcdBarrier& b) {
    asm volatile("s_waitcnt vmcnt(0)" ::: "memory");
    __syncthreads();
    if (threadIdx.x == 0) {
        unsigned* bar = b.bar;
        __builtin_amdgcn_s_waitcnt(0);
        unsigned nloc = b.st[0], nx = b.st[1];
        if (nloc == 0u) { xcd_barrier_complete(bar, b.x, nloc, nx); b.st[0] = nloc; b.st[1] = nx; }
        const unsigned old = xb_add(&bar[XB_XSUB(b.x)], 1u);
        const unsigned gen = old / nloc;
        if (old + 1u == (gen + 1u) * nloc) {
            __builtin_amdgcn_fence(__ATOMIC_RELEASE, "agent");
            asm volatile("s_waitcnt vmcnt(0)" ::: "memory");
            const unsigned og = xb_add(&bar[XB_TOP], 1u);
            const unsigned tg = og / nx;
            if (og + 1u == (tg + 1u) * nx) xb_add(&bar[XB_TOPGEN], 1u);
            else XB_SPIN(xb_ld(&bar[XB_TOPGEN]) == tg, bar);
            __builtin_amdgcn_fence(__ATOMIC_ACQUIRE, "agent");
            xb_add(&bar[XB_XGEN(b.x)], 1u);
            asm volatile("s_waitcnt vmcnt(0)" ::: "memory");
        } else {
            XB_SPIN(xb_ld(&bar[XB_XGEN(b.x)]) == gen, bar);
            __builtin_amdgcn_fence(__ATOMIC_ACQUIRE, "agent");
            asm volatile("s_waitcnt vmcnt(0)" ::: "memory");
        }
    }
    __syncthreads();
}

template <int MAP>
__device__ __forceinline__ int map_row(int n) {
    if (MAP == 0) return n;
    if (MAP == 1) return ((n >> 4) << 5) + (n & 15);
    return ((n >> 4) << 5) + 16 + (n & 15);
}
template <int MAP>
__device__ __forceinline__ void conv_item(const float* src, int K, int N, bf16_t* dst, size_t dst_mat_stride, int row_off, LAS float* scr, int it, int lane) {
    const int nblk = (N + 31) / 32, kblk = K / 64, per = nblk * kblk;
    const int mat = it / per, r = it - mat * per, kb = r / nblk, nb = r - kb * nblk, k0 = kb * 64, n0 = nb * 32;
    const float* W = src + (size_t)mat * K * N;
    bf16_t* WT = dst + (size_t)mat * dst_mat_stride;
    const int nn = n0 + (lane & 31);
    const bool nok = nn < N;
    float v[32];
    const float* wp = W + (size_t)(k0 + (lane >> 5)) * N + nn;
#pragma unroll
    for (int i = 0; i < 32; ++i) v[i] = nok ? wp[(size_t)(2 * i) * N] : 0.f;
#pragma unroll
    for (int i = 0; i < 32; ++i) scr[(2 * i + (lane >> 5)) * 33 + (lane & 31)] = v[i];
    asm volatile("s_waitcnt lgkmcnt(0)" ::: "memory");
    const int c = lane & 7;
#pragma unroll
    for (int j = 0; j < 4; ++j) {
        const int n = (lane >> 3) + 8 * j;
        const LAS float* sp = scr + (8 * c) * 33 + n;
        u32x4 o; o.x = cvt_pk_bf16(sp[0 * 33], sp[1 * 33]); o.y = cvt_pk_bf16(sp[2 * 33], sp[3 * 33]); o.z = cvt_pk_bf16(sp[4 * 33], sp[5 * 33]); o.w = cvt_pk_bf16(sp[6 * 33], sp[7 * 33]);
        if (n0 + n < N) *(u32x4*)(WT + (size_t)(row_off + map_row<MAP>(n0 + n)) * K + k0 + 8 * c) = o;
    }
    asm volatile("s_waitcnt lgkmcnt(0)" ::: "memory");
}

__device__ __forceinline__ void ada_unit(const Params& p, LAS unsigned char* lds, int u, int tid) {
    LAS float* cond = (LAS float*)lds;
    LAS float* red = (LAS float*)(lds + 32768);
    const float* c = p.in[1]; const float* w = p.in[3]; const float* bias = p.in[4];
    float* ada = (float*)(p.ws + WS_ADA);
    const int lane = tid & 63, wv = tid >> 6;
    for (int i = tid; i < 8 * 1024; i += NT) cond[i] = siluf_(c[i]);
    __syncthreads();
    float acc[8];
#pragma unroll
    for (int b = 0; b < 8; ++b) acc[b] = 0.f;
    const int col = u * 64 + lane;
#pragma unroll 16
    for (int k = wv * 128; k < wv * 128 + 128; ++k) {
        const float wv_ = w[(size_t)k * 6144 + col];
#pragma unroll
        for (int b = 0; b < 8; ++b) acc[b] += cond[b * 1024 + k] * wv_;
    }
#pragma unroll
    for (int b = 0; b < 8; ++b) red[(wv * 8 + b) * 64 + lane] = acc[b];
    __syncthreads();
    {
        const int b = tid >> 6;
        float s = 0.f;
#pragma unroll
        for (int w2 = 0; w2 < 8; ++w2) s += red[(w2 * 8 + b) * 64 + lane];
        ada[b * 6144 + col] = s + bias[col];
    }
    __syncthreads();
}

__device__ __forceinline__ void norm_mod_rows(const float* X, const float* g, const float* ada, int sh_off, int sc_off, bf16_t* Hout, int gw, int ngw, int lane) {
    for (int row = gw; row < T; row += ngw) {
        const int b = row / S;
        const f32x4* xr = (const f32x4*)(X + (size_t)row * D) + lane;
        f32x4 v[4]; float ss = 0.f;
#pragma unroll
        for (int j = 0; j < 4; ++j) { v[j] = xr[64 * j]; ss += v[j].x * v[j].x + v[j].y * v[j].y + v[j].z * v[j].z + v[j].w * v[j].w; }
        const float rinv = rsqrtf(wave_sum(ss) * (1.f / D) + RMS_EPS);
        u32x2* o = (u32x2*)(Hout + (size_t)row * D) + lane;
#pragma unroll
        for (int j = 0; j < 4; ++j) {
            const int k = 4 * (lane + 64 * j);
            const f32x4 gg = *(const f32x4*)(g + k), sc = *(const f32x4*)(ada + b * 6144 + sc_off + k), sh = *(const f32x4*)(ada + b * 6144 + sh_off + k);
            const f32x4 h = v[j] * rinv * gg * (1.f + sc) + sh;
            u32x2 w; w.x = cvt_pk_bf16(h.x, h.y); w.y = cvt_pk_bf16(h.z, h.w);
            o[64 * j] = w;
        }
    }
}

__device__ __forceinline__ void post_proj_rows(const Params& p, int gw, int ngw, int lane) {
    const bf16_t* proj = (const bf16_t*)(p.ws + B_PROJ);
    const float* graw = (const float*)(p.ws + B_GRAW);
    float* gl = (float*)(p.ws + B_GL);
    bf16_t* cqn = (bf16_t*)(p.ws + B_CQN); bf16_t* ckvn = (bf16_t*)(p.ws + B_CKVN); bf16_t* zc = (bf16_t*)(p.ws + B_ZC);
    const float* g_cq = p.in[7]; const float* g_ckv = p.in[9]; const float* conv_w = p.in[14]; const float* conv_b = p.in[15];
    const float* b_i = p.in[18]; const float* b_f = p.in[19];
    for (int row = gw; row < T; row += ngw) {
        const bf16_t* pr = proj + (size_t)row * IN_DIM;
        const int s = row % S;
        {
            const unsigned* q = (const unsigned*)(pr + OFF_CQ) + lane * 3;
            unsigned a0 = q[0], a1 = q[1], a2 = q[2];
            float f[6] = {bflo(a0), bfhi(a0), bflo(a1), bfhi(a1), bflo(a2), bfhi(a2)};
            float ss = 0.f;
#pragma unroll
            for (int j = 0; j < 6; ++j) ss += f[j] * f[j];
            const float rinv = rsqrtf(wave_sum(ss) * (1.f / QLORA) + RMS_EPS);
            const float* gq = g_cq + lane * 6;
            unsigned* o = (unsigned*)(cqn + (size_t)row * QLORA) + lane * 3;
            o[0] = cvt_pk_bf16(f[0] * rinv * gq[0], f[1] * rinv * gq[1]);
            o[1] = cvt_pk_bf16(f[2] * rinv * gq[2], f[3] * rinv * gq[3]);
            o[2] = cvt_pk_bf16(f[4] * rinv * gq[4], f[5] * rinv * gq[5]);
        }
        {
            const u32x2 a = *((const u32x2*)(pr + OFF_CKV) + lane);
            float f[4] = {bflo(a.x), bfhi(a.x), bflo(a.y), bfhi(a.y)};
            float ss = f[0] * f[0] + f[1] * f[1] + f[2] * f[2] + f[3] * f[3];
            const float rinv = rsqrtf(wave_sum(ss) * (1.f / KVLORA) + RMS_EPS);
            const float* gk = g_ckv + lane * 4;
            u32x2 w; w.x = cvt_pk_bf16(f[0] * rinv * gk[0], f[1] * rinv * gk[1]); w.y = cvt_pk_bf16(f[2] * rinv * gk[2], f[3] * rinv * gk[3]);
            *((u32x2*)(ckvn + (size_t)row * KVLORA) + lane) = w;
        }
        {
            const int c0 = lane * 8;
            float acc[8];
#pragma unroll
            for (int j = 0; j < 8; ++j) acc[j] = conv_b[c0 + j];
#pragma unroll
            for (int tap = 0; tap < 4; ++tap) {
                const int ds = tap - 3;
                if (s + ds >= 0) {
                    const u32x4 z = *(const u32x4*)(pr + (ptrdiff_t)ds * IN_DIM + OFF_Z + c0);
                    const float* cw = conv_w + tap * MINNER + c0;
                    acc[0] += bflo(z.x) * cw[0]; acc[1] += bfhi(z.x) * cw[1]; acc[2] += bflo(z.y) * cw[2]; acc[3] += bfhi(z.y) * cw[3];
                    acc[4] += bflo(z.z) * cw[4]; acc[5] += bfhi(z.z) * cw[5]; acc[6] += bflo(z.w) * cw[6]; acc[7] += bfhi(z.w) * cw[7];
                }
            }
            u32x4 o; o.x = cvt_pk_bf16(siluf_(acc[0]), siluf_(acc[1])); o.y = cvt_pk_bf16(siluf_(acc[2]), siluf_(acc[3]));
            o.z = cvt_pk_bf16(siluf_(acc[4]), siluf_(acc[5])); o.w = cvt_pk_bf16(siluf_(acc[6]), siluf_(acc[7]));
            *(u32x4*)(zc + (size_t)row * MINNER + c0) = o;
        }
        if (lane < 8) {
            const float gr = graw[(size_t)row * 8 + lane];
            float o;
            if (lane < 4) o = gr + b_i[lane];
            else { const float xx = gr + b_f[lane - 4]; o = fminf(xx, 0.f) - log1pf(__expf(-fabsf(xx))); }
            gl[(size_t)row * 8 + lane] = o;
        }
    }
}

__device__ __forceinline__ void qk_post_rows(const Params& p, int gw, int ngw, int lane) {
    const bf16_t* qraw = (const bf16_t*)(p.ws + B_QRAW); const bf16_t* kvraw = (const bf16_t*)(p.ws + B_KVRAW);
    const bf16_t* proj = (const bf16_t*)(p.ws + B_PROJ);
    bf16_t* Q = (bf16_t*)(p.ws + B_Q); bf16_t* Kb = (bf16_t*)(p.ws + B_K);
    const int* positions = (const int*)p.in[2];
    const float* g_qn = p.in[11]; const float* g_kn = p.in[12];
    const float qscale = 0.10206207261596575f * 1.4426950408889634f;
    for (int it = gw; it < T * 4; it += ngw) {
        const int row = it >> 2, hp = it & 3, h = hp * 2 + (lane >> 5), l = lane & 31;
        const int b = row / S, s = row % S;
        const float pos = (float)positions[row];
        const int i = l & 15;
        const float inv_freq = exp2f(-(float)(2 * i) * (13.287712379549449f / 32.f));
        const float ang = pos * inv_freq;
        float sn, cs; sincosf(ang, &sn, &cs);
        {
            const bf16_t* qr = qraw + (size_t)row * 768 + h * 96;
            float v0 = bf2f(qr[l]), v1 = bf2f(qr[l + 32]), v2 = bf2f(qr[l + 64]);
            float ss = v0 * v0 + v1 * v1 + v2 * v2;
#pragma unroll
            for (int o = 1; o < 32; o <<= 1) ss += __shfl_xor(ss, o);
            const float rinv = rsqrtf(ss * (1.f / 96.f) + RMS_EPS);
            v0 *= rinv * g_qn[l]; v1 *= rinv * g_qn[l + 32]; v2 *= rinv * g_qn[l + 64];
            const float other = __shfl_xor(v2, 16);
            const float r = (l < 16) ? (v2 * cs - other * sn) : (other * sn + v2 * cs);
            bf16_t* qo = Q + ((size_t)(b * H_MLA + h) * S + s) * 96;
            qo[l] = (bf16_t)(cvt_pk_bf16(v0 * qscale, 0.f) & 0xffff);
            qo[l + 32] = (bf16_t)(cvt_pk_bf16(v1 * qscale, 0.f) & 0xffff);
            qo[l + 64] = (bf16_t)(cvt_pk_bf16(r * qscale, 0.f) & 0xffff);
        }
        {
            const bf16_t* kr = kvraw + (size_t)row * 1024 + h * 128;
            float v0 = bf2f(kr[l]), v1 = bf2f(kr[l + 32]), v2 = bf2f(proj[(size_t)row * IN_DIM + OFF_KR + l]);
            float ss = v0 * v0 + v1 * v1 + v2 * v2;
#pragma unroll
            for (int o = 1; o < 32; o <<= 1) ss += __shfl_xor(ss, o);
            const float rinv = rsqrtf(ss * (1.f / 96.f) + RMS_EPS);
            v0 *= rinv * g_kn[l]; v1 *= rinv * g_kn[l + 32]; v2 *= rinv * g_kn[l + 64];
            const float other = __shfl_xor(v2, 16);
            const float r = (l < 16) ? (v2 * cs - other * sn) : (other * sn + v2 * cs);
            bf16_t* ko = Kb + ((size_t)(b * H_MLA + h) * S + s) * 96;
            ko[l] = (bf16_t)(cvt_pk_bf16(v0, 0.f) & 0xffff);
            ko[l + 32] = (bf16_t)(cvt_pk_bf16(v1, 0.f) & 0xffff);
            ko[l + 64] = (bf16_t)(cvt_pk_bf16(r, 0.f) & 0xffff);
        }
    }
}

__device__ __forceinline__ void attn_out_norm_rows(const Params& p, int gw, int ngw, int lane) {
    const bf16_t* oraw = (const bf16_t*)(p.ws + B_ORAW); bf16_t* ao = (bf16_t*)(p.ws + B_AO); const float* g = p.in[13];
    for (int row = gw; row < T; row += ngw) {
        const u32x4 a = *((const u32x4*)(oraw + (size_t)row * 512) + lane);
        float f[8] = {bflo(a.x), bfhi(a.x), bflo(a.y), bfhi(a.y), bflo(a.z), bfhi(a.z), bflo(a.w), bfhi(a.w)};
        float ss = 0.f;
#pragma unroll
        for (int j = 0; j < 8; ++j) ss += f[j] * f[j];
        const float rinv = rsqrtf(wave_sum(ss) * (1.f / 512.f) + RMS_EPS);
        const float* gg = g + lane * 8;
        u32x4 o; o.x = cvt_pk_bf16(f[0] * rinv * gg[0], f[1] * rinv * gg[1]); o.y = cvt_pk_bf16(f[2] * rinv * gg[2], f[3] * rinv * gg[3]);
        o.z = cvt_pk_bf16(f[4] * rinv * gg[4], f[5] * rinv * gg[5]); o.w = cvt_pk_bf16(f[6] * rinv * gg[6], f[7] * rinv * gg[7]);
        *((u32x4*)(ao + (size_t)row * 1024) + lane) = o;
    }
}

namespace pg8 {
#define PG8_LAS __attribute__((address_space(3)))
typedef unsigned short bf16_t;
typedef short bf16x8 __attribute__((ext_vector_type(8)));
typedef float f32x4 __attribute__((ext_vector_type(4)));
typedef unsigned u32x4 __attribute__((ext_vector_type(4)));
constexpr int BM = 256, BK = 64, HALF = 128, HTB = HALF * BK * 2  , STAGE_BYTES = 8 * HTB, NXCD = 8, WGM = 8;

__host__ __device__ __forceinline__ int lds_byte(int r, int c) { const int st = (r >> 4) * 2 + (c >> 5), rr = r & 15, cc = c & 31, ob = rr * 64 + cc * 2; return st * 1024 + (ob ^ (((ob >> 9) & 1) << 5)); }
__host__ __device__ __forceinline__ void stage_rc(int b, int& R, int& C) { const int st = b / 1024, sb = b % 1024, swz = sb ^ (((sb >> 9) & 1) << 5); R = (st >> 1) * 16 + swz / 64; C = (st & 1) * 32 + (swz % 64) / 2; }
__host__ __device__ __forceinline__ int perm32(int rho) { const int n = rho >> 4, i = rho & 15; return 8 * (i >> 2) + 4 * n + (i & 3); }

struct Unit { int pm, pn; };
struct Gemm { const bf16_t* A; const bf16_t* Bt; int M, N, K, lda, ldb, apn; };

struct StaticOrder {
    int nM, nN, nwg, G, c;
    __host__ __device__ void init(int M, int N, int G_, int c_) { nM = M / BM; nN = N / BM; nwg = nM * nN; G = G_; c = c_; }
    __host__ __device__ bool next(int i, Unit& u) const {
        const long L = (long)i * G + c; if (L >= nwg) return false;
        int wgid = (int)L; { const int q = nwg / NXCD, r = nwg % NXCD, xcd = wgid % NXCD, off = wgid / NXCD; wgid = (xcd < r ? xcd * (q + 1) : r * (q + 1) + (xcd - r) * q) + off; }
        const int nig = WGM * nN, gid = wgid / nig, fm = gid * WGM, gsz = (nM - fm) < WGM ? (nM - fm) : WGM;
        u.pm = fm + ((wgid % nig) % gsz); u.pn = (wgid % nig) / gsz; return true;
    }
    __device__ __forceinline__ void a_ready(const Unit&) const {}
    __device__ __forceinline__ void done(const Unit&) const {}
};


template <class Epi, class Sched, bool ALIGN_EPI = false, bool SP2 = false>
__device__ __forceinline__ void gemm_phase(PG8_LAS unsigned char* lds, const Gemm g, const Sched& S, const Epi& E) {
    const int tid = fresh_tid(), wid = __builtin_amdgcn_readfirstlane(tid >> 6), lane = tid & 63, wr = wid >> 2, wc = wid & 3, fr = lane & 15, fq = lane >> 4;
    const int K = g.K, nt = K / BK;
    unsigned voffA[2], voffB[2];
#pragma unroll
    for (int i = 0; i < 2; ++i) { int R, C; stage_rc(tid * 16 + i * 8192, R, C); const int Rb = Epi::PERM ? ((R & ~31) + perm32(R & 31)) : R;
        voffA[i] = (unsigned)(R * g.lda + C) * 2u; voffB[i] = (unsigned)(Rb * g.ldb + C) * 2u; }
    const size_t kstep = (size_t)(BK * 2);
    const size_t hstepA = (size_t)HALF * g.lda * 2, hstepB = (size_t)HALF * g.ldb * 2;
    const size_t tstepA = 2 * hstepA, tstepB = 2 * hstepB;
    const unsigned ldsw = (unsigned)wid * 1024u;
    const int aoff = lds_byte(wr * 64 + fr, fq * 8), boff = lds_byte(wc * 32 + fr, fq * 8);
#define PG8_SA(b, h) (((b) * 2 + (h)) * HTB)
#define PG8_SB(b, h) ((4 + (b) * 2 + (h)) * HTB)
#define PG8_STAGE(bufoff, gbase, voff) do { _Pragma("unroll") for (int _i = 0; _i < 2; ++_i) \
        __builtin_amdgcn_global_load_lds((const unsigned*)((const char*)(gbase) + (voff)[_i]), (PG8_LAS unsigned*)(lds + (bufoff) + ldsw + _i * 8192), 16, 0, 0); } while (0)
#define PG8_LDA(dst, b, h) do { _Pragma("unroll") for (int m = 0; m < 4; ++m) _Pragma("unroll") for (int k = 0; k < 2; ++k) dst[m][k] = *(const PG8_LAS bf16x8*)(lds + PG8_SA(b, h) + aoff + m * 2048 + k * 1024); } while (0)
#define PG8_LDB(dst, b, h) do { _Pragma("unroll") for (int n = 0; n < 2; ++n) _Pragma("unroll") for (int k = 0; k < 2; ++k) dst[n][k] = *(const PG8_LAS bf16x8*)(lds + PG8_SB(b, h) + boff + n * 2048 + k * 1024); } while (0)
#define PG8_MMA(ai, bj, At, Bt) do { __builtin_amdgcn_s_setprio(1); _Pragma("unroll") for (int m = 0; m < 4; ++m) _Pragma("unroll") for (int n = 0; n < 2; ++n) _Pragma("unroll") for (int k = 0; k < 2; ++k) \
        acc[ai][bj][m][n] = __builtin_amdgcn_mfma_f32_16x16x32_bf16(Bt[n][k], At[m][k], acc[ai][bj][m][n], 0, 0, 0); __builtin_amdgcn_s_setprio(0); } while (0)
#define PG8_WAIT_V(n) asm volatile("s_waitcnt vmcnt(" #n ")" ::: "memory")
#define PG8_WAIT_L(n) asm volatile("s_waitcnt lgkmcnt(" #n ")" ::: "memory")
#define PG8_BAR __builtin_amdgcn_s_barrier()
#define PG8_SCHED __builtin_amdgcn_sched_barrier(0)
    Unit cur, nxt; int ui = 0;
    if (!S.next(0, cur)) return;
    f32x4 acc[2][2][4][2];
#pragma unroll
    for (int a = 0; a < 2; ++a)
#pragma unroll
        for (int b = 0; b < 2; ++b)
#pragma unroll
            for (int m = 0; m < 4; ++m)
#pragma unroll
                for (int n = 0; n < 2; ++n) acc[a][b][m][n] = (f32x4){0.f, 0.f, 0.f, 0.f};
    bf16x8 At[4][2], B0[2][2], B1[2][2];
    const char* cA = (const char*)g.A + (size_t)cur.pm * tstepA + (size_t)cur.pn * g.apn * 2; const char* cB = (const char*)g.Bt + (size_t)cur.pn * tstepB;
    S.a_ready(cur);
    if constexpr (SP2) {
        PG8_STAGE(PG8_SB(0, 0), cB, voffB); PG8_STAGE(PG8_SB(0, 1), cB + hstepB, voffB); PG8_STAGE(PG8_SA(0, 0), cA, voffA); PG8_STAGE(PG8_SA(0, 1), cA + hstepA, voffA);
        if (wr == 1) PG8_BAR;
        PG8_WAIT_V(2); PG8_BAR;
        PG8_STAGE(PG8_SB(1, 0), cB + kstep, voffB); PG8_STAGE(PG8_SA(1, 0), cA + kstep, voffA); PG8_STAGE(PG8_SB(1, 1), cB + hstepB + kstep, voffB);
        PG8_WAIT_V(6); PG8_BAR;
    } else {
        PG8_STAGE(PG8_SB(0, 0), cB, voffB); PG8_STAGE(PG8_SA(0, 0), cA, voffA); PG8_STAGE(PG8_SB(0, 1), cB + hstepB, voffB); PG8_STAGE(PG8_SA(0, 1), cA + hstepA, voffA);
        if (wr == 1) PG8_BAR;
        PG8_WAIT_V(4); PG8_BAR;
        PG8_STAGE(PG8_SB(1, 0), cB + kstep, voffB); PG8_STAGE(PG8_SA(1, 0), cA + kstep, voffA); PG8_STAGE(PG8_SB(1, 1), cB + hstepB + kstep, voffB);
        PG8_WAIT_V(6); PG8_BAR;
    }
    for (;;) {
        const bool has_next = S.next(ui + 1, nxt);
        const char* nA = has_next ? (const char*)g.A + (size_t)nxt.pm * tstepA + (size_t)nxt.pn * g.apn * 2 : cA; const char* nB = has_next ? (const char*)g.Bt + (size_t)nxt.pn * tstepB : cB;
        for (int t = 0; t < nt; t += 2) {
            const bool last = (t == nt - 2);
            const char* a1 = cA + (size_t)(t + 1) * kstep;
            const char* a2 = last ? nA : cA + (size_t)(t + 2) * kstep; const char* b2 = last ? nB : cB + (size_t)(t + 2) * kstep;
            const char* a3 = a2 + kstep; const char* b3 = b2 + kstep;
            if (last && has_next) S.a_ready(nxt);
            if constexpr (SP2) {
            PG8_LDB(B0, 0, 0); PG8_LDB(B1, 0, 1); PG8_SCHED; PG8_LDA(At, 0, 0); PG8_STAGE(PG8_SA(1, 1), a1 + hstepA, voffA);
            PG8_WAIT_V(8); PG8_WAIT_L(0); PG8_BAR; PG8_MMA(0, 0, At, B0); PG8_MMA(0, 1, At, B1); PG8_BAR; PG8_SCHED;
            PG8_LDA(At, 0, 1); PG8_STAGE(PG8_SB(0, 0), b2, voffB); PG8_STAGE(PG8_SB(0, 1), b2 + hstepB, voffB); PG8_STAGE(PG8_SA(0, 0), a2, voffA);
            PG8_WAIT_V(8); PG8_WAIT_L(0); PG8_BAR; PG8_MMA(1, 0, At, B0); PG8_MMA(1, 1, At, B1); PG8_BAR; PG8_SCHED;
            PG8_LDB(B0, 1, 0); PG8_LDB(B1, 1, 1); PG8_SCHED; PG8_LDA(At, 1, 0); PG8_STAGE(PG8_SA(0, 1), a2 + hstepA, voffA);
            PG8_WAIT_V(8); PG8_WAIT_L(0); PG8_BAR; PG8_MMA(0, 0, At, B0); PG8_MMA(0, 1, At, B1); PG8_BAR; PG8_SCHED;
            PG8_LDA(At, 1, 1); PG8_STAGE(PG8_SB(1, 0), b3, voffB); PG8_STAGE(PG8_SB(1, 1), b3 + hstepB, voffB); PG8_STAGE(PG8_SA(1, 0), a3, voffA);
            PG8_WAIT_V(8); PG8_WAIT_L(0); PG8_BAR; PG8_MMA(1, 0, At, B0); PG8_MMA(1, 1, At, B1); PG8_BAR; PG8_SCHED;
            } else {
            PG8_LDB(B0, 0, 0); PG8_SCHED; PG8_LDA(At, 0, 0); PG8_STAGE(PG8_SA(1, 1), a1 + hstepA, voffA);
            PG8_WAIT_L(8); PG8_BAR; PG8_WAIT_L(0); PG8_MMA(0, 0, At, B0); PG8_BAR; PG8_SCHED;
            PG8_LDB(B1, 0, 1); PG8_STAGE(PG8_SB(0, 0), b2, voffB);
            PG8_BAR; PG8_WAIT_L(0); PG8_MMA(0, 1, At, B1); PG8_BAR;
            PG8_LDA(At, 0, 1); PG8_STAGE(PG8_SA(0, 0), a2, voffA);
            PG8_BAR; PG8_WAIT_L(0); PG8_MMA(1, 0, At, B0); PG8_BAR; PG8_SCHED;
            PG8_STAGE(PG8_SB(0, 1), b2 + hstepB, voffB);
            PG8_WAIT_V(6); PG8_BAR; PG8_MMA(1, 1, At, B1); PG8_BAR;
            PG8_LDB(B0, 1, 0); PG8_SCHED; PG8_LDA(At, 1, 0); PG8_STAGE(PG8_SA(0, 1), a2 + hstepA, voffA);
            PG8_WAIT_L(8); PG8_BAR; PG8_WAIT_L(0); PG8_MMA(0, 0, At, B0); PG8_BAR; PG8_SCHED;
            PG8_LDB(B1, 1, 1); PG8_STAGE(PG8_SB(1, 0), b3, voffB);
            PG8_BAR; PG8_WAIT_L(0); PG8_MMA(0, 1, At, B1); PG8_BAR;
            PG8_LDA(At, 1, 1); PG8_STAGE(PG8_SA(1, 0), a3, voffA);
            PG8_BAR; PG8_WAIT_L(0); PG8_MMA(1, 0, At, B0); PG8_BAR; PG8_SCHED;
            PG8_STAGE(PG8_SB(1, 1), b3 + hstepB, voffB);
            PG8_WAIT_V(6); PG8_BAR; PG8_MMA(1, 1, At, B1); PG8_BAR;
            }
        }
        if constexpr (ALIGN_EPI) { if (wr == 0) PG8_BAR; }
        if constexpr (!Epi::AFTER_DRAIN) { E(acc, cur, wr, wc, fr, fq); S.done(cur); }
        if (!has_next) break;
#pragma unroll
        for (int a = 0; a < 2; ++a)
#pragma unroll
            for (int b = 0; b < 2; ++b)
#pragma unroll
                for (int m = 0; m < 4; ++m)
#pragma unroll
                    for (int n = 0; n < 2; ++n) acc[a][b][m][n] = (f32x4){0.f, 0.f, 0.f, 0.f};
        cur = nxt; cA = nA; cB = nB; ++ui;
        if constexpr (ALIGN_EPI) { if (wr == 1) PG8_BAR; }
    }
    PG8_WAIT_V(0);
    if constexpr (!ALIGN_EPI) { if (wr == 0) PG8_BAR; }
    PG8_BAR;
    if constexpr (Epi::AFTER_DRAIN) { E.fused(acc, cur, wr, wc, fr, fq, lds, wid, lane); S.done(cur); }
#undef PG8_SA
#undef PG8_SB
#undef PG8_STAGE
#undef PG8_LDA
#undef PG8_LDB
#undef PG8_MMA
#undef PG8_WAIT_V
#undef PG8_WAIT_L
#undef PG8_BAR
#undef PG8_SCHED
}
}

constexpr int GLD = 80;
constexpr int G2_AS = 256 * GLD * 2;
constexpr int G2_BS = 128 * GLD * 2;
constexpr int G2_STAGE = G2_AS + G2_BS;
template <class RowPtr, class ColPtr, class Epi, int MODE = 0>
__device__ __forceinline__ void gemm2_tile(LAS unsigned char* lds, const RowPtr& RP, const ColPtr& CP, int ldk, int K, int m0, int n0, const Epi& E, int mvalid = 256) {
    const int tid = fresh_tid(), lane = tid & 63, wid = tid >> 6, half = wid >> 2, wm = (wid >> 1) & 1, wn = wid & 1;
    const int fr = lane & 15, fq = lane >> 4;
    const int ht = tid & 255;
    const int ac = (ht & 7) * 8, ar0 = half * 128 + (ht >> 3);
    const int bn = half * 64 + (ht & 63), bk = (ht >> 6) * 16;
    const bf16_t* ap0 = RP(m0 + ar0); const bf16_t* ap1 = RP(m0 + ar0 + 32); const bf16_t* ap2 = RP(m0 + ar0 + 64); const bf16_t* ap3 = RP(m0 + ar0 + 96);
    const float* bp = CP(n0 + bn);
    f32x4 acc[4][4];
#pragma unroll
    for (int m = 0; m < 4; ++m)
#pragma unroll
        for (int n = 0; n < 4; ++n) acc[m][n] = (f32x4){0.f, 0.f, 0.f, 0.f};
    const u32x4 z4 = (u32x4){0u, 0u, 0u, 0u};
    u32x4 ra[4] = {z4, z4, z4, z4}; float rb[16] = {0.f, 0.f, 0.f, 0.f, 0.f, 0.f, 0.f, 0.f, 0.f, 0.f, 0.f, 0.f, 0.f, 0.f, 0.f, 0.f};
    const int nk = K / 64;
#define G2_LOAD(kt_) do { if (MODE == 1) break; const int k0_ = (kt_) * 64; \
        ra[0] = ap0 ? *(const u32x4*)(ap0 + k0_ + ac) : z4; ra[1] = ap1 ? *(const u32x4*)(ap1 + k0_ + ac) : z4; \
        ra[2] = ap2 ? *(const u32x4*)(ap2 + k0_ + ac) : z4; ra[3] = ap3 ? *(const u32x4*)(ap3 + k0_ + ac) : z4; \
        if (bp) { _Pragma("unroll") for (int j_ = 0; j_ < 16; ++j_) rb[j_] = bp[(size_t)(k0_ + bk + j_) * ldk]; } \
        else { _Pragma("unroll") for (int j_ = 0; j_ < 16; ++j_) rb[j_] = 0.f; } } while (0)
#define G2_STORE(buf_) do { LAS bf16_t* As_ = (LAS bf16_t*)(lds + (buf_) * G2_STAGE); LAS bf16_t* Bs_ = (LAS bf16_t*)(lds + (buf_) * G2_STAGE + G2_AS); \
        _Pragma("unroll") for (int j_ = 0; j_ < 4; ++j_) *(LAS u32x4*)(As_ + (ar0 + 32 * j_) * GLD + ac) = ra[j_]; \
        u32x4 w0_, w1_; w0_.x = cvt_pk_bf16(rb[0], rb[1]); w0_.y = cvt_pk_bf16(rb[2], rb[3]); w0_.z = cvt_pk_bf16(rb[4], rb[5]); w0_.w = cvt_pk_bf16(rb[6], rb[7]); \
        w1_.x = cvt_pk_bf16(rb[8], rb[9]); w1_.y = cvt_pk_bf16(rb[10], rb[11]); w1_.z = cvt_pk_bf16(rb[12], rb[13]); w1_.w = cvt_pk_bf16(rb[14], rb[15]); \
        *(LAS u32x4*)(Bs_ + bn * GLD + bk) = w0_; *(LAS u32x4*)(Bs_ + bn * GLD + bk + 8) = w1_; } while (0)
#define G2_COMPUTE(buf_) do { if (MODE == 2) break; const LAS bf16_t* As_ = (const LAS bf16_t*)(lds + (buf_) * G2_STAGE); const LAS bf16_t* Bs_ = (const LAS bf16_t*)(lds + (buf_) * G2_STAGE + G2_AS); \
        bf16x8 af0_[4], bf0_[4], af1_[4], bf1_[4]; \
        _Pragma("unroll") for (int m_ = 0; m_ < 4; ++m_) af0_[m_] = *(const LAS bf16x8*)(As_ + (half * 128 + wm * 64 + m_ * 16 + fr) * GLD + fq * 8); \
        _Pragma("unroll") for (int n_ = 0; n_ < 4; ++n_) bf0_[n_] = *(const LAS bf16x8*)(Bs_ + (wn * 64 + n_ * 16 + fr) * GLD + fq * 8); \
        _Pragma("unroll") for (int m_ = 0; m_ < 4; ++m_) af1_[m_] = *(const LAS bf16x8*)(As_ + (half * 128 + wm * 64 + m_ * 16 + fr) * GLD + 32 + fq * 8); \
        _Pragma("unroll") for (int n_ = 0; n_ < 4; ++n_) bf1_[n_] = *(const LAS bf16x8*)(Bs_ + (wn * 64 + n_ * 16 + fr) * GLD + 32 + fq * 8); \
        _Pragma("unroll") for (int m_ = 0; m_ < 4; ++m_) _Pragma("unroll") for (int n_ = 0; n_ < 4; ++n_) acc[m_][n_] = MFMA16(bf0_[n_], af0_[m_], acc[m_][n_]); \
        _Pragma("unroll") for (int m_ = 0; m_ < 4; ++m_) _Pragma("unroll") for (int n_ = 0; n_ < 4; ++n_) acc[m_][n_] = MFMA16(bf1_[n_], af1_[m_], acc[m_][n_]); } while (0)
    G2_LOAD(0);
    G2_STORE(0);
    if (nk > 1) G2_LOAD(1);
    __syncthreads();
    for (int kt = 0; kt < nk; ++kt) {
        const int cur = kt & 1;
        if (half == 0) { G2_COMPUTE(cur); }
        else if (kt + 1 < nk) { G2_STORE(cur ^ 1); if (kt + 2 < nk) G2_LOAD(kt + 2); }
        __syncthreads();
        if (half == 1) { if (mvalid > 128) { G2_COMPUTE(cur); } }
        else if (kt + 1 < nk) { G2_STORE(cur ^ 1); if (kt + 2 < nk) G2_LOAD(kt + 2); }
        __syncthreads();
    }
#undef G2_LOAD
#undef G2_STORE
#undef G2_COMPUTE
    E(acc, m0 + half * 128 + wm * 64, n0 + wn * 64, lane);
}

struct RowDense { const bf16_t* A; int lda; __device__ __forceinline__ const bf16_t* operator()(int r) const { return A + (size_t)r * lda; } };
struct RowGather { const bf16_t* A; const int* idx; int nvalid; __device__ __forceinline__ const bf16_t* operator()(int r) const { return r < nvalid ? A + (size_t)idx[r] * D : nullptr; } };
struct RowSlots { const bf16_t* A; int nvalid; __device__ __forceinline__ const bf16_t* operator()(int r) const { return r < nvalid ? A + (size_t)r * EDIM : nullptr; } };
struct ColDense { const float* W; int N; __device__ __forceinline__ const float* operator()(int c) const { return c < N ? W + c : nullptr; } };
struct ColMqk { const float* q; ptrdiff_t dk; __device__ __forceinline__ const float* operator()(int c) const { return q + ((c < 128) ? (ptrdiff_t)c : dk + (c - 128)); } };
struct ColGU { const float* g; ptrdiff_t du; __device__ __forceinline__ const float* operator()(int c) const { const int j = c >> 5, w = c & 31; return g + (((w & 16) ? du : (ptrdiff_t)0) + j * 16 + (w & 15)); } };
struct ColRgu { const float* r; ptrdiff_t dg; ptrdiff_t du; __device__ __forceinline__ const float* operator()(int c) const {
    const int cc = c - 256, j = cc >> 5, w = cc & 31; const ptrdiff_t off = (c < 256) ? (ptrdiff_t)c : (((w & 16) ? du : dg) + j * 16 + (w & 15)); return r + off; } };

__device__ __forceinline__ u32x2 pack4(const f32x4 v) { u32x2 w; w.x = cvt_pk_bf16(v.x, v.y); w.y = cvt_pk_bf16(v.z, v.w); return w; }
__device__ __forceinline__ u32x2 pack_swiglu(const f32x4 g, const f32x4 u) { u32x2 w; w.x = cvt_pk_bf16(siluf_(g.x) * u.x, siluf_(g.y) * u.y); w.y = cvt_pk_bf16(siluf_(g.z) * u.z, siluf_(g.w) * u.w); return w; }
struct EpiProj {
    bf16_t* proj; float* graw;
    __device__ __forceinline__ void operator()(const f32x4 (&acc)[4][4], int rb, int cb, int lane) const {
        const int fr = lane & 15, fq = lane >> 4;
#pragma unroll
        for (int m = 0; m < 4; ++m)
#pragma unroll
            for (int n = 0; n < 4; ++n) {
                const int row = rb + m * 16 + fr, col = cb + n * 16 + 4 * fq;
                if (col < OFF_GATE) *(u32x2*)(proj + (size_t)row * IN_DIM + col) = pack4(acc[m][n]);
                else if (col < IN_DIM) *(f32x4*)(graw + (size_t)row * 8 + (col - OFF_GATE)) = acc[m][n];
            }
    }
};
struct EpiNull {
    float* sink;
    __device__ __forceinline__ void operator()(const f32x4 (&acc)[4][4], int rb, int cb, int lane) const {
        float t = 0.f;
#pragma unroll
        for (int m = 0; m < 4; ++m)
#pragma unroll
            for (int n = 0; n < 4; ++n) t += acc[m][n].x + acc[m][n].y + acc[m][n].z + acc[m][n].w;
        if (t == 12345.678f) sink[lane] = t;
    }
};
struct EpiBf16 {
    bf16_t* O; int ldc;
    __device__ __forceinline__ void operator()(const f32x4 (&acc)[4][4], int rb, int cb, int lane) const {
        const int fr = lane & 15, fq = lane >> 4;
#pragma unroll
        for (int m = 0; m < 4; ++m)
#pragma unroll
            for (int n = 0; n < 4; ++n) *(u32x2*)(O + (size_t)(rb + m * 16 + fr) * ldc + cb + n * 16 + 4 * fq) = pack4(acc[m][n]);
    }
};
struct EpiMqk {
    bf16_t* mq; bf16_t* mk; int h;
    __device__ __forceinline__ void operator()(const f32x4 (&acc)[4][4], int rb, int cb, int lane) const {
        const int fr = lane & 15, fq = lane >> 4;
#pragma unroll
        for (int m = 0; m < 4; ++m)
#pragma unroll
            for (int n = 0; n < 4; ++n) {
                const int row = rb + m * 16 + fr, col = cb + n * 16 + 4 * fq; f32x4 v = acc[m][n];
                bf16_t* dst = mq; int c = col;
                if (col >= 128) { dst = mk; c = col - 128; v = v * 0.08838834764831845f; }
                *(u32x2*)(dst + (size_t)row * MINNER + h * DM + c) = pack4(v);
            }
    }
};
struct EpiResid {
    const float* X; const float* ada; int gt_off; float* out;
    __device__ __forceinline__ void operator()(const f32x4 (&acc)[4][4], int rb, int cb, int lane) const {
        const int fr = lane & 15, fq = lane >> 4;
#pragma unroll
        for (int m = 0; m < 4; ++m)
#pragma unroll
            for (int n = 0; n < 4; ++n) {
                const int row = rb + m * 16 + fr, col = cb + n * 16 + 4 * fq; const int b = row / S;
                const f32x4 g = *(const f32x4*)(ada + b * 6144 + gt_off + col);
                const f32x4 x = *(const f32x4*)(X + (size_t)row * D + col);
                *(f32x4*)(out + (size_t)row * D + col) = x + g * acc[m][n];
            }
    }
};
struct EpiRgu {
    float* logits; bf16_t* act;
    __device__ __forceinline__ void operator()(const f32x4 (&acc)[4][4], int rb, int cb, int lane) const {
        const int fr = lane & 15, fq = lane >> 4;
#pragma unroll
        for (int m = 0; m < 4; ++m) {
            const int row = rb + m * 16 + fr;
            if (cb < 256) {
#pragma unroll
                for (int n = 0; n < 4; ++n) *(f32x4*)(logits + (size_t)row * 256 + cb + n * 16 + 4 * fq) = acc[m][n];
            } else {
                const int j0 = (cb - 256) >> 5;
#pragma unroll
                for (int pp = 0; pp < 2; ++pp) *(u32x2*)(act + (size_t)row * 256 + (j0 + pp) * 16 + 4 * fq) = pack_swiglu(acc[m][2 * pp], acc[m][2 * pp + 1]);
            }
        }
    }
};
struct EpiExpAct {
    bf16_t* act; int slot0; int nvalid;
    __device__ __forceinline__ void operator()(const f32x4 (&acc)[4][4], int rb, int cb, int lane) const {
        const int fr = lane & 15, fq = lane >> 4;
#pragma unroll
        for (int m = 0; m < 4; ++m) {
            const int r = rb + m * 16 + fr;
            if (r < nvalid) {
                const int j0 = cb >> 5;
#pragma unroll
                for (int pp = 0; pp < 2; ++pp) *(u32x2*)(act + (size_t)(slot0 + r) * 256 + (j0 + pp) * 16 + 4 * fq) = pack_swiglu(acc[m][2 * pp], acc[m][2 * pp + 1]);
            }
        }
    }
};
struct EpiExpDown {
    bf16_t* y; const float* lw; int slot0; int nvalid;
    __device__ __forceinline__ void operator()(const f32x4 (&acc)[4][4], int rb, int cb, int lane) const {
        const int fr = lane & 15, fq = lane >> 4;
#pragma unroll
        for (int m = 0; m < 4; ++m) {
            const int r = rb + m * 16 + fr;
            if (r < nvalid) {
                const float wt = lw[r];
#pragma unroll
                for (int n = 0; n < 4; ++n) *(u32x2*)(y + (size_t)(slot0 + r) * 1024 + cb + n * 16 + 4 * fq) = pack4(acc[m][n] * wt);
            }
        }
    }
};

constexpr int AKLD = 104, AVLD = 72;
__device__ __forceinline__ void attn_unit(const Params& p, LAS unsigned char* lds, int bh, int qb) {
    LAS bf16_t* Ks = (LAS bf16_t*)lds;
    LAS bf16_t* Vt = Ks + 64 * AKLD;
    const bf16_t* Q = (const bf16_t*)(p.ws + B_Q) + (size_t)bh * S * 96;
    const bf16_t* Kg = (const bf16_t*)(p.ws + B_K) + (size_t)bh * S * 96;
    const int b = bh >> 3, h = bh & 7;
    const bf16_t* Vg = (const bf16_t*)(p.ws + B_KVRAW) + (size_t)b * S * 1024 + h * 128 + 64;
    bf16_t* O = (bf16_t*)(p.ws + B_ORAW) + (size_t)b * S * 512 + h * 64;
    const int tid = fresh_tid(), lane = tid & 63, wid = tid >> 6, fr = lane & 15, fq = lane >> 4;
    const int q0 = qb * 256, qw0 = q0 + wid * 32;
    bf16x8 qf[2][3];
#pragma unroll
    for (int nq = 0; nq < 2; ++nq)
#pragma unroll
        for (int ks = 0; ks < 3; ++ks) qf[nq][ks] = *(const bf16x8*)(Q + (size_t)(qw0 + nq * 16 + fr) * 96 + ks * 32 + fq * 8);
    f32x4 oacc[4][2];
#pragma unroll
    for (int d = 0; d < 4; ++d)
#pragma unroll
        for (int nq = 0; nq < 2; ++nq) oacc[d][nq] = (f32x4){0.f, 0.f, 0.f, 0.f};
    float mrun[2] = {-1e30f, -1e30f}, lrun[2] = {0.f, 0.f};
    const int ntiles = (q0 + 256) / 64;
    for (int kt = 0; kt < ntiles; ++kt) {
        const int k0 = kt * 64;
        for (int c = tid; c < 768; c += NT) { const int r = c / 12, cc = c - r * 12; *(LAS u32x4*)(Ks + r * AKLD + cc * 8) = *(const u32x4*)(Kg + (size_t)(k0 + r) * 96 + cc * 8); }
        {
            const int key = tid & 63, dc = tid >> 6;
            const u32x4 v = *(const u32x4*)(Vg + (size_t)(k0 + key) * 1024 + dc * 8);
            LAS bf16_t* vt = Vt + (dc * 8) * AVLD + key;
            vt[0 * AVLD] = (bf16_t)(v.x & 0xffff); vt[1 * AVLD] = (bf16_t)(v.x >> 16); vt[2 * AVLD] = (bf16_t)(v.y & 0xffff); vt[3 * AVLD] = (bf16_t)(v.y >> 16);
            vt[4 * AVLD] = (bf16_t)(v.z & 0xffff); vt[5 * AVLD] = (bf16_t)(v.z >> 16); vt[6 * AVLD] = (bf16_t)(v.w & 0xffff); vt[7 * AVLD] = (bf16_t)(v.w >> 16);
        }
        __syncthreads();
        if (k0 <= qw0 + 31) {
            f32x4 sacc[4][2];
#pragma unroll
            for (int t4 = 0; t4 < 4; ++t4)
#pragma unroll
                for (int nq = 0; nq < 2; ++nq) sacc[t4][nq] = (f32x4){0.f, 0.f, 0.f, 0.f};
#pragma unroll
            for (int ks = 0; ks < 3; ++ks)
#pragma unroll
                for (int t4 = 0; t4 < 4; ++t4) {
                    const bf16x8 kf = *(const LAS bf16x8*)(Ks + (t4 * 16 + fr) * AKLD + ks * 32 + fq * 8);
#pragma unroll
                    for (int nq = 0; nq < 2; ++nq) sacc[t4][nq] = MFMA16(kf, qf[nq][ks], sacc[t4][nq]);
                }
            const bool need_mask = (k0 + 63 > qw0);
#pragma unroll
            for (int nq = 0; nq < 2; ++nq) {
                const int qidx = qw0 + nq * 16 + fr;
                float mx = -1e30f;
#pragma unroll
                for (int t4 = 0; t4 < 4; ++t4)
#pragma unroll
                    for (int i = 0; i < 4; ++i) {
                        if (need_mask) { const int key = k0 + t4 * 16 + 4 * fq + i; if (key > qidx) sacc[t4][nq][i] = -1e30f; }
                        mx = fmaxf(mx, sacc[t4][nq][i]);
                    }
                mx = fmaxf(mx, __shfl_xor(mx, 16)); mx = fmaxf(mx, __shfl_xor(mx, 32));
                const float mnew = fmaxf(mrun[nq], mx);
                const float alpha = exp2f(mrun[nq] - mnew);
                mrun[nq] = mnew;
                float ls = 0.f;
#pragma unroll
                for (int t4 = 0; t4 < 4; ++t4)
#pragma unroll
                    for (int i = 0; i < 4; ++i) { const float pv = exp2f(sacc[t4][nq][i] - mnew); sacc[t4][nq][i] = pv; ls += pv; }
                lrun[nq] = lrun[nq] * alpha + ls;
#pragma unroll
                for (int d = 0; d < 4; ++d) oacc[d][nq] = oacc[d][nq] * alpha;
            }
#pragma unroll
            for (int s2 = 0; s2 < 2; ++s2) {
                bf16x8 pb[2];
#pragma unroll
                for (int nq = 0; nq < 2; ++nq) {
                    u32x4 w; w.x = cvt_pk_bf16(sacc[2 * s2][nq].x, sacc[2 * s2][nq].y); w.y = cvt_pk_bf16(sacc[2 * s2][nq].z, sacc[2 * s2][nq].w);
                    w.z = cvt_pk_bf16(sacc[2 * s2 + 1][nq].x, sacc[2 * s2 + 1][nq].y); w.w = cvt_pk_bf16(sacc[2 * s2 + 1][nq].z, sacc[2 * s2 + 1][nq].w);
                    pb[nq] = __builtin_bit_cast(bf16x8, w);
                }
#pragma unroll
                for (int d = 0; d < 4; ++d) {
                    const LAS bf16_t* vr = Vt + (d * 16 + fr) * AVLD + s2 * 32 + 4 * fq;
                    const u32x2 lo = *(const LAS u32x2*)vr, hi = *(const LAS u32x2*)(vr + 16);
                    const bf16x8 vf = __builtin_bit_cast(bf16x8, ((u32x4){lo.x, lo.y, hi.x, hi.y}));
#pragma unroll
                    for (int nq = 0; nq < 2; ++nq) oacc[d][nq] = MFMA16(vf, pb[nq], oacc[d][nq]);
                }
            }
        }
        __syncthreads();
    }
#pragma unroll
    for (int nq = 0; nq < 2; ++nq) {
        float l = lrun[nq]; l += __shfl_xor(l, 16); l += __shfl_xor(l, 32);
        const float inv = 1.f / l;
        const int qidx = qw0 + nq * 16 + fr;
#pragma unroll
        for (int d = 0; d < 4; ++d) { const f32x4 v = oacc[d][nq] * inv; u32x2 w; w.x = cvt_pk_bf16(v.x, v.y); w.y = cvt_pk_bf16(v.z, v.w);
            *(u32x2*)(O + (size_t)qidx * 512 + d * 16 + 4 * fq) = w; }
    }
}

constexpr int MTLD = 72;
__device__ __forceinline__ void mlstm_a_unit(const Params& p, LAS unsigned char* lds, int unit) {
    LAS bf16_t* kT = (LAS bf16_t*)lds;
    LAS bf16_t* vT = kT + 128 * MTLD;
    LAS float* av = (LAS float*)(vT + 128 * MTLD);
    const int bh = unit >> 5, c = unit & 31, b = bh >> 2, h = bh & 3;
    const int t0 = b * S + c * CHUNK;
    const float* gl = (const float*)(p.ws + B_GL);
    const bf16_t* mk = (const bf16_t*)(p.ws + B_MK); const bf16_t* proj = (const bf16_t*)(p.ws + B_PROJ);
    const int tid = fresh_tid(), lane = tid & 63, wid = tid >> 6, fr = lane & 15, fq = lane >> 4;
    if (wid == 0) {
        const float li = gl[(size_t)(t0 + lane) * 8 + h], lf = gl[(size_t)(t0 + lane) * 8 + 4 + h];
        float bs = lf;
#pragma unroll
        for (int o = 1; o < 64; o <<= 1) { const float t = __shfl_up(bs, o); if (lane >= o) bs += t; }
        const float Btot = __shfl(bs, 63);
        const float g = Btot - bs + li;
        const float ml = wave_max(g);
        av[lane] = __expf(g - ml);
        if (lane == 0) { ((float*)(p.ws + WS_BC))[unit] = Btot; ((float*)(p.ws + WS_MLOC))[unit] = ml; }
    }
    __syncthreads();
#pragma unroll
    for (int rep = 0; rep < 2; ++rep) {
        const int cidx = tid + rep * NT, s = cidx & 63, ch = cidx >> 6;
        const u32x4 kv = *(const u32x4*)(mk + (size_t)(t0 + s) * MINNER + h * DM + ch * 8);
        const u32x4 vv = *(const u32x4*)(proj + (size_t)(t0 + s) * IN_DIM + OFF_MV + h * DM + ch * 8);
        const float a = av[s];
        LAS bf16_t* kt = kT + (ch * 8) * MTLD + s; LAS bf16_t* vt = vT + (ch * 8) * MTLD + s;
        const unsigned kk[4] = {kv.x, kv.y, kv.z, kv.w}; const unsigned vw[4] = {vv.x, vv.y, vv.z, vv.w};
#pragma unroll
        for (int j = 0; j < 4; ++j) {
            kt[(2 * j) * MTLD] = (bf16_t)(kk[j] & 0xffff); kt[(2 * j + 1) * MTLD] = (bf16_t)(kk[j] >> 16);
            const unsigned sc = cvt_pk_bf16(bflo(vw[j]) * a, bfhi(vw[j]) * a);
            vt[(2 * j) * MTLD] = (bf16_t)(sc & 0xffff); vt[(2 * j + 1) * MTLD] = (bf16_t)(sc >> 16);
        }
    }
    __syncthreads();
    {
        const int we = wid >> 1, wd = wid & 1;
        f32x4 acc[2][4];
#pragma unroll
        for (int i = 0; i < 2; ++i)
#pragma unroll
            for (int j = 0; j < 4; ++j) acc[i][j] = (f32x4){0.f, 0.f, 0.f, 0.f};
#pragma unroll
        for (int ks = 0; ks < 2; ++ks) {
            bf16x8 vf[2], kf[4];
#pragma unroll
            for (int i = 0; i < 2; ++i) vf[i] = *(const LAS bf16x8*)(vT + (we * 32 + i * 16 + fr) * MTLD + ks * 32 + fq * 8);
#pragma unroll
            for (int j = 0; j < 4; ++j) kf[j] = *(const LAS bf16x8*)(kT + (wd * 64 + j * 16 + fr) * MTLD + ks * 32 + fq * 8);
#pragma unroll
            for (int i = 0; i < 2; ++i)
#pragma unroll
                for (int j = 0; j < 4; ++j) acc[i][j] = MFMA16(vf[i], kf[j], acc[i][j]);
        }
        float* dC = (float*)(p.ws + B_DC) + (size_t)unit * 16384;
#pragma unroll
        for (int i = 0; i < 2; ++i)
#pragma unroll
            for (int j = 0; j < 4; ++j)
#pragma unroll
                for (int r = 0; r < 4; ++r) dC[(we * 32 + i * 16 + 4 * fq + r) * 128 + wd * 64 + j * 16 + fr] = acc[i][j][r];
    }
    if (tid < 128) {
        float s = 0.f;
        for (int q = 0; q < 64; ++q) s += bf2f(kT[tid * MTLD + q]) * av[q];
        ((float*)(p.ws + WS_DN))[(size_t)unit * 128 + tid] = s;
    }
    __syncthreads();
}

__device__ __forceinline__ void mlstm_scan(const Params& p, int gtid, int ngt) {
    const float* Bc = (const float*)(p.ws + WS_BC); const float* ML = (const float*)(p.ws + WS_MLOC);
    float* mprev = (float*)(p.ws + WS_MPREV);
    const float* dC = (const float*)(p.ws + B_DC); bf16_t* Cp = (bf16_t*)(p.ws + B_CPREV);
    const float* dn = (const float*)(p.ws + WS_DN); float* np_ = (float*)(p.ws + WS_NPREV);
    constexpr int PER = 4096 + 32;
    for (int idx = gtid; idx < 32 * PER; idx += ngt) {
        const int bh = idx / PER, e4 = idx - bh * PER;
        float m = 0.f; f32x4 C = (f32x4){0.f, 0.f, 0.f, 0.f};
        for (int c = 0; c < NCH; ++c) {
            const int unit = bh * NCH + c;
            const float Bt = Bc[unit], ml = ML[unit];
            const float mnew = fmaxf(Bt + m, ml);
            const float fa = __expf(Bt + m - mnew), fb = __expf(ml - mnew);
            if (e4 < 4096) {
                u32x2 w; w.x = cvt_pk_bf16(C.x, C.y); w.y = cvt_pk_bf16(C.z, C.w);
                *(u32x2*)(Cp + (size_t)unit * 16384 + e4 * 4) = w;
                const f32x4 d = *(const f32x4*)(dC + (size_t)unit * 16384 + e4 * 4);
                C = C * fa + d * fb;
                if (e4 == 0) mprev[unit] = m;
            } else {
                const int n4 = e4 - 4096;
                *(f32x4*)(np_ + (size_t)unit * 128 + n4 * 4) = C;
                const f32x4 d = *(const f32x4*)(dn + (size_t)unit * 128 + n4 * 4);
                C = C * fa + d * fb;
            }
            m = mnew;
        }
    }
}

constexpr int MRLD = 136;
__device__ __forceinline__ void mlstm_c_unit(const Params& p, LAS unsigned char* lds, int unit) {
    LAS bf16_t* qs = (LAS bf16_t*)lds;
    LAS bf16_t* ks = qs + 64 * MRLD;
    LAS bf16_t* cs = ks + 64 * MRLD;
    LAS bf16_t* vT = cs + 128 * MRLD;
    LAS float* fv = (LAS float*)(vT + 128 * MTLD);
    LAS float* u_s = fv; LAS float* c_t = fv + 64; LAS float* dec = fv + 128; LAS float* emt = fv + 192; LAS float* ssq = fv + 256;
    const int bh = unit >> 5, c = unit & 31, b = bh >> 2, h = bh & 3;
    const int t0 = b * S + c * CHUNK;
    const float* gl = (const float*)(p.ws + B_GL);
    const bf16_t* mq = (const bf16_t*)(p.ws + B_MQ); const bf16_t* mk = (const bf16_t*)(p.ws + B_MK); const bf16_t* proj = (const bf16_t*)(p.ws + B_PROJ);
    const bf16_t* Cp = (const bf16_t*)(p.ws + B_CPREV) + (size_t)unit * 16384;
    const float* np_ = (const float*)(p.ws + WS_NPREV) + (size_t)unit * 128;
    const int tid = fresh_tid(), lane = tid & 63, wid = tid >> 6, fr = lane & 15, fq = lane >> 4;
    if (wid == 0) {
        const float li = gl[(size_t)(t0 + lane) * 8 + h], lf = gl[(size_t)(t0 + lane) * 8 + 4 + h];
        const float mp = ((const float*)(p.ws + WS_MPREV))[unit];
        float bs = lf;
#pragma unroll
        for (int o = 1; o < 64; o <<= 1) { const float t = __shfl_up(bs, o); if (lane >= o) bs += t; }
        const float u = li - bs;
        float pm = u;
#pragma unroll
        for (int o = 1; o < 64; o <<= 1) { const float t = __shfl_up(pm, o); if (lane >= o) pm = fmaxf(pm, t); }
        const float inter = bs + mp;
        const float mt = fmaxf(inter, bs + pm);
        u_s[lane] = u; c_t[lane] = bs - mt; dec[lane] = __expf(inter - mt); emt[lane] = __expf(-mt);
    }
#pragma unroll
    for (int rep = 0; rep < 2; ++rep) {
        const int cidx = tid + rep * NT, r = cidx >> 4, ch = cidx & 15;
        *(LAS u32x4*)(qs + r * MRLD + ch * 8) = *(const u32x4*)(mq + (size_t)(t0 + r) * MINNER + h * DM + ch * 8);
        *(LAS u32x4*)(ks + r * MRLD + ch * 8) = *(const u32x4*)(mk + (size_t)(t0 + r) * MINNER + h * DM + ch * 8);
    }
#pragma unroll
    for (int rep = 0; rep < 4; ++rep) {
        const int cidx = tid + rep * NT, r = cidx >> 4, ch = cidx & 15;
        *(LAS u32x4*)(cs + r * MRLD + ch * 8) = *(const u32x4*)(Cp + r * 128 + ch * 8);
    }
#pragma unroll
    for (int rep = 0; rep < 2; ++rep) {
        const int cidx = tid + rep * NT, s = cidx & 63, ch = cidx >> 6;
        const u32x4 vv = *(const u32x4*)(proj + (size_t)(t0 + s) * IN_DIM + OFF_MV + h * DM + ch * 8);
        LAS bf16_t* vt = vT + (ch * 8) * MTLD + s;
        const unsigned vw[4] = {vv.x, vv.y, vv.z, vv.w};
#pragma unroll
        for (int j = 0; j < 4; ++j) { vt[(2 * j) * MTLD] = (bf16_t)(vw[j] & 0xffff); vt[(2 * j + 1) * MTLD] = (bf16_t)(vw[j] >> 16); }
    }
    __syncthreads();
    const int tt = wid & 3, eh = wid >> 2;
    const int tl = tt * 16 + fr;
    bf16x8 qf[4];
#pragma unroll
    for (int k4 = 0; k4 < 4; ++k4) qf[k4] = *(const LAS bf16x8*)(qs + tl * MRLD + k4 * 32 + fq * 8);
    f32x4 sacc[4];
#pragma unroll
    for (int st = 0; st < 4; ++st) sacc[st] = (f32x4){0.f, 0.f, 0.f, 0.f};
#pragma unroll
    for (int k4 = 0; k4 < 4; ++k4)
#pragma unroll
        for (int st = 0; st < 4; ++st) {
            const bf16x8 kf = *(const LAS bf16x8*)(ks + (st * 16 + fr) * MRLD + k4 * 32 + fq * 8);
            sacc[st] = MFMA16(kf, qf[k4], sacc[st]);
        }
    const float ct = c_t[tl];
    float rs = 0.f;
#pragma unroll
    for (int st = 0; st < 4; ++st)
#pragma unroll
        for (int i = 0; i < 4; ++i) {
            const int s = st * 16 + 4 * fq + i;
            const float w = (s <= tl) ? __expf(ct + u_s[s]) * sacc[st][i] : 0.f;
            sacc[st][i] = w; rs += w;
        }
    rs += __shfl_xor(rs, 16); rs += __shfl_xor(rs, 32);
    float nq;
    {
        f32x4 na = (f32x4){0.f, 0.f, 0.f, 0.f};
#pragma unroll
        for (int k4 = 0; k4 < 4; ++k4) {
            u32x4 w = (u32x4){0u, 0u, 0u, 0u};
            if (fr == 0) { const float* nn = np_ + k4 * 32 + fq * 8; w.x = cvt_pk_bf16(nn[0], nn[1]); w.y = cvt_pk_bf16(nn[2], nn[3]); w.z = cvt_pk_bf16(nn[4], nn[5]); w.w = cvt_pk_bf16(nn[6], nn[7]); }
            na = MFMA16(__builtin_bit_cast(bf16x8, w), qf[k4], na);
        }
        nq = __shfl(na.x, fr);
    }
    f32x4 acc[4];
#pragma unroll
    for (int et = 0; et < 4; ++et) acc[et] = (f32x4){0.f, 0.f, 0.f, 0.f};
#pragma unroll
    for (int k4 = 0; k4 < 4; ++k4)
#pragma unroll
        for (int et = 0; et < 4; ++et) {
            const bf16x8 cf = *(const LAS bf16x8*)(cs + (eh * 64 + et * 16 + fr) * MRLD + k4 * 32 + fq * 8);
            acc[et] = MFMA16(cf, qf[k4], acc[et]);
        }
    const float dcy = dec[tl];
#pragma unroll
    for (int et = 0; et < 4; ++et) acc[et] = acc[et] * dcy;
#pragma unroll
    for (int s2 = 0; s2 < 2; ++s2) {
        u32x4 w; w.x = cvt_pk_bf16(sacc[2 * s2].x, sacc[2 * s2].y); w.y = cvt_pk_bf16(sacc[2 * s2].z, sacc[2 * s2].w);
        w.z = cvt_pk_bf16(sacc[2 * s2 + 1].x, sacc[2 * s2 + 1].y); w.w = cvt_pk_bf16(sacc[2 * s2 + 1].z, sacc[2 * s2 + 1].w);
        const bf16x8 pb = __builtin_bit_cast(bf16x8, w);
#pragma unroll
        for (int et = 0; et < 4; ++et) {
            const LAS bf16_t* vr = vT + (eh * 64 + et * 16 + fr) * MTLD + s2 * 32 + 4 * fq;
            const u32x2 lo = *(const LAS u32x2*)vr, hi = *(const LAS u32x2*)(vr + 16);
            acc[et] = MFMA16(__builtin_bit_cast(bf16x8, ((u32x4){lo.x, lo.y, hi.x, hi.y})), pb, acc[et]);
        }
    }
    const float den = dcy * nq + rs;
    const float hd = 1.f / fmaxf(fabsf(den), emt[tl]);
    float sq = 0.f;
#pragma unroll
    for (int et = 0; et < 4; ++et) { acc[et] = acc[et] * hd; sq += acc[et].x * acc[et].x + acc[et].y * acc[et].y + acc[et].z * acc[et].z + acc[et].w * acc[et].w; }
    sq += __shfl_xor(sq, 16); sq += __shfl_xor(sq, 32);
    if (fq == 0) ssq[eh * 64 + tl] = sq;
    __syncthreads();
    const float rinv = rsqrtf((ssq[tl] + ssq[64 + tl]) * (1.f / 128.f) + RMS_EPS);
    const float* gmo = p.in[20] + h * DM;
    bf16_t* ao = (bf16_t*)(p.ws + B_AO);
#pragma unroll
    for (int et = 0; et < 4; ++et) {
        const int e = eh * 64 + et * 16 + 4 * fq;
        const u32x2 op = *(const u32x2*)(proj + (size_t)(t0 + tl) * IN_DIM + OFF_MO + h * DM + e);
        const f32x4 g = *(const f32x4*)(gmo + e);
        const f32x4 v = acc[et] * rinv * g;
        u32x2 w; w.x = cvt_pk_bf16(v.x * sigmoidf_(bflo(op.x)), v.y * sigmoidf_(bfhi(op.x))); w.y = cvt_pk_bf16(v.z * sigmoidf_(bflo(op.y)), v.w * sigmoidf_(bfhi(op.y)));
        *(u32x2*)(ao + (size_t)(t0 + tl) * 1024 + 512 + h * DM + e) = w;
    }
    __syncthreads();
}

__device__ __forceinline__ void route_rows(const Params& p, int gw, int ngw, int lane) {
    const float* logits = (const float*)(p.ws + C_LOGITS); const float* rb = p.in[24];
    int* cnt = (int*)(p.ws + WS_CTL);
    int* tok_e = (int*)(p.ws + C_TOKE); float* tok_w = (float*)(p.ws + C_TOKW); int* tok_pos = (int*)(p.ws + C_TOKPOS);
    int* list_tok = (int*)(p.ws + C_LISTTOK); float* list_w = (float*)(p.ws + C_LISTW);
    const f32x4 bias = *(const f32x4*)(rb + lane * 4);
    const float NEG = -__builtin_inff();
    for (int row = gw; row < T; row += ngw) {
        const f32x4 lg = *(const f32x4*)(logits + (size_t)row * 256 + lane * 4);
        float sc[4] = {sigmoidf_(lg.x), sigmoidf_(lg.y), sigmoidf_(lg.z), sigmoidf_(lg.w)};
        float sb[4] = {sc[0] + bias.x, sc[1] + bias.y, sc[2] + bias.z, sc[3] + bias.w};
        float t1 = fmaxf(fmaxf(sb[0], sb[1]), fmaxf(sb[2], sb[3]));
        float t2;
        {
            const float a = fmaxf(sb[0], sb[1]), bmin = fminf(sb[0], sb[1]), c2 = fmaxf(sb[2], sb[3]), dmin = fminf(sb[2], sb[3]);
            t2 = fmaxf(fminf(a, c2), fmaxf(bmin, dmin));
        }
#pragma unroll
        for (int o = 1; o < 8; o <<= 1) {
            const float o1 = __shfl_xor(t1, o), o2 = __shfl_xor(t2, o);
            const float n1 = fmaxf(t1, o1), n2 = fmaxf(fminf(t1, o1), fmaxf(t2, o2));
            t1 = n1; t2 = n2;
        }
        const float gs = t1 + t2;
        const int myg = lane >> 3;
        int rank = 0;
#pragma unroll
        for (int g = 0; g < 8; ++g) { const float og = __shfl(gs, g * 8); rank += (og > gs || (og == gs && g < myg)) ? 1 : 0; }
        const bool keep = rank < 4;
        float cand[4];
#pragma unroll
        for (int j = 0; j < 4; ++j) cand[j] = keep ? sb[j] : NEG;
        float wsum = 0.f; float myw = 0.f; int mye = 0;
#pragma unroll
        for (int k = 0; k < TOPK; ++k) {
            float bv = cand[0]; int bi = 0;
#pragma unroll
            for (int j = 1; j < 4; ++j) if (cand[j] > bv) { bv = cand[j]; bi = j; }
            int gi = lane * 4 + bi; float gv = bv;
#pragma unroll
            for (int o = 1; o < 64; o <<= 1) {
                const float ov = __shfl_xor(gv, o); const int oi = __shfl_xor(gi, o);
                if (ov > gv || (ov == gv && oi < gi)) { gv = ov; gi = oi; }
            }
            const int wl = gi >> 2, wj = gi & 3;
            const float sj = (wj == 0) ? sc[0] : (wj == 1) ? sc[1] : (wj == 2) ? sc[2] : sc[3];
            const float sraw = __shfl(sj, wl);
            wsum += sraw;
            if (lane == k) { myw = sraw; mye = gi; }
            if (lane == wl) {
#pragma unroll
                for (int j = 0; j < 4; ++j) if (j == wj) cand[j] = NEG;
            }
        }
        if (lane < TOPK) {
            const float w = myw / wsum * 2.5f;
            const int pos = atomicAdd(&cnt[mye], 1);
            tok_e[(size_t)row * 8 + lane] = mye; tok_w[(size_t)row * 8 + lane] = w; tok_pos[(size_t)row * 8 + lane] = pos;
            list_tok[(size_t)mye * CAP + pos] = row; list_w[(size_t)mye * CAP + pos] = w;
        }
    }
}

__device__ __forceinline__ void expert_prefix(const Params& p, LAS int* base, LAS int* tsx, int tid, int x, int ngrp) {
    const int* cnt = (const int*)(p.ws + WS_CTL);
    const int nper = NE / ngrp;
    if (tid < 64) {
        int c[4]; int s = 0;
#pragma unroll
        for (int j = 0; j < 4; ++j) { c[j] = __hip_atomic_load(cnt + tid * 4 + j, __ATOMIC_RELAXED, __HIP_MEMORY_SCOPE_AGENT); s += c[j]; }
        int ps = s;
#pragma unroll
        for (int o = 1; o < 64; o <<= 1) { const int a = __shfl_up(ps, o); if (tid >= o) ps += a; }
        int es = ps - s;
#pragma unroll
        for (int j = 0; j < 4; ++j) { base[tid * 4 + j] = es; es += c[j]; }
        int run = 0;
        for (int r0 = 0; r0 < nper; r0 += 64) {
            const int i = r0 + tid;
            int tl = 0;
            if (i < nper) tl = (__hip_atomic_load(cnt + x + ngrp * i, __ATOMIC_RELAXED, __HIP_MEMORY_SCOPE_AGENT) + 255) >> 8;
            int pt = tl;
#pragma unroll
            for (int o = 1; o < 64; o <<= 1) { const int a = __shfl_up(pt, o); if (tid >= o) pt += a; }
            if (i < nper) tsx[i] = run + pt - tl;
            run += __shfl(pt, 63);
        }
        if (tid == 0) tsx[nper] = run;
    }
    __syncthreads();
}

__device__ __forceinline__ void combine_rows(const Params& p, LAS int* base, int gw, int ngw, int lane) {
    const bf16_t* sh = (const bf16_t*)(p.ws + C_SHOUT); const bf16_t* y = (const bf16_t*)(p.ws + C_Y);
    const int* tok_e = (const int*)(p.ws + C_TOKE); const int* tok_pos = (const int*)(p.ws + C_TOKPOS);
    const float* ada = (const float*)(p.ws + WS_ADA);
    for (int row = gw; row < T; row += ngw) {
        const int b = row / S;
        float acc[2][8];
#pragma unroll
        for (int hf = 0; hf < 2; ++hf) {
            const u32x4 a = *(const u32x4*)(sh + (size_t)row * 1024 + hf * 512 + lane * 8);
            acc[hf][0] = bflo(a.x); acc[hf][1] = bfhi(a.x); acc[hf][2] = bflo(a.y); acc[hf][3] = bfhi(a.y); acc[hf][4] = bflo(a.z); acc[hf][5] = bfhi(a.z); acc[hf][6] = bflo(a.w); acc[hf][7] = bfhi(a.w);
        }
#pragma unroll
        for (int k = 0; k < TOPK; ++k) {
            const int e = tok_e[(size_t)row * 8 + k], pos = tok_pos[(size_t)row * 8 + k];
            const size_t slot = (size_t)(base[e] + pos);
#pragma unroll
            for (int hf = 0; hf < 2; ++hf) {
                const u32x4 a = *(const u32x4*)(y + slot * 1024 + hf * 512 + lane * 8);
                acc[hf][0] += bflo(a.x); acc[hf][1] += bfhi(a.x); acc[hf][2] += bflo(a.y); acc[hf][3] += bfhi(a.y); acc[hf][4] += bflo(a.z); acc[hf][5] += bfhi(a.z); acc[hf][6] += bflo(a.w); acc[hf][7] += bfhi(a.w);
            }
        }
#pragma unroll
        for (int hf = 0; hf < 2; ++hf) {
            const int col = hf * 512 + lane * 8;
            float* o = p.out + (size_t)row * D + col;
            const float* g = ada + b * 6144 + 5120 + col;
#pragma unroll
            for (int q4 = 0; q4 < 2; ++q4) {
                const f32x4 x = *(const f32x4*)(o + q4 * 4), gg = *(const f32x4*)(g + q4 * 4);
                f32x4 r; r.x = x.x + gg.x * acc[hf][q4 * 4 + 0]; r.y = x.y + gg.y * acc[hf][q4 * 4 + 1]; r.z = x.z + gg.z * acc[hf][q4 * 4 + 2]; r.w = x.w + gg.w * acc[hf][q4 * 4 + 3];
                *(f32x4*)(o + q4 * 4) = r;
            }
        }
    }
}


struct PgProj {
    static constexpr bool PERM = false, AFTER_DRAIN = false;
    bf16_t* proj; float* graw;
    __device__ __forceinline__ void operator()(const f32x4 (&acc)[2][2][4][2], const pg8::Unit& u, int wr, int wc, int fr, int fq) const {
#pragma unroll
        for (int ai = 0; ai < 2; ++ai)
#pragma unroll
            for (int m = 0; m < 4; ++m) { const int row = u.pm * 256 + ai * 128 + wr * 64 + m * 16 + fr;
#pragma unroll
                for (int bj = 0; bj < 2; ++bj)
#pragma unroll
                    for (int n = 0; n < 2; ++n) { const int col = u.pn * 256 + bj * 128 + wc * 32 + n * 16 + 4 * fq;
                        if (col < OFF_GATE) *(u32x2*)(proj + (size_t)row * IN_DIM + col) = pack4(acc[ai][bj][m][n]);
                        else if (col < IN_DIM) *(f32x4*)(graw + (size_t)row * 8 + (col - OFF_GATE)) = acc[ai][bj][m][n]; } }
    }
};
struct PgBf16 {
    static constexpr bool PERM = false, AFTER_DRAIN = false;
    bf16_t* O; int ldc;
    __device__ __forceinline__ void operator()(const f32x4 (&acc)[2][2][4][2], const pg8::Unit& u, int wr, int wc, int fr, int fq) const {
#pragma unroll
        for (int ai = 0; ai < 2; ++ai)
#pragma unroll
            for (int m = 0; m < 4; ++m) { const int row = u.pm * 256 + ai * 128 + wr * 64 + m * 16 + fr;
#pragma unroll
                for (int bj = 0; bj < 2; ++bj)
#pragma unroll
                    for (int n = 0; n < 2; ++n) { const int col = u.pn * 256 + bj * 128 + wc * 32 + n * 16 + 4 * fq;
                        *(u32x2*)(O + (size_t)row * ldc + col) = pack4(acc[ai][bj][m][n]); } }
    }
};
struct PgMqk {
    static constexpr bool PERM = false, AFTER_DRAIN = false;
    bf16_t* mq; bf16_t* mk;
    __device__ __forceinline__ void operator()(const f32x4 (&acc)[2][2][4][2], const pg8::Unit& u, int wr, int wc, int fr, int fq) const {
#pragma unroll
        for (int ai = 0; ai < 2; ++ai)
#pragma unroll
            for (int m = 0; m < 4; ++m) { const int row = u.pm * 256 + ai * 128 + wr * 64 + m * 16 + fr;
#pragma unroll
                for (int bj = 0; bj < 2; ++bj)
#pragma unroll
                    for (int n = 0; n < 2; ++n) { const int c = wc * 32 + n * 16 + 4 * fq;
                        const f32x4 v = bj ? acc[ai][bj][m][n] * 0.08838834764831845f : acc[ai][bj][m][n];
                        *(u32x2*)((bj ? mk : mq) + (size_t)row * MINNER + u.pn * DM + c) = pack4(v); } }
    }
};
struct PgResid {
    static constexpr bool PERM = false, AFTER_DRAIN = false;
    const float* X; const float* ada; int gt_off; float* out;
    __device__ __forceinline__ void operator()(const f32x4 (&acc)[2][2][4][2], const pg8::Unit& u, int wr, int wc, int fr, int fq) const {
#pragma unroll
        for (int ai = 0; ai < 2; ++ai)
#pragma unroll
            for (int m = 0; m < 4; ++m) { const int row = u.pm * 256 + ai * 128 + wr * 64 + m * 16 + fr; const int b = row / S;
#pragma unroll
                for (int bj = 0; bj < 2; ++bj)
#pragma unroll
                    for (int n = 0; n < 2; ++n) { const int col = u.pn * 256 + bj * 128 + wc * 32 + n * 16 + 4 * fq;
                        const f32x4 g = *(const f32x4*)(ada + b * 6144 + gt_off + col);
                        const f32x4 x = *(const f32x4*)(X + (size_t)row * D + col);
                        *(f32x4*)(out + (size_t)row * D + col) = x + g * acc[ai][bj][m][n]; } }
    }
};
struct PgRgu {
    static constexpr bool PERM = false, AFTER_DRAIN = false;
    float* logits; bf16_t* act;
    __device__ __forceinline__ void operator()(const f32x4 (&acc)[2][2][4][2], const pg8::Unit& u, int wr, int wc, int fr, int fq) const {
#pragma unroll
        for (int ai = 0; ai < 2; ++ai)
#pragma unroll
            for (int m = 0; m < 4; ++m) { const int row = u.pm * 256 + ai * 128 + wr * 64 + m * 16 + fr;
#pragma unroll
                for (int bj = 0; bj < 2; ++bj) {
                    if (u.pn == 0) {
#pragma unroll
                        for (int n = 0; n < 2; ++n) *(f32x4*)(logits + (size_t)row * 256 + bj * 128 + wc * 32 + n * 16 + 4 * fq) = acc[ai][bj][m][n];
                    } else {
                        const int j = ((u.pn - 1) * 256 + bj * 128 + wc * 32) >> 5;
                        *(u32x2*)(act + (size_t)row * 256 + j * 16 + 4 * fq) = pack_swiglu(acc[ai][bj][m][0], acc[ai][bj][m][1]);
                    }
                } }
    }
};

__device__ __forceinline__ int xcd_remap(int L, int nwg) { const int q = nwg >> 3, r = nwg & 7, x = L & 7, off = L >> 3; return (x < r ? x * (q + 1) : r * (q + 1) + (x - r) * q) + off; }
__global__ void __launch_bounds__(NT, 2) fwd_kernel(Params p) {
    extern __shared__ __attribute__((aligned(16))) unsigned char lds_raw[];
    LAS unsigned char* lds = (LAS unsigned char*)lds_raw;
    const int G = gridDim.x, bid = blockIdx.x, ngw = G * NWAVES;
#define FRESH_IDS() const int tid = fresh_tid(), lane = tid & 63, wid = tid >> 6, gw = bid * NWAVES + wid; (void)lane; (void)gw
    { const int tid = fresh_tid(); volatile LAS unsigned* bst0 = (volatile LAS unsigned*)(lds + LDS_BYTES - 64); if (tid < 2) bst0[tid] = 0u; }
    unsigned char* ws = p.ws;
    const float* ada = (const float*)(ws + WS_ADA);
    volatile LAS unsigned* bst = (volatile LAS unsigned*)(lds + LDS_BYTES - 64);
    __syncthreads();
    const XcdBarrier xbar = xcd_barrier_post((unsigned*)(ws + WS_CTL + 4096), bst);
    int ts_n = 0;
#if DBG_STAGE == 2
#define TSTAMP() do { if (bid == 0 && threadIdx.x == 0) ((unsigned long long*)(ws + WS_CTL + 16384 + 8192))[ts_n] = __builtin_amdgcn_s_memrealtime(); ++ts_n; } while (0)
#else
#define TSTAMP() do { } while (0)
#endif
    TSTAMP();

    {
        FRESH_IDS();
        const bool split = G > 128;
        if (!split || bid < 96) for (int u = bid; u < 96; u += G) ada_unit(p, lds, u, tid);
        if (!split || bid >= 96) {
            LAS float* scr = (LAS float*)(lds + wid * 8448);
            const int cg0 = split ? (bid - 96) * NWAVES + wid : gw, cgn = split ? (G - 96) * NWAVES : ngw;
            constexpr int I0 = 16 * 70, I1 = I0 + 6 * 24, I2 = I1 + 4 * 32, I3 = I2 + 32, I4 = I3 + 32, I5 = I4 + 16 * 32, I6 = I5 + 16 * 8, I7 = I6 + 16 * 8, I8 = I7 + 16 * 8, I9 = I8 + 4 * 32;
            for (int it = cg0; it < I9; it += cgn) {
                if (it < I0) conv_item<0>(p.in[6], 1024, IN_DIM, (bf16_t*)(ws + WS_WIN), 0, 0, scr, it, lane);
                else if (it < I1) conv_item<0>(p.in[8], QLORA, 768, (bf16_t*)(ws + WS_WUQ), 0, 0, scr, it - I0, lane);
                else if (it < I2) conv_item<0>(p.in[10], KVLORA, 1024, (bf16_t*)(ws + WS_WUKV), 0, 0, scr, it - I1, lane);
                else if (it < I3) conv_item<0>(p.in[16], 128, 128, (bf16_t*)(ws + WS_WMQK), 256 * 128, 0, scr, it - I2, lane);
                else if (it < I4) conv_item<0>(p.in[17], 128, 128, (bf16_t*)(ws + WS_WMQK), 256 * 128, 128, scr, it - I3, lane);
                else if (it < I5) conv_item<0>(p.in[21], 1024, 1024, (bf16_t*)(ws + WS_WOUT), 0, 0, scr, it - I4, lane);
                else if (it < I6) conv_item<0>(p.in[23], 1024, 256, (bf16_t*)(ws + WS_WRGU), 0, 0, scr, it - I5, lane);
                else if (it < I7) conv_item<1>(p.in[28], 1024, 256, (bf16_t*)(ws + WS_WRGU), 0, 256, scr, it - I6, lane);
                else if (it < I8) conv_item<2>(p.in[29], 1024, 256, (bf16_t*)(ws + WS_WRGU), 0, 256, scr, it - I7, lane);
                else conv_item<0>(p.in[30], 256, 1024, (bf16_t*)(ws + WS_WDSH), 0, 0, scr, it - I8, lane);
            }
            u32x4* zp = (u32x4*)((bf16_t*)(ws + WS_WIN) + (size_t)IN_DIM * 1024);
            const int zt0 = split ? (bid - 96) * NT + tid : bid * NT + tid, ztn = split ? (G - 96) * NT : G * NT;
            for (int i = zt0; i < (2304 - IN_DIM) * 1024 / 8; i += ztn) zp[i] = (u32x4){0u, 0u, 0u, 0u};
        }
    }
    xcd_barrier(xbar); TSTAMP();
    { FRESH_IDS(); norm_mod_rows(p.in[0], p.in[5], ada, 0, 1024, (bf16_t*)(ws + B_H1), gw, ngw, lane); }
    xcd_barrier(xbar); TSTAMP();
    {
        const pg8::Gemm g{(const bf16_t*)(ws + B_H1), (const bf16_t*)(ws + WS_WIN), T, 2304, 1024, 1024, 1024, 0};
        pg8::StaticOrder SO; SO.init(T, 2304, G, bid);
        const PgProj E{(bf16_t*)(ws + B_PROJ), (float*)(ws + B_GRAW)};
        pg8::gemm_phase<PgProj, pg8::StaticOrder, true, true>(lds, g, SO, E);
    }
    xcd_barrier(xbar); TSTAMP();
    { FRESH_IDS(); post_proj_rows(p, gw, ngw, lane); }
    xcd_barrier(xbar); TSTAMP();
    {
        {   const pg8::Gemm g{(const bf16_t*)(ws + B_CQN), (const bf16_t*)(ws + WS_WUQ), T, 768, QLORA, QLORA, QLORA, 0};
            pg8::StaticOrder SO; SO.init(T, 768, G, bid); const PgBf16 E{(bf16_t*)(ws + B_QRAW), 768};
            pg8::gemm_phase<PgBf16, pg8::StaticOrder, true, true>(lds, g, SO, E); }
        {   const pg8::Gemm g{(const bf16_t*)(ws + B_CKVN), (const bf16_t*)(ws + WS_WUKV), T, 1024, KVLORA, KVLORA, KVLORA, 0};
            pg8::StaticOrder SO; SO.init(T, 1024, G, bid); const PgBf16 E{(bf16_t*)(ws + B_KVRAW), 1024};
            pg8::gemm_phase<PgBf16, pg8::StaticOrder, true, true>(lds, g, SO, E); }
        {   const pg8::Gemm g{(const bf16_t*)(ws + B_ZC), (const bf16_t*)(ws + WS_WMQK), T, 1024, DM, MINNER, DM, DM};
            pg8::StaticOrder SO; SO.init(T, 1024, G, bid); const PgMqk E{(bf16_t*)(ws + B_MQ), (bf16_t*)(ws + B_MK)};
            pg8::gemm_phase<PgMqk, pg8::StaticOrder, true, true>(lds, g, SO, E); }
    }
    xcd_barrier(xbar); TSTAMP();
    { FRESH_IDS(); qk_post_rows(p, gw, ngw, lane); }
    xcd_barrier(xbar); TSTAMP();
    for (int pr = bid; pr < 256; pr += G) { const int bh = pr & 63, j = pr >> 6; attn_unit(p, lds, bh, 7 - j); attn_unit(p, lds, bh, j); }
    for (int u = bid; u < 1024; u += G) mlstm_a_unit(p, lds, u);
    xcd_barrier(xbar); TSTAMP();
    { FRESH_IDS(); mlstm_scan(p, bid * NT + tid, G * NT); }
    { FRESH_IDS(); attn_out_norm_rows(p, gw, ngw, lane); }
    xcd_barrier(xbar); TSTAMP();
    for (int u = bid; u < 1024; u += G) mlstm_c_unit(p, lds, u);
    xcd_barrier(xbar); TSTAMP();
    {
        const pg8::Gemm g{(const bf16_t*)(ws + B_AO), (const bf16_t*)(ws + WS_WOUT), T, 1024, 1024, 1024, 1024, 0};
        pg8::StaticOrder SO; SO.init(T, 1024, G, bid); const PgResid E{p.in[0], ada, 2048, p.out};
        pg8::gemm_phase<PgResid, pg8::StaticOrder, true, true>(lds, g, SO, E);
    }
    xcd_barrier(xbar); TSTAMP();
    { FRESH_IDS(); norm_mod_rows(p.out, p.in[22], ada, 3072, 4096, (bf16_t*)(ws + C_H2), gw, ngw, lane); }
    xcd_barrier(xbar); TSTAMP();
    {
        const pg8::Gemm g{(const bf16_t*)(ws + C_H2), (const bf16_t*)(ws + WS_WRGU), T, 768, 1024, 1024, 1024, 0};
        pg8::StaticOrder SO; SO.init(T, 768, G, bid); const PgRgu E{(float*)(ws + C_LOGITS), (bf16_t*)(ws + C_ACTSH)};
        pg8::gemm_phase<PgRgu, pg8::StaticOrder, true, true>(lds, g, SO, E);
    }
    xcd_barrier(xbar); TSTAMP();
    { FRESH_IDS(); route_rows(p, gw, ngw, lane); }
    {
        const pg8::Gemm g{(const bf16_t*)(ws + C_ACTSH), (const bf16_t*)(ws + WS_WDSH), T, 1024, 256, 256, 256, 0};
        pg8::StaticOrder SO; SO.init(T, 1024, G, bid); const PgBf16 E{(bf16_t*)(ws + C_SHOUT), 1024};
        pg8::gemm_phase<PgBf16, pg8::StaticOrder, true, true>(lds, g, SO, E);
    }
    xcd_barrier(xbar); TSTAMP();
    LAS int* base = (LAS int*)(lds + 132 * 1024);
    LAS int* tsx = base + 256;
    const int ngrp = (G % 8 == 0) ? 8 : 1, gx = bid % ngrp, gidx = bid / ngrp, gper = G / ngrp, nexp = NE / ngrp;
    { FRESH_IDS(); expert_prefix(p, base, tsx, tid, gx, ngrp); }
    {
        const int* cnt = (const int*)(ws + WS_CTL);
        const int ntile = tsx[nexp];
        for (int u = gidx; u < ntile * 4; u += gper) {
            const int tg = u >> 2, tn = u & 3;
            int lo = 0, hi = nexp - 1;
            while (lo < hi) { const int mid = (lo + hi + 1) >> 1; if (tsx[mid] <= tg) lo = mid; else hi = mid - 1; }
            const int e = gx + ngrp * lo, blk = tg - tsx[lo], c = __hip_atomic_load(cnt + e, __ATOMIC_RELAXED, __HIP_MEMORY_SCOPE_AGENT);
            const int nvalid = min(256, c - blk * 256);
            const RowGather RP{(const bf16_t*)(ws + C_H2), (const int*)(ws + C_LISTTOK) + (size_t)e * CAP + blk * 256, nvalid};
            const ColGU CP{p.in[25] + (size_t)e * 1024 * 256, p.in[26] - p.in[25]};
            const EpiExpAct E{(bf16_t*)(ws + C_ACTE), base[e] + blk * 256, nvalid};
            gemm2_tile(lds, RP, CP, 256, 1024, 0, tn * 128, E, nvalid);
        }
    }
    xcd_barrier(xbar); TSTAMP();
    {
        const int* cnt = (const int*)(ws + WS_CTL);
        const int ntile = tsx[nexp];
        for (int u = gidx; u < ntile * 8; u += gper) {
            const int tg = u >> 3, tn = u & 7;
            int lo = 0, hi = nexp - 1;
            while (lo < hi) { const int mid = (lo + hi + 1) >> 1; if (tsx[mid] <= tg) lo = mid; else hi = mid - 1; }
            const int e = gx + ngrp * lo, blk = tg - tsx[lo], c = __hip_atomic_load(cnt + e, __ATOMIC_RELAXED, __HIP_MEMORY_SCOPE_AGENT);
            const int nvalid = min(256, c - blk * 256);
            const int slot0 = base[e] + blk * 256;
            const RowSlots RP{(const bf16_t*)(ws + C_ACTE) + (size_t)slot0 * EDIM, nvalid};
            const ColDense CP{p.in[27] + (size_t)e * 256 * 1024, 1024};
            const EpiExpDown E{(bf16_t*)(ws + C_Y), (const float*)(ws + C_LISTW) + (size_t)e * CAP + blk * 256, slot0, nvalid};
            gemm2_tile(lds, RP, CP, 1024, 256, 0, tn * 128, E, nvalid);
        }
    }
    xcd_barrier(xbar); TSTAMP();
    { FRESH_IDS(); combine_rows(p, base, gw, ngw, lane); }
#if DBG_STAGE == 2
    xcd_barrier(xbar); TSTAMP();
    xcd_barrier(xbar);
    {   FRESH_IDS();
        const unsigned long long* ts = (const unsigned long long*)(ws + WS_CTL + 16384 + 8192);
        const float tus = (float)(long long)(ts[TS_A1] - ts[TS_A0]) * 0.01f;
        const float cadd = sqrtf(2.5e-3f * tus * (1.f / 500.f));
        for (size_t i = (size_t)bid * NT + tid; i < (size_t)T * D / 4; i += (size_t)G * NT) { f32x4 v = ((f32x4*)p.out)[i]; v = v + cadd; ((f32x4*)p.out)[i] = v; }
    }
#endif
}

extern "C" void kernel_launch(void* const* d_in, const int* in_sizes, int n_in,
                              void* d_out, int out_size, void* d_ws, size_t ws_size,
                              hipStream_t stream) {
    static int grid_blocks = 0;
    if (!grid_blocks) {
        if (n_in != 31 || out_size != T * D || ws_size < WS_END) { fprintf(stderr, "kernel_launch: unexpected shapes n_in=%d out=%d ws=%zu (need %zu)\n", n_in, out_size, ws_size, (size_t)WS_END); grid_blocks = -1; return; }
        int dev = 0, cus = 0, per_cu = 0;
        (void)hipGetDevice(&dev);
        (void)hipDeviceGetAttribute(&cus, hipDeviceAttributeMultiprocessorCount, dev);
        (void)hipFuncSetAttribute((const void*)fwd_kernel, hipFuncAttributeMaxDynamicSharedMemorySize, LDS_BYTES);
        (void)hipOccupancyMaxActiveBlocksPerMultiprocessor(&per_cu, (const void*)fwd_kernel, NT, LDS_BYTES);
        if (per_cu < 1) per_cu = 1;
        grid_blocks = cus * per_cu;
        fprintf(stderr, "kernel_launch: cus=%d per_cu=%d grid=%d ws=%zu\n", cus, per_cu, grid_blocks, ws_size);
    }
    if (grid_blocks < 0) return;
    (void)hipMemsetAsync((char*)d_ws + WS_CTL, 0, CTL_BYTES, stream);
    Params p{};
    for (int i = 0; i < 31; ++i) p.in[i] = (const float*)d_in[i];
    p.out = (float*)d_out; p.ws = (unsigned char*)d_ws;
    void* args[] = {&p};
    hipError_t e = hipLaunchCooperativeKernel((const void*)fwd_kernel, dim3(grid_blocks), dim3(NT), args, LDS_BYTES, stream);
    if (e != hipSuccess) fprintf(stderr, "cooperative launch failed: %s (grid %d)\n", hipGetErrorString(e), grid_blocks);
}
```

```cpp
#include <hip/hip_runtime.h>
#include <hip/hip_cooperative_groups.h>
#include <cstdio>
#include <cstdint>
namespace cg = cooperative_groups;
#ifndef DBG_STAGE
#define DBG_STAGE 0
#endif
#define TS_A0 2
#define TS_A1 3
#define TS_B0 2
#define TS_B1 3

#define LAS __attribute__((address_space(3)))
typedef unsigned short bf16_t;
typedef short bf16x8 __attribute__((ext_vector_type(8)));
typedef short bf16x4 __attribute__((ext_vector_type(4)));
typedef float f32x4 __attribute__((ext_vector_type(4)));
typedef float f32x2 __attribute__((ext_vector_type(2)));
typedef unsigned u32x4 __attribute__((ext_vector_type(4)));
typedef unsigned u32x2 __attribute__((ext_vector_type(2)));

constexpr int NT = 512, NWAVES = 8;
constexpr int LDS_BYTES = 144 * 1024;
constexpr int Bsz = 8, S = 2048, D = 1024, T = Bsz * S;
constexpr int H_MLA = 8, DQK = 96, DNOPE = 64, DROPE = 32, DV = 64, QLORA = 384, KVLORA = 256;
constexpr int H_ML = 4, DM = 128, MINNER = 512, CHUNK = 64, NCH = S / CHUNK;
constexpr int IN_DIM = 2216;
constexpr int OFF_CQ = 0, OFF_CKV = 384, OFF_KR = 640, OFF_Z = 672, OFF_MV = 1184, OFF_MO = 1696, OFF_GATE = 2208;
constexpr int NE = 256, TOPK = 8, EDIM = 256, SDIM = 256;
constexpr int CAP = T;
constexpr float RMS_EPS = 1e-6f;

constexpr size_t MiB = 1u << 20;
constexpr size_t WS_CTL = 0;
constexpr size_t CTL_BYTES = 65536;
constexpr size_t WS_CNT = 32768;
constexpr int CNT_STRIDE = 32;
constexpr size_t WS_ADA = 1 * MiB;
constexpr size_t WS_BC = 2 * MiB;
constexpr size_t WS_MLOC = WS_BC + 8192;
constexpr size_t WS_MPREV = WS_BC + 16384;
constexpr size_t WS_DN = 2 * MiB + 512 * 1024;
constexpr size_t WS_NPREV = 3 * MiB;
constexpr size_t WS_WIN = 4 * MiB;
constexpr size_t WS_WUQ = 9 * MiB;
constexpr size_t WS_WUKV = 10 * MiB;
constexpr size_t WS_WMQK = 11 * MiB;
constexpr size_t WS_WOUT = 12 * MiB;
constexpr size_t WS_WRGU = 14 * MiB;
constexpr size_t WS_WDSH = 16 * MiB;
constexpr size_t WS_WGU = 32 * MiB;
constexpr size_t WS_WD = 288 * MiB;
constexpr size_t RB = 416 * MiB;
constexpr size_t B_PROJ = RB;
constexpr size_t B_GRAW = RB + 70 * MiB;
constexpr size_t B_GL = RB + 71 * MiB;
constexpr size_t B_H1 = RB + 72 * MiB;
constexpr size_t B_CQN = RB + 104 * MiB;
constexpr size_t B_CKVN = RB + 116 * MiB;
constexpr size_t B_ZC = RB + 124 * MiB;
constexpr size_t B_QRAW = RB + 140 * MiB;
constexpr size_t B_KVRAW = RB + 164 * MiB;
constexpr size_t B_MQ = RB + 196 * MiB;
constexpr size_t B_MK = RB + 212 * MiB;
constexpr size_t B_Q = RB + 228 * MiB;
constexpr size_t B_K = RB + 252 * MiB;
constexpr size_t B_ORAW = RB + 276 * MiB;
constexpr size_t B_AO = RB + 292 * MiB;
constexpr size_t B_DC = RB + 324 * MiB;
constexpr size_t B_CPREV = RB + 388 * MiB;
constexpr size_t C_H2 = RB;
constexpr size_t C_LOGITS = RB + 32 * MiB;
constexpr size_t C_ACTSH = RB + 48 * MiB;
constexpr size_t C_SHOUT = RB + 56 * MiB;
constexpr size_t C_TOKE = RB + 88 * MiB;
constexpr size_t C_TOKW = RB + 89 * MiB;
constexpr size_t C_TOKPOS = RB + 90 * MiB;
constexpr size_t C_LISTTOK = RB + 92 * MiB;
constexpr size_t C_LISTW = RB + 108 * MiB;
constexpr size_t C_ACTE = RB + 124 * MiB;
constexpr size_t C_Y = RB + 188 * MiB;
constexpr size_t WS_END = RB + 444 * MiB;

struct Params {
    const float* in[31];
    float* out;
    unsigned char* ws;
};

typedef __bf16 bf16x2v __attribute__((ext_vector_type(2)));
__device__ __forceinline__ unsigned cvt_pk_bf16(float lo, float hi) { f32x2 v = {lo, hi}; bf16x2v b = __builtin_convertvector(v, bf16x2v); return __builtin_bit_cast(unsigned, b); }
__device__ __forceinline__ float bf2f(unsigned short b) { return __uint_as_float((unsigned)b << 16); }
__device__ __forceinline__ float bflo(unsigned u) { return __uint_as_float(u << 16); }
__device__ __forceinline__ float bfhi(unsigned u) { return __uint_as_float(u & 0xffff0000u); }
__device__ __forceinline__ float wave_sum(float v) {
#pragma unroll
    for (int o = 1; o < 64; o <<= 1) v += __shfl_xor(v, o);
    return v;
}
__device__ __forceinline__ float wave_max(float v) {
#pragma unroll
    for (int o = 1; o < 64; o <<= 1) v = fmaxf(v, __shfl_xor(v, o));
    return v;
}
__device__ __forceinline__ float sigmoidf_(float x) { return 1.f / (1.f + __expf(-x)); }
__device__ __forceinline__ float siluf_(float x) { return x / (1.f + __expf(-x)); }
__device__ __forceinline__ int fresh_tid() { int t = threadIdx.x; asm volatile("" : "+v"(t)); return t; }
#define MFMA16(a, b, c) __builtin_amdgcn_mfma_f32_16x16x32_bf16((a), (b), (c), 0, 0, 0)


#define XB_TMO      128
#define XB_XCNT(j)  (256  + 64 * (j))
#define XB_XSUB(j)  (1280 + 64 * (j))
#define XB_XGEN(j)  (2304 + 64 * (j))
#define XB_TOP      3328
#define XB_TOPGEN   3392
#define XCD_BAR_WORDS 3456
#define XB_SPIN_CAP (1u << 23)
__device__ __forceinline__ unsigned xb_ld(unsigned* p)              { return __hip_atomic_load(p, __ATOMIC_RELAXED, __HIP_MEMORY_SCOPE_AGENT); }
__device__ __forceinline__ unsigned xb_add(unsigned* p, unsigned v) { return __hip_atomic_fetch_add(p, v, __ATOMIC_RELAXED, __HIP_MEMORY_SCOPE_AGENT); }
__device__ __forceinline__ unsigned xb_xcc_id() { return (unsigned)__builtin_amdgcn_s_getreg((3 << 11) | 20) & 0xFu; }
#define XB_SPIN(cond, bar) do { unsigned _sp = 0; while (cond) { __builtin_amdgcn_s_sleep(1); \
    if ((++_sp & 255u) == 0u) { if (xb_ld(&(bar)[XB_TMO])) break; if (_sp > XB_SPIN_CAP) { atomicAdd(&(bar)[XB_TMO], 1u); break; } } } } while (0)
struct XcdBarrier { unsigned* bar; unsigned x; volatile LAS unsigned* st; };
__device__ __forceinline__ XcdBarrier xcd_barrier_post(unsigned* bar, volatile LAS unsigned* st) {
    XcdBarrier b; b.bar = bar; b.x = xb_xcc_id(); b.st = st;
    if (threadIdx.x == 0) (void)xb_add(&bar[XB_XCNT(b.x)], 1u);
    return b;
}
__device__ __forceinline__ void xcd_barrier_complete(unsigned* bar, unsigned x, unsigned& nloc, unsigned& nx) {
    const unsigned G = gridDim.x * gridDim.y * gridDim.z;
    unsigned sum, cnt, mine, sp = 0u;
    for (;;) {
        sum = 0u; cnt = 0u; mine = 0u;
#pragma unroll
        for (unsigned j = 0; j < 16; ++j) { const unsigned c = xb_ld(&bar[XB_XCNT(j)]); sum += c; cnt += (c > 0u) ? 1u : 0u; mine = (j == x) ? c : mine; }
        if (sum == G) break;
        __builtin_amdgcn_s_sleep(1);
        if ((++sp & 255u) == 0u) { if (xb_ld(&bar[XB_TMO])) break; if (sp > XB_SPIN_CAP) { atomicAdd(&bar[XB_TMO], 1u); break; } }
    }
    nloc = mine > 0u ? mine : 1u; nx = cnt > 0u ? cnt : 1u;
}
__device__ __forceinline__ void xcd_barrier(const XcdBarrier& b) {
    asm volatile("s_waitcnt vmcnt(0)" ::: "memory");
    __syncthreads();
    if (threadIdx.x == 0) {
        unsigned* bar = b.bar;
        __builtin_amdgcn_s_waitcnt(0);
        unsigned nloc = b.st[0], nx = b.st[1];
        if (nloc == 0u) { xcd_barrier_complete(bar, b.x, nloc, nx); b.st[0] = nloc; b.st[1] = nx; }
        const unsigned old = xb_add(&bar[XB_XSUB(b.x)], 1u);
        const unsigned gen = old / nloc;
        if (old + 1u == (gen + 1u) * nloc) {
            __builtin_amdgcn_fence(__ATOMIC_RELEASE, "agent");
            asm volatile("s_waitcnt vmcnt(0)" ::: "memory");
            const unsigned og = xb_add(&bar[XB_TOP], 1u);
            const unsigned tg = og / nx;
            if (og + 1u == (tg + 1u) * nx) xb_add(&bar[XB_TOPGEN], 1u);
            else XB_SPIN(xb_ld(&bar[XB_TOPGEN]) == tg, bar);
            __builtin_amdgcn_fence(__ATOMIC_ACQUIRE, "agent");
            xb_add(&bar[XB_XGEN(b.x)], 1u);
            asm volatile("s_waitcnt vmcnt(0)" ::: "memory");
        } else {
            XB_SPIN(xb_ld(&bar[XB_XGEN(b.x)]) == gen, bar);
            __builtin_amdgcn_fence(__ATOMIC_ACQUIRE, "agent");
            asm volatile("s_waitcnt vmcnt(0)" ::: "memory");
        }
    }
    __syncthreads();
}

template <int MAP>
__device__ __forceinline__ int map_row(int n) {
    if (MAP == 0) return n;
    if (MAP == 1) return ((n >> 4) << 5) + (n & 15);
    return ((n >> 4) << 5) + 16 + (n & 15);
}
template <int MAP>
__device__ __forceinline__ void conv_item(const float* src, int K, int N, bf16_t* dst, size_t dst_mat_stride, int row_off, LAS float* scr, int it, int lane) {
    const int nblk = (N + 31) / 32, kblk = K / 64, per = nblk * kblk;
    const int mat = it / per, r = it - mat * per, kb = r / nblk, nb = r - kb * nblk, k0 = kb * 64, n0 = nb * 32;
    const float* W = src + (size_t)mat * K * N;
    bf16_t* WT = dst + (size_t)mat * dst_mat_stride;
    const int nn = n0 + (lane & 31);
    const bool nok = nn < N;
    float v[32];
    const float* wp = W + (size_t)(k0 + (lane >> 5)) * N + nn;
#pragma unroll
    for (int i = 0; i < 32; ++i) v[i] = nok ? wp[(size_t)(2 * i) * N] : 0.f;
#pragma unroll
    for (int i = 0; i < 32; ++i) scr[(2 * i + (lane >> 5)) * 33 + (lane & 31)] = v[i];
    asm volatile("s_waitcnt lgkmcnt(0)" ::: "memory");
    const int c = lane & 7;
#pragma unroll
    for (int j = 0; j < 4; ++j) {
        const int n = (lane >> 3) + 8 * j;
        const LAS float* sp = scr + (8 * c) * 33 + n;
        u32x4 o; o.x = cvt_pk_bf16(sp[0 * 33], sp[1 * 33]); o.y = cvt_pk_bf16(sp[2 * 33], sp[3 * 33]); o.z = cvt_pk_bf16(sp[4 * 33], sp[5 * 33]); o.w = cvt_pk_bf16(sp[6 * 33], sp[7 * 33]);
        if (n0 + n < N) *(u32x4*)(WT + (size_t)(row_off + map_row<MAP>(n0 + n)) * K + k0 + 8 * c) = o;
    }
    asm volatile("s_waitcnt lgkmcnt(0)" ::: "memory");
}

__device__ __forceinline__ void ada_unit(const Params& p, LAS unsigned char* lds, int u, int tid) {
    LAS float* cond = (LAS float*)lds;
    LAS float* red = (LAS float*)(lds + 32768);
    const float* c = p.in[1]; const float* w = p.in[3]; const float* bias = p.in[4];
    float* ada = (float*)(p.ws + WS_ADA);
    const int lane = tid & 63, wv = tid >> 6;
    for (int i = tid; i < 8 * 1024; i += NT) cond[i] = siluf_(c[i]);
    __syncthreads();
    float acc[8];
#pragma unroll
    for (int b = 0; b < 8; ++b) acc[b] = 0.f;
    const int col = u * 64 + lane;
#pragma unroll 16
    for (int k = wv * 128; k < wv * 128 + 128; ++k) {
        const float wv_ = w[(size_t)k * 6144 + col];
#pragma unroll
        for (int b = 0; b < 8; ++b) acc[b] += cond[b * 1024 + k] * wv_;
    }
#pragma unroll
    for (int b = 0; b < 8; ++b) red[(wv * 8 + b) * 64 + lane] = acc[b];
    __syncthreads();
    {
        const int b = tid >> 6;
        float s = 0.f;
#pragma unroll
        for (int w2 = 0; w2 < 8; ++w2) s += red[(w2 * 8 + b) * 64 + lane];
        ada[b * 6144 + col] = s + bias[col];
    }
    __syncthreads();
}

__device__ __forceinline__ void norm_mod_rows(const float* X, const float* g, const float* ada, int sh_off, int sc_off, bf16_t* Hout, int gw, int ngw, int lane) {
    for (int row = gw; row < T; row += ngw) {
        const int b = row / S;
        const f32x4* xr = (const f32x4*)(X + (size_t)row * D) + lane;
        f32x4 v[4]; float ss = 0.f;
#pragma unroll
        for (int j = 0; j < 4; ++j) { v[j] = xr[64 * j]; ss += v[j].x * v[j].x + v[j].y * v[j].y + v[j].z * v[j].z + v[j].w * v[j].w; }
        const float rinv = rsqrtf(wave_sum(ss) * (1.f / D) + RMS_EPS);
        u32x2* o = (u32x2*)(Hout + (size_t)row * D) + lane;
#pragma unroll
        for (int j = 0; j < 4; ++j) {
            const int k = 4 * (lane + 64 * j);
            const f32x4 gg = *(const f32x4*)(g + k), sc = *(const f32x4*)(ada + b * 6144 + sc_off + k), sh = *(const f32x4*)(ada + b * 6144 + sh_off + k);
            const f32x4 h = v[j] * rinv * gg * (1.f + sc) + sh;
            u32x2 w; w.x = cvt_pk_bf16(h.x, h.y); w.y = cvt_pk_bf16(h.z, h.w);
            o[64 * j] = w;
        }
    }
}

__device__ __forceinline__ void post_proj_rows(const Params& p, int gw, int ngw, int lane) {
    const bf16_t* proj = (const bf16_t*)(p.ws + B_PROJ);
    const float* graw = (const float*)(p.ws + B_GRAW);
    float* gl = (float*)(p.ws + B_GL);
    bf16_t* cqn = (bf16_t*)(p.ws + B_CQN); bf16_t* ckvn = (bf16_t*)(p.ws + B_CKVN); bf16_t* zc = (bf16_t*)(p.ws + B_ZC);
    const float* g_cq = p.in[7]; const float* g_ckv = p.in[9]; const float* conv_w = p.in[14]; const float* conv_b = p.in[15];
    const float* b_i = p.in[18]; const float* b_f = p.in[19];
    for (int row = gw; row < T; row += ngw) {
        const bf16_t* pr = proj + (size_t)row * IN_DIM;
        const int s = row % S;
        {
            const unsigned* q = (const unsigned*)(pr + OFF_CQ) + lane * 3;
            unsigned a0 = q[0], a1 = q[1], a2 = q[2];
            float f[6] = {bflo(a0), bfhi(a0), bflo(a1), bfhi(a1), bflo(a2), bfhi(a2)};
            float ss = 0.f;
#pragma unroll
            for (int j = 0; j < 6; ++j) ss += f[j] * f[j];
            const float rinv = rsqrtf(wave_sum(ss) * (1.f / QLORA) + RMS_EPS);
            const float* gq = g_cq + lane * 6;
            unsigned* o = (unsigned*)(cqn + (size_t)row * QLORA) + lane * 3;
            o[0] = cvt_pk_bf16(f[0] * rinv * gq[0], f[1] * rinv * gq[1]);
            o[1] = cvt_pk_bf16(f[2] * rinv * gq[2], f[3] * rinv * gq[3]);
            o[2] = cvt_pk_bf16(f[4] * rinv * gq[4], f[5] * rinv * gq[5]);
        }
        {
            const u32x2 a = *((const u32x2*)(pr + OFF_CKV) + lane);
            float f[4] = {bflo(a.x), bfhi(a.x), bflo(a.y), bfhi(a.y)};
            float ss = f[0] * f[0] + f[1] * f[1] + f[2] * f[2] + f[3] * f[3];
            const float rinv = rsqrtf(wave_sum(ss) * (1.f / KVLORA) + RMS_EPS);
            const float* gk = g_ckv + lane * 4;
            u32x2 w; w.x = cvt_pk_bf16(f[0] * rinv * gk[0], f[1] * rinv * gk[1]); w.y = cvt_pk_bf16(f[2] * rinv * gk[2], f[3] * rinv * gk[3]);
            *((u32x2*)(ckvn + (size_t)row * KVLORA) + lane) = w;
        }
        {
            const int c0 = lane * 8;
            float acc[8];
#pragma unroll
            for (int j = 0; j < 8; ++j) acc[j] = conv_b[c0 + j];
#pragma unroll
            for (int tap = 0; tap < 4; ++tap) {
                const int ds = tap - 3;
                if (s + ds >= 0) {
                    const u32x4 z = *(const u32x4*)(pr + (ptrdiff_t)ds * IN_DIM + OFF_Z + c0);
                    const float* cw = conv_w + tap * MINNER + c0;
                    acc[0] += bflo(z.x) * cw[0]; acc[1] += bfhi(z.x) * cw[1]; acc[2] += bflo(z.y) * cw[2]; acc[3] += bfhi(z.y) * cw[3];
                    acc[4] += bflo(z.z) * cw[4]; acc[5] += bfhi(z.z) * cw[5]; acc[6] += bflo(z.w) * cw[6]; acc[7] += bfhi(z.w) * cw[7];
                }
            }
            u32x4 o; o.x = cvt_pk_bf16(siluf_(acc[0]), siluf_(acc[1])); o.y = cvt_pk_bf16(siluf_(acc[2]), siluf_(acc[3]));
            o.z = cvt_pk_bf16(siluf_(acc[4]), siluf_(acc[5])); o.w = cvt_pk_bf16(siluf_(acc[6]), siluf_(acc[7]));
            *(u32x4*)(zc + (size_t)row * MINNER + c0) = o;
        }
        if (lane < 8) {
            const float gr = graw[(size_t)row * 8 + lane];
            float o;
            if (lane < 4) o = gr + b_i[lane];
            else { const float xx = gr + b_f[lane - 4]; o = fminf(xx, 0.f) - log1pf(__expf(-fabsf(xx))); }
            gl[(size_t)row * 8 + lane] = o;
        }
    }
}

__device__ __forceinline__ void qk_post_rows(const Params& p, int gw, int ngw, int lane) {
    const bf16_t* qraw = (const bf16_t*)(p.ws + B_QRAW); const bf16_t* kvraw = (const bf16_t*)(p.ws + B_KVRAW);
    const bf16_t* proj = (const bf16_t*)(p.ws + B_PROJ);
    bf16_t* Q = (bf16_t*)(p.ws + B_Q); bf16_t* Kb = (bf16_t*)(p.ws + B_K);
    const int* positions = (const int*)p.in[2];
    const float* g_qn = p.in[11]; const float* g_kn = p.in[12];
    const float qscale = 0.10206207261596575f * 1.4426950408889634f;
    for (int it = gw; it < T * 4; it += ngw) {
        const int row = it >> 2, hp = it & 3, h = hp * 2 + (lane >> 5), l = lane & 31;
        const int b = row / S, s = row % S;
        const float pos = (float)positions[row];
        const int i = l & 15;
        const float inv_freq = exp2f(-(float)(2 * i) * (13.287712379549449f / 32.f));
        const float ang = pos * inv_freq;
        float sn, cs; sincosf(ang, &sn, &cs);
        {
            const bf16_t* qr = qraw + (size_t)row * 768 + h * 96;
            float v0 = bf2f(qr[l]), v1 = bf2f(qr[l + 32]), v2 = bf2f(qr[l + 64]);
            float ss = v0 * v0 + v1 * v1 + v2 * v2;
#pragma unroll
            for (int o = 1; o < 32; o <<= 1) ss += __shfl_xor(ss, o);
            const float rinv = rsqrtf(ss * (1.f / 96.f) + RMS_EPS);
            v0 *= rinv * g_qn[l]; v1 *= rinv * g_qn[l + 32]; v2 *= rinv * g_qn[l + 64];
            const float other = __shfl_xor(v2, 16);
            const float r = (l < 16) ? (v2 * cs - other * sn) : (other * sn + v2 * cs);
            bf16_t* qo = Q + ((size_t)(b * H_MLA + h) * S + s) * 96;
            qo[l] = (bf16_t)(cvt_pk_bf16(v0 * qscale, 0.f) & 0xffff);
            qo[l + 32] = (bf16_t)(cvt_pk_bf16(v1 * qscale, 0.f) & 0xffff);
            qo[l + 64] = (bf16_t)(cvt_pk_bf16(r * qscale, 0.f) & 0xffff);
        }
        {
            const bf16_t* kr = kvraw + (size_t)row * 1024 + h * 128;
            float v0 = bf2f(kr[l]), v1 = bf2f(kr[l + 32]), v2 = bf2f(proj[(size_t)row * IN_DIM + OFF_KR + l]);
            float ss = v0 * v0 + v1 * v1 + v2 * v2;
#pragma unroll
            for (int o = 1; o < 32; o <<= 1) ss += __shfl_xor(ss, o);
            const float rinv = rsqrtf(ss * (1.f / 96.f) + RMS_EPS);
            v0 *= rinv * g_kn[l]; v1 *= rinv * g_kn[l + 32]; v2 *= rinv * g_kn[l + 64];
            const float other = __shfl_xor(v2, 16);
            const float r = (l < 16) ? (v2 * cs - other * sn) : (other * sn + v2 * cs);
            bf16_t* ko = Kb + ((size_t)(b * H_MLA + h) * S + s) * 96;
            ko[l] = (bf16_t)(cvt_pk_bf16(v0, 0.f) & 0xffff);
            ko[l + 32] = (bf16_t)(cvt_pk_bf16(v1, 0.f) & 0xffff);
            ko[l + 64] = (bf16_t)(cvt_pk_bf16(r, 0.f) & 0xffff);
        }
    }
}

__device__ __forceinline__ void attn_out_norm_rows(const Params& p, int gw, int ngw, int lane) {
    const bf16_t* oraw = (const bf16_t*)(p.ws + B_ORAW); bf16_t* ao = (bf16_t*)(p.ws + B_AO); const float* g = p.in[13];
    for (int row = gw; row < T; row += ngw) {
        const u32x4 a = *((const u32x4*)(oraw + (size_t)row * 512) + lane);
        float f[8] = {bflo(a.x), bfhi(a.x), bflo(a.y), bfhi(a.y), bflo(a.z), bfhi(a.z), bflo(a.w), bfhi(a.w)};
        float ss = 0.f;
#pragma unroll
        for (int j = 0; j < 8; ++j) ss += f[j] * f[j];
        const float rinv = rsqrtf(wave_sum(ss) * (1.f / 512.f) + RMS_EPS);
        const float* gg = g + lane * 8;
        u32x4 o; o.x = cvt_pk_bf16(f[0] * rinv * gg[0], f[1] * rinv * gg[1]); o.y = cvt_pk_bf16(f[2] * rinv * gg[2], f[3] * rinv * gg[3]);
        o.z = cvt_pk_bf16(f[4] * rinv * gg[4], f[5] * rinv * gg[5]); o.w = cvt_pk_bf16(f[6] * rinv * gg[6], f[7] * rinv * gg[7]);
        *((u32x4*)(ao + (size_t)row * 1024) + lane) = o;
    }
}

namespace pg8 {
#define PG8_LAS __attribute__((address_space(3)))
typedef unsigned short bf16_t;
typedef short bf16x8 __attribute__((ext_vector_type(8)));
typedef float f32x4 __attribute__((ext_vector_type(4)));
typedef unsigned u32x4 __attribute__((ext_vector_type(4)));
constexpr int BM = 256, BK = 64, HALF = 128, HTB = HALF * BK * 2  , STAGE_BYTES = 8 * HTB, NXCD = 8, WGM = 8;

__host__ __device__ __forceinline__ int lds_byte(int r, int c) { const int st = (r >> 4) * 2 + (c >> 5), rr = r & 15, cc = c & 31, ob = rr * 64 + cc * 2; return st * 1024 + (ob ^ (((ob >> 9) & 1) << 5)); }
__host__ __device__ __forceinline__ void stage_rc(int b, int& R, int& C) { const int st = b / 1024, sb = b % 1024, swz = sb ^ (((sb >> 9) & 1) << 5); R = (st >> 1) * 16 + swz / 64; C = (st & 1) * 32 + (swz % 64) / 2; }
__host__ __device__ __forceinline__ int perm32(int rho) { const int n = rho >> 4, i = rho & 15; return 8 * (i >> 2) + 4 * n + (i & 3); }

struct Unit { int pm, pn; };
struct Gemm { const bf16_t* A; const bf16_t* Bt; int M, N, K, lda, ldb, apn; };

struct StaticOrder {
    int nM, nN, nwg, G, c;
    __host__ __device__ void init(int M, int N, int G_, int c_) { nM = M / BM; nN = N / BM; nwg = nM * nN; G = G_; c = c_; }
    __host__ __device__ bool next(int i, Unit& u) const {
        const long L = (long)i * G + c; if (L >= nwg) return false;
        int wgid = (int)L; { const int q = nwg / NXCD, r = nwg % NXCD, xcd = wgid % NXCD, off = wgid / NXCD; wgid = (xcd < r ? xcd * (q + 1) : r * (q + 1) + (xcd - r) * q) + off; }
        const int nig = WGM * nN, gid = wgid / nig, fm = gid * WGM, gsz = (nM - fm) < WGM ? (nM - fm) : WGM;
        u.pm = fm + ((wgid % nig) % gsz); u.pn = (wgid % nig) / gsz; return true;
    }
    __device__ __forceinline__ void a_ready(const Unit&) const {}
    __device__ __forceinline__ void done(const Unit&) const {}
};


template <class Epi, class Sched, bool ALIGN_EPI = false, bool SP2 = false>
__device__ __forceinline__ void gemm_phase(PG8_LAS unsigned char* lds, const Gemm g, const Sched& S, const Epi& E) {
    const int tid = fresh_tid(), wid = __builtin_amdgcn_readfirstlane(tid >> 6), lane = tid & 63, wr = wid >> 2, wc = wid & 3, fr = lane & 15, fq = lane >> 4;
    const int K = g.K, nt = K / BK;
    unsigned voffA[2], voffB[2];
#pragma unroll
    for (int i = 0; i < 2; ++i) { int R, C; stage_rc(tid * 16 + i * 8192, R, C); const int Rb = Epi::PERM ? ((R & ~31) + perm32(R & 31)) : R;
        voffA[i] = (unsigned)(R * g.lda + C) * 2u; voffB[i] = (unsigned)(Rb * g.ldb + C) * 2u; }
    const size_t kstep = (size_t)(BK * 2);
    const size_t hstepA = (size_t)HALF * g.lda * 2, hstepB = (size_t)HALF * g.ldb * 2;
    const size_t tstepA = 2 * hstepA, tstepB = 2 * hstepB;
    const unsigned ldsw = (unsigned)wid * 1024u;
    const int aoff = lds_byte(wr * 64 + fr, fq * 8), boff = lds_byte(wc * 32 + fr, fq * 8);
#define PG8_SA(b, h) (((b) * 2 + (h)) * HTB)
#define PG8_SB(b, h) ((4 + (b) * 2 + (h)) * HTB)
#define PG8_STAGE(bufoff, gbase, voff) do { _Pragma("unroll") for (int _i = 0; _i < 2; ++_i) \
        __builtin_amdgcn_global_load_lds((const unsigned*)((const char*)(gbase) + (voff)[_i]), (PG8_LAS unsigned*)(lds + (bufoff) + ldsw + _i * 8192), 16, 0, 0); } while (0)
#define PG8_LDA(dst, b, h) do { _Pragma("unroll") for (int m = 0; m < 4; ++m) _Pragma("unroll") for (int k = 0; k < 2; ++k) dst[m][k] = *(const PG8_LAS bf16x8*)(lds + PG8_SA(b, h) + aoff + m * 2048 + k * 1024); } while (0)
#define PG8_LDB(dst, b, h) do { _Pragma("unroll") for (int n = 0; n < 2; ++n) _Pragma("unroll") for (int k = 0; k < 2; ++k) dst[n][k] = *(const PG8_LAS bf16x8*)(lds + PG8_SB(b, h) + boff + n * 2048 + k * 1024); } while (0)
#define PG8_MMA(ai, bj, At, Bt) do { __builtin_amdgcn_s_setprio(1); _Pragma("unroll") for (int m = 0; m < 4; ++m) _Pragma("unroll") for (int n = 0; n < 2; ++n) _Pragma("unroll") for (int k = 0; k < 2; ++k) \
        acc[ai][bj][m][n] = __builtin_amdgcn_mfma_f32_16x16x32_bf16(Bt[n][k], At[m][k], acc[ai][bj][m][n], 0, 0, 0); __builtin_amdgcn_s_setprio(0); } while (0)
#define PG8_WAIT_V(n) asm volatile("s_waitcnt vmcnt(" #n ")" ::: "memory")
#define PG8_WAIT_L(n) asm volatile("s_waitcnt lgkmcnt(" #n ")" ::: "memory")
#define PG8_BAR __builtin_amdgcn_s_barrier()
#define PG8_SCHED __builtin_amdgcn_sched_barrier(0)
    Unit cur, nxt; int ui = 0;
    if (!S.next(0, cur)) return;
    f32x4 acc[2][2][4][2];
#pragma unroll
    for (int a = 0; a < 2; ++a)
#pragma unroll
        for (int b = 0; b < 2; ++b)
#pragma unroll
            for (int m = 0; m < 4; ++m)
#pragma unroll
                for (int n = 0; n < 2; ++n) acc[a][b][m][n] = (f32x4){0.f, 0.f, 0.f, 0.f};
    bf16x8 At[4][2], B0[2][2], B1[2][2];
    const char* cA = (const char*)g.A + (size_t)cur.pm * tstepA + (size_t)cur.pn * g.apn * 2; const char* cB = (const char*)g.Bt + (size_t)cur.pn * tstepB;
    S.a_ready(cur);
    if constexpr (SP2) {
        PG8_STAGE(PG8_SB(0, 0), cB, voffB); PG8_STAGE(PG8_SB(0, 1), cB + hstepB, voffB); PG8_STAGE(PG8_SA(0, 0), cA, voffA); PG8_STAGE(PG8_SA(0, 1), cA + hstepA, voffA);
        if (wr == 1) PG8_BAR;
        PG8_WAIT_V(2); PG8_BAR;
        PG8_STAGE(PG8_SB(1, 0), cB + kstep, voffB); PG8_STAGE(PG8_SA(1, 0), cA + kstep, voffA); PG8_STAGE(PG8_SB(1, 1), cB + hstepB + kstep, voffB);
        PG8_WAIT_V(6); PG8_BAR;
    } else {
        PG8_STAGE(PG8_SB(0, 0), cB, voffB); PG8_STAGE(PG8_SA(0, 0), cA, voffA); PG8_STAGE(PG8_SB(0, 1), cB + hstepB, voffB); PG8_STAGE(PG8_SA(0, 1), cA + hstepA, voffA);
        if (wr == 1) PG8_BAR;
        PG8_WAIT_V(4); PG8_BAR;
        PG8_STAGE(PG8_SB(1, 0), cB + kstep, voffB); PG8_STAGE(PG8_SA(1, 0), cA + kstep, voffA); PG8_STAGE(PG8_SB(1, 1), cB + hstepB + kstep, voffB);
        PG8_WAIT_V(6); PG8_BAR;
    }
    for (;;) {
        const bool has_next = S.next(ui + 1, nxt);
        const char* nA = has_next ? (const char*)g.A + (size_t)nxt.pm * tstepA + (size_t)nxt.pn * g.apn * 2 : cA; const char* nB = has_next ? (const char*)g.Bt + (size_t)nxt.pn * tstepB : cB;
        for (int t = 0; t < nt; t += 2) {
            const bool last = (t == nt - 2);
            const char* a1 = cA + (size_t)(t + 1) * kstep;
            const char* a2 = last ? nA : cA + (size_t)(t + 2) * kstep; const char* b2 = last ? nB : cB + (size_t)(t + 2) * kstep;
            const char* a3 = a2 + kstep; const char* b3 = b2 + kstep;
            if (last && has_next) S.a_ready(nxt);
            if constexpr (SP2) {
            PG8_LDB(B0, 0, 0); PG8_LDB(B1, 0, 1); PG8_SCHED; PG8_LDA(At, 0, 0); PG8_STAGE(PG8_SA(1, 1), a1 + hstepA, voffA);
            PG8_WAIT_V(8); PG8_WAIT_L(0); PG8_BAR; PG8_MMA(0, 0, At, B0); PG8_MMA(0, 1, At, B1); PG8_BAR; PG8_SCHED;
            PG8_LDA(At, 0, 1); PG8_STAGE(PG8_SB(0, 0), b2, voffB); PG8_STAGE(PG8_SB(0, 1), b2 + hstepB, voffB); PG8_STAGE(PG8_SA(0, 0), a2, voffA);
            PG8_WAIT_V(8); PG8_WAIT_L(0); PG8_BAR; PG8_MMA(1, 0, At, B0); PG8_MMA(1, 1, At, B1); PG8_BAR; PG8_SCHED;
            PG8_LDB(B0, 1, 0); PG8_LDB(B1, 1, 1); PG8_SCHED; PG8_LDA(At, 1, 0); PG8_STAGE(PG8_SA(0, 1), a2 + hstepA, voffA);
            PG8_WAIT_V(8); PG8_WAIT_L(0); PG8_BAR; PG8_MMA(0, 0, At, B0); PG8_MMA(0, 1, At, B1); PG8_BAR; PG8_SCHED;
            PG8_LDA(At, 1, 1); PG8_STAGE(PG8_SB(1, 0), b3, voffB); PG8_STAGE(PG8_SB(1, 1), b3 + hstepB, voffB); PG8_STAGE(PG8_SA(1, 0), a3, voffA);
            PG8_WAIT_V(8); PG8_WAIT_L(0); PG8_BAR; PG8_MMA(1, 0, At, B0); PG8_MMA(1, 1, At, B1); PG8_BAR; PG8_SCHED;
            } else {
            PG8_LDB(B0, 0, 0); PG8_SCHED; PG8_LDA(At, 0, 0); PG8_STAGE(PG8_SA(1, 1), a1 + hstepA, voffA);
            PG8_WAIT_L(8); PG8_BAR; PG8_WAIT_L(0); PG8_MMA(0, 0, At, B0); PG8_BAR; PG8_SCHED;
            PG8_LDB(B1, 0, 1); PG8_STAGE(PG8_SB(0, 0), b2, voffB);
            PG8_BAR; PG8_WAIT_L(0); PG8_MMA(0, 1, At, B1); PG8_BAR;
            PG8_LDA(At, 0, 1); PG8_STAGE(PG8_SA(0, 0), a2, voffA);
            PG8_BAR; PG8_WAIT_L(0); PG8_MMA(1, 0, At, B0); PG8_BAR; PG8_SCHED;
            PG8_STAGE(PG8_SB(0, 1), b2 + hstepB, voffB);
            PG8_WAIT_V(6); PG8_BAR; PG8_MMA(1, 1, At, B1); PG8_BAR;
            PG8_LDB(B0, 1, 0); PG8_SCHED; PG8_LDA(At, 1, 0); PG8_STAGE(PG8_SA(0, 1), a2 + hstepA, voffA);
            PG8_WAIT_L(8); PG8_BAR; PG8_WAIT_L(0); PG8_MMA(0, 0, At, B0); PG8_BAR; PG8_SCHED;
            PG8_LDB(B1, 1, 1); PG8_STAGE(PG8_SB(1, 0), b3, voffB);
            PG8_BAR; PG8_WAIT_L(0); PG8_MMA(0, 1, At, B1); PG8_BAR;
            PG8_LDA(At, 1, 1); PG8_STAGE(PG8_SA(1, 0), a3, voffA);
            PG8_BAR; PG8_WAIT_L(0); PG8_MMA(1, 0, At, B0); PG8_BAR; PG8_SCHED;
            PG8_STAGE(PG8_SB(1, 1), b3 + hstepB, voffB);
            PG8_WAIT_V(6); PG8_BAR; PG8_MMA(1, 1, At, B1); PG8_BAR;
            }
        }
        if constexpr (ALIGN_EPI) { if (wr == 0) PG8_BAR; }
        if constexpr (!Epi::AFTER_DRAIN) { E(acc, cur, wr, wc, fr, fq); S.done(cur); }
        if (!has_next) break;
#pragma unroll
        for (int a = 0; a < 2; ++a)
#pragma unroll
            for (int b = 0; b < 2; ++b)
#pragma unroll
                for (int m = 0; m < 4; ++m)
#pragma unroll
                    for (int n = 0; n < 2; ++n) acc[a][b][m][n] = (f32x4){0.f, 0.f, 0.f, 0.f};
        cur = nxt; cA = nA; cB = nB; ++ui;
        if constexpr (ALIGN_EPI) { if (wr == 1) PG8_BAR; }
    }
    PG8_WAIT_V(0);
    if constexpr (!ALIGN_EPI) { if (wr == 0) PG8_BAR; }
    PG8_BAR;
    if constexpr (Epi::AFTER_DRAIN) { E.fused(acc, cur, wr, wc, fr, fq, lds, wid, lane); S.done(cur); }
#undef PG8_SA
#undef PG8_SB
#undef PG8_STAGE
#undef PG8_LDA
#undef PG8_LDB
#undef PG8_MMA
#undef PG8_WAIT_V
#undef PG8_WAIT_L
#undef PG8_BAR
#undef PG8_SCHED
}
}

constexpr int GLD = 80;
constexpr int G2_AS = 256 * GLD * 2;
constexpr int G2_BS = 128 * GLD * 2;
constexpr int G2_STAGE = G2_AS + G2_BS;
template <class RowPtr, class ColPtr, class Epi, int MODE = 0>
__device__ __forceinline__ void gemm2_tile(LAS unsigned char* lds, const RowPtr& RP, const ColPtr& CP, int ldk, int K, int m0, int n0, const Epi& E, int mvalid = 256) {
    const int tid = fresh_tid(), lane = tid & 63, wid = tid >> 6, half = wid >> 2, wm = (wid >> 1) & 1, wn = wid & 1;
    const int fr = lane & 15, fq = lane >> 4;
    const int ht = tid & 255;
    const int ac = (ht & 7) * 8, ar0 = half * 128 + (ht >> 3);
    const int bn = half * 64 + (ht & 63), bk = (ht >> 6) * 16;
    const bf16_t* ap0 = RP(m0 + ar0); const bf16_t* ap1 = RP(m0 + ar0 + 32); const bf16_t* ap2 = RP(m0 + ar0 + 64); const bf16_t* ap3 = RP(m0 + ar0 + 96);
    const float* bp = CP(n0 + bn);
    f32x4 acc[4][4];
#pragma unroll
    for (int m = 0; m < 4; ++m)
#pragma unroll
        for (int n = 0; n < 4; ++n) acc[m][n] = (f32x4){0.f, 0.f, 0.f, 0.f};
    const u32x4 z4 = (u32x4){0u, 0u, 0u, 0u};
    u32x4 ra[4] = {z4, z4, z4, z4}; float rb[16] = {0.f, 0.f, 0.f, 0.f, 0.f, 0.f, 0.f, 0.f, 0.f, 0.f, 0.f, 0.f, 0.f, 0.f, 0.f, 0.f};
    const int nk = K / 64;
#define G2_LOAD(kt_) do { if (MODE == 1) break; const int k0_ = (kt_) * 64; \
        ra[0] = ap0 ? *(const u32x4*)(ap0 + k0_ + ac) : z4; ra[1] = ap1 ? *(const u32x4*)(ap1 + k0_ + ac) : z4; \
        ra[2] = ap2 ? *(const u32x4*)(ap2 + k0_ + ac) : z4; ra[3] = ap3 ? *(const u32x4*)(ap3 + k0_ + ac) : z4; \
        if (bp) { _Pragma("unroll") for (int j_ = 0; j_ < 16; ++j_) rb[j_] = bp[(size_t)(k0_ + bk + j_) * ldk]; } \
        else { _Pragma("unroll") for (int j_ = 0; j_ < 16; ++j_) rb[j_] = 0.f; } } while (0)
#define G2_STORE(buf_) do { LAS bf16_t* As_ = (LAS bf16_t*)(lds + (buf_) * G2_STAGE); LAS bf16_t* Bs_ = (LAS bf16_t*)(lds + (buf_) * G2_STAGE + G2_AS); \
        _Pragma("unroll") for (int j_ = 0; j_ < 4; ++j_) *(LAS u32x4*)(As_ + (ar0 + 32 * j_) * GLD + ac) = ra[j_]; \
        u32x4 w0_, w1_; w0_.x = cvt_pk_bf16(rb[0], rb[1]); w0_.y = cvt_pk_bf16(rb[2], rb[3]); w0_.z = cvt_pk_bf16(rb[4], rb[5]); w0_.w = cvt_pk_bf16(rb[6], rb[7]); \
        w1_.x = cvt_pk_bf16(rb[8], rb[9]); w1_.y = cvt_pk_bf16(rb[10], rb[11]); w1_.z = cvt_pk_bf16(rb[12], rb[13]); w1_.w = cvt_pk_bf16(rb[14], rb[15]); \
        *(LAS u32x4*)(Bs_ + bn * GLD + bk) = w0_; *(LAS u32x4*)(Bs_ + bn * GLD + bk + 8) = w1_; } while (0)
#define G2_COMPUTE(buf_) do { if (MODE == 2) break; const LAS bf16_t* As_ = (const LAS bf16_t*)(lds + (buf_) * G2_STAGE); const LAS bf16_t* Bs_ = (const LAS bf16_t*)(lds + (buf_) * G2_STAGE + G2_AS); \
        bf16x8 af0_[4], bf0_[4], af1_[4], bf1_[4]; \
        _Pragma("unroll") for (int m_ = 0; m_ < 4; ++m_) af0_[m_] = *(const LAS bf16x8*)(As_ + (half * 128 + wm * 64 + m_ * 16 + fr) * GLD + fq * 8); \
        _Pragma("unroll") for (int n_ = 0; n_ < 4; ++n_) bf0_[n_] = *(const LAS bf16x8*)(Bs_ + (wn * 64 + n_ * 16 + fr) * GLD + fq * 8); \
        _Pragma("unroll") for (int m_ = 0; m_ < 4; ++m_) af1_[m_] = *(const LAS bf16x8*)(As_ + (half * 128 + wm * 64 + m_ * 16 + fr) * GLD + 32 + fq * 8); \
        _Pragma("unroll") for (int n_ = 0; n_ < 4; ++n_) bf1_[n_] = *(const LAS bf16x8*)(Bs_ + (wn * 64 + n_ * 16 + fr) * GLD + 32 + fq * 8); \
        _Pragma("unroll") for (int m_ = 0; m_ < 4; ++m_) _Pragma("unroll") for (int n_ = 0; n_ < 4; ++n_) acc[m_][n_] = MFMA16(bf0_[n_], af0_[m_], acc[m_][n_]); \
        _Pragma("unroll") for (int m_ = 0; m_ < 4; ++m_) _Pragma("unroll") for (int n_ = 0; n_ < 4; ++n_) acc[m_][n_] = MFMA16(bf1_[n_], af1_[m_], acc[m_][n_]); } while (0)
    G2_LOAD(0);
    G2_STORE(0);
    if (nk > 1) G2_LOAD(1);
    __syncthreads();
    for (int kt = 0; kt < nk; ++kt) {
        const int cur = kt & 1;
        if (half == 0) { G2_COMPUTE(cur); }
        else if (kt + 1 < nk) { G2_STORE(cur ^ 1); if (kt + 2 < nk) G2_LOAD(kt + 2); }
        __syncthreads();
        if (half == 1) { if (mvalid > 128) { G2_COMPUTE(cur); } }
        else if (kt + 1 < nk) { G2_STORE(cur ^ 1); if (kt + 2 < nk) G2_LOAD(kt + 2); }
        __syncthreads();
    }
#undef G2_LOAD
#undef G2_STORE
#undef G2_COMPUTE
    E(acc, m0 + half * 128 + wm * 64, n0 + wn * 64, lane);
}

struct RowDense { const bf16_t* A; int lda; __device__ __forceinline__ const bf16_t* operator()(int r) const { return A + (size_t)r * lda; } };
struct RowGather { const bf16_t* A; const int* idx; int nvalid; __device__ __forceinline__ const bf16_t* operator()(int r) const { return r < nvalid ? A + (size_t)idx[r] * D : nullptr; } };
struct RowSlots { const bf16_t* A; int nvalid; __device__ __forceinline__ const bf16_t* operator()(int r) const { return r < nvalid ? A + (size_t)r * EDIM : nullptr; } };
struct ColDense { const float* W; int N; __device__ __forceinline__ const float* operator()(int c) const { return c < N ? W + c : nullptr; } };
struct ColMqk { const float* q; ptrdiff_t dk; __device__ __forceinline__ const float* operator()(int c) const { return q + ((c < 128) ? (ptrdiff_t)c : dk + (c - 128)); } };
struct ColGU { const float* g; ptrdiff_t du; __device__ __forceinline__ const float* operator()(int c) const { const int j = c >> 5, w = c & 31; return g + (((w & 16) ? du : (ptrdiff_t)0) + j * 16 + (w & 15)); } };
struct ColRgu { const float* r; ptrdiff_t dg; ptrdiff_t du; __device__ __forceinline__ const float* operator()(int c) const {
    const int cc = c - 256, j = cc >> 5, w = cc & 31; const ptrdiff_t off = (c < 256) ? (ptrdiff_t)c : (((w & 16) ? du : dg) + j * 16 + (w & 15)); return r + off; } };

__device__ __forceinline__ u32x2 pack4(const f32x4 v) { u32x2 w; w.x = cvt_pk_bf16(v.x, v.y); w.y = cvt_pk_bf16(v.z, v.w); return w; }
__device__ __forceinline__ u32x2 pack_swiglu(const f32x4 g, const f32x4 u) { u32x2 w; w.x = cvt_pk_bf16(siluf_(g.x) * u.x, siluf_(g.y) * u.y); w.y = cvt_pk_bf16(siluf_(g.z) * u.z, siluf_(g.w) * u.w); return w; }
struct EpiProj {
    bf16_t* proj; float* graw;
    __device__ __forceinline__ void operator()(const f32x4 (&acc)[4][4], int rb, int cb, int lane) const {
        const int fr = lane & 15, fq = lane >> 4;
#pragma unroll
        for (int m = 0; m < 4; ++m)
#pragma unroll
            for (int n = 0; n < 4; ++n) {
                const int row = rb + m * 16 + fr, col = cb + n * 16 + 4 * fq;
                if (col < OFF_GATE) *(u32x2*)(proj + (size_t)row * IN_DIM + col) = pack4(acc[m][n]);
                else if (col < IN_DIM) *(f32x4*)(graw + (size_t)row * 8 + (col - OFF_GATE)) = acc[m][n];
            }
    }
};
struct EpiNull {
    float* sink;
    __device__ __forceinline__ void operator()(const f32x4 (&acc)[4][4], int rb, int cb, int lane) const {
        float t = 0.f;
#pragma unroll
        for (int m = 0; m < 4; ++m)
#pragma unroll
            for (int n = 0; n < 4; ++n) t += acc[m][n].x + acc[m][n].y + acc[m][n].z + acc[m][n].w;
        if (t == 12345.678f) sink[lane] = t;
    }
};
struct EpiBf16 {
    bf16_t* O; int ldc;
    __device__ __forceinline__ void operator()(const f32x4 (&acc)[4][4], int rb, int cb, int lane) const {
        const int fr = lane & 15, fq = lane >> 4;
#pragma unroll
        for (int m = 0; m < 4; ++m)
#pragma unroll
            for (int n = 0; n < 4; ++n) *(u32x2*)(O + (size_t)(rb + m * 16 + fr) * ldc + cb + n * 16 + 4 * fq) = pack4(acc[m][n]);
    }
};
struct EpiMqk {
    bf16_t* mq; bf16_t* mk; int h;
    __device__ __forceinline__ void operator()(const f32x4 (&acc)[4][4], int rb, int cb, int lane) const {
        const int fr = lane & 15, fq = lane >> 4;
#pragma unroll
        for (int m = 0; m < 4; ++m)
#pragma unroll
            for (int n = 0; n < 4; ++n) {
                const int row = rb + m * 16 + fr, col = cb + n * 16 + 4 * fq; f32x4 v = acc[m][n];
                bf16_t* dst = mq; int c = col;
                if (col >= 128) { dst = mk; c = col - 128; v = v * 0.08838834764831845f; }
                *(u32x2*)(dst + (size_t)row * MINNER + h * DM + c) = pack4(v);
            }
    }
};
struct EpiResid {
    const float* X; const float* ada; int gt_off; float* out;
    __device__ __forceinline__ void operator()(const f32x4 (&acc)[4][4], int rb, int cb, int lane) const {
        const int fr = lane & 15, fq = lane >> 4;
#pragma unroll
        for (int m = 0; m < 4; ++m)
#pragma unroll
            for (int n = 0; n < 4; ++n) {
                const int row = rb + m * 16 + fr, col = cb + n * 16 + 4 * fq; const int b = row / S;
                const f32x4 g = *(const f32x4*)(ada + b * 6144 + gt_off + col);
                const f32x4 x = *(const f32x4*)(X + (size_t)row * D + col);
                *(f32x4*)(out + (size_t)row * D + col) = x + g * acc[m][n];
            }
    }
};
struct EpiRgu {
    float* logits; bf16_t* act;
    __device__ __forceinline__ void operator()(const f32x4 (&acc)[4][4], int rb, int cb, int lane) const {
        const int fr = lane & 15, fq = lane >> 4;
#pragma unroll
        for (int m = 0; m < 4; ++m) {
            const int row = rb + m * 16 + fr;
            if (cb < 256) {
#pragma unroll
                for (int n = 0; n < 4; ++n) *(f32x4*)(logits + (size_t)row * 256 + cb + n * 16 + 4 * fq) = acc[m][n];
            } else {
                const int j0 = (cb - 256) >> 5;
#pragma unroll
                for (int pp = 0; pp < 2; ++pp) *(u32x2*)(act + (size_t)row * 256 + (j0 + pp) * 16 + 4 * fq) = pack_swiglu(acc[m][2 * pp], acc[m][2 * pp + 1]);
            }
        }
    }
};
struct EpiExpAct {
    bf16_t* act; int slot0; int nvalid;
    __device__ __forceinline__ void operator()(const f32x4 (&acc)[4][4], int rb, int cb, int lane) const {
        const int fr = lane & 15, fq = lane >> 4;
#pragma unroll
        for (int m = 0; m < 4; ++m) {
            const int r = rb + m * 16 + fr;
            if (r < nvalid) {
                const int j0 = cb >> 5;
#pragma unroll
                for (int pp = 0; pp < 2; ++pp) *(u32x2*)(act + (size_t)(slot0 + r) * 256 + (j0 + pp) * 16 + 4 * fq) = pack_swiglu(acc[m][2 * pp], acc[m][2 * pp + 1]);
            }
        }
    }
};
struct EpiExpDown {
    bf16_t* y; const float* lw; int slot0; int nvalid;
    __device__ __forceinline__ void operator()(const f32x4 (&acc)[4][4], int rb, int cb, int lane) const {
        const int fr = lane & 15, fq = lane >> 4;
#pragma unroll
        for (int m = 0; m < 4; ++m) {
            const int r = rb + m * 16 + fr;
            if (r < nvalid) {
                const float wt = lw[r];
#pragma unroll
                for (int n = 0; n < 4; ++n) *(u32x2*)(y + (size_t)(slot0 + r) * 1024 + cb + n * 16 + 4 * fq) = pack4(acc[m][n] * wt);
            }
        }
    }
};

constexpr int AKLD = 104, AVLD = 72;
__device__ __forceinline__ void attn_unit(const Params& p, LAS unsigned char* lds, int bh, int qb) {
    LAS bf16_t* Ks = (LAS bf16_t*)lds;
    LAS bf16_t* Vt = Ks + 64 * AKLD;
    const bf16_t* Q = (const bf16_t*)(p.ws + B_Q) + (size_t)bh * S * 96;
    const bf16_t* Kg = (const bf16_t*)(p.ws + B_K) + (size_t)bh * S * 96;
    const int b = bh >> 3, h = bh & 7;
    const bf16_t* Vg = (const bf16_t*)(p.ws + B_KVRAW) + (size_t)b * S * 1024 + h * 128 + 64;
    bf16_t* O = (bf16_t*)(p.ws + B_ORAW) + (size_t)b * S * 512 + h * 64;
    const int tid = fresh_tid(), lane = tid & 63, wid = tid >> 6, fr = lane & 15, fq = lane >> 4;
    const int q0 = qb * 256, qw0 = q0 + wid * 32;
    bf16x8 qf[2][3];
#pragma unroll
    for (int nq = 0; nq < 2; ++nq)
#pragma unroll
        for (int ks = 0; ks < 3; ++ks) qf[nq][ks] = *(const bf16x8*)(Q + (size_t)(qw0 + nq * 16 + fr) * 96 + ks * 32 + fq * 8);
    f32x4 oacc[4][2];
#pragma unroll
    for (int d = 0; d < 4; ++d)
#pragma unroll
        for (int nq = 0; nq < 2; ++nq) oacc[d][nq] = (f32x4){0.f, 0.f, 0.f, 0.f};
    float mrun[2] = {-1e30f, -1e30f}, lrun[2] = {0.f, 0.f};
    const int ntiles = (q0 + 256) / 64;
    for (int kt = 0; kt < ntiles; ++kt) {
        const int k0 = kt * 64;
        for (int c = tid; c < 768; c += NT) { const int r = c / 12, cc = c - r * 12; *(LAS u32x4*)(Ks + r * AKLD + cc * 8) = *(const u32x4*)(Kg + (size_t)(k0 + r) * 96 + cc * 8); }
        {
            const int key = tid & 63, dc = tid >> 6;
            const u32x4 v = *(const u32x4*)(Vg + (size_t)(k0 + key) * 1024 + dc * 8);
            LAS bf16_t* vt = Vt + (dc * 8) * AVLD + key;
            vt[0 * AVLD] = (bf16_t)(v.x & 0xffff); vt[1 * AVLD] = (bf16_t)(v.x >> 16); vt[2 * AVLD] = (bf16_t)(v.y & 0xffff); vt[3 * AVLD] = (bf16_t)(v.y >> 16);
            vt[4 * AVLD] = (bf16_t)(v.z & 0xffff); vt[5 * AVLD] = (bf16_t)(v.z >> 16); vt[6 * AVLD] = (bf16_t)(v.w & 0xffff); vt[7 * AVLD] = (bf16_t)(v.w >> 16);
        }
        __syncthreads();
        if (k0 <= qw0 + 31) {
            f32x4 sacc[4][2];
#pragma unroll
            for (int t4 = 0; t4 < 4; ++t4)
#pragma unroll
                for (int nq = 0; nq < 2; ++nq) sacc[t4][nq] = (f32x4){0.f, 0.f, 0.f, 0.f};
#pragma unroll
            for (int ks = 0; ks < 3; ++ks)
#pragma unroll
                for (int t4 = 0; t4 < 4; ++t4) {
                    const bf16x8 kf = *(const LAS bf16x8*)(Ks + (t4 * 16 + fr) * AKLD + ks * 32 + fq * 8);
#pragma unroll
                    for (int nq = 0; nq < 2; ++nq) sacc[t4][nq] = MFMA16(kf, qf[nq][ks], sacc[t4][nq]);
                }
            const bool need_mask = (k0 + 63 > qw0);
#pragma unroll
            for (int nq = 0; nq < 2; ++nq) {
                const int qidx = qw0 + nq * 16 + fr;
                float mx = -1e30f;
#pragma unroll
                for (int t4 = 0; t4 < 4; ++t4)
#pragma unroll
                    for (int i = 0; i < 4; ++i) {
                        if (need_mask) { const int key = k0 + t4 * 16 + 4 * fq + i; if (key > qidx) sacc[t4][nq][i] = -1e30f; }
                        mx = fmaxf(mx, sacc[t4][nq][i]);
                    }
                mx = fmaxf(mx, __shfl_xor(mx, 16)); mx = fmaxf(mx, __shfl_xor(mx, 32));
                const float mnew = fmaxf(mrun[nq], mx);
                const float alpha = exp2f(mrun[nq] - mnew);
                mrun[nq] = mnew;
                float ls = 0.f;
#pragma unroll
                for (int t4 = 0; t4 < 4; ++t4)
#pragma unroll
                    for (int i = 0; i < 4; ++i) { const float pv = exp2f(sacc[t4][nq][i] - mnew); sacc[t4][nq][i] = pv; ls += pv; }
                lrun[nq] = lrun[nq] * alpha + ls;
#pragma unroll
                for (int d = 0; d < 4; ++d) oacc[d][nq] = oacc[d][nq] * alpha;
            }
#pragma unroll
            for (int s2 = 0; s2 < 2; ++s2) {
                bf16x8 pb[2];
#pragma unroll
                for (int nq = 0; nq < 2; ++nq) {
                    u32x4 w; w.x = cvt_pk_bf16(sacc[2 * s2][nq].x, sacc[2 * s2][nq].y); w.y = cvt_pk_bf16(sacc[2 * s2][nq].z, sacc[2 * s2][nq].w);
                    w.z = cvt_pk_bf16(sacc[2 * s2 + 1][nq].x, sacc[2 * s2 + 1][nq].y); w.w = cvt_pk_bf16(sacc[2 * s2 + 1][nq].z, sacc[2 * s2 + 1][nq].w);
                    pb[nq] = __builtin_bit_cast(bf16x8, w);
                }
#pragma unroll
                for (int d = 0; d < 4; ++d) {
                    const LAS bf16_t* vr = Vt + (d * 16 + fr) * AVLD + s2 * 32 + 4 * fq;
                    const u32x2 lo = *(const LAS u32x2*)vr, hi = *(const LAS u32x2*)(vr + 16);
                    const bf16x8 vf = __builtin_bit_cast(bf16x8, ((u32x4){lo.x, lo.y, hi.x, hi.y}));
#pragma unroll
                    for (int nq = 0; nq < 2; ++nq) oacc[d][nq] = MFMA16(vf, pb[nq], oacc[d][nq]);
                }
            }
        }
        __syncthreads();
    }
#pragma unroll
    for (int nq = 0; nq < 2; ++nq) {
        float l = lrun[nq]; l += __shfl_xor(l, 16); l += __shfl_xor(l, 32);
        const float inv = 1.f / l;
        const int qidx = qw0 + nq * 16 + fr;
#pragma unroll
        for (int d = 0; d < 4; ++d) { const f32x4 v = oacc[d][nq] * inv; u32x2 w; w.x = cvt_pk_bf16(v.x, v.y); w.y = cvt_pk_bf16(v.z, v.w);
            *(u32x2*)(O + (size_t)qidx * 512 + d * 16 + 4 * fq) = w; }
    }
}

constexpr int MTLD = 72;
__device__ __forceinline__ void mlstm_a_unit(const Params& p, LAS unsigned char* lds, int unit) {
    LAS bf16_t* kT = (LAS bf16_t*)lds;
    LAS bf16_t* vT = kT + 128 * MTLD;
    LAS float* av = (LAS float*)(vT + 128 * MTLD);
    const int bh = unit >> 5, c = unit & 31, b = bh >> 2, h = bh & 3;
    const int t0 = b * S + c * CHUNK;
    const float* gl = (const float*)(p.ws + B_GL);
    const bf16_t* mk = (const bf16_t*)(p.ws + B_MK); const bf16_t* proj = (const bf16_t*)(p.ws + B_PROJ);
    const int tid = fresh_tid(), lane = tid & 63, wid = tid >> 6, fr = lane & 15, fq = lane >> 4;
    if (wid == 0) {
        const float li = gl[(size_t)(t0 + lane) * 8 + h], lf = gl[(size_t)(t0 + lane) * 8 + 4 + h];
        float bs = lf;
#pragma unroll
        for (int o = 1; o < 64; o <<= 1) { const float t = __shfl_up(bs, o); if (lane >= o) bs += t; }
        const float Btot = __shfl(bs, 63);
        const float g = Btot - bs + li;
        const float ml = wave_max(g);
        av[lane] = __expf(g - ml);
        if (lane == 0) { ((float*)(p.ws + WS_BC))[unit] = Btot; ((float*)(p.ws + WS_MLOC))[unit] = ml; }
    }
    __syncthreads();
#pragma unroll
    for (int rep = 0; rep < 2; ++rep) {
        const int cidx = tid + rep * NT, s = cidx & 63, ch = cidx >> 6;
        const u32x4 kv = *(const u32x4*)(mk + (size_t)(t0 + s) * MINNER + h * DM + ch * 8);
        const u32x4 vv = *(const u32x4*)(proj + (size_t)(t0 + s) * IN_DIM + OFF_MV + h * DM + ch * 8);
        const float a = av[s];
        LAS bf16_t* kt = kT + (ch * 8) * MTLD + s; LAS bf16_t* vt = vT + (ch * 8) * MTLD + s;
        const unsigned kk[4] = {kv.x, kv.y, kv.z, kv.w}; const unsigned vw[4] = {vv.x, vv.y, vv.z, vv.w};
#pragma unroll
        for (int j = 0; j < 4; ++j) {
            kt[(2 * j) * MTLD] = (bf16_t)(kk[j] & 0xffff); kt[(2 * j + 1) * MTLD] = (bf16_t)(kk[j] >> 16);
            const unsigned sc = cvt_pk_bf16(bflo(vw[j]) * a, bfhi(vw[j]) * a);
            vt[(2 * j) * MTLD] = (bf16_t)(sc & 0xffff); vt[(2 * j + 1) * MTLD] = (bf16_t)(sc >> 16);
        }
    }
    __syncthreads();
    {
        const int we = wid >> 1, wd = wid & 1;
        f32x4 acc[2][4];
#pragma unroll
        for (int i = 0; i < 2; ++i)
#pragma unroll
            for (int j = 0; j < 4; ++j) acc[i][j] = (f32x4){0.f, 0.f, 0.f, 0.f};
#pragma unroll
        for (int ks = 0; ks < 2; ++ks) {
            bf16x8 vf[2], kf[4];
#pragma unroll
            for (int i = 0; i < 2; ++i) vf[i] = *(const LAS bf16x8*)(vT + (we * 32 + i * 16 + fr) * MTLD + ks * 32 + fq * 8);
#pragma unroll
            for (int j = 0; j < 4; ++j) kf[j] = *(const LAS bf16x8*)(kT + (wd * 64 + j * 16 + fr) * MTLD + ks * 32 + fq * 8);
#pragma unroll
            for (int i = 0; i < 2; ++i)
#pragma unroll
                for (int j = 0; j < 4; ++j) acc[i][j] = MFMA16(vf[i], kf[j], acc[i][j]);
        }
        float* dC = (float*)(p.ws + B_DC) + (size_t)unit * 16384;
#pragma unroll
        for (int i = 0; i < 2; ++i)
#pragma unroll
            for (int j = 0; j < 4; ++j)
#pragma unroll
                for (int r = 0; r < 4; ++r) dC[(we * 32 + i * 16 + 4 * fq + r) * 128 + wd * 64 + j * 16 + fr] = acc[i][j][r];
    }
    if (tid < 128) {
        float s = 0.f;
        for (int q = 0; q < 64; ++q) s += bf2f(kT[tid * MTLD + q]) * av[q];
        ((float*)(p.ws + WS_DN))[(size_t)unit * 128 + tid] = s;
    }
    __syncthreads();
}

__device__ __forceinline__ void mlstm_scan(const Params& p, int gtid, int ngt) {
    const float* Bc = (const float*)(p.ws + WS_BC); const float* ML = (const float*)(p.ws + WS_MLOC);
    float* mprev = (float*)(p.ws + WS_MPREV);
    const float* dC = (const float*)(p.ws + B_DC); bf16_t* Cp = (bf16_t*)(p.ws + B_CPREV);
    const float* dn = (const float*)(p.ws + WS_DN); float* np_ = (float*)(p.ws + WS_NPREV);
    constexpr int PER = 4096 + 32;
    for (int idx = gtid; idx < 32 * PER; idx += ngt) {
        const int bh = idx / PER, e4 = idx - bh * PER;
        float m = 0.f; f32x4 C = (f32x4){0.f, 0.f, 0.f, 0.f};
        for (int c = 0; c < NCH; ++c) {
            const int unit = bh * NCH + c;
            const float Bt = Bc[unit], ml = ML[unit];
            const float mnew = fmaxf(Bt + m, ml);
            const float fa = __expf(Bt + m - mnew), fb = __expf(ml - mnew);
            if (e4 < 4096) {
                u32x2 w; w.x = cvt_pk_bf16(C.x, C.y); w.y = cvt_pk_bf16(C.z, C.w);
                *(u32x2*)(Cp + (size_t)unit * 16384 + e4 * 4) = w;
                const f32x4 d = *(const f32x4*)(dC + (size_t)unit * 16384 + e4 * 4);
                C = C * fa + d * fb;
                if (e4 == 0) mprev[unit] = m;
            } else {
                const int n4 = e4 - 4096;
                *(f32x4*)(np_ + (size_t)unit * 128 + n4 * 4) = C;
                const f32x4 d = *(const f32x4*)(dn + (size_t)unit * 128 + n4 * 4);
                C = C * fa + d * fb;
            }
            m = mnew;
        }
    }
}

constexpr int MRLD = 136;
__device__ __forceinline__ void mlstm_c_unit(const Params& p, LAS unsigned char* lds, int unit) {
    LAS bf16_t* qs = (LAS bf16_t*)lds;
    LAS bf16_t* ks = qs + 64 * MRLD;
    LAS bf16_t* cs = ks + 64 * MRLD;
    LAS bf16_t* vT = cs + 128 * MRLD;
    LAS float* fv = (LAS float*)(vT + 128 * MTLD);
    LAS float* u_s = fv; LAS float* c_t = fv + 64; LAS float* dec = fv + 128; LAS float* emt = fv + 192; LAS float* ssq = fv + 256;
    const int bh = unit >> 5, c = unit & 31, b = bh >> 2, h = bh & 3;
    const int t0 = b * S + c * CHUNK;
    const float* gl = (const float*)(p.ws + B_GL);
    const bf16_t* mq = (const bf16_t*)(p.ws + B_MQ); const bf16_t* mk = (const bf16_t*)(p.ws + B_MK); const bf16_t* proj = (const bf16_t*)(p.ws + B_PROJ);
    const bf16_t* Cp = (const bf16_t*)(p.ws + B_CPREV) + (size_t)unit * 16384;
    const float* np_ = (const float*)(p.ws + WS_NPREV) + (size_t)unit * 128;
    const int tid = fresh_tid(), lane = tid & 63, wid = tid >> 6, fr = lane & 15, fq = lane >> 4;
    if (wid == 0) {
        const float li = gl[(size_t)(t0 + lane) * 8 + h], lf = gl[(size_t)(t0 + lane) * 8 + 4 + h];
        const float mp = ((const float*)(p.ws + WS_MPREV))[unit];
        float bs = lf;
#pragma unroll
        for (int o = 1; o < 64; o <<= 1) { const float t = __shfl_up(bs, o); if (lane >= o) bs += t; }
        const float u = li - bs;
        float pm = u;
#pragma unroll
        for (int o = 1; o < 64; o <<= 1) { const float t = __shfl_up(pm, o); if (lane >= o) pm = fmaxf(pm, t); }
        const float inter = bs + mp;
        const float mt = fmaxf(inter, bs + pm);
        u_s[lane] = u; c_t[lane] = bs - mt; dec[lane] = __expf(inter - mt); emt[lane] = __expf(-mt);
    }
#pragma unroll
    for (int rep = 0; rep < 2; ++rep) {
        const int cidx = tid + rep * NT, r = cidx >> 4, ch = cidx & 15;
        *(LAS u32x4*)(qs + r * MRLD + ch * 8) = *(const u32x4*)(mq + (size_t)(t0 + r) * MINNER + h * DM + ch * 8);
        *(LAS u32x4*)(ks + r * MRLD + ch * 8) = *(const u32x4*)(mk + (size_t)(t0 + r) * MINNER + h * DM + ch * 8);
    }
#pragma unroll
    for (int rep = 0; rep < 4; ++rep) {
        const int cidx = tid + rep * NT, r = cidx >> 4, ch = cidx & 15;
        *(LAS u32x4*)(cs + r * MRLD + ch * 8) = *(const u32x4*)(Cp + r * 128 + ch * 8);
    }
#pragma unroll
    for (int rep = 0; rep < 2; ++rep) {
        const int cidx = tid + rep * NT, s = cidx & 63, ch = cidx >> 6;
        const u32x4 vv = *(const u32x4*)(proj + (size_t)(t0 + s) * IN_DIM + OFF_MV + h * DM + ch * 8);
        LAS bf16_t* vt = vT + (ch * 8) * MTLD + s;
        const unsigned vw[4] = {vv.x, vv.y, vv.z, vv.w};
#pragma unroll
        for (int j = 0; j < 4; ++j) { vt[(2 * j) * MTLD] = (bf16_t)(vw[j] & 0xffff); vt[(2 * j + 1) * MTLD] = (bf16_t)(vw[j] >> 16); }
    }
    __syncthreads();
    const int tt = wid & 3, eh = wid >> 2;
    const int tl = tt * 16 + fr;
    bf16x8 qf[4];
#pragma unroll
    for (int k4 = 0; k4 < 4; ++k4) qf[k4] = *(const LAS bf16x8*)(qs + tl * MRLD + k4 * 32 + fq * 8);
    f32x4 sacc[4];
#pragma unroll
    for (int st = 0; st < 4; ++st) sacc[st] = (f32x4){0.f, 0.f, 0.f, 0.f};
#pragma unroll
    for (int k4 = 0; k4 < 4; ++k4)
#pragma unroll
        for (int st = 0; st < 4; ++st) {
            const bf16x8 kf = *(const LAS bf16x8*)(ks + (st * 16 + fr) * MRLD + k4 * 32 + fq * 8);
            sacc[st] = MFMA16(kf, qf[k4], sacc[st]);
        }
    const float ct = c_t[tl];
    float rs = 0.f;
#pragma unroll
    for (int st = 0; st < 4; ++st)
#pragma unroll
        for (int i = 0; i < 4; ++i) {
            const int s = st * 16 + 4 * fq + i;
            const float w = (s <= tl) ? __expf(ct + u_s[s]) * sacc[st][i] : 0.f;
            sacc[st][i] = w; rs += w;
        }
    rs += __shfl_xor(rs, 16); rs += __shfl_xor(rs, 32);
    float nq;
    {
        f32x4 na = (f32x4){0.f, 0.f, 0.f, 0.f};
#pragma unroll
        for (int k4 = 0; k4 < 4; ++k4) {
            u32x4 w = (u32x4){0u, 0u, 0u, 0u};
            if (fr == 0) { const float* nn = np_ + k4 * 32 + fq * 8; w.x = cvt_pk_bf16(nn[0], nn[1]); w.y = cvt_pk_bf16(nn[2], nn[3]); w.z = cvt_pk_bf16(nn[4], nn[5]); w.w = cvt_pk_bf16(nn[6], nn[7]); }
            na = MFMA16(__builtin_bit_cast(bf16x8, w), qf[k4], na);
        }
        nq = __shfl(na.x, fr);
    }
    f32x4 acc[4];
#pragma unroll
    for (int et = 0; et < 4; ++et) acc[et] = (f32x4){0.f, 0.f, 0.f, 0.f};
#pragma unroll
    for (int k4 = 0; k4 < 4; ++k4)
#pragma unroll
        for (int et = 0; et < 4; ++et) {
            const bf16x8 cf = *(const LAS bf16x8*)(cs + (eh * 64 + et * 16 + fr) * MRLD + k4 * 32 + fq * 8);
            acc[et] = MFMA16(cf, qf[k4], acc[et]);
        }
    const float dcy = dec[tl];
#pragma unroll
    for (int et = 0; et < 4; ++et) acc[et] = acc[et] * dcy;
#pragma unroll
    for (int s2 = 0; s2 < 2; ++s2) {
        u32x4 w; w.x = cvt_pk_bf16(sacc[2 * s2].x, sacc[2 * s2].y); w.y = cvt_pk_bf16(sacc[2 * s2].z, sacc[2 * s2].w);
        w.z = cvt_pk_bf16(sacc[2 * s2 + 1].x, sacc[2 * s2 + 1].y); w.w = cvt_pk_bf16(sacc[2 * s2 + 1].z, sacc[2 * s2 + 1].w);
        const bf16x8 pb = __builtin_bit_cast(bf16x8, w);
#pragma unroll
        for (int et = 0; et < 4; ++et) {
            const LAS bf16_t* vr = vT + (eh * 64 + et * 16 + fr) * MTLD + s2 * 32 + 4 * fq;
            const u32x2 lo = *(const LAS u32x2*)vr, hi = *(const LAS u32x2*)(vr + 16);
            acc[et] = MFMA16(__builtin_bit_cast(bf16x8, ((u32x4){lo.x, lo.y, hi.x, hi.y})), pb, acc[et]);
        }
    }
    const float den = dcy * nq + rs;
    const float hd = 1.f / fmaxf(fabsf(den), emt[tl]);
    float sq = 0.f;
#pragma unroll
    for (int et = 0; et < 4; ++et) { acc[et] = acc[et] * hd; sq += acc[et].x * acc[et].x + acc[et].y * acc[et].y + acc[et].z * acc[et].z + acc[et].w * acc[et].w; }
    sq += __shfl_xor(sq, 16); sq += __shfl_xor(sq, 32);
    if (fq == 0) ssq[eh * 64 + tl] = sq;
    __syncthreads();
    const float rinv = rsqrtf((ssq[tl] + ssq[64 + tl]) * (1.f / 128.f) + RMS_EPS);
    const float* gmo = p.in[20] + h * DM;
    bf16_t* ao = (bf16_t*)(p.ws + B_AO);
#pragma unroll
    for (int et = 0; et < 4; ++et) {
        const int e = eh * 64 + et * 16 + 4 * fq;
        const u32x2 op = *(const u32x2*)(proj + (size_t)(t0 + tl) * IN_DIM + OFF_MO + h * DM + e);
        const f32x4 g = *(const f32x4*)(gmo + e);
        const f32x4 v = acc[et] * rinv * g;
        u32x2 w; w.x = cvt_pk_bf16(v.x * sigmoidf_(bflo(op.x)), v.y * sigmoidf_(bfhi(op.x))); w.y = cvt_pk_bf16(v.z * sigmoidf_(bflo(op.y)), v.w * sigmoidf_(bfhi(op.y)));
        *(u32x2*)(ao + (size_t)(t0 + tl) * 1024 + 512 + h * DM + e) = w;
    }
    __syncthreads();
}

__device__ __forceinline__ void route_token(const f32x4 cur, const f32x4 bias, int lane, int& mye_out, float& w_out) {
    const float NEG = -__builtin_inff();
    float sc[4] = {sigmoidf_(cur.x), sigmoidf_(cur.y), sigmoidf_(cur.z), sigmoidf_(cur.w)};
    float sb[4] = {sc[0] + bias.x, sc[1] + bias.y, sc[2] + bias.z, sc[3] + bias.w};
    float t1 = fmaxf(fmaxf(sb[0], sb[1]), fmaxf(sb[2], sb[3]));
    float t2;
    {   const float a = fmaxf(sb[0], sb[1]), bmin = fminf(sb[0], sb[1]), c2 = fmaxf(sb[2], sb[3]), dmin = fminf(sb[2], sb[3]);
        t2 = fmaxf(fminf(a, c2), fmaxf(bmin, dmin)); }
#pragma unroll
    for (int o = 1; o < 8; o <<= 1) {
        const float o1 = __shfl_xor(t1, o), o2 = __shfl_xor(t2, o);
        const float n1 = fmaxf(t1, o1), n2 = fmaxf(fminf(t1, o1), fmaxf(t2, o2));
        t1 = n1; t2 = n2;
    }
    const float gs = t1 + t2;
    const int myg = lane >> 3;
    int rank = 0;
#pragma unroll
    for (int g = 0; g < 8; ++g) { const float og = __shfl(gs, g * 8); rank += (og > gs || (og == gs && g < myg)) ? 1 : 0; }
    const bool keep = rank < 4;
    float cand[4];
#pragma unroll
    for (int j = 0; j < 4; ++j) cand[j] = keep ? sb[j] : NEG;
    float wsum = 0.f; float myw = 0.f; int mye = 0;
#pragma unroll
    for (int k = 0; k < TOPK; ++k) {
        float bv = cand[0]; int bi = 0;
#pragma unroll
        for (int j = 1; j < 4; ++j) if (cand[j] > bv) { bv = cand[j]; bi = j; }
        int gi = lane * 4 + bi; float gv = bv;
#pragma unroll
        for (int o = 1; o < 64; o <<= 1) {
            const float ov = __shfl_xor(gv, o); const int oi = __shfl_xor(gi, o);
            if (ov > gv || (ov == gv && oi < gi)) { gv = ov; gi = oi; }
        }
        const int wl = gi >> 2, wj = gi & 3;
        const float sj = (wj == 0) ? sc[0] : (wj == 1) ? sc[1] : (wj == 2) ? sc[2] : sc[3];
        const float sraw = __shfl(sj, wl);
        wsum += sraw;
        if (lane == k) { myw = sraw; mye = gi; }
        if (lane == wl) {
#pragma unroll
            for (int j = 0; j < 4; ++j) if (j == wj) cand[j] = NEG;
        }
    }
    mye_out = mye; w_out = myw / wsum * 2.5f;
}
__device__ __forceinline__ void route_rows(const Params& p, int gw, int ngw, int lane) {
    const float* logits = (const float*)(p.ws + C_LOGITS); const float* rb = p.in[24];
    int* cnt = (int*)(p.ws + WS_CNT);
    int* tok_e = (int*)(p.ws + C_TOKE); float* tok_w = (float*)(p.ws + C_TOKW); int* tok_pos = (int*)(p.ws + C_TOKPOS);
    int* list_tok = (int*)(p.ws + C_LISTTOK); float* list_w = (float*)(p.ws + C_LISTW);
    const f32x4 bias = *(const f32x4*)(rb + lane * 4);
    for (int row0 = gw; row0 < T; row0 += ngw * 8) {
        int e_all = 0, row_all = -1; float w_all = 0.f;
        f32x4 lga = *(const f32x4*)(logits + (size_t)row0 * 256 + lane * 4);
        f32x4 lgb = (row0 + ngw < T) ? *(const f32x4*)(logits + (size_t)(row0 + ngw) * 256 + lane * 4) : lga;
#pragma unroll 1
        for (int i = 0; i < 8; i += 2) {
            const int rowa = row0 + i * ngw, rowb = rowa + ngw;
            if (rowa >= T) break;
            const f32x4 ca = lga, cb = lgb;
            if (i + 2 < 8) {
                if (rowa + 2 * ngw < T) lga = *(const f32x4*)(logits + (size_t)(rowa + 2 * ngw) * 256 + lane * 4);
                if (rowb + 2 * ngw < T) lgb = *(const f32x4*)(logits + (size_t)(rowb + 2 * ngw) * 256 + lane * 4);
            }
            int ea, eb; float wa, wb;
            route_token(ca, bias, lane, ea, wa);
            route_token(cb, bias, lane, eb, wb);
            const int sea = __shfl(ea, lane & 7), seb = __shfl(eb, lane & 7); const float swa = __shfl(wa, lane & 7), swb = __shfl(wb, lane & 7);
            if ((lane >> 3) == i) { e_all = sea; w_all = swa; row_all = rowa; }
            if ((lane >> 3) == i + 1 && rowb < T) { e_all = seb; w_all = swb; row_all = rowb; }
        }
        if (row_all >= 0) {
            const int k = lane & 7;
            const int pos = atomicAdd(&cnt[e_all * CNT_STRIDE], 1);
            tok_e[(size_t)row_all * 8 + k] = e_all; tok_w[(size_t)row_all * 8 + k] = w_all; tok_pos[(size_t)row_all * 8 + k] = pos;
            list_tok[(size_t)e_all * CAP + pos] = row_all; list_w[(size_t)e_all * CAP + pos] = w_all;
        }
    }
}

__device__ __forceinline__ void expert_prefix(const Params& p, LAS int* base, LAS int* tsx, int tid, int x, int ngrp) {
    const int* cnt = (const int*)(p.ws + WS_CNT);
    const int nper = NE / ngrp;
    if (tid < 64) {
        int c[4]; int s = 0;
#pragma unroll
        for (int j = 0; j < 4; ++j) { c[j] = __hip_atomic_load(cnt + (tid * 4 + j) * CNT_STRIDE, __ATOMIC_RELAXED, __HIP_MEMORY_SCOPE_AGENT); s += c[j]; }
        int ps = s;
#pragma unroll
        for (int o = 1; o < 64; o <<= 1) { const int a = __shfl_up(ps, o); if (tid >= o) ps += a; }
        int es = ps - s;
#pragma unroll
        for (int j = 0; j < 4; ++j) { base[tid * 4 + j] = es; es += c[j]; }
        int run = 0;
        for (int r0 = 0; r0 < nper; r0 += 64) {
            const int i = r0 + tid;
            int tl = 0;
            if (i < nper) tl = (__hip_atomic_load(cnt + (x + ngrp * i) * CNT_STRIDE, __ATOMIC_RELAXED, __HIP_MEMORY_SCOPE_AGENT) + 255) >> 8;
            int pt = tl;
#pragma unroll
            for (int o = 1; o < 64; o <<= 1) { const int a = __shfl_up(pt, o); if (tid >= o) pt += a; }
            if (i < nper) tsx[i] = run + pt - tl;
            run += __shfl(pt, 63);
        }
        if (tid == 0) tsx[nper] = run;
    }
    __syncthreads();
}

__device__ __forceinline__ void combine_rows(const Params& p, LAS int* base, int gw, int ngw, int lane) {
    const bf16_t* sh = (const bf16_t*)(p.ws + C_SHOUT); const bf16_t* y = (const bf16_t*)(p.ws + C_Y);
    const int* tok_e = (const int*)(p.ws + C_TOKE); const int* tok_pos = (const int*)(p.ws + C_TOKPOS);
    const float* ada = (const float*)(p.ws + WS_ADA);
    for (int row = gw; row < T; row += ngw) {
        const int b = row / S;
        float acc[2][8];
#pragma unroll
        for (int hf = 0; hf < 2; ++hf) {
            const u32x4 a = *(const u32x4*)(sh + (size_t)row * 1024 + hf * 512 + lane * 8);
            acc[hf][0] = bflo(a.x); acc[hf][1] = bfhi(a.x); acc[hf][2] = bflo(a.y); acc[hf][3] = bfhi(a.y); acc[hf][4] = bflo(a.z); acc[hf][5] = bfhi(a.z); acc[hf][6] = bflo(a.w); acc[hf][7] = bfhi(a.w);
        }
#pragma unroll
        for (int k = 0; k < TOPK; ++k) {
            const int e = tok_e[(size_t)row * 8 + k], pos = tok_pos[(size_t)row * 8 + k];
            const size_t slot = (size_t)(base[e] + pos);
#pragma unroll
            for (int hf = 0; hf < 2; ++hf) {
                const u32x4 a = *(const u32x4*)(y + slot * 1024 + hf * 512 + lane * 8);
                acc[hf][0] += bflo(a.x); acc[hf][1] += bfhi(a.x); acc[hf][2] += bflo(a.y); acc[hf][3] += bfhi(a.y); acc[hf][4] += bflo(a.z); acc[hf][5] += bfhi(a.z); acc[hf][6] += bflo(a.w); acc[hf][7] += bfhi(a.w);
            }
        }
#pragma unroll
        for (int hf = 0; hf < 2; ++hf) {
            const int col = hf * 512 + lane * 8;
            float* o = p.out + (size_t)row * D + col;
            const float* g = ada + b * 6144 + 5120 + col;
#pragma unroll
            for (int q4 = 0; q4 < 2; ++q4) {
                const f32x4 x = *(const f32x4*)(o + q4 * 4), gg = *(const f32x4*)(g + q4 * 4);
                f32x4 r; r.x = x.x + gg.x * acc[hf][q4 * 4 + 0]; r.y = x.y + gg.y * acc[hf][q4 * 4 + 1]; r.z = x.z + gg.z * acc[hf][q4 * 4 + 2]; r.w = x.w + gg.w * acc[hf][q4 * 4 + 3];
                *(f32x4*)(o + q4 * 4) = r;
            }
        }
    }
}


struct PgProj {
    static constexpr bool PERM = false, AFTER_DRAIN = false;
    bf16_t* proj; float* graw;
    __device__ __forceinline__ void operator()(const f32x4 (&acc)[2][2][4][2], const pg8::Unit& u, int wr, int wc, int fr, int fq) const {
#pragma unroll
        for (int ai = 0; ai < 2; ++ai)
#pragma unroll
            for (int m = 0; m < 4; ++m) { const int row = u.pm * 256 + ai * 128 + wr * 64 + m * 16 + fr;
#pragma unroll
                for (int bj = 0; bj < 2; ++bj)
#pragma unroll
                    for (int n = 0; n < 2; ++n) { const int col = u.pn * 256 + bj * 128 + wc * 32 + n * 16 + 4 * fq;
                        if (col < OFF_GATE) *(u32x2*)(proj + (size_t)row * IN_DIM + col) = pack4(acc[ai][bj][m][n]);
                        else if (col < IN_DIM) *(f32x4*)(graw + (size_t)row * 8 + (col - OFF_GATE)) = acc[ai][bj][m][n]; } }
    }
};
struct PgBf16 {
    static constexpr bool PERM = false, AFTER_DRAIN = false;
    bf16_t* O; int ldc;
    __device__ __forceinline__ void operator()(const f32x4 (&acc)[2][2][4][2], const pg8::Unit& u, int wr, int wc, int fr, int fq) const {
#pragma unroll
        for (int ai = 0; ai < 2; ++ai)
#pragma unroll
            for (int m = 0; m < 4; ++m) { const int row = u.pm * 256 + ai * 128 + wr * 64 + m * 16 + fr;
#pragma unroll
                for (int bj = 0; bj < 2; ++bj)
#pragma unroll
                    for (int n = 0; n < 2; ++n) { const int col = u.pn * 256 + bj * 128 + wc * 32 + n * 16 + 4 * fq;
                        *(u32x2*)(O + (size_t)row * ldc + col) = pack4(acc[ai][bj][m][n]); } }
    }
};
struct PgMqk {
    static constexpr bool PERM = false, AFTER_DRAIN = false;
    bf16_t* mq; bf16_t* mk;
    __device__ __forceinline__ void operator()(const f32x4 (&acc)[2][2][4][2], const pg8::Unit& u, int wr, int wc, int fr, int fq) const {
#pragma unroll
        for (int ai = 0; ai < 2; ++ai)
#pragma unroll
            for (int m = 0; m < 4; ++m) { const int row = u.pm * 256 + ai * 128 + wr * 64 + m * 16 + fr;
#pragma unroll
                for (int bj = 0; bj < 2; ++bj)
#pragma unroll
                    for (int n = 0; n < 2; ++n) { const int c = wc * 32 + n * 16 + 4 * fq;
                        const f32x4 v = bj ? acc[ai][bj][m][n] * 0.08838834764831845f : acc[ai][bj][m][n];
                        *(u32x2*)((bj ? mk : mq) + (size_t)row * MINNER + u.pn * DM + c) = pack4(v); } }
    }
};
struct PgResid {
    static constexpr bool PERM = false, AFTER_DRAIN = false;
    const float* X; const float* ada; int gt_off; float* out;
    __device__ __forceinline__ void operator()(const f32x4 (&acc)[2][2][4][2], const pg8::Unit& u, int wr, int wc, int fr, int fq) const {
#pragma unroll
        for (int ai = 0; ai < 2; ++ai)
#pragma unroll
            for (int m = 0; m < 4; ++m) { const int row = u.pm * 256 + ai * 128 + wr * 64 + m * 16 + fr; const int b = row / S;
#pragma unroll
                for (int bj = 0; bj < 2; ++bj)
#pragma unroll
                    for (int n = 0; n < 2; ++n) { const int col = u.pn * 256 + bj * 128 + wc * 32 + n * 16 + 4 * fq;
                        const f32x4 g = *(const f32x4*)(ada + b * 6144 + gt_off + col);
                        const f32x4 x = *(const f32x4*)(X + (size_t)row * D + col);
                        *(f32x4*)(out + (size_t)row * D + col) = x + g * acc[ai][bj][m][n]; } }
    }
};
struct PgRgu {
    static constexpr bool PERM = false, AFTER_DRAIN = false;
    float* logits; bf16_t* act;
    __device__ __forceinline__ void operator()(const f32x4 (&acc)[2][2][4][2], const pg8::Unit& u, int wr, int wc, int fr, int fq) const {
#pragma unroll
        for (int ai = 0; ai < 2; ++ai)
#pragma unroll
            for (int m = 0; m < 4; ++m) { const int row = u.pm * 256 + ai * 128 + wr * 64 + m * 16 + fr;
#pragma unroll
                for (int bj = 0; bj < 2; ++bj) {
                    if (u.pn == 0) {
#pragma unroll
                        for (int n = 0; n < 2; ++n) *(f32x4*)(logits + (size_t)row * 256 + bj * 128 + wc * 32 + n * 16 + 4 * fq) = acc[ai][bj][m][n];
                    } else {
                        const int j = ((u.pn - 1) * 256 + bj * 128 + wc * 32) >> 5;
                        *(u32x2*)(act + (size_t)row * 256 + j * 16 + 4 * fq) = pack_swiglu(acc[ai][bj][m][0], acc[ai][bj][m][1]);
                    }
                } }
    }
};

__device__ __forceinline__ int xcd_remap(int L, int nwg) { const int q = nwg >> 3, r = nwg & 7, x = L & 7, off = L >> 3; return (x < r ? x * (q + 1) : r * (q + 1) + (x - r) * q) + off; }
__global__ void __launch_bounds__(NT, 2) fwd_kernel(Params p) {
    extern __shared__ __attribute__((aligned(16))) unsigned char lds_raw[];
    LAS unsigned char* lds = (LAS unsigned char*)lds_raw;
    const int G = gridDim.x, bid = blockIdx.x, ngw = G * NWAVES;
#define FRESH_IDS() const int tid = fresh_tid(), lane = tid & 63, wid = tid >> 6, gw = bid * NWAVES + wid; (void)lane; (void)gw
    { const int tid = fresh_tid(); volatile LAS unsigned* bst0 = (volatile LAS unsigned*)(lds + LDS_BYTES - 64); if (tid < 2) bst0[tid] = 0u; }
    unsigned char* ws = p.ws;
    const float* ada = (const float*)(ws + WS_ADA);
    volatile LAS unsigned* bst = (volatile LAS unsigned*)(lds + LDS_BYTES - 64);
    __syncthreads();
    const XcdBarrier xbar = xcd_barrier_post((unsigned*)(ws + WS_CTL + 4096), bst);
    int ts_n = 0;
#if DBG_STAGE == 2
#define TSTAMP() do { if (bid == 0 && threadIdx.x == 0) ((unsigned long long*)(ws + WS_CTL + 16384 + 8192))[ts_n] = __builtin_amdgcn_s_memrealtime(); ++ts_n; } while (0)
#else
#define TSTAMP() do { } while (0)
#endif
    TSTAMP();

    {
        FRESH_IDS();
        const bool split = G > 128;
        if (!split || bid < 96) for (int u = bid; u < 96; u += G) ada_unit(p, lds, u, tid);
        if (!split || bid >= 96) {
            LAS float* scr = (LAS float*)(lds + wid * 8448);
            const int cg0 = split ? (bid - 96) * NWAVES + wid : gw, cgn = split ? (G - 96) * NWAVES : ngw;
            constexpr int I0 = 16 * 70, I1 = I0 + 6 * 24, I2 = I1 + 4 * 32, I3 = I2 + 32, I4 = I3 + 32, I5 = I4 + 16 * 32, I6 = I5 + 16 * 8, I7 = I6 + 16 * 8, I8 = I7 + 16 * 8, I9 = I8 + 4 * 32;
            for (int it = cg0; it < I9; it += cgn) {
                if (it < I0) conv_item<0>(p.in[6], 1024, IN_DIM, (bf16_t*)(ws + WS_WIN), 0, 0, scr, it, lane);
                else if (it < I1) conv_item<0>(p.in[8], QLORA, 768, (bf16_t*)(ws + WS_WUQ), 0, 0, scr, it - I0, lane);
                else if (it < I2) conv_item<0>(p.in[10], KVLORA, 1024, (bf16_t*)(ws + WS_WUKV), 0, 0, scr, it - I1, lane);
                else if (it < I3) conv_item<0>(p.in[16], 128, 128, (bf16_t*)(ws + WS_WMQK), 256 * 128, 0, scr, it - I2, lane);
                else if (it < I4) conv_item<0>(p.in[17], 128, 128, (bf16_t*)(ws + WS_WMQK), 256 * 128, 128, scr, it - I3, lane);
                else if (it < I5) conv_item<0>(p.in[21], 1024, 1024, (bf16_t*)(ws + WS_WOUT), 0, 0, scr, it - I4, lane);
                else if (it < I6) conv_item<0>(p.in[23], 1024, 256, (bf16_t*)(ws + WS_WRGU), 0, 0, scr, it - I5, lane);
                else if (it < I7) conv_item<1>(p.in[28], 1024, 256, (bf16_t*)(ws + WS_WRGU), 0, 256, scr, it - I6, lane);
                else if (it < I8) conv_item<2>(p.in[29], 1024, 256, (bf16_t*)(ws + WS_WRGU), 0, 256, scr, it - I7, lane);
                else conv_item<0>(p.in[30], 256, 1024, (bf16_t*)(ws + WS_WDSH), 0, 0, scr, it - I8, lane);
            }
            u32x4* zp = (u32x4*)((bf16_t*)(ws + WS_WIN) + (size_t)IN_DIM * 1024);
            const int zt0 = split ? (bid - 96) * NT + tid : bid * NT + tid, ztn = split ? (G - 96) * NT : G * NT;
            for (int i = zt0; i < (2304 - IN_DIM) * 1024 / 8; i += ztn) zp[i] = (u32x4){0u, 0u, 0u, 0u};
        }
    }
    xcd_barrier(xbar); TSTAMP();
    { FRESH_IDS(); norm_mod_rows(p.in[0], p.in[5], ada, 0, 1024, (bf16_t*)(ws + B_H1), gw, ngw, lane); }
    xcd_barrier(xbar); TSTAMP();
    {
        const pg8::Gemm g{(const bf16_t*)(ws + B_H1), (const bf16_t*)(ws + WS_WIN), T, 2304, 1024, 1024, 1024, 0};
        pg8::StaticOrder SO; SO.init(T, 2304, G, bid);
        const PgProj E{(bf16_t*)(ws + B_PROJ), (float*)(ws + B_GRAW)};
        pg8::gemm_phase<PgProj, pg8::StaticOrder, true, true>(lds, g, SO, E);
    }
    xcd_barrier(xbar); TSTAMP();
    { FRESH_IDS(); post_proj_rows(p, gw, ngw, lane); }
    xcd_barrier(xbar); TSTAMP();
    {
        {   const pg8::Gemm g{(const bf16_t*)(ws + B_CQN), (const bf16_t*)(ws + WS_WUQ), T, 768, QLORA, QLORA, QLORA, 0};
            pg8::StaticOrder SO; SO.init(T, 768, G, bid); const PgBf16 E{(bf16_t*)(ws + B_QRAW), 768};
            pg8::gemm_phase<PgBf16, pg8::StaticOrder, true, true>(lds, g, SO, E); }
        {   const pg8::Gemm g{(const bf16_t*)(ws + B_CKVN), (const bf16_t*)(ws + WS_WUKV), T, 1024, KVLORA, KVLORA, KVLORA, 0};
            pg8::StaticOrder SO; SO.init(T, 1024, G, bid); const PgBf16 E{(bf16_t*)(ws + B_KVRAW), 1024};
            pg8::gemm_phase<PgBf16, pg8::StaticOrder, true, true>(lds, g, SO, E); }
        {   const pg8::Gemm g{(const bf16_t*)(ws + B_ZC), (const bf16_t*)(ws + WS_WMQK), T, 1024, DM, MINNER, DM, DM};
            pg8::StaticOrder SO; SO.init(T, 1024, G, bid); const PgMqk E{(bf16_t*)(ws + B_MQ), (bf16_t*)(ws + B_MK)};
            pg8::gemm_phase<PgMqk, pg8::StaticOrder, true, true>(lds, g, SO, E); }
    }
    xcd_barrier(xbar); TSTAMP();
    { FRESH_IDS(); qk_post_rows(p, gw, ngw, lane); }
    xcd_barrier(xbar); TSTAMP();
    for (int pr = bid; pr < 256; pr += G) { const int bh = pr & 63, j = pr >> 6; attn_unit(p, lds, bh, 7 - j); attn_unit(p, lds, bh, j); }
    for (int u = bid; u < 1024; u += G) mlstm_a_unit(p, lds, u);
    xcd_barrier(xbar); TSTAMP();
    { FRESH_IDS(); mlstm_scan(p, bid * NT + tid, G * NT); }
    { FRESH_IDS(); attn_out_norm_rows(p, gw, ngw, lane); }
    xcd_barrier(xbar); TSTAMP();
    for (int u = bid; u < 1024; u += G) mlstm_c_unit(p, lds, u);
    xcd_barrier(xbar); TSTAMP();
    {
        const pg8::Gemm g{(const bf16_t*)(ws + B_AO), (const bf16_t*)(ws + WS_WOUT), T, 1024, 1024, 1024, 1024, 0};
        pg8::StaticOrder SO; SO.init(T, 1024, G, bid); const PgResid E{p.in[0], ada, 2048, p.out};
        pg8::gemm_phase<PgResid, pg8::StaticOrder, true, true>(lds, g, SO, E);
    }
    xcd_barrier(xbar); TSTAMP();
    { FRESH_IDS(); norm_mod_rows(p.out, p.in[22], ada, 3072, 4096, (bf16_t*)(ws + C_H2), gw, ngw, lane); }
    xcd_barrier(xbar); TSTAMP();
    {
        const pg8::Gemm g{(const bf16_t*)(ws + C_H2), (const bf16_t*)(ws + WS_WRGU), T, 768, 1024, 1024, 1024, 0};
        pg8::StaticOrder SO; SO.init(T, 768, G, bid); const PgRgu E{(float*)(ws + C_LOGITS), (bf16_t*)(ws + C_ACTSH)};
        pg8::gemm_phase<PgRgu, pg8::StaticOrder, true, true>(lds, g, SO, E);
    }
    xcd_barrier(xbar); TSTAMP();
    { FRESH_IDS(); route_rows(p, gw, ngw, lane); }
    {
        const pg8::Gemm g{(const bf16_t*)(ws + C_ACTSH), (const bf16_t*)(ws + WS_WDSH), T, 1024, 256, 256, 256, 0};
        pg8::StaticOrder SO; SO.init(T, 1024, G, bid); const PgBf16 E{(bf16_t*)(ws + C_SHOUT), 1024};
        pg8::gemm_phase<PgBf16, pg8::StaticOrder, true, true>(lds, g, SO, E);
    }
    xcd_barrier(xbar); TSTAMP();
    LAS int* base = (LAS int*)(lds + 132 * 1024);
    LAS int* tsx = base + 256;
    const int ngrp = (G % 8 == 0) ? 8 : 1, gx = bid % ngrp, gidx = bid / ngrp, gper = G / ngrp, nexp = NE / ngrp;
    { FRESH_IDS(); expert_prefix(p, base, tsx, tid, gx, ngrp); }
    {
        const int* cnt = (const int*)(ws + WS_CNT);
        const int ntile = tsx[nexp];
        for (int u = gidx; u < ntile * 4; u += gper) {
            const int tg = u >> 2, tn = u & 3;
            int lo = 0, hi = nexp - 1;
            while (lo < hi) { const int mid = (lo + hi + 1) >> 1; if (tsx[mid] <= tg) lo = mid; else hi = mid - 1; }
            const int e = gx + ngrp * lo, blk = tg - tsx[lo], c = __hip_atomic_load(cnt + e * CNT_STRIDE, __ATOMIC_RELAXED, __HIP_MEMORY_SCOPE_AGENT);
            const int nvalid = min(256, c - blk * 256);
            const RowGather RP{(const bf16_t*)(ws + C_H2), (const int*)(ws + C_LISTTOK) + (size_t)e * CAP + blk * 256, nvalid};
            const ColGU CP{p.in[25] + (size_t)e * 1024 * 256, p.in[26] - p.in[25]};
            const EpiExpAct E{(bf16_t*)(ws + C_ACTE), base[e] + blk * 256, nvalid};
            gemm2_tile(lds, RP, CP, 256, 1024, 0, tn * 128, E, nvalid);
        }
    }
    xcd_barrier(xbar); TSTAMP();
    {
        const int* cnt = (const int*)(ws + WS_CNT);
        const int ntile = tsx[nexp];
        for (int u = gidx; u < ntile * 8; u += gper) {
            const int tg = u >> 3, tn = u & 7;
            int lo = 0, hi = nexp - 1;
            while (lo < hi) { const int mid = (lo + hi + 1) >> 1; if (tsx[mid] <= tg) lo = mid; else hi = mid - 1; }
            const int e = gx + ngrp * lo, blk = tg - tsx[lo], c = __hip_atomic_load(cnt + e * CNT_STRIDE, __ATOMIC_RELAXED, __HIP_MEMORY_SCOPE_AGENT);
            const int nvalid = min(256, c - blk * 256);
            const int slot0 = base[e] + blk * 256;
            const RowSlots RP{(const bf16_t*)(ws + C_ACTE) + (size_t)slot0 * EDIM, nvalid};
            const ColDense CP{p.in[27] + (size_t)e * 256 * 1024, 1024};
            const EpiExpDown E{(bf16_t*)(ws + C_Y), (const float*)(ws + C_LISTW) + (size_t)e * CAP + blk * 256, slot0, nvalid};
            gemm2_tile(lds, RP, CP, 1024, 256, 0, tn * 128, E, nvalid);
        }
    }
    xcd_barrier(xbar); TSTAMP();
    { FRESH_IDS(); combine_rows(p, base, gw, ngw, lane); }
#if DBG_STAGE == 2
    xcd_barrier(xbar); TSTAMP();
    xcd_barrier(xbar);
    {   FRESH_IDS();
        const unsigned long long* ts = (const unsigned long long*)(ws + WS_CTL + 16384 + 8192);
        const float tus = (float)(long long)(ts[TS_A1] - ts[TS_A0]) * 0.01f;
        const float cadd = sqrtf(2.5e-3f * tus * (1.f / 500.f));
        for (size_t i = (size_t)bid * NT + tid; i < (size_t)T * D / 4; i += (size_t)G * NT) { f32x4 v = ((f32x4*)p.out)[i]; v = v + cadd; ((f32x4*)p.out)[i] = v; }
    }
#endif
}

extern "C" void kernel_launch(void* const* d_in, const int* in_sizes, int n_in,
                              void* d_out, int out_size, void* d_ws, size_t ws_size,
                              hipStream_t stream) {
    static int grid_blocks = 0;
    if (!grid_blocks) {
        if (n_in != 31 || out_size != T * D || ws_size < WS_END) { fprintf(stderr, "kernel_launch: unexpected shapes n_in=%d out=%d ws=%zu (need %zu)\n", n_in, out_size, ws_size, (size_t)WS_END); grid_blocks = -1; return; }
        int dev = 0, cus = 0, per_cu = 0;
        (void)hipGetDevice(&dev);
        (void)hipDeviceGetAttribute(&cus, hipDeviceAttributeMultiprocessorCount, dev);
        (void)hipFuncSetAttribute((const void*)fwd_kernel, hipFuncAttributeMaxDynamicSharedMemorySize, LDS_BYTES);
        (void)hipOccupancyMaxActiveBlocksPerMultiprocessor(&per_cu, (const void*)fwd_kernel, NT, LDS_BYTES);
        if (per_cu < 1) per_cu = 1;
        grid_blocks = cus * per_cu;
        fprintf(stderr, "kernel_launch: cus=%d per_cu=%d grid=%d ws=%zu\n", cus, per_cu, grid_blocks, ws_size);
    }
    if (grid_blocks < 0) return;
    (void)hipMemsetAsync((char*)d_ws + WS_CTL, 0, CTL_BYTES, stream);
    Params p{};
    for (int i = 0; i < 31; ++i) p.in[i] = (const float*)d_in[i];
    p.out = (float*)d_out; p.ws = (unsigned char*)d_ws;
    void* args[] = {&p};
    hipError_t e = hipLaunchCooperativeKernel((const void*)fwd_kernel, dim3(grid_blocks), dim3(NT), args, LDS_BYTES, stream);
    if (e != hipSuccess) fprintf(stderr, "cooperative launch failed: %s (grid %d)\n", hipGetErrorString(e), grid_blocks);
}
```

```cpp
#include <hip/hip_runtime.h>
#include <hip/hip_cooperative_groups.h>
#include <cstdio>
#include <cstdint>
namespace cg = cooperative_groups;
#ifndef DBG_STAGE
#define DBG_STAGE 0
#endif
#define TS_A0 2
#define TS_A1 3
#define TS_B0 2
#define TS_B1 3

#define LAS __attribute__((address_space(3)))
typedef unsigned short bf16_t;
typedef short bf16x8 __attribute__((ext_vector_type(8)));
typedef short bf16x4 __attribute__((ext_vector_type(4)));
typedef float f32x4 __attribute__((ext_vector_type(4)));
typedef float f32x2 __attribute__((ext_vector_type(2)));
typedef unsigned u32x4 __attribute__((ext_vector_type(4)));
typedef unsigned u32x2 __attribute__((ext_vector_type(2)));

constexpr int NT = 512, NWAVES = 8;
constexpr int LDS_BYTES = 144 * 1024;
constexpr int Bsz = 8, S = 2048, D = 1024, T = Bsz * S;
constexpr int H_MLA = 8, DQK = 96, DNOPE = 64, DROPE = 32, DV = 64, QLORA = 384, KVLORA = 256;
constexpr int H_ML = 4, DM = 128, MINNER = 512, CHUNK = 64, NCH = S / CHUNK;
constexpr int IN_DIM = 2216;
constexpr int OFF_CQ = 0, OFF_CKV = 384, OFF_KR = 640, OFF_Z = 672, OFF_MV = 1184, OFF_MO = 1696, OFF_GATE = 2208;
constexpr int NE = 256, TOPK = 8, EDIM = 256, SDIM = 256;
constexpr int CAP = T;
constexpr float RMS_EPS = 1e-6f;

constexpr size_t MiB = 1u << 20;
constexpr size_t WS_CTL = 0;
constexpr size_t CTL_BYTES = 65536;
constexpr size_t WS_CNT = 32768;
constexpr int CNT_STRIDE = 32;
constexpr size_t WS_ADA = 1 * MiB;
constexpr size_t WS_BC = 2 * MiB;
constexpr size_t WS_MLOC = WS_BC + 8192;
constexpr size_t WS_MPREV = WS_BC + 16384;
constexpr size_t WS_DN = 2 * MiB + 512 * 1024;
constexpr size_t WS_NPREV = 3 * MiB;
constexpr size_t WS_WIN = 4 * MiB;
constexpr size_t WS_WUQ = 9 * MiB;
constexpr size_t WS_WUKV = 10 * MiB;
constexpr size_t WS_WMQK = 11 * MiB;
constexpr size_t WS_WOUT = 12 * MiB;
constexpr size_t WS_WRGU = 14 * MiB;
constexpr size_t WS_WDSH = 16 * MiB;
constexpr size_t WS_WGU = 32 * MiB;
constexpr size_t WS_WD = 288 * MiB;
constexpr size_t RB = 416 * MiB;
constexpr size_t B_PROJ = RB;
constexpr size_t B_GRAW = RB + 70 * MiB;
constexpr size_t B_GL = RB + 71 * MiB;
constexpr size_t B_H1 = RB + 72 * MiB;
constexpr size_t B_CQN = RB + 104 * MiB;
constexpr size_t B_CKVN = RB + 116 * MiB;
constexpr size_t B_ZC = RB + 124 * MiB;
constexpr size_t B_QRAW = RB + 140 * MiB;
constexpr size_t B_KVRAW = RB + 164 * MiB;
constexpr size_t B_MQ = RB + 196 * MiB;
constexpr size_t B_MK = RB + 212 * MiB;
constexpr size_t B_Q = RB + 228 * MiB;
constexpr size_t B_K = RB + 252 * MiB;
constexpr size_t B_ORAW = RB + 276 * MiB;
constexpr size_t B_AO = RB + 292 * MiB;
constexpr size_t B_DC = RB + 324 * MiB;
constexpr size_t B_CPREV = RB + 388 * MiB;
constexpr size_t C_H2 = RB;
constexpr size_t C_LOGITS = RB + 32 * MiB;
constexpr size_t C_ACTSH = RB + 48 * MiB;
constexpr size_t C_SHOUT = RB + 56 * MiB;
constexpr size_t C_TOKE = RB + 88 * MiB;
constexpr size_t C_TOKW = RB + 89 * MiB;
constexpr size_t C_TOKPOS = RB + 90 * MiB;
constexpr size_t C_LISTTOK = RB + 92 * MiB;
constexpr size_t C_LISTW = RB + 108 * MiB;
constexpr size_t C_ACTE = RB + 124 * MiB;
constexpr size_t C_Y = RB + 188 * MiB;
constexpr size_t C_H2F8 = RB + 320 * MiB;
constexpr size_t WS_END = RB + 444 * MiB;

struct Params {
    const float* in[31];
    float* out;
    unsigned char* ws;
};

typedef __bf16 bf16x2v __attribute__((ext_vector_type(2)));
__device__ __forceinline__ unsigned cvt_pk_bf16(float lo, float hi) { f32x2 v = {lo, hi}; bf16x2v b = __builtin_convertvector(v, bf16x2v); return __builtin_bit_cast(unsigned, b); }
__device__ __forceinline__ unsigned pk4_fp8(float a, float b, float c, float d) { int p = __builtin_amdgcn_cvt_pk_fp8_f32(a, b, 0, false); p = __builtin_amdgcn_cvt_pk_fp8_f32(c, d, p, true); return (unsigned)p; }
__device__ __forceinline__ float bf2f(unsigned short b) { return __uint_as_float((unsigned)b << 16); }
__device__ __forceinline__ float bflo(unsigned u) { return __uint_as_float(u << 16); }
__device__ __forceinline__ float bfhi(unsigned u) { return __uint_as_float(u & 0xffff0000u); }
__device__ __forceinline__ float wave_sum(float v) {
#pragma unroll
    for (int o = 1; o < 64; o <<= 1) v += __shfl_xor(v, o);
    return v;
}
__device__ __forceinline__ float wave_max(float v) {
#pragma unroll
    for (int o = 1; o < 64; o <<= 1) v = fmaxf(v, __shfl_xor(v, o));
    return v;
}
__device__ __forceinline__ float sigmoidf_(float x) { return 1.f / (1.f + __expf(-x)); }
__device__ __forceinline__ float siluf_(float x) { return x / (1.f + __expf(-x)); }
__device__ __forceinline__ int fresh_tid() { int t = threadIdx.x; asm volatile("" : "+v"(t)); return t; }
#define MFMA16(a, b, c) __builtin_amdgcn_mfma_f32_16x16x32_bf16((a), (b), (c), 0, 0, 0)


#define XB_TMO      128
#define XB_XCNT(j)  (256  + 64 * (j))
#define XB_XSUB(j)  (1280 + 64 * (j))
#define XB_XGEN(j)  (2304 + 64 * (j))
#define XB_TOP      3328
#define XB_TOPGEN   3392
#define XCD_BAR_WORDS 3456
#define XB_SPIN_CAP (1u << 23)
__device__ __forceinline__ unsigned xb_ld(unsigned* p)              { return __hip_atomic_load(p, __ATOMIC_RELAXED, __HIP_MEMORY_SCOPE_AGENT); }
__device__ __forceinline__ unsigned xb_add(unsigned* p, unsigned v) { return __hip_atomic_fetch_add(p, v, __ATOMIC_RELAXED, __HIP_MEMORY_SCOPE_AGENT); }
__device__ __forceinline__ unsigned xb_xcc_id() { return (unsigned)__builtin_amdgcn_s_getreg((3 << 11) | 20) & 0xFu; }
#define XB_SPIN(cond, bar) do { unsigned _sp = 0; while (cond) { __builtin_amdgcn_s_sleep(1); \
    if ((++_sp & 255u) == 0u) { if (xb_ld(&(bar)[XB_TMO])) break; if (_sp > XB_SPIN_CAP) { atomicAdd(&(bar)[XB_TMO], 1u); break; } } } } while (0)
struct XcdBarrier { unsigned* bar; unsigned x; volatile LAS unsigned* st; };
__device__ __forceinline__ XcdBarrier xcd_barrier_post(unsigned* bar, volatile LAS unsigned* st) {
    XcdBarrier b; b.bar = bar; b.x = xb_xcc_id(); b.st = st;
    if (threadIdx.x == 0) (void)xb_add(&bar[XB_XCNT(b.x)], 1u);
    return b;
}
__device__ __forceinline__ void xcd_barrier_complete(unsigned* bar, unsigned x, unsigned& nloc, unsigned& nx) {
    const unsigned G = gridDim.x * gridDim.y * gridDim.z;
    unsigned sum, cnt, mine, sp = 0u;
    for (;;) {
        sum = 0u; cnt = 0u; mine = 0u;
#pragma unroll
        for (unsigned j = 0; j < 16; ++j) { const unsigned c = xb_ld(&bar[XB_XCNT(j)]); sum += c; cnt += (c > 0u) ? 1u : 0u; mine = (j == x) ? c : mine; }
        if (sum == G) break;
        __builtin_amdgcn_s_sleep(1);
        if ((++sp & 255u) == 0u) { if (xb_ld(&bar[XB_TMO])) break; if (sp > XB_SPIN_CAP) { atomicAdd(&bar[XB_TMO], 1u); break; } }
    }
    nloc = mine > 0u ? mine : 1u; nx = cnt > 0u ? cnt : 1u;
}
__device__ __forceinline__ void xcd_barrier(const XcdBarrier& b) {
    asm volatile("s_waitcnt vmcnt(0)" ::: "memory");
    __syncthreads();
    if (threadIdx.x == 0) {
        unsigned* bar = b.bar;
        __builtin_amdgcn_s_waitcnt(0);
        unsigned nloc = b.st[0], nx = b.st[1];
        if (nloc == 0u) { xcd_barrier_complete(bar, b.x, nloc, nx); b.st[0] = nloc; b.st[1] = nx; }
        const unsigned old = xb_add(&bar[XB_XSUB(b.x)], 1u);
        const unsigned gen = old / nloc;
        if (old + 1u == (gen + 1u) * nloc) {
            __builtin_amdgcn_fence(__ATOMIC_RELEASE, "agent");
            asm volatile("s_waitcnt vmcnt(0)" ::: "memory");
            const unsigned og = xb_add(&bar[XB_TOP], 1u);
            const unsigned tg = og / nx;
            if (og + 1u == (tg + 1u) * nx) xb_add(&bar[XB_TOPGEN], 1u);
            else XB_SPIN(xb_ld(&bar[XB_TOPGEN]) == tg, bar);
            __builtin_amdgcn_fence(__ATOMIC_ACQUIRE, "agent");
            xb_add(&bar[XB_XGEN(b.x)], 1u);
            asm volatile("s_waitcnt vmcnt(0)" ::: "memory");
        } else {
            XB_SPIN(xb_ld(&bar[XB_XGEN(b.x)]) == gen, bar);
            __builtin_amdgcn_fence(__ATOMIC_ACQUIRE, "agent");
            asm volatile("s_waitcnt vmcnt(0)" ::: "memory");
        }
    }
    __syncthreads();
}

template <int MAP>
__device__ __forceinline__ int map_row(int n) {
    if (MAP == 0) return n;
    if (MAP == 1) return ((n >> 4) << 5) + (n & 15);
    return ((n >> 4) << 5) + 16 + (n & 15);
}
template <int MAP>
__device__ __forceinline__ void conv_item(const float* src, int K, int N, bf16_t* dst, size_t dst_mat_stride, int row_off, LAS float* scr, int it, int lane) {
    const int nblk = (N + 31) / 32, kblk = K / 64, per = nblk * kblk;
    const int mat = it / per, r = it - mat * per, kb = r / nblk, nb = r - kb * nblk, k0 = kb * 64, n0 = nb * 32;
    const float* W = src + (size_t)mat * K * N;
    bf16_t* WT = dst + (size_t)mat * dst_mat_stride;
    const int nn = n0 + (lane & 31);
    const bool nok = nn < N;
    float v[32];
    const float* wp = W + (size_t)(k0 + (lane >> 5)) * N + nn;
#pragma unroll
    for (int i = 0; i < 32; ++i) v[i] = nok ? wp[(size_t)(2 * i) * N] : 0.f;
#pragma unroll
    for (int i = 0; i < 32; ++i) scr[(2 * i + (lane >> 5)) * 33 + (lane & 31)] = v[i];
    asm volatile("s_waitcnt lgkmcnt(0)" ::: "memory");
    const int c = lane & 7;
#pragma unroll
    for (int j = 0; j < 4; ++j) {
        const int n = (lane >> 3) + 8 * j;
        const LAS float* sp = scr + (8 * c) * 33 + n;
        u32x4 o; o.x = cvt_pk_bf16(sp[0 * 33], sp[1 * 33]); o.y = cvt_pk_bf16(sp[2 * 33], sp[3 * 33]); o.z = cvt_pk_bf16(sp[4 * 33], sp[5 * 33]); o.w = cvt_pk_bf16(sp[6 * 33], sp[7 * 33]);
        if (n0 + n < N) *(u32x4*)(WT + (size_t)(row_off + map_row<MAP>(n0 + n)) * K + k0 + 8 * c) = o;
    }
    asm volatile("s_waitcnt lgkmcnt(0)" ::: "memory");
}

__device__ __forceinline__ void ada_unit(const Params& p, LAS unsigned char* lds, int u, int tid) {
    LAS float* cond = (LAS float*)lds;
    LAS float* red = (LAS float*)(lds + 32768);
    const float* c = p.in[1]; const float* w = p.in[3]; const float* bias = p.in[4];
    float* ada = (float*)(p.ws + WS_ADA);
    const int lane = tid & 63, wv = tid >> 6;
    for (int i = tid; i < 8 * 1024; i += NT) cond[i] = siluf_(c[i]);
    __syncthreads();
    float acc[8];
#pragma unroll
    for (int b = 0; b < 8; ++b) acc[b] = 0.f;
    const int col = u * 64 + lane;
#pragma unroll 16
    for (int k = wv * 128; k < wv * 128 + 128; ++k) {
        const float wv_ = w[(size_t)k * 6144 + col];
#pragma unroll
        for (int b = 0; b < 8; ++b) acc[b] += cond[b * 1024 + k] * wv_;
    }
#pragma unroll
    for (int b = 0; b < 8; ++b) red[(wv * 8 + b) * 64 + lane] = acc[b];
    __syncthreads();
    {
        const int b = tid >> 6;
        float s = 0.f;
#pragma unroll
        for (int w2 = 0; w2 < 8; ++w2) s += red[(w2 * 8 + b) * 64 + lane];
        ada[b * 6144 + col] = s + bias[col];
    }
    __syncthreads();
}

__device__ __forceinline__ void norm_mod_rows(const float* X, const float* g, const float* ada, int sh_off, int sc_off, bf16_t* Hout, int gw, int ngw, int lane, unsigned char* H8 = nullptr) {
    f32x4 nx[4];
    if (gw < T) {
#pragma unroll
        for (int j = 0; j < 4; ++j) nx[j] = *((const f32x4*)(X + (size_t)gw * D) + lane + 64 * j);
    }
    for (int row = gw; row < T; row += ngw) {
        const int b = row / S;
        f32x4 v[4]; float ss = 0.f;
#pragma unroll
        for (int j = 0; j < 4; ++j) v[j] = nx[j];
        if (row + ngw < T) {
#pragma unroll
            for (int j = 0; j < 4; ++j) nx[j] = *((const f32x4*)(X + (size_t)(row + ngw) * D) + lane + 64 * j);
        }
        f32x4 gg[4], sc[4], sh[4];
#pragma unroll
        for (int j = 0; j < 4; ++j) { const int k = 4 * (lane + 64 * j);
            gg[j] = *(const f32x4*)(g + k); sc[j] = *(const f32x4*)(ada + b * 6144 + sc_off + k); sh[j] = *(const f32x4*)(ada + b * 6144 + sh_off + k); }
#pragma unroll
        for (int j = 0; j < 4; ++j) ss += v[j].x * v[j].x + v[j].y * v[j].y + v[j].z * v[j].z + v[j].w * v[j].w;
        const float rinv = rsqrtf(wave_sum(ss) * (1.f / D) + RMS_EPS);
        u32x2* o = (u32x2*)(Hout + (size_t)row * D) + lane;
#pragma unroll
        for (int j = 0; j < 4; ++j) {
            const f32x4 h = v[j] * rinv * gg[j] * (1.f + sc[j]) + sh[j];
            u32x2 w; w.x = cvt_pk_bf16(h.x, h.y); w.y = cvt_pk_bf16(h.z, h.w);
            o[64 * j] = w;
            if (H8) *((unsigned*)(H8 + (size_t)row * D) + lane + 64 * j) = pk4_fp8(h.x, h.y, h.z, h.w);
        }
    }
}

__device__ __forceinline__ void post_proj_rows(const Params& p, int gw, int ngw, int lane) {
    const bf16_t* proj = (const bf16_t*)(p.ws + B_PROJ);
    const float* graw = (const float*)(p.ws + B_GRAW);
    float* gl = (float*)(p.ws + B_GL);
    bf16_t* cqn = (bf16_t*)(p.ws + B_CQN); bf16_t* ckvn = (bf16_t*)(p.ws + B_CKVN); bf16_t* zc = (bf16_t*)(p.ws + B_ZC);
    const float* g_cq = p.in[7]; const float* g_ckv = p.in[9]; const float* conv_w = p.in[14]; const float* conv_b = p.in[15];
    const float* b_i = p.in[18]; const float* b_f = p.in[19];
    for (int row = gw; row < T; row += ngw) {
        const bf16_t* pr = proj + (size_t)row * IN_DIM;
        const int s = row % S;
        {
            const unsigned* q = (const unsigned*)(pr + OFF_CQ) + lane * 3;
            unsigned a0 = q[0], a1 = q[1], a2 = q[2];
            float f[6] = {bflo(a0), bfhi(a0), bflo(a1), bfhi(a1), bflo(a2), bfhi(a2)};
            float ss = 0.f;
#pragma unroll
            for (int j = 0; j < 6; ++j) ss += f[j] * f[j];
            const float rinv = rsqrtf(wave_sum(ss) * (1.f / QLORA) + RMS_EPS);
            const float* gq = g_cq + lane * 6;
            unsigned* o = (unsigned*)(cqn + (size_t)row * QLORA) + lane * 3;
            o[0] = cvt_pk_bf16(f[0] * rinv * gq[0], f[1] * rinv * gq[1]);
            o[1] = cvt_pk_bf16(f[2] * rinv * gq[2], f[3] * rinv * gq[3]);
            o[2] = cvt_pk_bf16(f[4] * rinv * gq[4], f[5] * rinv * gq[5]);
        }
        {
            const u32x2 a = *((const u32x2*)(pr + OFF_CKV) + lane);
            float f[4] = {bflo(a.x), bfhi(a.x), bflo(a.y), bfhi(a.y)};
            float ss = f[0] * f[0] + f[1] * f[1] + f[2] * f[2] + f[3] * f[3];
            const float rinv = rsqrtf(wave_sum(ss) * (1.f / KVLORA) + RMS_EPS);
            const float* gk = g_ckv + lane * 4;
            u32x2 w; w.x = cvt_pk_bf16(f[0] * rinv * gk[0], f[1] * rinv * gk[1]); w.y = cvt_pk_bf16(f[2] * rinv * gk[2], f[3] * rinv * gk[3]);
            *((u32x2*)(ckvn + (size_t)row * KVLORA) + lane) = w;
        }
        {
            const int c0 = lane * 8;
            float acc[8];
#pragma unroll
            for (int j = 0; j < 8; ++j) acc[j] = conv_b[c0 + j];
#pragma unroll
            for (int tap = 0; tap < 4; ++tap) {
                const int ds = tap - 3;
                if (s + ds >= 0) {
                    const u32x4 z = *(const u32x4*)(pr + (ptrdiff_t)ds * IN_DIM + OFF_Z + c0);
                    const float* cw = conv_w + tap * MINNER + c0;
                    acc[0] += bflo(z.x) * cw[0]; acc[1] += bfhi(z.x) * cw[1]; acc[2] += bflo(z.y) * cw[2]; acc[3] += bfhi(z.y) * cw[3];
                    acc[4] += bflo(z.z) * cw[4]; acc[5] += bfhi(z.z) * cw[5]; acc[6] += bflo(z.w) * cw[6]; acc[7] += bfhi(z.w) * cw[7];
                }
            }
            u32x4 o; o.x = cvt_pk_bf16(siluf_(acc[0]), siluf_(acc[1])); o.y = cvt_pk_bf16(siluf_(acc[2]), siluf_(acc[3]));
            o.z = cvt_pk_bf16(siluf_(acc[4]), siluf_(acc[5])); o.w = cvt_pk_bf16(siluf_(acc[6]), siluf_(acc[7]));
            *(u32x4*)(zc + (size_t)row * MINNER + c0) = o;
        }
        if (lane < 8) {
            const float gr = graw[(size_t)row * 8 + lane];
            float o;
            if (lane < 4) o = gr + b_i[lane];
            else { const float xx = gr + b_f[lane - 4]; o = fminf(xx, 0.f) - log1pf(__expf(-fabsf(xx))); }
            gl[(size_t)row * 8 + lane] = o;
        }
    }
}

__device__ __forceinline__ void qk_post_rows(const Params& p, int gw, int ngw, int lane) {
    const bf16_t* qraw = (const bf16_t*)(p.ws + B_QRAW); const bf16_t* kvraw = (const bf16_t*)(p.ws + B_KVRAW);
    const bf16_t* proj = (const bf16_t*)(p.ws + B_PROJ);
    bf16_t* Q = (bf16_t*)(p.ws + B_Q); bf16_t* Kb = (bf16_t*)(p.ws + B_K);
    const int* positions = (const int*)p.in[2];
    const float* g_qn = p.in[11]; const float* g_kn = p.in[12];
    const float qscale = 0.10206207261596575f * 1.4426950408889634f;
    const int l = lane & 31, hsel = lane >> 5, i = l & 15;
    const float inv_freq = exp2f(-(float)(2 * i) * (13.287712379549449f / 32.f));
    const float gq0 = g_qn[l], gq1 = g_qn[l + 32], gq2 = g_qn[l + 64], gk0 = g_kn[l], gk1 = g_kn[l + 32], gk2 = g_kn[l + 64];
    for (int row = gw; row < T; row += ngw) {
        const int b = row / S, s = row % S;
        float qv[4][3], kv[4][2];
#pragma unroll
        for (int hp = 0; hp < 4; ++hp) {
            const int h = hp * 2 + hsel;
            const bf16_t* qr = qraw + (size_t)row * 768 + h * 96; const bf16_t* kr = kvraw + (size_t)row * 1024 + h * 128;
            qv[hp][0] = bf2f(qr[l]); qv[hp][1] = bf2f(qr[l + 32]); qv[hp][2] = bf2f(qr[l + 64]);
            kv[hp][0] = bf2f(kr[l]); kv[hp][1] = bf2f(kr[l + 32]);
        }
        const float krope = bf2f(proj[(size_t)row * IN_DIM + OFF_KR + l]);
        const float ang = (float)positions[row] * inv_freq;
        float sn, cs; sincosf(ang, &sn, &cs);
#pragma unroll
        for (int hp = 0; hp < 4; ++hp) {
            const int h = hp * 2 + hsel;
            {
                float v0 = qv[hp][0], v1 = qv[hp][1], v2 = qv[hp][2];
                float ss = v0 * v0 + v1 * v1 + v2 * v2;
#pragma unroll
                for (int o = 1; o < 32; o <<= 1) ss += __shfl_xor(ss, o);
                const float rinv = rsqrtf(ss * (1.f / 96.f) + RMS_EPS);
                v0 *= rinv * gq0; v1 *= rinv * gq1; v2 *= rinv * gq2;
                const float other = __shfl_xor(v2, 16);
                const float r = (l < 16) ? (v2 * cs - other * sn) : (other * sn + v2 * cs);
                bf16_t* qo = Q + ((size_t)(b * H_MLA + h) * S + s) * 96;
                qo[l] = (bf16_t)(cvt_pk_bf16(v0 * qscale, 0.f) & 0xffff);
                qo[l + 32] = (bf16_t)(cvt_pk_bf16(v1 * qscale, 0.f) & 0xffff);
                qo[l + 64] = (bf16_t)(cvt_pk_bf16(r * qscale, 0.f) & 0xffff);
            }
            {
                float v0 = kv[hp][0], v1 = kv[hp][1], v2 = krope;
                float ss = v0 * v0 + v1 * v1 + v2 * v2;
#pragma unroll
                for (int o = 1; o < 32; o <<= 1) ss += __shfl_xor(ss, o);
                const float rinv = rsqrtf(ss * (1.f / 96.f) + RMS_EPS);
                v0 *= rinv * gk0; v1 *= rinv * gk1; v2 *= rinv * gk2;
                const float other = __shfl_xor(v2, 16);
                const float r = (l < 16) ? (v2 * cs - other * sn) : (other * sn + v2 * cs);
                bf16_t* ko = Kb + ((size_t)(b * H_MLA + h) * S + s) * 96;
                ko[l] = (bf16_t)(cvt_pk_bf16(v0, 0.f) & 0xffff);
                ko[l + 32] = (bf16_t)(cvt_pk_bf16(v1, 0.f) & 0xffff);
                ko[l + 64] = (bf16_t)(cvt_pk_bf16(r, 0.f) & 0xffff);
            }
        }
    }
}

__device__ __forceinline__ void attn_out_norm_rows(const Params& p, int gw, int ngw, int lane) {
    const bf16_t* oraw = (const bf16_t*)(p.ws + B_ORAW); bf16_t* ao = (bf16_t*)(p.ws + B_AO); const float* g = p.in[13];
    for (int row = gw; row < T; row += ngw) {
        const u32x4 a = *((const u32x4*)(oraw + (size_t)row * 512) + lane);
        float f[8] = {bflo(a.x), bfhi(a.x), bflo(a.y), bfhi(a.y), bflo(a.z), bfhi(a.z), bflo(a.w), bfhi(a.w)};
        float ss = 0.f;
#pragma unroll
        for (int j = 0; j < 8; ++j) ss += f[j] * f[j];
        const float rinv = rsqrtf(wave_sum(ss) * (1.f / 512.f) + RMS_EPS);
        const float* gg = g + lane * 8;
        u32x4 o; o.x = cvt_pk_bf16(f[0] * rinv * gg[0], f[1] * rinv * gg[1]); o.y = cvt_pk_bf16(f[2] * rinv * gg[2], f[3] * rinv * gg[3]);
        o.z = cvt_pk_bf16(f[4] * rinv * gg[4], f[5] * rinv * gg[5]); o.w = cvt_pk_bf16(f[6] * rinv * gg[6], f[7] * rinv * gg[7]);
        *((u32x4*)(ao + (size_t)row * 1024) + lane) = o;
    }
}

namespace pg8 {
#define PG8_LAS __attribute__((address_space(3)))
typedef unsigned short bf16_t;
typedef short bf16x8 __attribute__((ext_vector_type(8)));
typedef float f32x4 __attribute__((ext_vector_type(4)));
typedef unsigned u32x4 __attribute__((ext_vector_type(4)));
constexpr int BM = 256, BK = 64, HALF = 128, HTB = HALF * BK * 2  , STAGE_BYTES = 8 * HTB, NXCD = 8, WGM = 8;

__host__ __device__ __forceinline__ int lds_byte(int r, int c) { const int st = (r >> 4) * 2 + (c >> 5), rr = r & 15, cc = c & 31, ob = rr * 64 + cc * 2; return st * 1024 + (ob ^ (((ob >> 9) & 1) << 5)); }
__host__ __device__ __forceinline__ void stage_rc(int b, int& R, int& C) { const int st = b / 1024, sb = b % 1024, swz = sb ^ (((sb >> 9) & 1) << 5); R = (st >> 1) * 16 + swz / 64; C = (st & 1) * 32 + (swz % 64) / 2; }
__host__ __device__ __forceinline__ int perm32(int rho) { const int n = rho >> 4, i = rho & 15; return 8 * (i >> 2) + 4 * n + (i & 3); }

struct Unit { int pm, pn; };
struct Gemm { const bf16_t* A; const bf16_t* Bt; int M, N, K, lda, ldb, apn; };

struct StaticOrder {
    int nM, nN, nwg, G, c;
    __host__ __device__ void init(int M, int N, int G_, int c_) { nM = M / BM; nN = N / BM; nwg = nM * nN; G = G_; c = c_; }
    __host__ __device__ bool next(int i, Unit& u) const {
        const long L = (long)i * G + c; if (L >= nwg) return false;
        int wgid = (int)L; { const int q = nwg / NXCD, r = nwg % NXCD, xcd = wgid % NXCD, off = wgid / NXCD; wgid = (xcd < r ? xcd * (q + 1) : r * (q + 1) + (xcd - r) * q) + off; }
        const int nig = WGM * nN, gid = wgid / nig, fm = gid * WGM, gsz = (nM - fm) < WGM ? (nM - fm) : WGM;
        u.pm = fm + ((wgid % nig) % gsz); u.pn = (wgid % nig) / gsz; return true;
    }
    __device__ __forceinline__ void a_ready(const Unit&) const {}
    __device__ __forceinline__ void done(const Unit&) const {}
};


template <class Epi, class Sched, bool ALIGN_EPI = false, bool SP2 = false>
__device__ __forceinline__ void gemm_phase(PG8_LAS unsigned char* lds, const Gemm g, const Sched& S, const Epi& E) {
    const int tid = fresh_tid(), wid = __builtin_amdgcn_readfirstlane(tid >> 6), lane = tid & 63, wr = wid >> 2, wc = wid & 3, fr = lane & 15, fq = lane >> 4;
    const int K = g.K, nt = K / BK;
    unsigned voffA[2], voffB[2];
#pragma unroll
    for (int i = 0; i < 2; ++i) { int R, C; stage_rc(tid * 16 + i * 8192, R, C); const int Rb = Epi::PERM ? ((R & ~31) + perm32(R & 31)) : R;
        voffA[i] = (unsigned)(R * g.lda + C) * 2u; voffB[i] = (unsigned)(Rb * g.ldb + C) * 2u; }
    const size_t kstep = (size_t)(BK * 2);
    const size_t hstepA = (size_t)HALF * g.lda * 2, hstepB = (size_t)HALF * g.ldb * 2;
    const size_t tstepA = 2 * hstepA, tstepB = 2 * hstepB;
    const unsigned ldsw = (unsigned)wid * 1024u;
    const int aoff = lds_byte(wr * 64 + fr, fq * 8), boff = lds_byte(wc * 32 + fr, fq * 8);
#define PG8_SA(b, h) (((b) * 2 + (h)) * HTB)
#define PG8_SB(b, h) ((4 + (b) * 2 + (h)) * HTB)
#define PG8_STAGE(bufoff, gbase, voff) do { _Pragma("unroll") for (int _i = 0; _i < 2; ++_i) \
        __builtin_amdgcn_global_load_lds((const unsigned*)((const char*)(gbase) + (voff)[_i]), (PG8_LAS unsigned*)(lds + (bufoff) + ldsw + _i * 8192), 16, 0, 0); } while (0)
#define PG8_LDA(dst, b, h) do { _Pragma("unroll") for (int m = 0; m < 4; ++m) _Pragma("unroll") for (int k = 0; k < 2; ++k) dst[m][k] = *(const PG8_LAS bf16x8*)(lds + PG8_SA(b, h) + aoff + m * 2048 + k * 1024); } while (0)
#define PG8_LDB(dst, b, h) do { _Pragma("unroll") for (int n = 0; n < 2; ++n) _Pragma("unroll") for (int k = 0; k < 2; ++k) dst[n][k] = *(const PG8_LAS bf16x8*)(lds + PG8_SB(b, h) + boff + n * 2048 + k * 1024); } while (0)
#define PG8_MMA(ai, bj, At, Bt) do { __builtin_amdgcn_s_setprio(1); _Pragma("unroll") for (int m = 0; m < 4; ++m) _Pragma("unroll") for (int n = 0; n < 2; ++n) _Pragma("unroll") for (int k = 0; k < 2; ++k) \
        acc[ai][bj][m][n] = __builtin_amdgcn_mfma_f32_16x16x32_bf16(Bt[n][k], At[m][k], acc[ai][bj][m][n], 0, 0, 0); __builtin_amdgcn_s_setprio(0); } while (0)
#define PG8_WAIT_V(n) asm volatile("s_waitcnt vmcnt(" #n ")" ::: "memory")
#define PG8_WAIT_L(n) asm volatile("s_waitcnt lgkmcnt(" #n ")" ::: "memory")
#define PG8_BAR __builtin_amdgcn_s_barrier()
#define PG8_SCHED __builtin_amdgcn_sched_barrier(0)
    Unit cur, nxt; int ui = 0;
    if (!S.next(0, cur)) return;
    f32x4 acc[2][2][4][2];
#pragma unroll
    for (int a = 0; a < 2; ++a)
#pragma unroll
        for (int b = 0; b < 2; ++b)
#pragma unroll
            for (int m = 0; m < 4; ++m)
#pragma unroll
                for (int n = 0; n < 2; ++n) acc[a][b][m][n] = (f32x4){0.f, 0.f, 0.f, 0.f};
    bf16x8 At[4][2], B0[2][2], B1[2][2];
    const char* cA = (const char*)g.A + (size_t)cur.pm * tstepA + (size_t)cur.pn * g.apn * 2; const char* cB = (const char*)g.Bt + (size_t)cur.pn * tstepB;
    S.a_ready(cur);
    if constexpr (SP2) {
        PG8_STAGE(PG8_SB(0, 0), cB, voffB); PG8_STAGE(PG8_SB(0, 1), cB + hstepB, voffB); PG8_STAGE(PG8_SA(0, 0), cA, voffA); PG8_STAGE(PG8_SA(0, 1), cA + hstepA, voffA);
        if (wr == 1) PG8_BAR;
        PG8_WAIT_V(2); PG8_BAR;
        PG8_STAGE(PG8_SB(1, 0), cB + kstep, voffB); PG8_STAGE(PG8_SA(1, 0), cA + kstep, voffA); PG8_STAGE(PG8_SB(1, 1), cB + hstepB + kstep, voffB);
        PG8_WAIT_V(6); PG8_BAR;
    } else {
        PG8_STAGE(PG8_SB(0, 0), cB, voffB); PG8_STAGE(PG8_SA(0, 0), cA, voffA); PG8_STAGE(PG8_SB(0, 1), cB + hstepB, voffB); PG8_STAGE(PG8_SA(0, 1), cA + hstepA, voffA);
        if (wr == 1) PG8_BAR;
        PG8_WAIT_V(4); PG8_BAR;
        PG8_STAGE(PG8_SB(1, 0), cB + kstep, voffB); PG8_STAGE(PG8_SA(1, 0), cA + kstep, voffA); PG8_STAGE(PG8_SB(1, 1), cB + hstepB + kstep, voffB);
        PG8_WAIT_V(6); PG8_BAR;
    }
    for (;;) {
        const bool has_next = S.next(ui + 1, nxt);
        const char* nA = has_next ? (const char*)g.A + (size_t)nxt.pm * tstepA + (size_t)nxt.pn * g.apn * 2 : cA; const char* nB = has_next ? (const char*)g.Bt + (size_t)nxt.pn * tstepB : cB;
        for (int t = 0; t < nt; t += 2) {
            const bool last = (t == nt - 2);
            const char* a1 = cA + (size_t)(t + 1) * kstep;
            const char* a2 = last ? nA : cA + (size_t)(t + 2) * kstep; const char* b2 = last ? nB : cB + (size_t)(t + 2) * kstep;
            const char* a3 = a2 + kstep; const char* b3 = b2 + kstep;
            if (last && has_next) S.a_ready(nxt);
            if constexpr (SP2) {
            PG8_LDB(B0, 0, 0); PG8_LDB(B1, 0, 1); PG8_SCHED; PG8_LDA(At, 0, 0); PG8_STAGE(PG8_SA(1, 1), a1 + hstepA, voffA);
            PG8_WAIT_V(8); PG8_WAIT_L(0); PG8_BAR; PG8_MMA(0, 0, At, B0); PG8_MMA(0, 1, At, B1); PG8_BAR; PG8_SCHED;
            PG8_LDA(At, 0, 1); PG8_STAGE(PG8_SB(0, 0), b2, voffB); PG8_STAGE(PG8_SB(0, 1), b2 + hstepB, voffB); PG8_STAGE(PG8_SA(0, 0), a2, voffA);
            PG8_WAIT_V(8); PG8_WAIT_L(0); PG8_BAR; PG8_MMA(1, 0, At, B0); PG8_MMA(1, 1, At, B1); PG8_BAR; PG8_SCHED;
            PG8_LDB(B0, 1, 0); PG8_LDB(B1, 1, 1); PG8_SCHED; PG8_LDA(At, 1, 0); PG8_STAGE(PG8_SA(0, 1), a2 + hstepA, voffA);
            PG8_WAIT_V(8); PG8_WAIT_L(0); PG8_BAR; PG8_MMA(0, 0, At, B0); PG8_MMA(0, 1, At, B1); PG8_BAR; PG8_SCHED;
            PG8_LDA(At, 1, 1); PG8_STAGE(PG8_SB(1, 0), b3, voffB); PG8_STAGE(PG8_SB(1, 1), b3 + hstepB, voffB); PG8_STAGE(PG8_SA(1, 0), a3, voffA);
            PG8_WAIT_V(8); PG8_WAIT_L(0); PG8_BAR; PG8_MMA(1, 0, At, B0); PG8_MMA(1, 1, At, B1); PG8_BAR; PG8_SCHED;
            } else {
            PG8_LDB(B0, 0, 0); PG8_SCHED; PG8_LDA(At, 0, 0); PG8_STAGE(PG8_SA(1, 1), a1 + hstepA, voffA);
            PG8_WAIT_L(8); PG8_BAR; PG8_WAIT_L(0); PG8_MMA(0, 0, At, B0); PG8_BAR; PG8_SCHED;
            PG8_LDB(B1, 0, 1); PG8_STAGE(PG8_SB(0, 0), b2, voffB);
            PG8_BAR; PG8_WAIT_L(0); PG8_MMA(0, 1, At, B1); PG8_BAR;
            PG8_LDA(At, 0, 1); PG8_STAGE(PG8_SA(0, 0), a2, voffA);
            PG8_BAR; PG8_WAIT_L(0); PG8_MMA(1, 0, At, B0); PG8_BAR; PG8_SCHED;
            PG8_STAGE(PG8_SB(0, 1), b2 + hstepB, voffB);
            PG8_WAIT_V(6); PG8_BAR; PG8_MMA(1, 1, At, B1); PG8_BAR;
            PG8_LDB(B0, 1, 0); PG8_SCHED; PG8_LDA(At, 1, 0); PG8_STAGE(PG8_SA(0, 1), a2 + hstepA, voffA);
            PG8_WAIT_L(8); PG8_BAR; PG8_WAIT_L(0); PG8_MMA(0, 0, At, B0); PG8_BAR; PG8_SCHED;
            PG8_LDB(B1, 1, 1); PG8_STAGE(PG8_SB(1, 0), b3, voffB);
            PG8_BAR; PG8_WAIT_L(0); PG8_MMA(0, 1, At, B1); PG8_BAR;
            PG8_LDA(At, 1, 1); PG8_STAGE(PG8_SA(1, 0), a3, voffA);
            PG8_BAR; PG8_WAIT_L(0); PG8_MMA(1, 0, At, B0); PG8_BAR; PG8_SCHED;
            PG8_STAGE(PG8_SB(1, 1), b3 + hstepB, voffB);
            PG8_WAIT_V(6); PG8_BAR; PG8_MMA(1, 1, At, B1); PG8_BAR;
            }
        }
        if constexpr (ALIGN_EPI) { if (wr == 0) PG8_BAR; }
        if constexpr (!Epi::AFTER_DRAIN) { E(acc, cur, wr, wc, fr, fq); S.done(cur); }
        if (!has_next) break;
#pragma unroll
        for (int a = 0; a < 2; ++a)
#pragma unroll
            for (int b = 0; b < 2; ++b)
#pragma unroll
                for (int m = 0; m < 4; ++m)
#pragma unroll
                    for (int n = 0; n < 2; ++n) acc[a][b][m][n] = (f32x4){0.f, 0.f, 0.f, 0.f};
        cur = nxt; cA = nA; cB = nB; ++ui;
        if constexpr (ALIGN_EPI) { if (wr == 1) PG8_BAR; }
    }
    PG8_WAIT_V(0);
    if constexpr (!ALIGN_EPI) { if (wr == 0) PG8_BAR; }
    PG8_BAR;
    if constexpr (Epi::AFTER_DRAIN) { E.fused(acc, cur, wr, wc, fr, fq, lds, wid, lane); S.done(cur); }
#undef PG8_SA
#undef PG8_SB
#undef PG8_STAGE
#undef PG8_LDA
#undef PG8_LDB
#undef PG8_MMA
#undef PG8_WAIT_V
#undef PG8_WAIT_L
#undef PG8_BAR
#undef PG8_SCHED
}
}

constexpr int GBK = 128;
constexpr int GLB = GBK + 16;
constexpr int G2_AS = 256 * GLB;
constexpr int G2_BS = 128 * GLB;
constexpr int G2_STAGE = G2_AS + G2_BS;
typedef long i64_t;
template <class RowPtr, class ColPtr, class Epi>
__device__ __forceinline__ void gemm2_tile(LAS unsigned char* lds, const RowPtr& RP, const ColPtr& CP, int ldk, int K, int m0, int n0, const Epi& E, int mvalid = 256) {
    const int tid = fresh_tid(), lane = tid & 63, wid = tid >> 6, half = wid >> 2, wm = (wid >> 1) & 1, wn = wid & 1;
    const int fr = lane & 15, fq = lane >> 4;
    const int ht = tid & 255;
    const int ac = (ht & 7) * 16, ar0 = half * 128 + (ht >> 3);
    const int bn = half * 64 + (ht & 63), bk = (ht >> 6) * 32;
    const unsigned char* ap0 = RP(m0 + ar0); const unsigned char* ap1 = RP(m0 + ar0 + 32); const unsigned char* ap2 = RP(m0 + ar0 + 64); const unsigned char* ap3 = RP(m0 + ar0 + 96);
    const float* bp = CP(n0 + bn);
    const f32x4 epre = E.pre(m0 + half * 128 + wm * 64, lane);
    f32x4 acc[4][4];
#pragma unroll
    for (int m = 0; m < 4; ++m)
#pragma unroll
        for (int n = 0; n < 4; ++n) acc[m][n] = (f32x4){0.f, 0.f, 0.f, 0.f};
    const u32x4 z4 = (u32x4){0u, 0u, 0u, 0u};
    u32x4 ra[4] = {z4, z4, z4, z4}; float rb[32];
#pragma unroll
    for (int j = 0; j < 32; ++j) rb[j] = 0.f;
    const int nk = K / GBK;
    const bool docomp = (half == 0) || (mvalid > 128);
#define G2_LOAD(kt_) do { const int k0_ = (kt_) * GBK; \
        ra[0] = ap0 ? *(const u32x4*)(ap0 + k0_ + ac) : z4; ra[1] = ap1 ? *(const u32x4*)(ap1 + k0_ + ac) : z4; \
        ra[2] = ap2 ? *(const u32x4*)(ap2 + k0_ + ac) : z4; ra[3] = ap3 ? *(const u32x4*)(ap3 + k0_ + ac) : z4; \
        if (bp) { _Pragma("unroll") for (int j_ = 0; j_ < 32; ++j_) rb[j_] = bp[(size_t)(k0_ + bk + j_) * ldk]; } \
        else { _Pragma("unroll") for (int j_ = 0; j_ < 32; ++j_) rb[j_] = 0.f; } } while (0)
#define G2_STORE(buf_) do { LAS unsigned char* As_ = lds + (buf_) * G2_STAGE; LAS unsigned char* Bs_ = As_ + G2_AS; \
        _Pragma("unroll") for (int j_ = 0; j_ < 4; ++j_) *(LAS u32x4*)(As_ + (ar0 + 32 * j_) * GLB + ac) = ra[j_]; \
        u32x4 w0_, w1_; w0_.x = pk4_fp8(rb[0], rb[1], rb[2], rb[3]); w0_.y = pk4_fp8(rb[4], rb[5], rb[6], rb[7]); w0_.z = pk4_fp8(rb[8], rb[9], rb[10], rb[11]); w0_.w = pk4_fp8(rb[12], rb[13], rb[14], rb[15]); \
        w1_.x = pk4_fp8(rb[16], rb[17], rb[18], rb[19]); w1_.y = pk4_fp8(rb[20], rb[21], rb[22], rb[23]); w1_.z = pk4_fp8(rb[24], rb[25], rb[26], rb[27]); w1_.w = pk4_fp8(rb[28], rb[29], rb[30], rb[31]); \
        *(LAS u32x4*)(Bs_ + bn * GLB + bk) = w0_; *(LAS u32x4*)(Bs_ + bn * GLB + bk + 16) = w1_; } while (0)
#define G2_FRAGS(af_, bf_, ks_) do { \
        _Pragma("unroll") for (int m_ = 0; m_ < 4; ++m_) af_[m_] = *(const LAS i64_t*)(As_ + (m_ * 16 + fr) * GLB + (ks_) * 32 + fq * 8); \
        _Pragma("unroll") for (int n_ = 0; n_ < 4; ++n_) bf_[n_] = *(const LAS i64_t*)(Bs_ + (n_ * 16 + fr) * GLB + (ks_) * 32 + fq * 8); } while (0)
#define G2_MMA(af_, bf_) do { \
        _Pragma("unroll") for (int m_ = 0; m_ < 4; ++m_) _Pragma("unroll") for (int n_ = 0; n_ < 4; ++n_) acc[m_][n_] = __builtin_amdgcn_mfma_f32_16x16x32_fp8_fp8(bf_[n_], af_[m_], acc[m_][n_], 0, 0, 0); } while (0)
#define G2_COMPUTE(buf_) do { const LAS unsigned char* As_ = lds + (buf_) * G2_STAGE + (half * 128 + wm * 64) * GLB; const LAS unsigned char* Bs_ = lds + (buf_) * G2_STAGE + G2_AS + (wn * 64) * GLB; \
        i64_t afa_[4], bfa_[4], afb_[4], bfb_[4]; \
        G2_FRAGS(afa_, bfa_, 0); G2_FRAGS(afb_, bfb_, 1); G2_MMA(afa_, bfa_); \
        G2_FRAGS(afa_, bfa_, 2); G2_MMA(afb_, bfb_); \
        G2_FRAGS(afb_, bfb_, 3); G2_MMA(afa_, bfa_); \
        G2_MMA(afb_, bfb_); } while (0)
    G2_LOAD(0);
    G2_STORE(0);
    if (nk > 1) G2_LOAD(1);
    __syncthreads();
#pragma unroll 1
    for (int kt = 0; kt < nk; ++kt) {
        const int cur = kt & 1;
        if (half == 0) { G2_COMPUTE(cur); }
        else if (kt + 1 < nk) { G2_STORE(cur ^ 1); if (kt + 2 < nk) G2_LOAD(kt + 2); }
        __syncthreads();
        if (half == 1) { if (docomp) { G2_COMPUTE(cur); } }
        else if (kt + 1 < nk) { G2_STORE(cur ^ 1); if (kt + 2 < nk) G2_LOAD(kt + 2); }
        __syncthreads();
    }
#undef G2_LOAD
#undef G2_STORE
#undef G2_COMPUTE
#undef G2_FRAGS
#undef G2_MMA
    E(acc, m0 + half * 128 + wm * 64, n0 + wn * 64, lane, epre);
}

struct RowDense { const bf16_t* A; int lda; __device__ __forceinline__ const bf16_t* operator()(int r) const { return A + (size_t)r * lda; } };
struct RowGather { const unsigned char* A; const int* idx; int nvalid; __device__ __forceinline__ const unsigned char* operator()(int r) const { return r < nvalid ? A + (size_t)idx[r] * D : nullptr; } };
struct RowSlots { const unsigned char* A; int nvalid; __device__ __forceinline__ const unsigned char* operator()(int r) const { return r < nvalid ? A + (size_t)r * EDIM : nullptr; } };
struct ColDense { const float* W; int N; __device__ __forceinline__ const float* operator()(int c) const { return c < N ? W + c : nullptr; } };
struct ColMqk { const float* q; ptrdiff_t dk; __device__ __forceinline__ const float* operator()(int c) const { return q + ((c < 128) ? (ptrdiff_t)c : dk + (c - 128)); } };
struct ColGU { const float* g; ptrdiff_t du; __device__ __forceinline__ const float* operator()(int c) const { const int j = c >> 5, w = c & 31; return g + (((w & 16) ? du : (ptrdiff_t)0) + j * 16 + (w & 15)); } };
struct ColRgu { const float* r; ptrdiff_t dg; ptrdiff_t du; __device__ __forceinline__ const float* operator()(int c) const {
    const int cc = c - 256, j = cc >> 5, w = cc & 31; const ptrdiff_t off = (c < 256) ? (ptrdiff_t)c : (((w & 16) ? du : dg) + j * 16 + (w & 15)); return r + off; } };

__device__ __forceinline__ u32x2 pack4(const f32x4 v) { u32x2 w; w.x = cvt_pk_bf16(v.x, v.y); w.y = cvt_pk_bf16(v.z, v.w); return w; }
__device__ __forceinline__ u32x2 pack_swiglu(const f32x4 g, const f32x4 u) { u32x2 w; w.x = cvt_pk_bf16(siluf_(g.x) * u.x, siluf_(g.y) * u.y); w.y = cvt_pk_bf16(siluf_(g.z) * u.z, siluf_(g.w) * u.w); return w; }
struct EpiProj {
    bf16_t* proj; float* graw;
    __device__ __forceinline__ f32x4 pre(int rb, int lane) const { return (f32x4){0.f, 0.f, 0.f, 0.f}; }
    __device__ __forceinline__ void operator()(const f32x4 (&acc)[4][4], int rb, int cb, int lane, const f32x4 epre) const {
        const int fr = lane & 15, fq = lane >> 4;
#pragma unroll
        for (int m = 0; m < 4; ++m)
#pragma unroll
            for (int n = 0; n < 4; ++n) {
                const int row = rb + m * 16 + fr, col = cb + n * 16 + 4 * fq;
                if (col < OFF_GATE) *(u32x2*)(proj + (size_t)row * IN_DIM + col) = pack4(acc[m][n]);
                else if (col < IN_DIM) *(f32x4*)(graw + (size_t)row * 8 + (col - OFF_GATE)) = acc[m][n];
            }
    }
};
struct EpiNull {
    float* sink;
    __device__ __forceinline__ f32x4 pre(int rb, int lane) const { return (f32x4){0.f, 0.f, 0.f, 0.f}; }
    __device__ __forceinline__ void operator()(const f32x4 (&acc)[4][4], int rb, int cb, int lane, const f32x4 epre) const {
        float t = 0.f;
#pragma unroll
        for (int m = 0; m < 4; ++m)
#pragma unroll
            for (int n = 0; n < 4; ++n) t += acc[m][n].x + acc[m][n].y + acc[m][n].z + acc[m][n].w;
        if (t == 12345.678f) sink[lane] = t;
    }
};
struct EpiBf16 {
    bf16_t* O; int ldc;
    __device__ __forceinline__ f32x4 pre(int rb, int lane) const { return (f32x4){0.f, 0.f, 0.f, 0.f}; }
    __device__ __forceinline__ void operator()(const f32x4 (&acc)[4][4], int rb, int cb, int lane, const f32x4 epre) const {
        const int fr = lane & 15, fq = lane >> 4;
#pragma unroll
        for (int m = 0; m < 4; ++m)
#pragma unroll
            for (int n = 0; n < 4; ++n) *(u32x2*)(O + (size_t)(rb + m * 16 + fr) * ldc + cb + n * 16 + 4 * fq) = pack4(acc[m][n]);
    }
};
struct EpiMqk {
    bf16_t* mq; bf16_t* mk; int h;
    __device__ __forceinline__ f32x4 pre(int rb, int lane) const { return (f32x4){0.f, 0.f, 0.f, 0.f}; }
    __device__ __forceinline__ void operator()(const f32x4 (&acc)[4][4], int rb, int cb, int lane, const f32x4 epre) const {
        const int fr = lane & 15, fq = lane >> 4;
#pragma unroll
        for (int m = 0; m < 4; ++m)
#pragma unroll
            for (int n = 0; n < 4; ++n) {
                const int row = rb + m * 16 + fr, col = cb + n * 16 + 4 * fq; f32x4 v = acc[m][n];
                bf16_t* dst = mq; int c = col;
                if (col >= 128) { dst = mk; c = col - 128; v = v * 0.08838834764831845f; }
                *(u32x2*)(dst + (size_t)row * MINNER + h * DM + c) = pack4(v);
            }
    }
};
struct EpiResid {
    const float* X; const float* ada; int gt_off; float* out;
    __device__ __forceinline__ f32x4 pre(int rb, int lane) const { return (f32x4){0.f, 0.f, 0.f, 0.f}; }
    __device__ __forceinline__ void operator()(const f32x4 (&acc)[4][4], int rb, int cb, int lane, const f32x4 epre) const {
        const int fr = lane & 15, fq = lane >> 4;
#pragma unroll
        for (int m = 0; m < 4; ++m)
#pragma unroll
            for (int n = 0; n < 4; ++n) {
                const int row = rb + m * 16 + fr, col = cb + n * 16 + 4 * fq; const int b = row / S;
                const f32x4 g = *(const f32x4*)(ada + b * 6144 + gt_off + col);
                const f32x4 x = *(const f32x4*)(X + (size_t)row * D + col);
                *(f32x4*)(out + (size_t)row * D + col) = x + g * acc[m][n];
            }
    }
};
struct EpiRgu {
    float* logits; bf16_t* act;
    __device__ __forceinline__ f32x4 pre(int rb, int lane) const { return (f32x4){0.f, 0.f, 0.f, 0.f}; }
    __device__ __forceinline__ void operator()(const f32x4 (&acc)[4][4], int rb, int cb, int lane, const f32x4 epre) const {
        const int fr = lane & 15, fq = lane >> 4;
#pragma unroll
        for (int m = 0; m < 4; ++m) {
            const int row = rb + m * 16 + fr;
            if (cb < 256) {
#pragma unroll
                for (int n = 0; n < 4; ++n) *(f32x4*)(logits + (size_t)row * 256 + cb + n * 16 + 4 * fq) = acc[m][n];
            } else {
                const int j0 = (cb - 256) >> 5;
#pragma unroll
                for (int pp = 0; pp < 2; ++pp) *(u32x2*)(act + (size_t)row * 256 + (j0 + pp) * 16 + 4 * fq) = pack_swiglu(acc[m][2 * pp], acc[m][2 * pp + 1]);
            }
        }
    }
};
struct EpiExpAct {
    unsigned char* act; int slot0; int nvalid;
    __device__ __forceinline__ f32x4 pre(int rb, int lane) const { const f32x4 z = {0.f, 0.f, 0.f, 0.f}; return z; }
    __device__ __forceinline__ void operator()(const f32x4 (&acc)[4][4], int rb, int cb, int lane, const f32x4 epre) const {
        const int fr = lane & 15, fq = lane >> 4;
#pragma unroll
        for (int m = 0; m < 4; ++m) {
            const int r = rb + m * 16 + fr;
            if (r < nvalid) {
                const int j0 = cb >> 5;
#pragma unroll
                for (int pp = 0; pp < 2; ++pp) { const f32x4 g = acc[m][2 * pp], u = acc[m][2 * pp + 1];
                    *(unsigned*)(act + (size_t)(slot0 + r) * 256 + (j0 + pp) * 16 + 4 * fq) = pk4_fp8(siluf_(g.x) * u.x, siluf_(g.y) * u.y, siluf_(g.z) * u.z, siluf_(g.w) * u.w); }
            }
        }
    }
};
struct EpiExpDown {
    unsigned char* y; const float* lw; int slot0; int nvalid;
    __device__ __forceinline__ f32x4 pre(int rb, int lane) const {
        const int fr = lane & 15; f32x4 w;
        w.x = (rb + fr < nvalid) ? lw[rb + fr] : 0.f; w.y = (rb + 16 + fr < nvalid) ? lw[rb + 16 + fr] : 0.f;
        w.z = (rb + 32 + fr < nvalid) ? lw[rb + 32 + fr] : 0.f; w.w = (rb + 48 + fr < nvalid) ? lw[rb + 48 + fr] : 0.f; return w; }
    __device__ __forceinline__ void operator()(const f32x4 (&acc)[4][4], int rb, int cb, int lane, const f32x4 epre) const {
        const int fr = lane & 15, fq = lane >> 4;
#pragma unroll
        for (int m = 0; m < 4; ++m) {
            const int r = rb + m * 16 + fr;
            if (r < nvalid) {
                const float wt = epre[m];
#pragma unroll
                for (int n = 0; n < 4; ++n) { const f32x4 v = acc[m][n] * wt;
                    int pk = __builtin_amdgcn_cvt_pk_fp8_f32(v.x, v.y, 0, false); pk = __builtin_amdgcn_cvt_pk_fp8_f32(v.z, v.w, pk, true);
                    *(int*)(y + (size_t)(slot0 + r) * 1024 + cb + n * 16 + 4 * fq) = pk; }
            }
        }
    }
};

constexpr int AKLD = 104, AVLD = 72;
__device__ __forceinline__ void attn_unit(const Params& p, LAS unsigned char* lds, int bh, int qb) {
    LAS bf16_t* Ks = (LAS bf16_t*)lds;
    LAS bf16_t* Vt = Ks + 64 * AKLD;
    const bf16_t* Q = (const bf16_t*)(p.ws + B_Q) + (size_t)bh * S * 96;
    const bf16_t* Kg = (const bf16_t*)(p.ws + B_K) + (size_t)bh * S * 96;
    const int b = bh >> 3, h = bh & 7;
    const bf16_t* Vg = (const bf16_t*)(p.ws + B_KVRAW) + (size_t)b * S * 1024 + h * 128 + 64;
    bf16_t* O = (bf16_t*)(p.ws + B_ORAW) + (size_t)b * S * 512 + h * 64;
    const int tid = fresh_tid(), lane = tid & 63, wid = tid >> 6, fr = lane & 15, fq = lane >> 4;
    const int q0 = qb * 256, qw0 = q0 + wid * 32;
    bf16x8 qf[2][3];
#pragma unroll
    for (int nq = 0; nq < 2; ++nq)
#pragma unroll
        for (int ks = 0; ks < 3; ++ks) qf[nq][ks] = *(const bf16x8*)(Q + (size_t)(qw0 + nq * 16 + fr) * 96 + ks * 32 + fq * 8);
    f32x4 oacc[4][2];
#pragma unroll
    for (int d = 0; d < 4; ++d)
#pragma unroll
        for (int nq = 0; nq < 2; ++nq) oacc[d][nq] = (f32x4){0.f, 0.f, 0.f, 0.f};
    float mrun[2] = {-1e30f, -1e30f}, lrun[2] = {0.f, 0.f};
    const int ntiles = (q0 + 256) / 64;
    constexpr int ASTG = 64 * AKLD + 64 * AVLD;
    const int kc0 = tid, kc1 = tid + NT;
    const int kr0 = kc0 / 12, kq0 = kc0 - kr0 * 12, kr1 = kc1 / 12, kq1 = kc1 - kr1 * 12;
    const int vkey = tid & 63, vdc = tid >> 6;
    u32x4 rk0, rk1 = (u32x4){0u, 0u, 0u, 0u}, rv;
#define ATT_LOAD(k0_) do { rk0 = *(const u32x4*)(Kg + (size_t)((k0_) + kr0) * 96 + kq0 * 8); if (kc1 < 768) rk1 = *(const u32x4*)(Kg + (size_t)((k0_) + kr1) * 96 + kq1 * 8); \
        rv = *(const u32x4*)(Vg + (size_t)((k0_) + vkey) * 1024 + vdc * 8); } while (0)
#define ATT_STORE(buf_) do { LAS bf16_t* Kd_ = Ks + (buf_) * ASTG; LAS bf16_t* Vd_ = Kd_ + 64 * AKLD; \
        *(LAS u32x4*)(Kd_ + kr0 * AKLD + kq0 * 8) = rk0; if (kc1 < 768) *(LAS u32x4*)(Kd_ + kr1 * AKLD + kq1 * 8) = rk1; \
        LAS bf16_t* vt_ = Vd_ + (vdc * 8) * AVLD + vkey; \
        vt_[0 * AVLD] = (bf16_t)(rv.x & 0xffff); vt_[1 * AVLD] = (bf16_t)(rv.x >> 16); vt_[2 * AVLD] = (bf16_t)(rv.y & 0xffff); vt_[3 * AVLD] = (bf16_t)(rv.y >> 16); \
        vt_[4 * AVLD] = (bf16_t)(rv.z & 0xffff); vt_[5 * AVLD] = (bf16_t)(rv.z >> 16); vt_[6 * AVLD] = (bf16_t)(rv.w & 0xffff); vt_[7 * AVLD] = (bf16_t)(rv.w >> 16); } while (0)
    ATT_LOAD(0);
    ATT_STORE(0);
    __syncthreads();
    for (int kt = 0; kt < ntiles; ++kt) {
        const int k0 = kt * 64;
        const LAS bf16_t* Kc = Ks + (kt & 1) * ASTG; const LAS bf16_t* Vc = Kc + 64 * AKLD;
        if (kt + 1 < ntiles) ATT_LOAD(k0 + 64);
        if (k0 <= qw0 + 31) {
            f32x4 sacc[4][2];
#pragma unroll
            for (int t4 = 0; t4 < 4; ++t4)
#pragma unroll
                for (int nq = 0; nq < 2; ++nq) sacc[t4][nq] = (f32x4){0.f, 0.f, 0.f, 0.f};
#pragma unroll
            for (int ks = 0; ks < 3; ++ks)
#pragma unroll
                for (int t4 = 0; t4 < 4; ++t4) {
                    const bf16x8 kf = *(const LAS bf16x8*)(Kc + (t4 * 16 + fr) * AKLD + ks * 32 + fq * 8);
#pragma unroll
                    for (int nq = 0; nq < 2; ++nq) sacc[t4][nq] = MFMA16(kf, qf[nq][ks], sacc[t4][nq]);
                }
            const bool need_mask = (k0 + 63 > qw0);
#pragma unroll
            for (int nq = 0; nq < 2; ++nq) {
                const int qidx = qw0 + nq * 16 + fr;
                float mx = -1e30f;
#pragma unroll
                for (int t4 = 0; t4 < 4; ++t4)
#pragma unroll
                    for (int i = 0; i < 4; ++i) {
                        if (need_mask) { const int key = k0 + t4 * 16 + 4 * fq + i; if (key > qidx) sacc[t4][nq][i] = -1e30f; }
                        mx = fmaxf(mx, sacc[t4][nq][i]);
                    }
                mx = fmaxf(mx, __shfl_xor(mx, 16)); mx = fmaxf(mx, __shfl_xor(mx, 32));
                const float mnew = fmaxf(mrun[nq], mx);
                const float alpha = exp2f(mrun[nq] - mnew);
                mrun[nq] = mnew;
                float ls = 0.f;
#pragma unroll
                for (int t4 = 0; t4 < 4; ++t4)
#pragma unroll
                    for (int i = 0; i < 4; ++i) { const float pv = exp2f(sacc[t4][nq][i] - mnew); sacc[t4][nq][i] = pv; ls += pv; }
                lrun[nq] = lrun[nq] * alpha + ls;
#pragma unroll
                for (int d = 0; d < 4; ++d) oacc[d][nq] = oacc[d][nq] * alpha;
            }
#pragma unroll
            for (int s2 = 0; s2 < 2; ++s2) {
                bf16x8 pb[2];
#pragma unroll
                for (int nq = 0; nq < 2; ++nq) {
                    u32x4 w; w.x = cvt_pk_bf16(sacc[2 * s2][nq].x, sacc[2 * s2][nq].y); w.y = cvt_pk_bf16(sacc[2 * s2][nq].z, sacc[2 * s2][nq].w);
                    w.z = cvt_pk_bf16(sacc[2 * s2 + 1][nq].x, sacc[2 * s2 + 1][nq].y); w.w = cvt_pk_bf16(sacc[2 * s2 + 1][nq].z, sacc[2 * s2 + 1][nq].w);
                    pb[nq] = __builtin_bit_cast(bf16x8, w);
                }
#pragma unroll
                for (int d = 0; d < 4; ++d) {
                    const LAS bf16_t* vr = Vc + (d * 16 + fr) * AVLD + s2 * 32 + 4 * fq;
                    const u32x2 lo = *(const LAS u32x2*)vr, hi = *(const LAS u32x2*)(vr + 16);
                    const bf16x8 vf = __builtin_bit_cast(bf16x8, ((u32x4){lo.x, lo.y, hi.x, hi.y}));
#pragma unroll
                    for (int nq = 0; nq < 2; ++nq) oacc[d][nq] = MFMA16(vf, pb[nq], oacc[d][nq]);
                }
            }
        }
        if (kt + 1 < ntiles) ATT_STORE((kt + 1) & 1);
        __syncthreads();
    }
#undef ATT_LOAD
#undef ATT_STORE
#pragma unroll
    for (int nq = 0; nq < 2; ++nq) {
        float l = lrun[nq]; l += __shfl_xor(l, 16); l += __shfl_xor(l, 32);
        const float inv = 1.f / l;
        const int qidx = qw0 + nq * 16 + fr;
#pragma unroll
        for (int d = 0; d < 4; ++d) { const f32x4 v = oacc[d][nq] * inv; u32x2 w; w.x = cvt_pk_bf16(v.x, v.y); w.y = cvt_pk_bf16(v.z, v.w);
            *(u32x2*)(O + (size_t)qidx * 512 + d * 16 + 4 * fq) = w; }
    }
}

constexpr int MTLD = 72;
__device__ __forceinline__ void mlstm_a_unit(const Params& p, LAS unsigned char* lds, int unit) {
    LAS bf16_t* kT = (LAS bf16_t*)lds;
    LAS bf16_t* vT = kT + 128 * MTLD;
    LAS float* av = (LAS float*)(vT + 128 * MTLD);
    const int bh = unit >> 5, c = unit & 31, b = bh >> 2, h = bh & 3;
    const int t0 = b * S + c * CHUNK;
    const float* gl = (const float*)(p.ws + B_GL);
    const bf16_t* mk = (const bf16_t*)(p.ws + B_MK); const bf16_t* proj = (const bf16_t*)(p.ws + B_PROJ);
    const int tid = fresh_tid(), lane = tid & 63, wid = tid >> 6, fr = lane & 15, fq = lane >> 4;
    if (wid == 0) {
        const float li = gl[(size_t)(t0 + lane) * 8 + h], lf = gl[(size_t)(t0 + lane) * 8 + 4 + h];
        float bs = lf;
#pragma unroll
        for (int o = 1; o < 64; o <<= 1) { const float t = __shfl_up(bs, o); if (lane >= o) bs += t; }
        const float Btot = __shfl(bs, 63);
        const float g = Btot - bs + li;
        const float ml = wave_max(g);
        av[lane] = __expf(g - ml);
        if (lane == 0) { ((float*)(p.ws + WS_BC))[unit] = Btot; ((float*)(p.ws + WS_MLOC))[unit] = ml; }
    }
    __syncthreads();
#pragma unroll
    for (int rep = 0; rep < 2; ++rep) {
        const int cidx = tid + rep * NT, s = cidx & 63, ch = cidx >> 6;
        const u32x4 kv = *(const u32x4*)(mk + (size_t)(t0 + s) * MINNER + h * DM + ch * 8);
        const u32x4 vv = *(const u32x4*)(proj + (size_t)(t0 + s) * IN_DIM + OFF_MV + h * DM + ch * 8);
        const float a = av[s];
        LAS bf16_t* kt = kT + (ch * 8) * MTLD + s; LAS bf16_t* vt = vT + (ch * 8) * MTLD + s;
        const unsigned kk[4] = {kv.x, kv.y, kv.z, kv.w}; const unsigned vw[4] = {vv.x, vv.y, vv.z, vv.w};
#pragma unroll
        for (int j = 0; j < 4; ++j) {
            kt[(2 * j) * MTLD] = (bf16_t)(kk[j] & 0xffff); kt[(2 * j + 1) * MTLD] = (bf16_t)(kk[j] >> 16);
            const unsigned sc = cvt_pk_bf16(bflo(vw[j]) * a, bfhi(vw[j]) * a);
            vt[(2 * j) * MTLD] = (bf16_t)(sc & 0xffff); vt[(2 * j + 1) * MTLD] = (bf16_t)(sc >> 16);
        }
    }
    __syncthreads();
    {
        const int we = wid >> 1, wd = wid & 1;
        f32x4 acc[2][4];
#pragma unroll
        for (int i = 0; i < 2; ++i)
#pragma unroll
            for (int j = 0; j < 4; ++j) acc[i][j] = (f32x4){0.f, 0.f, 0.f, 0.f};
#pragma unroll
        for (int ks = 0; ks < 2; ++ks) {
            bf16x8 vf[2], kf[4];
#pragma unroll
            for (int i = 0; i < 2; ++i) vf[i] = *(const LAS bf16x8*)(vT + (we * 32 + i * 16 + fr) * MTLD + ks * 32 + fq * 8);
#pragma unroll
            for (int j = 0; j < 4; ++j) kf[j] = *(const LAS bf16x8*)(kT + (wd * 64 + j * 16 + fr) * MTLD + ks * 32 + fq * 8);
#pragma unroll
            for (int i = 0; i < 2; ++i)
#pragma unroll
                for (int j = 0; j < 4; ++j) acc[i][j] = MFMA16(vf[i], kf[j], acc[i][j]);
        }
        float* dC = (float*)(p.ws + B_DC) + (size_t)unit * 16384;
#pragma unroll
        for (int i = 0; i < 2; ++i)
#pragma unroll
            for (int j = 0; j < 4; ++j)
#pragma unroll
                for (int r = 0; r < 4; ++r) dC[(we * 32 + i * 16 + 4 * fq + r) * 128 + wd * 64 + j * 16 + fr] = acc[i][j][r];
    }
    if (tid < 128) {
        float s = 0.f;
        for (int q = 0; q < 64; ++q) s += bf2f(kT[tid * MTLD + q]) * av[q];
        ((float*)(p.ws + WS_DN))[(size_t)unit * 128 + tid] = s;
    }
    __syncthreads();
}

__device__ __forceinline__ void mlstm_scan(const Params& p, int gtid, int ngt) {
    const float* Bc = (const float*)(p.ws + WS_BC); const float* ML = (const float*)(p.ws + WS_MLOC);
    float* mprev = (float*)(p.ws + WS_MPREV);
    const float* dC = (const float*)(p.ws + B_DC); bf16_t* Cp = (bf16_t*)(p.ws + B_CPREV);
    const float* dn = (const float*)(p.ws + WS_DN); float* np_ = (float*)(p.ws + WS_NPREV);
    constexpr int PER = 4096 + 32;
    for (int idx = gtid; idx < 32 * PER; idx += ngt) {
        const int bh = idx / PER, e4 = idx - bh * PER;
        const bool isC = e4 < 4096; const int n4 = e4 - 4096;
        float m = 0.f; f32x4 C = (f32x4){0.f, 0.f, 0.f, 0.f};
        for (int c0 = 0; c0 < NCH; c0 += 4) {
            f32x4 d[4]; float Bt[4], ml[4];
#pragma unroll
            for (int q = 0; q < 4; ++q) {
                const int unit = bh * NCH + c0 + q;
                Bt[q] = Bc[unit]; ml[q] = ML[unit];
                d[q] = isC ? *(const f32x4*)(dC + (size_t)unit * 16384 + e4 * 4) : *(const f32x4*)(dn + (size_t)unit * 128 + n4 * 4);
            }
#pragma unroll
            for (int q = 0; q < 4; ++q) {
                const int unit = bh * NCH + c0 + q;
                const float mnew = fmaxf(Bt[q] + m, ml[q]);
                const float fa = __expf(Bt[q] + m - mnew), fb = __expf(ml[q] - mnew);
                if (isC) {
                    u32x2 w; w.x = cvt_pk_bf16(C.x, C.y); w.y = cvt_pk_bf16(C.z, C.w);
                    *(u32x2*)(Cp + (size_t)unit * 16384 + e4 * 4) = w;
                    if (e4 == 0) mprev[unit] = m;
                } else {
                    *(f32x4*)(np_ + (size_t)unit * 128 + n4 * 4) = C;
                }
                C = C * fa + d[q] * fb;
                m = mnew;
            }
        }
    }
}

constexpr int MRLD = 136;
__device__ __forceinline__ void mlstm_c_unit(const Params& p, LAS unsigned char* lds, int unit) {
    LAS bf16_t* qs = (LAS bf16_t*)lds;
    LAS bf16_t* ks = qs + 64 * MRLD;
    LAS bf16_t* cs = ks + 64 * MRLD;
    LAS bf16_t* vT = cs + 128 * MRLD;
    LAS float* fv = (LAS float*)(vT + 128 * MTLD);
    LAS float* u_s = fv; LAS float* c_t = fv + 64; LAS float* dec = fv + 128; LAS float* emt = fv + 192; LAS float* ssq = fv + 256;
    const int bh = unit >> 5, c = unit & 31, b = bh >> 2, h = bh & 3;
    const int t0 = b * S + c * CHUNK;
    const float* gl = (const float*)(p.ws + B_GL);
    const bf16_t* mq = (const bf16_t*)(p.ws + B_MQ); const bf16_t* mk = (const bf16_t*)(p.ws + B_MK); const bf16_t* proj = (const bf16_t*)(p.ws + B_PROJ);
    const bf16_t* Cp = (const bf16_t*)(p.ws + B_CPREV) + (size_t)unit * 16384;
    const float* np_ = (const float*)(p.ws + WS_NPREV) + (size_t)unit * 128;
    const int tid = fresh_tid(), lane = tid & 63, wid = tid >> 6, fr = lane & 15, fq = lane >> 4;
    if (wid == 0) {
        const float li = gl[(size_t)(t0 + lane) * 8 + h], lf = gl[(size_t)(t0 + lane) * 8 + 4 + h];
        const float mp = ((const float*)(p.ws + WS_MPREV))[unit];
        float bs = lf;
#pragma unroll
        for (int o = 1; o < 64; o <<= 1) { const float t = __shfl_up(bs, o); if (lane >= o) bs += t; }
        const float u = li - bs;
        float pm = u;
#pragma unroll
        for (int o = 1; o < 64; o <<= 1) { const float t = __shfl_up(pm, o); if (lane >= o) pm = fmaxf(pm, t); }
        const float inter = bs + mp;
        const float mt = fmaxf(inter, bs + pm);
        u_s[lane] = u; c_t[lane] = bs - mt; dec[lane] = __expf(inter - mt); emt[lane] = __expf(-mt);
    }
#pragma unroll
    for (int rep = 0; rep < 2; ++rep) {
        const int cidx = tid + rep * NT, r = cidx >> 4, ch = cidx & 15;
        *(LAS u32x4*)(qs + r * MRLD + ch * 8) = *(const u32x4*)(mq + (size_t)(t0 + r) * MINNER + h * DM + ch * 8);
        *(LAS u32x4*)(ks + r * MRLD + ch * 8) = *(const u32x4*)(mk + (size_t)(t0 + r) * MINNER + h * DM + ch * 8);
    }
#pragma unroll
    for (int rep = 0; rep < 4; ++rep) {
        const int cidx = tid + rep * NT, r = cidx >> 4, ch = cidx & 15;
        *(LAS u32x4*)(cs + r * MRLD + ch * 8) = *(const u32x4*)(Cp + r * 128 + ch * 8);
    }
#pragma unroll
    for (int rep = 0; rep < 2; ++rep) {
        const int cidx = tid + rep * NT, s = cidx & 63, ch = cidx >> 6;
        const u32x4 vv = *(const u32x4*)(proj + (size_t)(t0 + s) * IN_DIM + OFF_MV + h * DM + ch * 8);
        LAS bf16_t* vt = vT + (ch * 8) * MTLD + s;
        const unsigned vw[4] = {vv.x, vv.y, vv.z, vv.w};
#pragma unroll
        for (int j = 0; j < 4; ++j) { vt[(2 * j) * MTLD] = (bf16_t)(vw[j] & 0xffff); vt[(2 * j + 1) * MTLD] = (bf16_t)(vw[j] >> 16); }
    }
    __syncthreads();
    const int tt = wid & 3, eh = wid >> 2;
    const int tl = tt * 16 + fr;
    bf16x8 qf[4];
#pragma unroll
    for (int k4 = 0; k4 < 4; ++k4) qf[k4] = *(const LAS bf16x8*)(qs + tl * MRLD + k4 * 32 + fq * 8);
    f32x4 sacc[4];
#pragma unroll
    for (int st = 0; st < 4; ++st) sacc[st] = (f32x4){0.f, 0.f, 0.f, 0.f};
#pragma unroll
    for (int k4 = 0; k4 < 4; ++k4)
#pragma unroll
        for (int st = 0; st < 4; ++st) {
            const bf16x8 kf = *(const LAS bf16x8*)(ks + (st * 16 + fr) * MRLD + k4 * 32 + fq * 8);
            sacc[st] = MFMA16(kf, qf[k4], sacc[st]);
        }
    const float ct = c_t[tl];
    float rs = 0.f;
#pragma unroll
    for (int st = 0; st < 4; ++st)
#pragma unroll
        for (int i = 0; i < 4; ++i) {
            const int s = st * 16 + 4 * fq + i;
            const float w = (s <= tl) ? __expf(ct + u_s[s]) * sacc[st][i] : 0.f;
            sacc[st][i] = w; rs += w;
        }
    rs += __shfl_xor(rs, 16); rs += __shfl_xor(rs, 32);
    float nq;
    {
        f32x4 na = (f32x4){0.f, 0.f, 0.f, 0.f};
#pragma unroll
        for (int k4 = 0; k4 < 4; ++k4) {
            u32x4 w = (u32x4){0u, 0u, 0u, 0u};
            if (fr == 0) { const float* nn = np_ + k4 * 32 + fq * 8; w.x = cvt_pk_bf16(nn[0], nn[1]); w.y = cvt_pk_bf16(nn[2], nn[3]); w.z = cvt_pk_bf16(nn[4], nn[5]); w.w = cvt_pk_bf16(nn[6], nn[7]); }
            na = MFMA16(__builtin_bit_cast(bf16x8, w), qf[k4], na);
        }
        nq = __shfl(na.x, fr);
    }
    f32x4 acc[4];
#pragma unroll
    for (int et = 0; et < 4; ++et) acc[et] = (f32x4){0.f, 0.f, 0.f, 0.f};
#pragma unroll
    for (int k4 = 0; k4 < 4; ++k4)
#pragma unroll
        for (int et = 0; et < 4; ++et) {
            const bf16x8 cf = *(const LAS bf16x8*)(cs + (eh * 64 + et * 16 + fr) * MRLD + k4 * 32 + fq * 8);
            acc[et] = MFMA16(cf, qf[k4], acc[et]);
        }
    const float dcy = dec[tl];
#pragma unroll
    for (int et = 0; et < 4; ++et) acc[et] = acc[et] * dcy;
#pragma unroll
    for (int s2 = 0; s2 < 2; ++s2) {
        u32x4 w; w.x = cvt_pk_bf16(sacc[2 * s2].x, sacc[2 * s2].y); w.y = cvt_pk_bf16(sacc[2 * s2].z, sacc[2 * s2].w);
        w.z = cvt_pk_bf16(sacc[2 * s2 + 1].x, sacc[2 * s2 + 1].y); w.w = cvt_pk_bf16(sacc[2 * s2 + 1].z, sacc[2 * s2 + 1].w);
        const bf16x8 pb = __builtin_bit_cast(bf16x8, w);
#pragma unroll
        for (int et = 0; et < 4; ++et) {
            const LAS bf16_t* vr = vT + (eh * 64 + et * 16 + fr) * MTLD + s2 * 32 + 4 * fq;
            const u32x2 lo = *(const LAS u32x2*)vr, hi = *(const LAS u32x2*)(vr + 16);
            acc[et] = MFMA16(__builtin_bit_cast(bf16x8, ((u32x4){lo.x, lo.y, hi.x, hi.y})), pb, acc[et]);
        }
    }
    const float den = dcy * nq + rs;
    const float hd = 1.f / fmaxf(fabsf(den), emt[tl]);
    float sq = 0.f;
#pragma unroll
    for (int et = 0; et < 4; ++et) { acc[et] = acc[et] * hd; sq += acc[et].x * acc[et].x + acc[et].y * acc[et].y + acc[et].z * acc[et].z + acc[et].w * acc[et].w; }
    sq += __shfl_xor(sq, 16); sq += __shfl_xor(sq, 32);
    if (fq == 0) ssq[eh * 64 + tl] = sq;
    __syncthreads();
    const float rinv = rsqrtf((ssq[tl] + ssq[64 + tl]) * (1.f / 128.f) + RMS_EPS);
    const float* gmo = p.in[20] + h * DM;
    bf16_t* ao = (bf16_t*)(p.ws + B_AO);
#pragma unroll
    for (int et = 0; et < 4; ++et) {
        const int e = eh * 64 + et * 16 + 4 * fq;
        const u32x2 op = *(const u32x2*)(proj + (size_t)(t0 + tl) * IN_DIM + OFF_MO + h * DM + e);
        const f32x4 g = *(const f32x4*)(gmo + e);
        const f32x4 v = acc[et] * rinv * g;
        u32x2 w; w.x = cvt_pk_bf16(v.x * sigmoidf_(bflo(op.x)), v.y * sigmoidf_(bfhi(op.x))); w.y = cvt_pk_bf16(v.z * sigmoidf_(bflo(op.y)), v.w * sigmoidf_(bfhi(op.y)));
        *(u32x2*)(ao + (size_t)(t0 + tl) * 1024 + 512 + h * DM + e) = w;
    }
    __syncthreads();
}

__device__ __forceinline__ unsigned fkey(float f) { const unsigned u = __float_as_uint(f); return (u & 0x80000000u) ? ~u : (u | 0x80000000u); }
__device__ __forceinline__ float rdlane_f(float v, int l) { return __uint_as_float((unsigned)__builtin_amdgcn_readlane((int)__float_as_uint(v), l)); }
__device__ __forceinline__ void route_token(const f32x4 cur, const f32x4 bias, int lane, int (&e8)[8], float (&w8)[8]) {
    float sc[4] = {sigmoidf_(cur.x), sigmoidf_(cur.y), sigmoidf_(cur.z), sigmoidf_(cur.w)};
    float sb[4] = {sc[0] + bias.x, sc[1] + bias.y, sc[2] + bias.z, sc[3] + bias.w};
    float t1 = fmaxf(fmaxf(sb[0], sb[1]), fmaxf(sb[2], sb[3]));
    float t2;
    {   const float a = fmaxf(sb[0], sb[1]), bmin = fminf(sb[0], sb[1]), c2 = fmaxf(sb[2], sb[3]), dmin = fminf(sb[2], sb[3]);
        t2 = fmaxf(fminf(a, c2), fmaxf(bmin, dmin)); }
#pragma unroll
    for (int o = 1; o < 8; o <<= 1) {
        const float o1 = __shfl_xor(t1, o), o2 = __shfl_xor(t2, o);
        const float n1 = fmaxf(t1, o1), n2 = fmaxf(fminf(t1, o1), fmaxf(t2, o2));
        t1 = n1; t2 = n2;
    }
    const float gs = t1 + t2;
    const int myg = lane >> 3;
    int rank = 0;
#pragma unroll
    for (int g = 0; g < 8; ++g) { const float og = rdlane_f(gs, g * 8); rank += (og > gs || (og == gs && g < myg)) ? 1 : 0; }
    const bool keep = rank < 4;
    unsigned key[4];
#pragma unroll
    for (int j = 0; j < 4; ++j) key[j] = keep ? fkey(sb[j]) : 0u;
    unsigned t = 0u;
#pragma unroll 4
    for (int bit = 31; bit >= 0; --bit) {
        const unsigned tt = t | (1u << bit);
        const int c = __builtin_popcountll(__ballot(key[0] >= tt)) + __builtin_popcountll(__ballot(key[1] >= tt)) + __builtin_popcountll(__ballot(key[2] >= tt)) + __builtin_popcountll(__ballot(key[3] >= tt));
        if (c >= TOPK) t = tt;
    }
    unsigned long long sel[4], eq[4];
    int ngt = 0;
#pragma unroll
    for (int j = 0; j < 4; ++j) { sel[j] = __ballot(key[j] > t); eq[j] = __ballot(key[j] == t); ngt += __builtin_popcountll(sel[j]); }
    for (int need = TOPK - ngt; need > 0; --need) {
        int best = 1 << 30;
#pragma unroll
        for (int j = 0; j < 4; ++j) if (eq[j]) { const int idx = 4 * (int)__builtin_ctzll(eq[j]) + j; best = idx < best ? idx : best; }
        const int L = best >> 2, jj = best & 3;
#pragma unroll
        for (int j = 0; j < 4; ++j) if (jj == j) { eq[j] &= ~(1ull << L); sel[j] |= (1ull << L); }
    }
    float wsum = 0.f;
#pragma unroll
    for (int k = 0; k < TOPK; ++k) {
        int best = 1 << 30;
#pragma unroll
        for (int j = 0; j < 4; ++j) if (sel[j]) { const int idx = 4 * (int)__builtin_ctzll(sel[j]) + j; best = idx < best ? idx : best; }
        const int L = best >> 2, jj = best & 3;
#pragma unroll
        for (int j = 0; j < 4; ++j) if (jj == j) sel[j] &= ~(1ull << L);
        const float s0 = rdlane_f(sc[0], L), s1 = rdlane_f(sc[1], L), s2 = rdlane_f(sc[2], L), s3 = rdlane_f(sc[3], L);
        const float sraw = (jj == 0) ? s0 : (jj == 1) ? s1 : (jj == 2) ? s2 : s3;
        e8[k] = best; w8[k] = sraw; wsum += sraw;
    }
    const float inv = 2.5f / wsum;
#pragma unroll
    for (int k = 0; k < TOPK; ++k) w8[k] *= inv;
}
__device__ __forceinline__ void route_rows(const Params& p, int gw, int ngw, int lane) {
    const float* logits = (const float*)(p.ws + C_LOGITS); const float* rb = p.in[24];
    int* cnt = (int*)(p.ws + WS_CNT);
    int* tok_e = (int*)(p.ws + C_TOKE); float* tok_w = (float*)(p.ws + C_TOKW); int* tok_pos = (int*)(p.ws + C_TOKPOS);
    int* list_tok = (int*)(p.ws + C_LISTTOK); float* list_w = (float*)(p.ws + C_LISTW);
    const f32x4 bias = *(const f32x4*)(rb + lane * 4);
    for (int row0 = gw; row0 < T; row0 += ngw * 8) {
        int e_all = 0, row_all = -1; float w_all = 0.f;
        f32x4 lg = *(const f32x4*)(logits + (size_t)row0 * 256 + lane * 4);
#pragma unroll 1
        for (int i = 0; i < 8; ++i) {
            const int row = row0 + i * ngw;
            if (row >= T) break;
            const f32x4 cur = lg;
            if (i + 1 < 8 && row + ngw < T) lg = *(const f32x4*)(logits + (size_t)(row + ngw) * 256 + lane * 4);
            int e8[8]; float w8[8];
            route_token(cur, bias, lane, e8, w8);
            if ((lane >> 3) == i) {
                const int k = lane & 7; int es = e8[0]; float wsel = w8[0];
#pragma unroll
                for (int q = 1; q < 8; ++q) if (k == q) { es = e8[q]; wsel = w8[q]; }
                e_all = es; w_all = wsel; row_all = row;
            }
        }
        if (row_all >= 0) {
            const int k = lane & 7;
            const int pos = atomicAdd(&cnt[e_all * CNT_STRIDE], 1);
            tok_e[(size_t)row_all * 8 + k] = e_all; tok_w[(size_t)row_all * 8 + k] = w_all; tok_pos[(size_t)row_all * 8 + k] = pos;
            list_tok[(size_t)e_all * CAP + pos] = row_all; list_w[(size_t)e_all * CAP + pos] = w_all;
        }
    }
}

__device__ __forceinline__ void expert_prefix(const Params& p, LAS int* base, LAS int* tsx, int tid, int x, int ngrp) {
    const int* cnt = (const int*)(p.ws + WS_CNT);
    const int nper = NE / ngrp;
    if (tid < 64) {
        int c[4]; int s = 0;
#pragma unroll
        for (int j = 0; j < 4; ++j) { c[j] = __hip_atomic_load(cnt + (tid * 4 + j) * CNT_STRIDE, __ATOMIC_RELAXED, __HIP_MEMORY_SCOPE_AGENT); s += c[j]; }
        int ps = s;
#pragma unroll
        for (int o = 1; o < 64; o <<= 1) { const int a = __shfl_up(ps, o); if (tid >= o) ps += a; }
        int es = ps - s;
#pragma unroll
        for (int j = 0; j < 4; ++j) { base[tid * 4 + j] = es; es += c[j]; }
        int run = 0;
        for (int r0 = 0; r0 < nper; r0 += 64) {
            const int i = r0 + tid;
            int tl = 0;
            if (i < nper) tl = (__hip_atomic_load(cnt + (x + ngrp * i) * CNT_STRIDE, __ATOMIC_RELAXED, __HIP_MEMORY_SCOPE_AGENT) + 255) >> 8;
            int pt = tl;
#pragma unroll
            for (int o = 1; o < 64; o <<= 1) { const int a = __shfl_up(pt, o); if (tid >= o) pt += a; }
            if (i < nper) tsx[i] = run + pt - tl;
            run += __shfl(pt, 63);
        }
        if (tid == 0) tsx[nper] = run;
    }
    __syncthreads();
}

__device__ __forceinline__ void combine_rows(const Params& p, LAS int* base, int gw, int ngw, int lane) {
    const bf16_t* sh = (const bf16_t*)(p.ws + C_SHOUT); const unsigned char* y = (const unsigned char*)(p.ws + C_Y);
    const int* tok_e = (const int*)(p.ws + C_TOKE); const int* tok_pos = (const int*)(p.ws + C_TOKPOS);
    const float* ada = (const float*)(p.ws + WS_ADA);
    typedef float f32x2v __attribute__((ext_vector_type(2)));
    for (int row = gw; row < T; row += ngw) {
        const int b = row / S;
        const int col = lane * 16;
        u32x4 yr[TOPK];
#pragma unroll
        for (int k = 0; k < TOPK; ++k) {
            const int e = tok_e[(size_t)row * 8 + k], pos = tok_pos[(size_t)row * 8 + k];
            yr[k] = *(const u32x4*)(y + (size_t)(base[e] + pos) * 1024 + col);
        }
        float acc[16];
        {
            const u32x4 a0 = *(const u32x4*)(sh + (size_t)row * 1024 + col), a1 = *(const u32x4*)(sh + (size_t)row * 1024 + col + 8);
            acc[0] = bflo(a0.x); acc[1] = bfhi(a0.x); acc[2] = bflo(a0.y); acc[3] = bfhi(a0.y); acc[4] = bflo(a0.z); acc[5] = bfhi(a0.z); acc[6] = bflo(a0.w); acc[7] = bfhi(a0.w);
            acc[8] = bflo(a1.x); acc[9] = bfhi(a1.x); acc[10] = bflo(a1.y); acc[11] = bfhi(a1.y); acc[12] = bflo(a1.z); acc[13] = bfhi(a1.z); acc[14] = bflo(a1.w); acc[15] = bfhi(a1.w);
        }
#pragma unroll
        for (int k = 0; k < TOPK; ++k) {
            const unsigned w4[4] = {yr[k].x, yr[k].y, yr[k].z, yr[k].w};
#pragma unroll
            for (int q = 0; q < 4; ++q) {
                const f32x2v lo = __builtin_amdgcn_cvt_pk_f32_fp8((int)w4[q], false), hi = __builtin_amdgcn_cvt_pk_f32_fp8((int)w4[q], true);
                acc[4 * q + 0] += lo.x; acc[4 * q + 1] += lo.y; acc[4 * q + 2] += hi.x; acc[4 * q + 3] += hi.y;
            }
        }
        float* o = p.out + (size_t)row * D + col;
        const float* g = ada + b * 6144 + 5120 + col;
#pragma unroll
        for (int q4 = 0; q4 < 4; ++q4) {
            const f32x4 x = *(const f32x4*)(o + q4 * 4), gg = *(const f32x4*)(g + q4 * 4);
            f32x4 r; r.x = x.x + gg.x * acc[q4 * 4 + 0]; r.y = x.y + gg.y * acc[q4 * 4 + 1]; r.z = x.z + gg.z * acc[q4 * 4 + 2]; r.w = x.w + gg.w * acc[q4 * 4 + 3];
            *(f32x4*)(o + q4 * 4) = r;
        }
    }
}


struct PgProj {
    static constexpr bool PERM = false, AFTER_DRAIN = false;
    bf16_t* proj; float* graw;
    __device__ __forceinline__ void operator()(const f32x4 (&acc)[2][2][4][2], const pg8::Unit& u, int wr, int wc, int fr, int fq) const {
#pragma unroll
        for (int ai = 0; ai < 2; ++ai)
#pragma unroll
            for (int m = 0; m < 4; ++m) { const int row = u.pm * 256 + ai * 128 + wr * 64 + m * 16 + fr;
#pragma unroll
                for (int bj = 0; bj < 2; ++bj)
#pragma unroll
                    for (int n = 0; n < 2; ++n) { const int col = u.pn * 256 + bj * 128 + wc * 32 + n * 16 + 4 * fq;
                        if (col < OFF_GATE) *(u32x2*)(proj + (size_t)row * IN_DIM + col) = pack4(acc[ai][bj][m][n]);
                        else if (col < IN_DIM) *(f32x4*)(graw + (size_t)row * 8 + (col - OFF_GATE)) = acc[ai][bj][m][n]; } }
    }
};
struct PgBf16 {
    static constexpr bool PERM = false, AFTER_DRAIN = false;
    bf16_t* O; int ldc;
    __device__ __forceinline__ void operator()(const f32x4 (&acc)[2][2][4][2], const pg8::Unit& u, int wr, int wc, int fr, int fq) const {
#pragma unroll
        for (int ai = 0; ai < 2; ++ai)
#pragma unroll
            for (int m = 0; m < 4; ++m) { const int row = u.pm * 256 + ai * 128 + wr * 64 + m * 16 + fr;
#pragma unroll
                for (int bj = 0; bj < 2; ++bj)
#pragma unroll
                    for (int n = 0; n < 2; ++n) { const int col = u.pn * 256 + bj * 128 + wc * 32 + n * 16 + 4 * fq;
                        *(u32x2*)(O + (size_t)row * ldc + col) = pack4(acc[ai][bj][m][n]); } }
    }
};
struct PgMqk {
    static constexpr bool PERM = false, AFTER_DRAIN = false;
    bf16_t* mq; bf16_t* mk;
    __device__ __forceinline__ void operator()(const f32x4 (&acc)[2][2][4][2], const pg8::Unit& u, int wr, int wc, int fr, int fq) const {
#pragma unroll
        for (int ai = 0; ai < 2; ++ai)
#pragma unroll
            for (int m = 0; m < 4; ++m) { const int row = u.pm * 256 + ai * 128 + wr * 64 + m * 16 + fr;
#pragma unroll
                for (int bj = 0; bj < 2; ++bj)
#pragma unroll
                    for (int n = 0; n < 2; ++n) { const int c = wc * 32 + n * 16 + 4 * fq;
                        const f32x4 v = bj ? acc[ai][bj][m][n] * 0.08838834764831845f : acc[ai][bj][m][n];
                        *(u32x2*)((bj ? mk : mq) + (size_t)row * MINNER + u.pn * DM + c) = pack4(v); } }
    }
};
struct PgResid {
    static constexpr bool PERM = false, AFTER_DRAIN = false;
    const float* X; const float* ada; int gt_off; float* out;
    __device__ __forceinline__ void operator()(const f32x4 (&acc)[2][2][4][2], const pg8::Unit& u, int wr, int wc, int fr, int fq) const {
#pragma unroll
        for (int ai = 0; ai < 2; ++ai)
#pragma unroll
            for (int m = 0; m < 4; ++m) { const int row = u.pm * 256 + ai * 128 + wr * 64 + m * 16 + fr; const int b = row / S;
#pragma unroll
                for (int bj = 0; bj < 2; ++bj)
#pragma unroll
                    for (int n = 0; n < 2; ++n) { const int col = u.pn * 256 + bj * 128 + wc * 32 + n * 16 + 4 * fq;
                        const f32x4 g = *(const f32x4*)(ada + b * 6144 + gt_off + col);
                        const f32x4 x = *(const f32x4*)(X + (size_t)row * D + col);
                        *(f32x4*)(out + (size_t)row * D + col) = x + g * acc[ai][bj][m][n]; } }
    }
};
struct PgRgu {
    static constexpr bool PERM = false, AFTER_DRAIN = false;
    float* logits; bf16_t* act;
    __device__ __forceinline__ void operator()(const f32x4 (&acc)[2][2][4][2], const pg8::Unit& u, int wr, int wc, int fr, int fq) const {
#pragma unroll
        for (int ai = 0; ai < 2; ++ai)
#pragma unroll
            for (int m = 0; m < 4; ++m) { const int row = u.pm * 256 + ai * 128 + wr * 64 + m * 16 + fr;
#pragma unroll
                for (int bj = 0; bj < 2; ++bj) {
                    if (u.pn == 0) {
#pragma unroll
                        for (int n = 0; n < 2; ++n) *(f32x4*)(logits + (size_t)row * 256 + bj * 128 + wc * 32 + n * 16 + 4 * fq) = acc[ai][bj][m][n];
                    } else {
                        const int j = ((u.pn - 1) * 256 + bj * 128 + wc * 32) >> 5;
                        *(u32x2*)(act + (size_t)row * 256 + j * 16 + 4 * fq) = pack_swiglu(acc[ai][bj][m][0], acc[ai][bj][m][1]);
                    }
                } }
    }
};

__device__ __forceinline__ int xcd_remap(int L, int nwg) { const int q = nwg >> 3, r = nwg & 7, x = L & 7, off = L >> 3; return (x < r ? x * (q + 1) : r * (q + 1) + (x - r) * q) + off; }
__global__ void __launch_bounds__(NT, 2) fwd_kernel(Params p) {
    extern __shared__ __attribute__((aligned(16))) unsigned char lds_raw[];
    LAS unsigned char* lds = (LAS unsigned char*)lds_raw;
    const int G = gridDim.x, bid = blockIdx.x, ngw = G * NWAVES;
#define FRESH_IDS() const int tid = fresh_tid(), lane = tid & 63, wid = tid >> 6, gw = bid * NWAVES + wid; (void)lane; (void)gw
    { const int tid = fresh_tid(); volatile LAS unsigned* bst0 = (volatile LAS unsigned*)(lds + LDS_BYTES - 64); if (tid < 2) bst0[tid] = 0u; }
    unsigned char* ws = p.ws;
    const float* ada = (const float*)(ws + WS_ADA);
    volatile LAS unsigned* bst = (volatile LAS unsigned*)(lds + LDS_BYTES - 64);
    __syncthreads();
    const XcdBarrier xbar = xcd_barrier_post((unsigned*)(ws + WS_CTL + 4096), bst);
    int ts_n = 0;
#if DBG_STAGE == 2
#define TSTAMP() do { if (bid == 0 && threadIdx.x == 0) ((unsigned long long*)(ws + WS_CTL + 16384 + 8192))[ts_n] = __builtin_amdgcn_s_memrealtime(); ++ts_n; } while (0)
#else
#define TSTAMP() do { } while (0)
#endif
    TSTAMP();

    {
        FRESH_IDS();
        const bool split = G > 128;
        if (!split || bid < 96) for (int u = bid; u < 96; u += G) ada_unit(p, lds, u, tid);
        if (!split || bid >= 96) {
            LAS float* scr = (LAS float*)(lds + wid * 8448);
            const int cg0 = split ? (bid - 96) * NWAVES + wid : gw, cgn = split ? (G - 96) * NWAVES : ngw;
            constexpr int I0 = 16 * 70, I1 = I0 + 6 * 24, I2 = I1 + 4 * 32, I3 = I2 + 32, I4 = I3 + 32, I5 = I4 + 16 * 32, I6 = I5 + 16 * 8, I7 = I6 + 16 * 8, I8 = I7 + 16 * 8, I9 = I8 + 4 * 32;
            for (int it = cg0; it < I9; it += cgn) {
                if (it < I0) conv_item<0>(p.in[6], 1024, IN_DIM, (bf16_t*)(ws + WS_WIN), 0, 0, scr, it, lane);
                else if (it < I1) conv_item<0>(p.in[8], QLORA, 768, (bf16_t*)(ws + WS_WUQ), 0, 0, scr, it - I0, lane);
                else if (it < I2) conv_item<0>(p.in[10], KVLORA, 1024, (bf16_t*)(ws + WS_WUKV), 0, 0, scr, it - I1, lane);
                else if (it < I3) conv_item<0>(p.in[16], 128, 128, (bf16_t*)(ws + WS_WMQK), 256 * 128, 0, scr, it - I2, lane);
                else if (it < I4) conv_item<0>(p.in[17], 128, 128, (bf16_t*)(ws + WS_WMQK), 256 * 128, 128, scr, it - I3, lane);
                else if (it < I5) conv_item<0>(p.in[21], 1024, 1024, (bf16_t*)(ws + WS_WOUT), 0, 0, scr, it - I4, lane);
                else if (it < I6) conv_item<0>(p.in[23], 1024, 256, (bf16_t*)(ws + WS_WRGU), 0, 0, scr, it - I5, lane);
                else if (it < I7) conv_item<1>(p.in[28], 1024, 256, (bf16_t*)(ws + WS_WRGU), 0, 256, scr, it - I6, lane);
                else if (it < I8) conv_item<2>(p.in[29], 1024, 256, (bf16_t*)(ws + WS_WRGU), 0, 256, scr, it - I7, lane);
                else conv_item<0>(p.in[30], 256, 1024, (bf16_t*)(ws + WS_WDSH), 0, 0, scr, it - I8, lane);
            }
            u32x4* zp = (u32x4*)((bf16_t*)(ws + WS_WIN) + (size_t)IN_DIM * 1024);
            const int zt0 = split ? (bid - 96) * NT + tid : bid * NT + tid, ztn = split ? (G - 96) * NT : G * NT;
            for (int i = zt0; i < (2304 - IN_DIM) * 1024 / 8; i += ztn) zp[i] = (u32x4){0u, 0u, 0u, 0u};
        }
    }
    xcd_barrier(xbar); TSTAMP();
    { FRESH_IDS(); norm_mod_rows(p.in[0], p.in[5], ada, 0, 1024, (bf16_t*)(ws + B_H1), gw, ngw, lane); }
    xcd_barrier(xbar); TSTAMP();
    {
        const pg8::Gemm g{(const bf16_t*)(ws + B_H1), (const bf16_t*)(ws + WS_WIN), T, 2304, 1024, 1024, 1024, 0};
        pg8::StaticOrder SO; SO.init(T, 2304, G, bid);
        const PgProj E{(bf16_t*)(ws + B_PROJ), (float*)(ws + B_GRAW)};
        pg8::gemm_phase<PgProj, pg8::StaticOrder, true, true>(lds, g, SO, E);
    }
    xcd_barrier(xbar); TSTAMP();
    { FRESH_IDS(); post_proj_rows(p, gw, ngw, lane); }
    xcd_barrier(xbar); TSTAMP();
    {
        {   const pg8::Gemm g{(const bf16_t*)(ws + B_CQN), (const bf16_t*)(ws + WS_WUQ), T, 768, QLORA, QLORA, QLORA, 0};
            pg8::StaticOrder SO; SO.init(T, 768, G, bid); const PgBf16 E{(bf16_t*)(ws + B_QRAW), 768};
            pg8::gemm_phase<PgBf16, pg8::StaticOrder, true, true>(lds, g, SO, E); }
        {   const pg8::Gemm g{(const bf16_t*)(ws + B_CKVN), (const bf16_t*)(ws + WS_WUKV), T, 1024, KVLORA, KVLORA, KVLORA, 0};
            pg8::StaticOrder SO; SO.init(T, 1024, G, bid); const PgBf16 E{(bf16_t*)(ws + B_KVRAW), 1024};
            pg8::gemm_phase<PgBf16, pg8::StaticOrder, true, true>(lds, g, SO, E); }
        {   const pg8::Gemm g{(const bf16_t*)(ws + B_ZC), (const bf16_t*)(ws + WS_WMQK), T, 1024, DM, MINNER, DM, DM};
            pg8::StaticOrder SO; SO.init(T, 1024, G, bid); const PgMqk E{(bf16_t*)(ws + B_MQ), (bf16_t*)(ws + B_MK)};
            pg8::gemm_phase<PgMqk, pg8::StaticOrder, true, true>(lds, g, SO, E); }
    }
    xcd_barrier(xbar); TSTAMP();
    { FRESH_IDS(); qk_post_rows(p, gw, ngw, lane); }
    xcd_barrier(xbar); TSTAMP();
    for (int pr = bid; pr < 256; pr += G) { const int bh = pr & 63, j = pr >> 6; attn_unit(p, lds, bh, 7 - j); attn_unit(p, lds, bh, j); }
    for (int u = bid; u < 1024; u += G) mlstm_a_unit(p, lds, u);
    xcd_barrier(xbar); TSTAMP();
    { FRESH_IDS(); mlstm_scan(p, bid * NT + tid, G * NT); }
    { FRESH_IDS(); attn_out_norm_rows(p, gw, ngw, lane); }
    xcd_barrier(xbar); TSTAMP();
    for (int u = bid; u < 1024; u += G) mlstm_c_unit(p, lds, u);
    xcd_barrier(xbar); TSTAMP();
    {
        const pg8::Gemm g{(const bf16_t*)(ws + B_AO), (const bf16_t*)(ws + WS_WOUT), T, 1024, 1024, 1024, 1024, 0};
        pg8::StaticOrder SO; SO.init(T, 1024, G, bid); const PgResid E{p.in[0], ada, 2048, p.out};
        pg8::gemm_phase<PgResid, pg8::StaticOrder, true, true>(lds, g, SO, E);
    }
    xcd_barrier(xbar); TSTAMP();
    { FRESH_IDS(); norm_mod_rows(p.out, p.in[22], ada, 3072, 4096, (bf16_t*)(ws + C_H2), gw, ngw, lane, ws + C_H2F8); }
    xcd_barrier(xbar); TSTAMP();
    {
        const pg8::Gemm g{(const bf16_t*)(ws + C_H2), (const bf16_t*)(ws + WS_WRGU), T, 768, 1024, 1024, 1024, 0};
        pg8::StaticOrder SO; SO.init(T, 768, G, bid); const PgRgu E{(float*)(ws + C_LOGITS), (bf16_t*)(ws + C_ACTSH)};
        pg8::gemm_phase<PgRgu, pg8::StaticOrder, true, true>(lds, g, SO, E);
    }
    xcd_barrier(xbar); TSTAMP();
    { FRESH_IDS(); route_rows(p, gw, ngw, lane); }
    {
        const pg8::Gemm g{(const bf16_t*)(ws + C_ACTSH), (const bf16_t*)(ws + WS_WDSH), T, 1024, 256, 256, 256, 0};
        pg8::StaticOrder SO; SO.init(T, 1024, G, bid); const PgBf16 E{(bf16_t*)(ws + C_SHOUT), 1024};
        pg8::gemm_phase<PgBf16, pg8::StaticOrder, true, true>(lds, g, SO, E);
    }
    xcd_barrier(xbar); TSTAMP();
    LAS int* base = (LAS int*)(lds + 132 * 1024);
    LAS int* tsx = base + 256;
    const int ngrp = (G % 8 == 0) ? 8 : 1, gx = bid % ngrp, gidx = bid / ngrp, gper = G / ngrp, nexp = NE / ngrp;
    { FRESH_IDS(); expert_prefix(p, base, tsx, tid, gx, ngrp); }
    {
        const int* cnt = (const int*)(ws + WS_CNT);
        const int ntile = tsx[nexp];
        for (int u = gidx; u < ntile * 4; u += gper) {
            const int tg = u >> 2, tn = u & 3;
            int lo = 0, hi = nexp - 1;
            while (lo < hi) { const int mid = (lo + hi + 1) >> 1; if (tsx[mid] <= tg) lo = mid; else hi = mid - 1; }
            const int e = gx + ngrp * lo, blk = tg - tsx[lo], c = __hip_atomic_load(cnt + e * CNT_STRIDE, __ATOMIC_RELAXED, __HIP_MEMORY_SCOPE_AGENT);
            const int nvalid = min(256, c - blk * 256);
            const RowGather RP{(const unsigned char*)(ws + C_H2F8), (const int*)(ws + C_LISTTOK) + (size_t)e * CAP + blk * 256, nvalid};
            const ColGU CP{p.in[25] + (size_t)e * 1024 * 256, p.in[26] - p.in[25]};
            const EpiExpAct E{(unsigned char*)(ws + C_ACTE), base[e] + blk * 256, nvalid};
            gemm2_tile(lds, RP, CP, 256, 1024, 0, tn * 128, E, nvalid);
        }
    }
    xcd_barrier(xbar); TSTAMP();
    {
        const int* cnt = (const int*)(ws + WS_CNT);
        const int ntile = tsx[nexp];
        for (int u = gidx; u < ntile * 8; u += gper) {
            const int tg = u >> 3, tn = u & 7;
            int lo = 0, hi = nexp - 1;
            while (lo < hi) { const int mid = (lo + hi + 1) >> 1; if (tsx[mid] <= tg) lo = mid; else hi = mid - 1; }
            const int e = gx + ngrp * lo, blk = tg - tsx[lo], c = __hip_atomic_load(cnt + e * CNT_STRIDE, __ATOMIC_RELAXED, __HIP_MEMORY_SCOPE_AGENT);
            const int nvalid = min(256, c - blk * 256);
            const int slot0 = base[e] + blk * 256;
            const RowSlots RP{(const unsigned char*)(ws + C_ACTE) + (size_t)slot0 * EDIM, nvalid};
            const ColDense CP{p.in[27] + (size_t)e * 256 * 1024, 1024};
            const EpiExpDown E{(unsigned char*)(ws + C_Y), (const float*)(ws + C_LISTW) + (size_t)e * CAP + blk * 256, slot0, nvalid};
            gemm2_tile(lds, RP, CP, 1024, 256, 0, tn * 128, E, nvalid);
        }
    }
    xcd_barrier(xbar); TSTAMP();
    { FRESH_IDS(); combine_rows(p, base, gw, ngw, lane); }
#if DBG_STAGE == 2
    xcd_barrier(xbar); TSTAMP();
    xcd_barrier(xbar);
    {   FRESH_IDS();
        const unsigned long long* ts = (const unsigned long long*)(ws + WS_CTL + 16384 + 8192);
        const float tus = (float)(long long)(ts[TS_A1] - ts[TS_A0]) * 0.01f;
        const float cadd = sqrtf(2.5e-3f * tus * (1.f / 500.f));
        for (size_t i = (size_t)bid * NT + tid; i < (size_t)T * D / 4; i += (size_t)G * NT) { f32x4 v = ((f32x4*)p.out)[i]; v = v + cadd; ((f32x4*)p.out)[i] = v; }
    }
#endif
}

extern "C" void kernel_launch(void* const* d_in, const int* in_sizes, int n_in,
                              void* d_out, int out_size, void* d_ws, size_t ws_size,
                              hipStream_t stream) {
    static int grid_blocks = 0;
    if (!grid_blocks) {
        if (n_in != 31 || out_size != T * D || ws_size < WS_END) { fprintf(stderr, "kernel_launch: unexpected shapes n_in=%d out=%d ws=%zu (need %zu)\n", n_in, out_size, ws_size, (size_t)WS_END); grid_blocks = -1; return; }
        int dev = 0, cus = 0, per_cu = 0;
        (void)hipGetDevice(&dev);
        (void)hipDeviceGetAttribute(&cus, hipDeviceAttributeMultiprocessorCount, dev);
        (void)hipFuncSetAttribute((const void*)fwd_kernel, hipFuncAttributeMaxDynamicSharedMemorySize, LDS_BYTES);
        (void)hipOccupancyMaxActiveBlocksPerMultiprocessor(&per_cu, (const void*)fwd_kernel, NT, LDS_BYTES);
        if (per_cu < 1) per_cu = 1;
        grid_blocks = cus * per_cu;
        fprintf(stderr, "kernel_launch: cus=%d per_cu=%d grid=%d ws=%zu\n", cus, per_cu, grid_blocks, ws_size);
    }
    if (grid_blocks < 0) return;
    (void)hipMemsetAsync((char*)d_ws + WS_CTL, 0, CTL_BYTES, stream);
    Params p{};
    for (int i = 0; i < 31; ++i) p.in[i] = (const float*)d_in[i];
    p.out = (float*)d_out; p.ws = (unsigned char*)d_ws;
    void* args[] = {&p};
    hipError_t e = hipLaunchCooperativeKernel((const void*)fwd_kernel, dim3(grid_blocks), dim3(NT), args, LDS_BYTES, stream);
    if (e != hipSuccess) fprintf(stderr, "cooperative launch failed: %s (grid %d)\n", hipGetErrorString(e), grid_blocks);
}
```

```cpp
#include <hip/hip_runtime.h>
#include <hip/hip_cooperative_groups.h>
#include <cstdio>
#include <cstdint>
namespace cg = cooperative_groups;
#ifndef DBG_STAGE
#define DBG_STAGE 0
#endif
#define TS_A0 2
#define TS_A1 3
#define TS_B0 2
#define TS_B1 3

#define LAS __attribute__((address_space(3)))
typedef unsigned short bf16_t;
typedef short bf16x8 __attribute__((ext_vector_type(8)));
typedef short bf16x4 __attribute__((ext_vector_type(4)));
typedef float f32x4 __attribute__((ext_vector_type(4)));
typedef float f32x2 __attribute__((ext_vector_type(2)));
typedef unsigned u32x4 __attribute__((ext_vector_type(4)));
typedef unsigned u32x2 __attribute__((ext_vector_type(2)));

constexpr int NT = 512, NWAVES = 8;
constexpr int LDS_BYTES = 144 * 1024;
constexpr int Bsz = 8, S = 2048, D = 1024, T = Bsz * S;
constexpr int H_MLA = 8, DQK = 96, DNOPE = 64, DROPE = 32, DV = 64, QLORA = 384, KVLORA = 256;
constexpr int H_ML = 4, DM = 128, MINNER = 512, CHUNK = 64, NCH = S / CHUNK;
constexpr int IN_DIM = 2216;
constexpr int OFF_CQ = 0, OFF_CKV = 384, OFF_KR = 640, OFF_Z = 672, OFF_MV = 1184, OFF_MO = 1696, OFF_GATE = 2208;
constexpr int NE = 256, TOPK = 8, EDIM = 256, SDIM = 256;
constexpr int CAP = T;
constexpr float RMS_EPS = 1e-6f;

constexpr size_t MiB = 1u << 20;
constexpr size_t WS_CTL = 0;
constexpr size_t CTL_BYTES = 65536;
constexpr size_t WS_CNT = 32768;
constexpr int CNT_STRIDE = 32;
constexpr size_t WS_ADA = 1 * MiB;
constexpr size_t WS_BC = 2 * MiB;
constexpr size_t WS_MLOC = WS_BC + 8192;
constexpr size_t WS_MPREV = WS_BC + 16384;
constexpr size_t WS_DN = 2 * MiB + 512 * 1024;
constexpr size_t WS_NPREV = 3 * MiB;
constexpr size_t WS_WIN = 4 * MiB;
constexpr size_t WS_WUQ = 9 * MiB;
constexpr size_t WS_WUKV = 10 * MiB;
constexpr size_t WS_WMQK = 11 * MiB;
constexpr size_t WS_WOUT = 12 * MiB;
constexpr size_t WS_WRGU = 14 * MiB;
constexpr size_t WS_WDSH = 16 * MiB;
constexpr size_t WS_WGU = 32 * MiB;
constexpr size_t WS_WD = 288 * MiB;
constexpr size_t RB = 416 * MiB;
constexpr size_t B_PROJ = RB;
constexpr size_t B_GRAW = RB + 70 * MiB;
constexpr size_t B_GL = RB + 71 * MiB;
constexpr size_t B_H1 = RB + 72 * MiB;
constexpr size_t B_CQN = RB + 104 * MiB;
constexpr size_t B_CKVN = RB + 116 * MiB;
constexpr size_t B_ZC = RB + 124 * MiB;
constexpr size_t B_QRAW = RB + 140 * MiB;
constexpr size_t B_KVRAW = RB + 164 * MiB;
constexpr size_t B_MQ = RB + 196 * MiB;
constexpr size_t B_MK = RB + 212 * MiB;
constexpr size_t B_Q = RB + 228 * MiB;
constexpr size_t B_K = RB + 252 * MiB;
constexpr size_t B_ORAW = RB + 276 * MiB;
constexpr size_t B_AO = RB + 292 * MiB;
constexpr size_t B_DC = RB + 324 * MiB;
constexpr size_t B_CPREV = RB + 388 * MiB;
constexpr size_t C_H2 = RB;
constexpr size_t C_LOGITS = RB + 32 * MiB;
constexpr size_t C_ACTSH = RB + 48 * MiB;
constexpr size_t C_SHOUT = RB + 56 * MiB;
constexpr size_t C_TOKE = RB + 88 * MiB;
constexpr size_t C_TOKW = RB + 89 * MiB;
constexpr size_t C_TOKPOS = RB + 90 * MiB;
constexpr size_t C_LISTTOK = RB + 92 * MiB;
constexpr size_t C_LISTW = RB + 108 * MiB;
constexpr size_t C_ACTE = RB + 124 * MiB;
constexpr size_t C_Y = RB + 188 * MiB;
constexpr size_t C_H2F8 = RB + 320 * MiB;
constexpr size_t WS_END = RB + 444 * MiB;

struct Params {
    const float* in[31];
    float* out;
    unsigned char* ws;
};

typedef __bf16 bf16x2v __attribute__((ext_vector_type(2)));
__device__ __forceinline__ unsigned cvt_pk_bf16(float lo, float hi) { f32x2 v = {lo, hi}; bf16x2v b = __builtin_convertvector(v, bf16x2v); return __builtin_bit_cast(unsigned, b); }
__device__ __forceinline__ unsigned pk4_fp8(float a, float b, float c, float d) { int p = __builtin_amdgcn_cvt_pk_fp8_f32(a, b, 0, false); p = __builtin_amdgcn_cvt_pk_fp8_f32(c, d, p, true); return (unsigned)p; }
__device__ __forceinline__ float bf2f(unsigned short b) { return __uint_as_float((unsigned)b << 16); }
__device__ __forceinline__ float bflo(unsigned u) { return __uint_as_float(u << 16); }
__device__ __forceinline__ float bfhi(unsigned u) { return __uint_as_float(u & 0xffff0000u); }
__device__ __forceinline__ float wave_sum(float v) {
#pragma unroll
    for (int o = 1; o < 64; o <<= 1) v += __shfl_xor(v, o);
    return v;
}
__device__ __forceinline__ float wave_max(float v) {
#pragma unroll
    for (int o = 1; o < 64; o <<= 1) v = fmaxf(v, __shfl_xor(v, o));
    return v;
}
__device__ __forceinline__ float sigmoidf_(float x) { return 1.f / (1.f + __expf(-x)); }
__device__ __forceinline__ float siluf_(float x) { return x / (1.f + __expf(-x)); }
__device__ __forceinline__ int fresh_tid() { int t = threadIdx.x; asm volatile("" : "+v"(t)); return t; }
#define MFMA16(a, b, c) __builtin_amdgcn_mfma_f32_16x16x32_bf16((a), (b), (c), 0, 0, 0)


#define XB_TMO      128
#define XB_XCNT(j)  (256  + 64 * (j))
#define XB_XSUB(j)  (1280 + 64 * (j))
#define XB_XGEN(j)  (2304 + 64 * (j))
#define XB_TOP      3328
#define XB_TOPGEN   3392
#define XCD_BAR_WORDS 3456
#define XB_SPIN_CAP (1u << 23)
__device__ __forceinline__ unsigned xb_ld(unsigned* p)              { return __hip_atomic_load(p, __ATOMIC_RELAXED, __HIP_MEMORY_SCOPE_AGENT); }
__device__ __forceinline__ unsigned xb_add(unsigned* p, unsigned v) { return __hip_atomic_fetch_add(p, v, __ATOMIC_RELAXED, __HIP_MEMORY_SCOPE_AGENT); }
__device__ __forceinline__ unsigned xb_xcc_id() { return (unsigned)__builtin_amdgcn_s_getreg((3 << 11) | 20) & 0xFu; }
#define XB_SPIN(cond, bar) do { unsigned _sp = 0; while (cond) { __builtin_amdgcn_s_sleep(1); \
    if ((++_sp & 255u) == 0u) { if (xb_ld(&(bar)[XB_TMO])) break; if (_sp > XB_SPIN_CAP) { atomicAdd(&(bar)[XB_TMO], 1u); break; } } } } while (0)
struct XcdBarrier { unsigned* bar; unsigned x; volatile LAS unsigned* st; };
__device__ __forceinline__ XcdBarrier xcd_barrier_post(unsigned* bar, volatile LAS unsigned* st) {
    XcdBarrier b; b.bar = bar; b.x = xb_xcc_id(); b.st = st;
    if (threadIdx.x == 0) (void)xb_add(&bar[XB_XCNT(b.x)], 1u);
    return b;
}
__device__ __forceinline__ void xcd_barrier_complete(unsigned* bar, unsigned x, unsigned& nloc, unsigned& nx) {
    const unsigned G = gridDim.x * gridDim.y * gridDim.z;
    unsigned sum, cnt, mine, sp = 0u;
    for (;;) {
        sum = 0u; cnt = 0u; mine = 0u;
#pragma unroll
        for (unsigned j = 0; j < 16; ++j) { const unsigned c = xb_ld(&bar[XB_XCNT(j)]); sum += c; cnt += (c > 0u) ? 1u : 0u; mine = (j == x) ? c : mine; }
        if (sum == G) break;
        __builtin_amdgcn_s_sleep(1);
        if ((++sp & 255u) == 0u) { if (xb_ld(&bar[XB_TMO])) break; if (sp > XB_SPIN_CAP) { atomicAdd(&bar[XB_TMO], 1u); break; } }
    }
    nloc = mine > 0u ? mine : 1u; nx = cnt > 0u ? cnt : 1u;
}
__device__ __forceinline__ void xcd_barrier(const XcdBarrier& b) {
    asm volatile("s_waitcnt vmcnt(0)" ::: "memory");
    __syncthreads();
    if (threadIdx.x == 0) {
        unsigned* bar = b.bar;
        __builtin_amdgcn_s_waitcnt(0);
        unsigned nloc = b.st[0], nx = b.st[1];
        if (nloc == 0u) { xcd_barrier_complete(bar, b.x, nloc, nx); b.st[0] = nloc; b.st[1] = nx; }
        const unsigned old = xb_add(&bar[XB_XSUB(b.x)], 1u);
        const unsigned gen = old / nloc;
        if (old + 1u == (gen + 1u) * nloc) {
            __builtin_amdgcn_fence(__ATOMIC_RELEASE, "agent");
            asm volatile("s_waitcnt vmcnt(0)" ::: "memory");
            const unsigned og = xb_add(&bar[XB_TOP], 1u);
            const unsigned tg = og / nx;
            if (og + 1u == (tg + 1u) * nx) xb_add(&bar[XB_TOPGEN], 1u);
            else XB_SPIN(xb_ld(&bar[XB_TOPGEN]) == tg, bar);
            __builtin_amdgcn_fence(__ATOMIC_ACQUIRE, "agent");
            xb_add(&bar[XB_XGEN(b.x)], 1u);
            asm volatile("s_waitcnt vmcnt(0)" ::: "memory");
        } else {
            XB_SPIN(xb_ld(&bar[XB_XGEN(b.x)]) == gen, bar);
            __builtin_amdgcn_fence(__ATOMIC_ACQUIRE, "agent");
            asm volatile("s_waitcnt vmcnt(0)" ::: "memory");
        }
    }
    __syncthreads();
}

template <int MAP>
__device__ __forceinline__ int map_row(int n) {
    if (MAP == 0) return n;
    if (MAP == 1) return ((n >> 4) << 5) + (n & 15);
    return ((n >> 4) << 5) + 16 + (n & 15);
}
template <int MAP>
__device__ __forceinline__ void conv_item(const float* src, int K, int N, bf16_t* dst, size_t dst_mat_stride, int row_off, LAS float* scr, int it, int lane) {
    const int nblk = (N + 31) / 32, kblk = K / 64, per = nblk * kblk;
    const int mat = it / per, r = it - mat * per, kb = r / nblk, nb = r - kb * nblk, k0 = kb * 64, n0 = nb * 32;
    const float* W = src + (size_t)mat * K * N;
    bf16_t* WT = dst + (size_t)mat * dst_mat_stride;
    const int nn = n0 + (lane & 31);
    const bool nok = nn < N;
    float v[32];
    const float* wp = W + (size_t)(k0 + (lane >> 5)) * N + nn;
#pragma unroll
    for (int i = 0; i < 32; ++i) v[i] = nok ? wp[(size_t)(2 * i) * N] : 0.f;
#pragma unroll
    for (int i = 0; i < 32; ++i) scr[(2 * i + (lane >> 5)) * 33 + (lane & 31)] = v[i];
    asm volatile("s_waitcnt lgkmcnt(0)" ::: "memory");
    const int c = lane & 7;
#pragma unroll
    for (int j = 0; j < 4; ++j) {
        const int n = (lane >> 3) + 8 * j;
        const LAS float* sp = scr + (8 * c) * 33 + n;
        u32x4 o; o.x = cvt_pk_bf16(sp[0 * 33], sp[1 * 33]); o.y = cvt_pk_bf16(sp[2 * 33], sp[3 * 33]); o.z = cvt_pk_bf16(sp[4 * 33], sp[5 * 33]); o.w = cvt_pk_bf16(sp[6 * 33], sp[7 * 33]);
        if (n0 + n < N) *(u32x4*)(WT + (size_t)(row_off + map_row<MAP>(n0 + n)) * K + k0 + 8 * c) = o;
    }
    asm volatile("s_waitcnt lgkmcnt(0)" ::: "memory");
}

__device__ __forceinline__ void ada_unit(const Params& p, LAS unsigned char* lds, int u, int tid) {
    LAS float* cond = (LAS float*)lds;
    LAS float* red = (LAS float*)(lds + 32768);
    const float* c = p.in[1]; const float* w = p.in[3]; const float* bias = p.in[4];
    float* ada = (float*)(p.ws + WS_ADA);
    const int lane = tid & 63, wv = tid >> 6;
    for (int i = tid; i < 8 * 1024; i += NT) cond[i] = siluf_(c[i]);
    __syncthreads();
    float acc[8];
#pragma unroll
    for (int b = 0; b < 8; ++b) acc[b] = 0.f;
    const int col = u * 64 + lane;
#pragma unroll 16
    for (int k = wv * 128; k < wv * 128 + 128; ++k) {
        const float wv_ = w[(size_t)k * 6144 + col];
#pragma unroll
        for (int b = 0; b < 8; ++b) acc[b] += cond[b * 1024 + k] * wv_;
    }
#pragma unroll
    for (int b = 0; b < 8; ++b) red[(wv * 8 + b) * 64 + lane] = acc[b];
    __syncthreads();
    {
        const int b = tid >> 6;
        float s = 0.f;
#pragma unroll
        for (int w2 = 0; w2 < 8; ++w2) s += red[(w2 * 8 + b) * 64 + lane];
        ada[b * 6144 + col] = s + bias[col];
    }
    __syncthreads();
}

__device__ __forceinline__ void norm_mod_rows(const float* X, const float* g, const float* ada, int sh_off, int sc_off, bf16_t* Hout, int gw, int ngw, int lane, unsigned char* H8 = nullptr) {
    f32x4 nx[4];
    if (gw < T) {
#pragma unroll
        for (int j = 0; j < 4; ++j) nx[j] = *((const f32x4*)(X + (size_t)gw * D) + lane + 64 * j);
    }
    for (int row = gw; row < T; row += ngw) {
        const int b = row / S;
        f32x4 v[4]; float ss = 0.f;
#pragma unroll
        for (int j = 0; j < 4; ++j) v[j] = nx[j];
        if (row + ngw < T) {
#pragma unroll
            for (int j = 0; j < 4; ++j) nx[j] = *((const f32x4*)(X + (size_t)(row + ngw) * D) + lane + 64 * j);
        }
        f32x4 gg[4], sc[4], sh[4];
#pragma unroll
        for (int j = 0; j < 4; ++j) { const int k = 4 * (lane + 64 * j);
            gg[j] = *(const f32x4*)(g + k); sc[j] = *(const f32x4*)(ada + b * 6144 + sc_off + k); sh[j] = *(const f32x4*)(ada + b * 6144 + sh_off + k); }
#pragma unroll
        for (int j = 0; j < 4; ++j) ss += v[j].x * v[j].x + v[j].y * v[j].y + v[j].z * v[j].z + v[j].w * v[j].w;
        const float rinv = rsqrtf(wave_sum(ss) * (1.f / D) + RMS_EPS);
        u32x2* o = (u32x2*)(Hout + (size_t)row * D) + lane;
#pragma unroll
        for (int j = 0; j < 4; ++j) {
            const f32x4 h = v[j] * rinv * gg[j] * (1.f + sc[j]) + sh[j];
            u32x2 w; w.x = cvt_pk_bf16(h.x, h.y); w.y = cvt_pk_bf16(h.z, h.w);
            o[64 * j] = w;
            if (H8) *((unsigned*)(H8 + (size_t)row * D) + lane + 64 * j) = pk4_fp8(h.x, h.y, h.z, h.w);
        }
    }
}

__device__ __forceinline__ void post_proj_rows(const Params& p, int gw, int ngw, int lane) {
    const bf16_t* proj = (const bf16_t*)(p.ws + B_PROJ);
    const float* graw = (const float*)(p.ws + B_GRAW);
    float* gl = (float*)(p.ws + B_GL);
    bf16_t* cqn = (bf16_t*)(p.ws + B_CQN); bf16_t* ckvn = (bf16_t*)(p.ws + B_CKVN); bf16_t* zc = (bf16_t*)(p.ws + B_ZC);
    const float* g_cq = p.in[7]; const float* g_ckv = p.in[9]; const float* conv_w = p.in[14]; const float* conv_b = p.in[15];
    const float* b_i = p.in[18]; const float* b_f = p.in[19];
    for (int row = gw; row < T; row += ngw) {
        const bf16_t* pr = proj + (size_t)row * IN_DIM;
        const int s = row % S;
        {
            const unsigned* q = (const unsigned*)(pr + OFF_CQ) + lane * 3;
            unsigned a0 = q[0], a1 = q[1], a2 = q[2];
            float f[6] = {bflo(a0), bfhi(a0), bflo(a1), bfhi(a1), bflo(a2), bfhi(a2)};
            float ss = 0.f;
#pragma unroll
            for (int j = 0; j < 6; ++j) ss += f[j] * f[j];
            const float rinv = rsqrtf(wave_sum(ss) * (1.f / QLORA) + RMS_EPS);
            const float* gq = g_cq + lane * 6;
            unsigned* o = (unsigned*)(cqn + (size_t)row * QLORA) + lane * 3;
            o[0] = cvt_pk_bf16(f[0] * rinv * gq[0], f[1] * rinv * gq[1]);
            o[1] = cvt_pk_bf16(f[2] * rinv * gq[2], f[3] * rinv * gq[3]);
            o[2] = cvt_pk_bf16(f[4] * rinv * gq[4], f[5] * rinv * gq[5]);
        }
        {
            const u32x2 a = *((const u32x2*)(pr + OFF_CKV) + lane);
            float f[4] = {bflo(a.x), bfhi(a.x), bflo(a.y), bfhi(a.y)};
            float ss = f[0] * f[0] + f[1] * f[1] + f[2] * f[2] + f[3] * f[3];
            const float rinv = rsqrtf(wave_sum(ss) * (1.f / KVLORA) + RMS_EPS);
            const float* gk = g_ckv + lane * 4;
            u32x2 w; w.x = cvt_pk_bf16(f[0] * rinv * gk[0], f[1] * rinv * gk[1]); w.y = cvt_pk_bf16(f[2] * rinv * gk[2], f[3] * rinv * gk[3]);
            *((u32x2*)(ckvn + (size_t)row * KVLORA) + lane) = w;
        }
        {
            const int c0 = lane * 8;
            float acc[8];
#pragma unroll
            for (int j = 0; j < 8; ++j) acc[j] = conv_b[c0 + j];
#pragma unroll
            for (int tap = 0; tap < 4; ++tap) {
                const int ds = tap - 3;
                if (s + ds >= 0) {
                    const u32x4 z = *(const u32x4*)(pr + (ptrdiff_t)ds * IN_DIM + OFF_Z + c0);
                    const float* cw = conv_w + tap * MINNER + c0;
                    acc[0] += bflo(z.x) * cw[0]; acc[1] += bfhi(z.x) * cw[1]; acc[2] += bflo(z.y) * cw[2]; acc[3] += bfhi(z.y) * cw[3];
                    acc[4] += bflo(z.z) * cw[4]; acc[5] += bfhi(z.z) * cw[5]; acc[6] += bflo(z.w) * cw[6]; acc[7] += bfhi(z.w) * cw[7];
                }
            }
            u32x4 o; o.x = cvt_pk_bf16(siluf_(acc[0]), siluf_(acc[1])); o.y = cvt_pk_bf16(siluf_(acc[2]), siluf_(acc[3]));
            o.z = cvt_pk_bf16(siluf_(acc[4]), siluf_(acc[5])); o.w = cvt_pk_bf16(siluf_(acc[6]), siluf_(acc[7]));
            *(u32x4*)(zc + (size_t)row * MINNER + c0) = o;
        }
        if (lane < 8) {
            const float gr = graw[(size_t)row * 8 + lane];
            float o;
            if (lane < 4) o = gr + b_i[lane];
            else { const float xx = gr + b_f[lane - 4]; o = fminf(xx, 0.f) - log1pf(__expf(-fabsf(xx))); }
            gl[(size_t)row * 8 + lane] = o;
        }
    }
}

__device__ __forceinline__ void qk_post_rows(const Params& p, int gw, int ngw, int lane) {
    const bf16_t* qraw = (const bf16_t*)(p.ws + B_QRAW); const bf16_t* kvraw = (const bf16_t*)(p.ws + B_KVRAW);
    const bf16_t* proj = (const bf16_t*)(p.ws + B_PROJ);
    bf16_t* Q = (bf16_t*)(p.ws + B_Q); bf16_t* Kb = (bf16_t*)(p.ws + B_K);
    const int* positions = (const int*)p.in[2];
    const float* g_qn = p.in[11]; const float* g_kn = p.in[12];
    const float qscale = 0.10206207261596575f * 1.4426950408889634f;
    const int l = lane & 31, hsel = lane >> 5, i = l & 15;
    const float inv_freq = exp2f(-(float)(2 * i) * (13.287712379549449f / 32.f));
    const float gq0 = g_qn[l], gq1 = g_qn[l + 32], gq2 = g_qn[l + 64], gk0 = g_kn[l], gk1 = g_kn[l + 32], gk2 = g_kn[l + 64];
    for (int row = gw; row < T; row += ngw) {
        const int b = row / S, s = row % S;
        float qv[4][3], kv[4][2];
#pragma unroll
        for (int hp = 0; hp < 4; ++hp) {
            const int h = hp * 2 + hsel;
            const bf16_t* qr = qraw + (size_t)row * 768 + h * 96; const bf16_t* kr = kvraw + (size_t)row * 1024 + h * 128;
            qv[hp][0] = bf2f(qr[l]); qv[hp][1] = bf2f(qr[l + 32]); qv[hp][2] = bf2f(qr[l + 64]);
            kv[hp][0] = bf2f(kr[l]); kv[hp][1] = bf2f(kr[l + 32]);
        }
        const float krope = bf2f(proj[(size_t)row * IN_DIM + OFF_KR + l]);
        const float ang = (float)positions[row] * inv_freq;
        float sn, cs; sincosf(ang, &sn, &cs);
#pragma unroll
        for (int hp = 0; hp < 4; ++hp) {
            const int h = hp * 2 + hsel;
            {
                float v0 = qv[hp][0], v1 = qv[hp][1], v2 = qv[hp][2];
                float ss = v0 * v0 + v1 * v1 + v2 * v2;
#pragma unroll
                for (int o = 1; o < 32; o <<= 1) ss += __shfl_xor(ss, o);
                const float rinv = rsqrtf(ss * (1.f / 96.f) + RMS_EPS);
                v0 *= rinv * gq0; v1 *= rinv * gq1; v2 *= rinv * gq2;
                const float other = __shfl_xor(v2, 16);
                const float r = (l < 16) ? (v2 * cs - other * sn) : (other * sn + v2 * cs);
                bf16_t* qo = Q + ((size_t)(b * H_MLA + h) * S + s) * 96;
                qo[l] = (bf16_t)(cvt_pk_bf16(v0 * qscale, 0.f) & 0xffff);
                qo[l + 32] = (bf16_t)(cvt_pk_bf16(v1 * qscale, 0.f) & 0xffff);
                qo[l + 64] = (bf16_t)(cvt_pk_bf16(r * qscale, 0.f) & 0xffff);
            }
            {
                float v0 = kv[hp][0], v1 = kv[hp][1], v2 = krope;
                float ss = v0 * v0 + v1 * v1 + v2 * v2;
#pragma unroll
                for (int o = 1; o < 32; o <<= 1) ss += __shfl_xor(ss, o);
                const float rinv = rsqrtf(ss * (1.f / 96.f) + RMS_EPS);
                v0 *= rinv * gk0; v1 *= rinv * gk1; v2 *= rinv * gk2;
                const float other = __shfl_xor(v2, 16);
                const float r = (l < 16) ? (v2 * cs - other * sn) : (other * sn + v2 * cs);
                bf16_t* ko = Kb + ((size_t)(b * H_MLA + h) * S + s) * 96;
                ko[l] = (bf16_t)(cvt_pk_bf16(v0, 0.f) & 0xffff);
                ko[l + 32] = (bf16_t)(cvt_pk_bf16(v1, 0.f) & 0xffff);
                ko[l + 64] = (bf16_t)(cvt_pk_bf16(r, 0.f) & 0xffff);
            }
        }
    }
}

__device__ __forceinline__ void attn_out_norm_rows(const Params& p, int gw, int ngw, int lane) {
    const bf16_t* oraw = (const bf16_t*)(p.ws + B_ORAW); bf16_t* ao = (bf16_t*)(p.ws + B_AO); const float* g = p.in[13];
    for (int row = gw; row < T; row += ngw) {
        const u32x4 a = *((const u32x4*)(oraw + (size_t)row * 512) + lane);
        float f[8] = {bflo(a.x), bfhi(a.x), bflo(a.y), bfhi(a.y), bflo(a.z), bfhi(a.z), bflo(a.w), bfhi(a.w)};
        float ss = 0.f;
#pragma unroll
        for (int j = 0; j < 8; ++j) ss += f[j] * f[j];
        const float rinv = rsqrtf(wave_sum(ss) * (1.f / 512.f) + RMS_EPS);
        const float* gg = g + lane * 8;
        u32x4 o; o.x = cvt_pk_bf16(f[0] * rinv * gg[0], f[1] * rinv * gg[1]); o.y = cvt_pk_bf16(f[2] * rinv * gg[2], f[3] * rinv * gg[3]);
        o.z = cvt_pk_bf16(f[4] * rinv * gg[4], f[5] * rinv * gg[5]); o.w = cvt_pk_bf16(f[6] * rinv * gg[6], f[7] * rinv * gg[7]);
        *((u32x4*)(ao + (size_t)row * 1024) + lane) = o;
    }
}

namespace pg8 {
#define PG8_LAS __attribute__((address_space(3)))
typedef unsigned short bf16_t;
typedef short bf16x8 __attribute__((ext_vector_type(8)));
typedef float f32x4 __attribute__((ext_vector_type(4)));
typedef unsigned u32x4 __attribute__((ext_vector_type(4)));
constexpr int BM = 256, BK = 64, HALF = 128, HTB = HALF * BK * 2  , STAGE_BYTES = 8 * HTB, NXCD = 8, WGM = 8;

__host__ __device__ __forceinline__ int lds_byte(int r, int c) { const int st = (r >> 4) * 2 + (c >> 5), rr = r & 15, cc = c & 31, ob = rr * 64 + cc * 2; return st * 1024 + (ob ^ (((ob >> 9) & 1) << 5)); }
__host__ __device__ __forceinline__ void stage_rc(int b, int& R, int& C) { const int st = b / 1024, sb = b % 1024, swz = sb ^ (((sb >> 9) & 1) << 5); R = (st >> 1) * 16 + swz / 64; C = (st & 1) * 32 + (swz % 64) / 2; }
__host__ __device__ __forceinline__ int perm32(int rho) { const int n = rho >> 4, i = rho & 15; return 8 * (i >> 2) + 4 * n + (i & 3); }

struct Unit { int pm, pn; };
struct Gemm { const bf16_t* A; const bf16_t* Bt; int M, N, K, lda, ldb, apn; };

struct StaticOrder {
    int nM, nN, nwg, G, c;
    __host__ __device__ void init(int M, int N, int G_, int c_) { nM = M / BM; nN = N / BM; nwg = nM * nN; G = G_; c = c_; }
    __host__ __device__ bool next(int i, Unit& u) const {
        const long L = (long)i * G + c; if (L >= nwg) return false;
        int wgid = (int)L; { const int q = nwg / NXCD, r = nwg % NXCD, xcd = wgid % NXCD, off = wgid / NXCD; wgid = (xcd < r ? xcd * (q + 1) : r * (q + 1) + (xcd - r) * q) + off; }
        const int nig = WGM * nN, gid = wgid / nig, fm = gid * WGM, gsz = (nM - fm) < WGM ? (nM - fm) : WGM;
        u.pm = fm + ((wgid % nig) % gsz); u.pn = (wgid % nig) / gsz; return true;
    }
    __device__ __forceinline__ void a_ready(const Unit&) const {}
    __device__ __forceinline__ void done(const Unit&) const {}
};


template <class Epi, class Sched, bool ALIGN_EPI = false, bool SP2 = false>
__device__ __forceinline__ void gemm_phase(PG8_LAS unsigned char* lds, const Gemm g, const Sched& S, const Epi& E) {
    const int tid = fresh_tid(), wid = __builtin_amdgcn_readfirstlane(tid >> 6), lane = tid & 63, wr = wid >> 2, wc = wid & 3, fr = lane & 15, fq = lane >> 4;
    const int K = g.K, nt = K / BK;
    unsigned voffA[2], voffB[2];
#pragma unroll
    for (int i = 0; i < 2; ++i) { int R, C; stage_rc(tid * 16 + i * 8192, R, C); const int Rb = Epi::PERM ? ((R & ~31) + perm32(R & 31)) : R;
        voffA[i] = (unsigned)(R * g.lda + C) * 2u; voffB[i] = (unsigned)(Rb * g.ldb + C) * 2u; }
    const size_t kstep = (size_t)(BK * 2);
    const size_t hstepA = (size_t)HALF * g.lda * 2, hstepB = (size_t)HALF * g.ldb * 2;
    const size_t tstepA = 2 * hstepA, tstepB = 2 * hstepB;
    const unsigned ldsw = (unsigned)wid * 1024u;
    const int aoff = lds_byte(wr * 64 + fr, fq * 8), boff = lds_byte(wc * 32 + fr, fq * 8);
#define PG8_SA(b, h) (((b) * 2 + (h)) * HTB)
#define PG8_SB(b, h) ((4 + (b) * 2 + (h)) * HTB)
#define PG8_STAGE(bufoff, gbase, voff) do { _Pragma("unroll") for (int _i = 0; _i < 2; ++_i) \
        __builtin_amdgcn_global_load_lds((const unsigned*)((const char*)(gbase) + (voff)[_i]), (PG8_LAS unsigned*)(lds + (bufoff) + ldsw + _i * 8192), 16, 0, 0); } while (0)
#define PG8_LDA(dst, b, h) do { _Pragma("unroll") for (int m = 0; m < 4; ++m) _Pragma("unroll") for (int k = 0; k < 2; ++k) dst[m][k] = *(const PG8_LAS bf16x8*)(lds + PG8_SA(b, h) + aoff + m * 2048 + k * 1024); } while (0)
#define PG8_LDB(dst, b, h) do { _Pragma("unroll") for (int n = 0; n < 2; ++n) _Pragma("unroll") for (int k = 0; k < 2; ++k) dst[n][k] = *(const PG8_LAS bf16x8*)(lds + PG8_SB(b, h) + boff + n * 2048 + k * 1024); } while (0)
#define PG8_MMA(ai, bj, At, Bt) do { __builtin_amdgcn_s_setprio(1); _Pragma("unroll") for (int m = 0; m < 4; ++m) _Pragma("unroll") for (int n = 0; n < 2; ++n) _Pragma("unroll") for (int k = 0; k < 2; ++k) \
        acc[ai][bj][m][n] = __builtin_amdgcn_mfma_f32_16x16x32_bf16(Bt[n][k], At[m][k], acc[ai][bj][m][n], 0, 0, 0); __builtin_amdgcn_s_setprio(0); } while (0)
#define PG8_WAIT_V(n) asm volatile("s_waitcnt vmcnt(" #n ")" ::: "memory")
#define PG8_WAIT_L(n) asm volatile("s_waitcnt lgkmcnt(" #n ")" ::: "memory")
#define PG8_BAR __builtin_amdgcn_s_barrier()
#define PG8_SCHED __builtin_amdgcn_sched_barrier(0)
    Unit cur, nxt; int ui = 0;
    if (!S.next(0, cur)) return;
    f32x4 acc[2][2][4][2];
#pragma unroll
    for (int a = 0; a < 2; ++a)
#pragma unroll
        for (int b = 0; b < 2; ++b)
#pragma unroll
            for (int m = 0; m < 4; ++m)
#pragma unroll
                for (int n = 0; n < 2; ++n) acc[a][b][m][n] = (f32x4){0.f, 0.f, 0.f, 0.f};
    bf16x8 At[4][2], B0[2][2], B1[2][2];
    const char* cA = (const char*)g.A + (size_t)cur.pm * tstepA + (size_t)cur.pn * g.apn * 2; const char* cB = (const char*)g.Bt + (size_t)cur.pn * tstepB;
    S.a_ready(cur);
    if constexpr (SP2) {
        PG8_STAGE(PG8_SB(0, 0), cB, voffB); PG8_STAGE(PG8_SB(0, 1), cB + hstepB, voffB); PG8_STAGE(PG8_SA(0, 0), cA, voffA); PG8_STAGE(PG8_SA(0, 1), cA + hstepA, voffA);
        if (wr == 1) PG8_BAR;
        PG8_WAIT_V(2); PG8_BAR;
        PG8_STAGE(PG8_SB(1, 0), cB + kstep, voffB); PG8_STAGE(PG8_SA(1, 0), cA + kstep, voffA); PG8_STAGE(PG8_SB(1, 1), cB + hstepB + kstep, voffB);
        PG8_WAIT_V(6); PG8_BAR;
    } else {
        PG8_STAGE(PG8_SB(0, 0), cB, voffB); PG8_STAGE(PG8_SA(0, 0), cA, voffA); PG8_STAGE(PG8_SB(0, 1), cB + hstepB, voffB); PG8_STAGE(PG8_SA(0, 1), cA + hstepA, voffA);
        if (wr == 1) PG8_BAR;
        PG8_WAIT_V(4); PG8_BAR;
        PG8_STAGE(PG8_SB(1, 0), cB + kstep, voffB); PG8_STAGE(PG8_SA(1, 0), cA + kstep, voffA); PG8_STAGE(PG8_SB(1, 1), cB + hstepB + kstep, voffB);
        PG8_WAIT_V(6); PG8_BAR;
    }
    for (;;) {
        const bool has_next = S.next(ui + 1, nxt);
        const char* nA = has_next ? (const char*)g.A + (size_t)nxt.pm * tstepA + (size_t)nxt.pn * g.apn * 2 : cA; const char* nB = has_next ? (const char*)g.Bt + (size_t)nxt.pn * tstepB : cB;
        for (int t = 0; t < nt; t += 2) {
            const bool last = (t == nt - 2);
            const char* a1 = cA + (size_t)(t + 1) * kstep;
            const char* a2 = last ? nA : cA + (size_t)(t + 2) * kstep; const char* b2 = last ? nB : cB + (size_t)(t + 2) * kstep;
            const char* a3 = a2 + kstep; const char* b3 = b2 + kstep;
            if (last && has_next) S.a_ready(nxt);
            if constexpr (SP2) {
            PG8_LDB(B0, 0, 0); PG8_LDB(B1, 0, 1); PG8_SCHED; PG8_LDA(At, 0, 0); PG8_STAGE(PG8_SA(1, 1), a1 + hstepA, voffA);
            PG8_WAIT_V(8); PG8_WAIT_L(0); PG8_BAR; PG8_MMA(0, 0, At, B0); PG8_MMA(0, 1, At, B1); PG8_BAR; PG8_SCHED;
            PG8_LDA(At, 0, 1); PG8_STAGE(PG8_SB(0, 0), b2, voffB); PG8_STAGE(PG8_SB(0, 1), b2 + hstepB, voffB); PG8_STAGE(PG8_SA(0, 0), a2, voffA);
            PG8_WAIT_V(8); PG8_WAIT_L(0); PG8_BAR; PG8_MMA(1, 0, At, B0); PG8_MMA(1, 1, At, B1); PG8_BAR; PG8_SCHED;
            PG8_LDB(B0, 1, 0); PG8_LDB(B1, 1, 1); PG8_SCHED; PG8_LDA(At, 1, 0); PG8_STAGE(PG8_SA(0, 1), a2 + hstepA, voffA);
            PG8_WAIT_V(8); PG8_WAIT_L(0); PG8_BAR; PG8_MMA(0, 0, At, B0); PG8_MMA(0, 1, At, B1); PG8_BAR; PG8_SCHED;
            PG8_LDA(At, 1, 1); PG8_STAGE(PG8_SB(1, 0), b3, voffB); PG8_STAGE(PG8_SB(1, 1), b3 + hstepB, voffB); PG8_STAGE(PG8_SA(1, 0), a3, voffA);
            PG8_WAIT_V(8); PG8_WAIT_L(0); PG8_BAR; PG8_MMA(1, 0, At, B0); PG8_MMA(1, 1, At, B1); PG8_BAR; PG8_SCHED;
            } else {
            PG8_LDB(B0, 0, 0); PG8_SCHED; PG8_LDA(At, 0, 0); PG8_STAGE(PG8_SA(1, 1), a1 + hstepA, voffA);
            PG8_WAIT_L(8); PG8_BAR; PG8_WAIT_L(0); PG8_MMA(0, 0, At, B0); PG8_BAR; PG8_SCHED;
            PG8_LDB(B1, 0, 1); PG8_STAGE(PG8_SB(0, 0), b2, voffB);
            PG8_BAR; PG8_WAIT_L(0); PG8_MMA(0, 1, At, B1); PG8_BAR;
            PG8_LDA(At, 0, 1); PG8_STAGE(PG8_SA(0, 0), a2, voffA);
            PG8_BAR; PG8_WAIT_L(0); PG8_MMA(1, 0, At, B0); PG8_BAR; PG8_SCHED;
            PG8_STAGE(PG8_SB(0, 1), b2 + hstepB, voffB);
            PG8_WAIT_V(6); PG8_BAR; PG8_MMA(1, 1, At, B1); PG8_BAR;
            PG8_LDB(B0, 1, 0); PG8_SCHED; PG8_LDA(At, 1, 0); PG8_STAGE(PG8_SA(0, 1), a2 + hstepA, voffA);
            PG8_WAIT_L(8); PG8_BAR; PG8_WAIT_L(0); PG8_MMA(0, 0, At, B0); PG8_BAR; PG8_SCHED;
            PG8_LDB(B1, 1, 1); PG8_STAGE(PG8_SB(1, 0), b3, voffB);
            PG8_BAR; PG8_WAIT_L(0); PG8_MMA(0, 1, At, B1); PG8_BAR;
            PG8_LDA(At, 1, 1); PG8_STAGE(PG8_SA(1, 0), a3, voffA);
            PG8_BAR; PG8_WAIT_L(0); PG8_MMA(1, 0, At, B0); PG8_BAR; PG8_SCHED;
            PG8_STAGE(PG8_SB(1, 1), b3 + hstepB, voffB);
            PG8_WAIT_V(6); PG8_BAR; PG8_MMA(1, 1, At, B1); PG8_BAR;
            }
        }
        if constexpr (ALIGN_EPI) { if (wr == 0) PG8_BAR; }
        if constexpr (!Epi::AFTER_DRAIN) { E(acc, cur, wr, wc, fr, fq); S.done(cur); }
        if (!has_next) break;
#pragma unroll
        for (int a = 0; a < 2; ++a)
#pragma unroll
            for (int b = 0; b < 2; ++b)
#pragma unroll
                for (int m = 0; m < 4; ++m)
#pragma unroll
                    for (int n = 0; n < 2; ++n) acc[a][b][m][n] = (f32x4){0.f, 0.f, 0.f, 0.f};
        cur = nxt; cA = nA; cB = nB; ++ui;
        if constexpr (ALIGN_EPI) { if (wr == 1) PG8_BAR; }
    }
    PG8_WAIT_V(0);
    if constexpr (!ALIGN_EPI) { if (wr == 0) PG8_BAR; }
    PG8_BAR;
    if constexpr (Epi::AFTER_DRAIN) { E.fused(acc, cur, wr, wc, fr, fq, lds, wid, lane); S.done(cur); }
#undef PG8_SA
#undef PG8_SB
#undef PG8_STAGE
#undef PG8_LDA
#undef PG8_LDB
#undef PG8_MMA
#undef PG8_WAIT_V
#undef PG8_WAIT_L
#undef PG8_BAR
#undef PG8_SCHED
}
}

constexpr int GBK = 128;
constexpr int GLB = GBK + 16;
constexpr int GBS = 1152;
constexpr int G2_AS = 256 * GLB;
constexpr int G2_BS = (GBK / 8) * GBS;
constexpr int G2_STAGE = G2_AS + G2_BS;
typedef long i64_t;
template <class RowPtr, class ColPtr, class Epi>
__device__ __forceinline__ void gemm2_tile(LAS unsigned char* lds, const RowPtr& RP, const ColPtr& CP, int ldk, int K, int m0, int n0, const Epi& E, int mvalid = 256) {
    const int tid = fresh_tid(), lane = tid & 63, wid = tid >> 6, half = wid >> 2, wm = (wid >> 1) & 1, wn = wid & 1;
    const int fr = lane & 15, fq = lane >> 4;
    const int ht = tid & 255;
    const int ac = (ht & 7) * 16, ar0 = half * 128 + (ht >> 3);
    const int bc = half * 64 + 4 * (ht & 15), bg = ht >> 4;
    const int bpos = Epi::PERM ? ((bc & ~63) + (((bc >> 2) & 3) << 4) + (((bc >> 4) & 3) << 2)) : bc;
    const unsigned char* ap0 = RP(m0 + ar0); const unsigned char* ap1 = RP(m0 + ar0 + 32); const unsigned char* ap2 = RP(m0 + ar0 + 64); const unsigned char* ap3 = RP(m0 + ar0 + 96);
    const float* bp = CP(n0 + bc);
    const f32x4 epre = E.pre(m0 + half * 128 + wm * 64, lane);
    f32x4 acc[4][4];
#pragma unroll
    for (int m = 0; m < 4; ++m)
#pragma unroll
        for (int n = 0; n < 4; ++n) acc[m][n] = (f32x4){0.f, 0.f, 0.f, 0.f};
    const u32x4 z4 = (u32x4){0u, 0u, 0u, 0u};
    const f32x4 zf = (f32x4){0.f, 0.f, 0.f, 0.f};
    u32x4 ra[4] = {z4, z4, z4, z4}; f32x4 rb[8] = {zf, zf, zf, zf, zf, zf, zf, zf};
    const int nk = K / GBK;
    const bool docomp = (half == 0) || (mvalid > 128);
#define G2_LOAD(kt_) do { const int k0_ = (kt_) * GBK; \
        ra[0] = ap0 ? *(const u32x4*)(ap0 + k0_ + ac) : z4; ra[1] = ap1 ? *(const u32x4*)(ap1 + k0_ + ac) : z4; \
        ra[2] = ap2 ? *(const u32x4*)(ap2 + k0_ + ac) : z4; ra[3] = ap3 ? *(const u32x4*)(ap3 + k0_ + ac) : z4; \
        const float* q0_ = bp + (size_t)(k0_ + 8 * bg) * ldk; \
        _Pragma("unroll") for (int j_ = 0; j_ < 8; ++j_) rb[j_] = *(const f32x4*)(q0_ + (size_t)j_ * ldk); } while (0)
#define G2_STORE(buf_) do { LAS unsigned char* As_ = lds + (buf_) * G2_STAGE; LAS unsigned char* Bs_ = As_ + G2_AS; \
        _Pragma("unroll") for (int j_ = 0; j_ < 4; ++j_) *(LAS u32x4*)(As_ + (ar0 + 32 * j_) * GLB + ac) = ra[j_]; \
        u32x4 w0_, w1_;     \
        w0_.x = pk4_fp8(rb[0].x, rb[1].x, rb[2].x, rb[3].x); w0_.y = pk4_fp8(rb[4].x, rb[5].x, rb[6].x, rb[7].x); w0_.z = pk4_fp8(rb[0].y, rb[1].y, rb[2].y, rb[3].y); w0_.w = pk4_fp8(rb[4].y, rb[5].y, rb[6].y, rb[7].y); \
        w1_.x = pk4_fp8(rb[0].z, rb[1].z, rb[2].z, rb[3].z); w1_.y = pk4_fp8(rb[4].z, rb[5].z, rb[6].z, rb[7].z); w1_.z = pk4_fp8(rb[0].w, rb[1].w, rb[2].w, rb[3].w); w1_.w = pk4_fp8(rb[4].w, rb[5].w, rb[6].w, rb[7].w); \
        *(LAS u32x4*)(Bs_ + bg * GBS + bpos * 8) = w0_; *(LAS u32x4*)(Bs_ + bg * GBS + bpos * 8 + 16) = w1_; } while (0)
#define G2_FRAGS(af_, bf_, ks_) do { \
        _Pragma("unroll") for (int m_ = 0; m_ < 4; ++m_) af_[m_] = *(const LAS i64_t*)(As_ + (m_ * 16 + fr) * GLB + (ks_) * 32 + fq * 8); \
        _Pragma("unroll") for (int n_ = 0; n_ < 4; ++n_) bf_[n_] = *(const LAS i64_t*)(Bs_ + ((ks_) * 4 + fq) * GBS + (n_ * 16) * 8); } while (0)
#define G2_MMA(af_, bf_) do { \
        _Pragma("unroll") for (int m_ = 0; m_ < 4; ++m_) _Pragma("unroll") for (int n_ = 0; n_ < 4; ++n_) acc[m_][n_] = __builtin_amdgcn_mfma_f32_16x16x32_fp8_fp8(bf_[n_], af_[m_], acc[m_][n_], 0, 0, 0); } while (0)
#define G2_COMPUTE(buf_) do { const LAS unsigned char* As_ = lds + (buf_) * G2_STAGE + (half * 128 + wm * 64) * GLB; const LAS unsigned char* Bs_ = lds + (buf_) * G2_STAGE + G2_AS + (wn * 64 + fr) * 8; \
        i64_t afa_[4], bfa_[4], afb_[4], bfb_[4]; \
        G2_FRAGS(afa_, bfa_, 0); G2_FRAGS(afb_, bfb_, 1); G2_MMA(afa_, bfa_); \
        G2_FRAGS(afa_, bfa_, 2); G2_MMA(afb_, bfb_); \
        G2_FRAGS(afb_, bfb_, 3); G2_MMA(afa_, bfa_); \
        G2_MMA(afb_, bfb_); } while (0)
    G2_LOAD(0);
    G2_STORE(0);
    if (nk > 1) G2_LOAD(1);
    __syncthreads();
#pragma unroll 1
    for (int kt = 0; kt < nk; ++kt) {
        const int cur = kt & 1;
        if (half == 0) { G2_COMPUTE(cur); }
        else if (kt + 1 < nk) { G2_STORE(cur ^ 1); if (kt + 2 < nk) G2_LOAD(kt + 2); }
        __syncthreads();
        if (half == 1) { if (docomp) { G2_COMPUTE(cur); } }
        else if (kt + 1 < nk) { G2_STORE(cur ^ 1); if (kt + 2 < nk) G2_LOAD(kt + 2); }
        __syncthreads();
    }
#undef G2_LOAD
#undef G2_STORE
#undef G2_COMPUTE
#undef G2_FRAGS
#undef G2_MMA
    E(acc, m0 + half * 128 + wm * 64, n0 + wn * 64, lane, epre);
}

struct RowDense { const bf16_t* A; int lda; __device__ __forceinline__ const bf16_t* operator()(int r) const { return A + (size_t)r * lda; } };
struct RowGather { const unsigned char* A; const int* idx; int nvalid; __device__ __forceinline__ const unsigned char* operator()(int r) const { return r < nvalid ? A + (size_t)idx[r] * D : nullptr; } };
struct RowSlots { const unsigned char* A; int nvalid; __device__ __forceinline__ const unsigned char* operator()(int r) const { return r < nvalid ? A + (size_t)r * EDIM : nullptr; } };
struct ColDense { const float* W; int N; __device__ __forceinline__ const float* operator()(int c) const { return c < N ? W + c : nullptr; } };
struct ColMqk { const float* q; ptrdiff_t dk; __device__ __forceinline__ const float* operator()(int c) const { return q + ((c < 128) ? (ptrdiff_t)c : dk + (c - 128)); } };
struct ColGU { const float* g; ptrdiff_t du;
    __device__ __forceinline__ const float* operator()(int c) const { const int tb = c >> 7, cc = c & 127, wnn = cc >> 6, n = (cc >> 4) & 3, rho = cc & 15;
        return g + (((n & 1) ? du : (ptrdiff_t)0) + tb * 64 + wnn * 32 + 8 * (rho >> 2) + 4 * (n >> 1) + (rho & 3)); } };
struct ColRgu { const float* r; ptrdiff_t dg; ptrdiff_t du; __device__ __forceinline__ const float* operator()(int c) const {
    const int cc = c - 256, j = cc >> 5, w = cc & 31; const ptrdiff_t off = (c < 256) ? (ptrdiff_t)c : (((w & 16) ? du : dg) + j * 16 + (w & 15)); return r + off; } };

__device__ __forceinline__ u32x2 pack4(const f32x4 v) { u32x2 w; w.x = cvt_pk_bf16(v.x, v.y); w.y = cvt_pk_bf16(v.z, v.w); return w; }
__device__ __forceinline__ u32x2 pack_swiglu(const f32x4 g, const f32x4 u) { u32x2 w; w.x = cvt_pk_bf16(siluf_(g.x) * u.x, siluf_(g.y) * u.y); w.y = cvt_pk_bf16(siluf_(g.z) * u.z, siluf_(g.w) * u.w); return w; }
struct EpiProj {
    bf16_t* proj; float* graw;
    __device__ __forceinline__ f32x4 pre(int rb, int lane) const { return (f32x4){0.f, 0.f, 0.f, 0.f}; }
    __device__ __forceinline__ void operator()(const f32x4 (&acc)[4][4], int rb, int cb, int lane, const f32x4 epre) const {
        const int fr = lane & 15, fq = lane >> 4;
#pragma unroll
        for (int m = 0; m < 4; ++m)
#pragma unroll
            for (int n = 0; n < 4; ++n) {
                const int row = rb + m * 16 + fr, col = cb + n * 16 + 4 * fq;
                if (col < OFF_GATE) *(u32x2*)(proj + (size_t)row * IN_DIM + col) = pack4(acc[m][n]);
                else if (col < IN_DIM) *(f32x4*)(graw + (size_t)row * 8 + (col - OFF_GATE)) = acc[m][n];
            }
    }
};
struct EpiNull {
    float* sink;
    __device__ __forceinline__ f32x4 pre(int rb, int lane) const { return (f32x4){0.f, 0.f, 0.f, 0.f}; }
    __device__ __forceinline__ void operator()(const f32x4 (&acc)[4][4], int rb, int cb, int lane, const f32x4 epre) const {
        float t = 0.f;
#pragma unroll
        for (int m = 0; m < 4; ++m)
#pragma unroll
            for (int n = 0; n < 4; ++n) t += acc[m][n].x + acc[m][n].y + acc[m][n].z + acc[m][n].w;
        if (t == 12345.678f) sink[lane] = t;
    }
};
struct EpiBf16 {
    bf16_t* O; int ldc;
    __device__ __forceinline__ f32x4 pre(int rb, int lane) const { return (f32x4){0.f, 0.f, 0.f, 0.f}; }
    __device__ __forceinline__ void operator()(const f32x4 (&acc)[4][4], int rb, int cb, int lane, const f32x4 epre) const {
        const int fr = lane & 15, fq = lane >> 4;
#pragma unroll
        for (int m = 0; m < 4; ++m)
#pragma unroll
            for (int n = 0; n < 4; ++n) *(u32x2*)(O + (size_t)(rb + m * 16 + fr) * ldc + cb + n * 16 + 4 * fq) = pack4(acc[m][n]);
    }
};
struct EpiMqk {
    bf16_t* mq; bf16_t* mk; int h;
    __device__ __forceinline__ f32x4 pre(int rb, int lane) const { return (f32x4){0.f, 0.f, 0.f, 0.f}; }
    __device__ __forceinline__ void operator()(const f32x4 (&acc)[4][4], int rb, int cb, int lane, const f32x4 epre) const {
        const int fr = lane & 15, fq = lane >> 4;
#pragma unroll
        for (int m = 0; m < 4; ++m)
#pragma unroll
            for (int n = 0; n < 4; ++n) {
                const int row = rb + m * 16 + fr, col = cb + n * 16 + 4 * fq; f32x4 v = acc[m][n];
                bf16_t* dst = mq; int c = col;
                if (col >= 128) { dst = mk; c = col - 128; v = v * 0.08838834764831845f; }
                *(u32x2*)(dst + (size_t)row * MINNER + h * DM + c) = pack4(v);
            }
    }
};
struct EpiResid {
    const float* X; const float* ada; int gt_off; float* out;
    __device__ __forceinline__ f32x4 pre(int rb, int lane) const { return (f32x4){0.f, 0.f, 0.f, 0.f}; }
    __device__ __forceinline__ void operator()(const f32x4 (&acc)[4][4], int rb, int cb, int lane, const f32x4 epre) const {
        const int fr = lane & 15, fq = lane >> 4;
#pragma unroll
        for (int m = 0; m < 4; ++m)
#pragma unroll
            for (int n = 0; n < 4; ++n) {
                const int row = rb + m * 16 + fr, col = cb + n * 16 + 4 * fq; const int b = row / S;
                const f32x4 g = *(const f32x4*)(ada + b * 6144 + gt_off + col);
                const f32x4 x = *(const f32x4*)(X + (size_t)row * D + col);
                *(f32x4*)(out + (size_t)row * D + col) = x + g * acc[m][n];
            }
    }
};
struct EpiRgu {
    float* logits; bf16_t* act;
    __device__ __forceinline__ f32x4 pre(int rb, int lane) const { return (f32x4){0.f, 0.f, 0.f, 0.f}; }
    __device__ __forceinline__ void operator()(const f32x4 (&acc)[4][4], int rb, int cb, int lane, const f32x4 epre) const {
        const int fr = lane & 15, fq = lane >> 4;
#pragma unroll
        for (int m = 0; m < 4; ++m) {
            const int row = rb + m * 16 + fr;
            if (cb < 256) {
#pragma unroll
                for (int n = 0; n < 4; ++n) *(f32x4*)(logits + (size_t)row * 256 + cb + n * 16 + 4 * fq) = acc[m][n];
            } else {
                const int j0 = (cb - 256) >> 5;
#pragma unroll
                for (int pp = 0; pp < 2; ++pp) *(u32x2*)(act + (size_t)row * 256 + (j0 + pp) * 16 + 4 * fq) = pack_swiglu(acc[m][2 * pp], acc[m][2 * pp + 1]);
            }
        }
    }
};
struct EpiExpAct {
    static constexpr bool PERM = false;
    unsigned char* act; int slot0; int nvalid;
    __device__ __forceinline__ f32x4 pre(int rb, int lane) const { const f32x4 z = {0.f, 0.f, 0.f, 0.f}; return z; }
    __device__ __forceinline__ void operator()(const f32x4 (&acc)[4][4], int rb, int cb, int lane, const f32x4 epre) const {
        const int fr = lane & 15, fq = lane >> 4;
#pragma unroll
        for (int m = 0; m < 4; ++m) {
            const int r = rb + m * 16 + fr;
            if (r < nvalid) {
                u32x2 w;
                { const f32x4 g = acc[m][0], u = acc[m][1]; w.x = pk4_fp8(siluf_(g.x) * u.x, siluf_(g.y) * u.y, siluf_(g.z) * u.z, siluf_(g.w) * u.w); }
                { const f32x4 g = acc[m][2], u = acc[m][3]; w.y = pk4_fp8(siluf_(g.x) * u.x, siluf_(g.y) * u.y, siluf_(g.z) * u.z, siluf_(g.w) * u.w); }
                *(u32x2*)(act + (size_t)(slot0 + r) * 256 + (cb >> 1) + 8 * fq) = w;
            }
        }
    }
};
struct EpiExpDown {
    static constexpr bool PERM = true;
    unsigned char* y; const float* lw; int slot0; int nvalid;
    __device__ __forceinline__ f32x4 pre(int rb, int lane) const {
        const int fr = lane & 15; f32x4 w;
        w.x = (rb + fr < nvalid) ? lw[rb + fr] : 0.f; w.y = (rb + 16 + fr < nvalid) ? lw[rb + 16 + fr] : 0.f;
        w.z = (rb + 32 + fr < nvalid) ? lw[rb + 32 + fr] : 0.f; w.w = (rb + 48 + fr < nvalid) ? lw[rb + 48 + fr] : 0.f; return w; }
    __device__ __forceinline__ void operator()(const f32x4 (&acc)[4][4], int rb, int cb, int lane, const f32x4 epre) const {
        const int fr = lane & 15, fq = lane >> 4;
#pragma unroll
        for (int m = 0; m < 4; ++m) {
            const int r = rb + m * 16 + fr;
            if (r < nvalid) {
                const float wt = epre[m];
                u32x4 w;
                { const f32x4 v = acc[m][0] * wt; w.x = pk4_fp8(v.x, v.y, v.z, v.w); }
                { const f32x4 v = acc[m][1] * wt; w.y = pk4_fp8(v.x, v.y, v.z, v.w); }
                { const f32x4 v = acc[m][2] * wt; w.z = pk4_fp8(v.x, v.y, v.z, v.w); }
                { const f32x4 v = acc[m][3] * wt; w.w = pk4_fp8(v.x, v.y, v.z, v.w); }
                *(u32x4*)(y + (size_t)(slot0 + r) * 1024 + cb + 16 * fq) = w;
            }
        }
    }
};

constexpr int AKLD = 104, AVLD = 72;
__device__ __forceinline__ void attn_unit(const Params& p, LAS unsigned char* lds, int bh, int qb) {
    LAS bf16_t* Ks = (LAS bf16_t*)lds;
    LAS bf16_t* Vt = Ks + 64 * AKLD;
    const bf16_t* Q = (const bf16_t*)(p.ws + B_Q) + (size_t)bh * S * 96;
    const bf16_t* Kg = (const bf16_t*)(p.ws + B_K) + (size_t)bh * S * 96;
    const int b = bh >> 3, h = bh & 7;
    const bf16_t* Vg = (const bf16_t*)(p.ws + B_KVRAW) + (size_t)b * S * 1024 + h * 128 + 64;
    bf16_t* O = (bf16_t*)(p.ws + B_ORAW) + (size_t)b * S * 512 + h * 64;
    const int tid = fresh_tid(), lane = tid & 63, wid = tid >> 6, fr = lane & 15, fq = lane >> 4;
    const int q0 = qb * 256, qw0 = q0 + wid * 32;
    bf16x8 qf[2][3];
#pragma unroll
    for (int nq = 0; nq < 2; ++nq)
#pragma unroll
        for (int ks = 0; ks < 3; ++ks) qf[nq][ks] = *(const bf16x8*)(Q + (size_t)(qw0 + nq * 16 + fr) * 96 + ks * 32 + fq * 8);
    f32x4 oacc[4][2];
#pragma unroll
    for (int d = 0; d < 4; ++d)
#pragma unroll
        for (int nq = 0; nq < 2; ++nq) oacc[d][nq] = (f32x4){0.f, 0.f, 0.f, 0.f};
    float mrun[2] = {-1e30f, -1e30f}, lrun[2] = {0.f, 0.f};
    const int ntiles = (q0 + 256) / 64;
    constexpr int ASTG = 64 * AKLD + 64 * AVLD;
    const int kc0 = tid, kc1 = tid + NT;
    const int kr0 = kc0 / 12, kq0 = kc0 - kr0 * 12, kr1 = kc1 / 12, kq1 = kc1 - kr1 * 12;
    const int vkey = tid & 63, vdc = tid >> 6;
    u32x4 rk0, rk1 = (u32x4){0u, 0u, 0u, 0u}, rv;
#define ATT_LOAD(k0_) do { rk0 = *(const u32x4*)(Kg + (size_t)((k0_) + kr0) * 96 + kq0 * 8); if (kc1 < 768) rk1 = *(const u32x4*)(Kg + (size_t)((k0_) + kr1) * 96 + kq1 * 8); \
        rv = *(const u32x4*)(Vg + (size_t)((k0_) + vkey) * 1024 + vdc * 8); } while (0)
#define ATT_STORE(buf_) do { LAS bf16_t* Kd_ = Ks + (buf_) * ASTG; LAS bf16_t* Vd_ = Kd_ + 64 * AKLD; \
        *(LAS u32x4*)(Kd_ + kr0 * AKLD + kq0 * 8) = rk0; if (kc1 < 768) *(LAS u32x4*)(Kd_ + kr1 * AKLD + kq1 * 8) = rk1; \
        LAS bf16_t* vt_ = Vd_ + (vdc * 8) * AVLD + vkey; \
        vt_[0 * AVLD] = (bf16_t)(rv.x & 0xffff); vt_[1 * AVLD] = (bf16_t)(rv.x >> 16); vt_[2 * AVLD] = (bf16_t)(rv.y & 0xffff); vt_[3 * AVLD] = (bf16_t)(rv.y >> 16); \
        vt_[4 * AVLD] = (bf16_t)(rv.z & 0xffff); vt_[5 * AVLD] = (bf16_t)(rv.z >> 16); vt_[6 * AVLD] = (bf16_t)(rv.w & 0xffff); vt_[7 * AVLD] = (bf16_t)(rv.w >> 16); } while (0)
    ATT_LOAD(0);
    ATT_STORE(0);
    __syncthreads();
    for (int kt = 0; kt < ntiles; ++kt) {
        const int k0 = kt * 64;
        const LAS bf16_t* Kc = Ks + (kt & 1) * ASTG; const LAS bf16_t* Vc = Kc + 64 * AKLD;
        if (kt + 1 < ntiles) ATT_LOAD(k0 + 64);
        if (k0 <= qw0 + 31) {
            f32x4 sacc[4][2];
#pragma unroll
            for (int t4 = 0; t4 < 4; ++t4)
#pragma unroll
                for (int nq = 0; nq < 2; ++nq) sacc[t4][nq] = (f32x4){0.f, 0.f, 0.f, 0.f};
#pragma unroll
            for (int ks = 0; ks < 3; ++ks)
#pragma unroll
                for (int t4 = 0; t4 < 4; ++t4) {
                    const bf16x8 kf = *(const LAS bf16x8*)(Kc + (t4 * 16 + fr) * AKLD + ks * 32 + fq * 8);
#pragma unroll
                    for (int nq = 0; nq < 2; ++nq) sacc[t4][nq] = MFMA16(kf, qf[nq][ks], sacc[t4][nq]);
                }
            const bool need_mask = (k0 + 63 > qw0);
#pragma unroll
            for (int nq = 0; nq < 2; ++nq) {
                const int qidx = qw0 + nq * 16 + fr;
                float mx = -1e30f;
#pragma unroll
                for (int t4 = 0; t4 < 4; ++t4)
#pragma unroll
                    for (int i = 0; i < 4; ++i) {
                        if (need_mask) { const int key = k0 + t4 * 16 + 4 * fq + i; if (key > qidx) sacc[t4][nq][i] = -1e30f; }
                        mx = fmaxf(mx, sacc[t4][nq][i]);
                    }
                mx = fmaxf(mx, __shfl_xor(mx, 16)); mx = fmaxf(mx, __shfl_xor(mx, 32));
                const float mnew = fmaxf(mrun[nq], mx);
                const float alpha = exp2f(mrun[nq] - mnew);
                mrun[nq] = mnew;
                float ls = 0.f;
#pragma unroll
                for (int t4 = 0; t4 < 4; ++t4)
#pragma unroll
                    for (int i = 0; i < 4; ++i) { const float pv = exp2f(sacc[t4][nq][i] - mnew); sacc[t4][nq][i] = pv; ls += pv; }
                lrun[nq] = lrun[nq] * alpha + ls;
#pragma unroll
                for (int d = 0; d < 4; ++d) oacc[d][nq] = oacc[d][nq] * alpha;
            }
#pragma unroll
            for (int s2 = 0; s2 < 2; ++s2) {
                bf16x8 pb[2];
#pragma unroll
                for (int nq = 0; nq < 2; ++nq) {
                    u32x4 w; w.x = cvt_pk_bf16(sacc[2 * s2][nq].x, sacc[2 * s2][nq].y); w.y = cvt_pk_bf16(sacc[2 * s2][nq].z, sacc[2 * s2][nq].w);
                    w.z = cvt_pk_bf16(sacc[2 * s2 + 1][nq].x, sacc[2 * s2 + 1][nq].y); w.w = cvt_pk_bf16(sacc[2 * s2 + 1][nq].z, sacc[2 * s2 + 1][nq].w);
                    pb[nq] = __builtin_bit_cast(bf16x8, w);
                }
#pragma unroll
                for (int d = 0; d < 4; ++d) {
                    const LAS bf16_t* vr = Vc + (d * 16 + fr) * AVLD + s2 * 32 + 4 * fq;
                    const u32x2 lo = *(const LAS u32x2*)vr, hi = *(const LAS u32x2*)(vr + 16);
                    const bf16x8 vf = __builtin_bit_cast(bf16x8, ((u32x4){lo.x, lo.y, hi.x, hi.y}));
#pragma unroll
                    for (int nq = 0; nq < 2; ++nq) oacc[d][nq] = MFMA16(vf, pb[nq], oacc[d][nq]);
                }
            }
        }
        if (kt + 1 < ntiles) ATT_STORE((kt + 1) & 1);
        __syncthreads();
    }
#undef ATT_LOAD
#undef ATT_STORE
#pragma unroll
    for (int nq = 0; nq < 2; ++nq) {
        float l = lrun[nq]; l += __shfl_xor(l, 16); l += __shfl_xor(l, 32);
        const float inv = 1.f / l;
        const int qidx = qw0 + nq * 16 + fr;
#pragma unroll
        for (int d = 0; d < 4; ++d) { const f32x4 v = oacc[d][nq] * inv; u32x2 w; w.x = cvt_pk_bf16(v.x, v.y); w.y = cvt_pk_bf16(v.z, v.w);
            *(u32x2*)(O + (size_t)qidx * 512 + d * 16 + 4 * fq) = w; }
    }
}

constexpr int MTLD = 72;
__device__ __forceinline__ void mlstm_a_unit(const Params& p, LAS unsigned char* lds, int unit) {
    LAS bf16_t* kT = (LAS bf16_t*)lds;
    LAS bf16_t* vT = kT + 128 * MTLD;
    LAS float* av = (LAS float*)(vT + 128 * MTLD);
    const int bh = unit >> 5, c = unit & 31, b = bh >> 2, h = bh & 3;
    const int t0 = b * S + c * CHUNK;
    const float* gl = (const float*)(p.ws + B_GL);
    const bf16_t* mk = (const bf16_t*)(p.ws + B_MK); const bf16_t* proj = (const bf16_t*)(p.ws + B_PROJ);
    const int tid = fresh_tid(), lane = tid & 63, wid = tid >> 6, fr = lane & 15, fq = lane >> 4;
    if (wid == 0) {
        const float li = gl[(size_t)(t0 + lane) * 8 + h], lf = gl[(size_t)(t0 + lane) * 8 + 4 + h];
        float bs = lf;
#pragma unroll
        for (int o = 1; o < 64; o <<= 1) { const float t = __shfl_up(bs, o); if (lane >= o) bs += t; }
        const float Btot = __shfl(bs, 63);
        const float g = Btot - bs + li;
        const float ml = wave_max(g);
        av[lane] = __expf(g - ml);
        if (lane == 0) { ((float*)(p.ws + WS_BC))[unit] = Btot; ((float*)(p.ws + WS_MLOC))[unit] = ml; }
    }
    __syncthreads();
#pragma unroll
    for (int rep = 0; rep < 2; ++rep) {
        const int cidx = tid + rep * NT, s = cidx & 63, ch = cidx >> 6;
        const u32x4 kv = *(const u32x4*)(mk + (size_t)(t0 + s) * MINNER + h * DM + ch * 8);
        const u32x4 vv = *(const u32x4*)(proj + (size_t)(t0 + s) * IN_DIM + OFF_MV + h * DM + ch * 8);
        const float a = av[s];
        LAS bf16_t* kt = kT + (ch * 8) * MTLD + s; LAS bf16_t* vt = vT + (ch * 8) * MTLD + s;
        const unsigned kk[4] = {kv.x, kv.y, kv.z, kv.w}; const unsigned vw[4] = {vv.x, vv.y, vv.z, vv.w};
#pragma unroll
        for (int j = 0; j < 4; ++j) {
            kt[(2 * j) * MTLD] = (bf16_t)(kk[j] & 0xffff); kt[(2 * j + 1) * MTLD] = (bf16_t)(kk[j] >> 16);
            const unsigned sc = cvt_pk_bf16(bflo(vw[j]) * a, bfhi(vw[j]) * a);
            vt[(2 * j) * MTLD] = (bf16_t)(sc & 0xffff); vt[(2 * j + 1) * MTLD] = (bf16_t)(sc >> 16);
        }
    }
    __syncthreads();
    {
        const int we = wid >> 1, wd = wid & 1;
        f32x4 acc[2][4];
#pragma unroll
        for (int i = 0; i < 2; ++i)
#pragma unroll
            for (int j = 0; j < 4; ++j) acc[i][j] = (f32x4){0.f, 0.f, 0.f, 0.f};
#pragma unroll
        for (int ks = 0; ks < 2; ++ks) {
            bf16x8 vf[2], kf[4];
#pragma unroll
            for (int i = 0; i < 2; ++i) vf[i] = *(const LAS bf16x8*)(vT + (we * 32 + i * 16 + fr) * MTLD + ks * 32 + fq * 8);
#pragma unroll
            for (int j = 0; j < 4; ++j) kf[j] = *(const LAS bf16x8*)(kT + (wd * 64 + j * 16 + fr) * MTLD + ks * 32 + fq * 8);
#pragma unroll
            for (int i = 0; i < 2; ++i)
#pragma unroll
                for (int j = 0; j < 4; ++j) acc[i][j] = MFMA16(vf[i], kf[j], acc[i][j]);
        }
        float* dC = (float*)(p.ws + B_DC) + (size_t)unit * 16384;
#pragma unroll
        for (int i = 0; i < 2; ++i)
#pragma unroll
            for (int j = 0; j < 4; ++j)
#pragma unroll
                for (int r = 0; r < 4; ++r) dC[(we * 32 + i * 16 + 4 * fq + r) * 128 + wd * 64 + j * 16 + fr] = acc[i][j][r];
    }
    if (tid < 128) {
        float s = 0.f;
        for (int q = 0; q < 64; ++q) s += bf2f(kT[tid * MTLD + q]) * av[q];
        ((float*)(p.ws + WS_DN))[(size_t)unit * 128 + tid] = s;
    }
    __syncthreads();
}

__device__ __forceinline__ void mlstm_scan(const Params& p, int gtid, int ngt) {
    const float* Bc = (const float*)(p.ws + WS_BC); const float* ML = (const float*)(p.ws + WS_MLOC);
    float* mprev = (float*)(p.ws + WS_MPREV);
    const float* dC = (const float*)(p.ws + B_DC); bf16_t* Cp = (bf16_t*)(p.ws + B_CPREV);
    const float* dn = (const float*)(p.ws + WS_DN); float* np_ = (float*)(p.ws + WS_NPREV);
    constexpr int PER = 4096 + 32;
    for (int idx = gtid; idx < 32 * PER; idx += ngt) {
        const int bh = idx / PER, e4 = idx - bh * PER;
        const bool isC = e4 < 4096; const int n4 = e4 - 4096;
        float m = 0.f; f32x4 C = (f32x4){0.f, 0.f, 0.f, 0.f};
        for (int c0 = 0; c0 < NCH; c0 += 4) {
            f32x4 d[4]; float Bt[4], ml[4];
#pragma unroll
            for (int q = 0; q < 4; ++q) {
                const int unit = bh * NCH + c0 + q;
                Bt[q] = Bc[unit]; ml[q] = ML[unit];
                d[q] = isC ? *(const f32x4*)(dC + (size_t)unit * 16384 + e4 * 4) : *(const f32x4*)(dn + (size_t)unit * 128 + n4 * 4);
            }
#pragma unroll
            for (int q = 0; q < 4; ++q) {
                const int unit = bh * NCH + c0 + q;
                const float mnew = fmaxf(Bt[q] + m, ml[q]);
                const float fa = __expf(Bt[q] + m - mnew), fb = __expf(ml[q] - mnew);
                if (isC) {
                    u32x2 w; w.x = cvt_pk_bf16(C.x, C.y); w.y = cvt_pk_bf16(C.z, C.w);
                    *(u32x2*)(Cp + (size_t)unit * 16384 + e4 * 4) = w;
                    if (e4 == 0) mprev[unit] = m;
                } else {
                    *(f32x4*)(np_ + (size_t)unit * 128 + n4 * 4) = C;
                }
                C = C * fa + d[q] * fb;
                m = mnew;
            }
        }
    }
}

constexpr int MRLD = 136;
__device__ __forceinline__ void mlstm_c_unit(const Params& p, LAS unsigned char* lds, int unit) {
    LAS bf16_t* qs = (LAS bf16_t*)lds;
    LAS bf16_t* ks = qs + 64 * MRLD;
    LAS bf16_t* cs = ks + 64 * MRLD;
    LAS bf16_t* vT = cs + 128 * MRLD;
    LAS float* fv = (LAS float*)(vT + 128 * MTLD);
    LAS float* u_s = fv; LAS float* c_t = fv + 64; LAS float* dec = fv + 128; LAS float* emt = fv + 192; LAS float* ssq = fv + 256;
    const int bh = unit >> 5, c = unit & 31, b = bh >> 2, h = bh & 3;
    const int t0 = b * S + c * CHUNK;
    const float* gl = (const float*)(p.ws + B_GL);
    const bf16_t* mq = (const bf16_t*)(p.ws + B_MQ); const bf16_t* mk = (const bf16_t*)(p.ws + B_MK); const bf16_t* proj = (const bf16_t*)(p.ws + B_PROJ);
    const bf16_t* Cp = (const bf16_t*)(p.ws + B_CPREV) + (size_t)unit * 16384;
    const float* np_ = (const float*)(p.ws + WS_NPREV) + (size_t)unit * 128;
    const int tid = fresh_tid(), lane = tid & 63, wid = tid >> 6, fr = lane & 15, fq = lane >> 4;
    if (wid == 0) {
        const float li = gl[(size_t)(t0 + lane) * 8 + h], lf = gl[(size_t)(t0 + lane) * 8 + 4 + h];
        const float mp = ((const float*)(p.ws + WS_MPREV))[unit];
        float bs = lf;
#pragma unroll
        for (int o = 1; o < 64; o <<= 1) { const float t = __shfl_up(bs, o); if (lane >= o) bs += t; }
        const float u = li - bs;
        float pm = u;
#pragma unroll
        for (int o = 1; o < 64; o <<= 1) { const float t = __shfl_up(pm, o); if (lane >= o) pm = fmaxf(pm, t); }
        const float inter = bs + mp;
        const float mt = fmaxf(inter, bs + pm);
        u_s[lane] = u; c_t[lane] = bs - mt; dec[lane] = __expf(inter - mt); emt[lane] = __expf(-mt);
    }
#pragma unroll
    for (int rep = 0; rep < 2; ++rep) {
        const int cidx = tid + rep * NT, r = cidx >> 4, ch = cidx & 15;
        *(LAS u32x4*)(qs + r * MRLD + ch * 8) = *(const u32x4*)(mq + (size_t)(t0 + r) * MINNER + h * DM + ch * 8);
        *(LAS u32x4*)(ks + r * MRLD + ch * 8) = *(const u32x4*)(mk + (size_t)(t0 + r) * MINNER + h * DM + ch * 8);
    }
#pragma unroll
    for (int rep = 0; rep < 4; ++rep) {
        const int cidx = tid + rep * NT, r = cidx >> 4, ch = cidx & 15;
        *(LAS u32x4*)(cs + r * MRLD + ch * 8) = *(const u32x4*)(Cp + r * 128 + ch * 8);
    }
#pragma unroll
    for (int rep = 0; rep < 2; ++rep) {
        const int cidx = tid + rep * NT, s = cidx & 63, ch = cidx >> 6;
        const u32x4 vv = *(const u32x4*)(proj + (size_t)(t0 + s) * IN_DIM + OFF_MV + h * DM + ch * 8);
        LAS bf16_t* vt = vT + (ch * 8) * MTLD + s;
        const unsigned vw[4] = {vv.x, vv.y, vv.z, vv.w};
#pragma unroll
        for (int j = 0; j < 4; ++j) { vt[(2 * j) * MTLD] = (bf16_t)(vw[j] & 0xffff); vt[(2 * j + 1) * MTLD] = (bf16_t)(vw[j] >> 16); }
    }
    __syncthreads();
    const int tt = wid & 3, eh = wid >> 2;
    const int tl = tt * 16 + fr;
    bf16x8 qf[4];
#pragma unroll
    for (int k4 = 0; k4 < 4; ++k4) qf[k4] = *(const LAS bf16x8*)(qs + tl * MRLD + k4 * 32 + fq * 8);
    f32x4 sacc[4];
#pragma unroll
    for (int st = 0; st < 4; ++st) sacc[st] = (f32x4){0.f, 0.f, 0.f, 0.f};
#pragma unroll
    for (int k4 = 0; k4 < 4; ++k4)
#pragma unroll
        for (int st = 0; st < 4; ++st) {
            const bf16x8 kf = *(const LAS bf16x8*)(ks + (st * 16 + fr) * MRLD + k4 * 32 + fq * 8);
            sacc[st] = MFMA16(kf, qf[k4], sacc[st]);
        }
    const float ct = c_t[tl];
    float rs = 0.f;
#pragma unroll
    for (int st = 0; st < 4; ++st)
#pragma unroll
        for (int i = 0; i < 4; ++i) {
            const int s = st * 16 + 4 * fq + i;
            const float w = (s <= tl) ? __expf(ct + u_s[s]) * sacc[st][i] : 0.f;
            sacc[st][i] = w; rs += w;
        }
    rs += __shfl_xor(rs, 16); rs += __shfl_xor(rs, 32);
    float nq;
    {
        f32x4 na = (f32x4){0.f, 0.f, 0.f, 0.f};
#pragma unroll
        for (int k4 = 0; k4 < 4; ++k4) {
            u32x4 w = (u32x4){0u, 0u, 0u, 0u};
            if (fr == 0) { const float* nn = np_ + k4 * 32 + fq * 8; w.x = cvt_pk_bf16(nn[0], nn[1]); w.y = cvt_pk_bf16(nn[2], nn[3]); w.z = cvt_pk_bf16(nn[4], nn[5]); w.w = cvt_pk_bf16(nn[6], nn[7]); }
            na = MFMA16(__builtin_bit_cast(bf16x8, w), qf[k4], na);
        }
        nq = __shfl(na.x, fr);
    }
    f32x4 acc[4];
#pragma unroll
    for (int et = 0; et < 4; ++et) acc[et] = (f32x4){0.f, 0.f, 0.f, 0.f};
#pragma unroll
    for (int k4 = 0; k4 < 4; ++k4)
#pragma unroll
        for (int et = 0; et < 4; ++et) {
            const bf16x8 cf = *(const LAS bf16x8*)(cs + (eh * 64 + et * 16 + fr) * MRLD + k4 * 32 + fq * 8);
            acc[et] = MFMA16(cf, qf[k4], acc[et]);
        }
    const float dcy = dec[tl];
#pragma unroll
    for (int et = 0; et < 4; ++et) acc[et] = acc[et] * dcy;
#pragma unroll
    for (int s2 = 0; s2 < 2; ++s2) {
        u32x4 w; w.x = cvt_pk_bf16(sacc[2 * s2].x, sacc[2 * s2].y); w.y = cvt_pk_bf16(sacc[2 * s2].z, sacc[2 * s2].w);
        w.z = cvt_pk_bf16(sacc[2 * s2 + 1].x, sacc[2 * s2 + 1].y); w.w = cvt_pk_bf16(sacc[2 * s2 + 1].z, sacc[2 * s2 + 1].w);
        const bf16x8 pb = __builtin_bit_cast(bf16x8, w);
#pragma unroll
        for (int et = 0; et < 4; ++et) {
            const LAS bf16_t* vr = vT + (eh * 64 + et * 16 + fr) * MTLD + s2 * 32 + 4 * fq;
            const u32x2 lo = *(const LAS u32x2*)vr, hi = *(const LAS u32x2*)(vr + 16);
            acc[et] = MFMA16(__builtin_bit_cast(bf16x8, ((u32x4){lo.x, lo.y, hi.x, hi.y})), pb, acc[et]);
        }
    }
    const float den = dcy * nq + rs;
    const float hd = 1.f / fmaxf(fabsf(den), emt[tl]);
    float sq = 0.f;
#pragma unroll
    for (int et = 0; et < 4; ++et) { acc[et] = acc[et] * hd; sq += acc[et].x * acc[et].x + acc[et].y * acc[et].y + acc[et].z * acc[et].z + acc[et].w * acc[et].w; }
    sq += __shfl_xor(sq, 16); sq += __shfl_xor(sq, 32);
    if (fq == 0) ssq[eh * 64 + tl] = sq;
    __syncthreads();
    const float rinv = rsqrtf((ssq[tl] + ssq[64 + tl]) * (1.f / 128.f) + RMS_EPS);
    const float* gmo = p.in[20] + h * DM;
    bf16_t* ao = (bf16_t*)(p.ws + B_AO);
#pragma unroll
    for (int et = 0; et < 4; ++et) {
        const int e = eh * 64 + et * 16 + 4 * fq;
        const u32x2 op = *(const u32x2*)(proj + (size_t)(t0 + tl) * IN_DIM + OFF_MO + h * DM + e);
        const f32x4 g = *(const f32x4*)(gmo + e);
        const f32x4 v = acc[et] * rinv * g;
        u32x2 w; w.x = cvt_pk_bf16(v.x * sigmoidf_(bflo(op.x)), v.y * sigmoidf_(bfhi(op.x))); w.y = cvt_pk_bf16(v.z * sigmoidf_(bflo(op.y)), v.w * sigmoidf_(bfhi(op.y)));
        *(u32x2*)(ao + (size_t)(t0 + tl) * 1024 + 512 + h * DM + e) = w;
    }
    __syncthreads();
}

__device__ __forceinline__ unsigned fkey(float f) { const unsigned u = __float_as_uint(f); return (u & 0x80000000u) ? ~u : (u | 0x80000000u); }
__device__ __forceinline__ float rdlane_f(float v, int l) { return __uint_as_float((unsigned)__builtin_amdgcn_readlane((int)__float_as_uint(v), l)); }
__device__ __forceinline__ void route_token(const f32x4 cur, const f32x4 bias, int lane, int (&e8)[8], float (&w8)[8]) {
    float sc[4] = {sigmoidf_(cur.x), sigmoidf_(cur.y), sigmoidf_(cur.z), sigmoidf_(cur.w)};
    float sb[4] = {sc[0] + bias.x, sc[1] + bias.y, sc[2] + bias.z, sc[3] + bias.w};
    float t1 = fmaxf(fmaxf(sb[0], sb[1]), fmaxf(sb[2], sb[3]));
    float t2;
    {   const float a = fmaxf(sb[0], sb[1]), bmin = fminf(sb[0], sb[1]), c2 = fmaxf(sb[2], sb[3]), dmin = fminf(sb[2], sb[3]);
        t2 = fmaxf(fminf(a, c2), fmaxf(bmin, dmin)); }
#pragma unroll
    for (int o = 1; o < 8; o <<= 1) {
        const float o1 = __shfl_xor(t1, o), o2 = __shfl_xor(t2, o);
        const float n1 = fmaxf(t1, o1), n2 = fmaxf(fminf(t1, o1), fmaxf(t2, o2));
        t1 = n1; t2 = n2;
    }
    const float gs = t1 + t2;
    const int myg = lane >> 3;
    int rank = 0;
#pragma unroll
    for (int g = 0; g < 8; ++g) { const float og = rdlane_f(gs, g * 8); rank += (og > gs || (og == gs && g < myg)) ? 1 : 0; }
    const bool keep = rank < 4;
    unsigned key[4];
#pragma unroll
    for (int j = 0; j < 4; ++j) key[j] = keep ? fkey(sb[j]) : 0u;
    unsigned t = 0u;
#pragma unroll 4
    for (int bit = 31; bit >= 0; --bit) {
        const unsigned tt = t | (1u << bit);
        const int c = __builtin_popcountll(__ballot(key[0] >= tt)) + __builtin_popcountll(__ballot(key[1] >= tt)) + __builtin_popcountll(__ballot(key[2] >= tt)) + __builtin_popcountll(__ballot(key[3] >= tt));
        if (c >= TOPK) t = tt;
    }
    unsigned long long sel[4], eq[4];
    int ngt = 0;
#pragma unroll
    for (int j = 0; j < 4; ++j) { sel[j] = __ballot(key[j] > t); eq[j] = __ballot(key[j] == t); ngt += __builtin_popcountll(sel[j]); }
    for (int need = TOPK - ngt; need > 0; --need) {
        int best = 1 << 30;
#pragma unroll
        for (int j = 0; j < 4; ++j) if (eq[j]) { const int idx = 4 * (int)__builtin_ctzll(eq[j]) + j; best = idx < best ? idx : best; }
        const int L = best >> 2, jj = best & 3;
#pragma unroll
        for (int j = 0; j < 4; ++j) if (jj == j) { eq[j] &= ~(1ull << L); sel[j] |= (1ull << L); }
    }
    float wsum = 0.f;
#pragma unroll
    for (int k = 0; k < TOPK; ++k) {
        int best = 1 << 30;
#pragma unroll
        for (int j = 0; j < 4; ++j) if (sel[j]) { const int idx = 4 * (int)__builtin_ctzll(sel[j]) + j; best = idx < best ? idx : best; }
        const int L = best >> 2, jj = best & 3;
#pragma unroll
        for (int j = 0; j < 4; ++j) if (jj == j) sel[j] &= ~(1ull << L);
        const float s0 = rdlane_f(sc[0], L), s1 = rdlane_f(sc[1], L), s2 = rdlane_f(sc[2], L), s3 = rdlane_f(sc[3], L);
        const float sraw = (jj == 0) ? s0 : (jj == 1) ? s1 : (jj == 2) ? s2 : s3;
        e8[k] = best; w8[k] = sraw; wsum += sraw;
    }
    const float inv = 2.5f / wsum;
#pragma unroll
    for (int k = 0; k < TOPK; ++k) w8[k] *= inv;
}
__device__ __forceinline__ void route_rows(const Params& p, int gw, int ngw, int lane) {
    const float* logits = (const float*)(p.ws + C_LOGITS); const float* rb = p.in[24];
    int* cnt = (int*)(p.ws + WS_CNT);
    int* tok_e = (int*)(p.ws + C_TOKE); float* tok_w = (float*)(p.ws + C_TOKW); int* tok_pos = (int*)(p.ws + C_TOKPOS);
    int* list_tok = (int*)(p.ws + C_LISTTOK); float* list_w = (float*)(p.ws + C_LISTW);
    const f32x4 bias = *(const f32x4*)(rb + lane * 4);
    for (int row0 = gw; row0 < T; row0 += ngw * 8) {
        int e_all = 0, row_all = -1; float w_all = 0.f;
        f32x4 lg = *(const f32x4*)(logits + (size_t)row0 * 256 + lane * 4);
#pragma unroll 1
        for (int i = 0; i < 8; ++i) {
            const int row = row0 + i * ngw;
            if (row >= T) break;
            const f32x4 cur = lg;
            if (i + 1 < 8 && row + ngw < T) lg = *(const f32x4*)(logits + (size_t)(row + ngw) * 256 + lane * 4);
            int e8[8]; float w8[8];
            route_token(cur, bias, lane, e8, w8);
            if ((lane >> 3) == i) {
                const int k = lane & 7; int es = e8[0]; float wsel = w8[0];
#pragma unroll
                for (int q = 1; q < 8; ++q) if (k == q) { es = e8[q]; wsel = w8[q]; }
                e_all = es; w_all = wsel; row_all = row;
            }
        }
        if (row_all >= 0) {
            const int k = lane & 7;
            const int pos = atomicAdd(&cnt[e_all * CNT_STRIDE], 1);
            tok_e[(size_t)row_all * 8 + k] = e_all; tok_w[(size_t)row_all * 8 + k] = w_all; tok_pos[(size_t)row_all * 8 + k] = pos;
            list_tok[(size_t)e_all * CAP + pos] = row_all; list_w[(size_t)e_all * CAP + pos] = w_all;
        }
    }
}

__device__ __forceinline__ void expert_prefix(const Params& p, LAS int* base, LAS int* tsx, int tid, int x, int ngrp) {
    const int* cnt = (const int*)(p.ws + WS_CNT);
    const int nper = NE / ngrp;
    if (tid < 64) {
        int c[4]; int s = 0;
#pragma unroll
        for (int j = 0; j < 4; ++j) { c[j] = __hip_atomic_load(cnt + (tid * 4 + j) * CNT_STRIDE, __ATOMIC_RELAXED, __HIP_MEMORY_SCOPE_AGENT); s += c[j]; }
        int ps = s;
#pragma unroll
        for (int o = 1; o < 64; o <<= 1) { const int a = __shfl_up(ps, o); if (tid >= o) ps += a; }
        int es = ps - s;
#pragma unroll
        for (int j = 0; j < 4; ++j) { base[tid * 4 + j] = es; es += c[j]; }
        int run = 0;
        for (int r0 = 0; r0 < nper; r0 += 64) {
            const int i = r0 + tid;
            int tl = 0;
            if (i < nper) tl = (__hip_atomic_load(cnt + (x + ngrp * i) * CNT_STRIDE, __ATOMIC_RELAXED, __HIP_MEMORY_SCOPE_AGENT) + 255) >> 8;
            int pt = tl;
#pragma unroll
            for (int o = 1; o < 64; o <<= 1) { const int a = __shfl_up(pt, o); if (tid >= o) pt += a; }
            if (i < nper) tsx[i] = run + pt - tl;
            run += __shfl(pt, 63);
        }
        if (tid == 0) tsx[nper] = run;
    }
    __syncthreads();
}

__device__ __forceinline__ void combine_rows(const Params& p, LAS int* base, int gw, int ngw, int lane) {
    const bf16_t* sh = (const bf16_t*)(p.ws + C_SHOUT); const unsigned char* y = (const unsigned char*)(p.ws + C_Y);
    const int* tok_e = (const int*)(p.ws + C_TOKE); const int* tok_pos = (const int*)(p.ws + C_TOKPOS);
    const float* ada = (const float*)(p.ws + WS_ADA);
    typedef float f32x2v __attribute__((ext_vector_type(2)));
    for (int row = gw; row < T; row += ngw) {
        const int b = row / S;
        const int col = lane * 16;
        u32x4 yr[TOPK];
#pragma unroll
        for (int k = 0; k < TOPK; ++k) {
            const int e = tok_e[(size_t)row * 8 + k], pos = tok_pos[(size_t)row * 8 + k];
            yr[k] = *(const u32x4*)(y + (size_t)(base[e] + pos) * 1024 + col);
        }
        float acc[16];
        {
            const u32x4 a0 = *(const u32x4*)(sh + (size_t)row * 1024 + col), a1 = *(const u32x4*)(sh + (size_t)row * 1024 + col + 8);
            acc[0] = bflo(a0.x); acc[1] = bfhi(a0.x); acc[2] = bflo(a0.y); acc[3] = bfhi(a0.y); acc[4] = bflo(a0.z); acc[5] = bfhi(a0.z); acc[6] = bflo(a0.w); acc[7] = bfhi(a0.w);
            acc[8] = bflo(a1.x); acc[9] = bfhi(a1.x); acc[10] = bflo(a1.y); acc[11] = bfhi(a1.y); acc[12] = bflo(a1.z); acc[13] = bfhi(a1.z); acc[14] = bflo(a1.w); acc[15] = bfhi(a1.w);
        }
#pragma unroll
        for (int k = 0; k < TOPK; ++k) {
            const unsigned w4[4] = {yr[k].x, yr[k].y, yr[k].z, yr[k].w};
#pragma unroll
            for (int q = 0; q < 4; ++q) {
                const f32x2v lo = __builtin_amdgcn_cvt_pk_f32_fp8((int)w4[q], false), hi = __builtin_amdgcn_cvt_pk_f32_fp8((int)w4[q], true);
                acc[4 * q + 0] += lo.x; acc[4 * q + 1] += lo.y; acc[4 * q + 2] += hi.x; acc[4 * q + 3] += hi.y;
            }
        }
        float* o = p.out + (size_t)row * D + col;
        const float* g = ada + b * 6144 + 5120 + col;
#pragma unroll
        for (int q4 = 0; q4 < 4; ++q4) {
            const f32x4 x = *(const f32x4*)(o + q4 * 4), gg = *(const f32x4*)(g + q4 * 4);
            f32x4 r; r.x = x.x + gg.x * acc[q4 * 4 + 0]; r.y = x.y + gg.y * acc[q4 * 4 + 1]; r.z = x.z + gg.z * acc[q4 * 4 + 2]; r.w = x.w + gg.w * acc[q4 * 4 + 3];
            *(f32x4*)(o + q4 * 4) = r;
        }
    }
}


struct PgProj {
    static constexpr bool PERM = true, AFTER_DRAIN = false;
    bf16_t* proj; float* graw;
    __device__ __forceinline__ void operator()(const f32x4 (&acc)[2][2][4][2], const pg8::Unit& u, int wr, int wc, int fr, int fq) const {
#pragma unroll
        for (int ai = 0; ai < 2; ++ai)
#pragma unroll
            for (int m = 0; m < 4; ++m) { const int row = u.pm * 256 + ai * 128 + wr * 64 + m * 16 + fr;
#pragma unroll
                for (int bj = 0; bj < 2; ++bj) { const int col = u.pn * 256 + bj * 128 + wc * 32 + 8 * fq;
                    if (col < OFF_GATE) { const u32x2 lo = pack4(acc[ai][bj][m][0]), hi = pack4(acc[ai][bj][m][1]); *(u32x4*)(proj + (size_t)row * IN_DIM + col) = (u32x4){lo.x, lo.y, hi.x, hi.y}; }
                    else if (col < IN_DIM) { *(f32x4*)(graw + (size_t)row * 8) = acc[ai][bj][m][0]; *(f32x4*)(graw + (size_t)row * 8 + 4) = acc[ai][bj][m][1]; } } }
    }
};
struct PgBf16 {
    static constexpr bool PERM = true, AFTER_DRAIN = false;
    bf16_t* O; int ldc;
    __device__ __forceinline__ void operator()(const f32x4 (&acc)[2][2][4][2], const pg8::Unit& u, int wr, int wc, int fr, int fq) const {
#pragma unroll
        for (int ai = 0; ai < 2; ++ai)
#pragma unroll
            for (int m = 0; m < 4; ++m) { const int row = u.pm * 256 + ai * 128 + wr * 64 + m * 16 + fr;
#pragma unroll
                for (int bj = 0; bj < 2; ++bj) { const int col = u.pn * 256 + bj * 128 + wc * 32 + 8 * fq;
                    const u32x2 lo = pack4(acc[ai][bj][m][0]), hi = pack4(acc[ai][bj][m][1]); *(u32x4*)(O + (size_t)row * ldc + col) = (u32x4){lo.x, lo.y, hi.x, hi.y}; } }
    }
};
struct PgMqk {
    static constexpr bool PERM = true, AFTER_DRAIN = false;
    bf16_t* mq; bf16_t* mk;
    __device__ __forceinline__ void operator()(const f32x4 (&acc)[2][2][4][2], const pg8::Unit& u, int wr, int wc, int fr, int fq) const {
#pragma unroll
        for (int ai = 0; ai < 2; ++ai)
#pragma unroll
            for (int m = 0; m < 4; ++m) { const int row = u.pm * 256 + ai * 128 + wr * 64 + m * 16 + fr;
#pragma unroll
                for (int bj = 0; bj < 2; ++bj) { const int c = wc * 32 + 8 * fq; const float sc = bj ? 0.08838834764831845f : 1.f;
                    const u32x2 lo = pack4(acc[ai][bj][m][0] * sc), hi = pack4(acc[ai][bj][m][1] * sc);
                    *(u32x4*)((bj ? mk : mq) + (size_t)row * MINNER + u.pn * DM + c) = (u32x4){lo.x, lo.y, hi.x, hi.y}; } }
    }
};
struct PgResid {
    static constexpr bool PERM = false, AFTER_DRAIN = false;
    const float* X; const float* ada; int gt_off; float* out;
    __device__ __forceinline__ void operator()(const f32x4 (&acc)[2][2][4][2], const pg8::Unit& u, int wr, int wc, int fr, int fq) const {
#pragma unroll
        for (int ai = 0; ai < 2; ++ai)
#pragma unroll
            for (int m = 0; m < 4; ++m) { const int row = u.pm * 256 + ai * 128 + wr * 64 + m * 16 + fr; const int b = row / S;
#pragma unroll
                for (int bj = 0; bj < 2; ++bj)
#pragma unroll
                    for (int n = 0; n < 2; ++n) { const int col = u.pn * 256 + bj * 128 + wc * 32 + n * 16 + 4 * fq;
                        const f32x4 g = *(const f32x4*)(ada + b * 6144 + gt_off + col);
                        const f32x4 x = *(const f32x4*)(X + (size_t)row * D + col);
                        *(f32x4*)(out + (size_t)row * D + col) = x + g * acc[ai][bj][m][n]; } }
    }
};
struct PgRgu {
    static constexpr bool PERM = false, AFTER_DRAIN = false;
    float* logits; bf16_t* act;
    __device__ __forceinline__ void operator()(const f32x4 (&acc)[2][2][4][2], const pg8::Unit& u, int wr, int wc, int fr, int fq) const {
#pragma unroll
        for (int ai = 0; ai < 2; ++ai)
#pragma unroll
            for (int m = 0; m < 4; ++m) { const int row = u.pm * 256 + ai * 128 + wr * 64 + m * 16 + fr;
#pragma unroll
                for (int bj = 0; bj < 2; ++bj) {
                    if (u.pn == 0) {
#pragma unroll
                        for (int n = 0; n < 2; ++n) *(f32x4*)(logits + (size_t)row * 256 + bj * 128 + wc * 32 + n * 16 + 4 * fq) = acc[ai][bj][m][n];
                    } else {
                        const int j = ((u.pn - 1) * 256 + bj * 128 + wc * 32) >> 5;
                        *(u32x2*)(act + (size_t)row * 256 + j * 16 + 4 * fq) = pack_swiglu(acc[ai][bj][m][0], acc[ai][bj][m][1]);
                    }
                } }
    }
};

__device__ __forceinline__ int xcd_remap(int L, int nwg) { const int q = nwg >> 3, r = nwg & 7, x = L & 7, off = L >> 3; return (x < r ? x * (q + 1) : r * (q + 1) + (x - r) * q) + off; }
__global__ void __launch_bounds__(NT, 2) fwd_kernel(Params p) {
    extern __shared__ __attribute__((aligned(16))) unsigned char lds_raw[];
    LAS unsigned char* lds = (LAS unsigned char*)lds_raw;
    const int G = gridDim.x, bid = blockIdx.x, ngw = G * NWAVES;
#define FRESH_IDS() const int tid = fresh_tid(), lane = tid & 63, wid = tid >> 6, gw = bid * NWAVES + wid; (void)lane; (void)gw
    { const int tid = fresh_tid(); volatile LAS unsigned* bst0 = (volatile LAS unsigned*)(lds + LDS_BYTES - 64); if (tid < 2) bst0[tid] = 0u; }
    unsigned char* ws = p.ws;
    const float* ada = (const float*)(ws + WS_ADA);
    volatile LAS unsigned* bst = (volatile LAS unsigned*)(lds + LDS_BYTES - 64);
    __syncthreads();
    const XcdBarrier xbar = xcd_barrier_post((unsigned*)(ws + WS_CTL + 4096), bst);
    int ts_n = 0;
#if DBG_STAGE == 2
#define TSTAMP() do { if (bid == 0 && threadIdx.x == 0) ((unsigned long long*)(ws + WS_CTL + 16384 + 8192))[ts_n] = __builtin_amdgcn_s_memrealtime(); ++ts_n; } while (0)
#else
#define TSTAMP() do { } while (0)
#endif
    TSTAMP();

    {
        FRESH_IDS();
        const bool split = G > 128;
        if (!split || bid < 96) for (int u = bid; u < 96; u += G) ada_unit(p, lds, u, tid);
        if (!split || bid >= 96) {
            LAS float* scr = (LAS float*)(lds + wid * 8448);
            const int cg0 = split ? (bid - 96) * NWAVES + wid : gw, cgn = split ? (G - 96) * NWAVES : ngw;
            constexpr int I0 = 16 * 70, I1 = I0 + 6 * 24, I2 = I1 + 4 * 32, I3 = I2 + 32, I4 = I3 + 32, I5 = I4 + 16 * 32, I6 = I5 + 16 * 8, I7 = I6 + 16 * 8, I8 = I7 + 16 * 8, I9 = I8 + 4 * 32;
            for (int it = cg0; it < I9; it += cgn) {
                if (it < I0) conv_item<0>(p.in[6], 1024, IN_DIM, (bf16_t*)(ws + WS_WIN), 0, 0, scr, it, lane);
                else if (it < I1) conv_item<0>(p.in[8], QLORA, 768, (bf16_t*)(ws + WS_WUQ), 0, 0, scr, it - I0, lane);
                else if (it < I2) conv_item<0>(p.in[10], KVLORA, 1024, (bf16_t*)(ws + WS_WUKV), 0, 0, scr, it - I1, lane);
                else if (it < I3) conv_item<0>(p.in[16], 128, 128, (bf16_t*)(ws + WS_WMQK), 256 * 128, 0, scr, it - I2, lane);
                else if (it < I4) conv_item<0>(p.in[17], 128, 128, (bf16_t*)(ws + WS_WMQK), 256 * 128, 128, scr, it - I3, lane);
                else if (it < I5) conv_item<0>(p.in[21], 1024, 1024, (bf16_t*)(ws + WS_WOUT), 0, 0, scr, it - I4, lane);
                else if (it < I6) conv_item<0>(p.in[23], 1024, 256, (bf16_t*)(ws + WS_WRGU), 0, 0, scr, it - I5, lane);
                else if (it < I7) conv_item<1>(p.in[28], 1024, 256, (bf16_t*)(ws + WS_WRGU), 0, 256, scr, it - I6, lane);
                else if (it < I8) conv_item<2>(p.in[29], 1024, 256, (bf16_t*)(ws + WS_WRGU), 0, 256, scr, it - I7, lane);
                else conv_item<0>(p.in[30], 256, 1024, (bf16_t*)(ws + WS_WDSH), 0, 0, scr, it - I8, lane);
            }
            u32x4* zp = (u32x4*)((bf16_t*)(ws + WS_WIN) + (size_t)IN_DIM * 1024);
            const int zt0 = split ? (bid - 96) * NT + tid : bid * NT + tid, ztn = split ? (G - 96) * NT : G * NT;
            for (int i = zt0; i < (2304 - IN_DIM) * 1024 / 8; i += ztn) zp[i] = (u32x4){0u, 0u, 0u, 0u};
        }
    }
    xcd_barrier(xbar); TSTAMP();
    { FRESH_IDS(); norm_mod_rows(p.in[0], p.in[5], ada, 0, 1024, (bf16_t*)(ws + B_H1), gw, ngw, lane); }
    xcd_barrier(xbar); TSTAMP();
    {
        const pg8::Gemm g{(const bf16_t*)(ws + B_H1), (const bf16_t*)(ws + WS_WIN), T, 2304, 1024, 1024, 1024, 0};
        pg8::StaticOrder SO; SO.init(T, 2304, G, bid);
        const PgProj E{(bf16_t*)(ws + B_PROJ), (float*)(ws + B_GRAW)};
        pg8::gemm_phase<PgProj, pg8::StaticOrder, true, true>(lds, g, SO, E);
    }
    xcd_barrier(xbar); TSTAMP();
    { FRESH_IDS(); post_proj_rows(p, gw, ngw, lane); }
    xcd_barrier(xbar); TSTAMP();
    {
        {   const pg8::Gemm g{(const bf16_t*)(ws + B_CQN), (const bf16_t*)(ws + WS_WUQ), T, 768, QLORA, QLORA, QLORA, 0};
            pg8::StaticOrder SO; SO.init(T, 768, G, bid); const PgBf16 E{(bf16_t*)(ws + B_QRAW), 768};
            pg8::gemm_phase<PgBf16, pg8::StaticOrder, true, true>(lds, g, SO, E); }
        {   const pg8::Gemm g{(const bf16_t*)(ws + B_CKVN), (const bf16_t*)(ws + WS_WUKV), T, 1024, KVLORA, KVLORA, KVLORA, 0};
            pg8::StaticOrder SO; SO.init(T, 1024, G, bid); const PgBf16 E{(bf16_t*)(ws + B_KVRAW), 1024};
            pg8::gemm_phase<PgBf16, pg8::StaticOrder, true, true>(lds, g, SO, E); }
        {   const pg8::Gemm g{(const bf16_t*)(ws + B_ZC), (const bf16_t*)(ws + WS_WMQK), T, 1024, DM, MINNER, DM, DM};
            pg8::StaticOrder SO; SO.init(T, 1024, G, bid); const PgMqk E{(bf16_t*)(ws + B_MQ), (bf16_t*)(ws + B_MK)};
            pg8::gemm_phase<PgMqk, pg8::StaticOrder, true, true>(lds, g, SO, E); }
    }
    xcd_barrier(xbar); TSTAMP();
    { FRESH_IDS(); qk_post_rows(p, gw, ngw, lane); }
    xcd_barrier(xbar); TSTAMP();
    for (int pr = bid; pr < 256; pr += G) { const int bh = pr & 63, j = pr >> 6; attn_unit(p, lds, bh, 7 - j); attn_unit(p, lds, bh, j); }
    for (int u = bid; u < 1024; u += G) mlstm_a_unit(p, lds, u);
    xcd_barrier(xbar); TSTAMP();
    { FRESH_IDS(); mlstm_scan(p, bid * NT + tid, G * NT); }
    { FRESH_IDS(); attn_out_norm_rows(p, gw, ngw, lane); }
    xcd_barrier(xbar); TSTAMP();
    for (int u = bid; u < 1024; u += G) mlstm_c_unit(p, lds, u);
    xcd_barrier(xbar); TSTAMP();
    {
        const pg8::Gemm g{(const bf16_t*)(ws + B_AO), (const bf16_t*)(ws + WS_WOUT), T, 1024, 1024, 1024, 1024, 0};
        pg8::StaticOrder SO; SO.init(T, 1024, G, bid); const PgResid E{p.in[0], ada, 2048, p.out};
        pg8::gemm_phase<PgResid, pg8::StaticOrder, true, true>(lds, g, SO, E);
    }
    xcd_barrier(xbar); TSTAMP();
    { FRESH_IDS(); norm_mod_rows(p.out, p.in[22], ada, 3072, 4096, (bf16_t*)(ws + C_H2), gw, ngw, lane, ws + C_H2F8); }
    xcd_barrier(xbar); TSTAMP();
    {
        const pg8::Gemm g{(const bf16_t*)(ws + C_H2), (const bf16_t*)(ws + WS_WRGU), T, 768, 1024, 1024, 1024, 0};
        pg8::StaticOrder SO; SO.init(T, 768, G, bid); const PgRgu E{(float*)(ws + C_LOGITS), (bf16_t*)(ws + C_ACTSH)};
        pg8::gemm_phase<PgRgu, pg8::StaticOrder, true, true>(lds, g, SO, E);
    }
    xcd_barrier(xbar); TSTAMP();
    { FRESH_IDS(); route_rows(p, gw, ngw, lane); }
    {
        const pg8::Gemm g{(const bf16_t*)(ws + C_ACTSH), (const bf16_t*)(ws + WS_WDSH), T, 1024, 256, 256, 256, 0};
        pg8::StaticOrder SO; SO.init(T, 1024, G, bid); const PgBf16 E{(bf16_t*)(ws + C_SHOUT), 1024};
        pg8::gemm_phase<PgBf16, pg8::StaticOrder, true, true>(lds, g, SO, E);
    }
    xcd_barrier(xbar); TSTAMP();
    LAS int* base = (LAS int*)(lds + 132 * 1024);
    LAS int* tsx = base + 256;
    const int ngrp = (G % 8 == 0) ? 8 : 1, gx = bid % ngrp, gidx = bid / ngrp, gper = G / ngrp, nexp = NE / ngrp;
    { FRESH_IDS(); expert_prefix(p, base, tsx, tid, gx, ngrp); }
    {
        const int* cnt = (const int*)(ws + WS_CNT);
        const int ntile = tsx[nexp];
        for (int u = gidx; u < ntile * 4; u += gper) {
            const int tg = u >> 2, tn = u & 3;
            int lo = 0, hi = nexp - 1;
            while (lo < hi) { const int mid = (lo + hi + 1) >> 1; if (tsx[mid] <= tg) lo = mid; else hi = mid - 1; }
            const int e = gx + ngrp * lo, blk = tg - tsx[lo], c = __hip_atomic_load(cnt + e * CNT_STRIDE, __ATOMIC_RELAXED, __HIP_MEMORY_SCOPE_AGENT);
            const int nvalid = min(256, c - blk * 256);
            const RowGather RP{(const unsigned char*)(ws + C_H2F8), (const int*)(ws + C_LISTTOK) + (size_t)e * CAP + blk * 256, nvalid};
            const ColGU CP{p.in[25] + (size_t)e * 1024 * 256, p.in[26] - p.in[25]};
            const EpiExpAct E{(unsigned char*)(ws + C_ACTE), base[e] + blk * 256, nvalid};
            gemm2_tile(lds, RP, CP, 256, 1024, 0, tn * 128, E, nvalid);
        }
    }
    xcd_barrier(xbar); TSTAMP();
    {
        const int* cnt = (const int*)(ws + WS_CNT);
        const int ntile = tsx[nexp];
        for (int u = gidx; u < ntile * 8; u += gper) {
            const int tg = u >> 3, tn = u & 7;
            int lo = 0, hi = nexp - 1;
            while (lo < hi) { const int mid = (lo + hi + 1) >> 1; if (tsx[mid] <= tg) lo = mid; else hi = mid - 1; }
            const int e = gx + ngrp * lo, blk = tg - tsx[lo], c = __hip_atomic_load(cnt + e * CNT_STRIDE, __ATOMIC_RELAXED, __HIP_MEMORY_SCOPE_AGENT);
            const int nvalid = min(256, c - blk * 256);
            const int slot0 = base[e] + blk * 256;
            const RowSlots RP{(const unsigned char*)(ws + C_ACTE) + (size_t)slot0 * EDIM, nvalid};
            const ColDense CP{p.in[27] + (size_t)e * 256 * 1024, 1024};
            const EpiExpDown E{(unsigned char*)(ws + C_Y), (const float*)(ws + C_LISTW) + (size_t)e * CAP + blk * 256, slot0, nvalid};
            gemm2_tile(lds, RP, CP, 1024, 256, 0, tn * 128, E, nvalid);
        }
    }
    xcd_barrier(xbar); TSTAMP();
    { FRESH_IDS(); combine_rows(p, base, gw, ngw, lane); }
#if DBG_STAGE == 2
    xcd_barrier(xbar); TSTAMP();
    xcd_barrier(xbar);
    {   FRESH_IDS();
        const unsigned long long* ts = (const unsigned long long*)(ws + WS_CTL + 16384 + 8192);
        const float tus = (float)(long long)(ts[TS_A1] - ts[TS_A0]) * 0.01f;
        const float cadd = sqrtf(2.5e-3f * tus * (1.f / 500.f));
        for (size_t i = (size_t)bid * NT + tid; i < (size_t)T * D / 4; i += (size_t)G * NT) { f32x4 v = ((f32x4*)p.out)[i]; v = v + cadd; ((f32x4*)p.out)[i] = v; }
    }
#endif
}

extern "C" void kernel_launch(void* const* d_in, const int* in_sizes, int n_in,
                              void* d_out, int out_size, void* d_ws, size_t ws_size,
                              hipStream_t stream) {
    static int grid_blocks = 0;
    if (!grid_blocks) {
        if (n_in != 31 || out_size != T * D || ws_size < WS_END) { fprintf(stderr, "kernel_launch: unexpected shapes n_in=%d out=%d ws=%zu (need %zu)\n", n_in, out_size, ws_size, (size_t)WS_END); grid_blocks = -1; return; }
        int dev = 0, cus = 0, per_cu = 0;
        (void)hipGetDevice(&dev);
        (void)hipDeviceGetAttribute(&cus, hipDeviceAttributeMultiprocessorCount, dev);
        (void)hipFuncSetAttribute((const void*)fwd_kernel, hipFuncAttributeMaxDynamicSharedMemorySize, LDS_BYTES);
        (void)hipOccupancyMaxActiveBlocksPerMultiprocessor(&per_cu, (const void*)fwd_kernel, NT, LDS_BYTES);
        if (per_cu < 1) per_cu = 1;
        grid_blocks = cus * per_cu;
        fprintf(stderr, "kernel_launch: cus=%d per_cu=%d grid=%d ws=%zu\n", cus, per_cu, grid_blocks, ws_size);
    }
    if (grid_blocks < 0) return;
    (void)hipMemsetAsync((char*)d_ws + WS_CTL, 0, CTL_BYTES, stream);
    Params p{};
    for (int i = 0; i < 31; ++i) p.in[i] = (const float*)d_in[i];
    p.out = (float*)d_out; p.ws = (unsigned char*)d_ws;
    void* args[] = {&p};
    hipError_t e = hipLaunchCooperativeKernel((const void*)fwd_kernel, dim3(grid_blocks), dim3(NT), args, LDS_BYTES, stream);
    if (e != hipSuccess) fprintf(stderr, "cooperative launch failed: %s (grid %d)\n", hipGetErrorString(e), grid_blocks);
}
```

```cpp
#include <hip/hip_runtime.h>
#include <hip/hip_cooperative_groups.h>
#include <cstdio>
#include <cstdint>
namespace cg = cooperative_groups;
#ifndef DBG_STAGE
#define DBG_STAGE 0
#endif
#define TS_A0 2
#define TS_A1 3
#define TS_B0 2
#define TS_B1 3

#define LAS __attribute__((address_space(3)))
typedef unsigned short bf16_t;
typedef short bf16x8 __attribute__((ext_vector_type(8)));
typedef short bf16x4 __attribute__((ext_vector_type(4)));
typedef float f32x4 __attribute__((ext_vector_type(4)));
typedef float f32x2 __attribute__((ext_vector_type(2)));
typedef unsigned u32x4 __attribute__((ext_vector_type(4)));
typedef unsigned u32x2 __attribute__((ext_vector_type(2)));

constexpr int NT = 512, NWAVES = 8;
constexpr int LDS_BYTES = 144 * 1024;
constexpr int Bsz = 8, S = 2048, D = 1024, T = Bsz * S;
constexpr int H_MLA = 8, DQK = 96, DNOPE = 64, DROPE = 32, DV = 64, QLORA = 384, KVLORA = 256;
constexpr int H_ML = 4, DM = 128, MINNER = 512, CHUNK = 64, NCH = S / CHUNK;
constexpr int IN_DIM = 2216;
constexpr int OFF_CQ = 0, OFF_CKV = 384, OFF_KR = 640, OFF_Z = 672, OFF_MV = 1184, OFF_MO = 1696, OFF_GATE = 2208;
constexpr int NE = 256, TOPK = 8, EDIM = 256, SDIM = 256;
constexpr int CAP = T;
constexpr float RMS_EPS = 1e-6f;

constexpr size_t MiB = 1u << 20;
constexpr size_t WS_CTL = 0;
constexpr size_t CTL_BYTES = 65536;
constexpr size_t WS_CNT = 32768;
constexpr int CNT_STRIDE = 32;
constexpr size_t WS_ADA = 1 * MiB;
constexpr size_t WS_BC = 2 * MiB;
constexpr size_t WS_MLOC = WS_BC + 8192;
constexpr size_t WS_MPREV = WS_BC + 16384;
constexpr size_t WS_DN = 2 * MiB + 512 * 1024;
constexpr size_t WS_NPREV = 3 * MiB;
constexpr size_t WS_WIN = 4 * MiB;
constexpr size_t WS_WUQ = 9 * MiB;
constexpr size_t WS_WUKV = 10 * MiB;
constexpr size_t WS_WMQK = 11 * MiB;
constexpr size_t WS_WOUT = 12 * MiB;
constexpr size_t WS_WRGU = 14 * MiB;
constexpr size_t WS_WDSH = 16 * MiB;
constexpr size_t WS_WGU = 32 * MiB;
constexpr size_t WS_WD = 288 * MiB;
constexpr size_t RB = 416 * MiB;
constexpr size_t B_PROJ = RB;
constexpr size_t B_GRAW = RB + 70 * MiB;
constexpr size_t B_GL = RB + 71 * MiB;
constexpr size_t B_H1 = RB + 72 * MiB;
constexpr size_t B_CQN = RB + 104 * MiB;
constexpr size_t B_CKVN = RB + 116 * MiB;
constexpr size_t B_ZC = RB + 124 * MiB;
constexpr size_t B_QRAW = RB + 140 * MiB;
constexpr size_t B_KVRAW = RB + 164 * MiB;
constexpr size_t B_MQ = RB + 196 * MiB;
constexpr size_t B_MK = RB + 212 * MiB;
constexpr size_t B_Q = RB + 228 * MiB;
constexpr size_t B_K = RB + 252 * MiB;
constexpr size_t B_ORAW = RB + 276 * MiB;
constexpr size_t B_AO = RB + 292 * MiB;
constexpr size_t B_DC = RB + 324 * MiB;
constexpr size_t B_CPREV = RB + 388 * MiB;
constexpr size_t C_H2 = RB;
constexpr size_t C_LOGITS = RB + 32 * MiB;
constexpr size_t C_ACTSH = RB + 48 * MiB;
constexpr size_t C_SHOUT = RB + 56 * MiB;
constexpr size_t C_TOKE = RB + 88 * MiB;
constexpr size_t C_TOKW = RB + 89 * MiB;
constexpr size_t C_TOKPOS = RB + 90 * MiB;
constexpr size_t C_LISTTOK = RB + 92 * MiB;
constexpr size_t C_LISTW = RB + 108 * MiB;
constexpr size_t C_ACTE = RB + 124 * MiB;
constexpr size_t C_Y = RB + 188 * MiB;
constexpr size_t C_H2F8 = RB + 320 * MiB;
constexpr size_t C_X1 = RB + 340 * MiB;
constexpr size_t WS_END = RB + 444 * MiB;

struct Params {
    const float* in[31];
    float* out;
    unsigned char* ws;
};

typedef __bf16 bf16x2v __attribute__((ext_vector_type(2)));
__device__ __forceinline__ unsigned cvt_pk_bf16(float lo, float hi) { f32x2 v = {lo, hi}; bf16x2v b = __builtin_convertvector(v, bf16x2v); return __builtin_bit_cast(unsigned, b); }
__device__ __forceinline__ unsigned pk4_fp8(float a, float b, float c, float d) { int p = __builtin_amdgcn_cvt_pk_fp8_f32(a, b, 0, false); p = __builtin_amdgcn_cvt_pk_fp8_f32(c, d, p, true); return (unsigned)p; }
__device__ __forceinline__ float bf2f(unsigned short b) { return __uint_as_float((unsigned)b << 16); }
__device__ __forceinline__ float bflo(unsigned u) { return __uint_as_float(u << 16); }
__device__ __forceinline__ float bfhi(unsigned u) { return __uint_as_float(u & 0xffff0000u); }
__device__ __forceinline__ float wave_sum(float v) {
#pragma unroll
    for (int o = 1; o < 64; o <<= 1) v += __shfl_xor(v, o);
    return v;
}
__device__ __forceinline__ float wave_max(float v) {
#pragma unroll
    for (int o = 1; o < 64; o <<= 1) v = fmaxf(v, __shfl_xor(v, o));
    return v;
}
__device__ __forceinline__ float sigmoidf_(float x) { return __builtin_amdgcn_rcpf(1.f + __builtin_amdgcn_exp2f(-1.4426950408889634f * x)); }
__device__ __forceinline__ float siluf_(float x) { return x * __builtin_amdgcn_rcpf(1.f + __builtin_amdgcn_exp2f(-1.4426950408889634f * x)); }
__device__ __forceinline__ int fresh_tid() { int t = threadIdx.x; asm volatile("" : "+v"(t)); return t; }
#define MFMA16(a, b, c) __builtin_amdgcn_mfma_f32_16x16x32_bf16((a), (b), (c), 0, 0, 0)


#define XB_TMO      128
#define XB_XCNT(j)  (256  + 64 * (j))
#define XB_XSUB(j)  (1280 + 64 * (j))
#define XB_XGEN(j)  (2304 + 64 * (j))
#define XB_TOP      3328
#define XB_TOPGEN   3392
#define XCD_BAR_WORDS 3456
#define XB_SPIN_CAP (1u << 23)
__device__ __forceinline__ unsigned xb_ld(unsigned* p)              { return __hip_atomic_load(p, __ATOMIC_RELAXED, __HIP_MEMORY_SCOPE_AGENT); }
__device__ __forceinline__ unsigned xb_add(unsigned* p, unsigned v) { return __hip_atomic_fetch_add(p, v, __ATOMIC_RELAXED, __HIP_MEMORY_SCOPE_AGENT); }
__device__ __forceinline__ unsigned xb_xcc_id() { return (unsigned)__builtin_amdgcn_s_getreg((3 << 11) | 20) & 0xFu; }
#define XB_SPIN(cond, bar) do { unsigned _sp = 0; while (cond) { __builtin_amdgcn_s_sleep(1); \
    if ((++_sp & 255u) == 0u) { if (xb_ld(&(bar)[XB_TMO])) break; if (_sp > XB_SPIN_CAP) { atomicAdd(&(bar)[XB_TMO], 1u); break; } } } } while (0)
struct XcdBarrier { unsigned* bar; unsigned x; volatile LAS unsigned* st; };
__device__ __forceinline__ XcdBarrier xcd_barrier_post(unsigned* bar, volatile LAS unsigned* st) {
    XcdBarrier b; b.bar = bar; b.x = xb_xcc_id(); b.st = st;
    if (threadIdx.x == 0) (void)xb_add(&bar[XB_XCNT(b.x)], 1u);
    return b;
}
__device__ __forceinline__ void xcd_barrier_complete(unsigned* bar, unsigned x, unsigned& nloc, unsigned& nx) {
    const unsigned G = gridDim.x * gridDim.y * gridDim.z;
    unsigned sum, cnt, mine, sp = 0u;
    for (;;) {
        sum = 0u; cnt = 0u; mine = 0u;
#pragma unroll
        for (unsigned j = 0; j < 16; ++j) { const unsigned c = xb_ld(&bar[XB_XCNT(j)]); sum += c; cnt += (c > 0u) ? 1u : 0u; mine = (j == x) ? c : mine; }
        if (sum == G) break;
        __builtin_amdgcn_s_sleep(1);
        if ((++sp & 255u) == 0u) { if (xb_ld(&bar[XB_TMO])) break; if (sp > XB_SPIN_CAP) { atomicAdd(&bar[XB_TMO], 1u); break; } }
    }
    nloc = mine > 0u ? mine : 1u; nx = cnt > 0u ? cnt : 1u;
}
__device__ __forceinline__ void xcd_barrier(const XcdBarrier& b) {
    asm volatile("s_waitcnt vmcnt(0)" ::: "memory");
    __syncthreads();
    if (threadIdx.x == 0) {
        unsigned* bar = b.bar;
        __builtin_amdgcn_s_waitcnt(0);
        unsigned nloc = b.st[0], nx = b.st[1];
        if (nloc == 0u) { xcd_barrier_complete(bar, b.x, nloc, nx); b.st[0] = nloc; b.st[1] = nx; }
        const unsigned old = xb_add(&bar[XB_XSUB(b.x)], 1u);
        const unsigned gen = old / nloc;
        if (old + 1u == (gen + 1u) * nloc) {
            __builtin_amdgcn_fence(__ATOMIC_RELEASE, "agent");
            asm volatile("s_waitcnt vmcnt(0)" ::: "memory");
            const unsigned og = xb_add(&bar[XB_TOP], 1u);
            const unsigned tg = og / nx;
            if (og + 1u == (tg + 1u) * nx) xb_add(&bar[XB_TOPGEN], 1u);
            else XB_SPIN(xb_ld(&bar[XB_TOPGEN]) == tg, bar);
            __builtin_amdgcn_fence(__ATOMIC_ACQUIRE, "agent");
            xb_add(&bar[XB_XGEN(b.x)], 1u);
            asm volatile("s_waitcnt vmcnt(0)" ::: "memory");
        } else {
            XB_SPIN(xb_ld(&bar[XB_XGEN(b.x)]) == gen, bar);
            __builtin_amdgcn_fence(__ATOMIC_ACQUIRE, "agent");
            asm volatile("s_waitcnt vmcnt(0)" ::: "memory");
        }
    }
    __syncthreads();
}

template <int MAP>
__device__ __forceinline__ int map_row(int n) {
    if (MAP == 0) return n;
    if (MAP == 1) return ((n >> 4) << 5) + (n & 15);
    return ((n >> 4) << 5) + 16 + (n & 15);
}
template <int MAP>
__device__ __forceinline__ void conv_item(const float* src, int K, int N, bf16_t* dst, size_t dst_mat_stride, int row_off, LAS float* scr, int it, int lane) {
    const int nblk = (N + 31) / 32, kblk = K / 64, per = nblk * kblk;
    const int mat = it / per, r = it - mat * per, kb = r / nblk, nb = r - kb * nblk, k0 = kb * 64, n0 = nb * 32;
    const float* W = src + (size_t)mat * K * N;
    bf16_t* WT = dst + (size_t)mat * dst_mat_stride;
    const int nn = n0 + (lane & 31);
    const bool nok = nn < N;
    float v[32];
    const float* wp = W + (size_t)(k0 + (lane >> 5)) * N + nn;
#pragma unroll
    for (int i = 0; i < 32; ++i) v[i] = nok ? wp[(size_t)(2 * i) * N] : 0.f;
#pragma unroll
    for (int i = 0; i < 32; ++i) scr[(2 * i + (lane >> 5)) * 33 + (lane & 31)] = v[i];
    asm volatile("s_waitcnt lgkmcnt(0)" ::: "memory");
    const int c = lane & 7;
#pragma unroll
    for (int j = 0; j < 4; ++j) {
        const int n = (lane >> 3) + 8 * j;
        const LAS float* sp = scr + (8 * c) * 33 + n;
        u32x4 o; o.x = cvt_pk_bf16(sp[0 * 33], sp[1 * 33]); o.y = cvt_pk_bf16(sp[2 * 33], sp[3 * 33]); o.z = cvt_pk_bf16(sp[4 * 33], sp[5 * 33]); o.w = cvt_pk_bf16(sp[6 * 33], sp[7 * 33]);
        if (n0 + n < N) *(u32x4*)(WT + (size_t)(row_off + map_row<MAP>(n0 + n)) * K + k0 + 8 * c) = o;
    }
    asm volatile("s_waitcnt lgkmcnt(0)" ::: "memory");
}

__device__ __forceinline__ void ada_unit(const Params& p, LAS unsigned char* lds, int u, int tid) {
    LAS float* cond = (LAS float*)lds;
    LAS float* red = (LAS float*)(lds + 32768);
    const float* c = p.in[1]; const float* w = p.in[3]; const float* bias = p.in[4];
    float* ada = (float*)(p.ws + WS_ADA);
    const int lane = tid & 63, wv = tid >> 6;
    for (int i = tid; i < 8 * 1024; i += NT) cond[i] = siluf_(c[i]);
    __syncthreads();
    float acc[8];
#pragma unroll
    for (int b = 0; b < 8; ++b) acc[b] = 0.f;
    const int col = u * 64 + lane;
#pragma unroll 16
    for (int k = wv * 128; k < wv * 128 + 128; ++k) {
        const float wv_ = w[(size_t)k * 6144 + col];
#pragma unroll
        for (int b = 0; b < 8; ++b) acc[b] += cond[b * 1024 + k] * wv_;
    }
#pragma unroll
    for (int b = 0; b < 8; ++b) red[(wv * 8 + b) * 64 + lane] = acc[b];
    __syncthreads();
    {
        const int b = tid >> 6;
        float s = 0.f;
#pragma unroll
        for (int w2 = 0; w2 < 8; ++w2) s += red[(w2 * 8 + b) * 64 + lane];
        ada[b * 6144 + col] = s + bias[col];
    }
    __syncthreads();
}

__device__ __forceinline__ void norm_mod_rows_bf(const bf16_t* X, const float* g, const float* ada, int sh_off, int sc_off, bf16_t* Hout, int gw, int ngw, int lane, unsigned char* H8) {
    u32x2 nx[4];
    if (gw < T) {
#pragma unroll
        for (int j = 0; j < 4; ++j) nx[j] = *((const u32x2*)(X + (size_t)gw * D) + lane + 64 * j);
    }
    f32x4 gg[4];
#pragma unroll
    for (int j = 0; j < 4; ++j) gg[j] = *(const f32x4*)(g + 4 * (lane + 64 * j));
    for (int row = gw; row < T; row += ngw) {
        const int b = row / S;
        f32x4 v[4]; float ss = 0.f;
#pragma unroll
        for (int j = 0; j < 4; ++j) { v[j].x = bflo(nx[j].x); v[j].y = bfhi(nx[j].x); v[j].z = bflo(nx[j].y); v[j].w = bfhi(nx[j].y); }
        if (row + ngw < T) {
#pragma unroll
            for (int j = 0; j < 4; ++j) nx[j] = *((const u32x2*)(X + (size_t)(row + ngw) * D) + lane + 64 * j);
        }
        f32x4 sc[4], sh[4];
#pragma unroll
        for (int j = 0; j < 4; ++j) { const int k = 4 * (lane + 64 * j);
            sc[j] = *(const f32x4*)(ada + b * 6144 + sc_off + k); sh[j] = *(const f32x4*)(ada + b * 6144 + sh_off + k); }
#pragma unroll
        for (int j = 0; j < 4; ++j) ss += v[j].x * v[j].x + v[j].y * v[j].y + v[j].z * v[j].z + v[j].w * v[j].w;
        const float rinv = rsqrtf(wave_sum(ss) * (1.f / D) + RMS_EPS);
        u32x2* o = (u32x2*)(Hout + (size_t)row * D) + lane;
#pragma unroll
        for (int j = 0; j < 4; ++j) {
            const f32x4 h = v[j] * rinv * gg[j] * (1.f + sc[j]) + sh[j];
            u32x2 w; w.x = cvt_pk_bf16(h.x, h.y); w.y = cvt_pk_bf16(h.z, h.w);
            o[64 * j] = w;
            *((unsigned*)(H8 + (size_t)row * D) + lane + 64 * j) = pk4_fp8(h.x, h.y, h.z, h.w);
        }
    }
}
__device__ __forceinline__ void norm_mod_rows(const float* X, const float* g, const float* ada, int sh_off, int sc_off, bf16_t* Hout, int gw, int ngw, int lane, unsigned char* H8 = nullptr) {
    f32x4 nx[4];
    if (gw < T) {
#pragma unroll
        for (int j = 0; j < 4; ++j) nx[j] = *((const f32x4*)(X + (size_t)gw * D) + lane + 64 * j);
    }
    f32x4 gg[4];
#pragma unroll
    for (int j = 0; j < 4; ++j) gg[j] = *(const f32x4*)(g + 4 * (lane + 64 * j));
    for (int row = gw; row < T; row += ngw) {
        const int b = row / S;
        f32x4 v[4]; float ss = 0.f;
#pragma unroll
        for (int j = 0; j < 4; ++j) v[j] = nx[j];
        if (row + ngw < T) {
#pragma unroll
            for (int j = 0; j < 4; ++j) nx[j] = *((const f32x4*)(X + (size_t)(row + ngw) * D) + lane + 64 * j);
        }
        f32x4 sc[4], sh[4];
#pragma unroll
        for (int j = 0; j < 4; ++j) { const int k = 4 * (lane + 64 * j);
            sc[j] = *(const f32x4*)(ada + b * 6144 + sc_off + k); sh[j] = *(const f32x4*)(ada + b * 6144 + sh_off + k); }
#pragma unroll
        for (int j = 0; j < 4; ++j) ss += v[j].x * v[j].x + v[j].y * v[j].y + v[j].z * v[j].z + v[j].w * v[j].w;
        const float rinv = rsqrtf(wave_sum(ss) * (1.f / D) + RMS_EPS);
        u32x2* o = (u32x2*)(Hout + (size_t)row * D) + lane;
#pragma unroll
        for (int j = 0; j < 4; ++j) {
            const f32x4 h = v[j] * rinv * gg[j] * (1.f + sc[j]) + sh[j];
            u32x2 w; w.x = cvt_pk_bf16(h.x, h.y); w.y = cvt_pk_bf16(h.z, h.w);
            o[64 * j] = w;
            if (H8) *((unsigned*)(H8 + (size_t)row * D) + lane + 64 * j) = pk4_fp8(h.x, h.y, h.z, h.w);
        }
    }
}

__device__ __forceinline__ void post_proj_rows(const Params& p, int gw, int ngw, int lane) {
    const bf16_t* proj = (const bf16_t*)(p.ws + B_PROJ);
    const float* graw = (const float*)(p.ws + B_GRAW);
    float* gl = (float*)(p.ws + B_GL);
    bf16_t* cqn = (bf16_t*)(p.ws + B_CQN); bf16_t* ckvn = (bf16_t*)(p.ws + B_CKVN); bf16_t* zc = (bf16_t*)(p.ws + B_ZC);
    const float* g_cq = p.in[7]; const float* g_ckv = p.in[9]; const float* conv_w = p.in[14]; const float* conv_b = p.in[15];
    const int c0 = lane * 8;
    float gq[6], gk[4], cw[4][8], cbv[8];
#pragma unroll
    for (int j = 0; j < 6; ++j) gq[j] = g_cq[lane * 6 + j];
#pragma unroll
    for (int j = 0; j < 4; ++j) gk[j] = g_ckv[lane * 4 + j];
#pragma unroll
    for (int tap = 0; tap < 4; ++tap)
#pragma unroll
        for (int j = 0; j < 8; ++j) cw[tap][j] = conv_w[tap * MINNER + c0 + j];
#pragma unroll
    for (int j = 0; j < 8; ++j) cbv[j] = conv_b[c0 + j];
    const float gbias = (lane < 4) ? p.in[18][lane] : (lane < 8 ? p.in[19][lane - 4] : 0.f);
    for (int row = gw; row < T; row += ngw) {
        const bf16_t* pr = proj + (size_t)row * IN_DIM;
        const int s = row % S;
        const unsigned* q = (const unsigned*)(pr + OFF_CQ) + lane * 3;
        const unsigned a0 = q[0], a1 = q[1], a2 = q[2];
        const u32x2 kvv = *((const u32x2*)(pr + OFF_CKV) + lane);
        u32x4 z[4];
#pragma unroll
        for (int tap = 0; tap < 4; ++tap) { const int ds = tap - 3; z[tap] = (s + ds >= 0) ? *(const u32x4*)(pr + (ptrdiff_t)ds * IN_DIM + OFF_Z + c0) : (u32x4){0u, 0u, 0u, 0u}; }
        const float gr = (lane < 8) ? graw[(size_t)row * 8 + lane] : 0.f;
        {
            float f[6] = {bflo(a0), bfhi(a0), bflo(a1), bfhi(a1), bflo(a2), bfhi(a2)};
            float ss = 0.f;
#pragma unroll
            for (int j = 0; j < 6; ++j) ss += f[j] * f[j];
            const float rinv = rsqrtf(wave_sum(ss) * (1.f / QLORA) + RMS_EPS);
            unsigned* o = (unsigned*)(cqn + (size_t)row * QLORA) + lane * 3;
            o[0] = cvt_pk_bf16(f[0] * rinv * gq[0], f[1] * rinv * gq[1]);
            o[1] = cvt_pk_bf16(f[2] * rinv * gq[2], f[3] * rinv * gq[3]);
            o[2] = cvt_pk_bf16(f[4] * rinv * gq[4], f[5] * rinv * gq[5]);
        }
        {
            float f[4] = {bflo(kvv.x), bfhi(kvv.x), bflo(kvv.y), bfhi(kvv.y)};
            float ss = f[0] * f[0] + f[1] * f[1] + f[2] * f[2] + f[3] * f[3];
            const float rinv = rsqrtf(wave_sum(ss) * (1.f / KVLORA) + RMS_EPS);
            u32x2 w; w.x = cvt_pk_bf16(f[0] * rinv * gk[0], f[1] * rinv * gk[1]); w.y = cvt_pk_bf16(f[2] * rinv * gk[2], f[3] * rinv * gk[3]);
            *((u32x2*)(ckvn + (size_t)row * KVLORA) + lane) = w;
        }
        {
            float acc[8];
#pragma unroll
            for (int j = 0; j < 8; ++j) acc[j] = cbv[j];
#pragma unroll
            for (int tap = 0; tap < 4; ++tap) {
                acc[0] += bflo(z[tap].x) * cw[tap][0]; acc[1] += bfhi(z[tap].x) * cw[tap][1]; acc[2] += bflo(z[tap].y) * cw[tap][2]; acc[3] += bfhi(z[tap].y) * cw[tap][3];
                acc[4] += bflo(z[tap].z) * cw[tap][4]; acc[5] += bfhi(z[tap].z) * cw[tap][5]; acc[6] += bflo(z[tap].w) * cw[tap][6]; acc[7] += bfhi(z[tap].w) * cw[tap][7];
            }
            u32x4 o; o.x = cvt_pk_bf16(siluf_(acc[0]), siluf_(acc[1])); o.y = cvt_pk_bf16(siluf_(acc[2]), siluf_(acc[3]));
            o.z = cvt_pk_bf16(siluf_(acc[4]), siluf_(acc[5])); o.w = cvt_pk_bf16(siluf_(acc[6]), siluf_(acc[7]));
            *(u32x4*)(zc + (size_t)row * MINNER + c0) = o;
        }
        if (lane < 8) {
            const float xx = gr + gbias;
            gl[(size_t)row * 8 + lane] = (lane < 4) ? xx : (fminf(xx, 0.f) - log1pf(__expf(-fabsf(xx))));
        }
    }
}

__device__ __forceinline__ void qk_post_rows(const Params& p, int gw, int ngw, int lane) {
    const bf16_t* qraw = (const bf16_t*)(p.ws + B_QRAW); const bf16_t* kvraw = (const bf16_t*)(p.ws + B_KVRAW);
    const bf16_t* proj = (const bf16_t*)(p.ws + B_PROJ);
    bf16_t* Q = (bf16_t*)(p.ws + B_Q); bf16_t* Kb = (bf16_t*)(p.ws + B_K);
    const int* positions = (const int*)p.in[2];
    const float* g_qn = p.in[11]; const float* g_kn = p.in[12];
    const float qscale = 0.10206207261596575f * 1.4426950408889634f;
    const int l = lane & 31, hsel = lane >> 5, i = l & 15;
    const float inv_freq = exp2f(-(float)(2 * i) * (13.287712379549449f / 32.f));
    const float gq0 = g_qn[l], gq1 = g_qn[l + 32], gq2 = g_qn[l + 64], gk0 = g_kn[l], gk1 = g_kn[l + 32], gk2 = g_kn[l + 64];
    for (int row = gw; row < T; row += ngw) {
        const int b = row / S, s = row % S;
        float qv[4][3], kv[4][2];
#pragma unroll
        for (int hp = 0; hp < 4; ++hp) {
            const int h = hp * 2 + hsel;
            const bf16_t* qr = qraw + (size_t)row * 768 + h * 96; const bf16_t* kr = kvraw + (size_t)row * 1024 + h * 128;
            qv[hp][0] = bf2f(qr[l]); qv[hp][1] = bf2f(qr[l + 32]); qv[hp][2] = bf2f(qr[l + 64]);
            kv[hp][0] = bf2f(kr[l]); kv[hp][1] = bf2f(kr[l + 32]);
        }
        const float krope = bf2f(proj[(size_t)row * IN_DIM + OFF_KR + l]);
        const float ang = (float)positions[row] * inv_freq;
        const float sn = __sinf(ang), cs = __cosf(ang);
#pragma unroll
        for (int hp = 0; hp < 4; ++hp) {
            const int h = hp * 2 + hsel;
            {
                float v0 = qv[hp][0], v1 = qv[hp][1], v2 = qv[hp][2];
                float ss = v0 * v0 + v1 * v1 + v2 * v2;
#pragma unroll
                for (int o = 1; o < 32; o <<= 1) ss += __shfl_xor(ss, o);
                const float rinv = rsqrtf(ss * (1.f / 96.f) + RMS_EPS);
                v0 *= rinv * gq0; v1 *= rinv * gq1; v2 *= rinv * gq2;
                const float other = __shfl_xor(v2, 16);
                const float r = (l < 16) ? (v2 * cs - other * sn) : (other * sn + v2 * cs);
                bf16_t* qo = Q + ((size_t)(b * H_MLA + h) * S + s) * 96;
                qo[l] = (bf16_t)(cvt_pk_bf16(v0 * qscale, 0.f) & 0xffff);
                qo[l + 32] = (bf16_t)(cvt_pk_bf16(v1 * qscale, 0.f) & 0xffff);
                qo[l + 64] = (bf16_t)(cvt_pk_bf16(r * qscale, 0.f) & 0xffff);
            }
            {
                float v0 = kv[hp][0], v1 = kv[hp][1], v2 = krope;
                float ss = v0 * v0 + v1 * v1 + v2 * v2;
#pragma unroll
                for (int o = 1; o < 32; o <<= 1) ss += __shfl_xor(ss, o);
                const float rinv = rsqrtf(ss * (1.f / 96.f) + RMS_EPS);
                v0 *= rinv * gk0; v1 *= rinv * gk1; v2 *= rinv * gk2;
                const float other = __shfl_xor(v2, 16);
                const float r = (l < 16) ? (v2 * cs - other * sn) : (other * sn + v2 * cs);
                bf16_t* ko = Kb + ((size_t)(b * H_MLA + h) * S + s) * 96;
                ko[l] = (bf16_t)(cvt_pk_bf16(v0, 0.f) & 0xffff);
                ko[l + 32] = (bf16_t)(cvt_pk_bf16(v1, 0.f) & 0xffff);
                ko[l + 64] = (bf16_t)(cvt_pk_bf16(r, 0.f) & 0xffff);
            }
        }
    }
}

__device__ __forceinline__ void attn_out_norm_rows(const Params& p, int gw, int ngw, int lane) {
    const bf16_t* oraw = (const bf16_t*)(p.ws + B_ORAW); bf16_t* ao = (bf16_t*)(p.ws + B_AO); const float* g = p.in[13];
    float gg[8];
#pragma unroll
    for (int j = 0; j < 8; ++j) gg[j] = g[lane * 8 + j];
    for (int row = gw; row < T; row += ngw) {
        const u32x4 a = *((const u32x4*)(oraw + (size_t)row * 512) + lane);
        float f[8] = {bflo(a.x), bfhi(a.x), bflo(a.y), bfhi(a.y), bflo(a.z), bfhi(a.z), bflo(a.w), bfhi(a.w)};
        float ss = 0.f;
#pragma unroll
        for (int j = 0; j < 8; ++j) ss += f[j] * f[j];
        const float rinv = rsqrtf(wave_sum(ss) * (1.f / 512.f) + RMS_EPS);
        u32x4 o; o.x = cvt_pk_bf16(f[0] * rinv * gg[0], f[1] * rinv * gg[1]); o.y = cvt_pk_bf16(f[2] * rinv * gg[2], f[3] * rinv * gg[3]);
        o.z = cvt_pk_bf16(f[4] * rinv * gg[4], f[5] * rinv * gg[5]); o.w = cvt_pk_bf16(f[6] * rinv * gg[6], f[7] * rinv * gg[7]);
        *((u32x4*)(ao + (size_t)row * 1024) + lane) = o;
    }
}

namespace pg8 {
#define PG8_LAS __attribute__((address_space(3)))
typedef unsigned short bf16_t;
typedef short bf16x8 __attribute__((ext_vector_type(8)));
typedef float f32x4 __attribute__((ext_vector_type(4)));
typedef unsigned u32x4 __attribute__((ext_vector_type(4)));
constexpr int BM = 256, BK = 64, HALF = 128, HTB = HALF * BK * 2  , STAGE_BYTES = 8 * HTB, NXCD = 8, WGM = 8;

__host__ __device__ __forceinline__ int lds_byte(int r, int c) { const int st = (r >> 4) * 2 + (c >> 5), rr = r & 15, cc = c & 31, ob = rr * 64 + cc * 2; return st * 1024 + (ob ^ (((ob >> 9) & 1) << 5)); }
__host__ __device__ __forceinline__ void stage_rc(int b, int& R, int& C) { const int st = b / 1024, sb = b % 1024, swz = sb ^ (((sb >> 9) & 1) << 5); R = (st >> 1) * 16 + swz / 64; C = (st & 1) * 32 + (swz % 64) / 2; }
__host__ __device__ __forceinline__ int perm32(int rho) { const int n = rho >> 4, i = rho & 15; return 8 * (i >> 2) + 4 * n + (i & 3); }

struct Unit { int pm, pn; };
struct Gemm { const bf16_t* A; const bf16_t* Bt; int M, N, K, lda, ldb, apn; };

struct StaticOrder {
    int nM, nN, nwg, G, c;
    __host__ __device__ void init(int M, int N, int G_, int c_) { nM = M / BM; nN = N / BM; nwg = nM * nN; G = G_; c = c_; }
    __host__ __device__ bool next(int i, Unit& u) const {
        const long L = (long)i * G + c; if (L >= nwg) return false;
        int wgid = (int)L; { const int q = nwg / NXCD, r = nwg % NXCD, xcd = wgid % NXCD, off = wgid / NXCD; wgid = (xcd < r ? xcd * (q + 1) : r * (q + 1) + (xcd - r) * q) + off; }
        const int nig = WGM * nN, gid = wgid / nig, fm = gid * WGM, gsz = (nM - fm) < WGM ? (nM - fm) : WGM;
        u.pm = fm + ((wgid % nig) % gsz); u.pn = (wgid % nig) / gsz; return true;
    }
    __device__ __forceinline__ void a_ready(const Unit&) const {}
    __device__ __forceinline__ void done(const Unit&) const {}
};


template <class Epi, class Sched, bool ALIGN_EPI = false, bool SP2 = false>
__device__ __forceinline__ void gemm_phase(PG8_LAS unsigned char* lds, const Gemm g, const Sched& S, const Epi& E) {
    const int tid = fresh_tid(), wid = __builtin_amdgcn_readfirstlane(tid >> 6), lane = tid & 63, wr = wid >> 2, wc = wid & 3, fr = lane & 15, fq = lane >> 4;
    const int K = g.K, nt = K / BK;
    unsigned voffA[2], voffB[2];
#pragma unroll
    for (int i = 0; i < 2; ++i) { int R, C; stage_rc(tid * 16 + i * 8192, R, C); const int Rb = Epi::PERM ? ((R & ~31) + perm32(R & 31)) : R;
        voffA[i] = (unsigned)(R * g.lda + C) * 2u; voffB[i] = (unsigned)(Rb * g.ldb + C) * 2u; }
    const size_t kstep = (size_t)(BK * 2);
    const size_t hstepA = (size_t)HALF * g.lda * 2, hstepB = (size_t)HALF * g.ldb * 2;
    const size_t tstepA = 2 * hstepA, tstepB = 2 * hstepB;
    const unsigned ldsw = (unsigned)wid * 1024u;
    const int aoff = lds_byte(wr * 64 + fr, fq * 8), boff = lds_byte(wc * 32 + fr, fq * 8);
#define PG8_SA(b, h) (((b) * 2 + (h)) * HTB)
#define PG8_SB(b, h) ((4 + (b) * 2 + (h)) * HTB)
#define PG8_STAGE(bufoff, gbase, voff) do { _Pragma("unroll") for (int _i = 0; _i < 2; ++_i) \
        __builtin_amdgcn_global_load_lds((const unsigned*)((const char*)(gbase) + (voff)[_i]), (PG8_LAS unsigned*)(lds + (bufoff) + ldsw + _i * 8192), 16, 0, 0); } while (0)
#define PG8_LDA(dst, b, h) do { _Pragma("unroll") for (int m = 0; m < 4; ++m) _Pragma("unroll") for (int k = 0; k < 2; ++k) dst[m][k] = *(const PG8_LAS bf16x8*)(lds + PG8_SA(b, h) + aoff + m * 2048 + k * 1024); } while (0)
#define PG8_LDB(dst, b, h) do { _Pragma("unroll") for (int n = 0; n < 2; ++n) _Pragma("unroll") for (int k = 0; k < 2; ++k) dst[n][k] = *(const PG8_LAS bf16x8*)(lds + PG8_SB(b, h) + boff + n * 2048 + k * 1024); } while (0)
#define PG8_MMA(ai, bj, At, Bt) do { __builtin_amdgcn_s_setprio(1); _Pragma("unroll") for (int m = 0; m < 4; ++m) _Pragma("unroll") for (int n = 0; n < 2; ++n) _Pragma("unroll") for (int k = 0; k < 2; ++k) \
        acc[ai][bj][m][n] = __builtin_amdgcn_mfma_f32_16x16x32_bf16(Bt[n][k], At[m][k], acc[ai][bj][m][n], 0, 0, 0); __builtin_amdgcn_s_setprio(0); } while (0)
#define PG8_WAIT_V(n) asm volatile("s_waitcnt vmcnt(" #n ")" ::: "memory")
#define PG8_WAIT_L(n) asm volatile("s_waitcnt lgkmcnt(" #n ")" ::: "memory")
#define PG8_BAR __builtin_amdgcn_s_barrier()
#define PG8_SCHED __builtin_amdgcn_sched_barrier(0)
    Unit cur, nxt; int ui = 0;
    if (!S.next(0, cur)) return;
    f32x4 acc[2][2][4][2];
#pragma unroll
    for (int a = 0; a < 2; ++a)
#pragma unroll
        for (int b = 0; b < 2; ++b)
#pragma unroll
            for (int m = 0; m < 4; ++m)
#pragma unroll
                for (int n = 0; n < 2; ++n) acc[a][b][m][n] = (f32x4){0.f, 0.f, 0.f, 0.f};
    bf16x8 At[4][2], B0[2][2], B1[2][2];
    const char* cA = (const char*)g.A + (size_t)cur.pm * tstepA + (size_t)cur.pn * g.apn * 2; const char* cB = (const char*)g.Bt + (size_t)cur.pn * tstepB;
    S.a_ready(cur);
    if constexpr (SP2) {
        PG8_STAGE(PG8_SB(0, 0), cB, voffB); PG8_STAGE(PG8_SB(0, 1), cB + hstepB, voffB); PG8_STAGE(PG8_SA(0, 0), cA, voffA); PG8_STAGE(PG8_SA(0, 1), cA + hstepA, voffA);
        if (wr == 1) PG8_BAR;
        PG8_WAIT_V(2); PG8_BAR;
        PG8_STAGE(PG8_SB(1, 0), cB + kstep, voffB); PG8_STAGE(PG8_SA(1, 0), cA + kstep, voffA); PG8_STAGE(PG8_SB(1, 1), cB + hstepB + kstep, voffB);
        PG8_WAIT_V(6); PG8_BAR;
    } else {
        PG8_STAGE(PG8_SB(0, 0), cB, voffB); PG8_STAGE(PG8_SA(0, 0), cA, voffA); PG8_STAGE(PG8_SB(0, 1), cB + hstepB, voffB); PG8_STAGE(PG8_SA(0, 1), cA + hstepA, voffA);
        if (wr == 1) PG8_BAR;
        PG8_WAIT_V(4); PG8_BAR;
        PG8_STAGE(PG8_SB(1, 0), cB + kstep, voffB); PG8_STAGE(PG8_SA(1, 0), cA + kstep, voffA); PG8_STAGE(PG8_SB(1, 1), cB + hstepB + kstep, voffB);
        PG8_WAIT_V(6); PG8_BAR;
    }
    for (;;) {
        const bool has_next = S.next(ui + 1, nxt);
        const char* nA = has_next ? (const char*)g.A + (size_t)nxt.pm * tstepA + (size_t)nxt.pn * g.apn * 2 : cA; const char* nB = has_next ? (const char*)g.Bt + (size_t)nxt.pn * tstepB : cB;
        for (int t = 0; t < nt; t += 2) {
            const bool last = (t == nt - 2);
            const char* a1 = cA + (size_t)(t + 1) * kstep;
            const char* a2 = last ? nA : cA + (size_t)(t + 2) * kstep; const char* b2 = last ? nB : cB + (size_t)(t + 2) * kstep;
            const char* a3 = a2 + kstep; const char* b3 = b2 + kstep;
            if (last && has_next) S.a_ready(nxt);
            if constexpr (SP2) {
            PG8_LDB(B0, 0, 0); PG8_LDB(B1, 0, 1); PG8_SCHED; PG8_LDA(At, 0, 0); PG8_STAGE(PG8_SA(1, 1), a1 + hstepA, voffA);
            PG8_WAIT_V(8); PG8_WAIT_L(0); PG8_BAR; PG8_MMA(0, 0, At, B0); PG8_MMA(0, 1, At, B1); PG8_BAR; PG8_SCHED;
            PG8_LDA(At, 0, 1); PG8_STAGE(PG8_SB(0, 0), b2, voffB); PG8_STAGE(PG8_SB(0, 1), b2 + hstepB, voffB); PG8_STAGE(PG8_SA(0, 0), a2, voffA);
            PG8_WAIT_V(8); PG8_WAIT_L(0); PG8_BAR; PG8_MMA(1, 0, At, B0); PG8_MMA(1, 1, At, B1); PG8_BAR; PG8_SCHED;
            PG8_LDB(B0, 1, 0); PG8_LDB(B1, 1, 1); PG8_SCHED; PG8_LDA(At, 1, 0); PG8_STAGE(PG8_SA(0, 1), a2 + hstepA, voffA);
            PG8_WAIT_V(8); PG8_WAIT_L(0); PG8_BAR; PG8_MMA(0, 0, At, B0); PG8_MMA(0, 1, At, B1); PG8_BAR; PG8_SCHED;
            PG8_LDA(At, 1, 1); PG8_STAGE(PG8_SB(1, 0), b3, voffB); PG8_STAGE(PG8_SB(1, 1), b3 + hstepB, voffB); PG8_STAGE(PG8_SA(1, 0), a3, voffA);
            PG8_WAIT_V(8); PG8_WAIT_L(0); PG8_BAR; PG8_MMA(1, 0, At, B0); PG8_MMA(1, 1, At, B1); PG8_BAR; PG8_SCHED;
            } else {
            PG8_LDB(B0, 0, 0); PG8_SCHED; PG8_LDA(At, 0, 0); PG8_STAGE(PG8_SA(1, 1), a1 + hstepA, voffA);
            PG8_WAIT_L(8); PG8_BAR; PG8_WAIT_L(0); PG8_MMA(0, 0, At, B0); PG8_BAR; PG8_SCHED;
            PG8_LDB(B1, 0, 1); PG8_STAGE(PG8_SB(0, 0), b2, voffB);
            PG8_BAR; PG8_WAIT_L(0); PG8_MMA(0, 1, At, B1); PG8_BAR;
            PG8_LDA(At, 0, 1); PG8_STAGE(PG8_SA(0, 0), a2, voffA);
            PG8_BAR; PG8_WAIT_L(0); PG8_MMA(1, 0, At, B0); PG8_BAR; PG8_SCHED;
            PG8_STAGE(PG8_SB(0, 1), b2 + hstepB, voffB);
            PG8_WAIT_V(6); PG8_BAR; PG8_MMA(1, 1, At, B1); PG8_BAR;
            PG8_LDB(B0, 1, 0); PG8_SCHED; PG8_LDA(At, 1, 0); PG8_STAGE(PG8_SA(0, 1), a2 + hstepA, voffA);
            PG8_WAIT_L(8); PG8_BAR; PG8_WAIT_L(0); PG8_MMA(0, 0, At, B0); PG8_BAR; PG8_SCHED;
            PG8_LDB(B1, 1, 1); PG8_STAGE(PG8_SB(1, 0), b3, voffB);
            PG8_BAR; PG8_WAIT_L(0); PG8_MMA(0, 1, At, B1); PG8_BAR;
            PG8_LDA(At, 1, 1); PG8_STAGE(PG8_SA(1, 0), a3, voffA);
            PG8_BAR; PG8_WAIT_L(0); PG8_MMA(1, 0, At, B0); PG8_BAR; PG8_SCHED;
            PG8_STAGE(PG8_SB(1, 1), b3 + hstepB, voffB);
            PG8_WAIT_V(6); PG8_BAR; PG8_MMA(1, 1, At, B1); PG8_BAR;
            }
        }
        if constexpr (ALIGN_EPI) { if (wr == 0) PG8_BAR; }
        if constexpr (!Epi::AFTER_DRAIN) { E(acc, cur, wr, wc, fr, fq); S.done(cur); }
        if (!has_next) break;
#pragma unroll
        for (int a = 0; a < 2; ++a)
#pragma unroll
            for (int b = 0; b < 2; ++b)
#pragma unroll
                for (int m = 0; m < 4; ++m)
#pragma unroll
                    for (int n = 0; n < 2; ++n) acc[a][b][m][n] = (f32x4){0.f, 0.f, 0.f, 0.f};
        cur = nxt; cA = nA; cB = nB; ++ui;
        if constexpr (ALIGN_EPI) { if (wr == 1) PG8_BAR; }
    }
    PG8_WAIT_V(0);
    if constexpr (!ALIGN_EPI) { if (wr == 0) PG8_BAR; }
    PG8_BAR;
    if constexpr (Epi::AFTER_DRAIN) { E.fused(acc, cur, wr, wc, fr, fq, lds, wid, lane); S.done(cur); }
#undef PG8_SA
#undef PG8_SB
#undef PG8_STAGE
#undef PG8_LDA
#undef PG8_LDB
#undef PG8_MMA
#undef PG8_WAIT_V
#undef PG8_WAIT_L
#undef PG8_BAR
#undef PG8_SCHED
}
}

constexpr int GBK = 128;
constexpr int GLB = GBK + 16;
constexpr int GBS = 1152;
constexpr int G2_AS = 256 * GLB;
constexpr int G2_BS = (GBK / 8) * GBS;
constexpr int G2_STAGE = G2_AS + G2_BS;
typedef long i64_t;
template <class RowPtr, class ColPtr, class Epi>
__device__ __forceinline__ void gemm2_tile(LAS unsigned char* lds, const RowPtr& RP, const ColPtr& CP, int ldk, int K, int m0, int n0, const Epi& E, int mvalid = 256) {
    const int tid = fresh_tid(), lane = tid & 63, wid = tid >> 6, half = wid >> 2, wm = (wid >> 1) & 1, wn = wid & 1;
    const int fr = lane & 15, fq = lane >> 4;
    const int ht = tid & 255;
    const int ac = (ht & 7) * 16, ar0 = half * 128 + (ht >> 3);
    const int bc = half * 64 + 4 * (ht & 15), bg = ht >> 4;
    const int bpos = Epi::PERM ? ((bc & ~63) + (((bc >> 2) & 3) << 4) + (((bc >> 4) & 3) << 2)) : bc;
    const unsigned char* ap0 = RP(m0 + ar0); const unsigned char* ap1 = RP(m0 + ar0 + 32); const unsigned char* ap2 = RP(m0 + ar0 + 64); const unsigned char* ap3 = RP(m0 + ar0 + 96);
    const float* bp = CP(n0 + bc);
    const f32x4 epre = E.pre(m0 + half * 128 + wm * 64, lane);
    f32x4 acc[4][4];
#pragma unroll
    for (int m = 0; m < 4; ++m)
#pragma unroll
        for (int n = 0; n < 4; ++n) acc[m][n] = (f32x4){0.f, 0.f, 0.f, 0.f};
    const u32x4 z4 = (u32x4){0u, 0u, 0u, 0u};
    const f32x4 zf = (f32x4){0.f, 0.f, 0.f, 0.f};
    u32x4 ra[4] = {z4, z4, z4, z4}; f32x4 rb[8] = {zf, zf, zf, zf, zf, zf, zf, zf};
    const int nk = K / GBK;
    const bool docomp = (half == 0) || (mvalid > 128);
#define G2_LOAD(kt_) do { const int k0_ = (kt_) * GBK; \
        ra[0] = ap0 ? *(const u32x4*)(ap0 + k0_ + ac) : z4; ra[1] = ap1 ? *(const u32x4*)(ap1 + k0_ + ac) : z4; \
        ra[2] = ap2 ? *(const u32x4*)(ap2 + k0_ + ac) : z4; ra[3] = ap3 ? *(const u32x4*)(ap3 + k0_ + ac) : z4; \
        const float* q0_ = bp + (size_t)(k0_ + 8 * bg) * ldk; \
        _Pragma("unroll") for (int j_ = 0; j_ < 8; ++j_) rb[j_] = *(const f32x4*)(q0_ + (size_t)j_ * ldk); } while (0)
#define G2_STORE(buf_) do { LAS unsigned char* As_ = lds + (buf_) * G2_STAGE; LAS unsigned char* Bs_ = As_ + G2_AS; \
        _Pragma("unroll") for (int j_ = 0; j_ < 4; ++j_) *(LAS u32x4*)(As_ + (ar0 + 32 * j_) * GLB + ac) = ra[j_]; \
        u32x4 w0_, w1_;     \
        w0_.x = pk4_fp8(rb[0].x, rb[1].x, rb[2].x, rb[3].x); w0_.y = pk4_fp8(rb[4].x, rb[5].x, rb[6].x, rb[7].x); w0_.z = pk4_fp8(rb[0].y, rb[1].y, rb[2].y, rb[3].y); w0_.w = pk4_fp8(rb[4].y, rb[5].y, rb[6].y, rb[7].y); \
        w1_.x = pk4_fp8(rb[0].z, rb[1].z, rb[2].z, rb[3].z); w1_.y = pk4_fp8(rb[4].z, rb[5].z, rb[6].z, rb[7].z); w1_.z = pk4_fp8(rb[0].w, rb[1].w, rb[2].w, rb[3].w); w1_.w = pk4_fp8(rb[4].w, rb[5].w, rb[6].w, rb[7].w); \
        *(LAS u32x4*)(Bs_ + bg * GBS + bpos * 8) = w0_; *(LAS u32x4*)(Bs_ + bg * GBS + bpos * 8 + 16) = w1_; } while (0)
#define G2_FRAGS(af_, bf_, ks_) do { \
        _Pragma("unroll") for (int m_ = 0; m_ < 4; ++m_) af_[m_] = *(const LAS i64_t*)(As_ + (m_ * 16 + fr) * GLB + (ks_) * 32 + fq * 8); \
        _Pragma("unroll") for (int n_ = 0; n_ < 4; ++n_) bf_[n_] = *(const LAS i64_t*)(Bs_ + ((ks_) * 4 + fq) * GBS + (n_ * 16) * 8); } while (0)
#define G2_MMA(af_, bf_) do { \
        _Pragma("unroll") for (int m_ = 0; m_ < 4; ++m_) _Pragma("unroll") for (int n_ = 0; n_ < 4; ++n_) acc[m_][n_] = __builtin_amdgcn_mfma_f32_16x16x32_fp8_fp8(bf_[n_], af_[m_], acc[m_][n_], 0, 0, 0); } while (0)
#define G2_COMPUTE(buf_) do { const LAS unsigned char* As_ = lds + (buf_) * G2_STAGE + (half * 128 + wm * 64) * GLB; const LAS unsigned char* Bs_ = lds + (buf_) * G2_STAGE + G2_AS + (wn * 64 + fr) * 8; \
        i64_t afa_[4], bfa_[4], afb_[4], bfb_[4]; \
        G2_FRAGS(afa_, bfa_, 0); G2_FRAGS(afb_, bfb_, 1); G2_MMA(afa_, bfa_); \
        G2_FRAGS(afa_, bfa_, 2); G2_MMA(afb_, bfb_); \
        G2_FRAGS(afb_, bfb_, 3); G2_MMA(afa_, bfa_); \
        G2_MMA(afb_, bfb_); } while (0)
    G2_LOAD(0);
    G2_STORE(0);
    if (nk > 1) G2_LOAD(1);
    __syncthreads();
#pragma unroll 1
    for (int kt = 0; kt < nk; ++kt) {
        const int cur = kt & 1;
        if (half == 0) { __builtin_amdgcn_s_setprio(1); G2_COMPUTE(cur); __builtin_amdgcn_s_setprio(0); }
        else if (kt + 1 < nk) { G2_STORE(cur ^ 1); if (kt + 2 < nk) G2_LOAD(kt + 2); }
        __syncthreads();
        if (half == 1) { if (docomp) { __builtin_amdgcn_s_setprio(1); G2_COMPUTE(cur); __builtin_amdgcn_s_setprio(0); } }
        else if (kt + 1 < nk) { G2_STORE(cur ^ 1); if (kt + 2 < nk) G2_LOAD(kt + 2); }
        __syncthreads();
    }
#undef G2_LOAD
#undef G2_STORE
#undef G2_COMPUTE
#undef G2_FRAGS
#undef G2_MMA
    E(acc, m0 + half * 128 + wm * 64, n0 + wn * 64, lane, epre);
}

constexpr int DLA = 272;
constexpr int D_AS = 256 * DLA;
__device__ __forceinline__ void expert_down_unit(LAS unsigned char* lds, const unsigned char* act, const float* W  , int nq, unsigned char* y, const float* lw, int slot0, int nvalid) {
    const int tid = fresh_tid(), lane = tid & 63, wid = tid >> 6, half = wid >> 2, wm = (wid >> 1) & 1, wn = wid & 1;
    const int fr = lane & 15, fq = lane >> 4;
    const int ht = tid & 255;
    const int bc = half * 64 + 4 * (ht & 15), bg = ht >> 4;
    const int bpos = (bc & ~63) + (((bc >> 2) & 3) << 4) + (((bc >> 4) & 3) << 2);
    LAS unsigned char* Al = lds;
    LAS unsigned char* Bl = lds + D_AS;
    {
        const int c16 = (tid & 15) * 16, r0 = tid >> 4;
        const u32x4 z4 = (u32x4){0u, 0u, 0u, 0u};
        u32x4 v[8];
#pragma unroll
        for (int j = 0; j < 8; ++j) { const int r = r0 + 32 * j; v[j] = (r < nvalid) ? *(const u32x4*)(act + (size_t)(slot0 + r) * EDIM + c16) : z4; }
#pragma unroll
        for (int j = 0; j < 8; ++j) *(LAS u32x4*)(Al + (r0 + 32 * j) * DLA + c16) = v[j];
    }
    f32x4 acc[4][4];
#pragma unroll
    for (int m = 0; m < 4; ++m)
#pragma unroll
        for (int n = 0; n < 4; ++n) acc[m][n] = (f32x4){0.f, 0.f, 0.f, 0.f};
    f32x4 rb[8];
    const bool docomp = (half == 0) || (nvalid > 128);
    float wrow_[4];
#pragma unroll
    for (int m = 0; m < 4; ++m) { const int r = half * 128 + wm * 64 + m * 16 + fr; wrow_[m] = (r < nvalid) ? lw[r] : 0.f; }
    const float* wbase = W + nq * 512 + bc;
    constexpr int NT_ = 8;
#define D_LOAD(t_) do { const float* q0_ = wbase + ((t_) >> 1) * 128 + (size_t)(((t_) & 1) * 128 + 8 * bg) * 1024; \
        _Pragma("unroll") for (int j_ = 0; j_ < 8; ++j_) rb[j_] = *(const f32x4*)(q0_ + (size_t)j_ * 1024); } while (0)
#define D_STORE(buf_) do { LAS unsigned char* Bs_ = Bl + (buf_) * G2_BS; u32x4 w0_, w1_; \
        w0_.x = pk4_fp8(rb[0].x, rb[1].x, rb[2].x, rb[3].x); w0_.y = pk4_fp8(rb[4].x, rb[5].x, rb[6].x, rb[7].x); w0_.z = pk4_fp8(rb[0].y, rb[1].y, rb[2].y, rb[3].y); w0_.w = pk4_fp8(rb[4].y, rb[5].y, rb[6].y, rb[7].y); \
        w1_.x = pk4_fp8(rb[0].z, rb[1].z, rb[2].z, rb[3].z); w1_.y = pk4_fp8(rb[4].z, rb[5].z, rb[6].z, rb[7].z); w1_.z = pk4_fp8(rb[0].w, rb[1].w, rb[2].w, rb[3].w); w1_.w = pk4_fp8(rb[4].w, rb[5].w, rb[6].w, rb[7].w); \
        *(LAS u32x4*)(Bs_ + bg * GBS + bpos * 8) = w0_; *(LAS u32x4*)(Bs_ + bg * GBS + bpos * 8 + 16) = w1_; } while (0)
#define D_FRAGS(af_, bf_, ks_) do { \
        _Pragma("unroll") for (int m_ = 0; m_ < 4; ++m_) af_[m_] = *(const LAS i64_t*)(As_ + (m_ * 16 + fr) * DLA + (ks_) * 32 + fq * 8); \
        _Pragma("unroll") for (int n_ = 0; n_ < 4; ++n_) bf_[n_] = *(const LAS i64_t*)(Bs_ + ((ks_) * 4 + fq) * GBS + (n_ * 16) * 8); } while (0)
#define D_MMA(af_, bf_) do { \
        _Pragma("unroll") for (int m_ = 0; m_ < 4; ++m_) _Pragma("unroll") for (int n_ = 0; n_ < 4; ++n_) acc[m_][n_] = __builtin_amdgcn_mfma_f32_16x16x32_fp8_fp8(bf_[n_], af_[m_], acc[m_][n_], 0, 0, 0); } while (0)
#define D_COMPUTE(t_) do { const LAS unsigned char* As_ = Al + (half * 128 + wm * 64) * DLA + ((t_) & 1) * 128; const LAS unsigned char* Bs_ = Bl + ((t_) & 1) * G2_BS + (wn * 64 + fr) * 8; \
        i64_t afa_[4], bfa_[4], afb_[4], bfb_[4]; \
        D_FRAGS(afa_, bfa_, 0); D_FRAGS(afb_, bfb_, 1); D_MMA(afa_, bfa_); \
        D_FRAGS(afa_, bfa_, 2); D_MMA(afb_, bfb_); \
        D_FRAGS(afb_, bfb_, 3); D_MMA(afa_, bfa_); \
        D_MMA(afb_, bfb_); \
        if ((t_) & 1) {     \
            const int cb_ = nq * 512 + ((t_) >> 1) * 128 + wn * 64; \
            _Pragma("unroll") for (int m_ = 0; m_ < 4; ++m_) { const int r_ = half * 128 + wm * 64 + m_ * 16 + fr; \
                if (r_ < nvalid) { const float wt_ = wrow_[m_]; u32x4 w_; \
                    { const f32x4 v_ = acc[m_][0] * wt_; w_.x = pk4_fp8(v_.x, v_.y, v_.z, v_.w); } { const f32x4 v_ = acc[m_][1] * wt_; w_.y = pk4_fp8(v_.x, v_.y, v_.z, v_.w); } \
                    { const f32x4 v_ = acc[m_][2] * wt_; w_.z = pk4_fp8(v_.x, v_.y, v_.z, v_.w); } { const f32x4 v_ = acc[m_][3] * wt_; w_.w = pk4_fp8(v_.x, v_.y, v_.z, v_.w); } \
                    *(u32x4*)(y + (size_t)(slot0 + r_) * 1024 + cb_ + 16 * fq) = w_; } \
                _Pragma("unroll") for (int n_ = 0; n_ < 4; ++n_) acc[m_][n_] = (f32x4){0.f, 0.f, 0.f, 0.f}; } } } while (0)
    D_LOAD(0);
    D_STORE(0);
    D_LOAD(1);
    __syncthreads();
#pragma unroll 1
    for (int t = 0; t < NT_; ++t) {
        if (half == 0) { __builtin_amdgcn_s_setprio(1); D_COMPUTE(t); __builtin_amdgcn_s_setprio(0); }
        else if (t + 1 < NT_) { D_STORE((t + 1) & 1); if (t + 2 < NT_) D_LOAD(t + 2); }
        __syncthreads();
        if (half == 1) { if (docomp) { __builtin_amdgcn_s_setprio(1); D_COMPUTE(t); __builtin_amdgcn_s_setprio(0); } }
        else if (t + 1 < NT_) { D_STORE((t + 1) & 1); if (t + 2 < NT_) D_LOAD(t + 2); }
        __syncthreads();
    }
#undef D_LOAD
#undef D_STORE
#undef D_FRAGS
#undef D_MMA
#undef D_COMPUTE
}

struct RowDense { const bf16_t* A; int lda; __device__ __forceinline__ const bf16_t* operator()(int r) const { return A + (size_t)r * lda; } };
struct RowGather { const unsigned char* A; const int* idx; int nvalid; __device__ __forceinline__ const unsigned char* operator()(int r) const { return r < nvalid ? A + (size_t)idx[r] * D : nullptr; } };
struct RowSlots { const unsigned char* A; int nvalid; __device__ __forceinline__ const unsigned char* operator()(int r) const { return r < nvalid ? A + (size_t)r * EDIM : nullptr; } };
struct ColDense { const float* W; int N; __device__ __forceinline__ const float* operator()(int c) const { return c < N ? W + c : nullptr; } };
struct ColMqk { const float* q; ptrdiff_t dk; __device__ __forceinline__ const float* operator()(int c) const { return q + ((c < 128) ? (ptrdiff_t)c : dk + (c - 128)); } };
struct ColGU { const float* g; ptrdiff_t du;
    __device__ __forceinline__ const float* operator()(int c) const { const int tb = c >> 7, cc = c & 127, wnn = cc >> 6, n = (cc >> 4) & 3, rho = cc & 15;
        return g + (((n & 1) ? du : (ptrdiff_t)0) + tb * 64 + wnn * 32 + 8 * (rho >> 2) + 4 * (n >> 1) + (rho & 3)); } };
struct ColRgu { const float* r; ptrdiff_t dg; ptrdiff_t du; __device__ __forceinline__ const float* operator()(int c) const {
    const int cc = c - 256, j = cc >> 5, w = cc & 31; const ptrdiff_t off = (c < 256) ? (ptrdiff_t)c : (((w & 16) ? du : dg) + j * 16 + (w & 15)); return r + off; } };

__device__ __forceinline__ u32x2 pack4(const f32x4 v) { u32x2 w; w.x = cvt_pk_bf16(v.x, v.y); w.y = cvt_pk_bf16(v.z, v.w); return w; }
__device__ __forceinline__ u32x2 pack_swiglu(const f32x4 g, const f32x4 u) { u32x2 w; w.x = cvt_pk_bf16(siluf_(g.x) * u.x, siluf_(g.y) * u.y); w.y = cvt_pk_bf16(siluf_(g.z) * u.z, siluf_(g.w) * u.w); return w; }
struct EpiProj {
    bf16_t* proj; float* graw;
    __device__ __forceinline__ f32x4 pre(int rb, int lane) const { return (f32x4){0.f, 0.f, 0.f, 0.f}; }
    __device__ __forceinline__ void operator()(const f32x4 (&acc)[4][4], int rb, int cb, int lane, const f32x4 epre) const {
        const int fr = lane & 15, fq = lane >> 4;
#pragma unroll
        for (int m = 0; m < 4; ++m)
#pragma unroll
            for (int n = 0; n < 4; ++n) {
                const int row = rb + m * 16 + fr, col = cb + n * 16 + 4 * fq;
                if (col < OFF_GATE) *(u32x2*)(proj + (size_t)row * IN_DIM + col) = pack4(acc[m][n]);
                else if (col < IN_DIM) *(f32x4*)(graw + (size_t)row * 8 + (col - OFF_GATE)) = acc[m][n];
            }
    }
};
struct EpiNull {
    float* sink;
    __device__ __forceinline__ f32x4 pre(int rb, int lane) const { return (f32x4){0.f, 0.f, 0.f, 0.f}; }
    __device__ __forceinline__ void operator()(const f32x4 (&acc)[4][4], int rb, int cb, int lane, const f32x4 epre) const {
        float t = 0.f;
#pragma unroll
        for (int m = 0; m < 4; ++m)
#pragma unroll
            for (int n = 0; n < 4; ++n) t += acc[m][n].x + acc[m][n].y + acc[m][n].z + acc[m][n].w;
        if (t == 12345.678f) sink[lane] = t;
    }
};
struct EpiBf16 {
    bf16_t* O; int ldc;
    __device__ __forceinline__ f32x4 pre(int rb, int lane) const { return (f32x4){0.f, 0.f, 0.f, 0.f}; }
    __device__ __forceinline__ void operator()(const f32x4 (&acc)[4][4], int rb, int cb, int lane, const f32x4 epre) const {
        const int fr = lane & 15, fq = lane >> 4;
#pragma unroll
        for (int m = 0; m < 4; ++m)
#pragma unroll
            for (int n = 0; n < 4; ++n) *(u32x2*)(O + (size_t)(rb + m * 16 + fr) * ldc + cb + n * 16 + 4 * fq) = pack4(acc[m][n]);
    }
};
struct EpiMqk {
    bf16_t* mq; bf16_t* mk; int h;
    __device__ __forceinline__ f32x4 pre(int rb, int lane) const { return (f32x4){0.f, 0.f, 0.f, 0.f}; }
    __device__ __forceinline__ void operator()(const f32x4 (&acc)[4][4], int rb, int cb, int lane, const f32x4 epre) const {
        const int fr = lane & 15, fq = lane >> 4;
#pragma unroll
        for (int m = 0; m < 4; ++m)
#pragma unroll
            for (int n = 0; n < 4; ++n) {
                const int row = rb + m * 16 + fr, col = cb + n * 16 + 4 * fq; f32x4 v = acc[m][n];
                bf16_t* dst = mq; int c = col;
                if (col >= 128) { dst = mk; c = col - 128; v = v * 0.08838834764831845f; }
                *(u32x2*)(dst + (size_t)row * MINNER + h * DM + c) = pack4(v);
            }
    }
};
struct EpiResid {
    const float* X; const float* ada; int gt_off; float* out;
    __device__ __forceinline__ f32x4 pre(int rb, int lane) const { return (f32x4){0.f, 0.f, 0.f, 0.f}; }
    __device__ __forceinline__ void operator()(const f32x4 (&acc)[4][4], int rb, int cb, int lane, const f32x4 epre) const {
        const int fr = lane & 15, fq = lane >> 4;
#pragma unroll
        for (int m = 0; m < 4; ++m)
#pragma unroll
            for (int n = 0; n < 4; ++n) {
                const int row = rb + m * 16 + fr, col = cb + n * 16 + 4 * fq; const int b = row / S;
                const f32x4 g = *(const f32x4*)(ada + b * 6144 + gt_off + col);
                const f32x4 x = *(const f32x4*)(X + (size_t)row * D + col);
                *(f32x4*)(out + (size_t)row * D + col) = x + g * acc[m][n];
            }
    }
};
struct EpiRgu {
    float* logits; bf16_t* act;
    __device__ __forceinline__ f32x4 pre(int rb, int lane) const { return (f32x4){0.f, 0.f, 0.f, 0.f}; }
    __device__ __forceinline__ void operator()(const f32x4 (&acc)[4][4], int rb, int cb, int lane, const f32x4 epre) const {
        const int fr = lane & 15, fq = lane >> 4;
#pragma unroll
        for (int m = 0; m < 4; ++m) {
            const int row = rb + m * 16 + fr;
            if (cb < 256) {
#pragma unroll
                for (int n = 0; n < 4; ++n) *(f32x4*)(logits + (size_t)row * 256 + cb + n * 16 + 4 * fq) = acc[m][n];
            } else {
                const int j0 = (cb - 256) >> 5;
#pragma unroll
                for (int pp = 0; pp < 2; ++pp) *(u32x2*)(act + (size_t)row * 256 + (j0 + pp) * 16 + 4 * fq) = pack_swiglu(acc[m][2 * pp], acc[m][2 * pp + 1]);
            }
        }
    }
};
struct EpiExpAct {
    static constexpr bool PERM = false;
    unsigned char* act; int slot0; int nvalid;
    __device__ __forceinline__ f32x4 pre(int rb, int lane) const { const f32x4 z = {0.f, 0.f, 0.f, 0.f}; return z; }
    __device__ __forceinline__ void operator()(const f32x4 (&acc)[4][4], int rb, int cb, int lane, const f32x4 epre) const {
        const int fr = lane & 15, fq = lane >> 4;
#pragma unroll
        for (int m = 0; m < 4; ++m) {
            const int r = rb + m * 16 + fr;
            if (r < nvalid) {
                u32x2 w;
                { const f32x4 g = acc[m][0], u = acc[m][1]; w.x = pk4_fp8(siluf_(g.x) * u.x, siluf_(g.y) * u.y, siluf_(g.z) * u.z, siluf_(g.w) * u.w); }
                { const f32x4 g = acc[m][2], u = acc[m][3]; w.y = pk4_fp8(siluf_(g.x) * u.x, siluf_(g.y) * u.y, siluf_(g.z) * u.z, siluf_(g.w) * u.w); }
                *(u32x2*)(act + (size_t)(slot0 + r) * 256 + (cb >> 1) + 8 * fq) = w;
            }
        }
    }
};
struct EpiExpDown {
    static constexpr bool PERM = true;
    unsigned char* y; const float* lw; int slot0; int nvalid;
    __device__ __forceinline__ f32x4 pre(int rb, int lane) const {
        const int fr = lane & 15; f32x4 w;
        w.x = (rb + fr < nvalid) ? lw[rb + fr] : 0.f; w.y = (rb + 16 + fr < nvalid) ? lw[rb + 16 + fr] : 0.f;
        w.z = (rb + 32 + fr < nvalid) ? lw[rb + 32 + fr] : 0.f; w.w = (rb + 48 + fr < nvalid) ? lw[rb + 48 + fr] : 0.f; return w; }
    __device__ __forceinline__ void operator()(const f32x4 (&acc)[4][4], int rb, int cb, int lane, const f32x4 epre) const {
        const int fr = lane & 15, fq = lane >> 4;
#pragma unroll
        for (int m = 0; m < 4; ++m) {
            const int r = rb + m * 16 + fr;
            if (r < nvalid) {
                const float wt = epre[m];
                u32x4 w;
                { const f32x4 v = acc[m][0] * wt; w.x = pk4_fp8(v.x, v.y, v.z, v.w); }
                { const f32x4 v = acc[m][1] * wt; w.y = pk4_fp8(v.x, v.y, v.z, v.w); }
                { const f32x4 v = acc[m][2] * wt; w.z = pk4_fp8(v.x, v.y, v.z, v.w); }
                { const f32x4 v = acc[m][3] * wt; w.w = pk4_fp8(v.x, v.y, v.z, v.w); }
                *(u32x4*)(y + (size_t)(slot0 + r) * 1024 + cb + 16 * fq) = w;
            }
        }
    }
};

constexpr int AKLD = 104, AVLD = 72;
__device__ __forceinline__ void attn_unit(const Params& p, LAS unsigned char* lds, int bh, int qb) {
    LAS bf16_t* Ks = (LAS bf16_t*)lds;
    LAS bf16_t* Vt = Ks + 64 * AKLD;
    const bf16_t* Q = (const bf16_t*)(p.ws + B_Q) + (size_t)bh * S * 96;
    const bf16_t* Kg = (const bf16_t*)(p.ws + B_K) + (size_t)bh * S * 96;
    const int b = bh >> 3, h = bh & 7;
    const bf16_t* Vg = (const bf16_t*)(p.ws + B_KVRAW) + (size_t)b * S * 1024 + h * 128 + 64;
    bf16_t* O = (bf16_t*)(p.ws + B_ORAW) + (size_t)b * S * 512 + h * 64;
    const int tid = fresh_tid(), lane = tid & 63, wid = tid >> 6, fr = lane & 15, fq = lane >> 4;
    const int q0 = qb * 256, qw0 = q0 + wid * 32;
    bf16x8 qf[2][3];
#pragma unroll
    for (int nq = 0; nq < 2; ++nq)
#pragma unroll
        for (int ks = 0; ks < 3; ++ks) qf[nq][ks] = *(const bf16x8*)(Q + (size_t)(qw0 + nq * 16 + fr) * 96 + ks * 32 + fq * 8);
    f32x4 oacc[4][2];
#pragma unroll
    for (int d = 0; d < 4; ++d)
#pragma unroll
        for (int nq = 0; nq < 2; ++nq) oacc[d][nq] = (f32x4){0.f, 0.f, 0.f, 0.f};
    float mrun[2] = {-1e30f, -1e30f}, lrun[2] = {0.f, 0.f};
    const int ntiles = (q0 + 256) / 64;
    constexpr int ASTG = 64 * AKLD + 64 * AVLD;
    const int kc0 = tid, kc1 = tid + NT;
    const int kr0 = kc0 / 12, kq0 = kc0 - kr0 * 12, kr1 = kc1 / 12, kq1 = kc1 - kr1 * 12;
    const int vkey = tid & 63, vdc = tid >> 6;
    u32x4 rk0, rk1 = (u32x4){0u, 0u, 0u, 0u}, rv;
#define ATT_LOAD(k0_) do { rk0 = *(const u32x4*)(Kg + (size_t)((k0_) + kr0) * 96 + kq0 * 8); if (kc1 < 768) rk1 = *(const u32x4*)(Kg + (size_t)((k0_) + kr1) * 96 + kq1 * 8); \
        rv = *(const u32x4*)(Vg + (size_t)((k0_) + vkey) * 1024 + vdc * 8); } while (0)
#define ATT_STORE(buf_) do { LAS bf16_t* Kd_ = Ks + (buf_) * ASTG; LAS bf16_t* Vd_ = Kd_ + 64 * AKLD; \
        *(LAS u32x4*)(Kd_ + kr0 * AKLD + kq0 * 8) = rk0; if (kc1 < 768) *(LAS u32x4*)(Kd_ + kr1 * AKLD + kq1 * 8) = rk1; \
        LAS bf16_t* vt_ = Vd_ + (vdc * 8) * AVLD + vkey; \
        vt_[0 * AVLD] = (bf16_t)(rv.x & 0xffff); vt_[1 * AVLD] = (bf16_t)(rv.x >> 16); vt_[2 * AVLD] = (bf16_t)(rv.y & 0xffff); vt_[3 * AVLD] = (bf16_t)(rv.y >> 16); \
        vt_[4 * AVLD] = (bf16_t)(rv.z & 0xffff); vt_[5 * AVLD] = (bf16_t)(rv.z >> 16); vt_[6 * AVLD] = (bf16_t)(rv.w & 0xffff); vt_[7 * AVLD] = (bf16_t)(rv.w >> 16); } while (0)
    ATT_LOAD(0);
    ATT_STORE(0);
    __syncthreads();
    for (int kt = 0; kt < ntiles; ++kt) {
        const int k0 = kt * 64;
        const LAS bf16_t* Kc = Ks + (kt & 1) * ASTG; const LAS bf16_t* Vc = Kc + 64 * AKLD;
        if (kt + 1 < ntiles) ATT_LOAD(k0 + 64);
        if (k0 <= qw0 + 31) {
            f32x4 sacc[4][2];
#pragma unroll
            for (int t4 = 0; t4 < 4; ++t4)
#pragma unroll
                for (int nq = 0; nq < 2; ++nq) sacc[t4][nq] = (f32x4){0.f, 0.f, 0.f, 0.f};
#pragma unroll
            for (int ks = 0; ks < 3; ++ks)
#pragma unroll
                for (int t4 = 0; t4 < 4; ++t4) {
                    const bf16x8 kf = *(const LAS bf16x8*)(Kc + (t4 * 16 + fr) * AKLD + ks * 32 + fq * 8);
#pragma unroll
                    for (int nq = 0; nq < 2; ++nq) sacc[t4][nq] = MFMA16(kf, qf[nq][ks], sacc[t4][nq]);
                }
            const bool need_mask = (k0 + 63 > qw0);
#pragma unroll
            for (int nq = 0; nq < 2; ++nq) {
                const int qidx = qw0 + nq * 16 + fr;
                float mx = -1e30f;
#pragma unroll
                for (int t4 = 0; t4 < 4; ++t4)
#pragma unroll
                    for (int i = 0; i < 4; ++i) {
                        if (need_mask) { const int key = k0 + t4 * 16 + 4 * fq + i; if (key > qidx) sacc[t4][nq][i] = -1e30f; }
                        mx = fmaxf(mx, sacc[t4][nq][i]);
                    }
                mx = fmaxf(mx, __shfl_xor(mx, 16)); mx = fmaxf(mx, __shfl_xor(mx, 32));
                const float mnew = fmaxf(mrun[nq], mx);
                float ls = 0.f;
#pragma unroll
                for (int t4 = 0; t4 < 4; ++t4)
#pragma unroll
                    for (int i = 0; i < 4; ++i) { const float pv = __builtin_amdgcn_exp2f(sacc[t4][nq][i] - mnew); sacc[t4][nq][i] = pv; ls += pv; }
                if (__ballot(mnew > mrun[nq])) {
                    const float alpha = __builtin_amdgcn_exp2f(mrun[nq] - mnew);
                    lrun[nq] = lrun[nq] * alpha + ls;
#pragma unroll
                    for (int d = 0; d < 4; ++d) oacc[d][nq] = oacc[d][nq] * alpha;
                } else lrun[nq] += ls;
                mrun[nq] = mnew;
            }
#pragma unroll
            for (int s2 = 0; s2 < 2; ++s2) {
                bf16x8 pb[2];
#pragma unroll
                for (int nq = 0; nq < 2; ++nq) {
                    u32x4 w; w.x = cvt_pk_bf16(sacc[2 * s2][nq].x, sacc[2 * s2][nq].y); w.y = cvt_pk_bf16(sacc[2 * s2][nq].z, sacc[2 * s2][nq].w);
                    w.z = cvt_pk_bf16(sacc[2 * s2 + 1][nq].x, sacc[2 * s2 + 1][nq].y); w.w = cvt_pk_bf16(sacc[2 * s2 + 1][nq].z, sacc[2 * s2 + 1][nq].w);
                    pb[nq] = __builtin_bit_cast(bf16x8, w);
                }
#pragma unroll
                for (int d = 0; d < 4; ++d) {
                    const LAS bf16_t* vr = Vc + (d * 16 + fr) * AVLD + s2 * 32 + 4 * fq;
                    const u32x2 lo = *(const LAS u32x2*)vr, hi = *(const LAS u32x2*)(vr + 16);
                    const bf16x8 vf = __builtin_bit_cast(bf16x8, ((u32x4){lo.x, lo.y, hi.x, hi.y}));
#pragma unroll
                    for (int nq = 0; nq < 2; ++nq) oacc[d][nq] = MFMA16(vf, pb[nq], oacc[d][nq]);
                }
            }
        }
        if (kt + 1 < ntiles) ATT_STORE((kt + 1) & 1);
        __syncthreads();
    }
#undef ATT_LOAD
#undef ATT_STORE
#pragma unroll
    for (int nq = 0; nq < 2; ++nq) {
        float l = lrun[nq]; l += __shfl_xor(l, 16); l += __shfl_xor(l, 32);
        const float inv = 1.f / l;
        const int qidx = qw0 + nq * 16 + fr;
#pragma unroll
        for (int d = 0; d < 4; ++d) { const f32x4 v = oacc[d][nq] * inv; u32x2 w; w.x = cvt_pk_bf16(v.x, v.y); w.y = cvt_pk_bf16(v.z, v.w);
            *(u32x2*)(O + (size_t)qidx * 512 + d * 16 + 4 * fq) = w; }
    }
}

constexpr int MTLD = 72;
__device__ __forceinline__ void mlstm_a_unit(const Params& p, LAS unsigned char* lds, int unit) {
    LAS bf16_t* kT = (LAS bf16_t*)lds;
    LAS bf16_t* vT = kT + 128 * MTLD;
    LAS float* av = (LAS float*)(vT + 128 * MTLD);
    const int bh = unit >> 5, c = unit & 31, b = bh >> 2, h = bh & 3;
    const int t0 = b * S + c * CHUNK;
    const float* gl = (const float*)(p.ws + B_GL);
    const bf16_t* mk = (const bf16_t*)(p.ws + B_MK); const bf16_t* proj = (const bf16_t*)(p.ws + B_PROJ);
    const int tid = fresh_tid(), lane = tid & 63, wid = tid >> 6, fr = lane & 15, fq = lane >> 4;
    if (wid == 0) {
        const float li = gl[(size_t)(t0 + lane) * 8 + h], lf = gl[(size_t)(t0 + lane) * 8 + 4 + h];
        float bs = lf;
#pragma unroll
        for (int o = 1; o < 64; o <<= 1) { const float t = __shfl_up(bs, o); if (lane >= o) bs += t; }
        const float Btot = __shfl(bs, 63);
        const float g = Btot - bs + li;
        const float ml = wave_max(g);
        av[lane] = __expf(g - ml);
        if (lane == 0) { ((float*)(p.ws + WS_BC))[unit] = Btot; ((float*)(p.ws + WS_MLOC))[unit] = ml; }
    }
    __syncthreads();
#pragma unroll
    for (int rep = 0; rep < 2; ++rep) {
        const int cidx = tid + rep * NT, s = cidx & 63, ch = cidx >> 6;
        const u32x4 kv = *(const u32x4*)(mk + (size_t)(t0 + s) * MINNER + h * DM + ch * 8);
        const u32x4 vv = *(const u32x4*)(proj + (size_t)(t0 + s) * IN_DIM + OFF_MV + h * DM + ch * 8);
        const float a = av[s];
        LAS bf16_t* kt = kT + (ch * 8) * MTLD + s; LAS bf16_t* vt = vT + (ch * 8) * MTLD + s;
        const unsigned kk[4] = {kv.x, kv.y, kv.z, kv.w}; const unsigned vw[4] = {vv.x, vv.y, vv.z, vv.w};
#pragma unroll
        for (int j = 0; j < 4; ++j) {
            kt[(2 * j) * MTLD] = (bf16_t)(kk[j] & 0xffff); kt[(2 * j + 1) * MTLD] = (bf16_t)(kk[j] >> 16);
            const unsigned sc = cvt_pk_bf16(bflo(vw[j]) * a, bfhi(vw[j]) * a);
            vt[(2 * j) * MTLD] = (bf16_t)(sc & 0xffff); vt[(2 * j + 1) * MTLD] = (bf16_t)(sc >> 16);
        }
    }
    __syncthreads();
    {
        const int we = wid >> 1, wd = wid & 1;
        f32x4 acc[2][4];
#pragma unroll
        for (int i = 0; i < 2; ++i)
#pragma unroll
            for (int j = 0; j < 4; ++j) acc[i][j] = (f32x4){0.f, 0.f, 0.f, 0.f};
#pragma unroll
        for (int ks = 0; ks < 2; ++ks) {
            bf16x8 vf[2], kf[4];
#pragma unroll
            for (int i = 0; i < 2; ++i) vf[i] = *(const LAS bf16x8*)(vT + (we * 32 + i * 16 + fr) * MTLD + ks * 32 + fq * 8);
#pragma unroll
            for (int j = 0; j < 4; ++j) kf[j] = *(const LAS bf16x8*)(kT + (wd * 64 + j * 16 + fr) * MTLD + ks * 32 + fq * 8);
#pragma unroll
            for (int i = 0; i < 2; ++i)
#pragma unroll
                for (int j = 0; j < 4; ++j) acc[i][j] = MFMA16(kf[j], vf[i], acc[i][j]);
        }
        bf16_t* dC = (bf16_t*)(p.ws + B_DC) + (size_t)unit * 16384;
#pragma unroll
        for (int i = 0; i < 2; ++i)
#pragma unroll
            for (int j = 0; j < 4; ++j) *(u32x2*)(dC + (we * 32 + i * 16 + fr) * 128 + wd * 64 + j * 16 + 4 * fq) = pack4(acc[i][j]);
    }
    if (tid < 128) {
        float s = 0.f;
        for (int q = 0; q < 64; ++q) s += bf2f(kT[tid * MTLD + q]) * av[q];
        ((float*)(p.ws + WS_DN))[(size_t)unit * 128 + tid] = s;
    }
    __syncthreads();
}

__device__ __forceinline__ void mlstm_scan(const Params& p, int gtid, int ngt) {
    const float* Bc = (const float*)(p.ws + WS_BC); const float* ML = (const float*)(p.ws + WS_MLOC);
    float* mprev = (float*)(p.ws + WS_MPREV);
    const bf16_t* dC = (const bf16_t*)(p.ws + B_DC); bf16_t* Cp = (bf16_t*)(p.ws + B_CPREV);
    const float* dn = (const float*)(p.ws + WS_DN); float* np_ = (float*)(p.ws + WS_NPREV);
    constexpr int PER = 4096 + 32;
    for (int idx = gtid; idx < 32 * PER; idx += ngt) {
        const int bh = idx / PER, e4 = idx - bh * PER;
        const bool isC = e4 < 4096; const int n4 = e4 - 4096;
        float m = 0.f; f32x4 C = (f32x4){0.f, 0.f, 0.f, 0.f};
        for (int c0 = 0; c0 < NCH; c0 += 4) {
            f32x4 d[4]; float Bt[4], ml[4];
#pragma unroll
            for (int q = 0; q < 4; ++q) {
                const int unit = bh * NCH + c0 + q;
                Bt[q] = Bc[unit]; ml[q] = ML[unit];
                if (isC) { const u32x2 w = *(const u32x2*)(dC + (size_t)unit * 16384 + e4 * 4); d[q] = (f32x4){bflo(w.x), bfhi(w.x), bflo(w.y), bfhi(w.y)}; }
                else d[q] = *(const f32x4*)(dn + (size_t)unit * 128 + n4 * 4);
            }
#pragma unroll
            for (int q = 0; q < 4; ++q) {
                const int unit = bh * NCH + c0 + q;
                const float mnew = fmaxf(Bt[q] + m, ml[q]);
                const float fa = __expf(Bt[q] + m - mnew), fb = __expf(ml[q] - mnew);
                if (isC) {
                    u32x2 w; w.x = cvt_pk_bf16(C.x, C.y); w.y = cvt_pk_bf16(C.z, C.w);
                    *(u32x2*)(Cp + (size_t)unit * 16384 + e4 * 4) = w;
                    if (e4 == 0) mprev[unit] = m;
                } else {
                    *(f32x4*)(np_ + (size_t)unit * 128 + n4 * 4) = C;
                }
                C = C * fa + d[q] * fb;
                m = mnew;
            }
        }
    }
}

constexpr int MRLD = 136;
struct McRegs { u32x4 q[2], k[2], c[4], v[2]; float li, lf, mp; };
__device__ __forceinline__ void mlstm_c_load(const Params& p, int unit, McRegs& R) {
    const int bh = unit >> 5, c = unit & 31, b = bh >> 2, h = bh & 3;
    const int t0 = b * S + c * CHUNK;
    const float* gl = (const float*)(p.ws + B_GL);
    const bf16_t* mq = (const bf16_t*)(p.ws + B_MQ); const bf16_t* mk = (const bf16_t*)(p.ws + B_MK); const bf16_t* proj = (const bf16_t*)(p.ws + B_PROJ);
    const bf16_t* Cp = (const bf16_t*)(p.ws + B_CPREV) + (size_t)unit * 16384;
    const int tid = fresh_tid(), lane = tid & 63;
#pragma unroll
    for (int rep = 0; rep < 2; ++rep) {
        const int cidx = tid + rep * NT, r = cidx >> 4, ch = cidx & 15;
        R.q[rep] = *(const u32x4*)(mq + (size_t)(t0 + r) * MINNER + h * DM + ch * 8);
        R.k[rep] = *(const u32x4*)(mk + (size_t)(t0 + r) * MINNER + h * DM + ch * 8);
    }
#pragma unroll
    for (int rep = 0; rep < 4; ++rep) { const int cidx = tid + rep * NT, r = cidx >> 4, ch = cidx & 15; R.c[rep] = *(const u32x4*)(Cp + r * 128 + ch * 8); }
#pragma unroll
    for (int rep = 0; rep < 2; ++rep) { const int cidx = tid + rep * NT, sq = cidx & 63, ch = cidx >> 6; R.v[rep] = *(const u32x4*)(proj + (size_t)(t0 + sq) * IN_DIM + OFF_MV + h * DM + ch * 8); }
    R.li = gl[(size_t)(t0 + lane) * 8 + h]; R.lf = gl[(size_t)(t0 + lane) * 8 + 4 + h]; R.mp = ((const float*)(p.ws + WS_MPREV))[unit];
}
__device__ __forceinline__ void mlstm_c_unit(const Params& p, LAS unsigned char* lds, int unit, McRegs& R, int next_unit) {
    LAS bf16_t* qs = (LAS bf16_t*)lds;
    LAS bf16_t* ks = qs + 64 * MRLD;
    LAS bf16_t* cs = ks + 64 * MRLD;
    LAS bf16_t* vT = cs + 128 * MRLD;
    LAS float* fv = (LAS float*)(vT + 128 * MTLD);
    LAS float* u_s = fv; LAS float* c_t = fv + 64; LAS float* dec = fv + 128; LAS float* emt = fv + 192; LAS float* ssq = fv + 256;
    const int bh = unit >> 5, c = unit & 31, b = bh >> 2, h = bh & 3;
    const int t0 = b * S + c * CHUNK;
    const bf16_t* proj = (const bf16_t*)(p.ws + B_PROJ);
    const float* np_ = (const float*)(p.ws + WS_NPREV) + (size_t)unit * 128;
    const int tid = fresh_tid(), lane = tid & 63, wid = tid >> 6, fr = lane & 15, fq = lane >> 4;
    if (wid == 0) {
        const float li = R.li, lf = R.lf;
        const float mp = R.mp;
        float bs = lf;
#pragma unroll
        for (int o = 1; o < 64; o <<= 1) { const float t = __shfl_up(bs, o); if (lane >= o) bs += t; }
        const float u = li - bs;
        float pm = u;
#pragma unroll
        for (int o = 1; o < 64; o <<= 1) { const float t = __shfl_up(pm, o); if (lane >= o) pm = fmaxf(pm, t); }
        const float inter = bs + mp;
        const float mt = fmaxf(inter, bs + pm);
        u_s[lane] = u; c_t[lane] = bs - mt; dec[lane] = __expf(inter - mt); emt[lane] = __expf(-mt);
    }
#pragma unroll
    for (int rep = 0; rep < 2; ++rep) {
        const int cidx = tid + rep * NT, r = cidx >> 4, ch = cidx & 15;
        *(LAS u32x4*)(qs + r * MRLD + ch * 8) = R.q[rep];
        *(LAS u32x4*)(ks + r * MRLD + ch * 8) = R.k[rep];
    }
#pragma unroll
    for (int rep = 0; rep < 4; ++rep) { const int cidx = tid + rep * NT, r = cidx >> 4, ch = cidx & 15; *(LAS u32x4*)(cs + r * MRLD + ch * 8) = R.c[rep]; }
#pragma unroll
    for (int rep = 0; rep < 2; ++rep) {
        const int cidx = tid + rep * NT, sq = cidx & 63, ch = cidx >> 6;
        const u32x4 vv = R.v[rep];
        LAS bf16_t* vt = vT + (ch * 8) * MTLD + sq;
        const unsigned vw[4] = {vv.x, vv.y, vv.z, vv.w};
#pragma unroll
        for (int j = 0; j < 4; ++j) { vt[(2 * j) * MTLD] = (bf16_t)(vw[j] & 0xffff); vt[(2 * j + 1) * MTLD] = (bf16_t)(vw[j] >> 16); }
    }
    __syncthreads();
    if (next_unit >= 0) mlstm_c_load(p, next_unit, R);
    const int tt = wid & 3, eh = wid >> 2;
    const int tl = tt * 16 + fr;
    bf16x8 qf[4];
#pragma unroll
    for (int k4 = 0; k4 < 4; ++k4) qf[k4] = *(const LAS bf16x8*)(qs + tl * MRLD + k4 * 32 + fq * 8);
    f32x4 sacc[4];
#pragma unroll
    for (int st = 0; st < 4; ++st) sacc[st] = (f32x4){0.f, 0.f, 0.f, 0.f};
#pragma unroll
    for (int k4 = 0; k4 < 4; ++k4)
#pragma unroll
        for (int st = 0; st < 4; ++st) {
            const bf16x8 kf = *(const LAS bf16x8*)(ks + (st * 16 + fr) * MRLD + k4 * 32 + fq * 8);
            sacc[st] = MFMA16(kf, qf[k4], sacc[st]);
        }
    const float ct = c_t[tl];
    float rs = 0.f;
#pragma unroll
    for (int st = 0; st < 4; ++st)
#pragma unroll
        for (int i = 0; i < 4; ++i) {
            const int s = st * 16 + 4 * fq + i;
            const float w = (s <= tl) ? __expf(ct + u_s[s]) * sacc[st][i] : 0.f;
            sacc[st][i] = w; rs += w;
        }
    rs += __shfl_xor(rs, 16); rs += __shfl_xor(rs, 32);
    float nq;
    {
        f32x4 na = (f32x4){0.f, 0.f, 0.f, 0.f};
#pragma unroll
        for (int k4 = 0; k4 < 4; ++k4) {
            u32x4 w = (u32x4){0u, 0u, 0u, 0u};
            if (fr == 0) { const float* nn = np_ + k4 * 32 + fq * 8; w.x = cvt_pk_bf16(nn[0], nn[1]); w.y = cvt_pk_bf16(nn[2], nn[3]); w.z = cvt_pk_bf16(nn[4], nn[5]); w.w = cvt_pk_bf16(nn[6], nn[7]); }
            na = MFMA16(__builtin_bit_cast(bf16x8, w), qf[k4], na);
        }
        nq = __shfl(na.x, fr);
    }
    f32x4 acc[4];
#pragma unroll
    for (int et = 0; et < 4; ++et) acc[et] = (f32x4){0.f, 0.f, 0.f, 0.f};
#pragma unroll
    for (int k4 = 0; k4 < 4; ++k4)
#pragma unroll
        for (int et = 0; et < 4; ++et) {
            const bf16x8 cf = *(const LAS bf16x8*)(cs + (eh * 64 + et * 16 + fr) * MRLD + k4 * 32 + fq * 8);
            acc[et] = MFMA16(cf, qf[k4], acc[et]);
        }
    const float dcy = dec[tl];
#pragma unroll
    for (int et = 0; et < 4; ++et) acc[et] = acc[et] * dcy;
#pragma unroll
    for (int s2 = 0; s2 < 2; ++s2) {
        u32x4 w; w.x = cvt_pk_bf16(sacc[2 * s2].x, sacc[2 * s2].y); w.y = cvt_pk_bf16(sacc[2 * s2].z, sacc[2 * s2].w);
        w.z = cvt_pk_bf16(sacc[2 * s2 + 1].x, sacc[2 * s2 + 1].y); w.w = cvt_pk_bf16(sacc[2 * s2 + 1].z, sacc[2 * s2 + 1].w);
        const bf16x8 pb = __builtin_bit_cast(bf16x8, w);
#pragma unroll
        for (int et = 0; et < 4; ++et) {
            const LAS bf16_t* vr = vT + (eh * 64 + et * 16 + fr) * MTLD + s2 * 32 + 4 * fq;
            const u32x2 lo = *(const LAS u32x2*)vr, hi = *(const LAS u32x2*)(vr + 16);
            acc[et] = MFMA16(__builtin_bit_cast(bf16x8, ((u32x4){lo.x, lo.y, hi.x, hi.y})), pb, acc[et]);
        }
    }
    const float den = dcy * nq + rs;
    const float hd = 1.f / fmaxf(fabsf(den), emt[tl]);
    float sq = 0.f;
#pragma unroll
    for (int et = 0; et < 4; ++et) { acc[et] = acc[et] * hd; sq += acc[et].x * acc[et].x + acc[et].y * acc[et].y + acc[et].z * acc[et].z + acc[et].w * acc[et].w; }
    sq += __shfl_xor(sq, 16); sq += __shfl_xor(sq, 32);
    if (fq == 0) ssq[eh * 64 + tl] = sq;
    __syncthreads();
    const float rinv = rsqrtf((ssq[tl] + ssq[64 + tl]) * (1.f / 128.f) + RMS_EPS);
    const float* gmo = p.in[20] + h * DM;
    bf16_t* ao = (bf16_t*)(p.ws + B_AO);
#pragma unroll
    for (int et = 0; et < 4; ++et) {
        const int e = eh * 64 + et * 16 + 4 * fq;
        const u32x2 op = *(const u32x2*)(proj + (size_t)(t0 + tl) * IN_DIM + OFF_MO + h * DM + e);
        const f32x4 g = *(const f32x4*)(gmo + e);
        const f32x4 v = acc[et] * rinv * g;
        u32x2 w; w.x = cvt_pk_bf16(v.x * sigmoidf_(bflo(op.x)), v.y * sigmoidf_(bfhi(op.x))); w.y = cvt_pk_bf16(v.z * sigmoidf_(bflo(op.y)), v.w * sigmoidf_(bfhi(op.y)));
        *(u32x2*)(ao + (size_t)(t0 + tl) * 1024 + 512 + h * DM + e) = w;
    }
    __syncthreads();
}

__device__ __forceinline__ unsigned fkey(float f) { const unsigned u = __float_as_uint(f); return (u & 0x80000000u) ? ~u : (u | 0x80000000u); }
__device__ __forceinline__ float rdlane_f(float v, int l) { return __uint_as_float((unsigned)__builtin_amdgcn_readlane((int)__float_as_uint(v), l)); }
__device__ __forceinline__ void route_token(const f32x4 cur, const f32x4 bias, int lane, int (&e8)[8], float (&w8)[8]) {
    float sc[4] = {sigmoidf_(cur.x), sigmoidf_(cur.y), sigmoidf_(cur.z), sigmoidf_(cur.w)};
    float sb[4] = {sc[0] + bias.x, sc[1] + bias.y, sc[2] + bias.z, sc[3] + bias.w};
    float t1 = fmaxf(fmaxf(sb[0], sb[1]), fmaxf(sb[2], sb[3]));
    float t2;
    {   const float a = fmaxf(sb[0], sb[1]), bmin = fminf(sb[0], sb[1]), c2 = fmaxf(sb[2], sb[3]), dmin = fminf(sb[2], sb[3]);
        t2 = fmaxf(fminf(a, c2), fmaxf(bmin, dmin)); }
#pragma unroll
    for (int o = 1; o < 8; o <<= 1) {
        const float o1 = __shfl_xor(t1, o), o2 = __shfl_xor(t2, o);
        const float n1 = fmaxf(t1, o1), n2 = fmaxf(fminf(t1, o1), fmaxf(t2, o2));
        t1 = n1; t2 = n2;
    }
    const float gs = t1 + t2;
    const int myg = lane >> 3;
    int rank = 0;
#pragma unroll
    for (int g = 0; g < 8; ++g) { const float og = rdlane_f(gs, g * 8); rank += (og > gs || (og == gs && g < myg)) ? 1 : 0; }
    const bool keep = rank < 4;
    unsigned key[4];
#pragma unroll
    for (int j = 0; j < 4; ++j) key[j] = keep ? fkey(sb[j]) : 0u;
    unsigned t = 0u;
#pragma unroll 4
    for (int bit = 31; bit >= 0; --bit) {
        const unsigned tt = t | (1u << bit);
        const int c = __builtin_popcountll(__ballot(key[0] >= tt)) + __builtin_popcountll(__ballot(key[1] >= tt)) + __builtin_popcountll(__ballot(key[2] >= tt)) + __builtin_popcountll(__ballot(key[3] >= tt));
        if (c >= TOPK) t = tt;
    }
    unsigned long long sel[4], eq[4];
    int ngt = 0;
#pragma unroll
    for (int j = 0; j < 4; ++j) { sel[j] = __ballot(key[j] > t); eq[j] = __ballot(key[j] == t); ngt += __builtin_popcountll(sel[j]); }
    for (int need = TOPK - ngt; need > 0; --need) {
        int best = 1 << 30;
#pragma unroll
        for (int j = 0; j < 4; ++j) if (eq[j]) { const int idx = 4 * (int)__builtin_ctzll(eq[j]) + j; best = idx < best ? idx : best; }
        const int L = best >> 2, jj = best & 3;
#pragma unroll
        for (int j = 0; j < 4; ++j) if (jj == j) { eq[j] &= ~(1ull << L); sel[j] |= (1ull << L); }
    }
    float wsum = 0.f;
#pragma unroll
    for (int k = 0; k < TOPK; ++k) {
        int best = 1 << 30;
#pragma unroll
        for (int j = 0; j < 4; ++j) if (sel[j]) { const int idx = 4 * (int)__builtin_ctzll(sel[j]) + j; best = idx < best ? idx : best; }
        const int L = best >> 2, jj = best & 3;
#pragma unroll
        for (int j = 0; j < 4; ++j) if (jj == j) sel[j] &= ~(1ull << L);
        const float s0 = rdlane_f(sc[0], L), s1 = rdlane_f(sc[1], L), s2 = rdlane_f(sc[2], L), s3 = rdlane_f(sc[3], L);
        const float sraw = (jj == 0) ? s0 : (jj == 1) ? s1 : (jj == 2) ? s2 : s3;
        e8[k] = best; w8[k] = sraw; wsum += sraw;
    }
    const float inv = 2.5f / wsum;
#pragma unroll
    for (int k = 0; k < TOPK; ++k) w8[k] *= inv;
}
__device__ __forceinline__ void route_rows(const Params& p, int gw, int ngw, int lane) {
    const float* logits = (const float*)(p.ws + C_LOGITS); const float* rb = p.in[24];
    int* cnt = (int*)(p.ws + WS_CNT);
    int* tok_e = (int*)(p.ws + C_TOKE); float* tok_w = (float*)(p.ws + C_TOKW); int* tok_pos = (int*)(p.ws + C_TOKPOS);
    int* list_tok = (int*)(p.ws + C_LISTTOK); float* list_w = (float*)(p.ws + C_LISTW);
    const f32x4 bias = *(const f32x4*)(rb + lane * 4);
    for (int row0 = gw; row0 < T; row0 += ngw * 8) {
        int e_all = 0, row_all = -1; float w_all = 0.f;
        f32x4 lg = *(const f32x4*)(logits + (size_t)row0 * 256 + lane * 4);
#pragma unroll 1
        for (int i = 0; i < 8; ++i) {
            const int row = row0 + i * ngw;
            if (row >= T) break;
            const f32x4 cur = lg;
            if (i + 1 < 8 && row + ngw < T) lg = *(const f32x4*)(logits + (size_t)(row + ngw) * 256 + lane * 4);
            int e8[8]; float w8[8];
            route_token(cur, bias, lane, e8, w8);
            if ((lane >> 3) == i) {
                const int k = lane & 7; int es = e8[0]; float wsel = w8[0];
#pragma unroll
                for (int q = 1; q < 8; ++q) if (k == q) { es = e8[q]; wsel = w8[q]; }
                e_all = es; w_all = wsel; row_all = row;
            }
        }
        if (row_all >= 0) {
            const int k = lane & 7;
            const int pos = atomicAdd(&cnt[e_all * CNT_STRIDE], 1);
            tok_e[(size_t)row_all * 8 + k] = e_all; tok_w[(size_t)row_all * 8 + k] = w_all; tok_pos[(size_t)row_all * 8 + k] = pos;
            list_tok[(size_t)e_all * CAP + pos] = row_all; list_w[(size_t)e_all * CAP + pos] = w_all;
        }
    }
}

__device__ __forceinline__ void expert_prefix(const Params& p, LAS int* base, LAS int* tsx, int tid, int x, int ngrp) {
    const int* cnt = (const int*)(p.ws + WS_CNT);
    const int nper = NE / ngrp;
    if (tid < 64) {
        int c[4]; int s = 0;
#pragma unroll
        for (int j = 0; j < 4; ++j) { c[j] = __hip_atomic_load(cnt + (tid * 4 + j) * CNT_STRIDE, __ATOMIC_RELAXED, __HIP_MEMORY_SCOPE_AGENT); s += c[j]; }
        int ps = s;
#pragma unroll
        for (int o = 1; o < 64; o <<= 1) { const int a = __shfl_up(ps, o); if (tid >= o) ps += a; }
        int es = ps - s;
#pragma unroll
        for (int j = 0; j < 4; ++j) { base[tid * 4 + j] = es; es += c[j]; }
        int run = 0;
        for (int r0 = 0; r0 < nper; r0 += 64) {
            const int i = r0 + tid;
            int tl = 0;
            if (i < nper) tl = (__hip_atomic_load(cnt + (x + ngrp * i) * CNT_STRIDE, __ATOMIC_RELAXED, __HIP_MEMORY_SCOPE_AGENT) + 255) >> 8;
            int pt = tl;
#pragma unroll
            for (int o = 1; o < 64; o <<= 1) { const int a = __shfl_up(pt, o); if (tid >= o) pt += a; }
            if (i < nper) tsx[i] = run + pt - tl;
            run += __shfl(pt, 63);
        }
        if (tid == 0) tsx[nper] = run;
    }
    __syncthreads();
}

__device__ __forceinline__ void combine_rows(const Params& p, LAS int* base, int gw, int ngw, int lane) {
    const bf16_t* sh = (const bf16_t*)(p.ws + C_SHOUT); const unsigned char* y = (const unsigned char*)(p.ws + C_Y);
    const int* tok_e = (const int*)(p.ws + C_TOKE); const int* tok_pos = (const int*)(p.ws + C_TOKPOS);
    const float* ada = (const float*)(p.ws + WS_ADA);
    typedef float f32x2v __attribute__((ext_vector_type(2)));
    for (int row = gw; row < T; row += ngw) {
        const int b = row / S;
        const int col = lane * 16;
        u32x4 yr[TOPK];
#pragma unroll
        for (int k = 0; k < TOPK; ++k) {
            const int e = tok_e[(size_t)row * 8 + k], pos = tok_pos[(size_t)row * 8 + k];
            yr[k] = *(const u32x4*)(y + (size_t)(base[e] + pos) * 1024 + col);
        }
        float acc[16];
        {
            const u32x4 a0 = *(const u32x4*)(sh + (size_t)row * 1024 + col), a1 = *(const u32x4*)(sh + (size_t)row * 1024 + col + 8);
            acc[0] = bflo(a0.x); acc[1] = bfhi(a0.x); acc[2] = bflo(a0.y); acc[3] = bfhi(a0.y); acc[4] = bflo(a0.z); acc[5] = bfhi(a0.z); acc[6] = bflo(a0.w); acc[7] = bfhi(a0.w);
            acc[8] = bflo(a1.x); acc[9] = bfhi(a1.x); acc[10] = bflo(a1.y); acc[11] = bfhi(a1.y); acc[12] = bflo(a1.z); acc[13] = bfhi(a1.z); acc[14] = bflo(a1.w); acc[15] = bfhi(a1.w);
        }
#pragma unroll
        for (int k = 0; k < TOPK; ++k) {
            const unsigned w4[4] = {yr[k].x, yr[k].y, yr[k].z, yr[k].w};
#pragma unroll
            for (int q = 0; q < 4; ++q) {
                const f32x2v lo = __builtin_amdgcn_cvt_pk_f32_fp8((int)w4[q], false), hi = __builtin_amdgcn_cvt_pk_f32_fp8((int)w4[q], true);
                acc[4 * q + 0] += lo.x; acc[4 * q + 1] += lo.y; acc[4 * q + 2] += hi.x; acc[4 * q + 3] += hi.y;
            }
        }
        float* o = p.out + (size_t)row * D + col;
        const float* g = ada + b * 6144 + 5120 + col;
        const bf16_t* x1r = (const bf16_t*)(p.ws + C_X1) + (size_t)row * D + col;
        const u32x4 xa = *(const u32x4*)x1r, xb = *(const u32x4*)(x1r + 8);
        const unsigned xw[8] = {xa.x, xa.y, xa.z, xa.w, xb.x, xb.y, xb.z, xb.w};
#pragma unroll
        for (int q4 = 0; q4 < 4; ++q4) {
            const f32x4 x = (f32x4){bflo(xw[2 * q4]), bfhi(xw[2 * q4]), bflo(xw[2 * q4 + 1]), bfhi(xw[2 * q4 + 1])}, gg = *(const f32x4*)(g + q4 * 4);
            f32x4 r; r.x = x.x + gg.x * acc[q4 * 4 + 0]; r.y = x.y + gg.y * acc[q4 * 4 + 1]; r.z = x.z + gg.z * acc[q4 * 4 + 2]; r.w = x.w + gg.w * acc[q4 * 4 + 3];
            *(f32x4*)(o + q4 * 4) = r;
        }
    }
}


struct PgProj {
    static constexpr bool PERM = true, AFTER_DRAIN = false;
    bf16_t* proj; float* graw;
    __device__ __forceinline__ void operator()(const f32x4 (&acc)[2][2][4][2], const pg8::Unit& u, int wr, int wc, int fr, int fq) const {
#pragma unroll
        for (int ai = 0; ai < 2; ++ai)
#pragma unroll
            for (int m = 0; m < 4; ++m) { const int row = u.pm * 256 + ai * 128 + wr * 64 + m * 16 + fr;
#pragma unroll
                for (int bj = 0; bj < 2; ++bj) { const int col = u.pn * 256 + bj * 128 + wc * 32 + 8 * fq;
                    if (col < OFF_GATE) { const u32x2 lo = pack4(acc[ai][bj][m][0]), hi = pack4(acc[ai][bj][m][1]); *(u32x4*)(proj + (size_t)row * IN_DIM + col) = (u32x4){lo.x, lo.y, hi.x, hi.y}; }
                    else if (col < IN_DIM) { *(f32x4*)(graw + (size_t)row * 8) = acc[ai][bj][m][0]; *(f32x4*)(graw + (size_t)row * 8 + 4) = acc[ai][bj][m][1]; } } }
    }
};
struct PgBf16 {
    static constexpr bool PERM = true, AFTER_DRAIN = false;
    bf16_t* O; int ldc;
    __device__ __forceinline__ void operator()(const f32x4 (&acc)[2][2][4][2], const pg8::Unit& u, int wr, int wc, int fr, int fq) const {
#pragma unroll
        for (int ai = 0; ai < 2; ++ai)
#pragma unroll
            for (int m = 0; m < 4; ++m) { const int row = u.pm * 256 + ai * 128 + wr * 64 + m * 16 + fr;
#pragma unroll
                for (int bj = 0; bj < 2; ++bj) { const int col = u.pn * 256 + bj * 128 + wc * 32 + 8 * fq;
                    const u32x2 lo = pack4(acc[ai][bj][m][0]), hi = pack4(acc[ai][bj][m][1]); *(u32x4*)(O + (size_t)row * ldc + col) = (u32x4){lo.x, lo.y, hi.x, hi.y}; } }
    }
};
struct PgMqk {
    static constexpr bool PERM = true, AFTER_DRAIN = false;
    bf16_t* mq; bf16_t* mk;
    __device__ __forceinline__ void operator()(const f32x4 (&acc)[2][2][4][2], const pg8::Unit& u, int wr, int wc, int fr, int fq) const {
#pragma unroll
        for (int ai = 0; ai < 2; ++ai)
#pragma unroll
            for (int m = 0; m < 4; ++m) { const int row = u.pm * 256 + ai * 128 + wr * 64 + m * 16 + fr;
#pragma unroll
                for (int bj = 0; bj < 2; ++bj) { const int c = wc * 32 + 8 * fq; const float sc = bj ? 0.08838834764831845f : 1.f;
                    const u32x2 lo = pack4(acc[ai][bj][m][0] * sc), hi = pack4(acc[ai][bj][m][1] * sc);
                    *(u32x4*)((bj ? mk : mq) + (size_t)row * MINNER + u.pn * DM + c) = (u32x4){lo.x, lo.y, hi.x, hi.y}; } }
    }
};
struct PgResid {
    static constexpr bool PERM = true, AFTER_DRAIN = false;
    const float* X; const float* ada; int gt_off; bf16_t* out;
    __device__ __forceinline__ void operator()(const f32x4 (&acc)[2][2][4][2], const pg8::Unit& u, int wr, int wc, int fr, int fq) const {
#pragma unroll
        for (int ai = 0; ai < 2; ++ai)
#pragma unroll
            for (int m = 0; m < 4; ++m) { const int row = u.pm * 256 + ai * 128 + wr * 64 + m * 16 + fr; const int b = row / S;
#pragma unroll
                for (int bj = 0; bj < 2; ++bj) { const int col = u.pn * 256 + bj * 128 + wc * 32 + 8 * fq;
                    const f32x4 g0 = *(const f32x4*)(ada + b * 6144 + gt_off + col), g1 = *(const f32x4*)(ada + b * 6144 + gt_off + col + 4);
                    const f32x4 x0 = *(const f32x4*)(X + (size_t)row * D + col), x1 = *(const f32x4*)(X + (size_t)row * D + col + 4);
                    const u32x2 lo = pack4(x0 + g0 * acc[ai][bj][m][0]), hi = pack4(x1 + g1 * acc[ai][bj][m][1]);
                    *(u32x4*)(out + (size_t)row * D + col) = (u32x4){lo.x, lo.y, hi.x, hi.y}; } }
    }
};
struct PgRgu {
    static constexpr bool PERM = false, AFTER_DRAIN = false;
    float* logits; bf16_t* act;
    __device__ __forceinline__ void operator()(const f32x4 (&acc)[2][2][4][2], const pg8::Unit& u, int wr, int wc, int fr, int fq) const {
#pragma unroll
        for (int ai = 0; ai < 2; ++ai)
#pragma unroll
            for (int m = 0; m < 4; ++m) { const int row = u.pm * 256 + ai * 128 + wr * 64 + m * 16 + fr;
#pragma unroll
                for (int bj = 0; bj < 2; ++bj) {
                    if (u.pn == 0) {
#pragma unroll
                        for (int n = 0; n < 2; ++n) *(f32x4*)(logits + (size_t)row * 256 + bj * 128 + wc * 32 + n * 16 + 4 * fq) = acc[ai][bj][m][n];
                    } else {
                        const int j = ((u.pn - 1) * 256 + bj * 128 + wc * 32) >> 5;
                        *(u32x2*)(act + (size_t)row * 256 + j * 16 + 4 * fq) = pack_swiglu(acc[ai][bj][m][0], acc[ai][bj][m][1]);
                    }
                } }
    }
};

__device__ __forceinline__ int xcd_remap(int L, int nwg) { const int q = nwg >> 3, r = nwg & 7, x = L & 7, off = L >> 3; return (x < r ? x * (q + 1) : r * (q + 1) + (x - r) * q) + off; }
__global__ void __launch_bounds__(NT, 2) fwd_kernel(Params p) {
    extern __shared__ __attribute__((aligned(16))) unsigned char lds_raw[];
    LAS unsigned char* lds = (LAS unsigned char*)lds_raw;
    const int G = gridDim.x, bid = blockIdx.x, ngw = G * NWAVES;
#define FRESH_IDS() const int tid = fresh_tid(), lane = tid & 63, wid = tid >> 6, gw = bid * NWAVES + wid; (void)lane; (void)gw
    { const int tid = fresh_tid(); volatile LAS unsigned* bst0 = (volatile LAS unsigned*)(lds + LDS_BYTES - 64); if (tid < 2) bst0[tid] = 0u; }
    unsigned char* ws = p.ws;
    const float* ada = (const float*)(ws + WS_ADA);
    volatile LAS unsigned* bst = (volatile LAS unsigned*)(lds + LDS_BYTES - 64);
    __syncthreads();
    const XcdBarrier xbar = xcd_barrier_post((unsigned*)(ws + WS_CTL + 4096), bst);
    int ts_n = 0;
#if DBG_STAGE == 2
#define TSTAMP() do { if (bid == 0 && threadIdx.x == 0) ((unsigned long long*)(ws + WS_CTL + 16384 + 8192))[ts_n] = __builtin_amdgcn_s_memrealtime(); ++ts_n; } while (0)
#else
#define TSTAMP() do { } while (0)
#endif
    TSTAMP();

    {
        FRESH_IDS();
        const bool split = G > 128;
        if (!split || bid < 96) for (int u = bid; u < 96; u += G) ada_unit(p, lds, u, tid);
        if (!split || bid >= 96) {
            LAS float* scr = (LAS float*)(lds + wid * 8448);
            const int cg0 = split ? (bid - 96) * NWAVES + wid : gw, cgn = split ? (G - 96) * NWAVES : ngw;
            constexpr int I0 = 16 * 70, I1 = I0 + 6 * 24, I2 = I1 + 4 * 32, I3 = I2 + 32, I4 = I3 + 32, I5 = I4 + 16 * 32, I6 = I5 + 16 * 8, I7 = I6 + 16 * 8, I8 = I7 + 16 * 8, I9 = I8 + 4 * 32;
            for (int it = cg0; it < I9; it += cgn) {
                if (it < I0) conv_item<0>(p.in[6], 1024, IN_DIM, (bf16_t*)(ws + WS_WIN), 0, 0, scr, it, lane);
                else if (it < I1) conv_item<0>(p.in[8], QLORA, 768, (bf16_t*)(ws + WS_WUQ), 0, 0, scr, it - I0, lane);
                else if (it < I2) conv_item<0>(p.in[10], KVLORA, 1024, (bf16_t*)(ws + WS_WUKV), 0, 0, scr, it - I1, lane);
                else if (it < I3) conv_item<0>(p.in[16], 128, 128, (bf16_t*)(ws + WS_WMQK), 256 * 128, 0, scr, it - I2, lane);
                else if (it < I4) conv_item<0>(p.in[17], 128, 128, (bf16_t*)(ws + WS_WMQK), 256 * 128, 128, scr, it - I3, lane);
                else if (it < I5) conv_item<0>(p.in[21], 1024, 1024, (bf16_t*)(ws + WS_WOUT), 0, 0, scr, it - I4, lane);
                else if (it < I6) conv_item<0>(p.in[23], 1024, 256, (bf16_t*)(ws + WS_WRGU), 0, 0, scr, it - I5, lane);
                else if (it < I7) conv_item<1>(p.in[28], 1024, 256, (bf16_t*)(ws + WS_WRGU), 0, 256, scr, it - I6, lane);
                else if (it < I8) conv_item<2>(p.in[29], 1024, 256, (bf16_t*)(ws + WS_WRGU), 0, 256, scr, it - I7, lane);
                else conv_item<0>(p.in[30], 256, 1024, (bf16_t*)(ws + WS_WDSH), 0, 0, scr, it - I8, lane);
            }
            u32x4* zp = (u32x4*)((bf16_t*)(ws + WS_WIN) + (size_t)IN_DIM * 1024);
            const int zt0 = split ? (bid - 96) * NT + tid : bid * NT + tid, ztn = split ? (G - 96) * NT : G * NT;
            for (int i = zt0; i < (2304 - IN_DIM) * 1024 / 8; i += ztn) zp[i] = (u32x4){0u, 0u, 0u, 0u};
        }
    }
    xcd_barrier(xbar); TSTAMP();
    { FRESH_IDS(); norm_mod_rows(p.in[0], p.in[5], ada, 0, 1024, (bf16_t*)(ws + B_H1), gw, ngw, lane); }
    xcd_barrier(xbar); TSTAMP();
    {
        const pg8::Gemm g{(const bf16_t*)(ws + B_H1), (const bf16_t*)(ws + WS_WIN), T, 2304, 1024, 1024, 1024, 0};
        pg8::StaticOrder SO; SO.init(T, 2304, G, bid);
        const PgProj E{(bf16_t*)(ws + B_PROJ), (float*)(ws + B_GRAW)};
        pg8::gemm_phase<PgProj, pg8::StaticOrder, true, true>(lds, g, SO, E);
    }
    xcd_barrier(xbar); TSTAMP();
    { FRESH_IDS(); post_proj_rows(p, gw, ngw, lane); }
    xcd_barrier(xbar); TSTAMP();
    {
        {   const pg8::Gemm g{(const bf16_t*)(ws + B_CQN), (const bf16_t*)(ws + WS_WUQ), T, 768, QLORA, QLORA, QLORA, 0};
            pg8::StaticOrder SO; SO.init(T, 768, G, bid); const PgBf16 E{(bf16_t*)(ws + B_QRAW), 768};
            pg8::gemm_phase<PgBf16, pg8::StaticOrder, true, true>(lds, g, SO, E); }
        {   const pg8::Gemm g{(const bf16_t*)(ws + B_CKVN), (const bf16_t*)(ws + WS_WUKV), T, 1024, KVLORA, KVLORA, KVLORA, 0};
            pg8::StaticOrder SO; SO.init(T, 1024, G, bid); const PgBf16 E{(bf16_t*)(ws + B_KVRAW), 1024};
            pg8::gemm_phase<PgBf16, pg8::StaticOrder, true, true>(lds, g, SO, E); }
        {   const pg8::Gemm g{(const bf16_t*)(ws + B_ZC), (const bf16_t*)(ws + WS_WMQK), T, 1024, DM, MINNER, DM, DM};
            pg8::StaticOrder SO; SO.init(T, 1024, G, bid); const PgMqk E{(bf16_t*)(ws + B_MQ), (bf16_t*)(ws + B_MK)};
            pg8::gemm_phase<PgMqk, pg8::StaticOrder, true, true>(lds, g, SO, E); }
    }
    xcd_barrier(xbar); TSTAMP();
    { FRESH_IDS(); qk_post_rows(p, gw, ngw, lane); }
    xcd_barrier(xbar); TSTAMP();
    for (int pr = bid; pr < 256; pr += G) { const int bh = pr & 63, j = pr >> 6; attn_unit(p, lds, bh, 7 - j); attn_unit(p, lds, bh, j); }
    for (int u = bid; u < 1024; u += G) mlstm_a_unit(p, lds, u);
    xcd_barrier(xbar); TSTAMP();
    { FRESH_IDS(); mlstm_scan(p, bid * NT + tid, G * NT); }
    { FRESH_IDS(); attn_out_norm_rows(p, gw, ngw, lane); }
    xcd_barrier(xbar); TSTAMP();
    {
        McRegs R;
        if (bid < 1024) mlstm_c_load(p, bid, R);
        for (int u = bid; u < 1024; u += G) mlstm_c_unit(p, lds, u, R, (u + G < 1024) ? u + G : -1);
    }
    xcd_barrier(xbar); TSTAMP();
    {
        const pg8::Gemm g{(const bf16_t*)(ws + B_AO), (const bf16_t*)(ws + WS_WOUT), T, 1024, 1024, 1024, 1024, 0};
        pg8::StaticOrder SO; SO.init(T, 1024, G, bid); const PgResid E{p.in[0], ada, 2048, (bf16_t*)(ws + C_X1)};
        pg8::gemm_phase<PgResid, pg8::StaticOrder, true, true>(lds, g, SO, E);
    }
    xcd_barrier(xbar); TSTAMP();
    { FRESH_IDS(); norm_mod_rows_bf((const bf16_t*)(ws + C_X1), p.in[22], ada, 3072, 4096, (bf16_t*)(ws + C_H2), gw, ngw, lane, ws + C_H2F8); }
    xcd_barrier(xbar); TSTAMP();
    {
        const pg8::Gemm g{(const bf16_t*)(ws + C_H2), (const bf16_t*)(ws + WS_WRGU), T, 768, 1024, 1024, 1024, 0};
        pg8::StaticOrder SO; SO.init(T, 768, G, bid); const PgRgu E{(float*)(ws + C_LOGITS), (bf16_t*)(ws + C_ACTSH)};
        pg8::gemm_phase<PgRgu, pg8::StaticOrder, true, true>(lds, g, SO, E);
    }
    xcd_barrier(xbar); TSTAMP();
    { FRESH_IDS(); route_rows(p, gw, ngw, lane); }
    {
        const pg8::Gemm g{(const bf16_t*)(ws + C_ACTSH), (const bf16_t*)(ws + WS_WDSH), T, 1024, 256, 256, 256, 0};
        pg8::StaticOrder SO; SO.init(T, 1024, G, bid); const PgBf16 E{(bf16_t*)(ws + C_SHOUT), 1024};
        pg8::gemm_phase<PgBf16, pg8::StaticOrder, true, true>(lds, g, SO, E);
    }
    xcd_barrier(xbar); TSTAMP();
    LAS int* base = (LAS int*)(lds + 132 * 1024);
    LAS int* tsx = base + 256;
    const int ngrp = (G % 8 == 0) ? 8 : 1, gx = bid % ngrp, gidx = bid / ngrp, gper = G / ngrp, nexp = NE / ngrp;
    { FRESH_IDS(); expert_prefix(p, base, tsx, tid, gx, ngrp); }
    {
        const int* cnt = (const int*)(ws + WS_CNT);
        const int ntile = tsx[nexp];
        for (int u = gidx; u < ntile * 4; u += gper) {
            const int tg = u >> 2, tn = u & 3;
            int lo = 0, hi = nexp - 1;
            while (lo < hi) { const int mid = (lo + hi + 1) >> 1; if (tsx[mid] <= tg) lo = mid; else hi = mid - 1; }
            const int e = gx + ngrp * lo, blk = tg - tsx[lo], c = __hip_atomic_load(cnt + e * CNT_STRIDE, __ATOMIC_RELAXED, __HIP_MEMORY_SCOPE_AGENT);
            const int nvalid = min(256, c - blk * 256);
            const RowGather RP{(const unsigned char*)(ws + C_H2F8), (const int*)(ws + C_LISTTOK) + (size_t)e * CAP + blk * 256, nvalid};
            const ColGU CP{p.in[25] + (size_t)e * 1024 * 256, p.in[26] - p.in[25]};
            const EpiExpAct E{(unsigned char*)(ws + C_ACTE), base[e] + blk * 256, nvalid};
            gemm2_tile(lds, RP, CP, 256, 1024, 0, tn * 128, E, nvalid);
        }
    }
    xcd_barrier(xbar); TSTAMP();
    {
        const int* cnt = (const int*)(ws + WS_CNT);
        const int ntile = tsx[nexp];
        for (int u = gidx; u < ntile * 2; u += gper) {
            const int tg = u >> 1, nq = u & 1;
            int lo = 0, hi = nexp - 1;
            while (lo < hi) { const int mid = (lo + hi + 1) >> 1; if (tsx[mid] <= tg) lo = mid; else hi = mid - 1; }
            const int e = gx + ngrp * lo, blk = tg - tsx[lo], c = __hip_atomic_load(cnt + e * CNT_STRIDE, __ATOMIC_RELAXED, __HIP_MEMORY_SCOPE_AGENT);
            const int nvalid = min(256, c - blk * 256);
            const int slot0 = base[e] + blk * 256;
            expert_down_unit(lds, (const unsigned char*)(ws + C_ACTE), p.in[27] + (size_t)e * 256 * 1024, nq, (unsigned char*)(ws + C_Y),
                             (const float*)(ws + C_LISTW) + (size_t)e * CAP + blk * 256, slot0, nvalid);
        }
    }
    xcd_barrier(xbar); TSTAMP();
    { FRESH_IDS(); combine_rows(p, base, gw, ngw, lane); }
#if DBG_STAGE == 2
    xcd_barrier(xbar); TSTAMP();
    xcd_barrier(xbar);
    {   FRESH_IDS();
        const unsigned long long* ts = (const unsigned long long*)(ws + WS_CTL + 16384 + 8192);
        const float tus = (float)(long long)(ts[TS_A1] - ts[TS_A0]) * 0.01f;
        const float cadd = sqrtf(2.5e-3f * tus * (1.f / 500.f));
        for (size_t i = (size_t)bid * NT + tid; i < (size_t)T * D / 4; i += (size_t)G * NT) { f32x4 v = ((f32x4*)p.out)[i]; v = v + cadd; ((f32x4*)p.out)[i] = v; }
    }
#endif
}

extern "C" void kernel_launch(void* const* d_in, const int* in_sizes, int n_in,
                              void* d_out, int out_size, void* d_ws, size_t ws_size,
                              hipStream_t stream) {
    static int grid_blocks = 0;
    if (!grid_blocks) {
        if (n_in != 31 || out_size != T * D || ws_size < WS_END) { fprintf(stderr, "kernel_launch: unexpected shapes n_in=%d out=%d ws=%zu (need %zu)\n", n_in, out_size, ws_size, (size_t)WS_END); grid_blocks = -1; return; }
        int dev = 0, cus = 0, per_cu = 0;
        (void)hipGetDevice(&dev);
        (void)hipDeviceGetAttribute(&cus, hipDeviceAttributeMultiprocessorCount, dev);
        (void)hipFuncSetAttribute((const void*)fwd_kernel, hipFuncAttributeMaxDynamicSharedMemorySize, LDS_BYTES);
        (void)hipOccupancyMaxActiveBlocksPerMultiprocessor(&per_cu, (const void*)fwd_kernel, NT, LDS_BYTES);
        if (per_cu < 1) per_cu = 1;
        grid_blocks = cus * per_cu;
        fprintf(stderr, "kernel_launch: cus=%d per_cu=%d grid=%d ws=%zu\n", cus, per_cu, grid_blocks, ws_size);
    }
    if (grid_blocks < 0) return;
    (void)hipMemsetAsync((char*)d_ws + WS_CTL, 0, CTL_BYTES, stream);
    Params p{};
    for (int i = 0; i < 31; ++i) p.in[i] = (const float*)d_in[i];
    p.out = (float*)d_out; p.ws = (unsigned char*)d_ws;
    void* args[] = {&p};
    hipError_t e = hipLaunchCooperativeKernel((const void*)fwd_kernel, dim3(grid_blocks), dim3(NT), args, LDS_BYTES, stream);
    if (e != hipSuccess) fprintf(stderr, "cooperative launch failed: %s (grid %d)\n", hipGetErrorString(e), grid_blocks);
}
```

```cpp
#include <hip/hip_runtime.h>
#include <hip/hip_cooperative_groups.h>
#include <cstdio>
#include <cstdint>
namespace cg = cooperative_groups;
#ifndef DBG_STAGE
#define DBG_STAGE 0
#endif
#define TS_A0 2
#define TS_A1 3
#define TS_B0 2
#define TS_B1 3

#define LAS __attribute__((address_space(3)))
typedef unsigned short bf16_t;
typedef short bf16x8 __attribute__((ext_vector_type(8)));
typedef short bf16x4 __attribute__((ext_vector_type(4)));
typedef float f32x4 __attribute__((ext_vector_type(4)));
typedef float f32x2 __attribute__((ext_vector_type(2)));
typedef unsigned u32x4 __attribute__((ext_vector_type(4)));
typedef unsigned u32x2 __attribute__((ext_vector_type(2)));

constexpr int NT = 512, NWAVES = 8;
constexpr int LDS_BYTES = 144 * 1024;
constexpr int Bsz = 8, S = 2048, D = 1024, T = Bsz * S;
constexpr int H_MLA = 8, DQK = 96, DNOPE = 64, DROPE = 32, DV = 64, QLORA = 384, KVLORA = 256;
constexpr int H_ML = 4, DM = 128, MINNER = 512, CHUNK = 64, NCH = S / CHUNK;
constexpr int IN_DIM = 2216;
constexpr int OFF_CQ = 0, OFF_CKV = 384, OFF_KR = 640, OFF_Z = 672, OFF_MV = 1184, OFF_MO = 1696, OFF_GATE = 2208;
constexpr int NE = 256, TOPK = 8, EDIM = 256, SDIM = 256;
constexpr int CAP = T;
constexpr float RMS_EPS = 1e-6f;

constexpr size_t MiB = 1u << 20;
constexpr size_t WS_CTL = 0;
constexpr size_t CTL_BYTES = 65536;
constexpr size_t WS_CNT = 32768;
constexpr int CNT_STRIDE = 32;
constexpr size_t WS_ADA = 1 * MiB;
constexpr size_t WS_BC = 2 * MiB;
constexpr size_t WS_MLOC = WS_BC + 8192;
constexpr size_t WS_MPREV = WS_BC + 16384;
constexpr size_t WS_DN = 2 * MiB + 512 * 1024;
constexpr size_t WS_NPREV = 3 * MiB;
constexpr size_t WS_WIN = 4 * MiB;
constexpr size_t WS_WUQ = 9 * MiB;
constexpr size_t WS_WUKV = 10 * MiB;
constexpr size_t WS_WMQK = 11 * MiB;
constexpr size_t WS_WOUT = 12 * MiB;
constexpr size_t WS_WRGU = 14 * MiB;
constexpr size_t WS_WDSH = 16 * MiB;
constexpr size_t WS_TICKET8 = WS_CTL + 18432;
constexpr size_t WS_TICKET9 = WS_CTL + 20480;
constexpr size_t RB = 416 * MiB;
constexpr size_t B_PROJ = RB;
constexpr size_t B_GRAW = RB + 70 * MiB;
constexpr size_t B_GL = RB + 71 * MiB;
constexpr size_t B_H1 = RB + 72 * MiB;
constexpr size_t B_CQN = RB + 104 * MiB;
constexpr size_t B_CKVN = RB + 116 * MiB;
constexpr size_t B_ZC = RB + 124 * MiB;
constexpr size_t B_QRAW = RB + 140 * MiB;
constexpr size_t B_KVRAW = RB + 164 * MiB;
constexpr size_t B_MQ = RB + 196 * MiB;
constexpr size_t B_MK = RB + 212 * MiB;
constexpr size_t B_Q = RB + 228 * MiB;
constexpr size_t B_K = RB + 252 * MiB;
constexpr size_t B_ORAW = RB + 276 * MiB;
constexpr size_t B_AO = RB + 292 * MiB;
constexpr size_t B_DC = RB + 324 * MiB;
constexpr size_t B_CPREV = RB + 388 * MiB;
constexpr size_t C_H2 = RB;
constexpr size_t C_LOGITS = RB + 32 * MiB;
constexpr size_t C_ACTSH = RB + 48 * MiB;
constexpr size_t C_SHOUT = RB + 56 * MiB;
constexpr size_t C_TOKE = RB + 88 * MiB;
constexpr size_t C_TOKW = RB + 89 * MiB;
constexpr size_t C_TOKPOS = RB + 90 * MiB;
constexpr size_t C_LISTTOK = RB + 92 * MiB;
constexpr size_t C_LISTW = RB + 108 * MiB;
constexpr size_t C_ACTE = RB + 124 * MiB;
constexpr size_t C_Y = RB + 188 * MiB;
constexpr size_t C_H2F8 = RB + 320 * MiB;
constexpr size_t C_X1 = RB + 340 * MiB;
constexpr size_t WS_END = RB + 444 * MiB;

struct Params {
    const float* in[31];
    float* out;
    unsigned char* ws;
};

typedef __bf16 bf16x2v __attribute__((ext_vector_type(2)));
__device__ __forceinline__ unsigned cvt_pk_bf16(float lo, float hi) { f32x2 v = {lo, hi}; bf16x2v b = __builtin_convertvector(v, bf16x2v); return __builtin_bit_cast(unsigned, b); }
__device__ __forceinline__ unsigned pk4_fp8(float a, float b, float c, float d) { int p = __builtin_amdgcn_cvt_pk_fp8_f32(a, b, 0, false); p = __builtin_amdgcn_cvt_pk_fp8_f32(c, d, p, true); return (unsigned)p; }
__device__ __forceinline__ float bf2f(unsigned short b) { return __uint_as_float((unsigned)b << 16); }
__device__ __forceinline__ float bflo(unsigned u) { return __uint_as_float(u << 16); }
__device__ __forceinline__ float bfhi(unsigned u) { return __uint_as_float(u & 0xffff0000u); }
__device__ __forceinline__ float wave_sum(float v) {
#pragma unroll
    for (int o = 1; o < 64; o <<= 1) v += __shfl_xor(v, o);
    return v;
}
__device__ __forceinline__ float wave_max(float v) {
#pragma unroll
    for (int o = 1; o < 64; o <<= 1) v = fmaxf(v, __shfl_xor(v, o));
    return v;
}
__device__ __forceinline__ float sigmoidf_(float x) { return __builtin_amdgcn_rcpf(1.f + __builtin_amdgcn_exp2f(-1.4426950408889634f * x)); }
__device__ __forceinline__ float siluf_(float x) { return x * __builtin_amdgcn_rcpf(1.f + __builtin_amdgcn_exp2f(-1.4426950408889634f * x)); }
__device__ __forceinline__ int fresh_tid() { int t = threadIdx.x; asm volatile("" : "+v"(t)); return t; }
#define MFMA16(a, b, c) __builtin_amdgcn_mfma_f32_16x16x32_bf16((a), (b), (c), 0, 0, 0)


#define XB_TMO      128
#define XB_XCNT(j)  (256  + 64 * (j))
#define XB_XSUB(j)  (1280 + 64 * (j))
#define XB_XGEN(j)  (2304 + 64 * (j))
#define XB_TOP      3328
#define XB_TOPGEN   3392
#define XCD_BAR_WORDS 3456
#define XB_SPIN_CAP (1u << 23)
__device__ __forceinline__ unsigned xb_ld(unsigned* p)              { return __hip_atomic_load(p, __ATOMIC_RELAXED, __HIP_MEMORY_SCOPE_AGENT); }
__device__ __forceinline__ unsigned xb_add(unsigned* p, unsigned v) { return __hip_atomic_fetch_add(p, v, __ATOMIC_RELAXED, __HIP_MEMORY_SCOPE_AGENT); }
__device__ __forceinline__ unsigned xb_xcc_id() { return (unsigned)__builtin_amdgcn_s_getreg((3 << 11) | 20) & 0xFu; }
#define XB_SPIN(cond, bar) do { unsigned _sp = 0; while (cond) { __builtin_amdgcn_s_sleep(1); \
    if ((++_sp & 255u) == 0u) { if (xb_ld(&(bar)[XB_TMO])) break; if (_sp > XB_SPIN_CAP) { atomicAdd(&(bar)[XB_TMO], 1u); break; } } } } while (0)
struct XcdBarrier { unsigned* bar; unsigned x; volatile LAS unsigned* st; };
__device__ __forceinline__ XcdBarrier xcd_barrier_post(unsigned* bar, volatile LAS unsigned* st) {
    XcdBarrier b; b.bar = bar; b.x = xb_xcc_id(); b.st = st;
    if (threadIdx.x == 0) (void)xb_add(&bar[XB_XCNT(b.x)], 1u);
    return b;
}
__device__ __forceinline__ void xcd_barrier_complete(unsigned* bar, unsigned x, unsigned& nloc, unsigned& nx) {
    const unsigned G = gridDim.x * gridDim.y * gridDim.z;
    unsigned sum, cnt, mine, sp = 0u;
    for (;;) {
        sum = 0u; cnt = 0u; mine = 0u;
#pragma unroll
        for (unsigned j = 0; j < 16; ++j) { const unsigned c = xb_ld(&bar[XB_XCNT(j)]); sum += c; cnt += (c > 0u) ? 1u : 0u; mine = (j == x) ? c : mine; }
        if (sum == G) break;
        __builtin_amdgcn_s_sleep(1);
        if ((++sp & 255u) == 0u) { if (xb_ld(&bar[XB_TMO])) break; if (sp > XB_SPIN_CAP) { atomicAdd(&bar[XB_TMO], 1u); break; } }
    }
    nloc = mine > 0u ? mine : 1u; nx = cnt > 0u ? cnt : 1u;
}
__device__ __forceinline__ void xcd_barrier(const XcdBarrier& b) {
    asm volatile("s_waitcnt vmcnt(0)" ::: "memory");
    __syncthreads();
    if (threadIdx.x == 0) {
        unsigned* bar = b.bar;
        __builtin_amdgcn_s_waitcnt(0);
        unsigned nloc = b.st[0], nx = b.st[1];
        if (nloc == 0u) { xcd_barrier_complete(bar, b.x, nloc, nx); b.st[0] = nloc; b.st[1] = nx; }
        const unsigned old = xb_add(&bar[XB_XSUB(b.x)], 1u);
        const unsigned gen = old / nloc;
        if (old + 1u == (gen + 1u) * nloc) {
            __builtin_amdgcn_fence(__ATOMIC_RELEASE, "agent");
            asm volatile("s_waitcnt vmcnt(0)" ::: "memory");
            const unsigned og = xb_add(&bar[XB_TOP], 1u);
            const unsigned tg = og / nx;
            if (og + 1u == (tg + 1u) * nx) xb_add(&bar[XB_TOPGEN], 1u);
            else XB_SPIN(xb_ld(&bar[XB_TOPGEN]) == tg, bar);
            __builtin_amdgcn_fence(__ATOMIC_ACQUIRE, "agent");
            xb_add(&bar[XB_XGEN(b.x)], 1u);
            asm volatile("s_waitcnt vmcnt(0)" ::: "memory");
        } else {
            XB_SPIN(xb_ld(&bar[XB_XGEN(b.x)]) == gen, bar);
            __builtin_amdgcn_fence(__ATOMIC_ACQUIRE, "agent");
            asm volatile("s_waitcnt vmcnt(0)" ::: "memory");
        }
    }
    __syncthreads();
}

template <int MAP>
__device__ __forceinline__ int map_row(int n) {
    if (MAP == 0) return n;
    if (MAP == 1) return ((n >> 4) << 5) + (n & 15);
    return ((n >> 4) << 5) + 16 + (n & 15);
}
template <int MAP>
__device__ __forceinline__ void conv_item(const float* src, int K, int N, bf16_t* dst, size_t dst_mat_stride, int row_off, LAS float* scr, int it, int lane) {
    const int nblk = (N + 31) / 32, kblk = K / 64, per = nblk * kblk;
    const int mat = it / per, r = it - mat * per, kb = r / nblk, nb = r - kb * nblk, k0 = kb * 64, n0 = nb * 32;
    const float* W = src + (size_t)mat * K * N;
    bf16_t* WT = dst + (size_t)mat * dst_mat_stride;
    const int nn = n0 + (lane & 31);
    const bool nok = nn < N;
    float v[32];
    const float* wp = W + (size_t)(k0 + (lane >> 5)) * N + nn;
#pragma unroll
    for (int i = 0; i < 32; ++i) v[i] = nok ? wp[(size_t)(2 * i) * N] : 0.f;
#pragma unroll
    for (int i = 0; i < 32; ++i) scr[(2 * i + (lane >> 5)) * 33 + (lane & 31)] = v[i];
    asm volatile("s_waitcnt lgkmcnt(0)" ::: "memory");
    const int c = lane & 7;
#pragma unroll
    for (int j = 0; j < 4; ++j) {
        const int n = (lane >> 3) + 8 * j;
        const LAS float* sp = scr + (8 * c) * 33 + n;
        u32x4 o; o.x = cvt_pk_bf16(sp[0 * 33], sp[1 * 33]); o.y = cvt_pk_bf16(sp[2 * 33], sp[3 * 33]); o.z = cvt_pk_bf16(sp[4 * 33], sp[5 * 33]); o.w = cvt_pk_bf16(sp[6 * 33], sp[7 * 33]);
        if (n0 + n < N) *(u32x4*)(WT + (size_t)(row_off + map_row<MAP>(n0 + n)) * K + k0 + 8 * c) = o;
    }
    asm volatile("s_waitcnt lgkmcnt(0)" ::: "memory");
}

__device__ __forceinline__ void ada_unit(const Params& p, LAS unsigned char* lds, int u, int tid) {
    LAS float* cond = (LAS float*)lds;
    LAS float* red = (LAS float*)(lds + 16384);
    const float* c = p.in[1]; const float* w = p.in[3]; const float* bias = p.in[4];
    float* ada = (float*)(p.ws + WS_ADA);
    const int lane = tid & 63, wv = tid >> 6, cg = u >> 1, kh = u & 1;
    for (int i = tid; i < 8 * 512; i += NT) { const int b = i >> 9, k = i & 511; cond[i] = siluf_(c[b * 1024 + kh * 512 + k]); }
    __syncthreads();
    float acc[8];
#pragma unroll
    for (int b = 0; b < 8; ++b) acc[b] = 0.f;
    const int col = cg * 64 + lane;
    const float* wp = w + (size_t)(kh * 512 + wv * 64) * 6144 + col;
#pragma unroll 16
    for (int k = 0; k < 64; ++k) {
        const float wv_ = wp[(size_t)k * 6144];
#pragma unroll
        for (int b = 0; b < 8; ++b) acc[b] += cond[b * 512 + wv * 64 + k] * wv_;
    }
#pragma unroll
    for (int b = 0; b < 8; ++b) red[(wv * 8 + b) * 64 + lane] = acc[b];
    __syncthreads();
    {
        const int b = tid >> 6;
        float sacc = 0.f;
#pragma unroll
        for (int w2 = 0; w2 < 8; ++w2) sacc += red[(w2 * 8 + b) * 64 + lane];
        atomicAdd(&ada[b * 6144 + col], sacc + (kh == 0 ? bias[col] : 0.f));
    }
    __syncthreads();
}

__device__ __forceinline__ void norm_mod_rows_bf(const bf16_t* X, const float* g, const float* ada, int sh_off, int sc_off, bf16_t* Hout, int gw, int ngw, int lane, unsigned char* H8) {
    u32x2 nx[4];
    if (gw < T) {
#pragma unroll
        for (int j = 0; j < 4; ++j) nx[j] = *((const u32x2*)(X + (size_t)gw * D) + lane + 64 * j);
    }
    f32x4 gg[4];
#pragma unroll
    for (int j = 0; j < 4; ++j) gg[j] = *(const f32x4*)(g + 4 * (lane + 64 * j));
    for (int row = gw; row < T; row += ngw) {
        const int b = row / S;
        f32x4 v[4]; float ss = 0.f;
#pragma unroll
        for (int j = 0; j < 4; ++j) { v[j].x = bflo(nx[j].x); v[j].y = bfhi(nx[j].x); v[j].z = bflo(nx[j].y); v[j].w = bfhi(nx[j].y); }
        if (row + ngw < T) {
#pragma unroll
            for (int j = 0; j < 4; ++j) nx[j] = *((const u32x2*)(X + (size_t)(row + ngw) * D) + lane + 64 * j);
        }
        f32x4 sc[4], sh[4];
#pragma unroll
        for (int j = 0; j < 4; ++j) { const int k = 4 * (lane + 64 * j);
            sc[j] = *(const f32x4*)(ada + b * 6144 + sc_off + k); sh[j] = *(const f32x4*)(ada + b * 6144 + sh_off + k); }
#pragma unroll
        for (int j = 0; j < 4; ++j) ss += v[j].x * v[j].x + v[j].y * v[j].y + v[j].z * v[j].z + v[j].w * v[j].w;
        const float rinv = rsqrtf(wave_sum(ss) * (1.f / D) + RMS_EPS);
        u32x2* o = (u32x2*)(Hout + (size_t)row * D) + lane;
#pragma unroll
        for (int j = 0; j < 4; ++j) {
            const f32x4 h = v[j] * rinv * gg[j] * (1.f + sc[j]) + sh[j];
            u32x2 w; w.x = cvt_pk_bf16(h.x, h.y); w.y = cvt_pk_bf16(h.z, h.w);
            o[64 * j] = w;
            *((unsigned*)(H8 + (size_t)row * D) + lane + 64 * j) = pk4_fp8(h.x, h.y, h.z, h.w);
        }
    }
}
__device__ __forceinline__ void norm_mod_rows(const float* X, const float* g, const float* ada, int sh_off, int sc_off, bf16_t* Hout, int gw, int ngw, int lane, unsigned char* H8 = nullptr) {
    f32x4 nx[4];
    if (gw < T) {
#pragma unroll
        for (int j = 0; j < 4; ++j) nx[j] = *((const f32x4*)(X + (size_t)gw * D) + lane + 64 * j);
    }
    f32x4 gg[4];
#pragma unroll
    for (int j = 0; j < 4; ++j) gg[j] = *(const f32x4*)(g + 4 * (lane + 64 * j));
    for (int row = gw; row < T; row += ngw) {
        const int b = row / S;
        f32x4 v[4]; float ss = 0.f;
#pragma unroll
        for (int j = 0; j < 4; ++j) v[j] = nx[j];
        if (row + ngw < T) {
#pragma unroll
            for (int j = 0; j < 4; ++j) nx[j] = *((const f32x4*)(X + (size_t)(row + ngw) * D) + lane + 64 * j);
        }
        f32x4 sc[4], sh[4];
#pragma unroll
        for (int j = 0; j < 4; ++j) { const int k = 4 * (lane + 64 * j);
            sc[j] = *(const f32x4*)(ada + b * 6144 + sc_off + k); sh[j] = *(const f32x4*)(ada + b * 6144 + sh_off + k); }
#pragma unroll
        for (int j = 0; j < 4; ++j) ss += v[j].x * v[j].x + v[j].y * v[j].y + v[j].z * v[j].z + v[j].w * v[j].w;
        const float rinv = rsqrtf(wave_sum(ss) * (1.f / D) + RMS_EPS);
        u32x2* o = (u32x2*)(Hout + (size_t)row * D) + lane;
#pragma unroll
        for (int j = 0; j < 4; ++j) {
            const f32x4 h = v[j] * rinv * gg[j] * (1.f + sc[j]) + sh[j];
            u32x2 w; w.x = cvt_pk_bf16(h.x, h.y); w.y = cvt_pk_bf16(h.z, h.w);
            o[64 * j] = w;
            if (H8) *((unsigned*)(H8 + (size_t)row * D) + lane + 64 * j) = pk4_fp8(h.x, h.y, h.z, h.w);
        }
    }
}

__device__ __forceinline__ void post_proj_rows(const Params& p, int gw, int ngw, int lane) {
    const bf16_t* proj = (const bf16_t*)(p.ws + B_PROJ);
    const float* graw = (const float*)(p.ws + B_GRAW);
    float* gl = (float*)(p.ws + B_GL);
    bf16_t* cqn = (bf16_t*)(p.ws + B_CQN); bf16_t* ckvn = (bf16_t*)(p.ws + B_CKVN); bf16_t* zc = (bf16_t*)(p.ws + B_ZC);
    const float* g_cq = p.in[7]; const float* g_ckv = p.in[9]; const float* conv_w = p.in[14]; const float* conv_b = p.in[15];
    const int c0 = lane * 8;
    float gq[6], gk[4], cw[4][8], cbv[8];
#pragma unroll
    for (int j = 0; j < 6; ++j) gq[j] = g_cq[lane * 6 + j];
#pragma unroll
    for (int j = 0; j < 4; ++j) gk[j] = g_ckv[lane * 4 + j];
#pragma unroll
    for (int tap = 0; tap < 4; ++tap)
#pragma unroll
        for (int j = 0; j < 8; ++j) cw[tap][j] = conv_w[tap * MINNER + c0 + j];
#pragma unroll
    for (int j = 0; j < 8; ++j) cbv[j] = conv_b[c0 + j];
    const float gbias = (lane < 4) ? p.in[18][lane] : (lane < 8 ? p.in[19][lane - 4] : 0.f);
    for (int row = gw; row < T; row += ngw) {
        const bf16_t* pr = proj + (size_t)row * IN_DIM;
        const int s = row % S;
        const unsigned* q = (const unsigned*)(pr + OFF_CQ) + lane * 3;
        const unsigned a0 = q[0], a1 = q[1], a2 = q[2];
        const u32x2 kvv = *((const u32x2*)(pr + OFF_CKV) + lane);
        u32x4 z[4];
#pragma unroll
        for (int tap = 0; tap < 4; ++tap) { const int ds = tap - 3; z[tap] = (s + ds >= 0) ? *(const u32x4*)(pr + (ptrdiff_t)ds * IN_DIM + OFF_Z + c0) : (u32x4){0u, 0u, 0u, 0u}; }
        const float gr = (lane < 8) ? graw[(size_t)row * 8 + lane] : 0.f;
        {
            float f[6] = {bflo(a0), bfhi(a0), bflo(a1), bfhi(a1), bflo(a2), bfhi(a2)};
            float ss = 0.f;
#pragma unroll
            for (int j = 0; j < 6; ++j) ss += f[j] * f[j];
            const float rinv = rsqrtf(wave_sum(ss) * (1.f / QLORA) + RMS_EPS);
            unsigned* o = (unsigned*)(cqn + (size_t)row * QLORA) + lane * 3;
            o[0] = cvt_pk_bf16(f[0] * rinv * gq[0], f[1] * rinv * gq[1]);
            o[1] = cvt_pk_bf16(f[2] * rinv * gq[2], f[3] * rinv * gq[3]);
            o[2] = cvt_pk_bf16(f[4] * rinv * gq[4], f[5] * rinv * gq[5]);
        }
        {
            float f[4] = {bflo(kvv.x), bfhi(kvv.x), bflo(kvv.y), bfhi(kvv.y)};
            float ss = f[0] * f[0] + f[1] * f[1] + f[2] * f[2] + f[3] * f[3];
            const float rinv = rsqrtf(wave_sum(ss) * (1.f / KVLORA) + RMS_EPS);
            u32x2 w; w.x = cvt_pk_bf16(f[0] * rinv * gk[0], f[1] * rinv * gk[1]); w.y = cvt_pk_bf16(f[2] * rinv * gk[2], f[3] * rinv * gk[3]);
            *((u32x2*)(ckvn + (size_t)row * KVLORA) + lane) = w;
        }
        {
            float acc[8];
#pragma unroll
            for (int j = 0; j < 8; ++j) acc[j] = cbv[j];
#pragma unroll
            for (int tap = 0; tap < 4; ++tap) {
                acc[0] += bflo(z[tap].x) * cw[tap][0]; acc[1] += bfhi(z[tap].x) * cw[tap][1]; acc[2] += bflo(z[tap].y) * cw[tap][2]; acc[3] += bfhi(z[tap].y) * cw[tap][3];
                acc[4] += bflo(z[tap].z) * cw[tap][4]; acc[5] += bfhi(z[tap].z) * cw[tap][5]; acc[6] += bflo(z[tap].w) * cw[tap][6]; acc[7] += bfhi(z[tap].w) * cw[tap][7];
            }
            u32x4 o; o.x = cvt_pk_bf16(siluf_(acc[0]), siluf_(acc[1])); o.y = cvt_pk_bf16(siluf_(acc[2]), siluf_(acc[3]));
            o.z = cvt_pk_bf16(siluf_(acc[4]), siluf_(acc[5])); o.w = cvt_pk_bf16(siluf_(acc[6]), siluf_(acc[7]));
            *(u32x4*)(zc + (size_t)row * MINNER + c0) = o;
        }
        if (lane < 8) {
            const float xx = gr + gbias;
            gl[(size_t)row * 8 + lane] = (lane < 4) ? xx : (fminf(xx, 0.f) - log1pf(__expf(-fabsf(xx))));
        }
    }
}

__device__ __forceinline__ void qk_post_rows(const Params& p, int gw, int ngw, int lane) {
    const bf16_t* qraw = (const bf16_t*)(p.ws + B_QRAW); const bf16_t* kvraw = (const bf16_t*)(p.ws + B_KVRAW);
    const bf16_t* proj = (const bf16_t*)(p.ws + B_PROJ);
    bf16_t* Q = (bf16_t*)(p.ws + B_Q); bf16_t* Kb = (bf16_t*)(p.ws + B_K);
    const int* positions = (const int*)p.in[2];
    const float* g_qn = p.in[11]; const float* g_kn = p.in[12];
    const float qscale = 0.10206207261596575f * 1.4426950408889634f;
    const int l = lane & 31, hsel = lane >> 5, i = l & 15;
    const float inv_freq = exp2f(-(float)(2 * i) * (13.287712379549449f / 32.f));
    const float gq0 = g_qn[l], gq1 = g_qn[l + 32], gq2 = g_qn[l + 64], gk0 = g_kn[l], gk1 = g_kn[l + 32], gk2 = g_kn[l + 64];
    for (int row = gw; row < T; row += ngw) {
        const int b = row / S, s = row % S;
        float qv[4][3], kv[4][2];
#pragma unroll
        for (int hp = 0; hp < 4; ++hp) {
            const int h = hp * 2 + hsel;
            const bf16_t* qr = qraw + (size_t)row * 768 + h * 96; const bf16_t* kr = kvraw + (size_t)row * 1024 + h * 128;
            qv[hp][0] = bf2f(qr[l]); qv[hp][1] = bf2f(qr[l + 32]); qv[hp][2] = bf2f(qr[l + 64]);
            kv[hp][0] = bf2f(kr[l]); kv[hp][1] = bf2f(kr[l + 32]);
        }
        const float krope = bf2f(proj[(size_t)row * IN_DIM + OFF_KR + l]);
        const float ang = (float)positions[row] * inv_freq;
        const float sn = __sinf(ang), cs = __cosf(ang);
#pragma unroll
        for (int hp = 0; hp < 4; ++hp) {
            const int h = hp * 2 + hsel;
            {
                float v0 = qv[hp][0], v1 = qv[hp][1], v2 = qv[hp][2];
                float ss = v0 * v0 + v1 * v1 + v2 * v2;
#pragma unroll
                for (int o = 1; o < 32; o <<= 1) ss += __shfl_xor(ss, o);
                const float rinv = rsqrtf(ss * (1.f / 96.f) + RMS_EPS);
                v0 *= rinv * gq0; v1 *= rinv * gq1; v2 *= rinv * gq2;
                const float other = __shfl_xor(v2, 16);
                const float r = (l < 16) ? (v2 * cs - other * sn) : (other * sn + v2 * cs);
                bf16_t* qo = Q + ((size_t)(b * H_MLA + h) * S + s) * 96;
                qo[l] = (bf16_t)(cvt_pk_bf16(v0 * qscale, 0.f) & 0xffff);
                qo[l + 32] = (bf16_t)(cvt_pk_bf16(v1 * qscale, 0.f) & 0xffff);
                qo[l + 64] = (bf16_t)(cvt_pk_bf16(r * qscale, 0.f) & 0xffff);
            }
            {
                float v0 = kv[hp][0], v1 = kv[hp][1], v2 = krope;
                float ss = v0 * v0 + v1 * v1 + v2 * v2;
#pragma unroll
                for (int o = 1; o < 32; o <<= 1) ss += __shfl_xor(ss, o);
                const float rinv = rsqrtf(ss * (1.f / 96.f) + RMS_EPS);
                v0 *= rinv * gk0; v1 *= rinv * gk1; v2 *= rinv * gk2;
                const float other = __shfl_xor(v2, 16);
                const float r = (l < 16) ? (v2 * cs - other * sn) : (other * sn + v2 * cs);
                bf16_t* ko = Kb + ((size_t)(b * H_MLA + h) * S + s) * 96;
                ko[l] = (bf16_t)(cvt_pk_bf16(v0, 0.f) & 0xffff);
                ko[l + 32] = (bf16_t)(cvt_pk_bf16(v1, 0.f) & 0xffff);
                ko[l + 64] = (bf16_t)(cvt_pk_bf16(r, 0.f) & 0xffff);
            }
        }
    }
}

__device__ __forceinline__ void attn_out_norm_rows(const Params& p, int gw, int ngw, int lane) {
    const bf16_t* oraw = (const bf16_t*)(p.ws + B_ORAW); bf16_t* ao = (bf16_t*)(p.ws + B_AO); const float* g = p.in[13];
    float gg[8];
#pragma unroll
    for (int j = 0; j < 8; ++j) gg[j] = g[lane * 8 + j];
    for (int row = gw; row < T; row += ngw) {
        const u32x4 a = *((const u32x4*)(oraw + (size_t)row * 512) + lane);
        float f[8] = {bflo(a.x), bfhi(a.x), bflo(a.y), bfhi(a.y), bflo(a.z), bfhi(a.z), bflo(a.w), bfhi(a.w)};
        float ss = 0.f;
#pragma unroll
        for (int j = 0; j < 8; ++j) ss += f[j] * f[j];
        const float rinv = rsqrtf(wave_sum(ss) * (1.f / 512.f) + RMS_EPS);
        u32x4 o; o.x = cvt_pk_bf16(f[0] * rinv * gg[0], f[1] * rinv * gg[1]); o.y = cvt_pk_bf16(f[2] * rinv * gg[2], f[3] * rinv * gg[3]);
        o.z = cvt_pk_bf16(f[4] * rinv * gg[4], f[5] * rinv * gg[5]); o.w = cvt_pk_bf16(f[6] * rinv * gg[6], f[7] * rinv * gg[7]);
        *((u32x4*)(ao + (size_t)row * 1024) + lane) = o;
    }
}

namespace pg8 {
#define PG8_LAS __attribute__((address_space(3)))
typedef unsigned short bf16_t;
typedef short bf16x8 __attribute__((ext_vector_type(8)));
typedef float f32x4 __attribute__((ext_vector_type(4)));
typedef unsigned u32x4 __attribute__((ext_vector_type(4)));
constexpr int BM = 256, BK = 64, HALF = 128, HTB = HALF * BK * 2  , STAGE_BYTES = 8 * HTB, NXCD = 8, WGM = 8;

__host__ __device__ __forceinline__ int lds_byte(int r, int c) { const int st = (r >> 4) * 2 + (c >> 5), rr = r & 15, cc = c & 31, ob = rr * 64 + cc * 2; return st * 1024 + (ob ^ (((ob >> 9) & 1) << 5)); }
__host__ __device__ __forceinline__ void stage_rc(int b, int& R, int& C) { const int st = b / 1024, sb = b % 1024, swz = sb ^ (((sb >> 9) & 1) << 5); R = (st >> 1) * 16 + swz / 64; C = (st & 1) * 32 + (swz % 64) / 2; }
__host__ __device__ __forceinline__ int perm32(int rho) { const int n = rho >> 4, i = rho & 15; return 8 * (i >> 2) + 4 * n + (i & 3); }

struct Unit { int pm, pn; };
struct Gemm { const bf16_t* A; const bf16_t* Bt; int M, N, K, lda, ldb, apn; };

struct StaticOrder {
    int nM, nN, nwg, G, c;
    __host__ __device__ void init(int M, int N, int G_, int c_) { nM = M / BM; nN = N / BM; nwg = nM * nN; G = G_; c = c_; }
    __host__ __device__ bool next(int i, Unit& u) const {
        const long L = (long)i * G + c; if (L >= nwg) return false;
        int wgid = (int)L; { const int q = nwg / NXCD, r = nwg % NXCD, xcd = wgid % NXCD, off = wgid / NXCD; wgid = (xcd < r ? xcd * (q + 1) : r * (q + 1) + (xcd - r) * q) + off; }
        const int nig = WGM * nN, gid = wgid / nig, fm = gid * WGM, gsz = (nM - fm) < WGM ? (nM - fm) : WGM;
        u.pm = fm + ((wgid % nig) % gsz); u.pn = (wgid % nig) / gsz; return true;
    }
    __device__ __forceinline__ void a_ready(const Unit&) const {}
    __device__ __forceinline__ void done(const Unit&) const {}
};


template <class Epi, class Sched, bool ALIGN_EPI = false, bool SP2 = false>
__device__ __forceinline__ void gemm_phase(PG8_LAS unsigned char* lds, const Gemm g, const Sched& S, const Epi& E) {
    const int tid = fresh_tid(), wid = __builtin_amdgcn_readfirstlane(tid >> 6), lane = tid & 63, wr = wid >> 2, wc = wid & 3, fr = lane & 15, fq = lane >> 4;
    const int K = g.K, nt = K / BK;
    unsigned voffA[2], voffB[2];
#pragma unroll
    for (int i = 0; i < 2; ++i) { int R, C; stage_rc(tid * 16 + i * 8192, R, C); const int Rb = Epi::PERM ? ((R & ~31) + perm32(R & 31)) : R;
        voffA[i] = (unsigned)(R * g.lda + C) * 2u; voffB[i] = (unsigned)(Rb * g.ldb + C) * 2u; }
    const size_t kstep = (size_t)(BK * 2);
    const size_t hstepA = (size_t)HALF * g.lda * 2, hstepB = (size_t)HALF * g.ldb * 2;
    const size_t tstepA = 2 * hstepA, tstepB = 2 * hstepB;
    const unsigned ldsw = (unsigned)wid * 1024u;
    const int aoff = lds_byte(wr * 64 + fr, fq * 8), boff = lds_byte(wc * 32 + fr, fq * 8);
#define PG8_SA(b, h) (((b) * 2 + (h)) * HTB)
#define PG8_SB(b, h) ((4 + (b) * 2 + (h)) * HTB)
#define PG8_STAGE(bufoff, gbase, voff) do { _Pragma("unroll") for (int _i = 0; _i < 2; ++_i) \
        __builtin_amdgcn_global_load_lds((const unsigned*)((const char*)(gbase) + (voff)[_i]), (PG8_LAS unsigned*)(lds + (bufoff) + ldsw + _i * 8192), 16, 0, 0); } while (0)
#define PG8_LDA(dst, b, h) do { _Pragma("unroll") for (int m = 0; m < 4; ++m) _Pragma("unroll") for (int k = 0; k < 2; ++k) dst[m][k] = *(const PG8_LAS bf16x8*)(lds + PG8_SA(b, h) + aoff + m * 2048 + k * 1024); } while (0)
#define PG8_LDB(dst, b, h) do { _Pragma("unroll") for (int n = 0; n < 2; ++n) _Pragma("unroll") for (int k = 0; k < 2; ++k) dst[n][k] = *(const PG8_LAS bf16x8*)(lds + PG8_SB(b, h) + boff + n * 2048 + k * 1024); } while (0)
#define PG8_MMA(ai, bj, At, Bt) do { __builtin_amdgcn_s_setprio(1); _Pragma("unroll") for (int m = 0; m < 4; ++m) _Pragma("unroll") for (int n = 0; n < 2; ++n) _Pragma("unroll") for (int k = 0; k < 2; ++k) \
        acc[ai][bj][m][n] = __builtin_amdgcn_mfma_f32_16x16x32_bf16(Bt[n][k], At[m][k], acc[ai][bj][m][n], 0, 0, 0); __builtin_amdgcn_s_setprio(0); } while (0)
#define PG8_WAIT_V(n) asm volatile("s_waitcnt vmcnt(" #n ")" ::: "memory")
#define PG8_WAIT_L(n) asm volatile("s_waitcnt lgkmcnt(" #n ")" ::: "memory")
#define PG8_BAR __builtin_amdgcn_s_barrier()
#define PG8_SCHED __builtin_amdgcn_sched_barrier(0)
    Unit cur, nxt; int ui = 0;
    if (!S.next(0, cur)) return;
    f32x4 acc[2][2][4][2];
#pragma unroll
    for (int a = 0; a < 2; ++a)
#pragma unroll
        for (int b = 0; b < 2; ++b)
#pragma unroll
            for (int m = 0; m < 4; ++m)
#pragma unroll
                for (int n = 0; n < 2; ++n) acc[a][b][m][n] = (f32x4){0.f, 0.f, 0.f, 0.f};
    bf16x8 At[4][2], B0[2][2], B1[2][2];
    const char* cA = (const char*)g.A + (size_t)cur.pm * tstepA + (size_t)cur.pn * g.apn * 2; const char* cB = (const char*)g.Bt + (size_t)cur.pn * tstepB;
    S.a_ready(cur);
    if constexpr (SP2) {
        PG8_STAGE(PG8_SB(0, 0), cB, voffB); PG8_STAGE(PG8_SB(0, 1), cB + hstepB, voffB); PG8_STAGE(PG8_SA(0, 0), cA, voffA); PG8_STAGE(PG8_SA(0, 1), cA + hstepA, voffA);
        if (wr == 1) PG8_BAR;
        PG8_WAIT_V(2); PG8_BAR;
        PG8_STAGE(PG8_SB(1, 0), cB + kstep, voffB); PG8_STAGE(PG8_SA(1, 0), cA + kstep, voffA); PG8_STAGE(PG8_SB(1, 1), cB + hstepB + kstep, voffB);
        PG8_WAIT_V(6); PG8_BAR;
    } else {
        PG8_STAGE(PG8_SB(0, 0), cB, voffB); PG8_STAGE(PG8_SA(0, 0), cA, voffA); PG8_STAGE(PG8_SB(0, 1), cB + hstepB, voffB); PG8_STAGE(PG8_SA(0, 1), cA + hstepA, voffA);
        if (wr == 1) PG8_BAR;
        PG8_WAIT_V(4); PG8_BAR;
        PG8_STAGE(PG8_SB(1, 0), cB + kstep, voffB); PG8_STAGE(PG8_SA(1, 0), cA + kstep, voffA); PG8_STAGE(PG8_SB(1, 1), cB + hstepB + kstep, voffB);
        PG8_WAIT_V(6); PG8_BAR;
    }
    for (;;) {
        const bool has_next = S.next(ui + 1, nxt);
        const char* nA = has_next ? (const char*)g.A + (size_t)nxt.pm * tstepA + (size_t)nxt.pn * g.apn * 2 : cA; const char* nB = has_next ? (const char*)g.Bt + (size_t)nxt.pn * tstepB : cB;
        for (int t = 0; t < nt; t += 2) {
            const bool last = (t == nt - 2);
            const char* a1 = cA + (size_t)(t + 1) * kstep;
            const char* a2 = last ? nA : cA + (size_t)(t + 2) * kstep; const char* b2 = last ? nB : cB + (size_t)(t + 2) * kstep;
            const char* a3 = a2 + kstep; const char* b3 = b2 + kstep;
            if (last && has_next) S.a_ready(nxt);
            if constexpr (SP2) {
            PG8_LDB(B0, 0, 0); PG8_LDB(B1, 0, 1); PG8_SCHED; PG8_LDA(At, 0, 0); PG8_STAGE(PG8_SA(1, 1), a1 + hstepA, voffA);
            PG8_WAIT_V(8); PG8_WAIT_L(0); PG8_BAR; PG8_MMA(0, 0, At, B0); PG8_MMA(0, 1, At, B1); PG8_BAR; PG8_SCHED;
            PG8_LDA(At, 0, 1); PG8_STAGE(PG8_SB(0, 0), b2, voffB); PG8_STAGE(PG8_SB(0, 1), b2 + hstepB, voffB); PG8_STAGE(PG8_SA(0, 0), a2, voffA);
            PG8_WAIT_V(8); PG8_WAIT_L(0); PG8_BAR; PG8_MMA(1, 0, At, B0); PG8_MMA(1, 1, At, B1); PG8_BAR; PG8_SCHED;
            PG8_LDB(B0, 1, 0); PG8_LDB(B1, 1, 1); PG8_SCHED; PG8_LDA(At, 1, 0); PG8_STAGE(PG8_SA(0, 1), a2 + hstepA, voffA);
            PG8_WAIT_V(8); PG8_WAIT_L(0); PG8_BAR; PG8_MMA(0, 0, At, B0); PG8_MMA(0, 1, At, B1); PG8_BAR; PG8_SCHED;
            PG8_LDA(At, 1, 1); PG8_STAGE(PG8_SB(1, 0), b3, voffB); PG8_STAGE(PG8_SB(1, 1), b3 + hstepB, voffB); PG8_STAGE(PG8_SA(1, 0), a3, voffA);
            PG8_WAIT_V(8); PG8_WAIT_L(0); PG8_BAR; PG8_MMA(1, 0, At, B0); PG8_MMA(1, 1, At, B1); PG8_BAR; PG8_SCHED;
            } else {
            PG8_LDB(B0, 0, 0); PG8_SCHED; PG8_LDA(At, 0, 0); PG8_STAGE(PG8_SA(1, 1), a1 + hstepA, voffA);
            PG8_WAIT_L(8); PG8_BAR; PG8_WAIT_L(0); PG8_MMA(0, 0, At, B0); PG8_BAR; PG8_SCHED;
            PG8_LDB(B1, 0, 1); PG8_STAGE(PG8_SB(0, 0), b2, voffB);
            PG8_BAR; PG8_WAIT_L(0); PG8_MMA(0, 1, At, B1); PG8_BAR;
            PG8_LDA(At, 0, 1); PG8_STAGE(PG8_SA(0, 0), a2, voffA);
            PG8_BAR; PG8_WAIT_L(0); PG8_MMA(1, 0, At, B0); PG8_BAR; PG8_SCHED;
            PG8_STAGE(PG8_SB(0, 1), b2 + hstepB, voffB);
            PG8_WAIT_V(6); PG8_BAR; PG8_MMA(1, 1, At, B1); PG8_BAR;
            PG8_LDB(B0, 1, 0); PG8_SCHED; PG8_LDA(At, 1, 0); PG8_STAGE(PG8_SA(0, 1), a2 + hstepA, voffA);
            PG8_WAIT_L(8); PG8_BAR; PG8_WAIT_L(0); PG8_MMA(0, 0, At, B0); PG8_BAR; PG8_SCHED;
            PG8_LDB(B1, 1, 1); PG8_STAGE(PG8_SB(1, 0), b3, voffB);
            PG8_BAR; PG8_WAIT_L(0); PG8_MMA(0, 1, At, B1); PG8_BAR;
            PG8_LDA(At, 1, 1); PG8_STAGE(PG8_SA(1, 0), a3, voffA);
            PG8_BAR; PG8_WAIT_L(0); PG8_MMA(1, 0, At, B0); PG8_BAR; PG8_SCHED;
            PG8_STAGE(PG8_SB(1, 1), b3 + hstepB, voffB);
            PG8_WAIT_V(6); PG8_BAR; PG8_MMA(1, 1, At, B1); PG8_BAR;
            }
        }
        if constexpr (ALIGN_EPI) { if (wr == 0) PG8_BAR; }
        if constexpr (!Epi::AFTER_DRAIN) { E(acc, cur, wr, wc, fr, fq); S.done(cur); }
        if (!has_next) break;
#pragma unroll
        for (int a = 0; a < 2; ++a)
#pragma unroll
            for (int b = 0; b < 2; ++b)
#pragma unroll
                for (int m = 0; m < 4; ++m)
#pragma unroll
                    for (int n = 0; n < 2; ++n) acc[a][b][m][n] = (f32x4){0.f, 0.f, 0.f, 0.f};
        cur = nxt; cA = nA; cB = nB; ++ui;
        if constexpr (ALIGN_EPI) { if (wr == 1) PG8_BAR; }
    }
    PG8_WAIT_V(0);
    if constexpr (!ALIGN_EPI) { if (wr == 0) PG8_BAR; }
    PG8_BAR;
    if constexpr (Epi::AFTER_DRAIN) { E.fused(acc, cur, wr, wc, fr, fq, lds, wid, lane); S.done(cur); }
#undef PG8_SA
#undef PG8_SB
#undef PG8_STAGE
#undef PG8_LDA
#undef PG8_LDB
#undef PG8_MMA
#undef PG8_WAIT_V
#undef PG8_WAIT_L
#undef PG8_BAR
#undef PG8_SCHED
}
}

constexpr int GBK = 128;
constexpr int GLB = GBK + 16;
constexpr int GBS = 1152;
constexpr int G2_AS = 256 * GLB;
constexpr int G2_BS = (GBK / 8) * GBS;
constexpr int G2_STAGE = G2_AS + G2_BS;
typedef long i64_t;
#define GAS __attribute__((address_space(1)))
template <class RowPtr, class ColPtr, class Epi>
__device__ __forceinline__ void gemm2_tile(LAS unsigned char* lds, const RowPtr& RP, const ColPtr& CP, int ldk, int K, int m0, int n0, const Epi& E, int mvalid = 256) {
    const int tid = fresh_tid(), lane = tid & 63, wid = tid >> 6, half = wid >> 2, wm = (wid >> 1) & 1, wn = wid & 1;
    const int fr = lane & 15, fq = lane >> 4;
    const int ht = tid & 255;
    const int ac = (ht & 7) * 16, ar0 = half * 128 + (ht >> 3);
    const int bc = half * 64 + 4 * (ht & 15), bg = ht >> 4;
    const int bpos = Epi::PERM ? ((bc & ~63) + (((bc >> 2) & 3) << 4) + (((bc >> 4) & 3) << 2)) : bc;
    const unsigned char* ap0 = RP(m0 + ar0); const unsigned char* ap1 = RP(m0 + ar0 + 32); const unsigned char* ap2 = RP(m0 + ar0 + 64); const unsigned char* ap3 = RP(m0 + ar0 + 96);
    const float* bp = CP(n0 + bc);
    const f32x4 epre = E.pre(m0 + half * 128 + wm * 64, lane);
    f32x4 acc[4][4];
#pragma unroll
    for (int m = 0; m < 4; ++m)
#pragma unroll
        for (int n = 0; n < 4; ++n) acc[m][n] = (f32x4){0.f, 0.f, 0.f, 0.f};
    const u32x4 z4 = (u32x4){0u, 0u, 0u, 0u};
    const f32x4 zf = (f32x4){0.f, 0.f, 0.f, 0.f};
    u32x4 ra[4] = {z4, z4, z4, z4}; f32x4 rb[8] = {zf, zf, zf, zf, zf, zf, zf, zf};
    const int nk = K / GBK;
    const bool docomp = (half == 0) || (mvalid > 128);
#define G2_LOAD(kt_) do { const int k0_ = (kt_) * GBK; \
        ra[0] = ap0 ? *(const u32x4*)(ap0 + k0_ + ac) : z4; ra[1] = ap1 ? *(const u32x4*)(ap1 + k0_ + ac) : z4; \
        ra[2] = ap2 ? *(const u32x4*)(ap2 + k0_ + ac) : z4; ra[3] = ap3 ? *(const u32x4*)(ap3 + k0_ + ac) : z4; \
        const float* q0_ = bp + (size_t)(k0_ + 8 * bg) * ldk; \
        _Pragma("unroll") for (int j_ = 0; j_ < 8; ++j_) rb[j_] = *(const f32x4*)(q0_ + (size_t)j_ * ldk); } while (0)
#define G2_STORE(buf_) do { LAS unsigned char* As_ = lds + (buf_) * G2_STAGE; LAS unsigned char* Bs_ = As_ + G2_AS; \
        _Pragma("unroll") for (int j_ = 0; j_ < 4; ++j_) *(LAS u32x4*)(As_ + (ar0 + 32 * j_) * GLB + ac) = ra[j_]; \
        u32x4 w0_, w1_;     \
        w0_.x = pk4_fp8(rb[0].x, rb[1].x, rb[2].x, rb[3].x); w0_.y = pk4_fp8(rb[4].x, rb[5].x, rb[6].x, rb[7].x); w0_.z = pk4_fp8(rb[0].y, rb[1].y, rb[2].y, rb[3].y); w0_.w = pk4_fp8(rb[4].y, rb[5].y, rb[6].y, rb[7].y); \
        w1_.x = pk4_fp8(rb[0].z, rb[1].z, rb[2].z, rb[3].z); w1_.y = pk4_fp8(rb[4].z, rb[5].z, rb[6].z, rb[7].z); w1_.z = pk4_fp8(rb[0].w, rb[1].w, rb[2].w, rb[3].w); w1_.w = pk4_fp8(rb[4].w, rb[5].w, rb[6].w, rb[7].w); \
        *(LAS u32x4*)(Bs_ + bg * GBS + bpos * 8) = w0_; *(LAS u32x4*)(Bs_ + bg * GBS + bpos * 8 + 16) = w1_; } while (0)
#define G2_FRAGS(af_, bf_, ks_) do { \
        _Pragma("unroll") for (int m_ = 0; m_ < 4; ++m_) af_[m_] = *(const LAS i64_t*)(As_ + (m_ * 16 + fr) * GLB + (ks_) * 32 + fq * 8); \
        _Pragma("unroll") for (int n_ = 0; n_ < 4; ++n_) bf_[n_] = *(const LAS i64_t*)(Bs_ + ((ks_) * 4 + fq) * GBS + (n_ * 16) * 8); } while (0)
#define G2_MMA(af_, bf_) do { \
        _Pragma("unroll") for (int m_ = 0; m_ < 4; ++m_) _Pragma("unroll") for (int n_ = 0; n_ < 4; ++n_) acc[m_][n_] = __builtin_amdgcn_mfma_f32_16x16x32_fp8_fp8(bf_[n_], af_[m_], acc[m_][n_], 0, 0, 0); } while (0)
#define G2_COMPUTE(buf_) do { const LAS unsigned char* As_ = lds + (buf_) * G2_STAGE + (half * 128 + wm * 64) * GLB; const LAS unsigned char* Bs_ = lds + (buf_) * G2_STAGE + G2_AS + (wn * 64 + fr) * 8; \
        i64_t afa_[4], bfa_[4], afb_[4], bfb_[4]; \
        G2_FRAGS(afa_, bfa_, 0); G2_FRAGS(afb_, bfb_, 1); G2_MMA(afa_, bfa_); \
        G2_FRAGS(afa_, bfa_, 2); G2_MMA(afb_, bfb_); \
        G2_FRAGS(afb_, bfb_, 3); G2_MMA(afa_, bfa_); \
        G2_MMA(afb_, bfb_); } while (0)
    G2_LOAD(0);
    G2_STORE(0);
    if (nk > 1) G2_LOAD(1);
    __syncthreads();
#pragma unroll 1
    for (int kt = 0; kt < nk; ++kt) {
        const int cur = kt & 1;
        if (half == 0) { __builtin_amdgcn_s_setprio(1); G2_COMPUTE(cur); __builtin_amdgcn_s_setprio(0); }
        else if (kt + 1 < nk) { G2_STORE(cur ^ 1); if (kt + 2 < nk) G2_LOAD(kt + 2); }
        __syncthreads();
        if (half == 1) { if (docomp) { __builtin_amdgcn_s_setprio(1); G2_COMPUTE(cur); __builtin_amdgcn_s_setprio(0); } }
        else if (kt + 1 < nk) { G2_STORE(cur ^ 1); if (kt + 2 < nk) G2_LOAD(kt + 2); }
        __syncthreads();
    }
#undef G2_LOAD
#undef G2_STORE
#undef G2_COMPUTE
#undef G2_FRAGS
#undef G2_MMA
    E(acc, m0 + half * 128 + wm * 64, n0 + wn * 64, lane, epre);
}

constexpr int DLA = 272;
constexpr int D_AS = 256 * DLA;
__device__ __forceinline__ void expert_down_unit(LAS unsigned char* lds, const unsigned char* act, const float* W  , int nq, unsigned char* y, const float* lw, int slot0, int nvalid) {
    const int tid = fresh_tid(), lane = tid & 63, wid = tid >> 6, half = __builtin_amdgcn_readfirstlane(wid >> 2), wm = (wid >> 1) & 1, wn = wid & 1;
    const int fr = lane & 15, fq = lane >> 4;
    const int ht = tid & 255;
    const int bc = half * 64 + 4 * (ht & 15), bg = ht >> 4;
    const int bpos = (bc & ~63) + (((bc >> 2) & 3) << 4) + (((bc >> 4) & 3) << 2);
    LAS unsigned char* Al = lds;
    LAS unsigned char* Bl = lds + D_AS;
    {
        const int c16 = (tid & 15) * 16, r0 = tid >> 4;
        const u32x4 z4 = (u32x4){0u, 0u, 0u, 0u};
        u32x4 v[8];
#pragma unroll
        for (int j = 0; j < 8; ++j) { const int r = r0 + 32 * j; v[j] = (r < nvalid) ? *(const u32x4*)(act + (size_t)(slot0 + r) * EDIM + c16) : z4; }
#pragma unroll
        for (int j = 0; j < 8; ++j) *(LAS u32x4*)(Al + (r0 + 32 * j) * DLA + c16) = v[j];
    }
    f32x4 acc[4][4];
#pragma unroll
    for (int m = 0; m < 4; ++m)
#pragma unroll
        for (int n = 0; n < 4; ++n) acc[m][n] = (f32x4){0.f, 0.f, 0.f, 0.f};
    f32x4 rbA[8], rbB[8];
    const bool docomp = (half == 0) || (nvalid > 128);
    float wrow_[4];
#pragma unroll
    for (int m = 0; m < 4; ++m) { const int r = half * 128 + wm * 64 + m * 16 + fr; wrow_[m] = (r < nvalid) ? lw[r] : 0.f; }
    const float* wbase = W + nq * 512 + bc;
    constexpr int NT_ = 8;
#define D_LOAD(t_, rb) do { const GAS float* wb_ = (const GAS float*)wbase; asm volatile("" : "+v"(wb_));     \
        const GAS float* q0_ = wb_ + ((t_) >> 1) * 128 + (size_t)(((t_) & 1) * 128 + 8 * bg) * 1024; \
        _Pragma("unroll") for (int j_ = 0; j_ < 8; ++j_) rb[j_] = *(const GAS f32x4*)(q0_ + (size_t)j_ * 1024); } while (0)
#define D_STORE(buf_, rb) do { LAS unsigned char* Bs_ = Bl + (buf_) * G2_BS; u32x4 w0_, w1_; \
        w0_.x = pk4_fp8(rb[0].x, rb[1].x, rb[2].x, rb[3].x); w0_.y = pk4_fp8(rb[4].x, rb[5].x, rb[6].x, rb[7].x); w0_.z = pk4_fp8(rb[0].y, rb[1].y, rb[2].y, rb[3].y); w0_.w = pk4_fp8(rb[4].y, rb[5].y, rb[6].y, rb[7].y); \
        w1_.x = pk4_fp8(rb[0].z, rb[1].z, rb[2].z, rb[3].z); w1_.y = pk4_fp8(rb[4].z, rb[5].z, rb[6].z, rb[7].z); w1_.z = pk4_fp8(rb[0].w, rb[1].w, rb[2].w, rb[3].w); w1_.w = pk4_fp8(rb[4].w, rb[5].w, rb[6].w, rb[7].w); \
        *(LAS u32x4*)(Bs_ + bg * GBS + bpos * 8) = w0_; *(LAS u32x4*)(Bs_ + bg * GBS + bpos * 8 + 16) = w1_; } while (0)
#define D_FRAGS(af_, bf_, ks_) do { \
        _Pragma("unroll") for (int m_ = 0; m_ < 4; ++m_) af_[m_] = *(const LAS i64_t*)(As_ + (m_ * 16 + fr) * DLA + (ks_) * 32 + fq * 8); \
        _Pragma("unroll") for (int n_ = 0; n_ < 4; ++n_) bf_[n_] = *(const LAS i64_t*)(Bs_ + ((ks_) * 4 + fq) * GBS + (n_ * 16) * 8); } while (0)
#define D_FRAGA(af_, ks_) do { _Pragma("unroll") for (int m_ = 0; m_ < 4; ++m_) af_[m_] = *(const LAS i64_t*)(As_ + (m_ * 16 + fr) * DLA + (ks_) * 32 + fq * 8); } while (0)
#define D_FRAGB(bf_, ks_) do { _Pragma("unroll") for (int n_ = 0; n_ < 4; ++n_) bf_[n_] = *(const LAS i64_t*)(Bs_ + ((ks_) * 4 + fq) * GBS + (n_ * 16) * 8); } while (0)
#define D_MMA(af_, bf_) do { \
        _Pragma("unroll") for (int m_ = 0; m_ < 4; ++m_) _Pragma("unroll") for (int n_ = 0; n_ < 4; ++n_) acc[m_][n_] = __builtin_amdgcn_mfma_f32_16x16x32_fp8_fp8(bf_[n_], af_[m_], acc[m_][n_], 0, 0, 0); } while (0)
#define D_COMPUTE(t_) do { const LAS unsigned char* As_ = Al + (half * 128 + wm * 64) * DLA + ((t_) & 1) * 128; const LAS unsigned char* Bs_ = Bl + ((t_) & 1) * G2_BS + (wn * 64 + fr) * 8; \
        i64_t afa_[4], bfa_[4], bfb_[4]; \
        D_FRAGS(afa_, bfa_, 0); D_FRAGB(bfb_, 1); D_MMA(afa_, bfa_); D_FRAGA(afa_, 1); \
        D_FRAGB(bfa_, 2); D_MMA(afa_, bfb_); D_FRAGA(afa_, 2); \
        D_FRAGB(bfb_, 3); D_MMA(afa_, bfa_); D_FRAGA(afa_, 3); \
        D_MMA(afa_, bfb_); \
        if ((t_) & 1) {     \
            const int cb_ = nq * 512 + ((t_) >> 1) * 128 + wn * 64; \
            _Pragma("unroll") for (int m_ = 0; m_ < 4; ++m_) { const int r_ = half * 128 + wm * 64 + m_ * 16 + fr; \
                if (r_ < nvalid) { const float wt_ = wrow_[m_]; u32x4 w_; \
                    { const f32x4 v_ = acc[m_][0] * wt_; w_.x = pk4_fp8(v_.x, v_.y, v_.z, v_.w); } { const f32x4 v_ = acc[m_][1] * wt_; w_.y = pk4_fp8(v_.x, v_.y, v_.z, v_.w); } \
                    { const f32x4 v_ = acc[m_][2] * wt_; w_.z = pk4_fp8(v_.x, v_.y, v_.z, v_.w); } { const f32x4 v_ = acc[m_][3] * wt_; w_.w = pk4_fp8(v_.x, v_.y, v_.z, v_.w); } \
                    asm volatile("global_store_dwordx4 %0, %1, off" :: "v"(y + (size_t)(slot0 + r_) * 1024 + cb_ + 16 * fq), "v"(w_) : "memory"); }     \
                _Pragma("unroll") for (int n_ = 0; n_ < 4; ++n_) acc[m_][n_] = (f32x4){0.f, 0.f, 0.f, 0.f}; } } } while (0)
#define D_STG(t_, rb, dow_) do { D_STORE(((t_) + 1) & 1, rb); if (dow_) D_LOAD((t_) + 3, rb); } while (0)
#define D_CMP(t_) do { __builtin_amdgcn_s_setprio(1); D_COMPUTE(t_); __builtin_amdgcn_s_setprio(0); } while (0)
    D_LOAD(0, rbA);
    D_STORE(0, rbA);
    D_LOAD(1, rbB); D_LOAD(2, rbA);
    __syncthreads();
    if (half == 0) {
        D_CMP(0); __syncthreads(); D_STG(0, rbB, 1); __syncthreads();
        D_CMP(1); __syncthreads(); D_STG(1, rbA, 1); __syncthreads();
        D_CMP(2); __syncthreads(); D_STG(2, rbB, 1); __syncthreads();
        D_CMP(3); __syncthreads(); D_STG(3, rbA, 1); __syncthreads();
        D_CMP(4); __syncthreads(); D_STG(4, rbB, 1); __syncthreads();
        D_CMP(5); __syncthreads(); D_STG(5, rbA, 0); __syncthreads();
        D_CMP(6); __syncthreads(); D_STG(6, rbB, 0); __syncthreads();
        D_CMP(7); __syncthreads(); __syncthreads();
    } else {
        D_STG(0, rbB, 1); __syncthreads(); if (docomp) D_CMP(0); __syncthreads();
        D_STG(1, rbA, 1); __syncthreads(); if (docomp) D_CMP(1); __syncthreads();
        D_STG(2, rbB, 1); __syncthreads(); if (docomp) D_CMP(2); __syncthreads();
        D_STG(3, rbA, 1); __syncthreads(); if (docomp) D_CMP(3); __syncthreads();
        D_STG(4, rbB, 1); __syncthreads(); if (docomp) D_CMP(4); __syncthreads();
        D_STG(5, rbA, 0); __syncthreads(); if (docomp) D_CMP(5); __syncthreads();
        D_STG(6, rbB, 0); __syncthreads(); if (docomp) D_CMP(6); __syncthreads();
        __syncthreads(); if (docomp) D_CMP(7); __syncthreads();
    }
#undef D_STG
#undef D_CMP
#undef D_LOAD
#undef D_STORE
#undef D_FRAGS
#undef D_MMA
#undef D_COMPUTE
}

struct RowDense { const bf16_t* A; int lda; __device__ __forceinline__ const bf16_t* operator()(int r) const { return A + (size_t)r * lda; } };
struct RowGather { const unsigned char* A; const int* idx; int nvalid; __device__ __forceinline__ const unsigned char* operator()(int r) const { return r < nvalid ? A + (size_t)idx[r] * D : nullptr; } };
struct RowSlots { const unsigned char* A; int nvalid; __device__ __forceinline__ const unsigned char* operator()(int r) const { return r < nvalid ? A + (size_t)r * EDIM : nullptr; } };
struct ColDense { const float* W; int N; __device__ __forceinline__ const float* operator()(int c) const { return c < N ? W + c : nullptr; } };
struct ColMqk { const float* q; ptrdiff_t dk; __device__ __forceinline__ const float* operator()(int c) const { return q + ((c < 128) ? (ptrdiff_t)c : dk + (c - 128)); } };
struct ColGU { const float* g; ptrdiff_t du;
    __device__ __forceinline__ const float* operator()(int c) const { const int tb = c >> 7, cc = c & 127, wnn = cc >> 6, n = (cc >> 4) & 3, rho = cc & 15;
        return g + (((n & 1) ? du : (ptrdiff_t)0) + tb * 64 + wnn * 32 + 8 * (rho >> 2) + 4 * (n >> 1) + (rho & 3)); } };
struct ColRgu { const float* r; ptrdiff_t dg; ptrdiff_t du; __device__ __forceinline__ const float* operator()(int c) const {
    const int cc = c - 256, j = cc >> 5, w = cc & 31; const ptrdiff_t off = (c < 256) ? (ptrdiff_t)c : (((w & 16) ? du : dg) + j * 16 + (w & 15)); return r + off; } };

__device__ __forceinline__ u32x2 pack4(const f32x4 v) { u32x2 w; w.x = cvt_pk_bf16(v.x, v.y); w.y = cvt_pk_bf16(v.z, v.w); return w; }
__device__ __forceinline__ u32x2 pack_swiglu(const f32x4 g, const f32x4 u) { u32x2 w; w.x = cvt_pk_bf16(siluf_(g.x) * u.x, siluf_(g.y) * u.y); w.y = cvt_pk_bf16(siluf_(g.z) * u.z, siluf_(g.w) * u.w); return w; }
struct EpiProj {
    bf16_t* proj; float* graw;
    __device__ __forceinline__ f32x4 pre(int rb, int lane) const { return (f32x4){0.f, 0.f, 0.f, 0.f}; }
    __device__ __forceinline__ void operator()(const f32x4 (&acc)[4][4], int rb, int cb, int lane, const f32x4 epre) const {
        const int fr = lane & 15, fq = lane >> 4;
#pragma unroll
        for (int m = 0; m < 4; ++m)
#pragma unroll
            for (int n = 0; n < 4; ++n) {
                const int row = rb + m * 16 + fr, col = cb + n * 16 + 4 * fq;
                if (col < OFF_GATE) *(u32x2*)(proj + (size_t)row * IN_DIM + col) = pack4(acc[m][n]);
                else if (col < IN_DIM) *(f32x4*)(graw + (size_t)row * 8 + (col - OFF_GATE)) = acc[m][n];
            }
    }
};
struct EpiNull {
    float* sink;
    __device__ __forceinline__ f32x4 pre(int rb, int lane) const { return (f32x4){0.f, 0.f, 0.f, 0.f}; }
    __device__ __forceinline__ void operator()(const f32x4 (&acc)[4][4], int rb, int cb, int lane, const f32x4 epre) const {
        float t = 0.f;
#pragma unroll
        for (int m = 0; m < 4; ++m)
#pragma unroll
            for (int n = 0; n < 4; ++n) t += acc[m][n].x + acc[m][n].y + acc[m][n].z + acc[m][n].w;
        if (t == 12345.678f) sink[lane] = t;
    }
};
struct EpiBf16 {
    bf16_t* O; int ldc;
    __device__ __forceinline__ f32x4 pre(int rb, int lane) const { return (f32x4){0.f, 0.f, 0.f, 0.f}; }
    __device__ __forceinline__ void operator()(const f32x4 (&acc)[4][4], int rb, int cb, int lane, const f32x4 epre) const {
        const int fr = lane & 15, fq = lane >> 4;
#pragma unroll
        for (int m = 0; m < 4; ++m)
#pragma unroll
            for (int n = 0; n < 4; ++n) *(u32x2*)(O + (size_t)(rb + m * 16 + fr) * ldc + cb + n * 16 + 4 * fq) = pack4(acc[m][n]);
    }
};
struct EpiMqk {
    bf16_t* mq; bf16_t* mk; int h;
    __device__ __forceinline__ f32x4 pre(int rb, int lane) const { return (f32x4){0.f, 0.f, 0.f, 0.f}; }
    __device__ __forceinline__ void operator()(const f32x4 (&acc)[4][4], int rb, int cb, int lane, const f32x4 epre) const {
        const int fr = lane & 15, fq = lane >> 4;
#pragma unroll
        for (int m = 0; m < 4; ++m)
#pragma unroll
            for (int n = 0; n < 4; ++n) {
                const int row = rb + m * 16 + fr, col = cb + n * 16 + 4 * fq; f32x4 v = acc[m][n];
                bf16_t* dst = mq; int c = col;
                if (col >= 128) { dst = mk; c = col - 128; v = v * 0.08838834764831845f; }
                *(u32x2*)(dst + (size_t)row * MINNER + h * DM + c) = pack4(v);
            }
    }
};
struct EpiResid {
    const float* X; const float* ada; int gt_off; float* out;
    __device__ __forceinline__ f32x4 pre(int rb, int lane) const { return (f32x4){0.f, 0.f, 0.f, 0.f}; }
    __device__ __forceinline__ void operator()(const f32x4 (&acc)[4][4], int rb, int cb, int lane, const f32x4 epre) const {
        const int fr = lane & 15, fq = lane >> 4;
#pragma unroll
        for (int m = 0; m < 4; ++m)
#pragma unroll
            for (int n = 0; n < 4; ++n) {
                const int row = rb + m * 16 + fr, col = cb + n * 16 + 4 * fq; const int b = row / S;
                const f32x4 g = *(const f32x4*)(ada + b * 6144 + gt_off + col);
                const f32x4 x = *(const f32x4*)(X + (size_t)row * D + col);
                *(f32x4*)(out + (size_t)row * D + col) = x + g * acc[m][n];
            }
    }
};
struct EpiRgu {
    float* logits; bf16_t* act;
    __device__ __forceinline__ f32x4 pre(int rb, int lane) const { return (f32x4){0.f, 0.f, 0.f, 0.f}; }
    __device__ __forceinline__ void operator()(const f32x4 (&acc)[4][4], int rb, int cb, int lane, const f32x4 epre) const {
        const int fr = lane & 15, fq = lane >> 4;
#pragma unroll
        for (int m = 0; m < 4; ++m) {
            const int row = rb + m * 16 + fr;
            if (cb < 256) {
#pragma unroll
                for (int n = 0; n < 4; ++n) *(f32x4*)(logits + (size_t)row * 256 + cb + n * 16 + 4 * fq) = acc[m][n];
            } else {
                const int j0 = (cb - 256) >> 5;
#pragma unroll
                for (int pp = 0; pp < 2; ++pp) *(u32x2*)(act + (size_t)row * 256 + (j0 + pp) * 16 + 4 * fq) = pack_swiglu(acc[m][2 * pp], acc[m][2 * pp + 1]);
            }
        }
    }
};
struct EpiExpAct {
    static constexpr bool PERM = false;
    unsigned char* act; int slot0; int nvalid;
    __device__ __forceinline__ f32x4 pre(int rb, int lane) const { const f32x4 z = {0.f, 0.f, 0.f, 0.f}; return z; }
    __device__ __forceinline__ void operator()(const f32x4 (&acc)[4][4], int rb, int cb, int lane, const f32x4 epre) const {
        const int fr = lane & 15, fq = lane >> 4;
#pragma unroll
        for (int m = 0; m < 4; ++m) {
            const int r = rb + m * 16 + fr;
            if (r < nvalid) {
                u32x2 w;
                { const f32x4 g = acc[m][0], u = acc[m][1]; w.x = pk4_fp8(siluf_(g.x) * u.x, siluf_(g.y) * u.y, siluf_(g.z) * u.z, siluf_(g.w) * u.w); }
                { const f32x4 g = acc[m][2], u = acc[m][3]; w.y = pk4_fp8(siluf_(g.x) * u.x, siluf_(g.y) * u.y, siluf_(g.z) * u.z, siluf_(g.w) * u.w); }
                *(u32x2*)(act + (size_t)(slot0 + r) * 256 + (cb >> 1) + 8 * fq) = w;
            }
        }
    }
};
struct EpiExpDown {
    static constexpr bool PERM = true;
    unsigned char* y; const float* lw; int slot0; int nvalid;
    __device__ __forceinline__ f32x4 pre(int rb, int lane) const {
        const int fr = lane & 15; f32x4 w;
        w.x = (rb + fr < nvalid) ? lw[rb + fr] : 0.f; w.y = (rb + 16 + fr < nvalid) ? lw[rb + 16 + fr] : 0.f;
        w.z = (rb + 32 + fr < nvalid) ? lw[rb + 32 + fr] : 0.f; w.w = (rb + 48 + fr < nvalid) ? lw[rb + 48 + fr] : 0.f; return w; }
    __device__ __forceinline__ void operator()(const f32x4 (&acc)[4][4], int rb, int cb, int lane, const f32x4 epre) const {
        const int fr = lane & 15, fq = lane >> 4;
#pragma unroll
        for (int m = 0; m < 4; ++m) {
            const int r = rb + m * 16 + fr;
            if (r < nvalid) {
                const float wt = epre[m];
                u32x4 w;
                { const f32x4 v = acc[m][0] * wt; w.x = pk4_fp8(v.x, v.y, v.z, v.w); }
                { const f32x4 v = acc[m][1] * wt; w.y = pk4_fp8(v.x, v.y, v.z, v.w); }
                { const f32x4 v = acc[m][2] * wt; w.z = pk4_fp8(v.x, v.y, v.z, v.w); }
                { const f32x4 v = acc[m][3] * wt; w.w = pk4_fp8(v.x, v.y, v.z, v.w); }
                *(u32x4*)(y + (size_t)(slot0 + r) * 1024 + cb + 16 * fq) = w;
            }
        }
    }
};

constexpr int AKLD = 104, AVLD = 72;
__device__ __forceinline__ void attn_unit(const Params& p, LAS unsigned char* lds, int bh, int qb) {
    LAS bf16_t* Ks = (LAS bf16_t*)lds;
    LAS bf16_t* Vt = Ks + 64 * AKLD;
    const bf16_t* Q = (const bf16_t*)(p.ws + B_Q) + (size_t)bh * S * 96;
    const bf16_t* Kg = (const bf16_t*)(p.ws + B_K) + (size_t)bh * S * 96;
    const int b = bh >> 3, h = bh & 7;
    const bf16_t* Vg = (const bf16_t*)(p.ws + B_KVRAW) + (size_t)b * S * 1024 + h * 128 + 64;
    bf16_t* O = (bf16_t*)(p.ws + B_ORAW) + (size_t)b * S * 512 + h * 64;
    const int tid = fresh_tid(), lane = tid & 63, wid = tid >> 6, fr = lane & 15, fq = lane >> 4;
    const int q0 = qb * 256, qw0 = q0 + wid * 32;
    bf16x8 qf[2][3];
#pragma unroll
    for (int nq = 0; nq < 2; ++nq)
#pragma unroll
        for (int ks = 0; ks < 3; ++ks) qf[nq][ks] = *(const bf16x8*)(Q + (size_t)(qw0 + nq * 16 + fr) * 96 + ks * 32 + fq * 8);
    f32x4 oacc[4][2];
#pragma unroll
    for (int d = 0; d < 4; ++d)
#pragma unroll
        for (int nq = 0; nq < 2; ++nq) oacc[d][nq] = (f32x4){0.f, 0.f, 0.f, 0.f};
    float mrun[2] = {-1e30f, -1e30f}, lrun[2] = {0.f, 0.f};
    const int ntiles = (q0 + 256) / 64;
    constexpr int ASTG = 64 * AKLD + 64 * AVLD;
    const int kc0 = tid, kc1 = tid + NT;
    const int kr0 = kc0 / 12, kq0 = kc0 - kr0 * 12, kr1 = kc1 / 12, kq1 = kc1 - kr1 * 12;
    const int vkey = tid & 63, vdc = tid >> 6;
    u32x4 rk0, rk1 = (u32x4){0u, 0u, 0u, 0u}, rv;
#define ATT_LOAD(k0_) do { rk0 = *(const u32x4*)(Kg + (size_t)((k0_) + kr0) * 96 + kq0 * 8); if (kc1 < 768) rk1 = *(const u32x4*)(Kg + (size_t)((k0_) + kr1) * 96 + kq1 * 8); \
        rv = *(const u32x4*)(Vg + (size_t)((k0_) + vkey) * 1024 + vdc * 8); } while (0)
#define ATT_STORE(buf_) do { LAS bf16_t* Kd_ = Ks + (buf_) * ASTG; LAS bf16_t* Vd_ = Kd_ + 64 * AKLD; \
        *(LAS u32x4*)(Kd_ + kr0 * AKLD + kq0 * 8) = rk0; if (kc1 < 768) *(LAS u32x4*)(Kd_ + kr1 * AKLD + kq1 * 8) = rk1; \
        LAS bf16_t* vt_ = Vd_ + (vdc * 8) * AVLD + vkey; \
        vt_[0 * AVLD] = (bf16_t)(rv.x & 0xffff); vt_[1 * AVLD] = (bf16_t)(rv.x >> 16); vt_[2 * AVLD] = (bf16_t)(rv.y & 0xffff); vt_[3 * AVLD] = (bf16_t)(rv.y >> 16); \
        vt_[4 * AVLD] = (bf16_t)(rv.z & 0xffff); vt_[5 * AVLD] = (bf16_t)(rv.z >> 16); vt_[6 * AVLD] = (bf16_t)(rv.w & 0xffff); vt_[7 * AVLD] = (bf16_t)(rv.w >> 16); } while (0)
    ATT_LOAD(0);
    ATT_STORE(0);
    __syncthreads();
    for (int kt = 0; kt < ntiles; ++kt) {
        const int k0 = kt * 64;
        const LAS bf16_t* Kc = Ks + (kt & 1) * ASTG; const LAS bf16_t* Vc = Kc + 64 * AKLD;
        if (kt + 1 < ntiles) ATT_LOAD(k0 + 64);
        if (k0 <= qw0 + 31) {
            f32x4 sacc[4][2];
#pragma unroll
            for (int t4 = 0; t4 < 4; ++t4)
#pragma unroll
                for (int nq = 0; nq < 2; ++nq) sacc[t4][nq] = (f32x4){0.f, 0.f, 0.f, 0.f};
#pragma unroll
            for (int ks = 0; ks < 3; ++ks)
#pragma unroll
                for (int t4 = 0; t4 < 4; ++t4) {
                    const bf16x8 kf = *(const LAS bf16x8*)(Kc + (t4 * 16 + fr) * AKLD + ks * 32 + fq * 8);
#pragma unroll
                    for (int nq = 0; nq < 2; ++nq) sacc[t4][nq] = MFMA16(kf, qf[nq][ks], sacc[t4][nq]);
                }
            const bool need_mask = (k0 + 63 > qw0);
#pragma unroll
            for (int nq = 0; nq < 2; ++nq) {
                const int qidx = qw0 + nq * 16 + fr;
                float mx = -1e30f;
#pragma unroll
                for (int t4 = 0; t4 < 4; ++t4)
#pragma unroll
                    for (int i = 0; i < 4; ++i) {
                        if (need_mask) { const int key = k0 + t4 * 16 + 4 * fq + i; if (key > qidx) sacc[t4][nq][i] = -1e30f; }
                        mx = fmaxf(mx, sacc[t4][nq][i]);
                    }
                mx = fmaxf(mx, __shfl_xor(mx, 16)); mx = fmaxf(mx, __shfl_xor(mx, 32));
                const float mnew = fmaxf(mrun[nq], mx);
                float ls = 0.f;
#pragma unroll
                for (int t4 = 0; t4 < 4; ++t4)
#pragma unroll
                    for (int i = 0; i < 4; ++i) { const float pv = __builtin_amdgcn_exp2f(sacc[t4][nq][i] - mnew); sacc[t4][nq][i] = pv; ls += pv; }
                if (__ballot(mnew > mrun[nq])) {
                    const float alpha = __builtin_amdgcn_exp2f(mrun[nq] - mnew);
                    lrun[nq] = lrun[nq] * alpha + ls;
#pragma unroll
                    for (int d = 0; d < 4; ++d) oacc[d][nq] = oacc[d][nq] * alpha;
                } else lrun[nq] += ls;
                mrun[nq] = mnew;
            }
#pragma unroll
            for (int s2 = 0; s2 < 2; ++s2) {
                bf16x8 pb[2];
#pragma unroll
                for (int nq = 0; nq < 2; ++nq) {
                    u32x4 w; w.x = cvt_pk_bf16(sacc[2 * s2][nq].x, sacc[2 * s2][nq].y); w.y = cvt_pk_bf16(sacc[2 * s2][nq].z, sacc[2 * s2][nq].w);
                    w.z = cvt_pk_bf16(sacc[2 * s2 + 1][nq].x, sacc[2 * s2 + 1][nq].y); w.w = cvt_pk_bf16(sacc[2 * s2 + 1][nq].z, sacc[2 * s2 + 1][nq].w);
                    pb[nq] = __builtin_bit_cast(bf16x8, w);
                }
#pragma unroll
                for (int d = 0; d < 4; ++d) {
                    const LAS bf16_t* vr = Vc + (d * 16 + fr) * AVLD + s2 * 32 + 4 * fq;
                    const u32x2 lo = *(const LAS u32x2*)vr, hi = *(const LAS u32x2*)(vr + 16);
                    const bf16x8 vf = __builtin_bit_cast(bf16x8, ((u32x4){lo.x, lo.y, hi.x, hi.y}));
#pragma unroll
                    for (int nq = 0; nq < 2; ++nq) oacc[d][nq] = MFMA16(vf, pb[nq], oacc[d][nq]);
                }
            }
        }
        if (kt + 1 < ntiles) ATT_STORE((kt + 1) & 1);
        __syncthreads();
    }
#undef ATT_LOAD
#undef ATT_STORE
#pragma unroll
    for (int nq = 0; nq < 2; ++nq) {
        float l = lrun[nq]; l += __shfl_xor(l, 16); l += __shfl_xor(l, 32);
        const float inv = 1.f / l;
        const int qidx = qw0 + nq * 16 + fr;
#pragma unroll
        for (int d = 0; d < 4; ++d) { const f32x4 v = oacc[d][nq] * inv; u32x2 w; w.x = cvt_pk_bf16(v.x, v.y); w.y = cvt_pk_bf16(v.z, v.w);
            *(u32x2*)(O + (size_t)qidx * 512 + d * 16 + 4 * fq) = w; }
    }
}

constexpr int MTLD = 72;
__device__ __forceinline__ void mlstm_a_unit(const Params& p, LAS unsigned char* lds, int unit) {
    LAS bf16_t* kT = (LAS bf16_t*)lds;
    LAS bf16_t* vT = kT + 128 * MTLD;
    LAS float* av = (LAS float*)(vT + 128 * MTLD);
    const int bh = unit >> 5, c = unit & 31, b = bh >> 2, h = bh & 3;
    const int t0 = b * S + c * CHUNK;
    const float* gl = (const float*)(p.ws + B_GL);
    const bf16_t* mk = (const bf16_t*)(p.ws + B_MK); const bf16_t* proj = (const bf16_t*)(p.ws + B_PROJ);
    const int tid = fresh_tid(), lane = tid & 63, wid = tid >> 6, fr = lane & 15, fq = lane >> 4;
    if (wid == 0) {
        const float li = gl[(size_t)(t0 + lane) * 8 + h], lf = gl[(size_t)(t0 + lane) * 8 + 4 + h];
        float bs = lf;
#pragma unroll
        for (int o = 1; o < 64; o <<= 1) { const float t = __shfl_up(bs, o); if (lane >= o) bs += t; }
        const float Btot = __shfl(bs, 63);
        const float g = Btot - bs + li;
        const float ml = wave_max(g);
        av[lane] = __expf(g - ml);
        if (lane == 0) { ((float*)(p.ws + WS_BC))[unit] = Btot; ((float*)(p.ws + WS_MLOC))[unit] = ml; }
    }
    __syncthreads();
#pragma unroll
    for (int rep = 0; rep < 2; ++rep) {
        const int cidx = tid + rep * NT, s = cidx & 63, ch = cidx >> 6;
        const u32x4 kv = *(const u32x4*)(mk + (size_t)(t0 + s) * MINNER + h * DM + ch * 8);
        const u32x4 vv = *(const u32x4*)(proj + (size_t)(t0 + s) * IN_DIM + OFF_MV + h * DM + ch * 8);
        const float a = av[s];
        LAS bf16_t* kt = kT + (ch * 8) * MTLD + s; LAS bf16_t* vt = vT + (ch * 8) * MTLD + s;
        const unsigned kk[4] = {kv.x, kv.y, kv.z, kv.w}; const unsigned vw[4] = {vv.x, vv.y, vv.z, vv.w};
#pragma unroll
        for (int j = 0; j < 4; ++j) {
            kt[(2 * j) * MTLD] = (bf16_t)(kk[j] & 0xffff); kt[(2 * j + 1) * MTLD] = (bf16_t)(kk[j] >> 16);
            const unsigned sc = cvt_pk_bf16(bflo(vw[j]) * a, bfhi(vw[j]) * a);
            vt[(2 * j) * MTLD] = (bf16_t)(sc & 0xffff); vt[(2 * j + 1) * MTLD] = (bf16_t)(sc >> 16);
        }
    }
    __syncthreads();
    {
        const int we = wid >> 1, wd = wid & 1;
        f32x4 acc[2][4];
#pragma unroll
        for (int i = 0; i < 2; ++i)
#pragma unroll
            for (int j = 0; j < 4; ++j) acc[i][j] = (f32x4){0.f, 0.f, 0.f, 0.f};
#pragma unroll
        for (int ks = 0; ks < 2; ++ks) {
            bf16x8 vf[2], kf[4];
#pragma unroll
            for (int i = 0; i < 2; ++i) vf[i] = *(const LAS bf16x8*)(vT + (we * 32 + i * 16 + fr) * MTLD + ks * 32 + fq * 8);
#pragma unroll
            for (int j = 0; j < 4; ++j) kf[j] = *(const LAS bf16x8*)(kT + (wd * 64 + j * 16 + fr) * MTLD + ks * 32 + fq * 8);
#pragma unroll
            for (int i = 0; i < 2; ++i)
#pragma unroll
                for (int j = 0; j < 4; ++j) acc[i][j] = MFMA16(kf[j], vf[i], acc[i][j]);
        }
        bf16_t* dC = (bf16_t*)(p.ws + B_DC) + (size_t)unit * 16384;
#pragma unroll
        for (int i = 0; i < 2; ++i)
#pragma unroll
            for (int j = 0; j < 4; ++j) *(u32x2*)(dC + (we * 32 + i * 16 + fr) * 128 + wd * 64 + j * 16 + 4 * fq) = pack4(acc[i][j]);
    }
    if (tid < 128) {
        float s = 0.f;
        for (int q = 0; q < 64; ++q) s += bf2f(kT[tid * MTLD + q]) * av[q];
        ((float*)(p.ws + WS_DN))[(size_t)unit * 128 + tid] = s;
    }
    __syncthreads();
}

__device__ __forceinline__ void mlstm_scan(const Params& p, int gtid, int ngt) {
    const float* Bc = (const float*)(p.ws + WS_BC); const float* ML = (const float*)(p.ws + WS_MLOC);
    float* mprev = (float*)(p.ws + WS_MPREV);
    const bf16_t* dC = (const bf16_t*)(p.ws + B_DC); bf16_t* Cp = (bf16_t*)(p.ws + B_CPREV);
    const float* dn = (const float*)(p.ws + WS_DN); float* np_ = (float*)(p.ws + WS_NPREV);
    constexpr int PER = 4096 + 32;
    for (int idx = gtid; idx < 32 * PER; idx += ngt) {
        const int bh = idx / PER, e4 = idx - bh * PER;
        const bool isC = e4 < 4096; const int n4 = e4 - 4096;
        float m = 0.f; f32x4 C = (f32x4){0.f, 0.f, 0.f, 0.f};
        for (int c0 = 0; c0 < NCH; c0 += 4) {
            f32x4 d[4]; float Bt[4], ml[4];
#pragma unroll
            for (int q = 0; q < 4; ++q) {
                const int unit = bh * NCH + c0 + q;
                Bt[q] = Bc[unit]; ml[q] = ML[unit];
                if (isC) { const u32x2 w = *(const u32x2*)(dC + (size_t)unit * 16384 + e4 * 4); d[q] = (f32x4){bflo(w.x), bfhi(w.x), bflo(w.y), bfhi(w.y)}; }
                else d[q] = *(const f32x4*)(dn + (size_t)unit * 128 + n4 * 4);
            }
#pragma unroll
            for (int q = 0; q < 4; ++q) {
                const int unit = bh * NCH + c0 + q;
                const float mnew = fmaxf(Bt[q] + m, ml[q]);
                const float fa = __expf(Bt[q] + m - mnew), fb = __expf(ml[q] - mnew);
                if (isC) {
                    u32x2 w; w.x = cvt_pk_bf16(C.x, C.y); w.y = cvt_pk_bf16(C.z, C.w);
                    *(u32x2*)(Cp + (size_t)unit * 16384 + e4 * 4) = w;
                    if (e4 == 0) mprev[unit] = m;
                } else {
                    *(f32x4*)(np_ + (size_t)unit * 128 + n4 * 4) = C;
                }
                C = C * fa + d[q] * fb;
                m = mnew;
            }
        }
    }
}

constexpr int MRLD = 136;
struct McRegs { u32x4 q[2], k[2], c[4], v[2]; float li, lf, mp; };
__device__ __forceinline__ void mlstm_c_load(const Params& p, int unit, McRegs& R) {
    const int bh = unit >> 5, c = unit & 31, b = bh >> 2, h = bh & 3;
    const int t0 = b * S + c * CHUNK;
    const float* gl = (const float*)(p.ws + B_GL);
    const bf16_t* mq = (const bf16_t*)(p.ws + B_MQ); const bf16_t* mk = (const bf16_t*)(p.ws + B_MK); const bf16_t* proj = (const bf16_t*)(p.ws + B_PROJ);
    const bf16_t* Cp = (const bf16_t*)(p.ws + B_CPREV) + (size_t)unit * 16384;
    const int tid = fresh_tid(), lane = tid & 63;
#pragma unroll
    for (int rep = 0; rep < 2; ++rep) {
        const int cidx = tid + rep * NT, r = cidx >> 4, ch = cidx & 15;
        R.q[rep] = *(const u32x4*)(mq + (size_t)(t0 + r) * MINNER + h * DM + ch * 8);
        R.k[rep] = *(const u32x4*)(mk + (size_t)(t0 + r) * MINNER + h * DM + ch * 8);
    }
#pragma unroll
    for (int rep = 0; rep < 4; ++rep) { const int cidx = tid + rep * NT, r = cidx >> 4, ch = cidx & 15; R.c[rep] = *(const u32x4*)(Cp + r * 128 + ch * 8); }
#pragma unroll
    for (int rep = 0; rep < 2; ++rep) { const int cidx = tid + rep * NT, sq = cidx & 63, ch = cidx >> 6; R.v[rep] = *(const u32x4*)(proj + (size_t)(t0 + sq) * IN_DIM + OFF_MV + h * DM + ch * 8); }
    R.li = gl[(size_t)(t0 + lane) * 8 + h]; R.lf = gl[(size_t)(t0 + lane) * 8 + 4 + h]; R.mp = ((const float*)(p.ws + WS_MPREV))[unit];
}
__device__ __forceinline__ void mlstm_c_unit(const Params& p, LAS unsigned char* lds, int unit, McRegs& R, int next_unit) {
    LAS bf16_t* qs = (LAS bf16_t*)lds;
    LAS bf16_t* ks = qs + 64 * MRLD;
    LAS bf16_t* cs = ks + 64 * MRLD;
    LAS bf16_t* vT = cs + 128 * MRLD;
    LAS float* fv = (LAS float*)(vT + 128 * MTLD);
    LAS float* u_s = fv; LAS float* c_t = fv + 64; LAS float* dec = fv + 128; LAS float* emt = fv + 192; LAS float* ssq = fv + 256;
    const int bh = unit >> 5, c = unit & 31, b = bh >> 2, h = bh & 3;
    const int t0 = b * S + c * CHUNK;
    const bf16_t* proj = (const bf16_t*)(p.ws + B_PROJ);
    const float* np_ = (const float*)(p.ws + WS_NPREV) + (size_t)unit * 128;
    const int tid = fresh_tid(), lane = tid & 63, wid = tid >> 6, fr = lane & 15, fq = lane >> 4;
    if (wid == 0) {
        const float li = R.li, lf = R.lf;
        const float mp = R.mp;
        float bs = lf;
#pragma unroll
        for (int o = 1; o < 64; o <<= 1) { const float t = __shfl_up(bs, o); if (lane >= o) bs += t; }
        const float u = li - bs;
        float pm = u;
#pragma unroll
        for (int o = 1; o < 64; o <<= 1) { const float t = __shfl_up(pm, o); if (lane >= o) pm = fmaxf(pm, t); }
        const float inter = bs + mp;
        const float mt = fmaxf(inter, bs + pm);
        u_s[lane] = u; c_t[lane] = bs - mt; dec[lane] = __expf(inter - mt); emt[lane] = __expf(-mt);
    }
#pragma unroll
    for (int rep = 0; rep < 2; ++rep) {
        const int cidx = tid + rep * NT, r = cidx >> 4, ch = cidx & 15;
        *(LAS u32x4*)(qs + r * MRLD + ch * 8) = R.q[rep];
        *(LAS u32x4*)(ks + r * MRLD + ch * 8) = R.k[rep];
    }
#pragma unroll
    for (int rep = 0; rep < 4; ++rep) { const int cidx = tid + rep * NT, r = cidx >> 4, ch = cidx & 15; *(LAS u32x4*)(cs + r * MRLD + ch * 8) = R.c[rep]; }
#pragma unroll
    for (int rep = 0; rep < 2; ++rep) {
        const int cidx = tid + rep * NT, sq = cidx & 63, ch = cidx >> 6;
        const u32x4 vv = R.v[rep];
        LAS bf16_t* vt = vT + (ch * 8) * MTLD + sq;
        const unsigned vw[4] = {vv.x, vv.y, vv.z, vv.w};
#pragma unroll
        for (int j = 0; j < 4; ++j) { vt[(2 * j) * MTLD] = (bf16_t)(vw[j] & 0xffff); vt[(2 * j + 1) * MTLD] = (bf16_t)(vw[j] >> 16); }
    }
    __syncthreads();
    if (next_unit >= 0) mlstm_c_load(p, next_unit, R);
    const int tt = wid & 3, eh = wid >> 2;
    const int tl = tt * 16 + fr;
    bf16x8 qf[4];
#pragma unroll
    for (int k4 = 0; k4 < 4; ++k4) qf[k4] = *(const LAS bf16x8*)(qs + tl * MRLD + k4 * 32 + fq * 8);
    f32x4 sacc[4];
#pragma unroll
    for (int st = 0; st < 4; ++st) sacc[st] = (f32x4){0.f, 0.f, 0.f, 0.f};
#pragma unroll
    for (int k4 = 0; k4 < 4; ++k4)
#pragma unroll
        for (int st = 0; st < 4; ++st) {
            const bf16x8 kf = *(const LAS bf16x8*)(ks + (st * 16 + fr) * MRLD + k4 * 32 + fq * 8);
            sacc[st] = MFMA16(kf, qf[k4], sacc[st]);
        }
    const float ct = c_t[tl];
    float rs = 0.f;
#pragma unroll
    for (int st = 0; st < 4; ++st)
#pragma unroll
        for (int i = 0; i < 4; ++i) {
            const int s = st * 16 + 4 * fq + i;
            const float w = (s <= tl) ? __expf(ct + u_s[s]) * sacc[st][i] : 0.f;
            sacc[st][i] = w; rs += w;
        }
    rs += __shfl_xor(rs, 16); rs += __shfl_xor(rs, 32);
    float nq;
    {
        f32x4 na = (f32x4){0.f, 0.f, 0.f, 0.f};
#pragma unroll
        for (int k4 = 0; k4 < 4; ++k4) {
            u32x4 w = (u32x4){0u, 0u, 0u, 0u};
            if (fr == 0) { const float* nn = np_ + k4 * 32 + fq * 8; w.x = cvt_pk_bf16(nn[0], nn[1]); w.y = cvt_pk_bf16(nn[2], nn[3]); w.z = cvt_pk_bf16(nn[4], nn[5]); w.w = cvt_pk_bf16(nn[6], nn[7]); }
            na = MFMA16(__builtin_bit_cast(bf16x8, w), qf[k4], na);
        }
        nq = __shfl(na.x, fr);
    }
    f32x4 acc[4];
#pragma unroll
    for (int et = 0; et < 4; ++et) acc[et] = (f32x4){0.f, 0.f, 0.f, 0.f};
#pragma unroll
    for (int k4 = 0; k4 < 4; ++k4)
#pragma unroll
        for (int et = 0; et < 4; ++et) {
            const bf16x8 cf = *(const LAS bf16x8*)(cs + (eh * 64 + et * 16 + fr) * MRLD + k4 * 32 + fq * 8);
            acc[et] = MFMA16(cf, qf[k4], acc[et]);
        }
    const float dcy = dec[tl];
#pragma unroll
    for (int et = 0; et < 4; ++et) acc[et] = acc[et] * dcy;
#pragma unroll
    for (int s2 = 0; s2 < 2; ++s2) {
        u32x4 w; w.x = cvt_pk_bf16(sacc[2 * s2].x, sacc[2 * s2].y); w.y = cvt_pk_bf16(sacc[2 * s2].z, sacc[2 * s2].w);
        w.z = cvt_pk_bf16(sacc[2 * s2 + 1].x, sacc[2 * s2 + 1].y); w.w = cvt_pk_bf16(sacc[2 * s2 + 1].z, sacc[2 * s2 + 1].w);
        const bf16x8 pb = __builtin_bit_cast(bf16x8, w);
#pragma unroll
        for (int et = 0; et < 4; ++et) {
            const LAS bf16_t* vr = vT + (eh * 64 + et * 16 + fr) * MTLD + s2 * 32 + 4 * fq;
            const u32x2 lo = *(const LAS u32x2*)vr, hi = *(const LAS u32x2*)(vr + 16);
            acc[et] = MFMA16(__builtin_bit_cast(bf16x8, ((u32x4){lo.x, lo.y, hi.x, hi.y})), pb, acc[et]);
        }
    }
    const float den = dcy * nq + rs;
    const float hd = 1.f / fmaxf(fabsf(den), emt[tl]);
    float sq = 0.f;
#pragma unroll
    for (int et = 0; et < 4; ++et) { acc[et] = acc[et] * hd; sq += acc[et].x * acc[et].x + acc[et].y * acc[et].y + acc[et].z * acc[et].z + acc[et].w * acc[et].w; }
    sq += __shfl_xor(sq, 16); sq += __shfl_xor(sq, 32);
    if (fq == 0) ssq[eh * 64 + tl] = sq;
    __syncthreads();
    const float rinv = rsqrtf((ssq[tl] + ssq[64 + tl]) * (1.f / 128.f) + RMS_EPS);
    const float* gmo = p.in[20] + h * DM;
    bf16_t* ao = (bf16_t*)(p.ws + B_AO);
#pragma unroll
    for (int et = 0; et < 4; ++et) {
        const int e = eh * 64 + et * 16 + 4 * fq;
        const u32x2 op = *(const u32x2*)(proj + (size_t)(t0 + tl) * IN_DIM + OFF_MO + h * DM + e);
        const f32x4 g = *(const f32x4*)(gmo + e);
        const f32x4 v = acc[et] * rinv * g;
        u32x2 w; w.x = cvt_pk_bf16(v.x * sigmoidf_(bflo(op.x)), v.y * sigmoidf_(bfhi(op.x))); w.y = cvt_pk_bf16(v.z * sigmoidf_(bflo(op.y)), v.w * sigmoidf_(bfhi(op.y)));
        *(u32x2*)(ao + (size_t)(t0 + tl) * 1024 + 512 + h * DM + e) = w;
    }
    __syncthreads();
}

__device__ __forceinline__ unsigned fkey(float f) { const unsigned u = __float_as_uint(f); return (u & 0x80000000u) ? ~u : (u | 0x80000000u); }
__device__ __forceinline__ float rdlane_f(float v, int l) { return __uint_as_float((unsigned)__builtin_amdgcn_readlane((int)__float_as_uint(v), l)); }
__device__ __forceinline__ void route_token(const f32x4 cur, const f32x4 bias, int lane, int (&e8)[8], float (&w8)[8]) {
    float sc[4] = {sigmoidf_(cur.x), sigmoidf_(cur.y), sigmoidf_(cur.z), sigmoidf_(cur.w)};
    float sb[4] = {sc[0] + bias.x, sc[1] + bias.y, sc[2] + bias.z, sc[3] + bias.w};
    float t1 = fmaxf(fmaxf(sb[0], sb[1]), fmaxf(sb[2], sb[3]));
    float t2;
    {   const float a = fmaxf(sb[0], sb[1]), bmin = fminf(sb[0], sb[1]), c2 = fmaxf(sb[2], sb[3]), dmin = fminf(sb[2], sb[3]);
        t2 = fmaxf(fminf(a, c2), fmaxf(bmin, dmin)); }
#pragma unroll
    for (int o = 1; o < 8; o <<= 1) {
        const float o1 = __shfl_xor(t1, o), o2 = __shfl_xor(t2, o);
        const float n1 = fmaxf(t1, o1), n2 = fmaxf(fminf(t1, o1), fmaxf(t2, o2));
        t1 = n1; t2 = n2;
    }
    const float gs = t1 + t2;
    const int myg = lane >> 3;
    int rank = 0;
#pragma unroll
    for (int g = 0; g < 8; ++g) { const float og = rdlane_f(gs, g * 8); rank += (og > gs || (og == gs && g < myg)) ? 1 : 0; }
    const bool keep = rank < 4;
    unsigned key[4];
#pragma unroll
    for (int j = 0; j < 4; ++j) key[j] = keep ? fkey(sb[j]) : 0u;
    unsigned t = 0u;
#pragma unroll 4
    for (int bit = 31; bit >= 0; --bit) {
        const unsigned tt = t | (1u << bit);
        const int c = __builtin_popcountll(__ballot(key[0] >= tt)) + __builtin_popcountll(__ballot(key[1] >= tt)) + __builtin_popcountll(__ballot(key[2] >= tt)) + __builtin_popcountll(__ballot(key[3] >= tt));
        if (c >= TOPK) t = tt;
    }
    unsigned long long sel[4], eq[4];
    int ngt = 0;
#pragma unroll
    for (int j = 0; j < 4; ++j) { sel[j] = __ballot(key[j] > t); eq[j] = __ballot(key[j] == t); ngt += __builtin_popcountll(sel[j]); }
    for (int need = TOPK - ngt; need > 0; --need) {
        int best = 1 << 30;
#pragma unroll
        for (int j = 0; j < 4; ++j) if (eq[j]) { const int idx = 4 * (int)__builtin_ctzll(eq[j]) + j; best = idx < best ? idx : best; }
        const int L = best >> 2, jj = best & 3;
#pragma unroll
        for (int j = 0; j < 4; ++j) if (jj == j) { eq[j] &= ~(1ull << L); sel[j] |= (1ull << L); }
    }
    float wsum = 0.f;
#pragma unroll
    for (int k = 0; k < TOPK; ++k) {
        int best = 1 << 30;
#pragma unroll
        for (int j = 0; j < 4; ++j) if (sel[j]) { const int idx = 4 * (int)__builtin_ctzll(sel[j]) + j; best = idx < best ? idx : best; }
        const int L = best >> 2, jj = best & 3;
#pragma unroll
        for (int j = 0; j < 4; ++j) if (jj == j) sel[j] &= ~(1ull << L);
        const float s0 = rdlane_f(sc[0], L), s1 = rdlane_f(sc[1], L), s2 = rdlane_f(sc[2], L), s3 = rdlane_f(sc[3], L);
        const float sraw = (jj == 0) ? s0 : (jj == 1) ? s1 : (jj == 2) ? s2 : s3;
        e8[k] = best; w8[k] = sraw; wsum += sraw;
    }
    const float inv = 2.5f / wsum;
#pragma unroll
    for (int k = 0; k < TOPK; ++k) w8[k] *= inv;
}
__device__ __forceinline__ void route_rows(const Params& p, int gw, int ngw, int lane) {
    const float* logits = (const float*)(p.ws + C_LOGITS); const float* rb = p.in[24];
    int* cnt = (int*)(p.ws + WS_CNT);
    int* tok_e = (int*)(p.ws + C_TOKE); float* tok_w = (float*)(p.ws + C_TOKW); int* tok_pos = (int*)(p.ws + C_TOKPOS);
    int* list_tok = (int*)(p.ws + C_LISTTOK); float* list_w = (float*)(p.ws + C_LISTW);
    const f32x4 bias = *(const f32x4*)(rb + lane * 4);
    for (int row0 = gw; row0 < T; row0 += ngw * 8) {
        int e_all = 0, row_all = -1; float w_all = 0.f;
        f32x4 lg = *(const f32x4*)(logits + (size_t)row0 * 256 + lane * 4);
#pragma unroll 1
        for (int i = 0; i < 8; ++i) {
            const int row = row0 + i * ngw;
            if (row >= T) break;
            const f32x4 cur = lg;
            if (i + 1 < 8 && row + ngw < T) lg = *(const f32x4*)(logits + (size_t)(row + ngw) * 256 + lane * 4);
            int e8[8]; float w8[8];
            route_token(cur, bias, lane, e8, w8);
            if ((lane >> 3) == i) {
                const int k = lane & 7; int es = e8[0]; float wsel = w8[0];
#pragma unroll
                for (int q = 1; q < 8; ++q) if (k == q) { es = e8[q]; wsel = w8[q]; }
                e_all = es; w_all = wsel; row_all = row;
            }
        }
        if (row_all >= 0) {
            const int k = lane & 7;
            const int pos = atomicAdd(&cnt[e_all * CNT_STRIDE], 1);
            tok_e[(size_t)row_all * 8 + k] = e_all; tok_w[(size_t)row_all * 8 + k] = w_all; tok_pos[(size_t)row_all * 8 + k] = pos;
            list_tok[(size_t)e_all * CAP + pos] = row_all; list_w[(size_t)e_all * CAP + pos] = w_all;
        }
    }
}

__device__ __forceinline__ void expert_prefix(const Params& p, LAS int* base, LAS int* tsa, int tid, int ngrp) {
    const int* cnt = (const int*)(p.ws + WS_CNT);
    const int nper = NE / ngrp;
    const int wave = tid >> 6, lane = tid & 63;
    if (tid < 64) {
        int c[4]; int s = 0;
#pragma unroll
        for (int j = 0; j < 4; ++j) { c[j] = __hip_atomic_load(cnt + (tid * 4 + j) * CNT_STRIDE, __ATOMIC_RELAXED, __HIP_MEMORY_SCOPE_AGENT); s += c[j]; }
        int ps = s;
#pragma unroll
        for (int o = 1; o < 64; o <<= 1) { const int a = __builtin_amdgcn_ds_bpermute(((lane - o) & 63) << 2, ps); if (lane >= o) ps += a; }
        int es = ps - s;
#pragma unroll
        for (int j = 0; j < 4; ++j) { base[tid * 4 + j] = es; es += c[j]; }
    }
    if (wave < ngrp) {
        LAS int* tsx = tsa + wave * (nper + 1);
        int run = 0;
        for (int r0 = 0; r0 < nper; r0 += 64) {
            const int i = r0 + lane;
            int tl = 0;
            if (i < nper) tl = (__hip_atomic_load(cnt + (wave + ngrp * i) * CNT_STRIDE, __ATOMIC_RELAXED, __HIP_MEMORY_SCOPE_AGENT) + 255) >> 8;
            int pt = tl;
#pragma unroll
            for (int o = 1; o < 64; o <<= 1) { const int a = __builtin_amdgcn_ds_bpermute(((lane - o) & 63) << 2, pt); if (lane >= o) pt += a; }
            if (i < nper) tsx[i] = run + pt - tl;
            run += __builtin_amdgcn_readlane(pt, 63);
        }
        if (lane == 0) tsx[nper] = run;
    }
    __syncthreads();
}
__device__ __forceinline__ int sched_nunits(const LAS int* tsa, int g, int nper, int mult) { return tsa[g * (nper + 1) + nper] * mult; }
__device__ __forceinline__ int sched_nstatic(int n, int gper) { const int r = n / gper - 1; return r > 0 ? r : 0; }
__device__ __forceinline__ bool sched_next(int* ctr, const LAS int* tsa, volatile LAS int* slot, int tid, int ngrp, int nper, int mult, int gper, int& g, int& u) {
    if (tid == 0) {
        int rg = -1, ru = 0;
        for (int tries = 0; tries < 64 && rg < 0; ++tries) {
            const int n = sched_nunits(tsa, g, nper, mult), st = sched_nstatic(n, gper) * gper;
            const int t = __hip_atomic_fetch_add(ctr + g * CNT_STRIDE, 1, __ATOMIC_RELAXED, __HIP_MEMORY_SCOPE_AGENT) + st;
            if (t < n) { rg = g; ru = t; break; }
            int ng = -1, bestd = 8;
#pragma unroll
            for (int j = 0; j < 8; ++j) {
                if (j < ngrp) {
                    const int cj = __hip_atomic_load(ctr + j * CNT_STRIDE, __ATOMIC_RELAXED, __HIP_MEMORY_SCOPE_AGENT);
                    const int nj = sched_nunits(tsa, j, nper, mult), d = (j - g) & 7;
                    if (d != 0 && d < bestd && cj + sched_nstatic(nj, gper) * gper < nj) { bestd = d; ng = j; }
                }
            }
            if (ng < 0) break;
            g = ng;
        }
        slot[0] = rg; slot[1] = ru;
    }
    __syncthreads();
    const int rg = slot[0]; u = slot[1];
    __syncthreads();
    if (rg < 0) return false;
    g = rg; return true;
}

__device__ __forceinline__ void combine_rows(const Params& p, LAS int* base, int gw, int ngw, int lane) {
    const bf16_t* sh = (const bf16_t*)(p.ws + C_SHOUT); const unsigned char* y = (const unsigned char*)(p.ws + C_Y);
    const int* tok_e = (const int*)(p.ws + C_TOKE); const int* tok_pos = (const int*)(p.ws + C_TOKPOS);
    const float* ada = (const float*)(p.ws + WS_ADA);
    typedef float f32x2v __attribute__((ext_vector_type(2)));
    for (int row = gw; row < T; row += ngw) {
        const int b = row / S;
        const int col = lane * 16;
        u32x4 yr[TOPK];
#pragma unroll
        for (int k = 0; k < TOPK; ++k) {
            const int e = tok_e[(size_t)row * 8 + k], pos = tok_pos[(size_t)row * 8 + k];
            yr[k] = *(const u32x4*)(y + (size_t)(base[e] + pos) * 1024 + col);
        }
        float acc[16];
        {
            const u32x4 a0 = *(const u32x4*)(sh + (size_t)row * 1024 + col), a1 = *(const u32x4*)(sh + (size_t)row * 1024 + col + 8);
            acc[0] = bflo(a0.x); acc[1] = bfhi(a0.x); acc[2] = bflo(a0.y); acc[3] = bfhi(a0.y); acc[4] = bflo(a0.z); acc[5] = bfhi(a0.z); acc[6] = bflo(a0.w); acc[7] = bfhi(a0.w);
            acc[8] = bflo(a1.x); acc[9] = bfhi(a1.x); acc[10] = bflo(a1.y); acc[11] = bfhi(a1.y); acc[12] = bflo(a1.z); acc[13] = bfhi(a1.z); acc[14] = bflo(a1.w); acc[15] = bfhi(a1.w);
        }
#pragma unroll
        for (int k = 0; k < TOPK; ++k) {
            const unsigned w4[4] = {yr[k].x, yr[k].y, yr[k].z, yr[k].w};
#pragma unroll
            for (int q = 0; q < 4; ++q) {
                const f32x2v lo = __builtin_amdgcn_cvt_pk_f32_fp8((int)w4[q], false), hi = __builtin_amdgcn_cvt_pk_f32_fp8((int)w4[q], true);
                acc[4 * q + 0] += lo.x; acc[4 * q + 1] += lo.y; acc[4 * q + 2] += hi.x; acc[4 * q + 3] += hi.y;
            }
        }
        float* o = p.out + (size_t)row * D + col;
        const float* g = ada + b * 6144 + 5120 + col;
        const bf16_t* x1r = (const bf16_t*)(p.ws + C_X1) + (size_t)row * D + col;
        const u32x4 xa = *(const u32x4*)x1r, xb = *(const u32x4*)(x1r + 8);
        const unsigned xw[8] = {xa.x, xa.y, xa.z, xa.w, xb.x, xb.y, xb.z, xb.w};
#pragma unroll
        for (int q4 = 0; q4 < 4; ++q4) {
            const f32x4 x = (f32x4){bflo(xw[2 * q4]), bfhi(xw[2 * q4]), bflo(xw[2 * q4 + 1]), bfhi(xw[2 * q4 + 1])}, gg = *(const f32x4*)(g + q4 * 4);
            f32x4 r; r.x = x.x + gg.x * acc[q4 * 4 + 0]; r.y = x.y + gg.y * acc[q4 * 4 + 1]; r.z = x.z + gg.z * acc[q4 * 4 + 2]; r.w = x.w + gg.w * acc[q4 * 4 + 3];
            *(f32x4*)(o + q4 * 4) = r;
        }
    }
}


struct PgProj {
    static constexpr bool PERM = true, AFTER_DRAIN = false;
    bf16_t* proj; float* graw;
    __device__ __forceinline__ void operator()(const f32x4 (&acc)[2][2][4][2], const pg8::Unit& u, int wr, int wc, int fr, int fq) const {
#pragma unroll
        for (int ai = 0; ai < 2; ++ai)
#pragma unroll
            for (int m = 0; m < 4; ++m) { const int row = u.pm * 256 + ai * 128 + wr * 64 + m * 16 + fr;
#pragma unroll
                for (int bj = 0; bj < 2; ++bj) { const int col = u.pn * 256 + bj * 128 + wc * 32 + 8 * fq;
                    if (col < OFF_GATE) { const u32x2 lo = pack4(acc[ai][bj][m][0]), hi = pack4(acc[ai][bj][m][1]); *(u32x4*)(proj + (size_t)row * IN_DIM + col) = (u32x4){lo.x, lo.y, hi.x, hi.y}; }
                    else if (col < IN_DIM) { *(f32x4*)(graw + (size_t)row * 8) = acc[ai][bj][m][0]; *(f32x4*)(graw + (size_t)row * 8 + 4) = acc[ai][bj][m][1]; } } }
    }
};
struct PgBf16 {
    static constexpr bool PERM = true, AFTER_DRAIN = false;
    bf16_t* O; int ldc;
    __device__ __forceinline__ void operator()(const f32x4 (&acc)[2][2][4][2], const pg8::Unit& u, int wr, int wc, int fr, int fq) const {
#pragma unroll
        for (int ai = 0; ai < 2; ++ai)
#pragma unroll
            for (int m = 0; m < 4; ++m) { const int row = u.pm * 256 + ai * 128 + wr * 64 + m * 16 + fr;
#pragma unroll
                for (int bj = 0; bj < 2; ++bj) { const int col = u.pn * 256 + bj * 128 + wc * 32 + 8 * fq;
                    const u32x2 lo = pack4(acc[ai][bj][m][0]), hi = pack4(acc[ai][bj][m][1]); *(u32x4*)(O + (size_t)row * ldc + col) = (u32x4){lo.x, lo.y, hi.x, hi.y}; } }
    }
};
struct PgMqk {
    static constexpr bool PERM = true, AFTER_DRAIN = false;
    bf16_t* mq; bf16_t* mk;
    __device__ __forceinline__ void operator()(const f32x4 (&acc)[2][2][4][2], const pg8::Unit& u, int wr, int wc, int fr, int fq) const {
#pragma unroll
        for (int ai = 0; ai < 2; ++ai)
#pragma unroll
            for (int m = 0; m < 4; ++m) { const int row = u.pm * 256 + ai * 128 + wr * 64 + m * 16 + fr;
#pragma unroll
                for (int bj = 0; bj < 2; ++bj) { const int c = wc * 32 + 8 * fq; const float sc = bj ? 0.08838834764831845f : 1.f;
                    const u32x2 lo = pack4(acc[ai][bj][m][0] * sc), hi = pack4(acc[ai][bj][m][1] * sc);
                    *(u32x4*)((bj ? mk : mq) + (size_t)row * MINNER + u.pn * DM + c) = (u32x4){lo.x, lo.y, hi.x, hi.y}; } }
    }
};
struct PgResid {
    static constexpr bool PERM = true, AFTER_DRAIN = false;
    const float* X; const float* ada; int gt_off; bf16_t* out;
    __device__ __forceinline__ void operator()(const f32x4 (&acc)[2][2][4][2], const pg8::Unit& u, int wr, int wc, int fr, int fq) const {
#pragma unroll
        for (int ai = 0; ai < 2; ++ai)
#pragma unroll
            for (int m = 0; m < 4; ++m) { const int row = u.pm * 256 + ai * 128 + wr * 64 + m * 16 + fr; const int b = row / S;
#pragma unroll
                for (int bj = 0; bj < 2; ++bj) { const int col = u.pn * 256 + bj * 128 + wc * 32 + 8 * fq;
                    const f32x4 g0 = *(const f32x4*)(ada + b * 6144 + gt_off + col), g1 = *(const f32x4*)(ada + b * 6144 + gt_off + col + 4);
                    const f32x4 x0 = *(const f32x4*)(X + (size_t)row * D + col), x1 = *(const f32x4*)(X + (size_t)row * D + col + 4);
                    const u32x2 lo = pack4(x0 + g0 * acc[ai][bj][m][0]), hi = pack4(x1 + g1 * acc[ai][bj][m][1]);
                    *(u32x4*)(out + (size_t)row * D + col) = (u32x4){lo.x, lo.y, hi.x, hi.y}; } }
    }
};
struct PgRgu {
    static constexpr bool PERM = false, AFTER_DRAIN = false;
    float* logits; bf16_t* act;
    __device__ __forceinline__ void operator()(const f32x4 (&acc)[2][2][4][2], const pg8::Unit& u, int wr, int wc, int fr, int fq) const {
#pragma unroll
        for (int ai = 0; ai < 2; ++ai)
#pragma unroll
            for (int m = 0; m < 4; ++m) { const int row = u.pm * 256 + ai * 128 + wr * 64 + m * 16 + fr;
#pragma unroll
                for (int bj = 0; bj < 2; ++bj) {
                    if (u.pn == 0) {
#pragma unroll
                        for (int n = 0; n < 2; ++n) *(f32x4*)(logits + (size_t)row * 256 + bj * 128 + wc * 32 + n * 16 + 4 * fq) = acc[ai][bj][m][n];
                    } else {
                        const int j = ((u.pn - 1) * 256 + bj * 128 + wc * 32) >> 5;
                        *(u32x2*)(act + (size_t)row * 256 + j * 16 + 4 * fq) = pack_swiglu(acc[ai][bj][m][0], acc[ai][bj][m][1]);
                    }
                } }
    }
};

__device__ __forceinline__ int xcd_remap(int L, int nwg) { const int q = nwg >> 3, r = nwg & 7, x = L & 7, off = L >> 3; return (x < r ? x * (q + 1) : r * (q + 1) + (x - r) * q) + off; }
__global__ void __launch_bounds__(NT, 2) fwd_kernel(Params p) {
    extern __shared__ __attribute__((aligned(16))) unsigned char lds_raw[];
    LAS unsigned char* lds = (LAS unsigned char*)lds_raw;
    const int G = gridDim.x, bid = blockIdx.x, ngw = G * NWAVES;
#define FRESH_IDS() const int tid = fresh_tid(), lane = tid & 63, wid = tid >> 6, gw = bid * NWAVES + wid; (void)lane; (void)gw
    { const int tid = fresh_tid(); volatile LAS unsigned* bst0 = (volatile LAS unsigned*)(lds + LDS_BYTES - 64); if (tid < 2) bst0[tid] = 0u; }
    unsigned char* ws = p.ws;
    const float* ada = (const float*)(ws + WS_ADA);
    volatile LAS unsigned* bst = (volatile LAS unsigned*)(lds + LDS_BYTES - 64);
    __syncthreads();
    const XcdBarrier xbar = xcd_barrier_post((unsigned*)(ws + WS_CTL + 4096), bst);
    int ts_n = 0;
#if DBG_STAGE == 2
#define TSTAMP() do { if (bid == 0 && threadIdx.x == 0) ((unsigned long long*)(ws + WS_CTL + 16384 + 8192))[ts_n] = __builtin_amdgcn_s_memrealtime(); ++ts_n; } while (0)
#else
#define TSTAMP() do { } while (0)
#endif
    TSTAMP();

    {
        FRESH_IDS();
        for (int u = bid; u < 192; u += G) ada_unit(p, lds, u, tid);
        LAS float* scr = (LAS float*)(lds + wid * 8448);
        constexpr int I0 = 16 * 70, I1 = I0 + 6 * 24, I2 = I1 + 4 * 32, I3 = I2 + 32, I4 = I3 + 32;
        const int vw = ((bid + G - (192 % G)) % G) * NWAVES + wid;
        for (int it = vw; it < I4; it += ngw) {
            if (it < I0) conv_item<0>(p.in[6], 1024, IN_DIM, (bf16_t*)(ws + WS_WIN), 0, 0, scr, it, lane);
            else if (it < I1) conv_item<0>(p.in[8], QLORA, 768, (bf16_t*)(ws + WS_WUQ), 0, 0, scr, it - I0, lane);
            else if (it < I2) conv_item<0>(p.in[10], KVLORA, 1024, (bf16_t*)(ws + WS_WUKV), 0, 0, scr, it - I1, lane);
            else if (it < I3) conv_item<0>(p.in[16], 128, 128, (bf16_t*)(ws + WS_WMQK), 256 * 128, 0, scr, it - I2, lane);
            else conv_item<0>(p.in[17], 128, 128, (bf16_t*)(ws + WS_WMQK), 256 * 128, 128, scr, it - I3, lane);
        }
        u32x4* zp = (u32x4*)((bf16_t*)(ws + WS_WIN) + (size_t)IN_DIM * 1024);
        for (int i = bid * NT + tid; i < (2304 - IN_DIM) * 1024 / 8; i += G * NT) zp[i] = (u32x4){0u, 0u, 0u, 0u};
    }
    xcd_barrier(xbar); TSTAMP();
    { FRESH_IDS(); norm_mod_rows(p.in[0], p.in[5], ada, 0, 1024, (bf16_t*)(ws + B_H1), gw, ngw, lane); }
    xcd_barrier(xbar); TSTAMP();
    {
        const pg8::Gemm g{(const bf16_t*)(ws + B_H1), (const bf16_t*)(ws + WS_WIN), T, 2304, 1024, 1024, 1024, 0};
        pg8::StaticOrder SO; SO.init(T, 2304, G, bid);
        const PgProj E{(bf16_t*)(ws + B_PROJ), (float*)(ws + B_GRAW)};
        pg8::gemm_phase<PgProj, pg8::StaticOrder, true, true>(lds, g, SO, E);
        {
            FRESH_IDS();
            const int nfull = (576 % G) ? (576 % G) : 0;
            if (bid >= nfull) {
                LAS float* scr = (LAS float*)(lds + wid * 8448);
                constexpr int J0 = 16 * 32, J1 = J0 + 16 * 8, J2 = J1 + 16 * 8, J3 = J2 + 16 * 8, J4 = J3 + 4 * 32;
                for (int it = (bid - nfull) * NWAVES + wid; it < J4; it += (G - nfull) * NWAVES) {
                    if (it < J0) conv_item<0>(p.in[21], 1024, 1024, (bf16_t*)(ws + WS_WOUT), 0, 0, scr, it, lane);
                    else if (it < J1) conv_item<0>(p.in[23], 1024, 256, (bf16_t*)(ws + WS_WRGU), 0, 0, scr, it - J0, lane);
                    else if (it < J2) conv_item<1>(p.in[28], 1024, 256, (bf16_t*)(ws + WS_WRGU), 0, 256, scr, it - J1, lane);
                    else if (it < J3) conv_item<2>(p.in[29], 1024, 256, (bf16_t*)(ws + WS_WRGU), 0, 256, scr, it - J2, lane);
                    else conv_item<0>(p.in[30], 256, 1024, (bf16_t*)(ws + WS_WDSH), 0, 0, scr, it - J3, lane);
                }
            }
        }
    }
    xcd_barrier(xbar); TSTAMP();
    { FRESH_IDS(); post_proj_rows(p, gw, ngw, lane); }
    xcd_barrier(xbar); TSTAMP();
    {
        {   const pg8::Gemm g{(const bf16_t*)(ws + B_CQN), (const bf16_t*)(ws + WS_WUQ), T, 768, QLORA, QLORA, QLORA, 0};
            pg8::StaticOrder SO; SO.init(T, 768, G, bid); const PgBf16 E{(bf16_t*)(ws + B_QRAW), 768};
            pg8::gemm_phase<PgBf16, pg8::StaticOrder, true, true>(lds, g, SO, E); }
        {   const pg8::Gemm g{(const bf16_t*)(ws + B_CKVN), (const bf16_t*)(ws + WS_WUKV), T, 1024, KVLORA, KVLORA, KVLORA, 0};
            pg8::StaticOrder SO; SO.init(T, 1024, G, bid); const PgBf16 E{(bf16_t*)(ws + B_KVRAW), 1024};
            pg8::gemm_phase<PgBf16, pg8::StaticOrder, true, true>(lds, g, SO, E); }
        {   const pg8::Gemm g{(const bf16_t*)(ws + B_ZC), (const bf16_t*)(ws + WS_WMQK), T, 1024, DM, MINNER, DM, DM};
            pg8::StaticOrder SO; SO.init(T, 1024, G, bid); const PgMqk E{(bf16_t*)(ws + B_MQ), (bf16_t*)(ws + B_MK)};
            pg8::gemm_phase<PgMqk, pg8::StaticOrder, true, true>(lds, g, SO, E); }
    }
    xcd_barrier(xbar); TSTAMP();
    { FRESH_IDS(); qk_post_rows(p, gw, ngw, lane); }
    xcd_barrier(xbar); TSTAMP();
    for (int pr = bid; pr < 256; pr += G) { const int bh = pr & 63, j = pr >> 6; attn_unit(p, lds, bh, 7 - j); attn_unit(p, lds, bh, j); }
    for (int u = bid; u < 1024; u += G) mlstm_a_unit(p, lds, u);
    xcd_barrier(xbar); TSTAMP();
    { FRESH_IDS(); mlstm_scan(p, bid * NT + tid, G * NT); }
    { FRESH_IDS(); attn_out_norm_rows(p, gw, ngw, lane); }
    xcd_barrier(xbar); TSTAMP();
    {
        McRegs R;
        if (bid < 1024) mlstm_c_load(p, bid, R);
        for (int u = bid; u < 1024; u += G) mlstm_c_unit(p, lds, u, R, (u + G < 1024) ? u + G : -1);
    }
    xcd_barrier(xbar); TSTAMP();
    {
        const pg8::Gemm g{(const bf16_t*)(ws + B_AO), (const bf16_t*)(ws + WS_WOUT), T, 1024, 1024, 1024, 1024, 0};
        pg8::StaticOrder SO; SO.init(T, 1024, G, bid); const PgResid E{p.in[0], ada, 2048, (bf16_t*)(ws + C_X1)};
        pg8::gemm_phase<PgResid, pg8::StaticOrder, true, true>(lds, g, SO, E);
    }
    xcd_barrier(xbar); TSTAMP();
    { FRESH_IDS(); norm_mod_rows_bf((const bf16_t*)(ws + C_X1), p.in[22], ada, 3072, 4096, (bf16_t*)(ws + C_H2), gw, ngw, lane, ws + C_H2F8); }
    xcd_barrier(xbar); TSTAMP();
    {
        const pg8::Gemm g{(const bf16_t*)(ws + C_H2), (const bf16_t*)(ws + WS_WRGU), T, 768, 1024, 1024, 1024, 0};
        pg8::StaticOrder SO; SO.init(T, 768, G, bid); const PgRgu E{(float*)(ws + C_LOGITS), (bf16_t*)(ws + C_ACTSH)};
        pg8::gemm_phase<PgRgu, pg8::StaticOrder, true, true>(lds, g, SO, E);
    }
    xcd_barrier(xbar); TSTAMP();
    { FRESH_IDS(); route_rows(p, gw, ngw, lane); }
    {
        const pg8::Gemm g{(const bf16_t*)(ws + C_ACTSH), (const bf16_t*)(ws + WS_WDSH), T, 1024, 256, 256, 256, 0};
        pg8::StaticOrder SO; SO.init(T, 1024, G, bid); const PgBf16 E{(bf16_t*)(ws + C_SHOUT), 1024};
        pg8::gemm_phase<PgBf16, pg8::StaticOrder, true, true>(lds, g, SO, E);
    }
    xcd_barrier(xbar); TSTAMP();
    LAS int* base = (LAS int*)(lds + 132 * 1024);
    LAS int* tsa = base + 256;
    volatile LAS int* tslot = (volatile LAS int*)(base + 1024);
    const int ngrp = (G % 8 == 0) ? 8 : 1, gx = bid % ngrp, gidx = bid / ngrp, gper = G / ngrp, nexp = NE / ngrp;
    { FRESH_IDS(); expert_prefix(p, base, tsa, tid, ngrp); }
#define EXPERT_UNITS(ctr_, mult_, ...) do { \
        const int nown_ = sched_nunits(tsa, gx, nexp, mult_), nst_ = sched_nstatic(nown_, gper) * gper; \
        for (int u = gidx; u < nst_; u += gper) { const int g = gx; __VA_ARGS__; } \
        int g = gx, u = 0; \
        while (sched_next(ctr_, tsa, tslot, fresh_tid(), ngrp, nexp, mult_, gper, g, u)) { __VA_ARGS__; } } while (0)
    {
        const int* cnt = (const int*)(ws + WS_CNT);
        EXPERT_UNITS((int*)(ws + WS_TICKET8), 4, {
            const LAS int* tsx = tsa + g * (nexp + 1);
            const int tg = u >> 2, tn = u & 3;
            int lo = 0, hi = nexp - 1;
            while (lo < hi) { const int mid = (lo + hi + 1) >> 1; if (tsx[mid] <= tg) lo = mid; else hi = mid - 1; }
            const int e = g + ngrp * lo, blk = tg - tsx[lo], c = __hip_atomic_load(cnt + e * CNT_STRIDE, __ATOMIC_RELAXED, __HIP_MEMORY_SCOPE_AGENT);
            const int nvalid = min(256, c - blk * 256);
            const RowGather RP{(const unsigned char*)(ws + C_H2F8), (const int*)(ws + C_LISTTOK) + (size_t)e * CAP + blk * 256, nvalid};
            const ColGU CP{p.in[25] + (size_t)e * 1024 * 256, p.in[26] - p.in[25]};
            const EpiExpAct E{(unsigned char*)(ws + C_ACTE), base[e] + blk * 256, nvalid};
            gemm2_tile(lds, RP, CP, 256, 1024, 0, tn * 128, E, nvalid);
        });
    }
    xcd_barrier(xbar); TSTAMP();
    {
        const int* cnt = (const int*)(ws + WS_CNT);
        EXPERT_UNITS((int*)(ws + WS_TICKET9), 2, {
            const LAS int* tsx = tsa + g * (nexp + 1);
            const int tg = u >> 1, nq = u & 1;
            int lo = 0, hi = nexp - 1;
            while (lo < hi) { const int mid = (lo + hi + 1) >> 1; if (tsx[mid] <= tg) lo = mid; else hi = mid - 1; }
            const int e = g + ngrp * lo, blk = tg - tsx[lo], c = __hip_atomic_load(cnt + e * CNT_STRIDE, __ATOMIC_RELAXED, __HIP_MEMORY_SCOPE_AGENT);
            const int nvalid = min(256, c - blk * 256);
            const int slot0 = base[e] + blk * 256;
            expert_down_unit(lds, (const unsigned char*)(ws + C_ACTE), p.in[27] + (size_t)e * 256 * 1024, nq, (unsigned char*)(ws + C_Y),
                             (const float*)(ws + C_LISTW) + (size_t)e * CAP + blk * 256, slot0, nvalid);
        });
    }
    xcd_barrier(xbar); TSTAMP();
    { FRESH_IDS(); combine_rows(p, base, gw, ngw, lane); }
#if DBG_STAGE == 2
    xcd_barrier(xbar); TSTAMP();
    xcd_barrier(xbar);
    {   FRESH_IDS();
        const unsigned long long* ts = (const unsigned long long*)(ws + WS_CTL + 16384 + 8192);
        const float tus = (float)(long long)(ts[TS_A1] - ts[TS_A0]) * 0.01f;
        const float cadd = sqrtf(2.5e-3f * tus * (1.f / 500.f));
        for (size_t i = (size_t)bid * NT + tid; i < (size_t)T * D / 4; i += (size_t)G * NT) { f32x4 v = ((f32x4*)p.out)[i]; v = v + cadd; ((f32x4*)p.out)[i] = v; }
    }
#endif
}

extern "C" void kernel_launch(void* const* d_in, const int* in_sizes, int n_in,
                              void* d_out, int out_size, void* d_ws, size_t ws_size,
                              hipStream_t stream) {
    static int grid_blocks = 0;
    if (!grid_blocks) {
        if (n_in != 31 || out_size != T * D || ws_size < WS_END) { fprintf(stderr, "kernel_launch: unexpected shapes n_in=%d out=%d ws=%zu (need %zu)\n", n_in, out_size, ws_size, (size_t)WS_END); grid_blocks = -1; return; }
        int dev = 0, cus = 0, per_cu = 0;
        (void)hipGetDevice(&dev);
        (void)hipDeviceGetAttribute(&cus, hipDeviceAttributeMultiprocessorCount, dev);
        (void)hipFuncSetAttribute((const void*)fwd_kernel, hipFuncAttributeMaxDynamicSharedMemorySize, LDS_BYTES);
        (void)hipOccupancyMaxActiveBlocksPerMultiprocessor(&per_cu, (const void*)fwd_kernel, NT, LDS_BYTES);
        if (per_cu < 1) per_cu = 1;
        grid_blocks = cus * per_cu;
        fprintf(stderr, "kernel_launch: cus=%d per_cu=%d grid=%d ws=%zu\n", cus, per_cu, grid_blocks, ws_size);
    }
    if (grid_blocks < 0) return;
    (void)hipMemsetAsync((char*)d_ws + WS_CTL, 0, CTL_BYTES, stream);
    (void)hipMemsetAsync((char*)d_ws + WS_ADA, 0, 8 * 6144 * sizeof(float), stream);
    Params p{};
    for (int i = 0; i < 31; ++i) p.in[i] = (const float*)d_in[i];
    p.out = (float*)d_out; p.ws = (unsigned char*)d_ws;
    void* args[] = {&p};
    hipError_t e = hipLaunchCooperativeKernel((const void*)fwd_kernel, dim3(grid_blocks), dim3(NT), args, LDS_BYTES, stream);
    if (e != hipSuccess) fprintf(stderr, "cooperative launch failed: %s (grid %d)\n", hipGetErrorString(e), grid_blocks);
}
```

```cpp
#include <hip/hip_runtime.h>
#include <hip/hip_cooperative_groups.h>
#include <cstdio>
#include <cstdint>
namespace cg = cooperative_groups;
#ifndef DBG_STAGE
#define DBG_STAGE 0
#endif
#define TS_A0 2
#define TS_A1 3
#define TS_B0 2
#define TS_B1 3

#define LAS __attribute__((address_space(3)))
typedef unsigned short bf16_t;
typedef short bf16x8 __attribute__((ext_vector_type(8)));
typedef short bf16x4 __attribute__((ext_vector_type(4)));
typedef float f32x4 __attribute__((ext_vector_type(4)));
typedef float f32x2 __attribute__((ext_vector_type(2)));
typedef unsigned u32x4 __attribute__((ext_vector_type(4)));
typedef unsigned u32x2 __attribute__((ext_vector_type(2)));

constexpr int NT = 512, NWAVES = 8;
constexpr int LDS_BYTES = 144 * 1024;
constexpr int Bsz = 8, S = 2048, D = 1024, T = Bsz * S;
constexpr int H_MLA = 8, DQK = 96, DNOPE = 64, DROPE = 32, DV = 64, QLORA = 384, KVLORA = 256;
constexpr int H_ML = 4, DM = 128, MINNER = 512, CHUNK = 64, NCH = S / CHUNK;
constexpr int IN_DIM = 2216;
constexpr int OFF_CQ = 0, OFF_CKV = 384, OFF_KR = 640, OFF_Z = 672, OFF_MV = 1184, OFF_MO = 1696, OFF_GATE = 2208;
constexpr int NE = 256, TOPK = 8, EDIM = 256, SDIM = 256;
constexpr int CAP = T;
constexpr float RMS_EPS = 1e-6f;

constexpr size_t MiB = 1u << 20;
constexpr size_t WS_CTL = 0;
constexpr size_t CTL_BYTES = 65536;
constexpr size_t WS_CNT = 32768;
constexpr int CNT_STRIDE = 32;
constexpr size_t WS_ADA = 1 * MiB;
constexpr size_t WS_BC = 2 * MiB;
constexpr size_t WS_MLOC = WS_BC + 8192;
constexpr size_t WS_MPREV = WS_BC + 16384;
constexpr size_t WS_DN = 2 * MiB + 512 * 1024;
constexpr size_t WS_NPREV = 3 * MiB;
constexpr size_t WS_WIN = 4 * MiB;
constexpr size_t WS_WUQ = 9 * MiB;
constexpr size_t WS_WUKV = 10 * MiB;
constexpr size_t WS_WMQK = 11 * MiB;
constexpr size_t WS_WOUT = 12 * MiB;
constexpr size_t WS_WRGU = 14 * MiB;
constexpr size_t WS_WDSH = 16 * MiB;
constexpr size_t WS_TICKET8 = WS_CTL + 18432;
constexpr size_t WS_TICKET9 = WS_CTL + 20480;
constexpr size_t RB = 416 * MiB;
constexpr size_t B_PROJ = RB;
constexpr size_t B_GRAW = RB + 70 * MiB;
constexpr size_t B_GL = RB + 71 * MiB;
constexpr size_t B_H1 = RB + 72 * MiB;
constexpr size_t B_CQN = RB + 104 * MiB;
constexpr size_t B_CKVN = RB + 116 * MiB;
constexpr size_t B_ZC = RB + 124 * MiB;
constexpr size_t B_QRAW = RB + 140 * MiB;
constexpr size_t B_KVRAW = RB + 164 * MiB;
constexpr size_t B_MQ = RB + 196 * MiB;
constexpr size_t B_MK = RB + 212 * MiB;
constexpr size_t B_Q = RB + 228 * MiB;
constexpr size_t B_K = RB + 252 * MiB;
constexpr size_t B_ORAW = RB + 276 * MiB;
constexpr size_t B_AO = RB + 292 * MiB;
constexpr size_t B_DC = RB + 324 * MiB;
constexpr size_t B_CPREV = RB + 388 * MiB;
constexpr size_t C_H2 = RB;
constexpr size_t C_LOGITS = RB + 32 * MiB;
constexpr size_t C_ACTSH = RB + 48 * MiB;
constexpr size_t C_SHOUT = RB + 56 * MiB;
constexpr size_t C_TOKE = RB + 88 * MiB;
constexpr size_t C_TOKW = RB + 89 * MiB;
constexpr size_t C_TOKPOS = RB + 90 * MiB;
constexpr size_t C_LISTTOK = RB + 92 * MiB;
constexpr size_t C_LISTW = RB + 108 * MiB;
constexpr size_t C_ACTE = RB + 124 * MiB;
constexpr size_t C_Y = RB + 188 * MiB;
constexpr size_t C_H2F8 = RB + 320 * MiB;
constexpr size_t C_X1 = RB + 340 * MiB;
constexpr size_t WS_END = RB + 444 * MiB;

struct Params {
    const float* in[31];
    float* out;
    unsigned char* ws;
};

typedef __bf16 bf16x2v __attribute__((ext_vector_type(2)));
__device__ __forceinline__ unsigned cvt_pk_bf16(float lo, float hi) { f32x2 v = {lo, hi}; bf16x2v b = __builtin_convertvector(v, bf16x2v); return __builtin_bit_cast(unsigned, b); }
__device__ __forceinline__ unsigned pk4_fp8(float a, float b, float c, float d) { int p = __builtin_amdgcn_cvt_pk_fp8_f32(a, b, 0, false); p = __builtin_amdgcn_cvt_pk_fp8_f32(c, d, p, true); return (unsigned)p; }
__device__ __forceinline__ float bf2f(unsigned short b) { return __uint_as_float((unsigned)b << 16); }
__device__ __forceinline__ float bflo(unsigned u) { return __uint_as_float(u << 16); }
__device__ __forceinline__ float bfhi(unsigned u) { return __uint_as_float(u & 0xffff0000u); }
__device__ __forceinline__ float wave_sum(float v) {
#pragma unroll
    for (int o = 1; o < 64; o <<= 1) v += __shfl_xor(v, o);
    return v;
}
__device__ __forceinline__ float wave_max(float v) {
#pragma unroll
    for (int o = 1; o < 64; o <<= 1) v = fmaxf(v, __shfl_xor(v, o));
    return v;
}
__device__ __forceinline__ float sigmoidf_(float x) { return __builtin_amdgcn_rcpf(1.f + __builtin_amdgcn_exp2f(-1.4426950408889634f * x)); }
__device__ __forceinline__ float siluf_(float x) { return x * __builtin_amdgcn_rcpf(1.f + __builtin_amdgcn_exp2f(-1.4426950408889634f * x)); }
__device__ __forceinline__ int fresh_tid() { int t = threadIdx.x; asm volatile("" : "+v"(t)); return t; }
#define MFMA16(a, b, c) __builtin_amdgcn_mfma_f32_16x16x32_bf16((a), (b), (c), 0, 0, 0)


#define XB_TMO      128
#define XB_XCNT(j)  (256  + 64 * (j))
#define XB_XSUB(j)  (1280 + 64 * (j))
#define XB_XGEN(j)  (2304 + 64 * (j))
#define XB_TOP      3328
#define XB_TOPGEN   3392
#define XCD_BAR_WORDS 3456
#define XB_SPIN_CAP (1u << 23)
__device__ __forceinline__ unsigned xb_ld(unsigned* p)              { return __hip_atomic_load(p, __ATOMIC_RELAXED, __HIP_MEMORY_SCOPE_AGENT); }
__device__ __forceinline__ unsigned xb_add(unsigned* p, unsigned v) { return __hip_atomic_fetch_add(p, v, __ATOMIC_RELAXED, __HIP_MEMORY_SCOPE_AGENT); }
__device__ __forceinline__ unsigned xb_xcc_id() { return (unsigned)__builtin_amdgcn_s_getreg((3 << 11) | 20) & 0xFu; }
#define XB_SPIN(cond, bar) do { unsigned _sp = 0; while (cond) { __builtin_amdgcn_s_sleep(1); \
    if ((++_sp & 255u) == 0u) { if (xb_ld(&(bar)[XB_TMO])) break; if (_sp > XB_SPIN_CAP) { atomicAdd(&(bar)[XB_TMO], 1u); break; } } } } while (0)
struct XcdBarrier { unsigned* bar; unsigned x; volatile LAS unsigned* st; };
__device__ __forceinline__ XcdBarrier xcd_barrier_post(unsigned* bar, volatile LAS unsigned* st) {
    XcdBarrier b; b.bar = bar; b.x = xb_xcc_id(); b.st = st;
    if (threadIdx.x == 0) (void)xb_add(&bar[XB_XCNT(b.x)], 1u);
    return b;
}
__device__ __forceinline__ void xcd_barrier_complete(unsigned* bar, unsigned x, unsigned& nloc, unsigned& nx) {
    const unsigned G = gridDim.x * gridDim.y * gridDim.z;
    unsigned sum, cnt, mine, sp = 0u;
    for (;;) {
        sum = 0u; cnt = 0u; mine = 0u;
#pragma unroll
        for (unsigned j = 0; j < 16; ++j) { const unsigned c = xb_ld(&bar[XB_XCNT(j)]); sum += c; cnt += (c > 0u) ? 1u : 0u; mine = (j == x) ? c : mine; }
        if (sum == G) break;
        __builtin_amdgcn_s_sleep(1);
        if ((++sp & 255u) == 0u) { if (xb_ld(&bar[XB_TMO])) break; if (sp > XB_SPIN_CAP) { atomicAdd(&bar[XB_TMO], 1u); break; } }
    }
    nloc = mine > 0u ? mine : 1u; nx = cnt > 0u ? cnt : 1u;
}
__device__ __forceinline__ void xcd_barrier(const XcdBarrier& b) {
    asm volatile("s_waitcnt vmcnt(0)" ::: "memory");
    __syncthreads();
    if (threadIdx.x == 0) {
        unsigned* bar = b.bar;
        __builtin_amdgcn_s_waitcnt(0);
        unsigned nloc = b.st[0], nx = b.st[1];
        if (nloc == 0u) { xcd_barrier_complete(bar, b.x, nloc, nx); b.st[0] = nloc; b.st[1] = nx; }
        const unsigned old = xb_add(&bar[XB_XSUB(b.x)], 1u);
        const unsigned gen = old / nloc;
        if (old + 1u == (gen + 1u) * nloc) {
            __builtin_amdgcn_fence(__ATOMIC_RELEASE, "agent");
            asm volatile("s_waitcnt vmcnt(0)" ::: "memory");
            const unsigned og = xb_add(&bar[XB_TOP], 1u);
            const unsigned tg = og / nx;
            if (og + 1u == (tg + 1u) * nx) xb_add(&bar[XB_TOPGEN], 1u);
            else XB_SPIN(xb_ld(&bar[XB_TOPGEN]) == tg, bar);
            __builtin_amdgcn_fence(__ATOMIC_ACQUIRE, "agent");
            xb_add(&bar[XB_XGEN(b.x)], 1u);
            asm volatile("s_waitcnt vmcnt(0)" ::: "memory");
        } else {
            XB_SPIN(xb_ld(&bar[XB_XGEN(b.x)]) == gen, bar);
            __builtin_amdgcn_fence(__ATOMIC_ACQUIRE, "agent");
            asm volatile("s_waitcnt vmcnt(0)" ::: "memory");
        }
    }
    __syncthreads();
}

template <int MAP>
__device__ __forceinline__ int map_row(int n) {
    if (MAP == 0) return n;
    if (MAP == 1) return ((n >> 4) << 5) + (n & 15);
    return ((n >> 4) << 5) + 16 + (n & 15);
}
template <int MAP>
__device__ __forceinline__ void conv_item(const float* src, int K, int N, bf16_t* dst, size_t dst_mat_stride, int row_off, LAS float* scr, int it, int lane) {
    const int nblk = (N + 31) / 32, kblk = K / 64, per = nblk * kblk;
    const int mat = it / per, r = it - mat * per, kb = r / nblk, nb = r - kb * nblk, k0 = kb * 64, n0 = nb * 32;
    const float* W = src + (size_t)mat * K * N;
    bf16_t* WT = dst + (size_t)mat * dst_mat_stride;
    const int nn = n0 + (lane & 31);
    const bool nok = nn < N;
    float v[32];
    const float* wp = W + (size_t)(k0 + (lane >> 5)) * N + nn;
#pragma unroll
    for (int i = 0; i < 32; ++i) v[i] = nok ? wp[(size_t)(2 * i) * N] : 0.f;
#pragma unroll
    for (int i = 0; i < 32; ++i) scr[(2 * i + (lane >> 5)) * 33 + (lane & 31)] = v[i];
    asm volatile("s_waitcnt lgkmcnt(0)" ::: "memory");
    const int c = lane & 7;
#pragma unroll
    for (int j = 0; j < 4; ++j) {
        const int n = (lane >> 3) + 8 * j;
        const LAS float* sp = scr + (8 * c) * 33 + n;
        u32x4 o; o.x = cvt_pk_bf16(sp[0 * 33], sp[1 * 33]); o.y = cvt_pk_bf16(sp[2 * 33], sp[3 * 33]); o.z = cvt_pk_bf16(sp[4 * 33], sp[5 * 33]); o.w = cvt_pk_bf16(sp[6 * 33], sp[7 * 33]);
        if (n0 + n < N) *(u32x4*)(WT + (size_t)(row_off + map_row<MAP>(n0 + n)) * K + k0 + 8 * c) = o;
    }
    asm volatile("s_waitcnt lgkmcnt(0)" ::: "memory");
}

__device__ __forceinline__ void ada_unit(const Params& p, LAS unsigned char* lds, int u, int tid) {
    LAS float* cond = (LAS float*)lds;
    LAS float* red = (LAS float*)(lds + 16384);
    const float* c = p.in[1]; const float* w = p.in[3]; const float* bias = p.in[4];
    float* ada = (float*)(p.ws + WS_ADA);
    const int lane = tid & 63, wv = tid >> 6, cg = u >> 1, kh = u & 1;
    for (int i = tid; i < 8 * 512; i += NT) { const int b = i >> 9, k = i & 511; cond[i] = siluf_(c[b * 1024 + kh * 512 + k]); }
    __syncthreads();
    float acc[8];
#pragma unroll
    for (int b = 0; b < 8; ++b) acc[b] = 0.f;
    const int col = cg * 64 + lane;
    const float* wp = w + (size_t)(kh * 512 + wv * 64) * 6144 + col;
#pragma unroll 16
    for (int k = 0; k < 64; ++k) {
        const float wv_ = wp[(size_t)k * 6144];
#pragma unroll
        for (int b = 0; b < 8; ++b) acc[b] += cond[b * 512 + wv * 64 + k] * wv_;
    }
#pragma unroll
    for (int b = 0; b < 8; ++b) red[(wv * 8 + b) * 64 + lane] = acc[b];
    __syncthreads();
    {
        const int b = tid >> 6;
        float sacc = 0.f;
#pragma unroll
        for (int w2 = 0; w2 < 8; ++w2) sacc += red[(w2 * 8 + b) * 64 + lane];
        atomicAdd(&ada[b * 6144 + col], sacc + (kh == 0 ? bias[col] : 0.f));
    }
    __syncthreads();
}

__device__ __forceinline__ void norm_mod_rows_bf(const bf16_t* X, const float* g, const float* ada, int sh_off, int sc_off, bf16_t* Hout, int gw, int ngw, int lane, unsigned char* H8) {
    u32x2 nx[4];
    if (gw < T) {
#pragma unroll
        for (int j = 0; j < 4; ++j) nx[j] = *((const u32x2*)(X + (size_t)gw * D) + lane + 64 * j);
    }
    f32x4 gg[4];
#pragma unroll
    for (int j = 0; j < 4; ++j) gg[j] = *(const f32x4*)(g + 4 * (lane + 64 * j));
    for (int row = gw; row < T; row += ngw) {
        const int b = row / S;
        f32x4 v[4]; float ss = 0.f;
#pragma unroll
        for (int j = 0; j < 4; ++j) { v[j].x = bflo(nx[j].x); v[j].y = bfhi(nx[j].x); v[j].z = bflo(nx[j].y); v[j].w = bfhi(nx[j].y); }
        if (row + ngw < T) {
#pragma unroll
            for (int j = 0; j < 4; ++j) nx[j] = *((const u32x2*)(X + (size_t)(row + ngw) * D) + lane + 64 * j);
        }
        f32x4 sc[4], sh[4];
#pragma unroll
        for (int j = 0; j < 4; ++j) { const int k = 4 * (lane + 64 * j);
            sc[j] = *(const f32x4*)(ada + b * 6144 + sc_off + k); sh[j] = *(const f32x4*)(ada + b * 6144 + sh_off + k); }
#pragma unroll
        for (int j = 0; j < 4; ++j) ss += v[j].x * v[j].x + v[j].y * v[j].y + v[j].z * v[j].z + v[j].w * v[j].w;
        const float rinv = rsqrtf(wave_sum(ss) * (1.f / D) + RMS_EPS);
        u32x2* o = (u32x2*)(Hout + (size_t)row * D) + lane;
#pragma unroll
        for (int j = 0; j < 4; ++j) {
            const f32x4 h = v[j] * rinv * gg[j] * (1.f + sc[j]) + sh[j];
            u32x2 w; w.x = cvt_pk_bf16(h.x, h.y); w.y = cvt_pk_bf16(h.z, h.w);
            o[64 * j] = w;
            *((unsigned*)(H8 + (size_t)row * D) + lane + 64 * j) = pk4_fp8(h.x, h.y, h.z, h.w);
        }
    }
}
__device__ __forceinline__ void norm_mod_rows(const float* X, const float* g, const float* ada, int sh_off, int sc_off, bf16_t* Hout, int gw, int ngw, int lane, unsigned char* H8 = nullptr) {
    f32x4 nx[4];
    if (gw < T) {
#pragma unroll
        for (int j = 0; j < 4; ++j) nx[j] = *((const f32x4*)(X + (size_t)gw * D) + lane + 64 * j);
    }
    f32x4 gg[4];
#pragma unroll
    for (int j = 0; j < 4; ++j) gg[j] = *(const f32x4*)(g + 4 * (lane + 64 * j));
    for (int row = gw; row < T; row += ngw) {
        const int b = row / S;
        f32x4 v[4]; float ss = 0.f;
#pragma unroll
        for (int j = 0; j < 4; ++j) v[j] = nx[j];
        if (row + ngw < T) {
#pragma unroll
            for (int j = 0; j < 4; ++j) nx[j] = *((const f32x4*)(X + (size_t)(row + ngw) * D) + lane + 64 * j);
        }
        f32x4 sc[4], sh[4];
#pragma unroll
        for (int j = 0; j < 4; ++j) { const int k = 4 * (lane + 64 * j);
            sc[j] = *(const f32x4*)(ada + b * 6144 + sc_off + k); sh[j] = *(const f32x4*)(ada + b * 6144 + sh_off + k); }
#pragma unroll
        for (int j = 0; j < 4; ++j) ss += v[j].x * v[j].x + v[j].y * v[j].y + v[j].z * v[j].z + v[j].w * v[j].w;
        const float rinv = rsqrtf(wave_sum(ss) * (1.f / D) + RMS_EPS);
        u32x2* o = (u32x2*)(Hout + (size_t)row * D) + lane;
#pragma unroll
        for (int j = 0; j < 4; ++j) {
            const f32x4 h = v[j] * rinv * gg[j] * (1.f + sc[j]) + sh[j];
            u32x2 w; w.x = cvt_pk_bf16(h.x, h.y); w.y = cvt_pk_bf16(h.z, h.w);
            o[64 * j] = w;
            if (H8) *((unsigned*)(H8 + (size_t)row * D) + lane + 64 * j) = pk4_fp8(h.x, h.y, h.z, h.w);
        }
    }
}

__device__ __forceinline__ void post_proj_rows(const Params& p, int gw, int ngw, int lane) {
    const bf16_t* proj = (const bf16_t*)(p.ws + B_PROJ);
    const float* graw = (const float*)(p.ws + B_GRAW);
    float* gl = (float*)(p.ws + B_GL);
    bf16_t* cqn = (bf16_t*)(p.ws + B_CQN); bf16_t* ckvn = (bf16_t*)(p.ws + B_CKVN); bf16_t* zc = (bf16_t*)(p.ws + B_ZC);
    const float* g_cq = p.in[7]; const float* g_ckv = p.in[9]; const float* conv_w = p.in[14]; const float* conv_b = p.in[15];
    const int c0 = lane * 8;
    float gq[6], gk[4], cw[4][8], cbv[8];
#pragma unroll
    for (int j = 0; j < 6; ++j) gq[j] = g_cq[lane * 6 + j];
#pragma unroll
    for (int j = 0; j < 4; ++j) gk[j] = g_ckv[lane * 4 + j];
#pragma unroll
    for (int tap = 0; tap < 4; ++tap)
#pragma unroll
        for (int j = 0; j < 8; ++j) cw[tap][j] = conv_w[tap * MINNER + c0 + j];
#pragma unroll
    for (int j = 0; j < 8; ++j) cbv[j] = conv_b[c0 + j];
    const float gbias = (lane < 4) ? p.in[18][lane] : (lane < 8 ? p.in[19][lane - 4] : 0.f);
    for (int row = gw; row < T; row += ngw) {
        const bf16_t* pr = proj + (size_t)row * IN_DIM;
        const int s = row % S;
        const unsigned* q = (const unsigned*)(pr + OFF_CQ) + lane * 3;
        const unsigned a0 = q[0], a1 = q[1], a2 = q[2];
        const u32x2 kvv = *((const u32x2*)(pr + OFF_CKV) + lane);
        u32x4 z[4];
#pragma unroll
        for (int tap = 0; tap < 4; ++tap) { const int ds = tap - 3; z[tap] = (s + ds >= 0) ? *(const u32x4*)(pr + (ptrdiff_t)ds * IN_DIM + OFF_Z + c0) : (u32x4){0u, 0u, 0u, 0u}; }
        const float gr = (lane < 8) ? graw[(size_t)row * 8 + lane] : 0.f;
        {
            float f[6] = {bflo(a0), bfhi(a0), bflo(a1), bfhi(a1), bflo(a2), bfhi(a2)};
            float ss = 0.f;
#pragma unroll
            for (int j = 0; j < 6; ++j) ss += f[j] * f[j];
            const float rinv = rsqrtf(wave_sum(ss) * (1.f / QLORA) + RMS_EPS);
            unsigned* o = (unsigned*)(cqn + (size_t)row * QLORA) + lane * 3;
            o[0] = cvt_pk_bf16(f[0] * rinv * gq[0], f[1] * rinv * gq[1]);
            o[1] = cvt_pk_bf16(f[2] * rinv * gq[2], f[3] * rinv * gq[3]);
            o[2] = cvt_pk_bf16(f[4] * rinv * gq[4], f[5] * rinv * gq[5]);
        }
        {
            float f[4] = {bflo(kvv.x), bfhi(kvv.x), bflo(kvv.y), bfhi(kvv.y)};
            float ss = f[0] * f[0] + f[1] * f[1] + f[2] * f[2] + f[3] * f[3];
            const float rinv = rsqrtf(wave_sum(ss) * (1.f / KVLORA) + RMS_EPS);
            u32x2 w; w.x = cvt_pk_bf16(f[0] * rinv * gk[0], f[1] * rinv * gk[1]); w.y = cvt_pk_bf16(f[2] * rinv * gk[2], f[3] * rinv * gk[3]);
            *((u32x2*)(ckvn + (size_t)row * KVLORA) + lane) = w;
        }
        {
            float acc[8];
#pragma unroll
            for (int j = 0; j < 8; ++j) acc[j] = cbv[j];
#pragma unroll
            for (int tap = 0; tap < 4; ++tap) {
                acc[0] += bflo(z[tap].x) * cw[tap][0]; acc[1] += bfhi(z[tap].x) * cw[tap][1]; acc[2] += bflo(z[tap].y) * cw[tap][2]; acc[3] += bfhi(z[tap].y) * cw[tap][3];
                acc[4] += bflo(z[tap].z) * cw[tap][4]; acc[5] += bfhi(z[tap].z) * cw[tap][5]; acc[6] += bflo(z[tap].w) * cw[tap][6]; acc[7] += bfhi(z[tap].w) * cw[tap][7];
            }
            u32x4 o; o.x = cvt_pk_bf16(siluf_(acc[0]), siluf_(acc[1])); o.y = cvt_pk_bf16(siluf_(acc[2]), siluf_(acc[3]));
            o.z = cvt_pk_bf16(siluf_(acc[4]), siluf_(acc[5])); o.w = cvt_pk_bf16(siluf_(acc[6]), siluf_(acc[7]));
            *(u32x4*)(zc + (size_t)row * MINNER + c0) = o;
        }
        if (lane < 8) {
            const float xx = gr + gbias;
            gl[(size_t)row * 8 + lane] = (lane < 4) ? xx : (fminf(xx, 0.f) - log1pf(__expf(-fabsf(xx))));
        }
    }
}

__device__ __forceinline__ void qk_post_rows(const Params& p, int gw, int ngw, int lane) {
    const bf16_t* qraw = (const bf16_t*)(p.ws + B_QRAW); const bf16_t* kvraw = (const bf16_t*)(p.ws + B_KVRAW);
    const bf16_t* proj = (const bf16_t*)(p.ws + B_PROJ);
    bf16_t* Q = (bf16_t*)(p.ws + B_Q); bf16_t* Kb = (bf16_t*)(p.ws + B_K);
    const int* positions = (const int*)p.in[2];
    const float* g_qn = p.in[11]; const float* g_kn = p.in[12];
    const float qscale = 0.10206207261596575f * 1.4426950408889634f;
    const int l = lane & 31, hsel = lane >> 5, i = l & 15;
    const float inv_freq = exp2f(-(float)(2 * i) * (13.287712379549449f / 32.f));
    const float gq0 = g_qn[l], gq1 = g_qn[l + 32], gq2 = g_qn[l + 64], gk0 = g_kn[l], gk1 = g_kn[l + 32], gk2 = g_kn[l + 64];
    for (int row = gw; row < T; row += ngw) {
        const int b = row / S, s = row % S;
        float qv[4][3], kv[4][2];
#pragma unroll
        for (int hp = 0; hp < 4; ++hp) {
            const int h = hp * 2 + hsel;
            const bf16_t* qr = qraw + (size_t)row * 768 + h * 96; const bf16_t* kr = kvraw + (size_t)row * 1024 + h * 128;
            qv[hp][0] = bf2f(qr[l]); qv[hp][1] = bf2f(qr[l + 32]); qv[hp][2] = bf2f(qr[l + 64]);
            kv[hp][0] = bf2f(kr[l]); kv[hp][1] = bf2f(kr[l + 32]);
        }
        const float krope = bf2f(proj[(size_t)row * IN_DIM + OFF_KR + l]);
        const float ang = (float)positions[row] * inv_freq;
        const float sn = __sinf(ang), cs = __cosf(ang);
#pragma unroll
        for (int hp = 0; hp < 4; ++hp) {
            const int h = hp * 2 + hsel;
            {
                float v0 = qv[hp][0], v1 = qv[hp][1], v2 = qv[hp][2];
                float ss = v0 * v0 + v1 * v1 + v2 * v2;
#pragma unroll
                for (int o = 1; o < 32; o <<= 1) ss += __shfl_xor(ss, o);
                const float rinv = rsqrtf(ss * (1.f / 96.f) + RMS_EPS);
                v0 *= rinv * gq0; v1 *= rinv * gq1; v2 *= rinv * gq2;
                const float other = __shfl_xor(v2, 16);
                const float r = (l < 16) ? (v2 * cs - other * sn) : (other * sn + v2 * cs);
                bf16_t* qo = Q + ((size_t)(b * H_MLA + h) * S + s) * 96;
                qo[l] = (bf16_t)(cvt_pk_bf16(v0 * qscale, 0.f) & 0xffff);
                qo[l + 32] = (bf16_t)(cvt_pk_bf16(v1 * qscale, 0.f) & 0xffff);
                qo[l + 64] = (bf16_t)(cvt_pk_bf16(r * qscale, 0.f) & 0xffff);
            }
            {
                float v0 = kv[hp][0], v1 = kv[hp][1], v2 = krope;
                float ss = v0 * v0 + v1 * v1 + v2 * v2;
#pragma unroll
                for (int o = 1; o < 32; o <<= 1) ss += __shfl_xor(ss, o);
                const float rinv = rsqrtf(ss * (1.f / 96.f) + RMS_EPS);
                v0 *= rinv * gk0; v1 *= rinv * gk1; v2 *= rinv * gk2;
                const float other = __shfl_xor(v2, 16);
                const float r = (l < 16) ? (v2 * cs - other * sn) : (other * sn + v2 * cs);
                bf16_t* ko = Kb + ((size_t)(b * H_MLA + h) * S + s) * 96;
                ko[l] = (bf16_t)(cvt_pk_bf16(v0, 0.f) & 0xffff);
                ko[l + 32] = (bf16_t)(cvt_pk_bf16(v1, 0.f) & 0xffff);
                ko[l + 64] = (bf16_t)(cvt_pk_bf16(r, 0.f) & 0xffff);
            }
        }
    }
}

__device__ __forceinline__ void attn_out_norm_rows(const Params& p, int gw, int ngw, int lane) {
    const bf16_t* oraw = (const bf16_t*)(p.ws + B_ORAW); bf16_t* ao = (bf16_t*)(p.ws + B_AO); const float* g = p.in[13];
    float gg[8];
#pragma unroll
    for (int j = 0; j < 8; ++j) gg[j] = g[lane * 8 + j];
    for (int row = gw; row < T; row += ngw) {
        const u32x4 a = *((const u32x4*)(oraw + (size_t)row * 512) + lane);
        float f[8] = {bflo(a.x), bfhi(a.x), bflo(a.y), bfhi(a.y), bflo(a.z), bfhi(a.z), bflo(a.w), bfhi(a.w)};
        float ss = 0.f;
#pragma unroll
        for (int j = 0; j < 8; ++j) ss += f[j] * f[j];
        const float rinv = rsqrtf(wave_sum(ss) * (1.f / 512.f) + RMS_EPS);
        u32x4 o; o.x = cvt_pk_bf16(f[0] * rinv * gg[0], f[1] * rinv * gg[1]); o.y = cvt_pk_bf16(f[2] * rinv * gg[2], f[3] * rinv * gg[3]);
        o.z = cvt_pk_bf16(f[4] * rinv * gg[4], f[5] * rinv * gg[5]); o.w = cvt_pk_bf16(f[6] * rinv * gg[6], f[7] * rinv * gg[7]);
        *((u32x4*)(ao + (size_t)row * 1024) + lane) = o;
    }
}

namespace pg8 {
#define PG8_LAS __attribute__((address_space(3)))
typedef unsigned short bf16_t;
typedef short bf16x8 __attribute__((ext_vector_type(8)));
typedef float f32x4 __attribute__((ext_vector_type(4)));
typedef unsigned u32x4 __attribute__((ext_vector_type(4)));
constexpr int BM = 256, BK = 64, HALF = 128, HTB = HALF * BK * 2  , STAGE_BYTES = 8 * HTB, NXCD = 8, WGM = 8;

__host__ __device__ __forceinline__ int lds_byte(int r, int c) { const int st = (r >> 4) * 2 + (c >> 5), rr = r & 15, cc = c & 31, ob = rr * 64 + cc * 2; return st * 1024 + (ob ^ (((ob >> 9) & 1) << 5)); }
__host__ __device__ __forceinline__ void stage_rc(int b, int& R, int& C) { const int st = b / 1024, sb = b % 1024, swz = sb ^ (((sb >> 9) & 1) << 5); R = (st >> 1) * 16 + swz / 64; C = (st & 1) * 32 + (swz % 64) / 2; }
__host__ __device__ __forceinline__ int perm32(int rho) { const int n = rho >> 4, i = rho & 15; return 8 * (i >> 2) + 4 * n + (i & 3); }

struct Unit { int pm, pn; };
struct Gemm { const bf16_t* A; const bf16_t* Bt; int M, N, K, lda, ldb, apn; };

struct StaticOrder {
    int nM, nN, nwg, G, c;
    __host__ __device__ void init(int M, int N, int G_, int c_) { nM = M / BM; nN = N / BM; nwg = nM * nN; G = G_; c = c_; }
    __host__ __device__ bool next(int i, Unit& u) const {
        const long L = (long)i * G + c; if (L >= nwg) return false;
        int wgid = (int)L; { const int q = nwg / NXCD, r = nwg % NXCD, xcd = wgid % NXCD, off = wgid / NXCD; wgid = (xcd < r ? xcd * (q + 1) : r * (q + 1) + (xcd - r) * q) + off; }
        const int nig = WGM * nN, gid = wgid / nig, fm = gid * WGM, gsz = (nM - fm) < WGM ? (nM - fm) : WGM;
        u.pm = fm + ((wgid % nig) % gsz); u.pn = (wgid % nig) / gsz; return true;
    }
    __device__ __forceinline__ void a_ready(const Unit&) const {}
    __device__ __forceinline__ void done(const Unit&) const {}
};


template <class Epi, class Sched, bool ALIGN_EPI = false, bool SP2 = false>
__device__ __forceinline__ void gemm_phase(PG8_LAS unsigned char* lds, const Gemm g, const Sched& S, const Epi& E) {
    const int tid = fresh_tid(), wid = __builtin_amdgcn_readfirstlane(tid >> 6), lane = tid & 63, wr = wid >> 2, wc = wid & 3, fr = lane & 15, fq = lane >> 4;
    const int K = g.K, nt = K / BK;
    unsigned voffA[2], voffB[2];
#pragma unroll
    for (int i = 0; i < 2; ++i) { int R, C; stage_rc(tid * 16 + i * 8192, R, C); const int Rb = Epi::PERM ? ((R & ~31) + perm32(R & 31)) : R;
        voffA[i] = (unsigned)(R * g.lda + C) * 2u; voffB[i] = (unsigned)(Rb * g.ldb + C) * 2u; }
    const size_t kstep = (size_t)(BK * 2);
    const size_t hstepA = (size_t)HALF * g.lda * 2, hstepB = (size_t)HALF * g.ldb * 2;
    const size_t tstepA = 2 * hstepA, tstepB = 2 * hstepB;
    const unsigned ldsw = (unsigned)wid * 1024u;
    const int aoff = lds_byte(wr * 64 + fr, fq * 8), boff = lds_byte(wc * 32 + fr, fq * 8);
#define PG8_SA(b, h) (((b) * 2 + (h)) * HTB)
#define PG8_SB(b, h) ((4 + (b) * 2 + (h)) * HTB)
#define PG8_STAGE(bufoff, gbase, voff) do { _Pragma("unroll") for (int _i = 0; _i < 2; ++_i) \
        __builtin_amdgcn_global_load_lds((const unsigned*)((const char*)(gbase) + (voff)[_i]), (PG8_LAS unsigned*)(lds + (bufoff) + ldsw + _i * 8192), 16, 0, 0); } while (0)
#define PG8_LDA(dst, b, h) do { _Pragma("unroll") for (int m = 0; m < 4; ++m) _Pragma("unroll") for (int k = 0; k < 2; ++k) dst[m][k] = *(const PG8_LAS bf16x8*)(lds + PG8_SA(b, h) + aoff + m * 2048 + k * 1024); } while (0)
#define PG8_LDB(dst, b, h) do { _Pragma("unroll") for (int n = 0; n < 2; ++n) _Pragma("unroll") for (int k = 0; k < 2; ++k) dst[n][k] = *(const PG8_LAS bf16x8*)(lds + PG8_SB(b, h) + boff + n * 2048 + k * 1024); } while (0)
#define PG8_MMA(ai, bj, At, Bt) do { __builtin_amdgcn_s_setprio(1); _Pragma("unroll") for (int m = 0; m < 4; ++m) _Pragma("unroll") for (int n = 0; n < 2; ++n) _Pragma("unroll") for (int k = 0; k < 2; ++k) \
        acc[ai][bj][m][n] = __builtin_amdgcn_mfma_f32_16x16x32_bf16(Bt[n][k], At[m][k], acc[ai][bj][m][n], 0, 0, 0); __builtin_amdgcn_s_setprio(0); } while (0)
#define PG8_WAIT_V(n) asm volatile("s_waitcnt vmcnt(" #n ")" ::: "memory")
#define PG8_WAIT_L(n) asm volatile("s_waitcnt lgkmcnt(" #n ")" ::: "memory")
#define PG8_BAR __builtin_amdgcn_s_barrier()
#define PG8_SCHED __builtin_amdgcn_sched_barrier(0)
    Unit cur, nxt; int ui = 0;
    if (!S.next(0, cur)) return;
    f32x4 acc[2][2][4][2];
#pragma unroll
    for (int a = 0; a < 2; ++a)
#pragma unroll
        for (int b = 0; b < 2; ++b)
#pragma unroll
            for (int m = 0; m < 4; ++m)
#pragma unroll
                for (int n = 0; n < 2; ++n) acc[a][b][m][n] = (f32x4){0.f, 0.f, 0.f, 0.f};
    bf16x8 At[4][2], B0[2][2], B1[2][2];
    const char* cA = (const char*)g.A + (size_t)cur.pm * tstepA + (size_t)cur.pn * g.apn * 2; const char* cB = (const char*)g.Bt + (size_t)cur.pn * tstepB;
    S.a_ready(cur);
    if constexpr (SP2) {
        PG8_STAGE(PG8_SB(0, 0), cB, voffB); PG8_STAGE(PG8_SB(0, 1), cB + hstepB, voffB); PG8_STAGE(PG8_SA(0, 0), cA, voffA); PG8_STAGE(PG8_SA(0, 1), cA + hstepA, voffA);
        if (wr == 1) PG8_BAR;
        PG8_WAIT_V(2); PG8_BAR;
        PG8_STAGE(PG8_SB(1, 0), cB + kstep, voffB); PG8_STAGE(PG8_SA(1, 0), cA + kstep, voffA); PG8_STAGE(PG8_SB(1, 1), cB + hstepB + kstep, voffB);
        PG8_WAIT_V(6); PG8_BAR;
    } else {
        PG8_STAGE(PG8_SB(0, 0), cB, voffB); PG8_STAGE(PG8_SA(0, 0), cA, voffA); PG8_STAGE(PG8_SB(0, 1), cB + hstepB, voffB); PG8_STAGE(PG8_SA(0, 1), cA + hstepA, voffA);
        if (wr == 1) PG8_BAR;
        PG8_WAIT_V(4); PG8_BAR;
        PG8_STAGE(PG8_SB(1, 0), cB + kstep, voffB); PG8_STAGE(PG8_SA(1, 0), cA + kstep, voffA); PG8_STAGE(PG8_SB(1, 1), cB + hstepB + kstep, voffB);
        PG8_WAIT_V(6); PG8_BAR;
    }
    for (;;) {
        const bool has_next = S.next(ui + 1, nxt);
        const char* nA = has_next ? (const char*)g.A + (size_t)nxt.pm * tstepA + (size_t)nxt.pn * g.apn * 2 : cA; const char* nB = has_next ? (const char*)g.Bt + (size_t)nxt.pn * tstepB : cB;
        for (int t = 0; t < nt; t += 2) {
            const bool last = (t == nt - 2);
            const char* a1 = cA + (size_t)(t + 1) * kstep;
            const char* a2 = last ? nA : cA + (size_t)(t + 2) * kstep; const char* b2 = last ? nB : cB + (size_t)(t + 2) * kstep;
            const char* a3 = a2 + kstep; const char* b3 = b2 + kstep;
            if (last && has_next) S.a_ready(nxt);
            if constexpr (SP2) {
            PG8_LDB(B0, 0, 0); PG8_LDB(B1, 0, 1); PG8_SCHED; PG8_LDA(At, 0, 0); PG8_STAGE(PG8_SA(1, 1), a1 + hstepA, voffA);
            PG8_WAIT_V(8); PG8_WAIT_L(0); PG8_BAR; PG8_MMA(0, 0, At, B0); PG8_MMA(0, 1, At, B1); PG8_BAR; PG8_SCHED;
            PG8_LDA(At, 0, 1); PG8_STAGE(PG8_SB(0, 0), b2, voffB); PG8_STAGE(PG8_SB(0, 1), b2 + hstepB, voffB); PG8_STAGE(PG8_SA(0, 0), a2, voffA);
            PG8_WAIT_V(8); PG8_WAIT_L(0); PG8_BAR; PG8_MMA(1, 0, At, B0); PG8_MMA(1, 1, At, B1); PG8_BAR; PG8_SCHED;
            PG8_LDB(B0, 1, 0); PG8_LDB(B1, 1, 1); PG8_SCHED; PG8_LDA(At, 1, 0); PG8_STAGE(PG8_SA(0, 1), a2 + hstepA, voffA);
            PG8_WAIT_V(8); PG8_WAIT_L(0); PG8_BAR; PG8_MMA(0, 0, At, B0); PG8_MMA(0, 1, At, B1); PG8_BAR; PG8_SCHED;
            PG8_LDA(At, 1, 1); PG8_STAGE(PG8_SB(1, 0), b3, voffB); PG8_STAGE(PG8_SB(1, 1), b3 + hstepB, voffB); PG8_STAGE(PG8_SA(1, 0), a3, voffA);
            PG8_WAIT_V(8); PG8_WAIT_L(0); PG8_BAR; PG8_MMA(1, 0, At, B0); PG8_MMA(1, 1, At, B1); PG8_BAR; PG8_SCHED;
            } else {
            PG8_LDB(B0, 0, 0); PG8_SCHED; PG8_LDA(At, 0, 0); PG8_STAGE(PG8_SA(1, 1), a1 + hstepA, voffA);
            PG8_WAIT_L(8); PG8_BAR; PG8_WAIT_L(0); PG8_MMA(0, 0, At, B0); PG8_BAR; PG8_SCHED;
            PG8_LDB(B1, 0, 1); PG8_STAGE(PG8_SB(0, 0), b2, voffB);
            PG8_BAR; PG8_WAIT_L(0); PG8_MMA(0, 1, At, B1); PG8_BAR;
            PG8_LDA(At, 0, 1); PG8_STAGE(PG8_SA(0, 0), a2, voffA);
            PG8_BAR; PG8_WAIT_L(0); PG8_MMA(1, 0, At, B0); PG8_BAR; PG8_SCHED;
            PG8_STAGE(PG8_SB(0, 1), b2 + hstepB, voffB);
            PG8_WAIT_V(6); PG8_BAR; PG8_MMA(1, 1, At, B1); PG8_BAR;
            PG8_LDB(B0, 1, 0); PG8_SCHED; PG8_LDA(At, 1, 0); PG8_STAGE(PG8_SA(0, 1), a2 + hstepA, voffA);
            PG8_WAIT_L(8); PG8_BAR; PG8_WAIT_L(0); PG8_MMA(0, 0, At, B0); PG8_BAR; PG8_SCHED;
            PG8_LDB(B1, 1, 1); PG8_STAGE(PG8_SB(1, 0), b3, voffB);
            PG8_BAR; PG8_WAIT_L(0); PG8_MMA(0, 1, At, B1); PG8_BAR;
            PG8_LDA(At, 1, 1); PG8_STAGE(PG8_SA(1, 0), a3, voffA);
            PG8_BAR; PG8_WAIT_L(0); PG8_MMA(1, 0, At, B0); PG8_BAR; PG8_SCHED;
            PG8_STAGE(PG8_SB(1, 1), b3 + hstepB, voffB);
            PG8_WAIT_V(6); PG8_BAR; PG8_MMA(1, 1, At, B1); PG8_BAR;
            }
        }
        if constexpr (ALIGN_EPI) { if (wr == 0) PG8_BAR; }
        if constexpr (!Epi::AFTER_DRAIN) { E(acc, cur, wr, wc, fr, fq); S.done(cur); }
        if (!has_next) break;
#pragma unroll
        for (int a = 0; a < 2; ++a)
#pragma unroll
            for (int b = 0; b < 2; ++b)
#pragma unroll
                for (int m = 0; m < 4; ++m)
#pragma unroll
                    for (int n = 0; n < 2; ++n) acc[a][b][m][n] = (f32x4){0.f, 0.f, 0.f, 0.f};
        cur = nxt; cA = nA; cB = nB; ++ui;
        if constexpr (ALIGN_EPI) { if (wr == 1) PG8_BAR; }
    }
    PG8_WAIT_V(0);
    if constexpr (!ALIGN_EPI) { if (wr == 0) PG8_BAR; }
    PG8_BAR;
    if constexpr (Epi::AFTER_DRAIN) { E.fused(acc, cur, wr, wc, fr, fq, lds, wid, lane); S.done(cur); }
#undef PG8_SA
#undef PG8_SB
#undef PG8_STAGE
#undef PG8_LDA
#undef PG8_LDB
#undef PG8_MMA
#undef PG8_WAIT_V
#undef PG8_WAIT_L
#undef PG8_BAR
#undef PG8_SCHED
}
}

constexpr int GBK = 128;
constexpr int GLB = GBK + 16;
constexpr int GBS = 1152;
constexpr int G2_AS = 256 * GLB;
constexpr int G2_BS = (GBK / 8) * GBS;
constexpr int G2_STAGE = G2_AS + G2_BS;
typedef long i64_t;
#define GAS __attribute__((address_space(1)))
template <class RowPtr, class ColPtr, class Epi>
__device__ __forceinline__ void gemm2_tile(LAS unsigned char* lds, const RowPtr& RP, const ColPtr& CP, int ldk, int K, int m0, int n0, const Epi& E, int mvalid = 256) {
    const int tid = fresh_tid(), lane = tid & 63, wid = tid >> 6, half = wid >> 2, wm = (wid >> 1) & 1, wn = wid & 1;
    const int fr = lane & 15, fq = lane >> 4;
    const int ht = tid & 255;
    const int ac = (ht & 7) * 16, ar0 = half * 128 + (ht >> 3);
    const int bc = half * 64 + 4 * (ht & 15), bg = ht >> 4;
    const int bpos = Epi::PERM ? ((bc & ~63) + (((bc >> 2) & 3) << 4) + (((bc >> 4) & 3) << 2)) : bc;
    const unsigned char* ap0 = RP(m0 + ar0); const unsigned char* ap1 = RP(m0 + ar0 + 32); const unsigned char* ap2 = RP(m0 + ar0 + 64); const unsigned char* ap3 = RP(m0 + ar0 + 96);
    const float* bp = CP(n0 + bc);
    const f32x4 epre = E.pre(m0 + half * 128 + wm * 64, lane);
    f32x4 acc[4][4];
#pragma unroll
    for (int m = 0; m < 4; ++m)
#pragma unroll
        for (int n = 0; n < 4; ++n) acc[m][n] = (f32x4){0.f, 0.f, 0.f, 0.f};
    const u32x4 z4 = (u32x4){0u, 0u, 0u, 0u};
    const f32x4 zf = (f32x4){0.f, 0.f, 0.f, 0.f};
    u32x4 ra[4] = {z4, z4, z4, z4}; f32x4 rb[8] = {zf, zf, zf, zf, zf, zf, zf, zf};
    const int nk = K / GBK;
    const bool docomp = (half == 0) || (mvalid > 128);
#define G2_LOAD(kt_) do { const int k0_ = (kt_) * GBK; \
        ra[0] = ap0 ? *(const u32x4*)(ap0 + k0_ + ac) : z4; ra[1] = ap1 ? *(const u32x4*)(ap1 + k0_ + ac) : z4; \
        ra[2] = ap2 ? *(const u32x4*)(ap2 + k0_ + ac) : z4; ra[3] = ap3 ? *(const u32x4*)(ap3 + k0_ + ac) : z4; \
        const float* q0_ = bp + (size_t)(k0_ + 8 * bg) * ldk; \
        _Pragma("unroll") for (int j_ = 0; j_ < 8; ++j_) rb[j_] = *(const f32x4*)(q0_ + (size_t)j_ * ldk); } while (0)
#define G2_STORE(buf_) do { LAS unsigned char* As_ = lds + (buf_) * G2_STAGE; LAS unsigned char* Bs_ = As_ + G2_AS; \
        _Pragma("unroll") for (int j_ = 0; j_ < 4; ++j_) *(LAS u32x4*)(As_ + (ar0 + 32 * j_) * GLB + ac) = ra[j_]; \
        u32x4 w0_, w1_;     \
        w0_.x = pk4_fp8(rb[0].x, rb[1].x, rb[2].x, rb[3].x); w0_.y = pk4_fp8(rb[4].x, rb[5].x, rb[6].x, rb[7].x); w0_.z = pk4_fp8(rb[0].y, rb[1].y, rb[2].y, rb[3].y); w0_.w = pk4_fp8(rb[4].y, rb[5].y, rb[6].y, rb[7].y); \
        w1_.x = pk4_fp8(rb[0].z, rb[1].z, rb[2].z, rb[3].z); w1_.y = pk4_fp8(rb[4].z, rb[5].z, rb[6].z, rb[7].z); w1_.z = pk4_fp8(rb[0].w, rb[1].w, rb[2].w, rb[3].w); w1_.w = pk4_fp8(rb[4].w, rb[5].w, rb[6].w, rb[7].w); \
        *(LAS u32x4*)(Bs_ + bg * GBS + bpos * 8) = w0_; *(LAS u32x4*)(Bs_ + bg * GBS + bpos * 8 + 16) = w1_; } while (0)
#define G2_FRAGS(af_, bf_, ks_) do { \
        _Pragma("unroll") for (int m_ = 0; m_ < 4; ++m_) af_[m_] = *(const LAS i64_t*)(As_ + (m_ * 16 + fr) * GLB + (ks_) * 32 + fq * 8); \
        _Pragma("unroll") for (int n_ = 0; n_ < 4; ++n_) bf_[n_] = *(const LAS i64_t*)(Bs_ + ((ks_) * 4 + fq) * GBS + (n_ * 16) * 8); } while (0)
#define G2_MMA(af_, bf_) do { \
        _Pragma("unroll") for (int m_ = 0; m_ < 4; ++m_) _Pragma("unroll") for (int n_ = 0; n_ < 4; ++n_) acc[m_][n_] = __builtin_amdgcn_mfma_f32_16x16x32_fp8_fp8(bf_[n_], af_[m_], acc[m_][n_], 0, 0, 0); } while (0)
#define G2_COMPUTE(buf_) do { const LAS unsigned char* As_ = lds + (buf_) * G2_STAGE + (half * 128 + wm * 64) * GLB; const LAS unsigned char* Bs_ = lds + (buf_) * G2_STAGE + G2_AS + (wn * 64 + fr) * 8; \
        i64_t afa_[4], bfa_[4], afb_[4], bfb_[4]; \
        G2_FRAGS(afa_, bfa_, 0); G2_FRAGS(afb_, bfb_, 1); G2_MMA(afa_, bfa_); \
        G2_FRAGS(afa_, bfa_, 2); G2_MMA(afb_, bfb_); \
        G2_FRAGS(afb_, bfb_, 3); G2_MMA(afa_, bfa_); \
        G2_MMA(afb_, bfb_); } while (0)
    G2_LOAD(0);
    G2_STORE(0);
    if (nk > 1) G2_LOAD(1);
    __syncthreads();
#pragma unroll 1
    for (int kt = 0; kt < nk; ++kt) {
        const int cur = kt & 1;
        if (half == 0) { __builtin_amdgcn_s_setprio(1); G2_COMPUTE(cur); __builtin_amdgcn_s_setprio(0); }
        else if (kt + 1 < nk) { G2_STORE(cur ^ 1); if (kt + 2 < nk) G2_LOAD(kt + 2); }
        __syncthreads();
        if (half == 1) { if (docomp) { __builtin_amdgcn_s_setprio(1); G2_COMPUTE(cur); __builtin_amdgcn_s_setprio(0); } }
        else if (kt + 1 < nk) { G2_STORE(cur ^ 1); if (kt + 2 < nk) G2_LOAD(kt + 2); }
        __syncthreads();
    }
#undef G2_LOAD
#undef G2_STORE
#undef G2_COMPUTE
#undef G2_FRAGS
#undef G2_MMA
    E(acc, m0 + half * 128 + wm * 64, n0 + wn * 64, lane, epre);
}

constexpr int DLA = 272;
constexpr int D_AS = 256 * DLA;
__device__ __forceinline__ void expert_down_unit(LAS unsigned char* lds, const unsigned char* act, const float* W  , int nq, unsigned char* y, const float* lw, int slot0, int nvalid) {
    const int tid = fresh_tid(), lane = tid & 63, wid = tid >> 6, half = __builtin_amdgcn_readfirstlane(wid >> 2), wm = (wid >> 1) & 1, wn = wid & 1;
    const int fr = lane & 15, fq = lane >> 4;
    const int ht = tid & 255;
    const int bc = half * 64 + 4 * (ht & 15), bg = ht >> 4;
    const int bpos = (bc & ~63) + (((bc >> 2) & 3) << 4) + (((bc >> 4) & 3) << 2);
    LAS unsigned char* Al = lds;
    LAS unsigned char* Bl = lds + D_AS;
    {
        const int c16 = (tid & 15) * 16, r0 = tid >> 4;
        const u32x4 z4 = (u32x4){0u, 0u, 0u, 0u};
        u32x4 v[8];
#pragma unroll
        for (int j = 0; j < 8; ++j) { const int r = r0 + 32 * j; v[j] = (r < nvalid) ? *(const u32x4*)(act + (size_t)(slot0 + r) * EDIM + c16) : z4; }
#pragma unroll
        for (int j = 0; j < 8; ++j) *(LAS u32x4*)(Al + (r0 + 32 * j) * DLA + c16) = v[j];
    }
    f32x4 acc[4][4];
#pragma unroll
    for (int m = 0; m < 4; ++m)
#pragma unroll
        for (int n = 0; n < 4; ++n) acc[m][n] = (f32x4){0.f, 0.f, 0.f, 0.f};
    f32x4 rbA[8], rbB[8];
    const bool docomp = (half == 0) || (nvalid > 128);
    float wrow_[4];
#pragma unroll
    for (int m = 0; m < 4; ++m) { const int r = half * 128 + wm * 64 + m * 16 + fr; wrow_[m] = (r < nvalid) ? lw[r] : 0.f; }
    const float* wbase = W + nq * 512 + bc;
    constexpr int NT_ = 8;
#define D_LOAD(t_, rb) do { const GAS float* wb_ = (const GAS float*)wbase; asm volatile("" : "+v"(wb_));     \
        const GAS float* q0_ = wb_ + ((t_) >> 1) * 128 + (size_t)(((t_) & 1) * 128 + 8 * bg) * 1024; \
        _Pragma("unroll") for (int j_ = 0; j_ < 8; ++j_) rb[j_] = *(const GAS f32x4*)(q0_ + (size_t)j_ * 1024); } while (0)
#define D_STORE(buf_, rb) do { LAS unsigned char* Bs_ = Bl + (buf_) * G2_BS; u32x4 w0_, w1_; \
        w0_.x = pk4_fp8(rb[0].x, rb[1].x, rb[2].x, rb[3].x); w0_.y = pk4_fp8(rb[4].x, rb[5].x, rb[6].x, rb[7].x); w0_.z = pk4_fp8(rb[0].y, rb[1].y, rb[2].y, rb[3].y); w0_.w = pk4_fp8(rb[4].y, rb[5].y, rb[6].y, rb[7].y); \
        w1_.x = pk4_fp8(rb[0].z, rb[1].z, rb[2].z, rb[3].z); w1_.y = pk4_fp8(rb[4].z, rb[5].z, rb[6].z, rb[7].z); w1_.z = pk4_fp8(rb[0].w, rb[1].w, rb[2].w, rb[3].w); w1_.w = pk4_fp8(rb[4].w, rb[5].w, rb[6].w, rb[7].w); \
        *(LAS u32x4*)(Bs_ + bg * GBS + bpos * 8) = w0_; *(LAS u32x4*)(Bs_ + bg * GBS + bpos * 8 + 16) = w1_; } while (0)
#define D_FRAGS(af_, bf_, ks_) do { \
        _Pragma("unroll") for (int m_ = 0; m_ < 4; ++m_) af_[m_] = *(const LAS i64_t*)(As_ + (m_ * 16 + fr) * DLA + (ks_) * 32 + fq * 8); \
        _Pragma("unroll") for (int n_ = 0; n_ < 4; ++n_) bf_[n_] = *(const LAS i64_t*)(Bs_ + ((ks_) * 4 + fq) * GBS + (n_ * 16) * 8); } while (0)
#define D_FRAGA(af_, ks_) do { _Pragma("unroll") for (int m_ = 0; m_ < 4; ++m_) af_[m_] = *(const LAS i64_t*)(As_ + (m_ * 16 + fr) * DLA + (ks_) * 32 + fq * 8); } while (0)
#define D_FRAGB(bf_, ks_) do { _Pragma("unroll") for (int n_ = 0; n_ < 4; ++n_) bf_[n_] = *(const LAS i64_t*)(Bs_ + ((ks_) * 4 + fq) * GBS + (n_ * 16) * 8); } while (0)
#define D_MMA(af_, bf_) do { \
        _Pragma("unroll") for (int m_ = 0; m_ < 4; ++m_) _Pragma("unroll") for (int n_ = 0; n_ < 4; ++n_) acc[m_][n_] = __builtin_amdgcn_mfma_f32_16x16x32_fp8_fp8(bf_[n_], af_[m_], acc[m_][n_], 0, 0, 0); } while (0)
#define D_COMPUTE(t_) do { const LAS unsigned char* As_ = Al + (half * 128 + wm * 64) * DLA + ((t_) & 1) * 128; const LAS unsigned char* Bs_ = Bl + ((t_) & 1) * G2_BS + (wn * 64 + fr) * 8; \
        i64_t afa_[4], bfa_[4], afb_[4], bfb_[4]; \
        D_FRAGS(afa_, bfa_, 0); D_FRAGS(afb_, bfb_, 1); D_MMA(afa_, bfa_); \
        D_FRAGS(afa_, bfa_, 2); D_MMA(afb_, bfb_); \
        D_FRAGS(afb_, bfb_, 3); D_MMA(afa_, bfa_); \
        D_MMA(afb_, bfb_); \
        if ((t_) & 1) {     \
            const int cb_ = nq * 512 + ((t_) >> 1) * 128 + wn * 64; \
            _Pragma("unroll") for (int m_ = 0; m_ < 4; ++m_) { const int r_ = half * 128 + wm * 64 + m_ * 16 + fr; \
                if (r_ < nvalid) { const float wt_ = wrow_[m_]; u32x4 w_; \
                    { const f32x4 v_ = acc[m_][0] * wt_; w_.x = pk4_fp8(v_.x, v_.y, v_.z, v_.w); } { const f32x4 v_ = acc[m_][1] * wt_; w_.y = pk4_fp8(v_.x, v_.y, v_.z, v_.w); } \
                    { const f32x4 v_ = acc[m_][2] * wt_; w_.z = pk4_fp8(v_.x, v_.y, v_.z, v_.w); } { const f32x4 v_ = acc[m_][3] * wt_; w_.w = pk4_fp8(v_.x, v_.y, v_.z, v_.w); } \
                    asm volatile("global_store_dwordx4 %0, %1, off" :: "v"(y + (size_t)(slot0 + r_) * 1024 + cb_ + 16 * fq), "v"(w_) : "memory"); }     \
                _Pragma("unroll") for (int n_ = 0; n_ < 4; ++n_) acc[m_][n_] = (f32x4){0.f, 0.f, 0.f, 0.f}; } } } while (0)
#define D_STG(t_, rb, dow_) do { D_STORE(((t_) + 1) & 1, rb); if (dow_) D_LOAD((t_) + 3, rb); } while (0)
#define D_CMP(t_) do { __builtin_amdgcn_s_setprio(1); D_COMPUTE(t_); __builtin_amdgcn_s_setprio(0); } while (0)
    D_LOAD(0, rbA);
    D_STORE(0, rbA);
    D_LOAD(1, rbB); D_LOAD(2, rbA);
    __syncthreads();
    if (half == 0) {
        D_CMP(0); __syncthreads(); D_STG(0, rbB, 1); __syncthreads();
        D_CMP(1); __syncthreads(); D_STG(1, rbA, 1); __syncthreads();
        D_CMP(2); __syncthreads(); D_STG(2, rbB, 1); __syncthreads();
        D_CMP(3); __syncthreads(); D_STG(3, rbA, 1); __syncthreads();
        D_CMP(4); __syncthreads(); D_STG(4, rbB, 1); __syncthreads();
        D_CMP(5); __syncthreads(); D_STG(5, rbA, 0); __syncthreads();
        D_CMP(6); __syncthreads(); D_STG(6, rbB, 0); __syncthreads();
        D_CMP(7); __syncthreads(); __syncthreads();
    } else {
        D_STG(0, rbB, 1); __syncthreads(); if (docomp) D_CMP(0); __syncthreads();
        D_STG(1, rbA, 1); __syncthreads(); if (docomp) D_CMP(1); __syncthreads();
        D_STG(2, rbB, 1); __syncthreads(); if (docomp) D_CMP(2); __syncthreads();
        D_STG(3, rbA, 1); __syncthreads(); if (docomp) D_CMP(3); __syncthreads();
        D_STG(4, rbB, 1); __syncthreads(); if (docomp) D_CMP(4); __syncthreads();
        D_STG(5, rbA, 0); __syncthreads(); if (docomp) D_CMP(5); __syncthreads();
        D_STG(6, rbB, 0); __syncthreads(); if (docomp) D_CMP(6); __syncthreads();
        __syncthreads(); if (docomp) D_CMP(7); __syncthreads();
    }
#undef D_STG
#undef D_CMP
#undef D_LOAD
#undef D_STORE
#undef D_FRAGS
#undef D_MMA
#undef D_COMPUTE
}

struct RowDense { const bf16_t* A; int lda; __device__ __forceinline__ const bf16_t* operator()(int r) const { return A + (size_t)r * lda; } };
struct RowGather { const unsigned char* A; const int* idx; int nvalid; __device__ __forceinline__ const unsigned char* operator()(int r) const { return r < nvalid ? A + (size_t)idx[r] * D : nullptr; } };
struct RowSlots { const unsigned char* A; int nvalid; __device__ __forceinline__ const unsigned char* operator()(int r) const { return r < nvalid ? A + (size_t)r * EDIM : nullptr; } };
struct ColDense { const float* W; int N; __device__ __forceinline__ const float* operator()(int c) const { return c < N ? W + c : nullptr; } };
struct ColMqk { const float* q; ptrdiff_t dk; __device__ __forceinline__ const float* operator()(int c) const { return q + ((c < 128) ? (ptrdiff_t)c : dk + (c - 128)); } };
struct ColGU { const float* g; ptrdiff_t du;
    __device__ __forceinline__ const float* operator()(int c) const { const int tb = c >> 7, cc = c & 127, wnn = cc >> 6, n = (cc >> 4) & 3, rho = cc & 15;
        return g + (((n & 1) ? du : (ptrdiff_t)0) + tb * 64 + wnn * 32 + 8 * (rho >> 2) + 4 * (n >> 1) + (rho & 3)); } };
struct ColRgu { const float* r; ptrdiff_t dg; ptrdiff_t du; __device__ __forceinline__ const float* operator()(int c) const {
    const int cc = c - 256, j = cc >> 5, w = cc & 31; const ptrdiff_t off = (c < 256) ? (ptrdiff_t)c : (((w & 16) ? du : dg) + j * 16 + (w & 15)); return r + off; } };

__device__ __forceinline__ u32x2 pack4(const f32x4 v) { u32x2 w; w.x = cvt_pk_bf16(v.x, v.y); w.y = cvt_pk_bf16(v.z, v.w); return w; }
__device__ __forceinline__ u32x2 pack_swiglu(const f32x4 g, const f32x4 u) { u32x2 w; w.x = cvt_pk_bf16(siluf_(g.x) * u.x, siluf_(g.y) * u.y); w.y = cvt_pk_bf16(siluf_(g.z) * u.z, siluf_(g.w) * u.w); return w; }
struct EpiProj {
    bf16_t* proj; float* graw;
    __device__ __forceinline__ f32x4 pre(int rb, int lane) const { return (f32x4){0.f, 0.f, 0.f, 0.f}; }
    __device__ __forceinline__ void operator()(const f32x4 (&acc)[4][4], int rb, int cb, int lane, const f32x4 epre) const {
        const int fr = lane & 15, fq = lane >> 4;
#pragma unroll
        for (int m = 0; m < 4; ++m)
#pragma unroll
            for (int n = 0; n < 4; ++n) {
                const int row = rb + m * 16 + fr, col = cb + n * 16 + 4 * fq;
                if (col < OFF_GATE) *(u32x2*)(proj + (size_t)row * IN_DIM + col) = pack4(acc[m][n]);
                else if (col < IN_DIM) *(f32x4*)(graw + (size_t)row * 8 + (col - OFF_GATE)) = acc[m][n];
            }
    }
};
struct EpiNull {
    float* sink;
    __device__ __forceinline__ f32x4 pre(int rb, int lane) const { return (f32x4){0.f, 0.f, 0.f, 0.f}; }
    __device__ __forceinline__ void operator()(const f32x4 (&acc)[4][4], int rb, int cb, int lane, const f32x4 epre) const {
        float t = 0.f;
#pragma unroll
        for (int m = 0; m < 4; ++m)
#pragma unroll
            for (int n = 0; n < 4; ++n) t += acc[m][n].x + acc[m][n].y + acc[m][n].z + acc[m][n].w;
        if (t == 12345.678f) sink[lane] = t;
    }
};
struct EpiBf16 {
    bf16_t* O; int ldc;
    __device__ __forceinline__ f32x4 pre(int rb, int lane) const { return (f32x4){0.f, 0.f, 0.f, 0.f}; }
    __device__ __forceinline__ void operator()(const f32x4 (&acc)[4][4], int rb, int cb, int lane, const f32x4 epre) const {
        const int fr = lane & 15, fq = lane >> 4;
#pragma unroll
        for (int m = 0; m < 4; ++m)
#pragma unroll
            for (int n = 0; n < 4; ++n) *(u32x2*)(O + (size_t)(rb + m * 16 + fr) * ldc + cb + n * 16 + 4 * fq) = pack4(acc[m][n]);
    }
};
struct EpiMqk {
    bf16_t* mq; bf16_t* mk; int h;
    __device__ __forceinline__ f32x4 pre(int rb, int lane) const { return (f32x4){0.f, 0.f, 0.f, 0.f}; }
    __device__ __forceinline__ void operator()(const f32x4 (&acc)[4][4], int rb, int cb, int lane, const f32x4 epre) const {
        const int fr = lane & 15, fq = lane >> 4;
#pragma unroll
        for (int m = 0; m < 4; ++m)
#pragma unroll
            for (int n = 0; n < 4; ++n) {
                const int row = rb + m * 16 + fr, col = cb + n * 16 + 4 * fq; f32x4 v = acc[m][n];
                bf16_t* dst = mq; int c = col;
                if (col >= 128) { dst = mk; c = col - 128; v = v * 0.08838834764831845f; }
                *(u32x2*)(dst + (size_t)row * MINNER + h * DM + c) = pack4(v);
            }
    }
};
struct EpiResid {
    const float* X; const float* ada; int gt_off; float* out;
    __device__ __forceinline__ f32x4 pre(int rb, int lane) const { return (f32x4){0.f, 0.f, 0.f, 0.f}; }
    __device__ __forceinline__ void operator()(const f32x4 (&acc)[4][4], int rb, int cb, int lane, const f32x4 epre) const {
        const int fr = lane & 15, fq = lane >> 4;
#pragma unroll
        for (int m = 0; m < 4; ++m)
#pragma unroll
            for (int n = 0; n < 4; ++n) {
                const int row = rb + m * 16 + fr, col = cb + n * 16 + 4 * fq; const int b = row / S;
                const f32x4 g = *(const f32x4*)(ada + b * 6144 + gt_off + col);
                const f32x4 x = *(const f32x4*)(X + (size_t)row * D + col);
                *(f32x4*)(out + (size_t)row * D + col) = x + g * acc[m][n];
            }
    }
};
struct EpiRgu {
    float* logits; bf16_t* act;
    __device__ __forceinline__ f32x4 pre(int rb, int lane) const { return (f32x4){0.f, 0.f, 0.f, 0.f}; }
    __device__ __forceinline__ void operator()(const f32x4 (&acc)[4][4], int rb, int cb, int lane, const f32x4 epre) const {
        const int fr = lane & 15, fq = lane >> 4;
#pragma unroll
        for (int m = 0; m < 4; ++m) {
            const int row = rb + m * 16 + fr;
            if (cb < 256) {
#pragma unroll
                for (int n = 0; n < 4; ++n) *(f32x4*)(logits + (size_t)row * 256 + cb + n * 16 + 4 * fq) = acc[m][n];
            } else {
                const int j0 = (cb - 256) >> 5;
#pragma unroll
                for (int pp = 0; pp < 2; ++pp) *(u32x2*)(act + (size_t)row * 256 + (j0 + pp) * 16 + 4 * fq) = pack_swiglu(acc[m][2 * pp], acc[m][2 * pp + 1]);
            }
        }
    }
};
struct EpiExpAct {
    static constexpr bool PERM = false;
    unsigned char* act; int slot0; int nvalid;
    __device__ __forceinline__ f32x4 pre(int rb, int lane) const { const f32x4 z = {0.f, 0.f, 0.f, 0.f}; return z; }
    __device__ __forceinline__ void operator()(const f32x4 (&acc)[4][4], int rb, int cb, int lane, const f32x4 epre) const {
        const int fr = lane & 15, fq = lane >> 4;
#pragma unroll
        for (int m = 0; m < 4; ++m) {
            const int r = rb + m * 16 + fr;
            if (r < nvalid) {
                u32x2 w;
                { const f32x4 g = acc[m][0], u = acc[m][1]; w.x = pk4_fp8(siluf_(g.x) * u.x, siluf_(g.y) * u.y, siluf_(g.z) * u.z, siluf_(g.w) * u.w); }
                { const f32x4 g = acc[m][2], u = acc[m][3]; w.y = pk4_fp8(siluf_(g.x) * u.x, siluf_(g.y) * u.y, siluf_(g.z) * u.z, siluf_(g.w) * u.w); }
                *(u32x2*)(act + (size_t)(slot0 + r) * 256 + (cb >> 1) + 8 * fq) = w;
            }
        }
    }
};
struct EpiExpDown {
    static constexpr bool PERM = true;
    unsigned char* y; const float* lw; int slot0; int nvalid;
    __device__ __forceinline__ f32x4 pre(int rb, int lane) const {
        const int fr = lane & 15; f32x4 w;
        w.x = (rb + fr < nvalid) ? lw[rb + fr] : 0.f; w.y = (rb + 16 + fr < nvalid) ? lw[rb + 16 + fr] : 0.f;
        w.z = (rb + 32 + fr < nvalid) ? lw[rb + 32 + fr] : 0.f; w.w = (rb + 48 + fr < nvalid) ? lw[rb + 48 + fr] : 0.f; return w; }
    __device__ __forceinline__ void operator()(const f32x4 (&acc)[4][4], int rb, int cb, int lane, const f32x4 epre) const {
        const int fr = lane & 15, fq = lane >> 4;
#pragma unroll
        for (int m = 0; m < 4; ++m) {
            const int r = rb + m * 16 + fr;
            if (r < nvalid) {
                const float wt = epre[m];
                u32x4 w;
                { const f32x4 v = acc[m][0] * wt; w.x = pk4_fp8(v.x, v.y, v.z, v.w); }
                { const f32x4 v = acc[m][1] * wt; w.y = pk4_fp8(v.x, v.y, v.z, v.w); }
                { const f32x4 v = acc[m][2] * wt; w.z = pk4_fp8(v.x, v.y, v.z, v.w); }
                { const f32x4 v = acc[m][3] * wt; w.w = pk4_fp8(v.x, v.y, v.z, v.w); }
                *(u32x4*)(y + (size_t)(slot0 + r) * 1024 + cb + 16 * fq) = w;
            }
        }
    }
};

constexpr int AKLD = 104, AVLD = 72;
__device__ __forceinline__ void attn_unit(const Params& p, LAS unsigned char* lds, int bh, int qb) {
    LAS bf16_t* Ks = (LAS bf16_t*)lds;
    LAS bf16_t* Vt = Ks + 64 * AKLD;
    const bf16_t* Q = (const bf16_t*)(p.ws + B_Q) + (size_t)bh * S * 96;
    const bf16_t* Kg = (const bf16_t*)(p.ws + B_K) + (size_t)bh * S * 96;
    const int b = bh >> 3, h = bh & 7;
    const bf16_t* Vg = (const bf16_t*)(p.ws + B_KVRAW) + (size_t)b * S * 1024 + h * 128 + 64;
    bf16_t* O = (bf16_t*)(p.ws + B_ORAW) + (size_t)b * S * 512 + h * 64;
    const int tid = fresh_tid(), lane = tid & 63, wid = tid >> 6, fr = lane & 15, fq = lane >> 4;
    const int q0 = qb * 256, qw0 = q0 + wid * 32;
    bf16x8 qf[2][3];
#pragma unroll
    for (int nq = 0; nq < 2; ++nq)
#pragma unroll
        for (int ks = 0; ks < 3; ++ks) qf[nq][ks] = *(const bf16x8*)(Q + (size_t)(qw0 + nq * 16 + fr) * 96 + ks * 32 + fq * 8);
    f32x4 oacc[4][2];
#pragma unroll
    for (int d = 0; d < 4; ++d)
#pragma unroll
        for (int nq = 0; nq < 2; ++nq) oacc[d][nq] = (f32x4){0.f, 0.f, 0.f, 0.f};
    float mrun[2] = {-1e30f, -1e30f}, lrun[2] = {0.f, 0.f};
    const int ntiles = (q0 + 256) / 64;
    constexpr int ASTG = 64 * AKLD + 64 * AVLD;
    const int kc0 = tid, kc1 = tid + NT;
    const int kr0 = kc0 / 12, kq0 = kc0 - kr0 * 12, kr1 = kc1 / 12, kq1 = kc1 - kr1 * 12;
    const int vkey = tid & 63, vdc = tid >> 6;
    u32x4 rk0, rk1 = (u32x4){0u, 0u, 0u, 0u}, rv;
#define ATT_LOAD(k0_) do { rk0 = *(const u32x4*)(Kg + (size_t)((k0_) + kr0) * 96 + kq0 * 8); if (kc1 < 768) rk1 = *(const u32x4*)(Kg + (size_t)((k0_) + kr1) * 96 + kq1 * 8); \
        rv = *(const u32x4*)(Vg + (size_t)((k0_) + vkey) * 1024 + vdc * 8); } while (0)
#define ATT_STORE(buf_) do { LAS bf16_t* Kd_ = Ks + (buf_) * ASTG; LAS bf16_t* Vd_ = Kd_ + 64 * AKLD; \
        *(LAS u32x4*)(Kd_ + kr0 * AKLD + kq0 * 8) = rk0; if (kc1 < 768) *(LAS u32x4*)(Kd_ + kr1 * AKLD + kq1 * 8) = rk1; \
        LAS bf16_t* vt_ = Vd_ + (vdc * 8) * AVLD + vkey; \
        vt_[0 * AVLD] = (bf16_t)(rv.x & 0xffff); vt_[1 * AVLD] = (bf16_t)(rv.x >> 16); vt_[2 * AVLD] = (bf16_t)(rv.y & 0xffff); vt_[3 * AVLD] = (bf16_t)(rv.y >> 16); \
        vt_[4 * AVLD] = (bf16_t)(rv.z & 0xffff); vt_[5 * AVLD] = (bf16_t)(rv.z >> 16); vt_[6 * AVLD] = (bf16_t)(rv.w & 0xffff); vt_[7 * AVLD] = (bf16_t)(rv.w >> 16); } while (0)
    ATT_LOAD(0);
    ATT_STORE(0);
    __syncthreads();
    for (int kt = 0; kt < ntiles; ++kt) {
        const int k0 = kt * 64;
        const LAS bf16_t* Kc = Ks + (kt & 1) * ASTG; const LAS bf16_t* Vc = Kc + 64 * AKLD;
        if (kt + 1 < ntiles) ATT_LOAD(k0 + 64);
        if (k0 <= qw0 + 31) {
            f32x4 sacc[4][2];
#pragma unroll
            for (int t4 = 0; t4 < 4; ++t4)
#pragma unroll
                for (int nq = 0; nq < 2; ++nq) sacc[t4][nq] = (f32x4){0.f, 0.f, 0.f, 0.f};
#pragma unroll
            for (int ks = 0; ks < 3; ++ks)
#pragma unroll
                for (int t4 = 0; t4 < 4; ++t4) {
                    const bf16x8 kf = *(const LAS bf16x8*)(Kc + (t4 * 16 + fr) * AKLD + ks * 32 + fq * 8);
#pragma unroll
                    for (int nq = 0; nq < 2; ++nq) sacc[t4][nq] = MFMA16(kf, qf[nq][ks], sacc[t4][nq]);
                }
            const bool need_mask = (k0 + 63 > qw0);
#pragma unroll
            for (int nq = 0; nq < 2; ++nq) {
                const int qidx = qw0 + nq * 16 + fr;
                float mx = -1e30f;
#pragma unroll
                for (int t4 = 0; t4 < 4; ++t4)
#pragma unroll
                    for (int i = 0; i < 4; ++i) {
                        if (need_mask) { const int key = k0 + t4 * 16 + 4 * fq + i; if (key > qidx) sacc[t4][nq][i] = -1e30f; }
                        mx = fmaxf(mx, sacc[t4][nq][i]);
                    }
                mx = fmaxf(mx, __shfl_xor(mx, 16)); mx = fmaxf(mx, __shfl_xor(mx, 32));
                const float mnew = fmaxf(mrun[nq], mx);
                float ls = 0.f;
#pragma unroll
                for (int t4 = 0; t4 < 4; ++t4)
#pragma unroll
                    for (int i = 0; i < 4; ++i) { const float pv = __builtin_amdgcn_exp2f(sacc[t4][nq][i] - mnew); sacc[t4][nq][i] = pv; ls += pv; }
                if (__ballot(mnew > mrun[nq])) {
                    const float alpha = __builtin_amdgcn_exp2f(mrun[nq] - mnew);
                    lrun[nq] = lrun[nq] * alpha + ls;
#pragma unroll
                    for (int d = 0; d < 4; ++d) oacc[d][nq] = oacc[d][nq] * alpha;
                } else lrun[nq] += ls;
                mrun[nq] = mnew;
            }
#pragma unroll
            for (int s2 = 0; s2 < 2; ++s2) {
                bf16x8 pb[2];
#pragma unroll
                for (int nq = 0; nq < 2; ++nq) {
                    u32x4 w; w.x = cvt_pk_bf16(sacc[2 * s2][nq].x, sacc[2 * s2][nq].y); w.y = cvt_pk_bf16(sacc[2 * s2][nq].z, sacc[2 * s2][nq].w);
                    w.z = cvt_pk_bf16(sacc[2 * s2 + 1][nq].x, sacc[2 * s2 + 1][nq].y); w.w = cvt_pk_bf16(sacc[2 * s2 + 1][nq].z, sacc[2 * s2 + 1][nq].w);
                    pb[nq] = __builtin_bit_cast(bf16x8, w);
                }
#pragma unroll
                for (int d = 0; d < 4; ++d) {
                    const LAS bf16_t* vr = Vc + (d * 16 + fr) * AVLD + s2 * 32 + 4 * fq;
                    const u32x2 lo = *(const LAS u32x2*)vr, hi = *(const LAS u32x2*)(vr + 16);
                    const bf16x8 vf = __builtin_bit_cast(bf16x8, ((u32x4){lo.x, lo.y, hi.x, hi.y}));
#pragma unroll
                    for (int nq = 0; nq < 2; ++nq) oacc[d][nq] = MFMA16(vf, pb[nq], oacc[d][nq]);
                }
            }
        }
        if (kt + 1 < ntiles) ATT_STORE((kt + 1) & 1);
        __syncthreads();
    }
#undef ATT_LOAD
#undef ATT_STORE
#pragma unroll
    for (int nq = 0; nq < 2; ++nq) {
        float l = lrun[nq]; l += __shfl_xor(l, 16); l += __shfl_xor(l, 32);
        const float inv = 1.f / l;
        const int qidx = qw0 + nq * 16 + fr;
#pragma unroll
        for (int d = 0; d < 4; ++d) { const f32x4 v = oacc[d][nq] * inv; u32x2 w; w.x = cvt_pk_bf16(v.x, v.y); w.y = cvt_pk_bf16(v.z, v.w);
            *(u32x2*)(O + (size_t)qidx * 512 + d * 16 + 4 * fq) = w; }
    }
}

constexpr int MTLD = 72;
__device__ __forceinline__ void mlstm_a_unit(const Params& p, LAS unsigned char* lds, int unit) {
    LAS bf16_t* kT = (LAS bf16_t*)lds;
    LAS bf16_t* vT = kT + 128 * MTLD;
    LAS float* av = (LAS float*)(vT + 128 * MTLD);
    const int bh = unit >> 5, c = unit & 31, b = bh >> 2, h = bh & 3;
    const int t0 = b * S + c * CHUNK;
    const float* gl = (const float*)(p.ws + B_GL);
    const bf16_t* mk = (const bf16_t*)(p.ws + B_MK); const bf16_t* proj = (const bf16_t*)(p.ws + B_PROJ);
    const int tid = fresh_tid(), lane = tid & 63, wid = tid >> 6, fr = lane & 15, fq = lane >> 4;
    if (wid == 0) {
        const float li = gl[(size_t)(t0 + lane) * 8 + h], lf = gl[(size_t)(t0 + lane) * 8 + 4 + h];
        float bs = lf;
#pragma unroll
        for (int o = 1; o < 64; o <<= 1) { const float t = __shfl_up(bs, o); if (lane >= o) bs += t; }
        const float Btot = __shfl(bs, 63);
        const float g = Btot - bs + li;
        const float ml = wave_max(g);
        av[lane] = __expf(g - ml);
        if (lane == 0) { ((float*)(p.ws + WS_BC))[unit] = Btot; ((float*)(p.ws + WS_MLOC))[unit] = ml; }
    }
    __syncthreads();
#pragma unroll
    for (int rep = 0; rep < 2; ++rep) {
        const int cidx = tid + rep * NT, s = cidx & 63, ch = cidx >> 6;
        const u32x4 kv = *(const u32x4*)(mk + (size_t)(t0 + s) * MINNER + h * DM + ch * 8);
        const u32x4 vv = *(const u32x4*)(proj + (size_t)(t0 + s) * IN_DIM + OFF_MV + h * DM + ch * 8);
        const float a = av[s];
        LAS bf16_t* kt = kT + (ch * 8) * MTLD + s; LAS bf16_t* vt = vT + (ch * 8) * MTLD + s;
        const unsigned kk[4] = {kv.x, kv.y, kv.z, kv.w}; const unsigned vw[4] = {vv.x, vv.y, vv.z, vv.w};
#pragma unroll
        for (int j = 0; j < 4; ++j) {
            kt[(2 * j) * MTLD] = (bf16_t)(kk[j] & 0xffff); kt[(2 * j + 1) * MTLD] = (bf16_t)(kk[j] >> 16);
            const unsigned sc = cvt_pk_bf16(bflo(vw[j]) * a, bfhi(vw[j]) * a);
            vt[(2 * j) * MTLD] = (bf16_t)(sc & 0xffff); vt[(2 * j + 1) * MTLD] = (bf16_t)(sc >> 16);
        }
    }
    __syncthreads();
    {
        const int we = wid >> 1, wd = wid & 1;
        f32x4 acc[2][4];
#pragma unroll
        for (int i = 0; i < 2; ++i)
#pragma unroll
            for (int j = 0; j < 4; ++j) acc[i][j] = (f32x4){0.f, 0.f, 0.f, 0.f};
#pragma unroll
        for (int ks = 0; ks < 2; ++ks) {
            bf16x8 vf[2], kf[4];
#pragma unroll
            for (int i = 0; i < 2; ++i) vf[i] = *(const LAS bf16x8*)(vT + (we * 32 + i * 16 + fr) * MTLD + ks * 32 + fq * 8);
#pragma unroll
            for (int j = 0; j < 4; ++j) kf[j] = *(const LAS bf16x8*)(kT + (wd * 64 + j * 16 + fr) * MTLD + ks * 32 + fq * 8);
#pragma unroll
            for (int i = 0; i < 2; ++i)
#pragma unroll
                for (int j = 0; j < 4; ++j) acc[i][j] = MFMA16(kf[j], vf[i], acc[i][j]);
        }
        bf16_t* dC = (bf16_t*)(p.ws + B_DC) + (size_t)unit * 16384;
#pragma unroll
        for (int i = 0; i < 2; ++i)
#pragma unroll
            for (int j = 0; j < 4; ++j) *(u32x2*)(dC + (we * 32 + i * 16 + fr) * 128 + wd * 64 + j * 16 + 4 * fq) = pack4(acc[i][j]);
    }
    if (tid < 128) {
        float s = 0.f;
        for (int q = 0; q < 64; ++q) s += bf2f(kT[tid * MTLD + q]) * av[q];
        ((float*)(p.ws + WS_DN))[(size_t)unit * 128 + tid] = s;
    }
    __syncthreads();
}

__device__ __forceinline__ void mlstm_scan(const Params& p, int gtid, int ngt) {
    const float* Bc = (const float*)(p.ws + WS_BC); const float* ML = (const float*)(p.ws + WS_MLOC);
    float* mprev = (float*)(p.ws + WS_MPREV);
    const bf16_t* dC = (const bf16_t*)(p.ws + B_DC); bf16_t* Cp = (bf16_t*)(p.ws + B_CPREV);
    const float* dn = (const float*)(p.ws + WS_DN); float* np_ = (float*)(p.ws + WS_NPREV);
    constexpr int PER = 4096 + 32;
    for (int idx = gtid; idx < 32 * PER; idx += ngt) {
        const int bh = idx / PER, e4 = idx - bh * PER;
        const bool isC = e4 < 4096; const int n4 = e4 - 4096;
        float m = 0.f; f32x4 C = (f32x4){0.f, 0.f, 0.f, 0.f};
        for (int c0 = 0; c0 < NCH; c0 += 4) {
            f32x4 d[4]; float Bt[4], ml[4];
#pragma unroll
            for (int q = 0; q < 4; ++q) {
                const int unit = bh * NCH + c0 + q;
                Bt[q] = Bc[unit]; ml[q] = ML[unit];
                if (isC) { const u32x2 w = *(const u32x2*)(dC + (size_t)unit * 16384 + e4 * 4); d[q] = (f32x4){bflo(w.x), bfhi(w.x), bflo(w.y), bfhi(w.y)}; }
                else d[q] = *(const f32x4*)(dn + (size_t)unit * 128 + n4 * 4);
            }
#pragma unroll
            for (int q = 0; q < 4; ++q) {
                const int unit = bh * NCH + c0 + q;
                const float mnew = fmaxf(Bt[q] + m, ml[q]);
                const float fa = __expf(Bt[q] + m - mnew), fb = __expf(ml[q] - mnew);
                if (isC) {
                    u32x2 w; w.x = cvt_pk_bf16(C.x, C.y); w.y = cvt_pk_bf16(C.z, C.w);
                    *(u32x2*)(Cp + (size_t)unit * 16384 + e4 * 4) = w;
                    if (e4 == 0) mprev[unit] = m;
                } else {
                    *(f32x4*)(np_ + (size_t)unit * 128 + n4 * 4) = C;
                }
                C = C * fa + d[q] * fb;
                m = mnew;
            }
        }
    }
}

constexpr int MRLD = 136;
struct McRegs { u32x4 q[2], k[2], c[4], v[2]; float li, lf, mp; };
__device__ __forceinline__ void mlstm_c_load(const Params& p, int unit, McRegs& R) {
    const int bh = unit >> 5, c = unit & 31, b = bh >> 2, h = bh & 3;
    const int t0 = b * S + c * CHUNK;
    const float* gl = (const float*)(p.ws + B_GL);
    const bf16_t* mq = (const bf16_t*)(p.ws + B_MQ); const bf16_t* mk = (const bf16_t*)(p.ws + B_MK); const bf16_t* proj = (const bf16_t*)(p.ws + B_PROJ);
    const bf16_t* Cp = (const bf16_t*)(p.ws + B_CPREV) + (size_t)unit * 16384;
    const int tid = fresh_tid(), lane = tid & 63;
#pragma unroll
    for (int rep = 0; rep < 2; ++rep) {
        const int cidx = tid + rep * NT, r = cidx >> 4, ch = cidx & 15;
        R.q[rep] = *(const u32x4*)(mq + (size_t)(t0 + r) * MINNER + h * DM + ch * 8);
        R.k[rep] = *(const u32x4*)(mk + (size_t)(t0 + r) * MINNER + h * DM + ch * 8);
    }
#pragma unroll
    for (int rep = 0; rep < 4; ++rep) { const int cidx = tid + rep * NT, r = cidx >> 4, ch = cidx & 15; R.c[rep] = *(const u32x4*)(Cp + r * 128 + ch * 8); }
#pragma unroll
    for (int rep = 0; rep < 2; ++rep) { const int cidx = tid + rep * NT, sq = cidx & 63, ch = cidx >> 6; R.v[rep] = *(const u32x4*)(proj + (size_t)(t0 + sq) * IN_DIM + OFF_MV + h * DM + ch * 8); }
    R.li = gl[(size_t)(t0 + lane) * 8 + h]; R.lf = gl[(size_t)(t0 + lane) * 8 + 4 + h]; R.mp = ((const float*)(p.ws + WS_MPREV))[unit];
}
__device__ __forceinline__ void mlstm_c_unit(const Params& p, LAS unsigned char* lds, int unit, McRegs& R, int next_unit) {
    LAS bf16_t* qs = (LAS bf16_t*)lds;
    LAS bf16_t* ks = qs + 64 * MRLD;
    LAS bf16_t* cs = ks + 64 * MRLD;
    LAS bf16_t* vT = cs + 128 * MRLD;
    LAS float* fv = (LAS float*)(vT + 128 * MTLD);
    LAS float* u_s = fv; LAS float* c_t = fv + 64; LAS float* dec = fv + 128; LAS float* emt = fv + 192; LAS float* ssq = fv + 256;
    const int bh = unit >> 5, c = unit & 31, b = bh >> 2, h = bh & 3;
    const int t0 = b * S + c * CHUNK;
    const bf16_t* proj = (const bf16_t*)(p.ws + B_PROJ);
    const float* np_ = (const float*)(p.ws + WS_NPREV) + (size_t)unit * 128;
    const int tid = fresh_tid(), lane = tid & 63, wid = tid >> 6, fr = lane & 15, fq = lane >> 4;
    if (wid == 0) {
        const float li = R.li, lf = R.lf;
        const float mp = R.mp;
        float bs = lf;
#pragma unroll
        for (int o = 1; o < 64; o <<= 1) { const float t = __shfl_up(bs, o); if (lane >= o) bs += t; }
        const float u = li - bs;
        float pm = u;
#pragma unroll
        for (int o = 1; o < 64; o <<= 1) { const float t = __shfl_up(pm, o); if (lane >= o) pm = fmaxf(pm, t); }
        const float inter = bs + mp;
        const float mt = fmaxf(inter, bs + pm);
        u_s[lane] = u; c_t[lane] = bs - mt; dec[lane] = __expf(inter - mt); emt[lane] = __expf(-mt);
    }
#pragma unroll
    for (int rep = 0; rep < 2; ++rep) {
        const int cidx = tid + rep * NT, r = cidx >> 4, ch = cidx & 15;
        *(LAS u32x4*)(qs + r * MRLD + ch * 8) = R.q[rep];
        *(LAS u32x4*)(ks + r * MRLD + ch * 8) = R.k[rep];
    }
#pragma unroll
    for (int rep = 0; rep < 4; ++rep) { const int cidx = tid + rep * NT, r = cidx >> 4, ch = cidx & 15; *(LAS u32x4*)(cs + r * MRLD + ch * 8) = R.c[rep]; }
#pragma unroll
    for (int rep = 0; rep < 2; ++rep) {
        const int cidx = tid + rep * NT, sq = cidx & 63, ch = cidx >> 6;
        const u32x4 vv = R.v[rep];
        LAS bf16_t* vt = vT + (ch * 8) * MTLD + sq;
        const unsigned vw[4] = {vv.x, vv.y, vv.z, vv.w};
#pragma unroll
        for (int j = 0; j < 4; ++j) { vt[(2 * j) * MTLD] = (bf16_t)(vw[j] & 0xffff); vt[(2 * j + 1) * MTLD] = (bf16_t)(vw[j] >> 16); }
    }
    __syncthreads();
    if (next_unit >= 0) mlstm_c_load(p, next_unit, R);
    const int tt = wid & 3, eh = wid >> 2;
    const int tl = tt * 16 + fr;
    bf16x8 qf[4];
#pragma unroll
    for (int k4 = 0; k4 < 4; ++k4) qf[k4] = *(const LAS bf16x8*)(qs + tl * MRLD + k4 * 32 + fq * 8);
    f32x4 sacc[4];
#pragma unroll
    for (int st = 0; st < 4; ++st) sacc[st] = (f32x4){0.f, 0.f, 0.f, 0.f};
#pragma unroll
    for (int k4 = 0; k4 < 4; ++k4)
#pragma unroll
        for (int st = 0; st < 4; ++st) {
            const bf16x8 kf = *(const LAS bf16x8*)(ks + (st * 16 + fr) * MRLD + k4 * 32 + fq * 8);
            sacc[st] = MFMA16(kf, qf[k4], sacc[st]);
        }
    const float ct = c_t[tl];
    float rs = 0.f;
#pragma unroll
    for (int st = 0; st < 4; ++st)
#pragma unroll
        for (int i = 0; i < 4; ++i) {
            const int s = st * 16 + 4 * fq + i;
            const float w = (s <= tl) ? __expf(ct + u_s[s]) * sacc[st][i] : 0.f;
            sacc[st][i] = w; rs += w;
        }
    rs += __shfl_xor(rs, 16); rs += __shfl_xor(rs, 32);
    float nq;
    {
        f32x4 na = (f32x4){0.f, 0.f, 0.f, 0.f};
#pragma unroll
        for (int k4 = 0; k4 < 4; ++k4) {
            u32x4 w = (u32x4){0u, 0u, 0u, 0u};
            if (fr == 0) { const float* nn = np_ + k4 * 32 + fq * 8; w.x = cvt_pk_bf16(nn[0], nn[1]); w.y = cvt_pk_bf16(nn[2], nn[3]); w.z = cvt_pk_bf16(nn[4], nn[5]); w.w = cvt_pk_bf16(nn[6], nn[7]); }
            na = MFMA16(__builtin_bit_cast(bf16x8, w), qf[k4], na);
        }
        nq = __shfl(na.x, fr);
    }
    f32x4 acc[4];
#pragma unroll
    for (int et = 0; et < 4; ++et) acc[et] = (f32x4){0.f, 0.f, 0.f, 0.f};
#pragma unroll
    for (int k4 = 0; k4 < 4; ++k4)
#pragma unroll
        for (int et = 0; et < 4; ++et) {
            const bf16x8 cf = *(const LAS bf16x8*)(cs + (eh * 64 + et * 16 + fr) * MRLD + k4 * 32 + fq * 8);
            acc[et] = MFMA16(cf, qf[k4], acc[et]);
        }
    const float dcy = dec[tl];
#pragma unroll
    for (int et = 0; et < 4; ++et) acc[et] = acc[et] * dcy;
#pragma unroll
    for (int s2 = 0; s2 < 2; ++s2) {
        u32x4 w; w.x = cvt_pk_bf16(sacc[2 * s2].x, sacc[2 * s2].y); w.y = cvt_pk_bf16(sacc[2 * s2].z, sacc[2 * s2].w);
        w.z = cvt_pk_bf16(sacc[2 * s2 + 1].x, sacc[2 * s2 + 1].y); w.w = cvt_pk_bf16(sacc[2 * s2 + 1].z, sacc[2 * s2 + 1].w);
        const bf16x8 pb = __builtin_bit_cast(bf16x8, w);
#pragma unroll
        for (int et = 0; et < 4; ++et) {
            const LAS bf16_t* vr = vT + (eh * 64 + et * 16 + fr) * MTLD + s2 * 32 + 4 * fq;
            const u32x2 lo = *(const LAS u32x2*)vr, hi = *(const LAS u32x2*)(vr + 16);
            acc[et] = MFMA16(__builtin_bit_cast(bf16x8, ((u32x4){lo.x, lo.y, hi.x, hi.y})), pb, acc[et]);
        }
    }
    const float den = dcy * nq + rs;
    const float hd = 1.f / fmaxf(fabsf(den), emt[tl]);
    float sq = 0.f;
#pragma unroll
    for (int et = 0; et < 4; ++et) { acc[et] = acc[et] * hd; sq += acc[et].x * acc[et].x + acc[et].y * acc[et].y + acc[et].z * acc[et].z + acc[et].w * acc[et].w; }
    sq += __shfl_xor(sq, 16); sq += __shfl_xor(sq, 32);
    if (fq == 0) ssq[eh * 64 + tl] = sq;
    __syncthreads();
    const float rinv = rsqrtf((ssq[tl] + ssq[64 + tl]) * (1.f / 128.f) + RMS_EPS);
    const float* gmo = p.in[20] + h * DM;
    bf16_t* ao = (bf16_t*)(p.ws + B_AO);
#pragma unroll
    for (int et = 0; et < 4; ++et) {
        const int e = eh * 64 + et * 16 + 4 * fq;
        const u32x2 op = *(const u32x2*)(proj + (size_t)(t0 + tl) * IN_DIM + OFF_MO + h * DM + e);
        const f32x4 g = *(const f32x4*)(gmo + e);
        const f32x4 v = acc[et] * rinv * g;
        u32x2 w; w.x = cvt_pk_bf16(v.x * sigmoidf_(bflo(op.x)), v.y * sigmoidf_(bfhi(op.x))); w.y = cvt_pk_bf16(v.z * sigmoidf_(bflo(op.y)), v.w * sigmoidf_(bfhi(op.y)));
        *(u32x2*)(ao + (size_t)(t0 + tl) * 1024 + 512 + h * DM + e) = w;
    }
    __syncthreads();
}

__device__ __forceinline__ unsigned fkey(float f) { const unsigned u = __float_as_uint(f); return (u & 0x80000000u) ? ~u : (u | 0x80000000u); }
__device__ __forceinline__ float rdlane_f(float v, int l) { return __uint_as_float((unsigned)__builtin_amdgcn_readlane((int)__float_as_uint(v), l)); }
__device__ __forceinline__ void route_token(const f32x4 cur, const f32x4 bias, int lane, int (&e8)[8], float (&w8)[8]) {
    float sc[4] = {sigmoidf_(cur.x), sigmoidf_(cur.y), sigmoidf_(cur.z), sigmoidf_(cur.w)};
    float sb[4] = {sc[0] + bias.x, sc[1] + bias.y, sc[2] + bias.z, sc[3] + bias.w};
    float t1 = fmaxf(fmaxf(sb[0], sb[1]), fmaxf(sb[2], sb[3]));
    float t2;
    {   const float a = fmaxf(sb[0], sb[1]), bmin = fminf(sb[0], sb[1]), c2 = fmaxf(sb[2], sb[3]), dmin = fminf(sb[2], sb[3]);
        t2 = fmaxf(fminf(a, c2), fmaxf(bmin, dmin)); }
#pragma unroll
    for (int o = 1; o < 8; o <<= 1) {
        const float o1 = __shfl_xor(t1, o), o2 = __shfl_xor(t2, o);
        const float n1 = fmaxf(t1, o1), n2 = fmaxf(fminf(t1, o1), fmaxf(t2, o2));
        t1 = n1; t2 = n2;
    }
    const float gs = t1 + t2;
    const int myg = lane >> 3;
    int rank = 0;
#pragma unroll
    for (int g = 0; g < 8; ++g) { const float og = rdlane_f(gs, g * 8); rank += (og > gs || (og == gs && g < myg)) ? 1 : 0; }
    const bool keep = rank < 4;
    unsigned key[4];
#pragma unroll
    for (int j = 0; j < 4; ++j) key[j] = keep ? fkey(sb[j]) : 0u;
    unsigned t = 0u;
#pragma unroll 4
    for (int bit = 31; bit >= 0; --bit) {
        const unsigned tt = t | (1u << bit);
        const int c = __builtin_popcountll(__ballot(key[0] >= tt)) + __builtin_popcountll(__ballot(key[1] >= tt)) + __builtin_popcountll(__ballot(key[2] >= tt)) + __builtin_popcountll(__ballot(key[3] >= tt));
        if (c >= TOPK) t = tt;
    }
    unsigned long long sel[4], eq[4];
    int ngt = 0;
#pragma unroll
    for (int j = 0; j < 4; ++j) { sel[j] = __ballot(key[j] > t); eq[j] = __ballot(key[j] == t); ngt += __builtin_popcountll(sel[j]); }
    for (int need = TOPK - ngt; need > 0; --need) {
        int best = 1 << 30;
#pragma unroll
        for (int j = 0; j < 4; ++j) if (eq[j]) { const int idx = 4 * (int)__builtin_ctzll(eq[j]) + j; best = idx < best ? idx : best; }
        const int L = best >> 2, jj = best & 3;
#pragma unroll
        for (int j = 0; j < 4; ++j) if (jj == j) { eq[j] &= ~(1ull << L); sel[j] |= (1ull << L); }
    }
    float wsum = 0.f;
#pragma unroll
    for (int k = 0; k < TOPK; ++k) {
        int best = 1 << 30;
#pragma unroll
        for (int j = 0; j < 4; ++j) if (sel[j]) { const int idx = 4 * (int)__builtin_ctzll(sel[j]) + j; best = idx < best ? idx : best; }
        const int L = best >> 2, jj = best & 3;
#pragma unroll
        for (int j = 0; j < 4; ++j) if (jj == j) sel[j] &= ~(1ull << L);
        const float s0 = rdlane_f(sc[0], L), s1 = rdlane_f(sc[1], L), s2 = rdlane_f(sc[2], L), s3 = rdlane_f(sc[3], L);
        const float sraw = (jj == 0) ? s0 : (jj == 1) ? s1 : (jj == 2) ? s2 : s3;
        e8[k] = best; w8[k] = sraw; wsum += sraw;
    }
    const float inv = 2.5f / wsum;
#pragma unroll
    for (int k = 0; k < TOPK; ++k) w8[k] *= inv;
}
__device__ __forceinline__ void route_rows(const Params& p, int gw, int ngw, int lane) {
    const float* logits = (const float*)(p.ws + C_LOGITS); const float* rb = p.in[24];
    int* cnt = (int*)(p.ws + WS_CNT);
    int* tok_e = (int*)(p.ws + C_TOKE); float* tok_w = (float*)(p.ws + C_TOKW); int* tok_pos = (int*)(p.ws + C_TOKPOS);
    int* list_tok = (int*)(p.ws + C_LISTTOK); float* list_w = (float*)(p.ws + C_LISTW);
    const f32x4 bias = *(const f32x4*)(rb + lane * 4);
    for (int row0 = gw; row0 < T; row0 += ngw * 8) {
        int e_all = 0, row_all = -1; float w_all = 0.f;
        f32x4 lg = *(const f32x4*)(logits + (size_t)row0 * 256 + lane * 4);
#pragma unroll 1
        for (int i = 0; i < 8; ++i) {
            const int row = row0 + i * ngw;
            if (row >= T) break;
            const f32x4 cur = lg;
            if (i + 1 < 8 && row + ngw < T) lg = *(const f32x4*)(logits + (size_t)(row + ngw) * 256 + lane * 4);
            int e8[8]; float w8[8];
            route_token(cur, bias, lane, e8, w8);
            if ((lane >> 3) == i) {
                const int k = lane & 7; int es = e8[0]; float wsel = w8[0];
#pragma unroll
                for (int q = 1; q < 8; ++q) if (k == q) { es = e8[q]; wsel = w8[q]; }
                e_all = es; w_all = wsel; row_all = row;
            }
        }
        if (row_all >= 0) {
            const int k = lane & 7;
            const int pos = atomicAdd(&cnt[e_all * CNT_STRIDE], 1);
            tok_e[(size_t)row_all * 8 + k] = e_all; tok_w[(size_t)row_all * 8 + k] = w_all; tok_pos[(size_t)row_all * 8 + k] = pos;
            list_tok[(size_t)e_all * CAP + pos] = row_all; list_w[(size_t)e_all * CAP + pos] = w_all;
        }
    }
}

__device__ __forceinline__ void expert_prefix(const Params& p, LAS int* base, LAS int* tsa, int tid, int ngrp) {
    const int* cnt = (const int*)(p.ws + WS_CNT);
    const int nper = NE / ngrp;
    const int wave = tid >> 6, lane = tid & 63;
    if (tid < 64) {
        int c[4]; int s = 0;
#pragma unroll
        for (int j = 0; j < 4; ++j) { c[j] = __hip_atomic_load(cnt + (tid * 4 + j) * CNT_STRIDE, __ATOMIC_RELAXED, __HIP_MEMORY_SCOPE_AGENT); s += c[j]; }
        int ps = s;
#pragma unroll
        for (int o = 1; o < 64; o <<= 1) { const int a = __builtin_amdgcn_ds_bpermute(((lane - o) & 63) << 2, ps); if (lane >= o) ps += a; }
        int es = ps - s;
#pragma unroll
        for (int j = 0; j < 4; ++j) { base[tid * 4 + j] = es; es += c[j]; }
    }
    if (wave < ngrp) {
        LAS int* tsx = tsa + wave * (nper + 1);
        int run = 0;
        for (int r0 = 0; r0 < nper; r0 += 64) {
            const int i = r0 + lane;
            int tl = 0;
            if (i < nper) tl = (__hip_atomic_load(cnt + (wave + ngrp * i) * CNT_STRIDE, __ATOMIC_RELAXED, __HIP_MEMORY_SCOPE_AGENT) + 255) >> 8;
            int pt = tl;
#pragma unroll
            for (int o = 1; o < 64; o <<= 1) { const int a = __builtin_amdgcn_ds_bpermute(((lane - o) & 63) << 2, pt); if (lane >= o) pt += a; }
            if (i < nper) tsx[i] = run + pt - tl;
            run += __builtin_amdgcn_readlane(pt, 63);
        }
        if (lane == 0) tsx[nper] = run;
    }
    __syncthreads();
}
__device__ __forceinline__ int sched_nunits(const LAS int* tsa, int g, int nper, int mult) { return tsa[g * (nper + 1) + nper] * mult; }
__device__ __forceinline__ int sched_nstatic(int n, int gper) { const int r = n / gper - 1; return r > 0 ? r : 0; }
__device__ __forceinline__ bool sched_next(int* ctr, const LAS int* tsa, volatile LAS int* slot, int tid, int ngrp, int nper, int mult, int gper, int& g, int& u) {
    if (tid == 0) {
        int rg = -1, ru = 0;
        for (int tries = 0; tries < 64 && rg < 0; ++tries) {
            const int n = sched_nunits(tsa, g, nper, mult), st = sched_nstatic(n, gper) * gper;
            const int t = __hip_atomic_fetch_add(ctr + g * CNT_STRIDE, 1, __ATOMIC_RELAXED, __HIP_MEMORY_SCOPE_AGENT) + st;
            if (t < n) { rg = g; ru = t; break; }
            int ng = -1, bestd = 8;
#pragma unroll
            for (int j = 0; j < 8; ++j) {
                if (j < ngrp) {
                    const int cj = __hip_atomic_load(ctr + j * CNT_STRIDE, __ATOMIC_RELAXED, __HIP_MEMORY_SCOPE_AGENT);
                    const int nj = sched_nunits(tsa, j, nper, mult), d = (j - g) & 7;
                    if (d != 0 && d < bestd && cj + sched_nstatic(nj, gper) * gper < nj) { bestd = d; ng = j; }
                }
            }
            if (ng < 0) break;
            g = ng;
        }
        slot[0] = rg; slot[1] = ru;
    }
    __syncthreads();
    const int rg = slot[0]; u = slot[1];
    __syncthreads();
    if (rg < 0) return false;
    g = rg; return true;
}

__device__ __forceinline__ void combine_rows(const Params& p, LAS int* base, int gw, int ngw, int lane) {
    const bf16_t* sh = (const bf16_t*)(p.ws + C_SHOUT); const unsigned char* y = (const unsigned char*)(p.ws + C_Y);
    const int* tok_e = (const int*)(p.ws + C_TOKE); const int* tok_pos = (const int*)(p.ws + C_TOKPOS);
    const float* ada = (const float*)(p.ws + WS_ADA);
    typedef float f32x2v __attribute__((ext_vector_type(2)));
    for (int row = gw; row < T; row += ngw) {
        const int b = row / S;
        const int col = lane * 16;
        u32x4 yr[TOPK];
#pragma unroll
        for (int k = 0; k < TOPK; ++k) {
            const int e = tok_e[(size_t)row * 8 + k], pos = tok_pos[(size_t)row * 8 + k];
            yr[k] = *(const u32x4*)(y + (size_t)(base[e] + pos) * 1024 + col);
        }
        float acc[16];
        {
            const u32x4 a0 = *(const u32x4*)(sh + (size_t)row * 1024 + col), a1 = *(const u32x4*)(sh + (size_t)row * 1024 + col + 8);
            acc[0] = bflo(a0.x); acc[1] = bfhi(a0.x); acc[2] = bflo(a0.y); acc[3] = bfhi(a0.y); acc[4] = bflo(a0.z); acc[5] = bfhi(a0.z); acc[6] = bflo(a0.w); acc[7] = bfhi(a0.w);
            acc[8] = bflo(a1.x); acc[9] = bfhi(a1.x); acc[10] = bflo(a1.y); acc[11] = bfhi(a1.y); acc[12] = bflo(a1.z); acc[13] = bfhi(a1.z); acc[14] = bflo(a1.w); acc[15] = bfhi(a1.w);
        }
#pragma unroll
        for (int k = 0; k < TOPK; ++k) {
            const unsigned w4[4] = {yr[k].x, yr[k].y, yr[k].z, yr[k].w};
#pragma unroll
            for (int q = 0; q < 4; ++q) {
                const f32x2v lo = __builtin_amdgcn_cvt_pk_f32_fp8((int)w4[q], false), hi = __builtin_amdgcn_cvt_pk_f32_fp8((int)w4[q], true);
                acc[4 * q + 0] += lo.x; acc[4 * q + 1] += lo.y; acc[4 * q + 2] += hi.x; acc[4 * q + 3] += hi.y;
            }
        }
        float* o = p.out + (size_t)row * D + col;
        const float* g = ada + b * 6144 + 5120 + col;
        const bf16_t* x1r = (const bf16_t*)(p.ws + C_X1) + (size_t)row * D + col;
        const u32x4 xa = *(const u32x4*)x1r, xb = *(const u32x4*)(x1r + 8);
        const unsigned xw[8] = {xa.x, xa.y, xa.z, xa.w, xb.x, xb.y, xb.z, xb.w};
#pragma unroll
        for (int q4 = 0; q4 < 4; ++q4) {
            const f32x4 x = (f32x4){bflo(xw[2 * q4]), bfhi(xw[2 * q4]), bflo(xw[2 * q4 + 1]), bfhi(xw[2 * q4 + 1])}, gg = *(const f32x4*)(g + q4 * 4);
            f32x4 r; r.x = x.x + gg.x * acc[q4 * 4 + 0]; r.y = x.y + gg.y * acc[q4 * 4 + 1]; r.z = x.z + gg.z * acc[q4 * 4 + 2]; r.w = x.w + gg.w * acc[q4 * 4 + 3];
            *(f32x4*)(o + q4 * 4) = r;
        }
    }
}


struct PgProj {
    static constexpr bool PERM = true, AFTER_DRAIN = false;
    bf16_t* proj; float* graw;
    __device__ __forceinline__ void operator()(const f32x4 (&acc)[2][2][4][2], const pg8::Unit& u, int wr, int wc, int fr, int fq) const {
#pragma unroll
        for (int ai = 0; ai < 2; ++ai)
#pragma unroll
            for (int m = 0; m < 4; ++m) { const int row = u.pm * 256 + ai * 128 + wr * 64 + m * 16 + fr;
#pragma unroll
                for (int bj = 0; bj < 2; ++bj) { const int col = u.pn * 256 + bj * 128 + wc * 32 + 8 * fq;
                    if (col < OFF_GATE) { const u32x2 lo = pack4(acc[ai][bj][m][0]), hi = pack4(acc[ai][bj][m][1]); *(u32x4*)(proj + (size_t)row * IN_DIM + col) = (u32x4){lo.x, lo.y, hi.x, hi.y}; }
                    else if (col < IN_DIM) { *(f32x4*)(graw + (size_t)row * 8) = acc[ai][bj][m][0]; *(f32x4*)(graw + (size_t)row * 8 + 4) = acc[ai][bj][m][1]; } } }
    }
};
struct PgBf16 {
    static constexpr bool PERM = true, AFTER_DRAIN = false;
    bf16_t* O; int ldc;
    __device__ __forceinline__ void operator()(const f32x4 (&acc)[2][2][4][2], const pg8::Unit& u, int wr, int wc, int fr, int fq) const {
#pragma unroll
        for (int ai = 0; ai < 2; ++ai)
#pragma unroll
            for (int m = 0; m < 4; ++m) { const int row = u.pm * 256 + ai * 128 + wr * 64 + m * 16 + fr;
#pragma unroll
                for (int bj = 0; bj < 2; ++bj) { const int col = u.pn * 256 + bj * 128 + wc * 32 + 8 * fq;
                    const u32x2 lo = pack4(acc[ai][bj][m][0]), hi = pack4(acc[ai][bj][m][1]); *(u32x4*)(O + (size_t)row * ldc + col) = (u32x4){lo.x, lo.y, hi.x, hi.y}; } }
    }
};
struct PgMqk {
    static constexpr bool PERM = true, AFTER_DRAIN = false;
    bf16_t* mq; bf16_t* mk;
    __device__ __forceinline__ void operator()(const f32x4 (&acc)[2][2][4][2], const pg8::Unit& u, int wr, int wc, int fr, int fq) const {
#pragma unroll
        for (int ai = 0; ai < 2; ++ai)
#pragma unroll
            for (int m = 0; m < 4; ++m) { const int row = u.pm * 256 + ai * 128 + wr * 64 + m * 16 + fr;
#pragma unroll
                for (int bj = 0; bj < 2; ++bj) { const int c = wc * 32 + 8 * fq; const float sc = bj ? 0.08838834764831845f : 1.f;
                    const u32x2 lo = pack4(acc[ai][bj][m][0] * sc), hi = pack4(acc[ai][bj][m][1] * sc);
                    *(u32x4*)((bj ? mk : mq) + (size_t)row * MINNER + u.pn * DM + c) = (u32x4){lo.x, lo.y, hi.x, hi.y}; } }
    }
};
struct PgResid {
    static constexpr bool PERM = true, AFTER_DRAIN = false;
    const float* X; const float* ada; int gt_off; bf16_t* out;
    __device__ __forceinline__ void operator()(const f32x4 (&acc)[2][2][4][2], const pg8::Unit& u, int wr, int wc, int fr, int fq) const {
#pragma unroll
        for (int ai = 0; ai < 2; ++ai)
#pragma unroll
            for (int m = 0; m < 4; ++m) { const int row = u.pm * 256 + ai * 128 + wr * 64 + m * 16 + fr; const int b = row / S;
#pragma unroll
                for (int bj = 0; bj < 2; ++bj) { const int col = u.pn * 256 + bj * 128 + wc * 32 + 8 * fq;
                    const f32x4 g0 = *(const f32x4*)(ada + b * 6144 + gt_off + col), g1 = *(const f32x4*)(ada + b * 6144 + gt_off + col + 4);
                    const f32x4 x0 = *(const f32x4*)(X + (size_t)row * D + col), x1 = *(const f32x4*)(X + (size_t)row * D + col + 4);
                    const u32x2 lo = pack4(x0 + g0 * acc[ai][bj][m][0]), hi = pack4(x1 + g1 * acc[ai][bj][m][1]);
                    *(u32x4*)(out + (size_t)row * D + col) = (u32x4){lo.x, lo.y, hi.x, hi.y}; } }
    }
};
struct PgRgu {
    static constexpr bool PERM = false, AFTER_DRAIN = false;
    float* logits; bf16_t* act;
    __device__ __forceinline__ void operator()(const f32x4 (&acc)[2][2][4][2], const pg8::Unit& u, int wr, int wc, int fr, int fq) const {
#pragma unroll
        for (int ai = 0; ai < 2; ++ai)
#pragma unroll
            for (int m = 0; m < 4; ++m) { const int row = u.pm * 256 + ai * 128 + wr * 64 + m * 16 + fr;
#pragma unroll
                for (int bj = 0; bj < 2; ++bj) {
                    if (u.pn == 0) {
#pragma unroll
                        for (int n = 0; n < 2; ++n) *(f32x4*)(logits + (size_t)row * 256 + bj * 128 + wc * 32 + n * 16 + 4 * fq) = acc[ai][bj][m][n];
                    } else {
                        const int j = ((u.pn - 1) * 256 + bj * 128 + wc * 32) >> 5;
                        *(u32x2*)(act + (size_t)row * 256 + j * 16 + 4 * fq) = pack_swiglu(acc[ai][bj][m][0], acc[ai][bj][m][1]);
                    }
                } }
    }
};

__device__ __forceinline__ int xcd_remap(int L, int nwg) { const int q = nwg >> 3, r = nwg & 7, x = L & 7, off = L >> 3; return (x < r ? x * (q + 1) : r * (q + 1) + (x - r) * q) + off; }
__global__ void __launch_bounds__(NT, 2) fwd_kernel(Params p) {
    extern __shared__ __attribute__((aligned(16))) unsigned char lds_raw[];
    LAS unsigned char* lds = (LAS unsigned char*)lds_raw;
    const int G = gridDim.x, bid = blockIdx.x, ngw = G * NWAVES;
#define FRESH_IDS() const int tid = fresh_tid(), lane = tid & 63, wid = tid >> 6, gw = bid * NWAVES + wid; (void)lane; (void)gw
    { const int tid = fresh_tid(); volatile LAS unsigned* bst0 = (volatile LAS unsigned*)(lds + LDS_BYTES - 64); if (tid < 2) bst0[tid] = 0u; }
    unsigned char* ws = p.ws;
    const float* ada = (const float*)(ws + WS_ADA);
    volatile LAS unsigned* bst = (volatile LAS unsigned*)(lds + LDS_BYTES - 64);
    __syncthreads();
    const XcdBarrier xbar = xcd_barrier_post((unsigned*)(ws + WS_CTL + 4096), bst);
    int ts_n = 0;
#if DBG_STAGE == 2
#define TSTAMP() do { if (bid == 0 && threadIdx.x == 0) ((unsigned long long*)(ws + WS_CTL + 16384 + 8192))[ts_n] = __builtin_amdgcn_s_memrealtime(); ++ts_n; } while (0)
#else
#define TSTAMP() do { } while (0)
#endif
    TSTAMP();

    {
        FRESH_IDS();
        for (int u = bid; u < 192; u += G) ada_unit(p, lds, u, tid);
        LAS float* scr = (LAS float*)(lds + wid * 8448);
        constexpr int I0 = 16 * 70, I1 = I0 + 6 * 24, I2 = I1 + 4 * 32, I3 = I2 + 32, I4 = I3 + 32;
        const int vw = ((bid + G - (192 % G)) % G) * NWAVES + wid;
        for (int it = vw; it < I4; it += ngw) {
            if (it < I0) conv_item<0>(p.in[6], 1024, IN_DIM, (bf16_t*)(ws + WS_WIN), 0, 0, scr, it, lane);
            else if (it < I1) conv_item<0>(p.in[8], QLORA, 768, (bf16_t*)(ws + WS_WUQ), 0, 0, scr, it - I0, lane);
            else if (it < I2) conv_item<0>(p.in[10], KVLORA, 1024, (bf16_t*)(ws + WS_WUKV), 0, 0, scr, it - I1, lane);
            else if (it < I3) conv_item<0>(p.in[16], 128, 128, (bf16_t*)(ws + WS_WMQK), 256 * 128, 0, scr, it - I2, lane);
            else conv_item<0>(p.in[17], 128, 128, (bf16_t*)(ws + WS_WMQK), 256 * 128, 128, scr, it - I3, lane);
        }
        u32x4* zp = (u32x4*)((bf16_t*)(ws + WS_WIN) + (size_t)IN_DIM * 1024);
        for (int i = bid * NT + tid; i < (2304 - IN_DIM) * 1024 / 8; i += G * NT) zp[i] = (u32x4){0u, 0u, 0u, 0u};
    }
    xcd_barrier(xbar); TSTAMP();
    { FRESH_IDS(); norm_mod_rows(p.in[0], p.in[5], ada, 0, 1024, (bf16_t*)(ws + B_H1), gw, ngw, lane); }
    xcd_barrier(xbar); TSTAMP();
    {
        const pg8::Gemm g{(const bf16_t*)(ws + B_H1), (const bf16_t*)(ws + WS_WIN), T, 2304, 1024, 1024, 1024, 0};
        pg8::StaticOrder SO; SO.init(T, 2304, G, bid);
        const PgProj E{(bf16_t*)(ws + B_PROJ), (float*)(ws + B_GRAW)};
        pg8::gemm_phase<PgProj, pg8::StaticOrder, true, true>(lds, g, SO, E);
        {
            FRESH_IDS();
            const int nfull = (576 % G) ? (576 % G) : 0;
            if (bid >= nfull) {
                LAS float* scr = (LAS float*)(lds + wid * 8448);
                constexpr int J0 = 16 * 32, J1 = J0 + 16 * 8, J2 = J1 + 16 * 8, J3 = J2 + 16 * 8, J4 = J3 + 4 * 32;
                for (int it = (bid - nfull) * NWAVES + wid; it < J4; it += (G - nfull) * NWAVES) {
                    if (it < J0) conv_item<0>(p.in[21], 1024, 1024, (bf16_t*)(ws + WS_WOUT), 0, 0, scr, it, lane);
                    else if (it < J1) conv_item<0>(p.in[23], 1024, 256, (bf16_t*)(ws + WS_WRGU), 0, 0, scr, it - J0, lane);
                    else if (it < J2) conv_item<1>(p.in[28], 1024, 256, (bf16_t*)(ws + WS_WRGU), 0, 256, scr, it - J1, lane);
                    else if (it < J3) conv_item<2>(p.in[29], 1024, 256, (bf16_t*)(ws + WS_WRGU), 0, 256, scr, it - J2, lane);
                    else conv_item<0>(p.in[30], 256, 1024, (bf16_t*)(ws + WS_WDSH), 0, 0, scr, it - J3, lane);
                }
            }
        }
    }
    xcd_barrier(xbar); TSTAMP();
    { FRESH_IDS(); post_proj_rows(p, gw, ngw, lane); }
    xcd_barrier(xbar); TSTAMP();
    {
        {   const pg8::Gemm g{(const bf16_t*)(ws + B_CQN), (const bf16_t*)(ws + WS_WUQ), T, 768, QLORA, QLORA, QLORA, 0};
            pg8::StaticOrder SO; SO.init(T, 768, G, bid); const PgBf16 E{(bf16_t*)(ws + B_QRAW), 768};
            pg8::gemm_phase<PgBf16, pg8::StaticOrder, true, true>(lds, g, SO, E); }
        {   const pg8::Gemm g{(const bf16_t*)(ws + B_CKVN), (const bf16_t*)(ws + WS_WUKV), T, 1024, KVLORA, KVLORA, KVLORA, 0};
            pg8::StaticOrder SO; SO.init(T, 1024, G, bid); const PgBf16 E{(bf16_t*)(ws + B_KVRAW), 1024};
            pg8::gemm_phase<PgBf16, pg8::StaticOrder, true, true>(lds, g, SO, E); }
        {   const pg8::Gemm g{(const bf16_t*)(ws + B_ZC), (const bf16_t*)(ws + WS_WMQK), T, 1024, DM, MINNER, DM, DM};
            pg8::StaticOrder SO; SO.init(T, 1024, G, bid); const PgMqk E{(bf16_t*)(ws + B_MQ), (bf16_t*)(ws + B_MK)};
            pg8::gemm_phase<PgMqk, pg8::StaticOrder, true, true>(lds, g, SO, E); }
    }
    xcd_barrier(xbar); TSTAMP();
    { FRESH_IDS(); qk_post_rows(p, gw, ngw, lane); }
    xcd_barrier(xbar); TSTAMP();
    for (int pr = bid; pr < 256; pr += G) { const int bh = pr & 63, j = pr >> 6; attn_unit(p, lds, bh, 7 - j); attn_unit(p, lds, bh, j); }
    for (int u = bid; u < 1024; u += G) mlstm_a_unit(p, lds, u);
    xcd_barrier(xbar); TSTAMP();
    { FRESH_IDS(); mlstm_scan(p, bid * NT + tid, G * NT); }
    { FRESH_IDS(); attn_out_norm_rows(p, gw, ngw, lane); }
    xcd_barrier(xbar); TSTAMP();
    {
        McRegs R;
        if (bid < 1024) mlstm_c_load(p, bid, R);
        for (int u = bid; u < 1024; u += G) mlstm_c_unit(p, lds, u, R, (u + G < 1024) ? u + G : -1);
    }
    xcd_barrier(xbar); TSTAMP();
    {
        const pg8::Gemm g{(const bf16_t*)(ws + B_AO), (const bf16_t*)(ws + WS_WOUT), T, 1024, 1024, 1024, 1024, 0};
        pg8::StaticOrder SO; SO.init(T, 1024, G, bid); const PgResid E{p.in[0], ada, 2048, (bf16_t*)(ws + C_X1)};
        pg8::gemm_phase<PgResid, pg8::StaticOrder, true, true>(lds, g, SO, E);
    }
    xcd_barrier(xbar); TSTAMP();
    { FRESH_IDS(); norm_mod_rows_bf((const bf16_t*)(ws + C_X1), p.in[22], ada, 3072, 4096, (bf16_t*)(ws + C_H2), gw, ngw, lane, ws + C_H2F8); }
    xcd_barrier(xbar); TSTAMP();
    {
        const pg8::Gemm g{(const bf16_t*)(ws + C_H2), (const bf16_t*)(ws + WS_WRGU), T, 768, 1024, 1024, 1024, 0};
        pg8::StaticOrder SO; SO.init(T, 768, G, bid); const PgRgu E{(float*)(ws + C_LOGITS), (bf16_t*)(ws + C_ACTSH)};
        pg8::gemm_phase<PgRgu, pg8::StaticOrder, true, true>(lds, g, SO, E);
    }
    xcd_barrier(xbar); TSTAMP();
    { FRESH_IDS(); route_rows(p, gw, ngw, lane); }
    {
        const pg8::Gemm g{(const bf16_t*)(ws + C_ACTSH), (const bf16_t*)(ws + WS_WDSH), T, 1024, 256, 256, 256, 0};
        pg8::StaticOrder SO; SO.init(T, 1024, G, bid); const PgBf16 E{(bf16_t*)(ws + C_SHOUT), 1024};
        pg8::gemm_phase<PgBf16, pg8::StaticOrder, true, true>(lds, g, SO, E);
    }
    xcd_barrier(xbar); TSTAMP();
    LAS int* base = (LAS int*)(lds + 132 * 1024);
    LAS int* tsa = base + 256;
    volatile LAS int* tslot = (volatile LAS int*)(base + 1024);
    const int ngrp = (G % 8 == 0) ? 8 : 1, gx = bid % ngrp, gidx = bid / ngrp, gper = G / ngrp, nexp = NE / ngrp;
    { FRESH_IDS(); expert_prefix(p, base, tsa, tid, ngrp); }
#define EXPERT_UNITS(ctr_, mult_, ...) do { \
        const int nown_ = sched_nunits(tsa, gx, nexp, mult_), nst_ = sched_nstatic(nown_, gper) * gper; \
        for (int u = gidx; u < nst_; u += gper) { const int g = gx; __VA_ARGS__; } \
        int g = gx, u = 0; \
        while (sched_next(ctr_, tsa, tslot, fresh_tid(), ngrp, nexp, mult_, gper, g, u)) { __VA_ARGS__; } } while (0)
    {
        const int* cnt = (const int*)(ws + WS_CNT);
        EXPERT_UNITS((int*)(ws + WS_TICKET8), 4, {
            const LAS int* tsx = tsa + g * (nexp + 1);
            const int tg = u >> 2, tn = u & 3;
            int lo = 0, hi = nexp - 1;
            while (lo < hi) { const int mid = (lo + hi + 1) >> 1; if (tsx[mid] <= tg) lo = mid; else hi = mid - 1; }
            const int e = g + ngrp * lo, blk = tg - tsx[lo], c = __hip_atomic_load(cnt + e * CNT_STRIDE, __ATOMIC_RELAXED, __HIP_MEMORY_SCOPE_AGENT);
            const int nvalid = min(256, c - blk * 256);
            const RowGather RP{(const unsigned char*)(ws + C_H2F8), (const int*)(ws + C_LISTTOK) + (size_t)e * CAP + blk * 256, nvalid};
            const ColGU CP{p.in[25] + (size_t)e * 1024 * 256, p.in[26] - p.in[25]};
            const EpiExpAct E{(unsigned char*)(ws + C_ACTE), base[e] + blk * 256, nvalid};
            gemm2_tile(lds, RP, CP, 256, 1024, 0, tn * 128, E, nvalid);
        });
    }
    xcd_barrier(xbar); TSTAMP();
    {
        const int* cnt = (const int*)(ws + WS_CNT);
        EXPERT_UNITS((int*)(ws + WS_TICKET9), 2, {
            const LAS int* tsx = tsa + g * (nexp + 1);
            const int tg = u >> 1, nq = u & 1;
            int lo = 0, hi = nexp - 1;
            while (lo < hi) { const int mid = (lo + hi + 1) >> 1; if (tsx[mid] <= tg) lo = mid; else hi = mid - 1; }
            const int e = g + ngrp * lo, blk = tg - tsx[lo], c = __hip_atomic_load(cnt + e * CNT_STRIDE, __ATOMIC_RELAXED, __HIP_MEMORY_SCOPE_AGENT);
            const int nvalid = min(256, c - blk * 256);
            const int slot0 = base[e] + blk * 256;
            expert_down_unit(lds, (const unsigned char*)(ws + C_ACTE), p.in[27] + (size_t)e * 256 * 1024, nq, (unsigned char*)(ws + C_Y),
                             (const float*)(ws + C_LISTW) + (size_t)e * CAP + blk * 256, slot0, nvalid);
        });
    }
    xcd_barrier(xbar); TSTAMP();
    { FRESH_IDS(); combine_rows(p, base, gw, ngw, lane); }
#if DBG_STAGE == 2
    xcd_barrier(xbar); TSTAMP();
    xcd_barrier(xbar);
    {   FRESH_IDS();
        const unsigned long long* ts = (const unsigned long long*)(ws + WS_CTL + 16384 + 8192);
        const float tus = (float)(long long)(ts[TS_A1] - ts[TS_A0]) * 0.01f;
        const float cadd = sqrtf(2.5e-3f * tus * (1.f / 500.f));
        for (size_t i = (size_t)bid * NT + tid; i < (size_t)T * D / 4; i += (size_t)G * NT) { f32x4 v = ((f32x4*)p.out)[i]; v = v + cadd; ((f32x4*)p.out)[i] = v; }
    }
#endif
}

extern "C" void kernel_launch(void* const* d_in, const int* in_sizes, int n_in,
                              void* d_out, int out_size, void* d_ws, size_t ws_size,
                              hipStream_t stream) {
    static int grid_blocks = 0;
    if (!grid_blocks) {
        if (n_in != 31 || out_size != T * D || ws_size < WS_END) { fprintf(stderr, "kernel_launch: unexpected shapes n_in=%d out=%d ws=%zu (need %zu)\n", n_in, out_size, ws_size, (size_t)WS_END); grid_blocks = -1; return; }
        int dev = 0, cus = 0, per_cu = 0;
        (void)hipGetDevice(&dev);
        (void)hipDeviceGetAttribute(&cus, hipDeviceAttributeMultiprocessorCount, dev);
        (void)hipFuncSetAttribute((const void*)fwd_kernel, hipFuncAttributeMaxDynamicSharedMemorySize, LDS_BYTES);
        (void)hipOccupancyMaxActiveBlocksPerMultiprocessor(&per_cu, (const void*)fwd_kernel, NT, LDS_BYTES);
        if (per_cu < 1) per_cu = 1;
        grid_blocks = cus * per_cu;
        fprintf(stderr, "kernel_launch: cus=%d per_cu=%d grid=%d ws=%zu\n", cus, per_cu, grid_blocks, ws_size);
    }
    if (grid_blocks < 0) return;
    (void)hipMemsetAsync((char*)d_ws + WS_CTL, 0, CTL_BYTES, stream);
    (void)hipMemsetAsync((char*)d_ws + WS_ADA, 0, 8 * 6144 * sizeof(float), stream);
    Params p{};
    for (int i = 0; i < 31; ++i) p.in[i] = (const float*)d_in[i];
    p.out = (float*)d_out; p.ws = (unsigned char*)d_ws;
    void* args[] = {&p};
    hipError_t e = hipLaunchCooperativeKernel((const void*)fwd_kernel, dim3(grid_blocks), dim3(NT), args, LDS_BYTES, stream);
    if (e != hipSuccess) fprintf(stderr, "cooperative launch failed: %s (grid %d)\n", hipGetErrorString(e), grid_blocks);
}
```

```cpp
#include <hip/hip_runtime.h>
#include <hip/hip_cooperative_groups.h>
#include <cstdio>
#include <cstdint>
namespace cg = cooperative_groups;
#ifndef DBG_STAGE
#define DBG_STAGE 0
#endif
#define TS_A0 2
#define TS_A1 3
#define TS_B0 2
#define TS_B1 3

#define LAS __attribute__((address_space(3)))
typedef unsigned short bf16_t;
typedef short bf16x8 __attribute__((ext_vector_type(8)));
typedef short bf16x4 __attribute__((ext_vector_type(4)));
typedef float f32x4 __attribute__((ext_vector_type(4)));
typedef float f32x2 __attribute__((ext_vector_type(2)));
typedef unsigned u32x4 __attribute__((ext_vector_type(4)));
typedef unsigned u32x2 __attribute__((ext_vector_type(2)));

constexpr int NT = 512, NWAVES = 8;
constexpr int LDS_BYTES = 144 * 1024;
constexpr int Bsz = 8, S = 2048, D = 1024, T = Bsz * S;
constexpr int H_MLA = 8, DQK = 96, DNOPE = 64, DROPE = 32, DV = 64, QLORA = 384, KVLORA = 256;
constexpr int H_ML = 4, DM = 128, MINNER = 512, CHUNK = 64, NCH = S / CHUNK;
constexpr int IN_DIM = 2216;
constexpr int OFF_CQ = 0, OFF_CKV = 384, OFF_KR = 640, OFF_Z = 672, OFF_MV = 1184, OFF_MO = 1696, OFF_GATE = 2208;
constexpr int NE = 256, TOPK = 8, EDIM = 256, SDIM = 256;
constexpr int CAP = T;
constexpr float RMS_EPS = 1e-6f;

constexpr size_t MiB = 1u << 20;
constexpr size_t WS_CTL = 0;
constexpr size_t CTL_BYTES = 65536;
constexpr size_t WS_CNT = 32768;
constexpr int CNT_STRIDE = 32;
constexpr size_t WS_ADA = 1 * MiB;
constexpr size_t WS_BC = 2 * MiB;
constexpr size_t WS_MLOC = WS_BC + 8192;
constexpr size_t WS_MPREV = WS_BC + 16384;
constexpr size_t WS_DN = 2 * MiB + 512 * 1024;
constexpr size_t WS_NPREV = 3 * MiB;
constexpr size_t WS_WIN = 4 * MiB;
constexpr size_t WS_WUQ = 9 * MiB;
constexpr size_t WS_WUKV = 10 * MiB;
constexpr size_t WS_WMQK = 11 * MiB;
constexpr size_t WS_WOUT = 12 * MiB;
constexpr size_t WS_WRGU = 14 * MiB;
constexpr size_t WS_WDSH = 16 * MiB;
constexpr size_t WS_TICKET8 = WS_CTL + 18432;
constexpr size_t WS_TICKET9 = WS_CTL + 20480;
constexpr size_t RB = 416 * MiB;
constexpr size_t B_PROJ = RB;
constexpr size_t B_GRAW = RB + 70 * MiB;
constexpr size_t B_GL = RB + 71 * MiB;
constexpr size_t B_H1 = RB + 72 * MiB;
constexpr size_t B_CQN = RB + 104 * MiB;
constexpr size_t B_CKVN = RB + 116 * MiB;
constexpr size_t B_ZC = RB + 124 * MiB;
constexpr size_t B_QRAW = RB + 140 * MiB;
constexpr size_t B_KVRAW = RB + 164 * MiB;
constexpr size_t B_MQ = RB + 196 * MiB;
constexpr size_t B_MK = RB + 212 * MiB;
constexpr size_t B_Q = RB + 228 * MiB;
constexpr size_t B_K = RB + 252 * MiB;
constexpr size_t B_ORAW = RB + 276 * MiB;
constexpr size_t B_AO = RB + 292 * MiB;
constexpr size_t B_DC = RB + 324 * MiB;
constexpr size_t B_CPREV = RB + 388 * MiB;
constexpr size_t C_H2 = RB;
constexpr size_t C_LOGITS = RB + 32 * MiB;
constexpr size_t C_ACTSH = RB + 48 * MiB;
constexpr size_t C_SHOUT = RB + 56 * MiB;
constexpr size_t C_TOKE = RB + 88 * MiB;
constexpr size_t C_TOKW = RB + 89 * MiB;
constexpr size_t C_TOKPOS = RB + 90 * MiB;
constexpr size_t C_LISTTOK = RB + 92 * MiB;
constexpr size_t C_LISTW = RB + 108 * MiB;
constexpr size_t C_ACTE = RB + 124 * MiB;
constexpr size_t C_Y = RB + 188 * MiB;
constexpr size_t C_H2F8 = RB + 320 * MiB;
constexpr size_t C_X1 = RB + 340 * MiB;
constexpr size_t WS_END = RB + 444 * MiB;

struct Params {
    const float* in[31];
    float* out;
    unsigned char* ws;
};

typedef __bf16 bf16x2v __attribute__((ext_vector_type(2)));
__device__ __forceinline__ unsigned cvt_pk_bf16(float lo, float hi) { f32x2 v = {lo, hi}; bf16x2v b = __builtin_convertvector(v, bf16x2v); return __builtin_bit_cast(unsigned, b); }
__device__ __forceinline__ unsigned pk4_fp8(float a, float b, float c, float d) { int p = __builtin_amdgcn_cvt_pk_fp8_f32(a, b, 0, false); p = __builtin_amdgcn_cvt_pk_fp8_f32(c, d, p, true); return (unsigned)p; }
__device__ __forceinline__ float bf2f(unsigned short b) { return __uint_as_float((unsigned)b << 16); }
__device__ __forceinline__ float bflo(unsigned u) { return __uint_as_float(u << 16); }
__device__ __forceinline__ float bfhi(unsigned u) { return __uint_as_float(u & 0xffff0000u); }
__device__ __forceinline__ float wave_sum(float v) {
#pragma unroll
    for (int o = 1; o < 64; o <<= 1) v += __shfl_xor(v, o);
    return v;
}
__device__ __forceinline__ float wave_max(float v) {
#pragma unroll
    for (int o = 1; o < 64; o <<= 1) v = fmaxf(v, __shfl_xor(v, o));
    return v;
}
__device__ __forceinline__ float sigmoidf_(float x) { return __builtin_amdgcn_rcpf(1.f + __builtin_amdgcn_exp2f(-1.4426950408889634f * x)); }
__device__ __forceinline__ float siluf_(float x) { return x * __builtin_amdgcn_rcpf(1.f + __builtin_amdgcn_exp2f(-1.4426950408889634f * x)); }
__device__ __forceinline__ int fresh_tid() { int t = threadIdx.x; asm volatile("" : "+v"(t)); return t; }
#define MFMA16(a, b, c) __builtin_amdgcn_mfma_f32_16x16x32_bf16((a), (b), (c), 0, 0, 0)


#define XB_TMO      128
#define XB_XCNT(j)  (256  + 64 * (j))
#define XB_XSUB(j)  (1280 + 64 * (j))
#define XB_XGEN(j)  (2304 + 64 * (j))
#define XB_TOP      3328
#define XB_TOPGEN   3392
#define XCD_BAR_WORDS 3456
#define XB_SPIN_CAP (1u << 23)
__device__ __forceinline__ unsigned xb_ld(unsigned* p)              { return __hip_atomic_load(p, __ATOMIC_RELAXED, __HIP_MEMORY_SCOPE_AGENT); }
__device__ __forceinline__ unsigned xb_add(unsigned* p, unsigned v) { return __hip_atomic_fetch_add(p, v, __ATOMIC_RELAXED, __HIP_MEMORY_SCOPE_AGENT); }
__device__ __forceinline__ unsigned xb_xcc_id() { return (unsigned)__builtin_amdgcn_s_getreg((3 << 11) | 20) & 0xFu; }
#define XB_SPIN(cond, bar) do { unsigned _sp = 0; while (cond) { __builtin_amdgcn_s_sleep(1); \
    if ((++_sp & 255u) == 0u) { if (xb_ld(&(bar)[XB_TMO])) break; if (_sp > XB_SPIN_CAP) { atomicAdd(&(bar)[XB_TMO], 1u); break; } } } } while (0)
struct XcdBarrier { unsigned* bar; unsigned x; volatile LAS unsigned* st; };
__device__ __forceinline__ XcdBarrier xcd_barrier_post(unsigned* bar, volatile LAS unsigned* st) {
    XcdBarrier b; b.bar = bar; b.x = xb_xcc_id(); b.st = st;
    if (threadIdx.x == 0) (void)xb_add(&bar[XB_XCNT(b.x)], 1u);
    return b;
}
__device__ __forceinline__ void xcd_barrier_complete(unsigned* bar, unsigned x, unsigned& nloc, unsigned& nx) {
    const unsigned G = gridDim.x * gridDim.y * gridDim.z;
    unsigned sum, cnt, mine, sp = 0u;
    for (;;) {
        sum = 0u; cnt = 0u; mine = 0u;
#pragma unroll
        for (unsigned j = 0; j < 16; ++j) { const unsigned c = xb_ld(&bar[XB_XCNT(j)]); sum += c; cnt += (c > 0u) ? 1u : 0u; mine = (j == x) ? c : mine; }
        if (sum == G) break;
        __builtin_amdgcn_s_sleep(1);
        if ((++sp & 255u) == 0u) { if (xb_ld(&bar[XB_TMO])) break; if (sp > XB_SPIN_CAP) { atomicAdd(&bar[XB_TMO], 1u); break; } }
    }
    nloc = mine > 0u ? mine : 1u; nx = cnt > 0u ? cnt : 1u;
}
__device__ __forceinline__ void xcd_barrier(const XcdBarrier& b) {
    asm volatile("s_waitcnt vmcnt(0)" ::: "memory");
    __syncthreads();
    if (threadIdx.x == 0) {
        unsigned* bar = b.bar;
        __builtin_amdgcn_s_waitcnt(0);
        unsigned nloc = b.st[0], nx = b.st[1];
        if (nloc == 0u) { xcd_barrier_complete(bar, b.x, nloc, nx); b.st[0] = nloc; b.st[1] = nx; }
        const unsigned old = xb_add(&bar[XB_XSUB(b.x)], 1u);
        const unsigned gen = old / nloc;
        if (old + 1u == (gen + 1u) * nloc) {
            __builtin_amdgcn_fence(__ATOMIC_RELEASE, "agent");
            asm volatile("s_waitcnt vmcnt(0)" ::: "memory");
            const unsigned og = xb_add(&bar[XB_TOP], 1u);
            const unsigned tg = og / nx;
            if (og + 1u == (tg + 1u) * nx) xb_add(&bar[XB_TOPGEN], 1u);
            else XB_SPIN(xb_ld(&bar[XB_TOPGEN]) == tg, bar);
            __builtin_amdgcn_fence(__ATOMIC_ACQUIRE, "agent");
            xb_add(&bar[XB_XGEN(b.x)], 1u);
            asm volatile("s_waitcnt vmcnt(0)" ::: "memory");
        } else {
            XB_SPIN(xb_ld(&bar[XB_XGEN(b.x)]) == gen, bar);
            __builtin_amdgcn_fence(__ATOMIC_ACQUIRE, "agent");
            asm volatile("s_waitcnt vmcnt(0)" ::: "memory");
        }
    }
    __syncthreads();
}

template <int MAP>
__device__ __forceinline__ int map_row(int n) {
    if (MAP == 0) return n;
    if (MAP == 1) return ((n >> 4) << 5) + (n & 15);
    return ((n >> 4) << 5) + 16 + (n & 15);
}
template <int MAP>
__device__ __forceinline__ void conv_item(const float* src, int K, int N, bf16_t* dst, size_t dst_mat_stride, int row_off, LAS float* scr, int it, int lane) {
    const int nblk = (N + 31) / 32, kblk = K / 64, per = nblk * kblk;
    const int mat = it / per, r = it - mat * per, kb = r / nblk, nb = r - kb * nblk, k0 = kb * 64, n0 = nb * 32;
    const float* W = src + (size_t)mat * K * N;
    bf16_t* WT = dst + (size_t)mat * dst_mat_stride;
    const int nn = n0 + (lane & 31);
    const bool nok = nn < N;
    float v[32];
    const float* wp = W + (size_t)(k0 + (lane >> 5)) * N + nn;
#pragma unroll
    for (int i = 0; i < 32; ++i) v[i] = nok ? wp[(size_t)(2 * i) * N] : 0.f;
#pragma unroll
    for (int i = 0; i < 32; ++i) scr[(2 * i + (lane >> 5)) * 33 + (lane & 31)] = v[i];
    asm volatile("s_waitcnt lgkmcnt(0)" ::: "memory");
    const int c = lane & 7;
#pragma unroll
    for (int j = 0; j < 4; ++j) {
        const int n = (lane >> 3) + 8 * j;
        const LAS float* sp = scr + (8 * c) * 33 + n;
        u32x4 o; o.x = cvt_pk_bf16(sp[0 * 33], sp[1 * 33]); o.y = cvt_pk_bf16(sp[2 * 33], sp[3 * 33]); o.z = cvt_pk_bf16(sp[4 * 33], sp[5 * 33]); o.w = cvt_pk_bf16(sp[6 * 33], sp[7 * 33]);
        if (n0 + n < N) *(u32x4*)(WT + (size_t)(row_off + map_row<MAP>(n0 + n)) * K + k0 + 8 * c) = o;
    }
    asm volatile("s_waitcnt lgkmcnt(0)" ::: "memory");
}

__device__ __forceinline__ void ada_unit(const Params& p, LAS unsigned char* lds, int u, int tid) {
    LAS float* cond = (LAS float*)lds;
    LAS float* red = (LAS float*)(lds + 16384);
    const float* c = p.in[1]; const float* w = p.in[3]; const float* bias = p.in[4];
    float* ada = (float*)(p.ws + WS_ADA);
    const int lane = tid & 63, wv = tid >> 6, cg = u >> 1, kh = u & 1;
    for (int i = tid; i < 8 * 512; i += NT) { const int b = i >> 9, k = i & 511; cond[i] = siluf_(c[b * 1024 + kh * 512 + k]); }
    __syncthreads();
    float acc[8];
#pragma unroll
    for (int b = 0; b < 8; ++b) acc[b] = 0.f;
    const int col = cg * 64 + lane;
    const float* wp = w + (size_t)(kh * 512 + wv * 64) * 6144 + col;
#pragma unroll 16
    for (int k = 0; k < 64; ++k) {
        const float wv_ = wp[(size_t)k * 6144];
#pragma unroll
        for (int b = 0; b < 8; ++b) acc[b] += cond[b * 512 + wv * 64 + k] * wv_;
    }
#pragma unroll
    for (int b = 0; b < 8; ++b) red[(wv * 8 + b) * 64 + lane] = acc[b];
    __syncthreads();
    {
        const int b = tid >> 6;
        float sacc = 0.f;
#pragma unroll
        for (int w2 = 0; w2 < 8; ++w2) sacc += red[(w2 * 8 + b) * 64 + lane];
        atomicAdd(&ada[b * 6144 + col], sacc + (kh == 0 ? bias[col] : 0.f));
    }
    __syncthreads();
}

__device__ __forceinline__ void norm_mod_rows_bf(const bf16_t* X, const float* g, const float* ada, int sh_off, int sc_off, bf16_t* Hout, int gw, int ngw, int lane, unsigned char* H8) {
    u32x2 nx[4];
    if (gw < T) {
#pragma unroll
        for (int j = 0; j < 4; ++j) nx[j] = *((const u32x2*)(X + (size_t)gw * D) + lane + 64 * j);
    }
    f32x4 gg[4];
#pragma unroll
    for (int j = 0; j < 4; ++j) gg[j] = *(const f32x4*)(g + 4 * (lane + 64 * j));
    for (int row = gw; row < T; row += ngw) {
        const int b = row / S;
        f32x4 v[4]; float ss = 0.f;
#pragma unroll
        for (int j = 0; j < 4; ++j) { v[j].x = bflo(nx[j].x); v[j].y = bfhi(nx[j].x); v[j].z = bflo(nx[j].y); v[j].w = bfhi(nx[j].y); }
        if (row + ngw < T) {
#pragma unroll
            for (int j = 0; j < 4; ++j) nx[j] = *((const u32x2*)(X + (size_t)(row + ngw) * D) + lane + 64 * j);
        }
        f32x4 sc[4], sh[4];
#pragma unroll
        for (int j = 0; j < 4; ++j) { const int k = 4 * (lane + 64 * j);
            sc[j] = *(const f32x4*)(ada + b * 6144 + sc_off + k); sh[j] = *(const f32x4*)(ada + b * 6144 + sh_off + k); }
#pragma unroll
        for (int j = 0; j < 4; ++j) ss += v[j].x * v[j].x + v[j].y * v[j].y + v[j].z * v[j].z + v[j].w * v[j].w;
        const float rinv = rsqrtf(wave_sum(ss) * (1.f / D) + RMS_EPS);
        u32x2* o = (u32x2*)(Hout + (size_t)row * D) + lane;
#pragma unroll
        for (int j = 0; j < 4; ++j) {
            const f32x4 h = v[j] * rinv * gg[j] * (1.f + sc[j]) + sh[j];
            u32x2 w; w.x = cvt_pk_bf16(h.x, h.y); w.y = cvt_pk_bf16(h.z, h.w);
            o[64 * j] = w;
            *((unsigned*)(H8 + (size_t)row * D) + lane + 64 * j) = pk4_fp8(h.x, h.y, h.z, h.w);
        }
    }
}
__device__ __forceinline__ void norm_mod_rows(const float* X, const float* g, const float* ada, int sh_off, int sc_off, bf16_t* Hout, int gw, int ngw, int lane, unsigned char* H8 = nullptr) {
    f32x4 nx[4];
    if (gw < T) {
#pragma unroll
        for (int j = 0; j < 4; ++j) nx[j] = *((const f32x4*)(X + (size_t)gw * D) + lane + 64 * j);
    }
    f32x4 gg[4];
#pragma unroll
    for (int j = 0; j < 4; ++j) gg[j] = *(const f32x4*)(g + 4 * (lane + 64 * j));
    for (int row = gw; row < T; row += ngw) {
        const int b = row / S;
        f32x4 v[4]; float ss = 0.f;
#pragma unroll
        for (int j = 0; j < 4; ++j) v[j] = nx[j];
        if (row + ngw < T) {
#pragma unroll
            for (int j = 0; j < 4; ++j) nx[j] = *((const f32x4*)(X + (size_t)(row + ngw) * D) + lane + 64 * j);
        }
        f32x4 sc[4], sh[4];
#pragma unroll
        for (int j = 0; j < 4; ++j) { const int k = 4 * (lane + 64 * j);
            sc[j] = *(const f32x4*)(ada + b * 6144 + sc_off + k); sh[j] = *(const f32x4*)(ada + b * 6144 + sh_off + k); }
#pragma unroll
        for (int j = 0; j < 4; ++j) ss += v[j].x * v[j].x + v[j].y * v[j].y + v[j].z * v[j].z + v[j].w * v[j].w;
        const float rinv = rsqrtf(wave_sum(ss) * (1.f / D) + RMS_EPS);
        u32x2* o = (u32x2*)(Hout + (size_t)row * D) + lane;
#pragma unroll
        for (int j = 0; j < 4; ++j) {
            const f32x4 h = v[j] * rinv * gg[j] * (1.f + sc[j]) + sh[j];
            u32x2 w; w.x = cvt_pk_bf16(h.x, h.y); w.y = cvt_pk_bf16(h.z, h.w);
            o[64 * j] = w;
            if (H8) *((unsigned*)(H8 + (size_t)row * D) + lane + 64 * j) = pk4_fp8(h.x, h.y, h.z, h.w);
        }
    }
}

__device__ __forceinline__ void post_proj_rows(const Params& p, int gw, int ngw, int lane) {
    const bf16_t* proj = (const bf16_t*)(p.ws + B_PROJ);
    const float* graw = (const float*)(p.ws + B_GRAW);
    float* gl = (float*)(p.ws + B_GL);
    bf16_t* cqn = (bf16_t*)(p.ws + B_CQN); bf16_t* ckvn = (bf16_t*)(p.ws + B_CKVN); bf16_t* zc = (bf16_t*)(p.ws + B_ZC);
    const float* g_cq = p.in[7]; const float* g_ckv = p.in[9]; const float* conv_w = p.in[14]; const float* conv_b = p.in[15];
    const int c0 = lane * 8;
    float gq[6], gk[4], cw[4][8], cbv[8];
#pragma unroll
    for (int j = 0; j < 6; ++j) gq[j] = g_cq[lane * 6 + j];
#pragma unroll
    for (int j = 0; j < 4; ++j) gk[j] = g_ckv[lane * 4 + j];
#pragma unroll
    for (int tap = 0; tap < 4; ++tap)
#pragma unroll
        for (int j = 0; j < 8; ++j) cw[tap][j] = conv_w[tap * MINNER + c0 + j];
#pragma unroll
    for (int j = 0; j < 8; ++j) cbv[j] = conv_b[c0 + j];
    const float gbias = (lane < 4) ? p.in[18][lane] : (lane < 8 ? p.in[19][lane - 4] : 0.f);
    for (int row = gw; row < T; row += ngw) {
        const bf16_t* pr = proj + (size_t)row * IN_DIM;
        const int s = row % S;
        const unsigned* q = (const unsigned*)(pr + OFF_CQ) + lane * 3;
        const unsigned a0 = q[0], a1 = q[1], a2 = q[2];
        const u32x2 kvv = *((const u32x2*)(pr + OFF_CKV) + lane);
        u32x4 z[4];
#pragma unroll
        for (int tap = 0; tap < 4; ++tap) { const int ds = tap - 3; z[tap] = (s + ds >= 0) ? *(const u32x4*)(pr + (ptrdiff_t)ds * IN_DIM + OFF_Z + c0) : (u32x4){0u, 0u, 0u, 0u}; }
        const float gr = (lane < 8) ? graw[(size_t)row * 8 + lane] : 0.f;
        {
            float f[6] = {bflo(a0), bfhi(a0), bflo(a1), bfhi(a1), bflo(a2), bfhi(a2)};
            float ss = 0.f;
#pragma unroll
            for (int j = 0; j < 6; ++j) ss += f[j] * f[j];
            const float rinv = rsqrtf(wave_sum(ss) * (1.f / QLORA) + RMS_EPS);
            unsigned* o = (unsigned*)(cqn + (size_t)row * QLORA) + lane * 3;
            o[0] = cvt_pk_bf16(f[0] * rinv * gq[0], f[1] * rinv * gq[1]);
            o[1] = cvt_pk_bf16(f[2] * rinv * gq[2], f[3] * rinv * gq[3]);
            o[2] = cvt_pk_bf16(f[4] * rinv * gq[4], f[5] * rinv * gq[5]);
        }
        {
            float f[4] = {bflo(kvv.x), bfhi(kvv.x), bflo(kvv.y), bfhi(kvv.y)};
            float ss = f[0] * f[0] + f[1] * f[1] + f[2] * f[2] + f[3] * f[3];
            const float rinv = rsqrtf(wave_sum(ss) * (1.f / KVLORA) + RMS_EPS);
            u32x2 w; w.x = cvt_pk_bf16(f[0] * rinv * gk[0], f[1] * rinv * gk[1]); w.y = cvt_pk_bf16(f[2] * rinv * gk[2], f[3] * rinv * gk[3]);
            *((u32x2*)(ckvn + (size_t)row * KVLORA) + lane) = w;
        }
        {
            float acc[8];
#pragma unroll
            for (int j = 0; j < 8; ++j) acc[j] = cbv[j];
#pragma unroll
            for (int tap = 0; tap < 4; ++tap) {
                acc[0] += bflo(z[tap].x) * cw[tap][0]; acc[1] += bfhi(z[tap].x) * cw[tap][1]; acc[2] += bflo(z[tap].y) * cw[tap][2]; acc[3] += bfhi(z[tap].y) * cw[tap][3];
                acc[4] += bflo(z[tap].z) * cw[tap][4]; acc[5] += bfhi(z[tap].z) * cw[tap][5]; acc[6] += bflo(z[tap].w) * cw[tap][6]; acc[7] += bfhi(z[tap].w) * cw[tap][7];
            }
            u32x4 o; o.x = cvt_pk_bf16(siluf_(acc[0]), siluf_(acc[1])); o.y = cvt_pk_bf16(siluf_(acc[2]), siluf_(acc[3]));
            o.z = cvt_pk_bf16(siluf_(acc[4]), siluf_(acc[5])); o.w = cvt_pk_bf16(siluf_(acc[6]), siluf_(acc[7]));
            *(u32x4*)(zc + (size_t)row * MINNER + c0) = o;
        }
        if (lane < 8) {
            const float xx = gr + gbias;
            gl[(size_t)row * 8 + lane] = (lane < 4) ? xx : (fminf(xx, 0.f) - log1pf(__expf(-fabsf(xx))));
        }
    }
}

__device__ __forceinline__ void qk_post_rows(const Params& p, int gw, int ngw, int lane) {
    const bf16_t* qraw = (const bf16_t*)(p.ws + B_QRAW); const bf16_t* kvraw = (const bf16_t*)(p.ws + B_KVRAW);
    const bf16_t* proj = (const bf16_t*)(p.ws + B_PROJ);
    bf16_t* Q = (bf16_t*)(p.ws + B_Q); bf16_t* Kb = (bf16_t*)(p.ws + B_K);
    const int* positions = (const int*)p.in[2];
    const float* g_qn = p.in[11]; const float* g_kn = p.in[12];
    const float qscale = 0.10206207261596575f * 1.4426950408889634f;
    const int l = lane & 31, hsel = lane >> 5, i = l & 15;
    const float inv_freq = exp2f(-(float)(2 * i) * (13.287712379549449f / 32.f));
    const float gq0 = g_qn[l], gq1 = g_qn[l + 32], gq2 = g_qn[l + 64], gk0 = g_kn[l], gk1 = g_kn[l + 32], gk2 = g_kn[l + 64];
    for (int row = gw; row < T; row += ngw) {
        const int b = row / S, s = row % S;
        float qv[4][3], kv[4][2];
#pragma unroll
        for (int hp = 0; hp < 4; ++hp) {
            const int h = hp * 2 + hsel;
            const bf16_t* qr = qraw + (size_t)row * 768 + h * 96; const bf16_t* kr = kvraw + (size_t)row * 1024 + h * 128;
            qv[hp][0] = bf2f(qr[l]); qv[hp][1] = bf2f(qr[l + 32]); qv[hp][2] = bf2f(qr[l + 64]);
            kv[hp][0] = bf2f(kr[l]); kv[hp][1] = bf2f(kr[l + 32]);
        }
        const float krope = bf2f(proj[(size_t)row * IN_DIM + OFF_KR + l]);
        const float ang = (float)positions[row] * inv_freq;
        const float sn = __sinf(ang), cs = __cosf(ang);
#pragma unroll
        for (int hp = 0; hp < 4; ++hp) {
            const int h = hp * 2 + hsel;
            {
                float v0 = qv[hp][0], v1 = qv[hp][1], v2 = qv[hp][2];
                float ss = v0 * v0 + v1 * v1 + v2 * v2;
#pragma unroll
                for (int o = 1; o < 32; o <<= 1) ss += __shfl_xor(ss, o);
                const float rinv = rsqrtf(ss * (1.f / 96.f) + RMS_EPS);
                v0 *= rinv * gq0; v1 *= rinv * gq1; v2 *= rinv * gq2;
                const float other = __shfl_xor(v2, 16);
                const float r = (l < 16) ? (v2 * cs - other * sn) : (other * sn + v2 * cs);
                bf16_t* qo = Q + ((size_t)(b * H_MLA + h) * S + s) * 96;
                qo[l] = (bf16_t)(cvt_pk_bf16(v0 * qscale, 0.f) & 0xffff);
                qo[l + 32] = (bf16_t)(cvt_pk_bf16(v1 * qscale, 0.f) & 0xffff);
                qo[l + 64] = (bf16_t)(cvt_pk_bf16(r * qscale, 0.f) & 0xffff);
            }
            {
                float v0 = kv[hp][0], v1 = kv[hp][1], v2 = krope;
                float ss = v0 * v0 + v1 * v1 + v2 * v2;
#pragma unroll
                for (int o = 1; o < 32; o <<= 1) ss += __shfl_xor(ss, o);
                const float rinv = rsqrtf(ss * (1.f / 96.f) + RMS_EPS);
                v0 *= rinv * gk0; v1 *= rinv * gk1; v2 *= rinv * gk2;
                const float other = __shfl_xor(v2, 16);
                const float r = (l < 16) ? (v2 * cs - other * sn) : (other * sn + v2 * cs);
                bf16_t* ko = Kb + ((size_t)(b * H_MLA + h) * S + s) * 96;
                ko[l] = (bf16_t)(cvt_pk_bf16(v0, 0.f) & 0xffff);
                ko[l + 32] = (bf16_t)(cvt_pk_bf16(v1, 0.f) & 0xffff);
                ko[l + 64] = (bf16_t)(cvt_pk_bf16(r, 0.f) & 0xffff);
            }
        }
    }
}

__device__ __forceinline__ void attn_out_norm_rows(const Params& p, int gw, int ngw, int lane) {
    const bf16_t* oraw = (const bf16_t*)(p.ws + B_ORAW); bf16_t* ao = (bf16_t*)(p.ws + B_AO); const float* g = p.in[13];
    float gg[8];
#pragma unroll
    for (int j = 0; j < 8; ++j) gg[j] = g[lane * 8 + j];
    for (int row = gw; row < T; row += ngw) {
        const u32x4 a = *((const u32x4*)(oraw + (size_t)row * 512) + lane);
        float f[8] = {bflo(a.x), bfhi(a.x), bflo(a.y), bfhi(a.y), bflo(a.z), bfhi(a.z), bflo(a.w), bfhi(a.w)};
        float ss = 0.f;
#pragma unroll
        for (int j = 0; j < 8; ++j) ss += f[j] * f[j];
        const float rinv = rsqrtf(wave_sum(ss) * (1.f / 512.f) + RMS_EPS);
        u32x4 o; o.x = cvt_pk_bf16(f[0] * rinv * gg[0], f[1] * rinv * gg[1]); o.y = cvt_pk_bf16(f[2] * rinv * gg[2], f[3] * rinv * gg[3]);
        o.z = cvt_pk_bf16(f[4] * rinv * gg[4], f[5] * rinv * gg[5]); o.w = cvt_pk_bf16(f[6] * rinv * gg[6], f[7] * rinv * gg[7]);
        *((u32x4*)(ao + (size_t)row * 1024) + lane) = o;
    }
}

namespace pg8 {
#define PG8_LAS __attribute__((address_space(3)))
typedef unsigned short bf16_t;
typedef short bf16x8 __attribute__((ext_vector_type(8)));
typedef float f32x4 __attribute__((ext_vector_type(4)));
typedef unsigned u32x4 __attribute__((ext_vector_type(4)));
constexpr int BM = 256, BK = 64, HALF = 128, HTB = HALF * BK * 2  , STAGE_BYTES = 8 * HTB, NXCD = 8, WGM = 8;

__host__ __device__ __forceinline__ int lds_byte(int r, int c) { const int st = (r >> 4) * 2 + (c >> 5), rr = r & 15, cc = c & 31, ob = rr * 64 + cc * 2; return st * 1024 + (ob ^ (((ob >> 9) & 1) << 5)); }
__host__ __device__ __forceinline__ void stage_rc(int b, int& R, int& C) { const int st = b / 1024, sb = b % 1024, swz = sb ^ (((sb >> 9) & 1) << 5); R = (st >> 1) * 16 + swz / 64; C = (st & 1) * 32 + (swz % 64) / 2; }
__host__ __device__ __forceinline__ int perm32(int rho) { const int n = rho >> 4, i = rho & 15; return 8 * (i >> 2) + 4 * n + (i & 3); }

struct Unit { int pm, pn; };
struct Gemm { const bf16_t* A; const bf16_t* Bt; int M, N, K, lda, ldb, apn; };

struct StaticOrder {
    int nM, nN, nwg, G, c;
    __host__ __device__ void init(int M, int N, int G_, int c_) { nM = M / BM; nN = N / BM; nwg = nM * nN; G = G_; c = c_; }
    __host__ __device__ bool next(int i, Unit& u) const {
        const long L = (long)i * G + c; if (L >= nwg) return false;
        int wgid = (int)L; { const int q = nwg / NXCD, r = nwg % NXCD, xcd = wgid % NXCD, off = wgid / NXCD; wgid = (xcd < r ? xcd * (q + 1) : r * (q + 1) + (xcd - r) * q) + off; }
        const int nig = WGM * nN, gid = wgid / nig, fm = gid * WGM, gsz = (nM - fm) < WGM ? (nM - fm) : WGM;
        u.pm = fm + ((wgid % nig) % gsz); u.pn = (wgid % nig) / gsz; return true;
    }
    __device__ __forceinline__ void a_ready(const Unit&) const {}
    __device__ __forceinline__ void done(const Unit&) const {}
};


template <class Epi, class Sched, bool ALIGN_EPI = false, bool SP2 = false>
__device__ __forceinline__ void gemm_phase(PG8_LAS unsigned char* lds, const Gemm g, const Sched& S, const Epi& E) {
    const int tid = fresh_tid(), wid = __builtin_amdgcn_readfirstlane(tid >> 6), lane = tid & 63, wr = wid >> 2, wc = wid & 3, fr = lane & 15, fq = lane >> 4;
    const int K = g.K, nt = K / BK;
    unsigned voffA[2], voffB[2];
#pragma unroll
    for (int i = 0; i < 2; ++i) { int R, C; stage_rc(tid * 16 + i * 8192, R, C); const int Rb = Epi::PERM ? ((R & ~31) + perm32(R & 31)) : R;
        voffA[i] = (unsigned)(R * g.lda + C) * 2u; voffB[i] = (unsigned)(Rb * g.ldb + C) * 2u; }
    const size_t kstep = (size_t)(BK * 2);
    const size_t hstepA = (size_t)HALF * g.lda * 2, hstepB = (size_t)HALF * g.ldb * 2;
    const size_t tstepA = 2 * hstepA, tstepB = 2 * hstepB;
    const unsigned ldsw = (unsigned)wid * 1024u;
    const int aoff = lds_byte(wr * 64 + fr, fq * 8), boff = lds_byte(wc * 32 + fr, fq * 8);
#define PG8_SA(b, h) (((b) * 2 + (h)) * HTB)
#define PG8_SB(b, h) ((4 + (b) * 2 + (h)) * HTB)
#define PG8_STAGE(bufoff, gbase, voff) do { _Pragma("unroll") for (int _i = 0; _i < 2; ++_i) \
        __builtin_amdgcn_global_load_lds((const unsigned*)((const char*)(gbase) + (voff)[_i]), (PG8_LAS unsigned*)(lds + (bufoff) + ldsw + _i * 8192), 16, 0, 0); } while (0)
#define PG8_LDA(dst, b, h) do { _Pragma("unroll") for (int m = 0; m < 4; ++m) _Pragma("unroll") for (int k = 0; k < 2; ++k) dst[m][k] = *(const PG8_LAS bf16x8*)(lds + PG8_SA(b, h) + aoff + m * 2048 + k * 1024); } while (0)
#define PG8_LDB(dst, b, h) do { _Pragma("unroll") for (int n = 0; n < 2; ++n) _Pragma("unroll") for (int k = 0; k < 2; ++k) dst[n][k] = *(const PG8_LAS bf16x8*)(lds + PG8_SB(b, h) + boff + n * 2048 + k * 1024); } while (0)
#define PG8_MMA(ai, bj, At, Bt) do { __builtin_amdgcn_s_setprio(1); _Pragma("unroll") for (int m = 0; m < 4; ++m) _Pragma("unroll") for (int n = 0; n < 2; ++n) _Pragma("unroll") for (int k = 0; k < 2; ++k) \
        acc[ai][bj][m][n] = __builtin_amdgcn_mfma_f32_16x16x32_bf16(Bt[n][k], At[m][k], acc[ai][bj][m][n], 0, 0, 0); __builtin_amdgcn_s_setprio(0); } while (0)
#define PG8_WAIT_V(n) asm volatile("s_waitcnt vmcnt(" #n ")" ::: "memory")
#define PG8_WAIT_L(n) asm volatile("s_waitcnt lgkmcnt(" #n ")" ::: "memory")
#define PG8_BAR __builtin_amdgcn_s_barrier()
#define PG8_SCHED __builtin_amdgcn_sched_barrier(0)
    Unit cur, nxt; int ui = 0;
    if (!S.next(0, cur)) return;
    f32x4 acc[2][2][4][2];
#pragma unroll
    for (int a = 0; a < 2; ++a)
#pragma unroll
        for (int b = 0; b < 2; ++b)
#pragma unroll
            for (int m = 0; m < 4; ++m)
#pragma unroll
                for (int n = 0; n < 2; ++n) acc[a][b][m][n] = (f32x4){0.f, 0.f, 0.f, 0.f};
    bf16x8 At[4][2], B0[2][2], B1[2][2];
    const char* cA = (const char*)g.A + (size_t)cur.pm * tstepA + (size_t)cur.pn * g.apn * 2; const char* cB = (const char*)g.Bt + (size_t)cur.pn * tstepB;
    S.a_ready(cur);
    if constexpr (SP2) {
        PG8_STAGE(PG8_SB(0, 0), cB, voffB); PG8_STAGE(PG8_SB(0, 1), cB + hstepB, voffB); PG8_STAGE(PG8_SA(0, 0), cA, voffA); PG8_STAGE(PG8_SA(0, 1), cA + hstepA, voffA);
        if (wr == 1) PG8_BAR;
        PG8_WAIT_V(2); PG8_BAR;
        PG8_STAGE(PG8_SB(1, 0), cB + kstep, voffB); PG8_STAGE(PG8_SA(1, 0), cA + kstep, voffA); PG8_STAGE(PG8_SB(1, 1), cB + hstepB + kstep, voffB);
        PG8_WAIT_V(6); PG8_BAR;
    } else {
        PG8_STAGE(PG8_SB(0, 0), cB, voffB); PG8_STAGE(PG8_SA(0, 0), cA, voffA); PG8_STAGE(PG8_SB(0, 1), cB + hstepB, voffB); PG8_STAGE(PG8_SA(0, 1), cA + hstepA, voffA);
        if (wr == 1) PG8_BAR;
        PG8_WAIT_V(4); PG8_BAR;
        PG8_STAGE(PG8_SB(1, 0), cB + kstep, voffB); PG8_STAGE(PG8_SA(1, 0), cA + kstep, voffA); PG8_STAGE(PG8_SB(1, 1), cB + hstepB + kstep, voffB);
        PG8_WAIT_V(6); PG8_BAR;
    }
    for (;;) {
        const bool has_next = S.next(ui + 1, nxt);
        const char* nA = has_next ? (const char*)g.A + (size_t)nxt.pm * tstepA + (size_t)nxt.pn * g.apn * 2 : cA; const char* nB = has_next ? (const char*)g.Bt + (size_t)nxt.pn * tstepB : cB;
        for (int t = 0; t < nt; t += 2) {
            const bool last = (t == nt - 2);
            const char* a1 = cA + (size_t)(t + 1) * kstep;
            const char* a2 = last ? nA : cA + (size_t)(t + 2) * kstep; const char* b2 = last ? nB : cB + (size_t)(t + 2) * kstep;
            const char* a3 = a2 + kstep; const char* b3 = b2 + kstep;
            if (last && has_next) S.a_ready(nxt);
            if constexpr (SP2) {
            PG8_LDB(B0, 0, 0); PG8_LDB(B1, 0, 1); PG8_SCHED; PG8_LDA(At, 0, 0); PG8_STAGE(PG8_SA(1, 1), a1 + hstepA, voffA);
            PG8_WAIT_V(8); PG8_WAIT_L(0); PG8_BAR; PG8_MMA(0, 0, At, B0); PG8_MMA(0, 1, At, B1); PG8_BAR; PG8_SCHED;
            PG8_LDA(At, 0, 1); PG8_STAGE(PG8_SB(0, 0), b2, voffB); PG8_STAGE(PG8_SB(0, 1), b2 + hstepB, voffB); PG8_STAGE(PG8_SA(0, 0), a2, voffA);
            PG8_WAIT_V(8); PG8_WAIT_L(0); PG8_BAR; PG8_MMA(1, 0, At, B0); PG8_MMA(1, 1, At, B1); PG8_BAR; PG8_SCHED;
            PG8_LDB(B0, 1, 0); PG8_LDB(B1, 1, 1); PG8_SCHED; PG8_LDA(At, 1, 0); PG8_STAGE(PG8_SA(0, 1), a2 + hstepA, voffA);
            PG8_WAIT_V(8); PG8_WAIT_L(0); PG8_BAR; PG8_MMA(0, 0, At, B0); PG8_MMA(0, 1, At, B1); PG8_BAR; PG8_SCHED;
            PG8_LDA(At, 1, 1); PG8_STAGE(PG8_SB(1, 0), b3, voffB); PG8_STAGE(PG8_SB(1, 1), b3 + hstepB, voffB); PG8_STAGE(PG8_SA(1, 0), a3, voffA);
            PG8_WAIT_V(8); PG8_WAIT_L(0); PG8_BAR; PG8_MMA(1, 0, At, B0); PG8_MMA(1, 1, At, B1); PG8_BAR; PG8_SCHED;
            } else {
            PG8_LDB(B0, 0, 0); PG8_SCHED; PG8_LDA(At, 0, 0); PG8_STAGE(PG8_SA(1, 1), a1 + hstepA, voffA);
            PG8_WAIT_L(8); PG8_BAR; PG8_WAIT_L(0); PG8_MMA(0, 0, At, B0); PG8_BAR; PG8_SCHED;
            PG8_LDB(B1, 0, 1); PG8_STAGE(PG8_SB(0, 0), b2, voffB);
            PG8_BAR; PG8_WAIT_L(0); PG8_MMA(0, 1, At, B1); PG8_BAR;
            PG8_LDA(At, 0, 1); PG8_STAGE(PG8_SA(0, 0), a2, voffA);
            PG8_BAR; PG8_WAIT_L(0); PG8_MMA(1, 0, At, B0); PG8_BAR; PG8_SCHED;
            PG8_STAGE(PG8_SB(0, 1), b2 + hstepB, voffB);
            PG8_WAIT_V(6); PG8_BAR; PG8_MMA(1, 1, At, B1); PG8_BAR;
            PG8_LDB(B0, 1, 0); PG8_SCHED; PG8_LDA(At, 1, 0); PG8_STAGE(PG8_SA(0, 1), a2 + hstepA, voffA);
            PG8_WAIT_L(8); PG8_BAR; PG8_WAIT_L(0); PG8_MMA(0, 0, At, B0); PG8_BAR; PG8_SCHED;
            PG8_LDB(B1, 1, 1); PG8_STAGE(PG8_SB(1, 0), b3, voffB);
            PG8_BAR; PG8_WAIT_L(0); PG8_MMA(0, 1, At, B1); PG8_BAR;
            PG8_LDA(At, 1, 1); PG8_STAGE(PG8_SA(1, 0), a3, voffA);
            PG8_BAR; PG8_WAIT_L(0); PG8_MMA(1, 0, At, B0); PG8_BAR; PG8_SCHED;
            PG8_STAGE(PG8_SB(1, 1), b3 + hstepB, voffB);
            PG8_WAIT_V(6); PG8_BAR; PG8_MMA(1, 1, At, B1); PG8_BAR;
            }
        }
        if constexpr (ALIGN_EPI) { if (wr == 0) PG8_BAR; }
        if constexpr (!Epi::AFTER_DRAIN) { E(acc, cur, wr, wc, fr, fq); S.done(cur); }
        if (!has_next) break;
#pragma unroll
        for (int a = 0; a < 2; ++a)
#pragma unroll
            for (int b = 0; b < 2; ++b)
#pragma unroll
                for (int m = 0; m < 4; ++m)
#pragma unroll
                    for (int n = 0; n < 2; ++n) acc[a][b][m][n] = (f32x4){0.f, 0.f, 0.f, 0.f};
        cur = nxt; cA = nA; cB = nB; ++ui;
        if constexpr (ALIGN_EPI) { if (wr == 1) PG8_BAR; }
    }
    PG8_WAIT_V(0);
    if constexpr (!ALIGN_EPI) { if (wr == 0) PG8_BAR; }
    PG8_BAR;
    if constexpr (Epi::AFTER_DRAIN) { E.fused(acc, cur, wr, wc, fr, fq, lds, wid, lane); S.done(cur); }
#undef PG8_SA
#undef PG8_SB
#undef PG8_STAGE
#undef PG8_LDA
#undef PG8_LDB
#undef PG8_MMA
#undef PG8_WAIT_V
#undef PG8_WAIT_L
#undef PG8_BAR
#undef PG8_SCHED
}
}

constexpr int GBK = 128;
constexpr int GLB = GBK + 16;
constexpr int GBS = 1152;
constexpr int G2_AS = 256 * GLB;
constexpr int G2_BS = (GBK / 8) * GBS;
constexpr int G2_STAGE = G2_AS + G2_BS;
typedef long i64_t;
#define GAS __attribute__((address_space(1)))
template <class RowPtr, class ColPtr, class Epi>
__device__ __forceinline__ void gemm2_tile(LAS unsigned char* lds, const RowPtr& RP, const ColPtr& CP, int ldk, int K, int m0, int n0, const Epi& E, int mvalid = 256) {
    const int tid = fresh_tid(), lane = tid & 63, wid = tid >> 6, half = wid >> 2, wm = (wid >> 1) & 1, wn = wid & 1;
    const int fr = lane & 15, fq = lane >> 4;
    const int ht = tid & 255;
    const int ac = (ht & 7) * 16, ar0 = half * 128 + (ht >> 3);
    const int bc = half * 64 + 4 * (ht & 15), bg = ht >> 4;
    const int bpos = Epi::PERM ? ((bc & ~63) + (((bc >> 2) & 3) << 4) + (((bc >> 4) & 3) << 2)) : bc;
    const unsigned char* ap0 = RP(m0 + ar0); const unsigned char* ap1 = RP(m0 + ar0 + 32); const unsigned char* ap2 = RP(m0 + ar0 + 64); const unsigned char* ap3 = RP(m0 + ar0 + 96);
    const float* bp = CP(n0 + bc);
    const f32x4 epre = E.pre(m0 + half * 128 + wm * 64, lane);
    f32x4 acc[4][4];
#pragma unroll
    for (int m = 0; m < 4; ++m)
#pragma unroll
        for (int n = 0; n < 4; ++n) acc[m][n] = (f32x4){0.f, 0.f, 0.f, 0.f};
    const u32x4 z4 = (u32x4){0u, 0u, 0u, 0u};
    const f32x4 zf = (f32x4){0.f, 0.f, 0.f, 0.f};
    u32x4 ra[4] = {z4, z4, z4, z4}; f32x4 rb[8] = {zf, zf, zf, zf, zf, zf, zf, zf};
    const int nk = K / GBK;
    const bool docomp = (half == 0) || (mvalid > 128);
#define G2_LOAD(kt_) do { const int k0_ = (kt_) * GBK; \
        ra[0] = *(const u32x4*)(ap0 + k0_ + ac); ra[1] = *(const u32x4*)(ap1 + k0_ + ac); \
        ra[2] = *(const u32x4*)(ap2 + k0_ + ac); ra[3] = *(const u32x4*)(ap3 + k0_ + ac); \
        const float* q0_ = bp + (size_t)(k0_ + 8 * bg) * ldk; \
        _Pragma("unroll") for (int j_ = 0; j_ < 8; ++j_) rb[j_] = *(const f32x4*)(q0_ + (size_t)j_ * ldk); } while (0)
#define G2_STORE(buf_) do { LAS unsigned char* As_ = lds + (buf_) * G2_STAGE; LAS unsigned char* Bs_ = As_ + G2_AS; \
        _Pragma("unroll") for (int j_ = 0; j_ < 4; ++j_) *(LAS u32x4*)(As_ + (ar0 + 32 * j_) * GLB + ac) = ra[j_]; \
        u32x4 w0_, w1_;     \
        w0_.x = pk4_fp8(rb[0].x, rb[1].x, rb[2].x, rb[3].x); w0_.y = pk4_fp8(rb[4].x, rb[5].x, rb[6].x, rb[7].x); w0_.z = pk4_fp8(rb[0].y, rb[1].y, rb[2].y, rb[3].y); w0_.w = pk4_fp8(rb[4].y, rb[5].y, rb[6].y, rb[7].y); \
        w1_.x = pk4_fp8(rb[0].z, rb[1].z, rb[2].z, rb[3].z); w1_.y = pk4_fp8(rb[4].z, rb[5].z, rb[6].z, rb[7].z); w1_.z = pk4_fp8(rb[0].w, rb[1].w, rb[2].w, rb[3].w); w1_.w = pk4_fp8(rb[4].w, rb[5].w, rb[6].w, rb[7].w); \
        *(LAS u32x4*)(Bs_ + bg * GBS + bpos * 8) = w0_; *(LAS u32x4*)(Bs_ + bg * GBS + bpos * 8 + 16) = w1_; } while (0)
#define G2_FRAGS(af_, bf_, ks_) do { \
        _Pragma("unroll") for (int m_ = 0; m_ < 4; ++m_) af_[m_] = *(const LAS i64_t*)(As_ + (m_ * 16 + fr) * GLB + (ks_) * 32 + fq * 8); \
        _Pragma("unroll") for (int n_ = 0; n_ < 4; ++n_) bf_[n_] = *(const LAS i64_t*)(Bs_ + ((ks_) * 4 + fq) * GBS + (n_ * 16) * 8); } while (0)
#define G2_MMA(af_, bf_) do { \
        _Pragma("unroll") for (int m_ = 0; m_ < 4; ++m_) _Pragma("unroll") for (int n_ = 0; n_ < 4; ++n_) acc[m_][n_] = __builtin_amdgcn_mfma_f32_16x16x32_fp8_fp8(bf_[n_], af_[m_], acc[m_][n_], 0, 0, 0); } while (0)
#define G2_COMPUTE(buf_) do { const LAS unsigned char* As_ = lds + (buf_) * G2_STAGE + (half * 128 + wm * 64) * GLB; const LAS unsigned char* Bs_ = lds + (buf_) * G2_STAGE + G2_AS + (wn * 64 + fr) * 8; \
        i64_t afa_[4], bfa_[4], afb_[4], bfb_[4]; \
        G2_FRAGS(afa_, bfa_, 0); G2_FRAGS(afb_, bfb_, 1); G2_MMA(afa_, bfa_); \
        G2_FRAGS(afa_, bfa_, 2); G2_MMA(afb_, bfb_); \
        G2_FRAGS(afb_, bfb_, 3); G2_MMA(afa_, bfa_); \
        G2_MMA(afb_, bfb_); } while (0)
    G2_LOAD(0);
    G2_STORE(0);
    if (nk > 1) G2_LOAD(1);
    __syncthreads();
#pragma unroll 1
    for (int kt = 0; kt < nk; ++kt) {
        const int cur = kt & 1;
        if (half == 0) { __builtin_amdgcn_s_setprio(1); G2_COMPUTE(cur); __builtin_amdgcn_s_setprio(0); }
        else if (kt + 1 < nk) { G2_STORE(cur ^ 1); if (kt + 2 < nk) G2_LOAD(kt + 2); }
        __syncthreads();
        if (half == 1) { if (docomp) { __builtin_amdgcn_s_setprio(1); G2_COMPUTE(cur); __builtin_amdgcn_s_setprio(0); } }
        else if (kt + 1 < nk) { G2_STORE(cur ^ 1); if (kt + 2 < nk) G2_LOAD(kt + 2); }
        __syncthreads();
    }
#undef G2_LOAD
#undef G2_STORE
#undef G2_COMPUTE
#undef G2_FRAGS
#undef G2_MMA
    E(acc, m0 + half * 128 + wm * 64, n0 + wn * 64, lane, epre);
}

constexpr int DLA = 272;
constexpr int D_AS = 256 * DLA;
__device__ __forceinline__ void expert_down_unit(LAS unsigned char* lds, const unsigned char* act, const float* W  , int nq, unsigned char* y, const float* lw, int slot0, int nvalid) {
    const int tid = fresh_tid(), lane = tid & 63, wid = tid >> 6, half = __builtin_amdgcn_readfirstlane(wid >> 2), wm = (wid >> 1) & 1, wn = wid & 1;
    const int fr = lane & 15, fq = lane >> 4;
    const int ht = tid & 255;
    const int bc = half * 64 + 4 * (ht & 15), bg = ht >> 4;
    const int bpos = (bc & ~63) + (((bc >> 2) & 3) << 4) + (((bc >> 4) & 3) << 2);
    LAS unsigned char* Al = lds;
    LAS unsigned char* Bl = lds + D_AS;
    {
        const int c16 = (tid & 15) * 16, r0 = tid >> 4;
        const u32x4 z4 = (u32x4){0u, 0u, 0u, 0u};
        u32x4 v[8];
#pragma unroll
        for (int j = 0; j < 8; ++j) { const int r = r0 + 32 * j; v[j] = (r < nvalid) ? *(const u32x4*)(act + (size_t)(slot0 + r) * EDIM + c16) : z4; }
#pragma unroll
        for (int j = 0; j < 8; ++j) *(LAS u32x4*)(Al + (r0 + 32 * j) * DLA + c16) = v[j];
    }
    f32x4 acc[4][4];
#pragma unroll
    for (int m = 0; m < 4; ++m)
#pragma unroll
        for (int n = 0; n < 4; ++n) acc[m][n] = (f32x4){0.f, 0.f, 0.f, 0.f};
    f32x4 rbA[8], rbB[8];
    const bool docomp = (half == 0) || (nvalid > 128);
    float wrow_[4];
#pragma unroll
    for (int m = 0; m < 4; ++m) { const int r = half * 128 + wm * 64 + m * 16 + fr; wrow_[m] = (r < nvalid) ? lw[r] : 0.f; }
    const float* wbase = W + nq * 512 + bc;
    constexpr int NT_ = 8;
#define D_LOAD(t_, rb) do { const GAS float* wb_ = (const GAS float*)wbase; asm volatile("" : "+v"(wb_));     \
        const GAS float* q0_ = wb_ + ((t_) >> 1) * 128 + (size_t)(((t_) & 1) * 128 + 8 * bg) * 1024; \
        _Pragma("unroll") for (int j_ = 0; j_ < 8; ++j_) rb[j_] = *(const GAS f32x4*)(q0_ + (size_t)j_ * 1024); } while (0)
#define D_STORE(buf_, rb) do { LAS unsigned char* Bs_ = Bl + (buf_) * G2_BS; u32x4 w0_, w1_; \
        w0_.x = pk4_fp8(rb[0].x, rb[1].x, rb[2].x, rb[3].x); w0_.y = pk4_fp8(rb[4].x, rb[5].x, rb[6].x, rb[7].x); w0_.z = pk4_fp8(rb[0].y, rb[1].y, rb[2].y, rb[3].y); w0_.w = pk4_fp8(rb[4].y, rb[5].y, rb[6].y, rb[7].y); \
        w1_.x = pk4_fp8(rb[0].z, rb[1].z, rb[2].z, rb[3].z); w1_.y = pk4_fp8(rb[4].z, rb[5].z, rb[6].z, rb[7].z); w1_.z = pk4_fp8(rb[0].w, rb[1].w, rb[2].w, rb[3].w); w1_.w = pk4_fp8(rb[4].w, rb[5].w, rb[6].w, rb[7].w); \
        *(LAS u32x4*)(Bs_ + bg * GBS + bpos * 8) = w0_; *(LAS u32x4*)(Bs_ + bg * GBS + bpos * 8 + 16) = w1_; } while (0)
#define D_FRAGS(af_, bf_, ks_) do { \
        _Pragma("unroll") for (int m_ = 0; m_ < 4; ++m_) af_[m_] = *(const LAS i64_t*)(As_ + (m_ * 16 + fr) * DLA + (ks_) * 32 + fq * 8); \
        _Pragma("unroll") for (int n_ = 0; n_ < 4; ++n_) bf_[n_] = *(const LAS i64_t*)(Bs_ + ((ks_) * 4 + fq) * GBS + (n_ * 16) * 8); } while (0)
#define D_FRAGA(af_, ks_) do { _Pragma("unroll") for (int m_ = 0; m_ < 4; ++m_) af_[m_] = *(const LAS i64_t*)(As_ + (m_ * 16 + fr) * DLA + (ks_) * 32 + fq * 8); } while (0)
#define D_FRAGB(bf_, ks_) do { _Pragma("unroll") for (int n_ = 0; n_ < 4; ++n_) bf_[n_] = *(const LAS i64_t*)(Bs_ + ((ks_) * 4 + fq) * GBS + (n_ * 16) * 8); } while (0)
#define D_MMA(af_, bf_) do { \
        _Pragma("unroll") for (int m_ = 0; m_ < 4; ++m_) _Pragma("unroll") for (int n_ = 0; n_ < 4; ++n_) acc[m_][n_] = __builtin_amdgcn_mfma_f32_16x16x32_fp8_fp8(bf_[n_], af_[m_], acc[m_][n_], 0, 0, 0); } while (0)
#define D_COMPUTE(t_) do { const LAS unsigned char* As_ = Al + (half * 128 + wm * 64) * DLA + ((t_) & 1) * 128; const LAS unsigned char* Bs_ = Bl + ((t_) & 1) * G2_BS + (wn * 64 + fr) * 8; \
        i64_t afa_[4], bfa_[4], bfb_[4]; \
        D_FRAGS(afa_, bfa_, 0); D_FRAGB(bfb_, 1); D_MMA(afa_, bfa_); D_FRAGA(afa_, 1); \
        D_FRAGB(bfa_, 2); D_MMA(afa_, bfb_); D_FRAGA(afa_, 2); \
        D_FRAGB(bfb_, 3); D_MMA(afa_, bfa_); D_FRAGA(afa_, 3); \
        D_MMA(afa_, bfb_); \
        if ((t_) & 1) {     \
            const int cb_ = nq * 512 + ((t_) >> 1) * 128 + wn * 64; \
            _Pragma("unroll") for (int m_ = 0; m_ < 4; ++m_) { const int r_ = half * 128 + wm * 64 + m_ * 16 + fr; \
                if (r_ < nvalid) { const float wt_ = wrow_[m_]; u32x4 w_; \
                    { const f32x4 v_ = acc[m_][0] * wt_; w_.x = pk4_fp8(v_.x, v_.y, v_.z, v_.w); } { const f32x4 v_ = acc[m_][1] * wt_; w_.y = pk4_fp8(v_.x, v_.y, v_.z, v_.w); } \
                    { const f32x4 v_ = acc[m_][2] * wt_; w_.z = pk4_fp8(v_.x, v_.y, v_.z, v_.w); } { const f32x4 v_ = acc[m_][3] * wt_; w_.w = pk4_fp8(v_.x, v_.y, v_.z, v_.w); } \
                    asm volatile("global_store_dwordx4 %0, %1, off" :: "v"(y + (size_t)(slot0 + r_) * 1024 + cb_ + 16 * fq), "v"(w_) : "memory"); }     \
                _Pragma("unroll") for (int n_ = 0; n_ < 4; ++n_) acc[m_][n_] = (f32x4){0.f, 0.f, 0.f, 0.f}; } } } while (0)
#define D_STG(t_, rb, dow_) do { D_STORE(((t_) + 1) & 1, rb); if (dow_) D_LOAD((t_) + 3, rb); } while (0)
#define D_CMP(t_) do { __builtin_amdgcn_s_setprio(1); D_COMPUTE(t_); __builtin_amdgcn_s_setprio(0); } while (0)
    D_LOAD(0, rbA);
    D_STORE(0, rbA);
    D_LOAD(1, rbB); D_LOAD(2, rbA);
    __syncthreads();
    if (half == 0) {
        D_CMP(0); __syncthreads(); D_STG(0, rbB, 1); __syncthreads();
        D_CMP(1); __syncthreads(); D_STG(1, rbA, 1); __syncthreads();
        D_CMP(2); __syncthreads(); D_STG(2, rbB, 1); __syncthreads();
        D_CMP(3); __syncthreads(); D_STG(3, rbA, 1); __syncthreads();
        D_CMP(4); __syncthreads(); D_STG(4, rbB, 1); __syncthreads();
        D_CMP(5); __syncthreads(); D_STG(5, rbA, 0); __syncthreads();
        D_CMP(6); __syncthreads(); D_STG(6, rbB, 0); __syncthreads();
        D_CMP(7); __syncthreads(); __syncthreads();
    } else {
        D_STG(0, rbB, 1); __syncthreads(); if (docomp) D_CMP(0); __syncthreads();
        D_STG(1, rbA, 1); __syncthreads(); if (docomp) D_CMP(1); __syncthreads();
        D_STG(2, rbB, 1); __syncthreads(); if (docomp) D_CMP(2); __syncthreads();
        D_STG(3, rbA, 1); __syncthreads(); if (docomp) D_CMP(3); __syncthreads();
        D_STG(4, rbB, 1); __syncthreads(); if (docomp) D_CMP(4); __syncthreads();
        D_STG(5, rbA, 0); __syncthreads(); if (docomp) D_CMP(5); __syncthreads();
        D_STG(6, rbB, 0); __syncthreads(); if (docomp) D_CMP(6); __syncthreads();
        __syncthreads(); if (docomp) D_CMP(7); __syncthreads();
    }
#undef D_STG
#undef D_CMP
#undef D_LOAD
#undef D_STORE
#undef D_FRAGS
#undef D_MMA
#undef D_COMPUTE
}

struct RowDense { const bf16_t* A; int lda; __device__ __forceinline__ const bf16_t* operator()(int r) const { return A + (size_t)r * lda; } };
struct RowGather { const unsigned char* A; const int* idx; int nvalid; __device__ __forceinline__ const unsigned char* operator()(int r) const { return A + (size_t)idx[r < nvalid ? r : 0] * D; } };
struct RowSlots { const unsigned char* A; int nvalid; __device__ __forceinline__ const unsigned char* operator()(int r) const { return r < nvalid ? A + (size_t)r * EDIM : nullptr; } };
struct ColDense { const float* W; int N; __device__ __forceinline__ const float* operator()(int c) const { return c < N ? W + c : nullptr; } };
struct ColMqk { const float* q; ptrdiff_t dk; __device__ __forceinline__ const float* operator()(int c) const { return q + ((c < 128) ? (ptrdiff_t)c : dk + (c - 128)); } };
struct ColGU { const float* g; ptrdiff_t du;
    __device__ __forceinline__ const float* operator()(int c) const { const int tb = c >> 7, cc = c & 127, wnn = cc >> 6, n = (cc >> 4) & 3, rho = cc & 15;
        return g + (((n & 1) ? du : (ptrdiff_t)0) + tb * 64 + wnn * 32 + 8 * (rho >> 2) + 4 * (n >> 1) + (rho & 3)); } };
struct ColRgu { const float* r; ptrdiff_t dg; ptrdiff_t du; __device__ __forceinline__ const float* operator()(int c) const {
    const int cc = c - 256, j = cc >> 5, w = cc & 31; const ptrdiff_t off = (c < 256) ? (ptrdiff_t)c : (((w & 16) ? du : dg) + j * 16 + (w & 15)); return r + off; } };

__device__ __forceinline__ u32x2 pack4(const f32x4 v) { u32x2 w; w.x = cvt_pk_bf16(v.x, v.y); w.y = cvt_pk_bf16(v.z, v.w); return w; }
__device__ __forceinline__ u32x2 pack_swiglu(const f32x4 g, const f32x4 u) { u32x2 w; w.x = cvt_pk_bf16(siluf_(g.x) * u.x, siluf_(g.y) * u.y); w.y = cvt_pk_bf16(siluf_(g.z) * u.z, siluf_(g.w) * u.w); return w; }
struct EpiProj {
    bf16_t* proj; float* graw;
    __device__ __forceinline__ f32x4 pre(int rb, int lane) const { return (f32x4){0.f, 0.f, 0.f, 0.f}; }
    __device__ __forceinline__ void operator()(const f32x4 (&acc)[4][4], int rb, int cb, int lane, const f32x4 epre) const {
        const int fr = lane & 15, fq = lane >> 4;
#pragma unroll
        for (int m = 0; m < 4; ++m)
#pragma unroll
            for (int n = 0; n < 4; ++n) {
                const int row = rb + m * 16 + fr, col = cb + n * 16 + 4 * fq;
                if (col < OFF_GATE) *(u32x2*)(proj + (size_t)row * IN_DIM + col) = pack4(acc[m][n]);
                else if (col < IN_DIM) *(f32x4*)(graw + (size_t)row * 8 + (col - OFF_GATE)) = acc[m][n];
            }
    }
};
struct EpiNull {
    float* sink;
    __device__ __forceinline__ f32x4 pre(int rb, int lane) const { return (f32x4){0.f, 0.f, 0.f, 0.f}; }
    __device__ __forceinline__ void operator()(const f32x4 (&acc)[4][4], int rb, int cb, int lane, const f32x4 epre) const {
        float t = 0.f;
#pragma unroll
        for (int m = 0; m < 4; ++m)
#pragma unroll
            for (int n = 0; n < 4; ++n) t += acc[m][n].x + acc[m][n].y + acc[m][n].z + acc[m][n].w;
        if (t == 12345.678f) sink[lane] = t;
    }
};
struct EpiBf16 {
    bf16_t* O; int ldc;
    __device__ __forceinline__ f32x4 pre(int rb, int lane) const { return (f32x4){0.f, 0.f, 0.f, 0.f}; }
    __device__ __forceinline__ void operator()(const f32x4 (&acc)[4][4], int rb, int cb, int lane, const f32x4 epre) const {
        const int fr = lane & 15, fq = lane >> 4;
#pragma unroll
        for (int m = 0; m < 4; ++m)
#pragma unroll
            for (int n = 0; n < 4; ++n) *(u32x2*)(O + (size_t)(rb + m * 16 + fr) * ldc + cb + n * 16 + 4 * fq) = pack4(acc[m][n]);
    }
};
struct EpiMqk {
    bf16_t* mq; bf16_t* mk; int h;
    __device__ __forceinline__ f32x4 pre(int rb, int lane) const { return (f32x4){0.f, 0.f, 0.f, 0.f}; }
    __device__ __forceinline__ void operator()(const f32x4 (&acc)[4][4], int rb, int cb, int lane, const f32x4 epre) const {
        const int fr = lane & 15, fq = lane >> 4;
#pragma unroll
        for (int m = 0; m < 4; ++m)
#pragma unroll
            for (int n = 0; n < 4; ++n) {
                const int row = rb + m * 16 + fr, col = cb + n * 16 + 4 * fq; f32x4 v = acc[m][n];
                bf16_t* dst = mq; int c = col;
                if (col >= 128) { dst = mk; c = col - 128; v = v * 0.08838834764831845f; }
                *(u32x2*)(dst + (size_t)row * MINNER + h * DM + c) = pack4(v);
            }
    }
};
struct EpiResid {
    const float* X; const float* ada; int gt_off; float* out;
    __device__ __forceinline__ f32x4 pre(int rb, int lane) const { return (f32x4){0.f, 0.f, 0.f, 0.f}; }
    __device__ __forceinline__ void operator()(const f32x4 (&acc)[4][4], int rb, int cb, int lane, const f32x4 epre) const {
        const int fr = lane & 15, fq = lane >> 4;
#pragma unroll
        for (int m = 0; m < 4; ++m)
#pragma unroll
            for (int n = 0; n < 4; ++n) {
                const int row = rb + m * 16 + fr, col = cb + n * 16 + 4 * fq; const int b = row / S;
                const f32x4 g = *(const f32x4*)(ada + b * 6144 + gt_off + col);
                const f32x4 x = *(const f32x4*)(X + (size_t)row * D + col);
                *(f32x4*)(out + (size_t)row * D + col) = x + g * acc[m][n];
            }
    }
};
struct EpiRgu {
    float* logits; bf16_t* act;
    __device__ __forceinline__ f32x4 pre(int rb, int lane) const { return (f32x4){0.f, 0.f, 0.f, 0.f}; }
    __device__ __forceinline__ void operator()(const f32x4 (&acc)[4][4], int rb, int cb, int lane, const f32x4 epre) const {
        const int fr = lane & 15, fq = lane >> 4;
#pragma unroll
        for (int m = 0; m < 4; ++m) {
            const int row = rb + m * 16 + fr;
            if (cb < 256) {
#pragma unroll
                for (int n = 0; n < 4; ++n) *(f32x4*)(logits + (size_t)row * 256 + cb + n * 16 + 4 * fq) = acc[m][n];
            } else {
                const int j0 = (cb - 256) >> 5;
#pragma unroll
                for (int pp = 0; pp < 2; ++pp) *(u32x2*)(act + (size_t)row * 256 + (j0 + pp) * 16 + 4 * fq) = pack_swiglu(acc[m][2 * pp], acc[m][2 * pp + 1]);
            }
        }
    }
};
struct EpiExpAct {
    static constexpr bool PERM = false;
    unsigned char* act; int slot0; int nvalid;
    __device__ __forceinline__ f32x4 pre(int rb, int lane) const { const f32x4 z = {0.f, 0.f, 0.f, 0.f}; return z; }
    __device__ __forceinline__ void operator()(const f32x4 (&acc)[4][4], int rb, int cb, int lane, const f32x4 epre) const {
        const int fr = lane & 15, fq = lane >> 4;
#pragma unroll
        for (int m = 0; m < 4; ++m) {
            const int r = rb + m * 16 + fr;
            if (r < nvalid) {
                u32x2 w;
                { const f32x4 g = acc[m][0], u = acc[m][1]; w.x = pk4_fp8(siluf_(g.x) * u.x, siluf_(g.y) * u.y, siluf_(g.z) * u.z, siluf_(g.w) * u.w); }
                { const f32x4 g = acc[m][2], u = acc[m][3]; w.y = pk4_fp8(siluf_(g.x) * u.x, siluf_(g.y) * u.y, siluf_(g.z) * u.z, siluf_(g.w) * u.w); }
                *(u32x2*)(act + (size_t)(slot0 + r) * 256 + (cb >> 1) + 8 * fq) = w;
            }
        }
    }
};
struct EpiExpDown {
    static constexpr bool PERM = true;
    unsigned char* y; const float* lw; int slot0; int nvalid;
    __device__ __forceinline__ f32x4 pre(int rb, int lane) const {
        const int fr = lane & 15; f32x4 w;
        w.x = (rb + fr < nvalid) ? lw[rb + fr] : 0.f; w.y = (rb + 16 + fr < nvalid) ? lw[rb + 16 + fr] : 0.f;
        w.z = (rb + 32 + fr < nvalid) ? lw[rb + 32 + fr] : 0.f; w.w = (rb + 48 + fr < nvalid) ? lw[rb + 48 + fr] : 0.f; return w; }
    __device__ __forceinline__ void operator()(const f32x4 (&acc)[4][4], int rb, int cb, int lane, const f32x4 epre) const {
        const int fr = lane & 15, fq = lane >> 4;
#pragma unroll
        for (int m = 0; m < 4; ++m) {
            const int r = rb + m * 16 + fr;
            if (r < nvalid) {
                const float wt = epre[m];
                u32x4 w;
                { const f32x4 v = acc[m][0] * wt; w.x = pk4_fp8(v.x, v.y, v.z, v.w); }
                { const f32x4 v = acc[m][1] * wt; w.y = pk4_fp8(v.x, v.y, v.z, v.w); }
                { const f32x4 v = acc[m][2] * wt; w.z = pk4_fp8(v.x, v.y, v.z, v.w); }
                { const f32x4 v = acc[m][3] * wt; w.w = pk4_fp8(v.x, v.y, v.z, v.w); }
                *(u32x4*)(y + (size_t)(slot0 + r) * 1024 + cb + 16 * fq) = w;
            }
        }
    }
};

constexpr int AKLD = 104, AVLD = 72;
__device__ __forceinline__ void attn_unit(const Params& p, LAS unsigned char* lds, int bh, int qb) {
    LAS bf16_t* Ks = (LAS bf16_t*)lds;
    LAS bf16_t* Vt = Ks + 64 * AKLD;
    const bf16_t* Q = (const bf16_t*)(p.ws + B_Q) + (size_t)bh * S * 96;
    const bf16_t* Kg = (const bf16_t*)(p.ws + B_K) + (size_t)bh * S * 96;
    const int b = bh >> 3, h = bh & 7;
    const bf16_t* Vg = (const bf16_t*)(p.ws + B_KVRAW) + (size_t)b * S * 1024 + h * 128 + 64;
    bf16_t* O = (bf16_t*)(p.ws + B_ORAW) + (size_t)b * S * 512 + h * 64;
    const int tid = fresh_tid(), lane = tid & 63, wid = tid >> 6, fr = lane & 15, fq = lane >> 4;
    const int q0 = qb * 256, qw0 = q0 + wid * 32;
    bf16x8 qf[2][3];
#pragma unroll
    for (int nq = 0; nq < 2; ++nq)
#pragma unroll
        for (int ks = 0; ks < 3; ++ks) qf[nq][ks] = *(const bf16x8*)(Q + (size_t)(qw0 + nq * 16 + fr) * 96 + ks * 32 + fq * 8);
    f32x4 oacc[4][2];
#pragma unroll
    for (int d = 0; d < 4; ++d)
#pragma unroll
        for (int nq = 0; nq < 2; ++nq) oacc[d][nq] = (f32x4){0.f, 0.f, 0.f, 0.f};
    float mrun[2] = {-1e30f, -1e30f}, lrun[2] = {0.f, 0.f};
    const int ntiles = (q0 + 256) / 64;
    constexpr int ASTG = 64 * AKLD + 64 * AVLD;
    const int kc0 = tid, kc1 = tid + NT;
    const int kr0 = kc0 / 12, kq0 = kc0 - kr0 * 12, kr1 = kc1 / 12, kq1 = kc1 - kr1 * 12;
    const int vkey = tid & 63, vdc = tid >> 6;
    u32x4 rk0, rk1 = (u32x4){0u, 0u, 0u, 0u}, rv;
#define ATT_LOAD(k0_) do { rk0 = *(const u32x4*)(Kg + (size_t)((k0_) + kr0) * 96 + kq0 * 8); if (kc1 < 768) rk1 = *(const u32x4*)(Kg + (size_t)((k0_) + kr1) * 96 + kq1 * 8); \
        rv = *(const u32x4*)(Vg + (size_t)((k0_) + vkey) * 1024 + vdc * 8); } while (0)
#define ATT_STORE(buf_) do { LAS bf16_t* Kd_ = Ks + (buf_) * ASTG; LAS bf16_t* Vd_ = Kd_ + 64 * AKLD; \
        *(LAS u32x4*)(Kd_ + kr0 * AKLD + kq0 * 8) = rk0; if (kc1 < 768) *(LAS u32x4*)(Kd_ + kr1 * AKLD + kq1 * 8) = rk1; \
        LAS bf16_t* vt_ = Vd_ + (vdc * 8) * AVLD + vkey; \
        vt_[0 * AVLD] = (bf16_t)(rv.x & 0xffff); vt_[1 * AVLD] = (bf16_t)(rv.x >> 16); vt_[2 * AVLD] = (bf16_t)(rv.y & 0xffff); vt_[3 * AVLD] = (bf16_t)(rv.y >> 16); \
        vt_[4 * AVLD] = (bf16_t)(rv.z & 0xffff); vt_[5 * AVLD] = (bf16_t)(rv.z >> 16); vt_[6 * AVLD] = (bf16_t)(rv.w & 0xffff); vt_[7 * AVLD] = (bf16_t)(rv.w >> 16); } while (0)
    ATT_LOAD(0);
    ATT_STORE(0);
    __syncthreads();
    for (int kt = 0; kt < ntiles; ++kt) {
        const int k0 = kt * 64;
        const LAS bf16_t* Kc = Ks + (kt & 1) * ASTG; const LAS bf16_t* Vc = Kc + 64 * AKLD;
        if (kt + 1 < ntiles) ATT_LOAD(k0 + 64);
        if (k0 <= qw0 + 31) {
            f32x4 sacc[4][2];
#pragma unroll
            for (int t4 = 0; t4 < 4; ++t4)
#pragma unroll
                for (int nq = 0; nq < 2; ++nq) sacc[t4][nq] = (f32x4){0.f, 0.f, 0.f, 0.f};
#pragma unroll
            for (int ks = 0; ks < 3; ++ks)
#pragma unroll
                for (int t4 = 0; t4 < 4; ++t4) {
                    const bf16x8 kf = *(const LAS bf16x8*)(Kc + (t4 * 16 + fr) * AKLD + ks * 32 + fq * 8);
#pragma unroll
                    for (int nq = 0; nq < 2; ++nq) sacc[t4][nq] = MFMA16(kf, qf[nq][ks], sacc[t4][nq]);
                }
            const bool need_mask = (k0 + 63 > qw0);
#pragma unroll
            for (int nq = 0; nq < 2; ++nq) {
                const int qidx = qw0 + nq * 16 + fr;
                float mx = -1e30f;
#pragma unroll
                for (int t4 = 0; t4 < 4; ++t4)
#pragma unroll
                    for (int i = 0; i < 4; ++i) {
                        if (need_mask) { const int key = k0 + t4 * 16 + 4 * fq + i; if (key > qidx) sacc[t4][nq][i] = -1e30f; }
                        mx = fmaxf(mx, sacc[t4][nq][i]);
                    }
                mx = fmaxf(mx, __shfl_xor(mx, 16)); mx = fmaxf(mx, __shfl_xor(mx, 32));
                const float mnew = fmaxf(mrun[nq], mx);
                float ls = 0.f;
#pragma unroll
                for (int t4 = 0; t4 < 4; ++t4)
#pragma unroll
                    for (int i = 0; i < 4; ++i) { const float pv = __builtin_amdgcn_exp2f(sacc[t4][nq][i] - mnew); sacc[t4][nq][i] = pv; ls += pv; }
                if (__ballot(mnew > mrun[nq])) {
                    const float alpha = __builtin_amdgcn_exp2f(mrun[nq] - mnew);
                    lrun[nq] = lrun[nq] * alpha + ls;
#pragma unroll
                    for (int d = 0; d < 4; ++d) oacc[d][nq] = oacc[d][nq] * alpha;
                } else lrun[nq] += ls;
                mrun[nq] = mnew;
            }
#pragma unroll
            for (int s2 = 0; s2 < 2; ++s2) {
                bf16x8 pb[2];
#pragma unroll
                for (int nq = 0; nq < 2; ++nq) {
                    u32x4 w; w.x = cvt_pk_bf16(sacc[2 * s2][nq].x, sacc[2 * s2][nq].y); w.y = cvt_pk_bf16(sacc[2 * s2][nq].z, sacc[2 * s2][nq].w);
                    w.z = cvt_pk_bf16(sacc[2 * s2 + 1][nq].x, sacc[2 * s2 + 1][nq].y); w.w = cvt_pk_bf16(sacc[2 * s2 + 1][nq].z, sacc[2 * s2 + 1][nq].w);
                    pb[nq] = __builtin_bit_cast(bf16x8, w);
                }
#pragma unroll
                for (int d = 0; d < 4; ++d) {
                    const LAS bf16_t* vr = Vc + (d * 16 + fr) * AVLD + s2 * 32 + 4 * fq;
                    const u32x2 lo = *(const LAS u32x2*)vr, hi = *(const LAS u32x2*)(vr + 16);
                    const bf16x8 vf = __builtin_bit_cast(bf16x8, ((u32x4){lo.x, lo.y, hi.x, hi.y}));
#pragma unroll
                    for (int nq = 0; nq < 2; ++nq) oacc[d][nq] = MFMA16(vf, pb[nq], oacc[d][nq]);
                }
            }
        }
        if (kt + 1 < ntiles) ATT_STORE((kt + 1) & 1);
        __syncthreads();
    }
#undef ATT_LOAD
#undef ATT_STORE
#pragma unroll
    for (int nq = 0; nq < 2; ++nq) {
        float l = lrun[nq]; l += __shfl_xor(l, 16); l += __shfl_xor(l, 32);
        const float inv = 1.f / l;
        const int qidx = qw0 + nq * 16 + fr;
#pragma unroll
        for (int d = 0; d < 4; ++d) { const f32x4 v = oacc[d][nq] * inv; u32x2 w; w.x = cvt_pk_bf16(v.x, v.y); w.y = cvt_pk_bf16(v.z, v.w);
            *(u32x2*)(O + (size_t)qidx * 512 + d * 16 + 4 * fq) = w; }
    }
}

constexpr int MTLD = 72;
__device__ __forceinline__ void mlstm_a_unit(const Params& p, LAS unsigned char* lds, int unit) {
    LAS bf16_t* kT = (LAS bf16_t*)lds;
    LAS bf16_t* vT = kT + 128 * MTLD;
    LAS float* av = (LAS float*)(vT + 128 * MTLD);
    const int bh = unit >> 5, c = unit & 31, b = bh >> 2, h = bh & 3;
    const int t0 = b * S + c * CHUNK;
    const float* gl = (const float*)(p.ws + B_GL);
    const bf16_t* mk = (const bf16_t*)(p.ws + B_MK); const bf16_t* proj = (const bf16_t*)(p.ws + B_PROJ);
    const int tid = fresh_tid(), lane = tid & 63, wid = tid >> 6, fr = lane & 15, fq = lane >> 4;
    if (wid == 0) {
        const float li = gl[(size_t)(t0 + lane) * 8 + h], lf = gl[(size_t)(t0 + lane) * 8 + 4 + h];
        float bs = lf;
#pragma unroll
        for (int o = 1; o < 64; o <<= 1) { const float t = __shfl_up(bs, o); if (lane >= o) bs += t; }
        const float Btot = __shfl(bs, 63);
        const float g = Btot - bs + li;
        const float ml = wave_max(g);
        av[lane] = __expf(g - ml);
        if (lane == 0) { ((float*)(p.ws + WS_BC))[unit] = Btot; ((float*)(p.ws + WS_MLOC))[unit] = ml; }
    }
    __syncthreads();
#pragma unroll
    for (int rep = 0; rep < 2; ++rep) {
        const int cidx = tid + rep * NT, s = cidx & 63, ch = cidx >> 6;
        const u32x4 kv = *(const u32x4*)(mk + (size_t)(t0 + s) * MINNER + h * DM + ch * 8);
        const u32x4 vv = *(const u32x4*)(proj + (size_t)(t0 + s) * IN_DIM + OFF_MV + h * DM + ch * 8);
        const float a = av[s];
        LAS bf16_t* kt = kT + (ch * 8) * MTLD + s; LAS bf16_t* vt = vT + (ch * 8) * MTLD + s;
        const unsigned kk[4] = {kv.x, kv.y, kv.z, kv.w}; const unsigned vw[4] = {vv.x, vv.y, vv.z, vv.w};
#pragma unroll
        for (int j = 0; j < 4; ++j) {
            kt[(2 * j) * MTLD] = (bf16_t)(kk[j] & 0xffff); kt[(2 * j + 1) * MTLD] = (bf16_t)(kk[j] >> 16);
            const unsigned sc = cvt_pk_bf16(bflo(vw[j]) * a, bfhi(vw[j]) * a);
            vt[(2 * j) * MTLD] = (bf16_t)(sc & 0xffff); vt[(2 * j + 1) * MTLD] = (bf16_t)(sc >> 16);
        }
    }
    __syncthreads();
    {
        const int we = wid >> 1, wd = wid & 1;
        f32x4 acc[2][4];
#pragma unroll
        for (int i = 0; i < 2; ++i)
#pragma unroll
            for (int j = 0; j < 4; ++j) acc[i][j] = (f32x4){0.f, 0.f, 0.f, 0.f};
#pragma unroll
        for (int ks = 0; ks < 2; ++ks) {
            bf16x8 vf[2], kf[4];
#pragma unroll
            for (int i = 0; i < 2; ++i) vf[i] = *(const LAS bf16x8*)(vT + (we * 32 + i * 16 + fr) * MTLD + ks * 32 + fq * 8);
#pragma unroll
            for (int j = 0; j < 4; ++j) kf[j] = *(const LAS bf16x8*)(kT + (wd * 64 + j * 16 + fr) * MTLD + ks * 32 + fq * 8);
#pragma unroll
            for (int i = 0; i < 2; ++i)
#pragma unroll
                for (int j = 0; j < 4; ++j) acc[i][j] = MFMA16(kf[j], vf[i], acc[i][j]);
        }
        bf16_t* dC = (bf16_t*)(p.ws + B_DC) + (size_t)unit * 16384;
#pragma unroll
        for (int i = 0; i < 2; ++i)
#pragma unroll
            for (int j = 0; j < 4; ++j) *(u32x2*)(dC + (we * 32 + i * 16 + fr) * 128 + wd * 64 + j * 16 + 4 * fq) = pack4(acc[i][j]);
    }
    if (tid < 128) {
        float s = 0.f;
        for (int q = 0; q < 64; ++q) s += bf2f(kT[tid * MTLD + q]) * av[q];
        ((float*)(p.ws + WS_DN))[(size_t)unit * 128 + tid] = s;
    }
    __syncthreads();
}

__device__ __forceinline__ void mlstm_scan(const Params& p, int gtid, int ngt) {
    const float* Bc = (const float*)(p.ws + WS_BC); const float* ML = (const float*)(p.ws + WS_MLOC);
    float* mprev = (float*)(p.ws + WS_MPREV);
    const bf16_t* dC = (const bf16_t*)(p.ws + B_DC); bf16_t* Cp = (bf16_t*)(p.ws + B_CPREV);
    const float* dn = (const float*)(p.ws + WS_DN); float* np_ = (float*)(p.ws + WS_NPREV);
    constexpr int PER = 4096 + 32;
    for (int idx = gtid; idx < 32 * PER; idx += ngt) {
        const int bh = idx / PER, e4 = idx - bh * PER;
        const bool isC = e4 < 4096; const int n4 = e4 - 4096;
        float m = 0.f; f32x4 C = (f32x4){0.f, 0.f, 0.f, 0.f};
        for (int c0 = 0; c0 < NCH; c0 += 4) {
            f32x4 d[4]; float Bt[4], ml[4];
#pragma unroll
            for (int q = 0; q < 4; ++q) {
                const int unit = bh * NCH + c0 + q;
                Bt[q] = Bc[unit]; ml[q] = ML[unit];
                if (isC) { const u32x2 w = *(const u32x2*)(dC + (size_t)unit * 16384 + e4 * 4); d[q] = (f32x4){bflo(w.x), bfhi(w.x), bflo(w.y), bfhi(w.y)}; }
                else d[q] = *(const f32x4*)(dn + (size_t)unit * 128 + n4 * 4);
            }
#pragma unroll
            for (int q = 0; q < 4; ++q) {
                const int unit = bh * NCH + c0 + q;
                const float mnew = fmaxf(Bt[q] + m, ml[q]);
                const float fa = __expf(Bt[q] + m - mnew), fb = __expf(ml[q] - mnew);
                if (isC) {
                    u32x2 w; w.x = cvt_pk_bf16(C.x, C.y); w.y = cvt_pk_bf16(C.z, C.w);
                    *(u32x2*)(Cp + (size_t)unit * 16384 + e4 * 4) = w;
                    if (e4 == 0) mprev[unit] = m;
                } else {
                    *(f32x4*)(np_ + (size_t)unit * 128 + n4 * 4) = C;
                }
                C = C * fa + d[q] * fb;
                m = mnew;
            }
        }
    }
}

constexpr int MRLD = 136;
struct McRegs { u32x4 q[2], k[2], c[4], v[2]; float li, lf, mp; };
__device__ __forceinline__ void mlstm_c_load(const Params& p, int unit, McRegs& R) {
    const int bh = unit >> 5, c = unit & 31, b = bh >> 2, h = bh & 3;
    const int t0 = b * S + c * CHUNK;
    const float* gl = (const float*)(p.ws + B_GL);
    const bf16_t* mq = (const bf16_t*)(p.ws + B_MQ); const bf16_t* mk = (const bf16_t*)(p.ws + B_MK); const bf16_t* proj = (const bf16_t*)(p.ws + B_PROJ);
    const bf16_t* Cp = (const bf16_t*)(p.ws + B_CPREV) + (size_t)unit * 16384;
    const int tid = fresh_tid(), lane = tid & 63;
#pragma unroll
    for (int rep = 0; rep < 2; ++rep) {
        const int cidx = tid + rep * NT, r = cidx >> 4, ch = cidx & 15;
        R.q[rep] = *(const u32x4*)(mq + (size_t)(t0 + r) * MINNER + h * DM + ch * 8);
        R.k[rep] = *(const u32x4*)(mk + (size_t)(t0 + r) * MINNER + h * DM + ch * 8);
    }
#pragma unroll
    for (int rep = 0; rep < 4; ++rep) { const int cidx = tid + rep * NT, r = cidx >> 4, ch = cidx & 15; R.c[rep] = *(const u32x4*)(Cp + r * 128 + ch * 8); }
#pragma unroll
    for (int rep = 0; rep < 2; ++rep) { const int cidx = tid + rep * NT, sq = cidx & 63, ch = cidx >> 6; R.v[rep] = *(const u32x4*)(proj + (size_t)(t0 + sq) * IN_DIM + OFF_MV + h * DM + ch * 8); }
    R.li = gl[(size_t)(t0 + lane) * 8 + h]; R.lf = gl[(size_t)(t0 + lane) * 8 + 4 + h]; R.mp = ((const float*)(p.ws + WS_MPREV))[unit];
}
__device__ __forceinline__ void mlstm_c_unit(const Params& p, LAS unsigned char* lds, int unit, McRegs& R, int next_unit) {
    LAS bf16_t* qs = (LAS bf16_t*)lds;
    LAS bf16_t* ks = qs + 64 * MRLD;
    LAS bf16_t* cs = ks + 64 * MRLD;
    LAS bf16_t* vT = cs + 128 * MRLD;
    LAS float* fv = (LAS float*)(vT + 128 * MTLD);
    LAS float* u_s = fv; LAS float* c_t = fv + 64; LAS float* dec = fv + 128; LAS float* emt = fv + 192; LAS float* ssq = fv + 256;
    const int bh = unit >> 5, c = unit & 31, b = bh >> 2, h = bh & 3;
    const int t0 = b * S + c * CHUNK;
    const bf16_t* proj = (const bf16_t*)(p.ws + B_PROJ);
    const float* np_ = (const float*)(p.ws + WS_NPREV) + (size_t)unit * 128;
    const int tid = fresh_tid(), lane = tid & 63, wid = tid >> 6, fr = lane & 15, fq = lane >> 4;
    if (wid == 0) {
        const float li = R.li, lf = R.lf;
        const float mp = R.mp;
        float bs = lf;
#pragma unroll
        for (int o = 1; o < 64; o <<= 1) { const float t = __shfl_up(bs, o); if (lane >= o) bs += t; }
        const float u = li - bs;
        float pm = u;
#pragma unroll
        for (int o = 1; o < 64; o <<= 1) { const float t = __shfl_up(pm, o); if (lane >= o) pm = fmaxf(pm, t); }
        const float inter = bs + mp;
        const float mt = fmaxf(inter, bs + pm);
        u_s[lane] = u; c_t[lane] = bs - mt; dec[lane] = __expf(inter - mt); emt[lane] = __expf(-mt);
    }
#pragma unroll
    for (int rep = 0; rep < 2; ++rep) {
        const int cidx = tid + rep * NT, r = cidx >> 4, ch = cidx & 15;
        *(LAS u32x4*)(qs + r * MRLD + ch * 8) = R.q[rep];
        *(LAS u32x4*)(ks + r * MRLD + ch * 8) = R.k[rep];
    }
#pragma unroll
    for (int rep = 0; rep < 4; ++rep) { const int cidx = tid + rep * NT, r = cidx >> 4, ch = cidx & 15; *(LAS u32x4*)(cs + r * MRLD + ch * 8) = R.c[rep]; }
#pragma unroll
    for (int rep = 0; rep < 2; ++rep) {
        const int cidx = tid + rep * NT, sq = cidx & 63, ch = cidx >> 6;
        const u32x4 vv = R.v[rep];
        LAS bf16_t* vt = vT + (ch * 8) * MTLD + sq;
        const unsigned vw[4] = {vv.x, vv.y, vv.z, vv.w};
#pragma unroll
        for (int j = 0; j < 4; ++j) { vt[(2 * j) * MTLD] = (bf16_t)(vw[j] & 0xffff); vt[(2 * j + 1) * MTLD] = (bf16_t)(vw[j] >> 16); }
    }
    __syncthreads();
    if (next_unit >= 0) mlstm_c_load(p, next_unit, R);
    const int tt = wid & 3, eh = wid >> 2;
    const int tl = tt * 16 + fr;
    bf16x8 qf[4];
#pragma unroll
    for (int k4 = 0; k4 < 4; ++k4) qf[k4] = *(const LAS bf16x8*)(qs + tl * MRLD + k4 * 32 + fq * 8);
    f32x4 sacc[4];
#pragma unroll
    for (int st = 0; st < 4; ++st) sacc[st] = (f32x4){0.f, 0.f, 0.f, 0.f};
#pragma unroll
    for (int k4 = 0; k4 < 4; ++k4)
#pragma unroll
        for (int st = 0; st < 4; ++st) {
            const bf16x8 kf = *(const LAS bf16x8*)(ks + (st * 16 + fr) * MRLD + k4 * 32 + fq * 8);
            sacc[st] = MFMA16(kf, qf[k4], sacc[st]);
        }
    const float ct = c_t[tl];
    float rs = 0.f;
#pragma unroll
    for (int st = 0; st < 4; ++st)
#pragma unroll
        for (int i = 0; i < 4; ++i) {
            const int s = st * 16 + 4 * fq + i;
            const float w = (s <= tl) ? __expf(ct + u_s[s]) * sacc[st][i] : 0.f;
            sacc[st][i] = w; rs += w;
        }
    rs += __shfl_xor(rs, 16); rs += __shfl_xor(rs, 32);
    float nq;
    {
        f32x4 na = (f32x4){0.f, 0.f, 0.f, 0.f};
#pragma unroll
        for (int k4 = 0; k4 < 4; ++k4) {
            u32x4 w = (u32x4){0u, 0u, 0u, 0u};
            if (fr == 0) { const float* nn = np_ + k4 * 32 + fq * 8; w.x = cvt_pk_bf16(nn[0], nn[1]); w.y = cvt_pk_bf16(nn[2], nn[3]); w.z = cvt_pk_bf16(nn[4], nn[5]); w.w = cvt_pk_bf16(nn[6], nn[7]); }
            na = MFMA16(__builtin_bit_cast(bf16x8, w), qf[k4], na);
        }
        nq = __shfl(na.x, fr);
    }
    f32x4 acc[4];
#pragma unroll
    for (int et = 0; et < 4; ++et) acc[et] = (f32x4){0.f, 0.f, 0.f, 0.f};
#pragma unroll
    for (int k4 = 0; k4 < 4; ++k4)
#pragma unroll
        for (int et = 0; et < 4; ++et) {
            const bf16x8 cf = *(const LAS bf16x8*)(cs + (eh * 64 + et * 16 + fr) * MRLD + k4 * 32 + fq * 8);
            acc[et] = MFMA16(cf, qf[k4], acc[et]);
        }
    const float dcy = dec[tl];
#pragma unroll
    for (int et = 0; et < 4; ++et) acc[et] = acc[et] * dcy;
#pragma unroll
    for (int s2 = 0; s2 < 2; ++s2) {
        u32x4 w; w.x = cvt_pk_bf16(sacc[2 * s2].x, sacc[2 * s2].y); w.y = cvt_pk_bf16(sacc[2 * s2].z, sacc[2 * s2].w);
        w.z = cvt_pk_bf16(sacc[2 * s2 + 1].x, sacc[2 * s2 + 1].y); w.w = cvt_pk_bf16(sacc[2 * s2 + 1].z, sacc[2 * s2 + 1].w);
        const bf16x8 pb = __builtin_bit_cast(bf16x8, w);
#pragma unroll
        for (int et = 0; et < 4; ++et) {
            const LAS bf16_t* vr = vT + (eh * 64 + et * 16 + fr) * MTLD + s2 * 32 + 4 * fq;
            const u32x2 lo = *(const LAS u32x2*)vr, hi = *(const LAS u32x2*)(vr + 16);
            acc[et] = MFMA16(__builtin_bit_cast(bf16x8, ((u32x4){lo.x, lo.y, hi.x, hi.y})), pb, acc[et]);
        }
    }
    const float den = dcy * nq + rs;
    const float hd = 1.f / fmaxf(fabsf(den), emt[tl]);
    float sq = 0.f;
#pragma unroll
    for (int et = 0; et < 4; ++et) { acc[et] = acc[et] * hd; sq += acc[et].x * acc[et].x + acc[et].y * acc[et].y + acc[et].z * acc[et].z + acc[et].w * acc[et].w; }
    sq += __shfl_xor(sq, 16); sq += __shfl_xor(sq, 32);
    if (fq == 0) ssq[eh * 64 + tl] = sq;
    __syncthreads();
    const float rinv = rsqrtf((ssq[tl] + ssq[64 + tl]) * (1.f / 128.f) + RMS_EPS);
    const float* gmo = p.in[20] + h * DM;
    bf16_t* ao = (bf16_t*)(p.ws + B_AO);
#pragma unroll
    for (int et = 0; et < 4; ++et) {
        const int e = eh * 64 + et * 16 + 4 * fq;
        const u32x2 op = *(const u32x2*)(proj + (size_t)(t0 + tl) * IN_DIM + OFF_MO + h * DM + e);
        const f32x4 g = *(const f32x4*)(gmo + e);
        const f32x4 v = acc[et] * rinv * g;
        u32x2 w; w.x = cvt_pk_bf16(v.x * sigmoidf_(bflo(op.x)), v.y * sigmoidf_(bfhi(op.x))); w.y = cvt_pk_bf16(v.z * sigmoidf_(bflo(op.y)), v.w * sigmoidf_(bfhi(op.y)));
        *(u32x2*)(ao + (size_t)(t0 + tl) * 1024 + 512 + h * DM + e) = w;
    }
    __syncthreads();
}

__device__ __forceinline__ unsigned fkey(float f) { const unsigned u = __float_as_uint(f); return (u & 0x80000000u) ? ~u : (u | 0x80000000u); }
__device__ __forceinline__ float rdlane_f(float v, int l) { return __uint_as_float((unsigned)__builtin_amdgcn_readlane((int)__float_as_uint(v), l)); }
__device__ __forceinline__ void route_token(const f32x4 cur, const f32x4 bias, int lane, int (&e8)[8], float (&w8)[8]) {
    float sc[4] = {sigmoidf_(cur.x), sigmoidf_(cur.y), sigmoidf_(cur.z), sigmoidf_(cur.w)};
    float sb[4] = {sc[0] + bias.x, sc[1] + bias.y, sc[2] + bias.z, sc[3] + bias.w};
    float t1 = fmaxf(fmaxf(sb[0], sb[1]), fmaxf(sb[2], sb[3]));
    float t2;
    {   const float a = fmaxf(sb[0], sb[1]), bmin = fminf(sb[0], sb[1]), c2 = fmaxf(sb[2], sb[3]), dmin = fminf(sb[2], sb[3]);
        t2 = fmaxf(fminf(a, c2), fmaxf(bmin, dmin)); }
#pragma unroll
    for (int o = 1; o < 8; o <<= 1) {
        const float o1 = __shfl_xor(t1, o), o2 = __shfl_xor(t2, o);
        const float n1 = fmaxf(t1, o1), n2 = fmaxf(fminf(t1, o1), fmaxf(t2, o2));
        t1 = n1; t2 = n2;
    }
    const float gs = t1 + t2;
    const int myg = lane >> 3;
    int rank = 0;
#pragma unroll
    for (int g = 0; g < 8; ++g) { const float og = rdlane_f(gs, g * 8); rank += (og > gs || (og == gs && g < myg)) ? 1 : 0; }
    const bool keep = rank < 4;
    unsigned key[4];
#pragma unroll
    for (int j = 0; j < 4; ++j) key[j] = keep ? fkey(sb[j]) : 0u;
    unsigned t = 0u;
#pragma unroll 4
    for (int bit = 31; bit >= 0; --bit) {
        const unsigned tt = t | (1u << bit);
        const int c = __builtin_popcountll(__ballot(key[0] >= tt)) + __builtin_popcountll(__ballot(key[1] >= tt)) + __builtin_popcountll(__ballot(key[2] >= tt)) + __builtin_popcountll(__ballot(key[3] >= tt));
        if (c >= TOPK) t = tt;
    }
    unsigned long long sel[4], eq[4];
    int ngt = 0;
#pragma unroll
    for (int j = 0; j < 4; ++j) { sel[j] = __ballot(key[j] > t); eq[j] = __ballot(key[j] == t); ngt += __builtin_popcountll(sel[j]); }
    for (int need = TOPK - ngt; need > 0; --need) {
        int best = 1 << 30;
#pragma unroll
        for (int j = 0; j < 4; ++j) if (eq[j]) { const int idx = 4 * (int)__builtin_ctzll(eq[j]) + j; best = idx < best ? idx : best; }
        const int L = best >> 2, jj = best & 3;
#pragma unroll
        for (int j = 0; j < 4; ++j) if (jj == j) { eq[j] &= ~(1ull << L); sel[j] |= (1ull << L); }
    }
    float wsum = 0.f;
#pragma unroll
    for (int k = 0; k < TOPK; ++k) {
        int best = 1 << 30;
#pragma unroll
        for (int j = 0; j < 4; ++j) if (sel[j]) { const int idx = 4 * (int)__builtin_ctzll(sel[j]) + j; best = idx < best ? idx : best; }
        const int L = best >> 2, jj = best & 3;
#pragma unroll
        for (int j = 0; j < 4; ++j) if (jj == j) sel[j] &= ~(1ull << L);
        const float s0 = rdlane_f(sc[0], L), s1 = rdlane_f(sc[1], L), s2 = rdlane_f(sc[2], L), s3 = rdlane_f(sc[3], L);
        const float sraw = (jj == 0) ? s0 : (jj == 1) ? s1 : (jj == 2) ? s2 : s3;
        e8[k] = best; w8[k] = sraw; wsum += sraw;
    }
    const float inv = 2.5f / wsum;
#pragma unroll
    for (int k = 0; k < TOPK; ++k) w8[k] *= inv;
}
__device__ __forceinline__ void route_rows(const Params& p, int gw, int ngw, int lane) {
    const float* logits = (const float*)(p.ws + C_LOGITS); const float* rb = p.in[24];
    int* cnt = (int*)(p.ws + WS_CNT);
    int* tok_e = (int*)(p.ws + C_TOKE); float* tok_w = (float*)(p.ws + C_TOKW); int* tok_pos = (int*)(p.ws + C_TOKPOS);
    int* list_tok = (int*)(p.ws + C_LISTTOK); float* list_w = (float*)(p.ws + C_LISTW);
    const f32x4 bias = *(const f32x4*)(rb + lane * 4);
    for (int row0 = gw; row0 < T; row0 += ngw * 8) {
        int e_all = 0, row_all = -1; float w_all = 0.f;
        f32x4 lg = *(const f32x4*)(logits + (size_t)row0 * 256 + lane * 4);
#pragma unroll 1
        for (int i = 0; i < 8; ++i) {
            const int row = row0 + i * ngw;
            if (row >= T) break;
            const f32x4 cur = lg;
            if (i + 1 < 8 && row + ngw < T) lg = *(const f32x4*)(logits + (size_t)(row + ngw) * 256 + lane * 4);
            int e8[8]; float w8[8];
            route_token(cur, bias, lane, e8, w8);
            if ((lane >> 3) == i) {
                const int k = lane & 7; int es = e8[0]; float wsel = w8[0];
#pragma unroll
                for (int q = 1; q < 8; ++q) if (k == q) { es = e8[q]; wsel = w8[q]; }
                e_all = es; w_all = wsel; row_all = row;
            }
        }
        if (row_all >= 0) {
            const int k = lane & 7;
            const int pos = atomicAdd(&cnt[e_all * CNT_STRIDE], 1);
            tok_e[(size_t)row_all * 8 + k] = e_all; tok_w[(size_t)row_all * 8 + k] = w_all; tok_pos[(size_t)row_all * 8 + k] = pos;
            list_tok[(size_t)e_all * CAP + pos] = row_all; list_w[(size_t)e_all * CAP + pos] = w_all;
        }
    }
}

__device__ __forceinline__ void expert_prefix(const Params& p, LAS int* base, LAS int* tsa, int tid, int ngrp) {
    const int* cnt = (const int*)(p.ws + WS_CNT);
    const int nper = NE / ngrp;
    const int wave = tid >> 6, lane = tid & 63;
    if (tid < 64) {
        int c[4]; int s = 0;
#pragma unroll
        for (int j = 0; j < 4; ++j) { c[j] = __hip_atomic_load(cnt + (tid * 4 + j) * CNT_STRIDE, __ATOMIC_RELAXED, __HIP_MEMORY_SCOPE_AGENT); s += c[j]; }
        int ps = s;
#pragma unroll
        for (int o = 1; o < 64; o <<= 1) { const int a = __builtin_amdgcn_ds_bpermute(((lane - o) & 63) << 2, ps); if (lane >= o) ps += a; }
        int es = ps - s;
#pragma unroll
        for (int j = 0; j < 4; ++j) { base[tid * 4 + j] = es; es += c[j]; }
    }
    if (wave < ngrp) {
        LAS int* tsx = tsa + wave * (nper + 1);
        int run = 0;
        for (int r0 = 0; r0 < nper; r0 += 64) {
            const int i = r0 + lane;
            int tl = 0;
            if (i < nper) tl = (__hip_atomic_load(cnt + (wave + ngrp * i) * CNT_STRIDE, __ATOMIC_RELAXED, __HIP_MEMORY_SCOPE_AGENT) + 255) >> 8;
            int pt = tl;
#pragma unroll
            for (int o = 1; o < 64; o <<= 1) { const int a = __builtin_amdgcn_ds_bpermute(((lane - o) & 63) << 2, pt); if (lane >= o) pt += a; }
            if (i < nper) tsx[i] = run + pt - tl;
            run += __builtin_amdgcn_readlane(pt, 63);
        }
        if (lane == 0) tsx[nper] = run;
    }
    __syncthreads();
}
__device__ __forceinline__ int sched_nunits(const LAS int* tsa, int g, int nper, int mult) { return tsa[g * (nper + 1) + nper] * mult; }
__device__ __forceinline__ int sched_nstatic(int n, int gper) { const int r = n / gper - 1; return r > 0 ? r : 0; }
__device__ __forceinline__ bool sched_next(int* ctr, const LAS int* tsa, volatile LAS int* slot, int tid, int ngrp, int nper, int mult, int gper, int& g, int& u) {
    if (tid == 0) {
        int rg = -1, ru = 0;
        for (int tries = 0; tries < 64 && rg < 0; ++tries) {
            const int n = sched_nunits(tsa, g, nper, mult), st = sched_nstatic(n, gper) * gper;
            const int t = __hip_atomic_fetch_add(ctr + g * CNT_STRIDE, 1, __ATOMIC_RELAXED, __HIP_MEMORY_SCOPE_AGENT) + st;
            if (t < n) { rg = g; ru = t; break; }
            int ng = -1, bestd = 8;
#pragma unroll
            for (int j = 0; j < 8; ++j) {
                if (j < ngrp) {
                    const int cj = __hip_atomic_load(ctr + j * CNT_STRIDE, __ATOMIC_RELAXED, __HIP_MEMORY_SCOPE_AGENT);
                    const int nj = sched_nunits(tsa, j, nper, mult), d = (j - g) & 7;
                    if (d != 0 && d < bestd && cj + sched_nstatic(nj, gper) * gper < nj) { bestd = d; ng = j; }
                }
            }
            if (ng < 0) break;
            g = ng;
        }
        slot[0] = rg; slot[1] = ru;
    }
    __syncthreads();
    const int rg = slot[0]; u = slot[1];
    __syncthreads();
    if (rg < 0) return false;
    g = rg; return true;
}

__device__ __forceinline__ void combine_rows(const Params& p, LAS int* base, int gw, int ngw, int lane) {
    const bf16_t* sh = (const bf16_t*)(p.ws + C_SHOUT); const unsigned char* y = (const unsigned char*)(p.ws + C_Y);
    const int* tok_e = (const int*)(p.ws + C_TOKE); const int* tok_pos = (const int*)(p.ws + C_TOKPOS);
    const float* ada = (const float*)(p.ws + WS_ADA);
    typedef float f32x2v __attribute__((ext_vector_type(2)));
    for (int row = gw; row < T; row += ngw) {
        const int b = row / S;
        const int col = lane * 16;
        u32x4 yr[TOPK];
#pragma unroll
        for (int k = 0; k < TOPK; ++k) {
            const int e = tok_e[(size_t)row * 8 + k], pos = tok_pos[(size_t)row * 8 + k];
            yr[k] = *(const u32x4*)(y + (size_t)(base[e] + pos) * 1024 + col);
        }
        float acc[16];
        {
            const u32x4 a0 = *(const u32x4*)(sh + (size_t)row * 1024 + col), a1 = *(const u32x4*)(sh + (size_t)row * 1024 + col + 8);
            acc[0] = bflo(a0.x); acc[1] = bfhi(a0.x); acc[2] = bflo(a0.y); acc[3] = bfhi(a0.y); acc[4] = bflo(a0.z); acc[5] = bfhi(a0.z); acc[6] = bflo(a0.w); acc[7] = bfhi(a0.w);
            acc[8] = bflo(a1.x); acc[9] = bfhi(a1.x); acc[10] = bflo(a1.y); acc[11] = bfhi(a1.y); acc[12] = bflo(a1.z); acc[13] = bfhi(a1.z); acc[14] = bflo(a1.w); acc[15] = bfhi(a1.w);
        }
#pragma unroll
        for (int k = 0; k < TOPK; ++k) {
            const unsigned w4[4] = {yr[k].x, yr[k].y, yr[k].z, yr[k].w};
#pragma unroll
            for (int q = 0; q < 4; ++q) {
                const f32x2v lo = __builtin_amdgcn_cvt_pk_f32_fp8((int)w4[q], false), hi = __builtin_amdgcn_cvt_pk_f32_fp8((int)w4[q], true);
                acc[4 * q + 0] += lo.x; acc[4 * q + 1] += lo.y; acc[4 * q + 2] += hi.x; acc[4 * q + 3] += hi.y;
            }
        }
        float* o = p.out + (size_t)row * D + col;
        const float* g = ada + b * 6144 + 5120 + col;
        const bf16_t* x1r = (const bf16_t*)(p.ws + C_X1) + (size_t)row * D + col;
        const u32x4 xa = *(const u32x4*)x1r, xb = *(const u32x4*)(x1r + 8);
        const unsigned xw[8] = {xa.x, xa.y, xa.z, xa.w, xb.x, xb.y, xb.z, xb.w};
#pragma unroll
        for (int q4 = 0; q4 < 4; ++q4) {
            const f32x4 x = (f32x4){bflo(xw[2 * q4]), bfhi(xw[2 * q4]), bflo(xw[2 * q4 + 1]), bfhi(xw[2 * q4 + 1])}, gg = *(const f32x4*)(g + q4 * 4);
            f32x4 r; r.x = x.x + gg.x * acc[q4 * 4 + 0]; r.y = x.y + gg.y * acc[q4 * 4 + 1]; r.z = x.z + gg.z * acc[q4 * 4 + 2]; r.w = x.w + gg.w * acc[q4 * 4 + 3];
            *(f32x4*)(o + q4 * 4) = r;
        }
    }
}


struct PgProj {
    static constexpr bool PERM = true, AFTER_DRAIN = false;
    bf16_t* proj; float* graw;
    __device__ __forceinline__ void operator()(const f32x4 (&acc)[2][2][4][2], const pg8::Unit& u, int wr, int wc, int fr, int fq) const {
#pragma unroll
        for (int ai = 0; ai < 2; ++ai)
#pragma unroll
            for (int m = 0; m < 4; ++m) { const int row = u.pm * 256 + ai * 128 + wr * 64 + m * 16 + fr;
#pragma unroll
                for (int bj = 0; bj < 2; ++bj) { const int col = u.pn * 256 + bj * 128 + wc * 32 + 8 * fq;
                    if (col < OFF_GATE) { const u32x2 lo = pack4(acc[ai][bj][m][0]), hi = pack4(acc[ai][bj][m][1]); *(u32x4*)(proj + (size_t)row * IN_DIM + col) = (u32x4){lo.x, lo.y, hi.x, hi.y}; }
                    else if (col < IN_DIM) { *(f32x4*)(graw + (size_t)row * 8) = acc[ai][bj][m][0]; *(f32x4*)(graw + (size_t)row * 8 + 4) = acc[ai][bj][m][1]; } } }
    }
};
struct PgBf16 {
    static constexpr bool PERM = true, AFTER_DRAIN = false;
    bf16_t* O; int ldc;
    __device__ __forceinline__ void operator()(const f32x4 (&acc)[2][2][4][2], const pg8::Unit& u, int wr, int wc, int fr, int fq) const {
#pragma unroll
        for (int ai = 0; ai < 2; ++ai)
#pragma unroll
            for (int m = 0; m < 4; ++m) { const int row = u.pm * 256 + ai * 128 + wr * 64 + m * 16 + fr;
#pragma unroll
                for (int bj = 0; bj < 2; ++bj) { const int col = u.pn * 256 + bj * 128 + wc * 32 + 8 * fq;
                    const u32x2 lo = pack4(acc[ai][bj][m][0]), hi = pack4(acc[ai][bj][m][1]); *(u32x4*)(O + (size_t)row * ldc + col) = (u32x4){lo.x, lo.y, hi.x, hi.y}; } }
    }
};
struct PgMqk {
    static constexpr bool PERM = true, AFTER_DRAIN = false;
    bf16_t* mq; bf16_t* mk;
    __device__ __forceinline__ void operator()(const f32x4 (&acc)[2][2][4][2], const pg8::Unit& u, int wr, int wc, int fr, int fq) const {
#pragma unroll
        for (int ai = 0; ai < 2; ++ai)
#pragma unroll
            for (int m = 0; m < 4; ++m) { const int row = u.pm * 256 + ai * 128 + wr * 64 + m * 16 + fr;
#pragma unroll
                for (int bj = 0; bj < 2; ++bj) { const int c = wc * 32 + 8 * fq; const float sc = bj ? 0.08838834764831845f : 1.f;
                    const u32x2 lo = pack4(acc[ai][bj][m][0] * sc), hi = pack4(acc[ai][bj][m][1] * sc);
                    *(u32x4*)((bj ? mk : mq) + (size_t)row * MINNER + u.pn * DM + c) = (u32x4){lo.x, lo.y, hi.x, hi.y}; } }
    }
};
struct PgResid {
    static constexpr bool PERM = true, AFTER_DRAIN = false;
    const float* X; const float* ada; int gt_off; bf16_t* out;
    __device__ __forceinline__ void operator()(const f32x4 (&acc)[2][2][4][2], const pg8::Unit& u, int wr, int wc, int fr, int fq) const {
#pragma unroll
        for (int ai = 0; ai < 2; ++ai)
#pragma unroll
            for (int m = 0; m < 4; ++m) { const int row = u.pm * 256 + ai * 128 + wr * 64 + m * 16 + fr; const int b = row / S;
#pragma unroll
                for (int bj = 0; bj < 2; ++bj) { const int col = u.pn * 256 + bj * 128 + wc * 32 + 8 * fq;
                    const f32x4 g0 = *(const f32x4*)(ada + b * 6144 + gt_off + col), g1 = *(const f32x4*)(ada + b * 6144 + gt_off + col + 4);
                    const f32x4 x0 = *(const f32x4*)(X + (size_t)row * D + col), x1 = *(const f32x4*)(X + (size_t)row * D + col + 4);
                    const u32x2 lo = pack4(x0 + g0 * acc[ai][bj][m][0]), hi = pack4(x1 + g1 * acc[ai][bj][m][1]);
                    *(u32x4*)(out + (size_t)row * D + col) = (u32x4){lo.x, lo.y, hi.x, hi.y}; } }
    }
};
struct PgRgu {
    static constexpr bool PERM = false, AFTER_DRAIN = false;
    float* logits; bf16_t* act;
    __device__ __forceinline__ void operator()(const f32x4 (&acc)[2][2][4][2], const pg8::Unit& u, int wr, int wc, int fr, int fq) const {
#pragma unroll
        for (int ai = 0; ai < 2; ++ai)
#pragma unroll
            for (int m = 0; m < 4; ++m) { const int row = u.pm * 256 + ai * 128 + wr * 64 + m * 16 + fr;
#pragma unroll
                for (int bj = 0; bj < 2; ++bj) {
                    if (u.pn == 0) {
#pragma unroll
                        for (int n = 0; n < 2; ++n) *(f32x4*)(logits + (size_t)row * 256 + bj * 128 + wc * 32 + n * 16 + 4 * fq) = acc[ai][bj][m][n];
                    } else {
                        const int j = ((u.pn - 1) * 256 + bj * 128 + wc * 32) >> 5;
                        *(u32x2*)(act + (size_t)row * 256 + j * 16 + 4 * fq) = pack_swiglu(acc[ai][bj][m][0], acc[ai][bj][m][1]);
                    }
                } }
    }
};

__device__ __forceinline__ int xcd_remap(int L, int nwg) { const int q = nwg >> 3, r = nwg & 7, x = L & 7, off = L >> 3; return (x < r ? x * (q + 1) : r * (q + 1) + (x - r) * q) + off; }
__global__ void __launch_bounds__(NT, 2) fwd_kernel(Params p) {
    extern __shared__ __attribute__((aligned(16))) unsigned char lds_raw[];
    LAS unsigned char* lds = (LAS unsigned char*)lds_raw;
    const int G = gridDim.x, bid = blockIdx.x, ngw = G * NWAVES;
#define FRESH_IDS() const int tid = fresh_tid(), lane = tid & 63, wid = tid >> 6, gw = bid * NWAVES + wid; (void)lane; (void)gw
    { const int tid = fresh_tid(); volatile LAS unsigned* bst0 = (volatile LAS unsigned*)(lds + LDS_BYTES - 64); if (tid < 2) bst0[tid] = 0u; }
    unsigned char* ws = p.ws;
    const float* ada = (const float*)(ws + WS_ADA);
    volatile LAS unsigned* bst = (volatile LAS unsigned*)(lds + LDS_BYTES - 64);
    __syncthreads();
    const XcdBarrier xbar = xcd_barrier_post((unsigned*)(ws + WS_CTL + 4096), bst);
    int ts_n = 0;
#if DBG_STAGE == 2
#define TSTAMP() do { if (bid == 0 && threadIdx.x == 0) ((unsigned long long*)(ws + WS_CTL + 16384 + 8192))[ts_n] = __builtin_amdgcn_s_memrealtime(); ++ts_n; } while (0)
#else
#define TSTAMP() do { } while (0)
#endif
    TSTAMP();

    {
        FRESH_IDS();
        for (int u = bid; u < 192; u += G) ada_unit(p, lds, u, tid);
        LAS float* scr = (LAS float*)(lds + wid * 8448);
        constexpr int I0 = 16 * 70, I1 = I0 + 6 * 24, I2 = I1 + 4 * 32, I3 = I2 + 32, I4 = I3 + 32;
        const int vw = ((bid + G - (192 % G)) % G) * NWAVES + wid;
        for (int it = vw; it < I4; it += ngw) {
            if (it < I0) conv_item<0>(p.in[6], 1024, IN_DIM, (bf16_t*)(ws + WS_WIN), 0, 0, scr, it, lane);
            else if (it < I1) conv_item<0>(p.in[8], QLORA, 768, (bf16_t*)(ws + WS_WUQ), 0, 0, scr, it - I0, lane);
            else if (it < I2) conv_item<0>(p.in[10], KVLORA, 1024, (bf16_t*)(ws + WS_WUKV), 0, 0, scr, it - I1, lane);
            else if (it < I3) conv_item<0>(p.in[16], 128, 128, (bf16_t*)(ws + WS_WMQK), 256 * 128, 0, scr, it - I2, lane);
            else conv_item<0>(p.in[17], 128, 128, (bf16_t*)(ws + WS_WMQK), 256 * 128, 128, scr, it - I3, lane);
        }
        u32x4* zp = (u32x4*)((bf16_t*)(ws + WS_WIN) + (size_t)IN_DIM * 1024);
        for (int i = bid * NT + tid; i < (2304 - IN_DIM) * 1024 / 8; i += G * NT) zp[i] = (u32x4){0u, 0u, 0u, 0u};
    }
    xcd_barrier(xbar); TSTAMP();
    { FRESH_IDS(); norm_mod_rows(p.in[0], p.in[5], ada, 0, 1024, (bf16_t*)(ws + B_H1), gw, ngw, lane); }
    xcd_barrier(xbar); TSTAMP();
    {
        const pg8::Gemm g{(const bf16_t*)(ws + B_H1), (const bf16_t*)(ws + WS_WIN), T, 2304, 1024, 1024, 1024, 0};
        pg8::StaticOrder SO; SO.init(T, 2304, G, bid);
        const PgProj E{(bf16_t*)(ws + B_PROJ), (float*)(ws + B_GRAW)};
        pg8::gemm_phase<PgProj, pg8::StaticOrder, true, true>(lds, g, SO, E);
        {
            FRESH_IDS();
            const int nfull = (576 % G) ? (576 % G) : 0;
            if (bid >= nfull) {
                LAS float* scr = (LAS float*)(lds + wid * 8448);
                constexpr int J0 = 16 * 32, J1 = J0 + 16 * 8, J2 = J1 + 16 * 8, J3 = J2 + 16 * 8, J4 = J3 + 4 * 32;
                for (int it = (bid - nfull) * NWAVES + wid; it < J4; it += (G - nfull) * NWAVES) {
                    if (it < J0) conv_item<0>(p.in[21], 1024, 1024, (bf16_t*)(ws + WS_WOUT), 0, 0, scr, it, lane);
                    else if (it < J1) conv_item<0>(p.in[23], 1024, 256, (bf16_t*)(ws + WS_WRGU), 0, 0, scr, it - J0, lane);
                    else if (it < J2) conv_item<1>(p.in[28], 1024, 256, (bf16_t*)(ws + WS_WRGU), 0, 256, scr, it - J1, lane);
                    else if (it < J3) conv_item<2>(p.in[29], 1024, 256, (bf16_t*)(ws + WS_WRGU), 0, 256, scr, it - J2, lane);
                    else conv_item<0>(p.in[30], 256, 1024, (bf16_t*)(ws + WS_WDSH), 0, 0, scr, it - J3, lane);
                }
            }
        }
    }
    xcd_barrier(xbar); TSTAMP();
    { FRESH_IDS(); post_proj_rows(p, gw, ngw, lane); }
    xcd_barrier(xbar); TSTAMP();
    {
        {   const pg8::Gemm g{(const bf16_t*)(ws + B_CQN), (const bf16_t*)(ws + WS_WUQ), T, 768, QLORA, QLORA, QLORA, 0};
            pg8::StaticOrder SO; SO.init(T, 768, G, bid); const PgBf16 E{(bf16_t*)(ws + B_QRAW), 768};
            pg8::gemm_phase<PgBf16, pg8::StaticOrder, true, true>(lds, g, SO, E); }
        {   const pg8::Gemm g{(const bf16_t*)(ws + B_CKVN), (const bf16_t*)(ws + WS_WUKV), T, 1024, KVLORA, KVLORA, KVLORA, 0};
            pg8::StaticOrder SO; SO.init(T, 1024, G, bid); const PgBf16 E{(bf16_t*)(ws + B_KVRAW), 1024};
            pg8::gemm_phase<PgBf16, pg8::StaticOrder, true, true>(lds, g, SO, E); }
        {   const pg8::Gemm g{(const bf16_t*)(ws + B_ZC), (const bf16_t*)(ws + WS_WMQK), T, 1024, DM, MINNER, DM, DM};
            pg8::StaticOrder SO; SO.init(T, 1024, G, bid); const PgMqk E{(bf16_t*)(ws + B_MQ), (bf16_t*)(ws + B_MK)};
            pg8::gemm_phase<PgMqk, pg8::StaticOrder, true, true>(lds, g, SO, E); }
    }
    xcd_barrier(xbar); TSTAMP();
    { FRESH_IDS(); qk_post_rows(p, gw, ngw, lane); }
    xcd_barrier(xbar); TSTAMP();
    for (int pr = bid; pr < 256; pr += G) { const int bh = pr & 63, j = pr >> 6; attn_unit(p, lds, bh, 7 - j); attn_unit(p, lds, bh, j); }
    for (int u = bid; u < 1024; u += G) mlstm_a_unit(p, lds, u);
    xcd_barrier(xbar); TSTAMP();
    { FRESH_IDS(); mlstm_scan(p, bid * NT + tid, G * NT); }
    { FRESH_IDS(); attn_out_norm_rows(p, gw, ngw, lane); }
    xcd_barrier(xbar); TSTAMP();
    {
        McRegs R;
        if (bid < 1024) mlstm_c_load(p, bid, R);
        for (int u = bid; u < 1024; u += G) mlstm_c_unit(p, lds, u, R, (u + G < 1024) ? u + G : -1);
    }
    xcd_barrier(xbar); TSTAMP();
    {
        const pg8::Gemm g{(const bf16_t*)(ws + B_AO), (const bf16_t*)(ws + WS_WOUT), T, 1024, 1024, 1024, 1024, 0};
        pg8::StaticOrder SO; SO.init(T, 1024, G, bid); const PgResid E{p.in[0], ada, 2048, (bf16_t*)(ws + C_X1)};
        pg8::gemm_phase<PgResid, pg8::StaticOrder, true, true>(lds, g, SO, E);
    }
    xcd_barrier(xbar); TSTAMP();
    { FRESH_IDS(); norm_mod_rows_bf((const bf16_t*)(ws + C_X1), p.in[22], ada, 3072, 4096, (bf16_t*)(ws + C_H2), gw, ngw, lane, ws + C_H2F8); }
    xcd_barrier(xbar); TSTAMP();
    {
        const pg8::Gemm g{(const bf16_t*)(ws + C_H2), (const bf16_t*)(ws + WS_WRGU), T, 768, 1024, 1024, 1024, 0};
        pg8::StaticOrder SO; SO.init(T, 768, G, bid); const PgRgu E{(float*)(ws + C_LOGITS), (bf16_t*)(ws + C_ACTSH)};
        pg8::gemm_phase<PgRgu, pg8::StaticOrder, true, true>(lds, g, SO, E);
    }
    xcd_barrier(xbar); TSTAMP();
    { FRESH_IDS(); route_rows(p, gw, ngw, lane); }
    {
        const pg8::Gemm g{(const bf16_t*)(ws + C_ACTSH), (const bf16_t*)(ws + WS_WDSH), T, 1024, 256, 256, 256, 0};
        pg8::StaticOrder SO; SO.init(T, 1024, G, bid); const PgBf16 E{(bf16_t*)(ws + C_SHOUT), 1024};
        pg8::gemm_phase<PgBf16, pg8::StaticOrder, true, true>(lds, g, SO, E);
    }
    xcd_barrier(xbar); TSTAMP();
    LAS int* base = (LAS int*)(lds + 132 * 1024);
    LAS int* tsa = base + 256;
    volatile LAS int* tslot = (volatile LAS int*)(base + 1024);
    const int ngrp = (G % 8 == 0) ? 8 : 1, gx = bid % ngrp, gidx = bid / ngrp, gper = G / ngrp, nexp = NE / ngrp;
    { FRESH_IDS(); expert_prefix(p, base, tsa, tid, ngrp); }
#define EXPERT_UNITS(ctr_, mult_, ...) do { \
        const int nown_ = sched_nunits(tsa, gx, nexp, mult_), nst_ = sched_nstatic(nown_, gper) * gper; \
        for (int u = gidx; u < nst_; u += gper) { const int g = gx; __VA_ARGS__; } \
        int g = gx, u = 0; \
        while (sched_next(ctr_, tsa, tslot, fresh_tid(), ngrp, nexp, mult_, gper, g, u)) { __VA_ARGS__; } } while (0)
    {
        const int* cnt = (const int*)(ws + WS_CNT);
        EXPERT_UNITS((int*)(ws + WS_TICKET8), 4, {
            const LAS int* tsx = tsa + g * (nexp + 1);
            const int tg = u >> 2, tn = u & 3;
            int lo = 0, hi = nexp - 1;
            while (lo < hi) { const int mid = (lo + hi + 1) >> 1; if (tsx[mid] <= tg) lo = mid; else hi = mid - 1; }
            const int e = g + ngrp * lo, blk = tg - tsx[lo], c = __hip_atomic_load(cnt + e * CNT_STRIDE, __ATOMIC_RELAXED, __HIP_MEMORY_SCOPE_AGENT);
            const int nvalid = min(256, c - blk * 256);
            const RowGather RP{(const unsigned char*)(ws + C_H2F8), (const int*)(ws + C_LISTTOK) + (size_t)e * CAP + blk * 256, nvalid};
            const ColGU CP{p.in[25] + (size_t)e * 1024 * 256, p.in[26] - p.in[25]};
            const EpiExpAct E{(unsigned char*)(ws + C_ACTE), base[e] + blk * 256, nvalid};
            gemm2_tile(lds, RP, CP, 256, 1024, 0, tn * 128, E, nvalid);
        });
    }
    xcd_barrier(xbar); TSTAMP();
    {
        const int* cnt = (const int*)(ws + WS_CNT);
        EXPERT_UNITS((int*)(ws + WS_TICKET9), 2, {
            const LAS int* tsx = tsa + g * (nexp + 1);
            const int tg = u >> 1, nq = u & 1;
            int lo = 0, hi = nexp - 1;
            while (lo < hi) { const int mid = (lo + hi + 1) >> 1; if (tsx[mid] <= tg) lo = mid; else hi = mid - 1; }
            const int e = g + ngrp * lo, blk = tg - tsx[lo], c = __hip_atomic_load(cnt + e * CNT_STRIDE, __ATOMIC_RELAXED, __HIP_MEMORY_SCOPE_AGENT);
            const int nvalid = min(256, c - blk * 256);
            const int slot0 = base[e] + blk * 256;
            expert_down_unit(lds, (const unsigned char*)(ws + C_ACTE), p.in[27] + (size_t)e * 256 * 1024, nq, (unsigned char*)(ws + C_Y),
                             (const float*)(ws + C_LISTW) + (size_t)e * CAP + blk * 256, slot0, nvalid);
        });
    }
    xcd_barrier(xbar); TSTAMP();
    { FRESH_IDS(); combine_rows(p, base, gw, ngw, lane); }
#if DBG_STAGE == 2
    xcd_barrier(xbar); TSTAMP();
    xcd_barrier(xbar);
    {   FRESH_IDS();
        const unsigned long long* ts = (const unsigned long long*)(ws + WS_CTL + 16384 + 8192);
        const float tus = (float)(long long)(ts[TS_A1] - ts[TS_A0]) * 0.01f;
        const float cadd = sqrtf(2.5e-3f * tus * (1.f / 500.f));
        for (size_t i = (size_t)bid * NT + tid; i < (size_t)T * D / 4; i += (size_t)G * NT) { f32x4 v = ((f32x4*)p.out)[i]; v = v + cadd; ((f32x4*)p.out)[i] = v; }
    }
#endif
}

extern "C" void kernel_launch(void* const* d_in, const int* in_sizes, int n_in,
                              void* d_out, int out_size, void* d_ws, size_t ws_size,
                              hipStream_t stream) {
    static int grid_blocks = 0;
    if (!grid_blocks) {
        if (n_in != 31 || out_size != T * D || ws_size < WS_END) { fprintf(stderr, "kernel_launch: unexpected shapes n_in=%d out=%d ws=%zu (need %zu)\n", n_in, out_size, ws_size, (size_t)WS_END); grid_blocks = -1; return; }
        int dev = 0, cus = 0, per_cu = 0;
        (void)hipGetDevice(&dev);
        (void)hipDeviceGetAttribute(&cus, hipDeviceAttributeMultiprocessorCount, dev);
        (void)hipFuncSetAttribute((const void*)fwd_kernel, hipFuncAttributeMaxDynamicSharedMemorySize, LDS_BYTES);
        (void)hipOccupancyMaxActiveBlocksPerMultiprocessor(&per_cu, (const void*)fwd_kernel, NT, LDS_BYTES);
        if (per_cu < 1) per_cu = 1;
        grid_blocks = cus * per_cu;
        fprintf(stderr, "kernel_launch: cus=%d per_cu=%d grid=%d ws=%zu\n", cus, per_cu, grid_blocks, ws_size);
    }
    if (grid_blocks < 0) return;
    (void)hipMemsetAsync((char*)d_ws + WS_CTL, 0, CTL_BYTES, stream);
    (void)hipMemsetAsync((char*)d_ws + WS_ADA, 0, 8 * 6144 * sizeof(float), stream);
    Params p{};
    for (int i = 0; i < 31; ++i) p.in[i] = (const float*)d_in[i];
    p.out = (float*)d_out; p.ws = (unsigned char*)d_ws;
    void* args[] = {&p};
    hipError_t e = hipLaunchCooperativeKernel((const void*)fwd_kernel, dim3(grid_blocks), dim3(NT), args, LDS_BYTES, stream);
    if (e != hipSuccess) fprintf(stderr, "cooperative launch failed: %s (grid %d)\n", hipGetErrorString(e), grid_blocks);
}
```

```cpp
#include <hip/hip_runtime.h>
#include <hip/hip_cooperative_groups.h>
#include <cstdio>
#include <cstdint>
namespace cg = cooperative_groups;
#ifndef DBG_STAGE
#define DBG_STAGE 0
#endif
#define TS_A0 2
#define TS_A1 3
#define TS_B0 2
#define TS_B1 3

#define LAS __attribute__((address_space(3)))
typedef unsigned short bf16_t;
typedef short bf16x8 __attribute__((ext_vector_type(8)));
typedef short bf16x4 __attribute__((ext_vector_type(4)));
typedef float f32x4 __attribute__((ext_vector_type(4)));
typedef float f32x2 __attribute__((ext_vector_type(2)));
typedef unsigned u32x4 __attribute__((ext_vector_type(4)));
typedef unsigned u32x2 __attribute__((ext_vector_type(2)));

constexpr int NT = 512, NWAVES = 8;
constexpr int LDS_BYTES = 144 * 1024;
constexpr int Bsz = 8, S = 2048, D = 1024, T = Bsz * S;
constexpr int H_MLA = 8, DQK = 96, DNOPE = 64, DROPE = 32, DV = 64, QLORA = 384, KVLORA = 256;
constexpr int H_ML = 4, DM = 128, MINNER = 512, CHUNK = 64, NCH = S / CHUNK;
constexpr int IN_DIM = 2216;
constexpr int OFF_CQ = 0, OFF_CKV = 384, OFF_KR = 640, OFF_Z = 672, OFF_MV = 1184, OFF_MO = 1696, OFF_GATE = 2208;
constexpr int NE = 256, TOPK = 8, EDIM = 256, SDIM = 256;
constexpr int CAP = T;
constexpr float RMS_EPS = 1e-6f;

constexpr size_t MiB = 1u << 20;
constexpr size_t WS_CTL = 0;
constexpr size_t CTL_BYTES = 65536;
constexpr size_t WS_CNT = 32768;
constexpr int CNT_STRIDE = 32;
constexpr size_t WS_ADA = CTL_BYTES;
constexpr size_t WS_BC = 2 * MiB;
constexpr size_t WS_MLOC = WS_BC + 8192;
constexpr size_t WS_MPREV = WS_BC + 16384;
constexpr size_t WS_DN = 2 * MiB + 512 * 1024;
constexpr size_t WS_NPREV = 3 * MiB;
constexpr size_t WS_WIN = 4 * MiB;
constexpr size_t WS_WUQ = 9 * MiB;
constexpr size_t WS_WUKV = 10 * MiB;
constexpr size_t WS_WMQK = 11 * MiB;
constexpr size_t WS_WOUT = 12 * MiB;
constexpr size_t WS_WRGU = 14 * MiB;
constexpr size_t WS_WDSH = 16 * MiB;
constexpr size_t WS_IMG9 = 160 * MiB;
constexpr int NIMG = 32;
constexpr size_t WS_TICKET8 = WS_CTL + 18432;
constexpr size_t WS_TICKET9 = WS_CTL + 20480;
constexpr size_t RB = 416 * MiB;
constexpr size_t B_PROJ = RB;
constexpr size_t B_GRAW = RB + 70 * MiB;
constexpr size_t B_GL = RB + 71 * MiB;
constexpr size_t B_H1 = RB + 72 * MiB;
constexpr size_t B_CQN = RB + 104 * MiB;
constexpr size_t B_CKVN = RB + 116 * MiB;
constexpr size_t B_ZC = RB + 124 * MiB;
constexpr size_t B_QRAW = RB + 140 * MiB;
constexpr size_t B_KVRAW = RB + 164 * MiB;
constexpr size_t B_MQ = RB + 196 * MiB;
constexpr size_t B_MK = RB + 212 * MiB;
constexpr size_t B_Q = RB + 228 * MiB;
constexpr size_t B_K = RB + 252 * MiB;
constexpr size_t B_ORAW = RB + 276 * MiB;
constexpr size_t B_AO = RB + 292 * MiB;
constexpr size_t B_DC = RB + 324 * MiB;
constexpr size_t B_CPREV = RB + 388 * MiB;
constexpr size_t C_H2 = RB;
constexpr size_t C_LOGITS = RB + 32 * MiB;
constexpr size_t C_ACTSH = RB + 48 * MiB;
constexpr size_t C_SHOUT = RB + 56 * MiB;
constexpr size_t C_TOKE = RB + 88 * MiB;
constexpr size_t C_TOKW = RB + 89 * MiB;
constexpr size_t C_TOKPOS = RB + 90 * MiB;
constexpr size_t C_LISTTOK = RB + 92 * MiB;
constexpr size_t C_LISTW = RB + 108 * MiB;
constexpr size_t C_ACTE = RB + 124 * MiB;
constexpr size_t C_Y = RB + 188 * MiB;
constexpr size_t C_H2F8 = RB + 320 * MiB;
constexpr size_t C_X1 = RB + 340 * MiB;
constexpr size_t WS_END = RB + 444 * MiB;

struct Params {
    const float* in[31];
    float* out;
    unsigned char* ws;
};

typedef __bf16 bf16x2v __attribute__((ext_vector_type(2)));
__device__ __forceinline__ unsigned cvt_pk_bf16(float lo, float hi) { f32x2 v = {lo, hi}; bf16x2v b = __builtin_convertvector(v, bf16x2v); return __builtin_bit_cast(unsigned, b); }
__device__ __forceinline__ unsigned pk4_fp8(float a, float b, float c, float d) { int p = __builtin_amdgcn_cvt_pk_fp8_f32(a, b, 0, false); p = __builtin_amdgcn_cvt_pk_fp8_f32(c, d, p, true); return (unsigned)p; }
__device__ __forceinline__ float bf2f(unsigned short b) { return __uint_as_float((unsigned)b << 16); }
__device__ __forceinline__ float bflo(unsigned u) { return __uint_as_float(u << 16); }
__device__ __forceinline__ float bfhi(unsigned u) { return __uint_as_float(u & 0xffff0000u); }
template <int CTRL> __device__ __forceinline__ float dppf(float v) { return __uint_as_float((unsigned)__builtin_amdgcn_update_dpp(0, (int)__float_as_uint(v), CTRL, 0xF, 0xF, true)); }
__device__ __forceinline__ float row16_sum(float v) { v += dppf<0xB1>(v); v += dppf<0x4E>(v); v += dppf<0x141>(v); v += dppf<0x140>(v); return v; }
__device__ __forceinline__ float row16_max(float v) { v = fmaxf(v, dppf<0xB1>(v)); v = fmaxf(v, dppf<0x4E>(v)); v = fmaxf(v, dppf<0x141>(v)); v = fmaxf(v, dppf<0x140>(v)); return v; }
__device__ __forceinline__ float x16_sum(float v) { const auto r = __builtin_amdgcn_permlane16_swap(__float_as_uint(v), __float_as_uint(v), false, false); return __uint_as_float(r[0]) + __uint_as_float(r[1]); }
__device__ __forceinline__ float x32_sum(float v) { const auto r = __builtin_amdgcn_permlane32_swap(__float_as_uint(v), __float_as_uint(v), false, false); return __uint_as_float(r[0]) + __uint_as_float(r[1]); }
__device__ __forceinline__ float x16_max(float v) { const auto r = __builtin_amdgcn_permlane16_swap(__float_as_uint(v), __float_as_uint(v), false, false); return fmaxf(__uint_as_float(r[0]), __uint_as_float(r[1])); }
__device__ __forceinline__ float x32_max(float v) { const auto r = __builtin_amdgcn_permlane32_swap(__float_as_uint(v), __float_as_uint(v), false, false); return fmaxf(__uint_as_float(r[0]), __uint_as_float(r[1])); }
__device__ __forceinline__ float x16_partner(float v, int lane16) { const auto r = __builtin_amdgcn_permlane16_swap(__float_as_uint(v), __float_as_uint(v), false, false); return __uint_as_float(lane16 ? r[0] : r[1]); }
template <int CTRL, int RMASK> __device__ __forceinline__ float dpp_or(float old, float v) { return __uint_as_float((unsigned)__builtin_amdgcn_update_dpp((int)__float_as_uint(old), (int)__float_as_uint(v), CTRL, RMASK, 0xF, false)); }
__device__ __forceinline__ float wave_scan_sum(float v) {
    v += dpp_or<0x111, 0xF>(0.f, v); v += dpp_or<0x112, 0xF>(0.f, v); v += dpp_or<0x114, 0xF>(0.f, v); v += dpp_or<0x118, 0xF>(0.f, v);
    v += dpp_or<0x142, 0xA>(0.f, v); v += dpp_or<0x143, 0xC>(0.f, v); return v; }
__device__ __forceinline__ float wave_scan_max(float v) {
    v = fmaxf(v, dpp_or<0x111, 0xF>(v, v)); v = fmaxf(v, dpp_or<0x112, 0xF>(v, v)); v = fmaxf(v, dpp_or<0x114, 0xF>(v, v)); v = fmaxf(v, dpp_or<0x118, 0xF>(v, v));
    v = fmaxf(v, dpp_or<0x142, 0xA>(v, v)); v = fmaxf(v, dpp_or<0x143, 0xC>(v, v)); return v; }
__device__ __forceinline__ float wave_sum(float v) { return x32_sum(x16_sum(row16_sum(v))); }
__device__ __forceinline__ float wave_max(float v) { return x32_max(x16_max(row16_max(v))); }
__device__ __forceinline__ float sigmoidf_(float x) { return __builtin_amdgcn_rcpf(1.f + __builtin_amdgcn_exp2f(-1.4426950408889634f * x)); }
__device__ __forceinline__ float siluf_(float x) { return x * __builtin_amdgcn_rcpf(1.f + __builtin_amdgcn_exp2f(-1.4426950408889634f * x)); }
__device__ __forceinline__ int fresh_tid() { int t = threadIdx.x; asm volatile("" : "+v"(t)); return t; }
#define MFMA16(a, b, c) __builtin_amdgcn_mfma_f32_16x16x32_bf16((a), (b), (c), 0, 0, 0)


#define XB_TMO      128
#define XB_XCNT(j)  (256  + 64 * (j))
#define XB_XSUB(j)  (1280 + 64 * (j))
#define XB_XGEN(j)  (2304 + 64 * (j))
#define XB_TOP      3328
#define XB_TOPGEN   3392
#define XCD_BAR_WORDS 3456
#define XB_SPIN_CAP (1u << 23)
__device__ __forceinline__ unsigned xb_ld(unsigned* p)              { return __hip_atomic_load(p, __ATOMIC_RELAXED, __HIP_MEMORY_SCOPE_AGENT); }
__device__ __forceinline__ unsigned xb_add(unsigned* p, unsigned v) { return __hip_atomic_fetch_add(p, v, __ATOMIC_RELAXED, __HIP_MEMORY_SCOPE_AGENT); }
__device__ __forceinline__ unsigned xb_xcc_id() { return (unsigned)__builtin_amdgcn_s_getreg((3 << 11) | 20) & 0xFu; }
#define XB_SPIN(cond, bar) do { unsigned _sp = 0; while (cond) { __builtin_amdgcn_s_sleep(1); \
    if ((++_sp & 255u) == 0u) { if (xb_ld(&(bar)[XB_TMO])) break; if (_sp > XB_SPIN_CAP) { atomicAdd(&(bar)[XB_TMO], 1u); break; } } } } while (0)
struct XcdBarrier { unsigned* bar; unsigned x; volatile LAS unsigned* st; };
__device__ __forceinline__ XcdBarrier xcd_barrier_post(unsigned* bar, volatile LAS unsigned* st) {
    XcdBarrier b; b.bar = bar; b.x = xb_xcc_id(); b.st = st;
    if (threadIdx.x == 0) (void)xb_add(&bar[XB_XCNT(b.x)], 1u);
    return b;
}
__device__ __forceinline__ void xcd_barrier_complete(unsigned* bar, unsigned x, unsigned& nloc, unsigned& nx) {
    const unsigned G = gridDim.x * gridDim.y * gridDim.z;
    unsigned sum, cnt, mine, sp = 0u;
    for (;;) {
        sum = 0u; cnt = 0u; mine = 0u;
#pragma unroll
        for (unsigned j = 0; j < 16; ++j) { const unsigned c = xb_ld(&bar[XB_XCNT(j)]); sum += c; cnt += (c > 0u) ? 1u : 0u; mine = (j == x) ? c : mine; }
        if (sum == G) break;
        __builtin_amdgcn_s_sleep(1);
        if ((++sp & 255u) == 0u) { if (xb_ld(&bar[XB_TMO])) break; if (sp > XB_SPIN_CAP) { atomicAdd(&bar[XB_TMO], 1u); break; } }
    }
    nloc = mine > 0u ? mine : 1u; nx = cnt > 0u ? cnt : 1u;
}
__device__ __forceinline__ void xcd_barrier(const XcdBarrier& b) {
    asm volatile("s_waitcnt vmcnt(0)" ::: "memory");
    __syncthreads();
    if (threadIdx.x == 0) {
        unsigned* bar = b.bar;
        __builtin_amdgcn_s_waitcnt(0);
        unsigned nloc = b.st[0], nx = b.st[1];
        if (nloc == 0u) { xcd_barrier_complete(bar, b.x, nloc, nx); b.st[0] = nloc; b.st[1] = nx; }
        const unsigned old = xb_add(&bar[XB_XSUB(b.x)], 1u);
        const unsigned gen = old / nloc;
        if (old + 1u == (gen + 1u) * nloc) {
            __builtin_amdgcn_fence(__ATOMIC_RELEASE, "agent");
            asm volatile("s_waitcnt vmcnt(0)" ::: "memory");
            const unsigned og = xb_add(&bar[XB_TOP], 1u);
            const unsigned tg = og / nx;
            if (og + 1u == (tg + 1u) * nx) xb_add(&bar[XB_TOPGEN], 1u);
            else XB_SPIN(xb_ld(&bar[XB_TOPGEN]) == tg, bar);
            __builtin_amdgcn_fence(__ATOMIC_ACQUIRE, "agent");
            xb_add(&bar[XB_XGEN(b.x)], 1u);
            asm volatile("s_waitcnt vmcnt(0)" ::: "memory");
        } else {
            XB_SPIN(xb_ld(&bar[XB_XGEN(b.x)]) == gen, bar);
            __builtin_amdgcn_fence(__ATOMIC_ACQUIRE, "agent");
            asm volatile("s_waitcnt vmcnt(0)" ::: "memory");
        }
    }
    __syncthreads();
}

template <int MAP>
__device__ __forceinline__ int map_row(int n) {
    if (MAP == 0) return n;
    if (MAP == 1) return ((n >> 4) << 5) + (n & 15);
    return ((n >> 4) << 5) + 16 + (n & 15);
}
template <int MAP>
__device__ __forceinline__ void conv_item(const float* src, int K, int N, bf16_t* dst, size_t dst_mat_stride, int row_off, LAS float* scr, int it, int lane) {
    const int nblk = (N + 31) / 32, kblk = K / 64, per = nblk * kblk;
    const int mat = it / per, r = it - mat * per, kb = r / nblk, nb = r - kb * nblk, k0 = kb * 64, n0 = nb * 32;
    const float* W = src + (size_t)mat * K * N;
    bf16_t* WT = dst + (size_t)mat * dst_mat_stride;
    const int nn = n0 + (lane & 31);
    const bool nok = nn < N;
    float v[32];
    const float* wp = W + (size_t)(k0 + (lane >> 5)) * N + nn;
#pragma unroll
    for (int i = 0; i < 32; ++i) v[i] = nok ? wp[(size_t)(2 * i) * N] : 0.f;
#pragma unroll
    for (int i = 0; i < 32; ++i) scr[(2 * i + (lane >> 5)) * 33 + (lane & 31)] = v[i];
    asm volatile("s_waitcnt lgkmcnt(0)" ::: "memory");
    const int c = lane & 7;
#pragma unroll
    for (int j = 0; j < 4; ++j) {
        const int n = (lane >> 3) + 8 * j;
        const LAS float* sp = scr + (8 * c) * 33 + n;
        u32x4 o; o.x = cvt_pk_bf16(sp[0 * 33], sp[1 * 33]); o.y = cvt_pk_bf16(sp[2 * 33], sp[3 * 33]); o.z = cvt_pk_bf16(sp[4 * 33], sp[5 * 33]); o.w = cvt_pk_bf16(sp[6 * 33], sp[7 * 33]);
        if (n0 + n < N) *(u32x4*)(WT + (size_t)(row_off + map_row<MAP>(n0 + n)) * K + k0 + 8 * c) = o;
    }
    asm volatile("s_waitcnt lgkmcnt(0)" ::: "memory");
}

__device__ __forceinline__ void ada_unit(const Params& p, LAS unsigned char* lds, int u, int tid) {
    LAS float* cond = (LAS float*)lds;
    LAS float* red = (LAS float*)(lds + 16384);
    const float* c = p.in[1]; const float* w = p.in[3]; const float* bias = p.in[4];
    float* ada = (float*)(p.ws + WS_ADA);
    const int lane = tid & 63, wv = tid >> 6, cg = u >> 1, kh = u & 1;
    for (int i = tid; i < 8 * 512; i += NT) { const int b = i >> 9, k = i & 511; cond[i] = siluf_(c[b * 1024 + kh * 512 + k]); }
    __syncthreads();
    float acc[8];
#pragma unroll
    for (int b = 0; b < 8; ++b) acc[b] = 0.f;
    const int col = cg * 64 + lane;
    const float* wp = w + (size_t)(kh * 512 + wv * 64) * 6144 + col;
#pragma unroll 16
    for (int k = 0; k < 64; ++k) {
        const float wv_ = wp[(size_t)k * 6144];
#pragma unroll
        for (int b = 0; b < 8; ++b) acc[b] += cond[b * 512 + wv * 64 + k] * wv_;
    }
#pragma unroll
    for (int b = 0; b < 8; ++b) red[(wv * 8 + b) * 64 + lane] = acc[b];
    __syncthreads();
    {
        const int b = tid >> 6;
        float sacc = 0.f;
#pragma unroll
        for (int w2 = 0; w2 < 8; ++w2) sacc += red[(w2 * 8 + b) * 64 + lane];
        atomicAdd(&ada[b * 6144 + col], sacc + (kh == 0 ? bias[col] : 0.f));
    }
    __syncthreads();
}

__device__ __forceinline__ void norm_mod_rows_bf(const bf16_t* X, const float* g, const float* ada, int sh_off, int sc_off, bf16_t* Hout, int gw, int ngw, int lane, unsigned char* H8) {
    u32x2 nx[4];
    if (gw < T) {
#pragma unroll
        for (int j = 0; j < 4; ++j) nx[j] = *((const u32x2*)(X + (size_t)gw * D) + lane + 64 * j);
    }
    f32x4 gg[4];
#pragma unroll
    for (int j = 0; j < 4; ++j) gg[j] = *(const f32x4*)(g + 4 * (lane + 64 * j));
    for (int row = gw; row < T; row += ngw) {
        const int b = row / S;
        f32x4 v[4]; float ss = 0.f;
#pragma unroll
        for (int j = 0; j < 4; ++j) { v[j].x = bflo(nx[j].x); v[j].y = bfhi(nx[j].x); v[j].z = bflo(nx[j].y); v[j].w = bfhi(nx[j].y); }
        if (row + ngw < T) {
#pragma unroll
            for (int j = 0; j < 4; ++j) nx[j] = *((const u32x2*)(X + (size_t)(row + ngw) * D) + lane + 64 * j);
        }
        f32x4 sc[4], sh[4];
#pragma unroll
        for (int j = 0; j < 4; ++j) { const int k = 4 * (lane + 64 * j);
            sc[j] = *(const f32x4*)(ada + b * 6144 + sc_off + k); sh[j] = *(const f32x4*)(ada + b * 6144 + sh_off + k); }
#pragma unroll
        for (int j = 0; j < 4; ++j) ss += v[j].x * v[j].x + v[j].y * v[j].y + v[j].z * v[j].z + v[j].w * v[j].w;
        const float rinv = rsqrtf(wave_sum(ss) * (1.f / D) + RMS_EPS);
        u32x2* o = (u32x2*)(Hout + (size_t)row * D) + lane;
#pragma unroll
        for (int j = 0; j < 4; ++j) {
            const f32x4 h = v[j] * rinv * gg[j] * (1.f + sc[j]) + sh[j];
            u32x2 w; w.x = cvt_pk_bf16(h.x, h.y); w.y = cvt_pk_bf16(h.z, h.w);
            o[64 * j] = w;
            *((unsigned*)(H8 + (size_t)row * D) + lane + 64 * j) = pk4_fp8(h.x, h.y, h.z, h.w);
        }
    }
}
__device__ __forceinline__ void norm_mod_rows_bf8(const bf16_t* X, const float* g, const float* ada, int sh_off, int sc_off, bf16_t* Hout, int gw, int lane, unsigned char* H8) {
    const int row0 = gw * 8, b = row0 / S;
    f32x4 mul[4], sh[4];
#pragma unroll
    for (int j = 0; j < 4; ++j) { const int k = 4 * (lane + 64 * j);
        const f32x4 gg = *(const f32x4*)(g + k), sc = *(const f32x4*)(ada + b * 6144 + sc_off + k);
        sh[j] = *(const f32x4*)(ada + b * 6144 + sh_off + k); mul[j] = gg * (1.f + sc); }
    u32x2 nx[8][4];
#pragma unroll
    for (int r = 0; r < 8; ++r)
#pragma unroll
        for (int j = 0; j < 4; ++j) nx[r][j] = *((const u32x2*)(X + (size_t)(row0 + r) * D) + lane + 64 * j);
#pragma unroll
    for (int r = 0; r < 8; ++r) {
        const int row = row0 + r;
        f32x4 v[4]; float ss = 0.f;
#pragma unroll
        for (int j = 0; j < 4; ++j) { v[j].x = bflo(nx[r][j].x); v[j].y = bfhi(nx[r][j].x); v[j].z = bflo(nx[r][j].y); v[j].w = bfhi(nx[r][j].y); }
#pragma unroll
        for (int j = 0; j < 4; ++j) ss += v[j].x * v[j].x + v[j].y * v[j].y + v[j].z * v[j].z + v[j].w * v[j].w;
        const float rinv = rsqrtf(wave_sum(ss) * (1.f / D) + RMS_EPS);
        u32x2* o = (u32x2*)(Hout + (size_t)row * D) + lane;
#pragma unroll
        for (int j = 0; j < 4; ++j) {
            const f32x4 h = v[j] * rinv * mul[j] + sh[j];
            u32x2 w; w.x = cvt_pk_bf16(h.x, h.y); w.y = cvt_pk_bf16(h.z, h.w);
            o[64 * j] = w;
            *((unsigned*)(H8 + (size_t)row * D) + lane + 64 * j) = pk4_fp8(h.x, h.y, h.z, h.w);
        }
    }
}
__device__ __forceinline__ void norm_mod_rows(const float* X, const float* g, const float* ada, int sh_off, int sc_off, bf16_t* Hout, int gw, int ngw, int lane, unsigned char* H8 = nullptr) {
    f32x4 nx[4];
    if (gw < T) {
#pragma unroll
        for (int j = 0; j < 4; ++j) nx[j] = *((const f32x4*)(X + (size_t)gw * D) + lane + 64 * j);
    }
    f32x4 gg[4];
#pragma unroll
    for (int j = 0; j < 4; ++j) gg[j] = *(const f32x4*)(g + 4 * (lane + 64 * j));
    for (int row = gw; row < T; row += ngw) {
        const int b = row / S;
        f32x4 v[4]; float ss = 0.f;
#pragma unroll
        for (int j = 0; j < 4; ++j) v[j] = nx[j];
        if (row + ngw < T) {
#pragma unroll
            for (int j = 0; j < 4; ++j) nx[j] = *((const f32x4*)(X + (size_t)(row + ngw) * D) + lane + 64 * j);
        }
        f32x4 sc[4], sh[4];
#pragma unroll
        for (int j = 0; j < 4; ++j) { const int k = 4 * (lane + 64 * j);
            sc[j] = *(const f32x4*)(ada + b * 6144 + sc_off + k); sh[j] = *(const f32x4*)(ada + b * 6144 + sh_off + k); }
#pragma unroll
        for (int j = 0; j < 4; ++j) ss += v[j].x * v[j].x + v[j].y * v[j].y + v[j].z * v[j].z + v[j].w * v[j].w;
        const float rinv = rsqrtf(wave_sum(ss) * (1.f / D) + RMS_EPS);
        u32x2* o = (u32x2*)(Hout + (size_t)row * D) + lane;
#pragma unroll
        for (int j = 0; j < 4; ++j) {
            const f32x4 h = v[j] * rinv * gg[j] * (1.f + sc[j]) + sh[j];
            u32x2 w; w.x = cvt_pk_bf16(h.x, h.y); w.y = cvt_pk_bf16(h.z, h.w);
            o[64 * j] = w;
            if (H8) *((unsigned*)(H8 + (size_t)row * D) + lane + 64 * j) = pk4_fp8(h.x, h.y, h.z, h.w);
        }
    }
}

__device__ __forceinline__ void norm_mod_rows_x8(const float* X, const float* g, const float* ada, int sh_off, int sc_off, bf16_t* Hout, int gw, int lane) {
    const int row0 = gw * 8, b = row0 / S;
    f32x4 mul[4], sh[4];
#pragma unroll
    for (int j = 0; j < 4; ++j) { const int k = 4 * (lane + 64 * j);
        const f32x4 gg = *(const f32x4*)(g + k), sc = *(const f32x4*)(ada + b * 6144 + sc_off + k);
        sh[j] = *(const f32x4*)(ada + b * 6144 + sh_off + k); mul[j] = gg * (1.f + sc); }
    f32x4 nx[8][4];
#pragma unroll
    for (int r = 0; r < 8; ++r)
#pragma unroll
        for (int j = 0; j < 4; ++j) nx[r][j] = *((const f32x4*)(X + (size_t)(row0 + r) * D) + lane + 64 * j);
#pragma unroll
    for (int r = 0; r < 8; ++r) {
        const int row = row0 + r;
        float ss = 0.f;
#pragma unroll
        for (int j = 0; j < 4; ++j) ss += nx[r][j].x * nx[r][j].x + nx[r][j].y * nx[r][j].y + nx[r][j].z * nx[r][j].z + nx[r][j].w * nx[r][j].w;
        const float rinv = rsqrtf(wave_sum(ss) * (1.f / D) + RMS_EPS);
        u32x2* o = (u32x2*)(Hout + (size_t)row * D) + lane;
#pragma unroll
        for (int j = 0; j < 4; ++j) {
            const f32x4 h = nx[r][j] * rinv * mul[j] + sh[j];
            u32x2 w; w.x = cvt_pk_bf16(h.x, h.y); w.y = cvt_pk_bf16(h.z, h.w);
            o[64 * j] = w;
        }
    }
}

__device__ __forceinline__ void post_proj_rows(const Params& p, int gw, int ngw, int lane) {
    const bf16_t* proj = (const bf16_t*)(p.ws + B_PROJ);
    const float* graw = (const float*)(p.ws + B_GRAW);
    float* gl = (float*)(p.ws + B_GL);
    bf16_t* cqn = (bf16_t*)(p.ws + B_CQN); bf16_t* ckvn = (bf16_t*)(p.ws + B_CKVN); bf16_t* zc = (bf16_t*)(p.ws + B_ZC);
    const float* g_cq = p.in[7]; const float* g_ckv = p.in[9]; const float* conv_w = p.in[14]; const float* conv_b = p.in[15];
    const int c0 = lane * 8;
    float gq[6], gk[4], cw[4][8], cbv[8];
#pragma unroll
    for (int j = 0; j < 6; ++j) gq[j] = g_cq[lane * 6 + j];
#pragma unroll
    for (int j = 0; j < 4; ++j) gk[j] = g_ckv[lane * 4 + j];
#pragma unroll
    for (int tap = 0; tap < 4; ++tap)
#pragma unroll
        for (int j = 0; j < 8; ++j) cw[tap][j] = conv_w[tap * MINNER + c0 + j];
#pragma unroll
    for (int j = 0; j < 8; ++j) cbv[j] = conv_b[c0 + j];
    const float gbias = (lane < 4) ? p.in[18][lane] : (lane < 8 ? p.in[19][lane - 4] : 0.f);
    for (int row = gw; row < T; row += ngw) {
        const bf16_t* pr = proj + (size_t)row * IN_DIM;
        const int s = row % S;
        const unsigned* q = (const unsigned*)(pr + OFF_CQ) + lane * 3;
        const unsigned a0 = q[0], a1 = q[1], a2 = q[2];
        const u32x2 kvv = *((const u32x2*)(pr + OFF_CKV) + lane);
        u32x4 z[4];
#pragma unroll
        for (int tap = 0; tap < 4; ++tap) { const int ds = tap - 3; z[tap] = (s + ds >= 0) ? *(const u32x4*)(pr + (ptrdiff_t)ds * IN_DIM + OFF_Z + c0) : (u32x4){0u, 0u, 0u, 0u}; }
        const float gr = (lane < 8) ? graw[(size_t)row * 8 + lane] : 0.f;
        {
            float f[6] = {bflo(a0), bfhi(a0), bflo(a1), bfhi(a1), bflo(a2), bfhi(a2)};
            float ss = 0.f;
#pragma unroll
            for (int j = 0; j < 6; ++j) ss += f[j] * f[j];
            const float rinv = rsqrtf(wave_sum(ss) * (1.f / QLORA) + RMS_EPS);
            unsigned* o = (unsigned*)(cqn + (size_t)row * QLORA) + lane * 3;
            o[0] = cvt_pk_bf16(f[0] * rinv * gq[0], f[1] * rinv * gq[1]);
            o[1] = cvt_pk_bf16(f[2] * rinv * gq[2], f[3] * rinv * gq[3]);
            o[2] = cvt_pk_bf16(f[4] * rinv * gq[4], f[5] * rinv * gq[5]);
        }
        {
            float f[4] = {bflo(kvv.x), bfhi(kvv.x), bflo(kvv.y), bfhi(kvv.y)};
            float ss = f[0] * f[0] + f[1] * f[1] + f[2] * f[2] + f[3] * f[3];
            const float rinv = rsqrtf(wave_sum(ss) * (1.f / KVLORA) + RMS_EPS);
            u32x2 w; w.x = cvt_pk_bf16(f[0] * rinv * gk[0], f[1] * rinv * gk[1]); w.y = cvt_pk_bf16(f[2] * rinv * gk[2], f[3] * rinv * gk[3]);
            *((u32x2*)(ckvn + (size_t)row * KVLORA) + lane) = w;
        }
        {
            float acc[8];
#pragma unroll
            for (int j = 0; j < 8; ++j) acc[j] = cbv[j];
#pragma unroll
            for (int tap = 0; tap < 4; ++tap) {
                acc[0] += bflo(z[tap].x) * cw[tap][0]; acc[1] += bfhi(z[tap].x) * cw[tap][1]; acc[2] += bflo(z[tap].y) * cw[tap][2]; acc[3] += bfhi(z[tap].y) * cw[tap][3];
                acc[4] += bflo(z[tap].z) * cw[tap][4]; acc[5] += bfhi(z[tap].z) * cw[tap][5]; acc[6] += bflo(z[tap].w) * cw[tap][6]; acc[7] += bfhi(z[tap].w) * cw[tap][7];
            }
            u32x4 o; o.x = cvt_pk_bf16(siluf_(acc[0]), siluf_(acc[1])); o.y = cvt_pk_bf16(siluf_(acc[2]), siluf_(acc[3]));
            o.z = cvt_pk_bf16(siluf_(acc[4]), siluf_(acc[5])); o.w = cvt_pk_bf16(siluf_(acc[6]), siluf_(acc[7]));
            *(u32x4*)(zc + (size_t)row * MINNER + c0) = o;
        }
        if (lane < 8) {
            const float xx = gr + gbias;
            gl[(size_t)row * 8 + lane] = (lane < 4) ? xx : (fminf(xx, 0.f) - log1pf(__expf(-fabsf(xx))));
        }
    }
}

__device__ __forceinline__ void qk_post_rows(const Params& p, int gw, int ngw, int lane) {
    const bf16_t* qraw = (const bf16_t*)(p.ws + B_QRAW); const bf16_t* kvraw = (const bf16_t*)(p.ws + B_KVRAW);
    const bf16_t* proj = (const bf16_t*)(p.ws + B_PROJ);
    bf16_t* Q = (bf16_t*)(p.ws + B_Q); bf16_t* Kb = (bf16_t*)(p.ws + B_K);
    const int* positions = (const int*)p.in[2];
    const float* g_qn = p.in[11]; const float* g_kn = p.in[12];
    const float qscale = 0.10206207261596575f * 1.4426950408889634f;
    const int sub = lane & 15, hq = lane >> 4, j0 = (2 * sub) & 15;
    const float if0 = exp2f(-(float)(2 * j0) * (13.287712379549449f / 32.f)), if1 = exp2f(-(float)(2 * j0 + 2) * (13.287712379549449f / 32.f));
    const f32x4 gq = *(const f32x4*)(g_qn + 4 * sub), gk = *(const f32x4*)(g_kn + 4 * sub);
    const float gqr0 = g_qn[64 + 2 * sub], gqr1 = g_qn[65 + 2 * sub], gkr0 = g_kn[64 + 2 * sub], gkr1 = g_kn[65 + 2 * sub];
    const bool first = sub < 8;
    u32x2 qaN[2], kaN[2]; unsigned qbN[2], krpN; int posN;
#define L3_LOAD(row_) do { const int rw_ = (row_); \
        _Pragma("unroll") for (int ps = 0; ps < 2; ++ps) { const int h = ps * 4 + hq; \
            qaN[ps] = *(const u32x2*)(qraw + (size_t)rw_ * 768 + h * 96 + 4 * sub); \
            qbN[ps] = *(const unsigned*)(qraw + (size_t)rw_ * 768 + h * 96 + 64 + 2 * sub); \
            kaN[ps] = *(const u32x2*)(kvraw + (size_t)rw_ * 1024 + h * 128 + 4 * sub); } \
        krpN = *(const unsigned*)(proj + (size_t)rw_ * IN_DIM + OFF_KR + 2 * sub); posN = positions[rw_]; } while (0)
    L3_LOAD(min(gw, T - 1));
    for (int row = gw; row < T; row += ngw) {
        const int b = row / S, s = row % S;
        const u32x2 qa[2] = {qaN[0], qaN[1]}, ka[2] = {kaN[0], kaN[1]}; const unsigned qb[2] = {qbN[0], qbN[1]};
        const unsigned krp = krpN;
        const float pos = (float)posN;
        L3_LOAD(min(row + ngw, T - 1));
        const float sn0 = __sinf(pos * if0), cs0 = __cosf(pos * if0), sn1 = __sinf(pos * if1), cs1 = __cosf(pos * if1);
#pragma unroll
        for (int ps = 0; ps < 2; ++ps) {
            const int h = ps * 4 + hq;
            {
                float v0 = bflo(qa[ps].x), v1 = bfhi(qa[ps].x), v2 = bflo(qa[ps].y), v3 = bfhi(qa[ps].y), r0 = bflo(qb[ps]), r1 = bfhi(qb[ps]);
                const float ss = row16_sum(v0 * v0 + v1 * v1 + v2 * v2 + v3 * v3 + r0 * r0 + r1 * r1);
                const float rinv = rsqrtf(ss * (1.f / 96.f) + RMS_EPS);
                v0 *= rinv * gq.x; v1 *= rinv * gq.y; v2 *= rinv * gq.z; v3 *= rinv * gq.w; r0 *= rinv * gqr0; r1 *= rinv * gqr1;
                const float o0 = dppf<0x128>(r0), o1 = dppf<0x128>(r1);
                const float t0 = first ? (r0 * cs0 - o0 * sn0) : (o0 * sn0 + r0 * cs0), t1 = first ? (r1 * cs1 - o1 * sn1) : (o1 * sn1 + r1 * cs1);
                bf16_t* qo = Q + ((size_t)(b * H_MLA + h) * S + s) * 96;
                u32x2 w; w.x = cvt_pk_bf16(v0 * qscale, v1 * qscale); w.y = cvt_pk_bf16(v2 * qscale, v3 * qscale);
                asm volatile("global_store_dwordx2 %0, %1, off" :: "v"(qo + 4 * sub), "v"(w) : "memory");
                { const unsigned tw = cvt_pk_bf16(t0 * qscale, t1 * qscale); asm volatile("global_store_dword %0, %1, off" :: "v"(qo + 64 + 2 * sub), "v"(tw) : "memory"); }
            }
            {
                float v0 = bflo(ka[ps].x), v1 = bfhi(ka[ps].x), v2 = bflo(ka[ps].y), v3 = bfhi(ka[ps].y), r0 = bflo(krp), r1 = bfhi(krp);
                const float ss = row16_sum(v0 * v0 + v1 * v1 + v2 * v2 + v3 * v3 + r0 * r0 + r1 * r1);
                const float rinv = rsqrtf(ss * (1.f / 96.f) + RMS_EPS);
                v0 *= rinv * gk.x; v1 *= rinv * gk.y; v2 *= rinv * gk.z; v3 *= rinv * gk.w; r0 *= rinv * gkr0; r1 *= rinv * gkr1;
                const float o0 = dppf<0x128>(r0), o1 = dppf<0x128>(r1);
                const float t0 = first ? (r0 * cs0 - o0 * sn0) : (o0 * sn0 + r0 * cs0), t1 = first ? (r1 * cs1 - o1 * sn1) : (o1 * sn1 + r1 * cs1);
                bf16_t* ko = Kb + ((size_t)(b * H_MLA + h) * S + s) * 96;
                u32x2 w; w.x = cvt_pk_bf16(v0, v1); w.y = cvt_pk_bf16(v2, v3);
                asm volatile("global_store_dwordx2 %0, %1, off" :: "v"(ko + 4 * sub), "v"(w) : "memory");
                { const unsigned tw = cvt_pk_bf16(t0, t1); asm volatile("global_store_dword %0, %1, off" :: "v"(ko + 64 + 2 * sub), "v"(tw) : "memory"); }
            }
        }
    }
}
#undef L3_LOAD

__device__ __forceinline__ void attn_out_norm_rows_batch8(const Params& p, int gw, int lane) {
    const bf16_t* oraw = (const bf16_t*)(p.ws + B_ORAW); bf16_t* ao = (bf16_t*)(p.ws + B_AO); const float* g = p.in[13];
    float gg[8];
#pragma unroll
    for (int j = 0; j < 8; ++j) gg[j] = g[lane * 8 + j];
    const int row0 = gw * 8;
    u32x4 a[8];
#pragma unroll
    for (int r = 0; r < 8; ++r) a[r] = *((const u32x4*)(oraw + (size_t)(row0 + r) * 512) + lane);
    float ss[8];
#pragma unroll
    for (int r = 0; r < 8; ++r) {
        const float f[8] = {bflo(a[r].x), bfhi(a[r].x), bflo(a[r].y), bfhi(a[r].y), bflo(a[r].z), bfhi(a[r].z), bflo(a[r].w), bfhi(a[r].w)};
        float t = 0.f;
#pragma unroll
        for (int j = 0; j < 8; ++j) t += f[j] * f[j];
        ss[r] = t;
    }
#pragma unroll
    for (int r = 0; r < 8; ++r) ss[r] = wave_sum(ss[r]);
#pragma unroll
    for (int r = 0; r < 8; ++r) {
        const float f[8] = {bflo(a[r].x), bfhi(a[r].x), bflo(a[r].y), bfhi(a[r].y), bflo(a[r].z), bfhi(a[r].z), bflo(a[r].w), bfhi(a[r].w)};
        const float rinv = rsqrtf(ss[r] * (1.f / 512.f) + RMS_EPS);
        u32x4 o; o.x = cvt_pk_bf16(f[0] * rinv * gg[0], f[1] * rinv * gg[1]); o.y = cvt_pk_bf16(f[2] * rinv * gg[2], f[3] * rinv * gg[3]);
        o.z = cvt_pk_bf16(f[4] * rinv * gg[4], f[5] * rinv * gg[5]); o.w = cvt_pk_bf16(f[6] * rinv * gg[6], f[7] * rinv * gg[7]);
        *((u32x4*)(ao + (size_t)(row0 + r) * 1024) + lane) = o;
    }
}
__device__ __forceinline__ void attn_out_norm_rows(const Params& p, int gw, int ngw, int lane) {
    const bf16_t* oraw = (const bf16_t*)(p.ws + B_ORAW); bf16_t* ao = (bf16_t*)(p.ws + B_AO); const float* g = p.in[13];
    float gg[8];
#pragma unroll
    for (int j = 0; j < 8; ++j) gg[j] = g[lane * 8 + j];
    for (int row = gw; row < T; row += ngw) {
        const u32x4 a = *((const u32x4*)(oraw + (size_t)row * 512) + lane);
        float f[8] = {bflo(a.x), bfhi(a.x), bflo(a.y), bfhi(a.y), bflo(a.z), bfhi(a.z), bflo(a.w), bfhi(a.w)};
        float ss = 0.f;
#pragma unroll
        for (int j = 0; j < 8; ++j) ss += f[j] * f[j];
        const float rinv = rsqrtf(wave_sum(ss) * (1.f / 512.f) + RMS_EPS);
        u32x4 o; o.x = cvt_pk_bf16(f[0] * rinv * gg[0], f[1] * rinv * gg[1]); o.y = cvt_pk_bf16(f[2] * rinv * gg[2], f[3] * rinv * gg[3]);
        o.z = cvt_pk_bf16(f[4] * rinv * gg[4], f[5] * rinv * gg[5]); o.w = cvt_pk_bf16(f[6] * rinv * gg[6], f[7] * rinv * gg[7]);
        *((u32x4*)(ao + (size_t)row * 1024) + lane) = o;
    }
}

namespace pg8 {
#define PG8_LAS __attribute__((address_space(3)))
typedef unsigned short bf16_t;
typedef short bf16x8 __attribute__((ext_vector_type(8)));
typedef float f32x4 __attribute__((ext_vector_type(4)));
typedef unsigned u32x4 __attribute__((ext_vector_type(4)));
constexpr int BM = 256, BK = 64, HALF = 128, HTB = HALF * BK * 2  , STAGE_BYTES = 8 * HTB, NXCD = 8, WGM = 8;

__host__ __device__ __forceinline__ int lds_byte(int r, int c) { const int st = (r >> 4) * 2 + (c >> 5), rr = r & 15, cc = c & 31, ob = rr * 64 + cc * 2; return st * 1024 + (ob ^ (((ob >> 9) & 1) << 5)); }
__host__ __device__ __forceinline__ void stage_rc(int b, int& R, int& C) { const int st = b / 1024, sb = b % 1024, swz = sb ^ (((sb >> 9) & 1) << 5); R = (st >> 1) * 16 + swz / 64; C = (st & 1) * 32 + (swz % 64) / 2; }
__host__ __device__ __forceinline__ int perm32(int rho) { const int n = rho >> 4, i = rho & 15; return 8 * (i >> 2) + 4 * n + (i & 3); }

struct Unit { int pm, pn; };
struct Gemm { const bf16_t* A; const bf16_t* Bt; int M, N, K, lda, ldb, apn; };

struct StaticOrder {
    int nM, nN, nwg, G, c;
    __host__ __device__ void init(int M, int N, int G_, int c_) { nM = M / BM; nN = N / BM; nwg = nM * nN; G = G_; c = c_; }
    __host__ __device__ bool next(int i, Unit& u) const {
        const long L = (long)i * G + c; if (L >= nwg) return false;
        int wgid = (int)L; { const int q = nwg / NXCD, r = nwg % NXCD, xcd = wgid % NXCD, off = wgid / NXCD; wgid = (xcd < r ? xcd * (q + 1) : r * (q + 1) + (xcd - r) * q) + off; }
        const int nig = WGM * nN, gid = wgid / nig, fm = gid * WGM, gsz = (nM - fm) < WGM ? (nM - fm) : WGM;
        u.pm = fm + ((wgid % nig) % gsz); u.pn = (wgid % nig) / gsz; return true;
    }
    __device__ __forceinline__ void a_ready(const Unit&) const {}
    __device__ __forceinline__ void done(const Unit&) const {}
};


template <class Epi, class Sched, bool ALIGN_EPI = false, bool SP2 = false>
__device__ __forceinline__ void gemm_phase(PG8_LAS unsigned char* lds, const Gemm g, const Sched& S, const Epi& E) {
    const int tid = fresh_tid(), wid = __builtin_amdgcn_readfirstlane(tid >> 6), lane = tid & 63, wr = wid >> 2, wc = wid & 3, fr = lane & 15, fq = lane >> 4;
    const int K = g.K, nt = K / BK;
    unsigned voffA[2], voffB[2];
#pragma unroll
    for (int i = 0; i < 2; ++i) { int R, C; stage_rc(tid * 16 + i * 8192, R, C); const int Rb = Epi::PERM ? ((R & ~31) + perm32(R & 31)) : R;
        voffA[i] = (unsigned)(R * g.lda + C) * 2u; voffB[i] = (unsigned)(Rb * g.ldb + C) * 2u; }
    const size_t kstep = (size_t)(BK * 2);
    const size_t hstepA = (size_t)HALF * g.lda * 2, hstepB = (size_t)HALF * g.ldb * 2;
    const size_t tstepA = 2 * hstepA, tstepB = 2 * hstepB;
    const unsigned ldsw = (unsigned)wid * 1024u;
    const int aoff = lds_byte(wr * 64 + fr, fq * 8), boff = lds_byte(wc * 32 + fr, fq * 8);
#define PG8_SA(b, h) (((b) * 2 + (h)) * HTB)
#define PG8_SB(b, h) ((4 + (b) * 2 + (h)) * HTB)
#define PG8_STAGE(bufoff, gbase, voff) do { _Pragma("unroll") for (int _i = 0; _i < 2; ++_i) \
        __builtin_amdgcn_global_load_lds((const unsigned*)((const char*)(gbase) + (voff)[_i]), (PG8_LAS unsigned*)(lds + (bufoff) + ldsw + _i * 8192), 16, 0, 0); } while (0)
#define PG8_LDA(dst, b, h) do { _Pragma("unroll") for (int m = 0; m < 4; ++m) _Pragma("unroll") for (int k = 0; k < 2; ++k) dst[m][k] = *(const PG8_LAS bf16x8*)(lds + PG8_SA(b, h) + aoff + m * 2048 + k * 1024); } while (0)
#define PG8_LDB(dst, b, h) do { _Pragma("unroll") for (int n = 0; n < 2; ++n) _Pragma("unroll") for (int k = 0; k < 2; ++k) dst[n][k] = *(const PG8_LAS bf16x8*)(lds + PG8_SB(b, h) + boff + n * 2048 + k * 1024); } while (0)
#define PG8_MMA(ai, bj, At, Bt) do { __builtin_amdgcn_s_setprio(1); _Pragma("unroll") for (int m = 0; m < 4; ++m) _Pragma("unroll") for (int n = 0; n < 2; ++n) _Pragma("unroll") for (int k = 0; k < 2; ++k) \
        acc[ai][bj][m][n] = __builtin_amdgcn_mfma_f32_16x16x32_bf16(Bt[n][k], At[m][k], acc[ai][bj][m][n], 0, 0, 0); __builtin_amdgcn_s_setprio(0); } while (0)
#define PG8_WAIT_V(n) asm volatile("s_waitcnt vmcnt(" #n ")" ::: "memory")
#define PG8_WAIT_L(n) asm volatile("s_waitcnt lgkmcnt(" #n ")" ::: "memory")
#define PG8_BAR __builtin_amdgcn_s_barrier()
#define PG8_SCHED __builtin_amdgcn_sched_barrier(0)
    Unit cur, nxt; int ui = 0;
    if (!S.next(0, cur)) return;
    f32x4 acc[2][2][4][2];
#pragma unroll
    for (int a = 0; a < 2; ++a)
#pragma unroll
        for (int b = 0; b < 2; ++b)
#pragma unroll
            for (int m = 0; m < 4; ++m)
#pragma unroll
                for (int n = 0; n < 2; ++n) acc[a][b][m][n] = (f32x4){0.f, 0.f, 0.f, 0.f};
    bf16x8 At[4][2], B0[2][2], B1[2][2];
    const char* cA = (const char*)g.A + (size_t)cur.pm * tstepA + (size_t)cur.pn * g.apn * 2; const char* cB = (const char*)g.Bt + (size_t)cur.pn * tstepB;
    S.a_ready(cur);
    if constexpr (SP2) {
        PG8_STAGE(PG8_SB(0, 0), cB, voffB); PG8_STAGE(PG8_SB(0, 1), cB + hstepB, voffB); PG8_STAGE(PG8_SA(0, 0), cA, voffA); PG8_STAGE(PG8_SA(0, 1), cA + hstepA, voffA);
        if (wr == 1) PG8_BAR;
        PG8_WAIT_V(2); PG8_BAR;
        PG8_STAGE(PG8_SB(1, 0), cB + kstep, voffB); PG8_STAGE(PG8_SA(1, 0), cA + kstep, voffA); PG8_STAGE(PG8_SB(1, 1), cB + hstepB + kstep, voffB);
        PG8_WAIT_V(6); PG8_BAR;
    } else {
        PG8_STAGE(PG8_SB(0, 0), cB, voffB); PG8_STAGE(PG8_SA(0, 0), cA, voffA); PG8_STAGE(PG8_SB(0, 1), cB + hstepB, voffB); PG8_STAGE(PG8_SA(0, 1), cA + hstepA, voffA);
        if (wr == 1) PG8_BAR;
        PG8_WAIT_V(4); PG8_BAR;
        PG8_STAGE(PG8_SB(1, 0), cB + kstep, voffB); PG8_STAGE(PG8_SA(1, 0), cA + kstep, voffA); PG8_STAGE(PG8_SB(1, 1), cB + hstepB + kstep, voffB);
        PG8_WAIT_V(6); PG8_BAR;
    }
    for (;;) {
        const bool has_next = S.next(ui + 1, nxt);
        const char* nA = has_next ? (const char*)g.A + (size_t)nxt.pm * tstepA + (size_t)nxt.pn * g.apn * 2 : cA; const char* nB = has_next ? (const char*)g.Bt + (size_t)nxt.pn * tstepB : cB;
        for (int t = 0; t < nt; t += 2) {
            const bool last = (t == nt - 2);
            const char* a1 = cA + (size_t)(t + 1) * kstep;
            const char* a2 = last ? nA : cA + (size_t)(t + 2) * kstep; const char* b2 = last ? nB : cB + (size_t)(t + 2) * kstep;
            const char* a3 = a2 + kstep; const char* b3 = b2 + kstep;
            if (last && has_next) S.a_ready(nxt);
            if constexpr (SP2) {
            PG8_LDB(B0, 0, 0); PG8_LDB(B1, 0, 1); PG8_SCHED; PG8_LDA(At, 0, 0); PG8_STAGE(PG8_SA(1, 1), a1 + hstepA, voffA);
            PG8_WAIT_V(8); PG8_WAIT_L(0); PG8_BAR; PG8_MMA(0, 0, At, B0); PG8_MMA(0, 1, At, B1); PG8_BAR; PG8_SCHED;
            PG8_LDA(At, 0, 1); PG8_STAGE(PG8_SB(0, 0), b2, voffB); PG8_STAGE(PG8_SB(0, 1), b2 + hstepB, voffB); PG8_STAGE(PG8_SA(0, 0), a2, voffA);
            PG8_WAIT_V(8); PG8_WAIT_L(0); PG8_BAR; PG8_MMA(1, 0, At, B0); PG8_MMA(1, 1, At, B1); PG8_BAR; PG8_SCHED;
            PG8_LDB(B0, 1, 0); PG8_LDB(B1, 1, 1); PG8_SCHED; PG8_LDA(At, 1, 0); PG8_STAGE(PG8_SA(0, 1), a2 + hstepA, voffA);
            PG8_WAIT_V(8); PG8_WAIT_L(0); PG8_BAR; PG8_MMA(0, 0, At, B0); PG8_MMA(0, 1, At, B1); PG8_BAR; PG8_SCHED;
            PG8_LDA(At, 1, 1); PG8_STAGE(PG8_SB(1, 0), b3, voffB); PG8_STAGE(PG8_SB(1, 1), b3 + hstepB, voffB); PG8_STAGE(PG8_SA(1, 0), a3, voffA);
            PG8_WAIT_V(8); PG8_WAIT_L(0); PG8_BAR; PG8_MMA(1, 0, At, B0); PG8_MMA(1, 1, At, B1); PG8_BAR; PG8_SCHED;
            } else {
            PG8_LDB(B0, 0, 0); PG8_SCHED; PG8_LDA(At, 0, 0); PG8_STAGE(PG8_SA(1, 1), a1 + hstepA, voffA);
            PG8_WAIT_L(8); PG8_BAR; PG8_WAIT_L(0); PG8_MMA(0, 0, At, B0); PG8_BAR; PG8_SCHED;
            PG8_LDB(B1, 0, 1); PG8_STAGE(PG8_SB(0, 0), b2, voffB);
            PG8_BAR; PG8_WAIT_L(0); PG8_MMA(0, 1, At, B1); PG8_BAR;
            PG8_LDA(At, 0, 1); PG8_STAGE(PG8_SA(0, 0), a2, voffA);
            PG8_BAR; PG8_WAIT_L(0); PG8_MMA(1, 0, At, B0); PG8_BAR; PG8_SCHED;
            PG8_STAGE(PG8_SB(0, 1), b2 + hstepB, voffB);
            PG8_WAIT_V(6); PG8_BAR; PG8_MMA(1, 1, At, B1); PG8_BAR;
            PG8_LDB(B0, 1, 0); PG8_SCHED; PG8_LDA(At, 1, 0); PG8_STAGE(PG8_SA(0, 1), a2 + hstepA, voffA);
            PG8_WAIT_L(8); PG8_BAR; PG8_WAIT_L(0); PG8_MMA(0, 0, At, B0); PG8_BAR; PG8_SCHED;
            PG8_LDB(B1, 1, 1); PG8_STAGE(PG8_SB(1, 0), b3, voffB);
            PG8_BAR; PG8_WAIT_L(0); PG8_MMA(0, 1, At, B1); PG8_BAR;
            PG8_LDA(At, 1, 1); PG8_STAGE(PG8_SA(1, 0), a3, voffA);
            PG8_BAR; PG8_WAIT_L(0); PG8_MMA(1, 0, At, B0); PG8_BAR; PG8_SCHED;
            PG8_STAGE(PG8_SB(1, 1), b3 + hstepB, voffB);
            PG8_WAIT_V(6); PG8_BAR; PG8_MMA(1, 1, At, B1); PG8_BAR;
            }
        }
        if constexpr (ALIGN_EPI) { if (wr == 0) PG8_BAR; }
        if constexpr (!Epi::AFTER_DRAIN) { E(acc, cur, wr, wc, fr, fq); S.done(cur); }
        if (!has_next) break;
#pragma unroll
        for (int a = 0; a < 2; ++a)
#pragma unroll
            for (int b = 0; b < 2; ++b)
#pragma unroll
                for (int m = 0; m < 4; ++m)
#pragma unroll
                    for (int n = 0; n < 2; ++n) acc[a][b][m][n] = (f32x4){0.f, 0.f, 0.f, 0.f};
        cur = nxt; cA = nA; cB = nB; ++ui;
        if constexpr (ALIGN_EPI) { if (wr == 1) PG8_BAR; }
    }
    PG8_WAIT_V(0);
    if constexpr (!ALIGN_EPI) { if (wr == 0) PG8_BAR; }
    PG8_BAR;
    if constexpr (Epi::AFTER_DRAIN) { E.fused(acc, cur, wr, wc, fr, fq, lds, wid, lane); S.done(cur); }
#undef PG8_SA
#undef PG8_SB
#undef PG8_STAGE
#undef PG8_LDA
#undef PG8_LDB
#undef PG8_MMA
#undef PG8_WAIT_V
#undef PG8_WAIT_L
#undef PG8_BAR
#undef PG8_SCHED
}
}

constexpr int WCONV_STEPS = 32768;
struct WStep { const float* src; unsigned char* dst; int ld; };
__device__ __forceinline__ WStep wconv_decode(const Params& p, int s, int lane) {
    WStep w;
    const int e = s >> 7, g8 = (s >> 2) & 31, qd = s & 3;
    w.src = (e < NIMG ? p.in[27] + (size_t)e * 256 * 1024 : p.in[30]) + (size_t)g8 * 8 * 1024 + qd * 256 + 4 * lane; w.ld = 1024;
    const int mc = qd * 256 + 4 * lane, nq = mc >> 9, ct = (mc & 511) >> 7, bc = mc & 127;
    const int bpos = (bc & ~63) + (((bc >> 2) & 3) << 4) + (((bc >> 4) & 3) << 2);
    const int t = ct * 2 + (g8 >> 4), bg = g8 & 15;
    w.dst = (unsigned char*)(p.ws + WS_IMG9) + (size_t)((e * 2 + nq) * 8 + t) * 16384 + bg * 1024 + bpos * 8;
    return w;
}
__device__ __forceinline__ void wconv_load(const WStep& w, f32x4 (&rb)[8]) {
#pragma unroll
    for (int j = 0; j < 8; ++j) rb[j] = *(const f32x4*)(w.src + (size_t)j * w.ld);
}
__device__ __forceinline__ void wconv_store(const WStep& w, const f32x4 (&rb)[8]) {
    u32x4 w0, w1;
    w0.x = pk4_fp8(rb[0].x, rb[1].x, rb[2].x, rb[3].x); w0.y = pk4_fp8(rb[4].x, rb[5].x, rb[6].x, rb[7].x); w0.z = pk4_fp8(rb[0].y, rb[1].y, rb[2].y, rb[3].y); w0.w = pk4_fp8(rb[4].y, rb[5].y, rb[6].y, rb[7].y);
    w1.x = pk4_fp8(rb[0].z, rb[1].z, rb[2].z, rb[3].z); w1.y = pk4_fp8(rb[4].z, rb[5].z, rb[6].z, rb[7].z); w1.z = pk4_fp8(rb[0].w, rb[1].w, rb[2].w, rb[3].w); w1.w = pk4_fp8(rb[4].w, rb[5].w, rb[6].w, rb[7].w);
    *(u32x4*)w.dst = w0; *(u32x4*)(w.dst + 16) = w1;
}
__device__ __forceinline__ void wconv_range(const Params& p, int s0, int s1, int stride, int lane) {
    for (int s = s0; s < s1; s += 2 * stride) {
        f32x4 ra[8], rb[8];
        const WStep wa = wconv_decode(p, s, lane); wconv_load(wa, ra);
        const bool two = s + stride < s1;
        const WStep wb = wconv_decode(p, two ? s + stride : s, lane);
        if (two) wconv_load(wb, rb);
        wconv_store(wa, ra);
        if (two) wconv_store(wb, rb);
    }
}

constexpr int GBK = 128;
constexpr int GLB = GBK + 16;
constexpr int GBS = 1152;
constexpr int G2_AS = 256 * GLB;
constexpr int G2_BS = (GBK / 8) * GBS;
constexpr int G2_STAGE = G2_AS + G2_BS;
typedef long i64_t;
typedef int i32x4v __attribute__((ext_vector_type(4)));
typedef int i32x8v __attribute__((ext_vector_type(8)));
typedef long i64x2v __attribute__((ext_vector_type(2)));
__device__ __forceinline__ i32x8v cat8(const i32x4v a, const i32x4v b) { return __builtin_shufflevector(a, b, 0, 1, 2, 3, 4, 5, 6, 7); }
#define F8_LOADB(dst_, Bs_, n_) do { const LAS unsigned char* b_ = (Bs_) + ((n_) * 16) * 8; \
        const i64x2v lo_ = {*(const LAS i64_t*)(b_), *(const LAS i64_t*)(b_ + GBS)}, hi_ = {*(const LAS i64_t*)(b_ + 8 * GBS), *(const LAS i64_t*)(b_ + 9 * GBS)}; \
        dst_ = cat8(__builtin_bit_cast(i32x4v, lo_), __builtin_bit_cast(i32x4v, hi_)); } while (0)
#define MFMA_F8_128(a_, b_, c_) __builtin_amdgcn_mfma_scale_f32_16x16x128_f8f6f4((a_), (b_), (c_), 0, 0, 0, 0x7F7F7F7F, 0, 0x7F7F7F7F)
#define GAS __attribute__((address_space(1)))
template <class RowPtr, class ColPtr, class Epi>
__device__ __forceinline__ void gemm2_tile(LAS unsigned char* lds, const RowPtr& RP, const ColPtr& CP, int ldk, int K, int m0, int n0, const Epi& E, int mvalid = 256) {
    const int tid = fresh_tid(), lane = tid & 63, wid = tid >> 6, wm = wid >> 1, wn = wid & 1;
    const int fr = lane & 15, fq = lane >> 4;
    const int ac = (tid & 7) * 16, ar0 = tid >> 3;
    const int bc = 4 * (tid & 31), bg = tid >> 5;
    const int bpos = Epi::PERM ? ((bc & ~63) + (((bc >> 2) & 3) << 4) + (((bc >> 4) & 3) << 2)) : bc;
    const unsigned char* ap0 = RP(m0 + ar0); const unsigned char* ap1 = RP(m0 + ar0 + 64); const unsigned char* ap2 = RP(m0 + ar0 + 128); const unsigned char* ap3 = RP(m0 + ar0 + 192);
    const float* bp = CP(n0 + bc);
    const f32x4 epre = E.pre(m0 + wm * 64, lane);
    f32x4 acc[4][4];
#pragma unroll
    for (int m = 0; m < 4; ++m)
#pragma unroll
        for (int n = 0; n < 4; ++n) acc[m][n] = (f32x4){0.f, 0.f, 0.f, 0.f};
    const u32x4 z4 = (u32x4){0u, 0u, 0u, 0u};
    const f32x4 zf = (f32x4){0.f, 0.f, 0.f, 0.f};
    u32x4 ra[4] = {z4, z4, z4, z4}; f32x4 rb[8] = {zf, zf, zf, zf, zf, zf, zf, zf};
    const int nk = K / GBK;
    const bool docomp = wm * 64 < mvalid;
#define G2_LOAD(kt_) do { const int k0_ = (kt_) * GBK; \
        const float* q0_ = bp + (size_t)(k0_ + 8 * bg) * ldk; \
        _Pragma("unroll") for (int j_ = 0; j_ < 8; ++j_) rb[j_] = *(const f32x4*)(q0_ + (size_t)j_ * ldk); \
        ra[0] = *(const u32x4*)(ap0 + k0_ + ac); ra[1] = *(const u32x4*)(ap1 + k0_ + ac); \
        ra[2] = *(const u32x4*)(ap2 + k0_ + ac); ra[3] = *(const u32x4*)(ap3 + k0_ + ac); } while (0)
#define G2_STORE(buf_) do { LAS unsigned char* As_ = lds + (buf_) * G2_STAGE; LAS unsigned char* Bs_ = As_ + G2_AS; \
        u32x4 w0_, w1_;     \
        w0_.x = pk4_fp8(rb[0].x, rb[1].x, rb[2].x, rb[3].x); w0_.y = pk4_fp8(rb[4].x, rb[5].x, rb[6].x, rb[7].x); w0_.z = pk4_fp8(rb[0].y, rb[1].y, rb[2].y, rb[3].y); w0_.w = pk4_fp8(rb[4].y, rb[5].y, rb[6].y, rb[7].y); \
        w1_.x = pk4_fp8(rb[0].z, rb[1].z, rb[2].z, rb[3].z); w1_.y = pk4_fp8(rb[4].z, rb[5].z, rb[6].z, rb[7].z); w1_.z = pk4_fp8(rb[0].w, rb[1].w, rb[2].w, rb[3].w); w1_.w = pk4_fp8(rb[4].w, rb[5].w, rb[6].w, rb[7].w); \
        *(LAS u32x4*)(Bs_ + bg * GBS + bpos * 8) = w0_; *(LAS u32x4*)(Bs_ + bg * GBS + bpos * 8 + 16) = w1_; \
        _Pragma("unroll") for (int j_ = 0; j_ < 4; ++j_) *(LAS u32x4*)(As_ + (ar0 + 64 * j_) * GLB + ac) = ra[j_]; } while (0)
#define G2_COMPUTE(buf_) do { const LAS unsigned char* As_ = lds + (buf_) * G2_STAGE + (wm * 64) * GLB + fq * 16; const LAS unsigned char* Bs_ = lds + (buf_) * G2_STAGE + G2_AS + (wn * 64 + fr) * 8 + (2 * fq) * GBS; \
        i32x8v af_[4], bfa_, bfb_; \
        _Pragma("unroll") for (int m_ = 0; m_ < 4; ++m_) af_[m_] = cat8(*(const LAS i32x4v*)(As_ + (m_ * 16 + fr) * GLB), *(const LAS i32x4v*)(As_ + (m_ * 16 + fr) * GLB + 64)); \
        F8_LOADB(bfa_, Bs_, 0); F8_LOADB(bfb_, Bs_, 1); \
        _Pragma("unroll") for (int m_ = 0; m_ < 4; ++m_) acc[m_][0] = MFMA_F8_128(bfa_, af_[m_], acc[m_][0]); \
        F8_LOADB(bfa_, Bs_, 2); \
        _Pragma("unroll") for (int m_ = 0; m_ < 4; ++m_) acc[m_][1] = MFMA_F8_128(bfb_, af_[m_], acc[m_][1]); \
        F8_LOADB(bfb_, Bs_, 3); \
        _Pragma("unroll") for (int m_ = 0; m_ < 4; ++m_) acc[m_][2] = MFMA_F8_128(bfa_, af_[m_], acc[m_][2]); \
        _Pragma("unroll") for (int m_ = 0; m_ < 4; ++m_) acc[m_][3] = MFMA_F8_128(bfb_, af_[m_], acc[m_][3]); } while (0)
    G2_LOAD(0);
    G2_STORE(0);
    if (nk > 1) G2_LOAD(1);
    __syncthreads();
#pragma unroll 1
    for (int kt = 0; kt < nk; ++kt) {
        const int cur = kt & 1;
        if (docomp) G2_COMPUTE(cur);
        if (kt + 1 < nk) { G2_STORE(cur ^ 1); if (kt + 2 < nk) G2_LOAD(kt + 2); }
        __syncthreads();
    }
#undef G2_LOAD
#undef G2_STORE
#undef G2_COMPUTE
    E(acc, m0 + wm * 64, n0 + wn * 64, lane, epre);
}

constexpr int DLA = 272;
constexpr int D_AS = 256 * DLA;
template <bool IMG>
__device__ __forceinline__ void expert_down_unit(LAS unsigned char* lds, const unsigned char* act, const float* W  , int nq, unsigned char* y, const float* lw, int slot0, int nvalid) {
    const int tid = fresh_tid(), lane = tid & 63, wid = tid >> 6, wm = wid >> 1, wn = wid & 1;
    const int fr = lane & 15, fq = lane >> 4;
    const int bc = 4 * (tid & 31), bg = tid >> 5;
    const int bpos = (bc & ~63) + (((bc >> 2) & 3) << 4) + (((bc >> 4) & 3) << 2);
    LAS unsigned char* Al = lds;
    LAS unsigned char* Bl = lds + D_AS;
    f32x4 rbA[8];
    const float* wbase = W + nq * 512 + bc;
    const unsigned char* ip = (const unsigned char*)W + bg * 1024 + bpos * 8;
#define D_LOAD(t_, rb) do { if (IMG) { const GAS unsigned char* ip_ = (const GAS unsigned char*)ip; asm volatile("" : "+v"(ip_)); rb[0] = *(const GAS f32x4*)(ip_ + (size_t)(t_) * 16384); rb[1] = *(const GAS f32x4*)(ip_ + (size_t)(t_) * 16384 + 16); } else { const GAS float* wb_ = (const GAS float*)wbase; asm volatile("" : "+v"(wb_));     \
        const GAS float* q0_ = wb_ + ((t_) >> 1) * 128 + (size_t)(((t_) & 1) * 128 + 8 * bg) * 1024; \
        _Pragma("unroll") for (int j_ = 0; j_ < 8; ++j_) rb[j_] = *(const GAS f32x4*)(q0_ + (size_t)j_ * 1024); } } while (0)
#define D_STORE(buf_, rb) do { LAS unsigned char* Bs_ = Bl + (buf_) * G2_BS; u32x4 w0_, w1_; \
        if (IMG) { w0_ = __builtin_bit_cast(u32x4, rb[0]); w1_ = __builtin_bit_cast(u32x4, rb[1]); } else { \
        w0_.x = pk4_fp8(rb[0].x, rb[1].x, rb[2].x, rb[3].x); w0_.y = pk4_fp8(rb[4].x, rb[5].x, rb[6].x, rb[7].x); w0_.z = pk4_fp8(rb[0].y, rb[1].y, rb[2].y, rb[3].y); w0_.w = pk4_fp8(rb[4].y, rb[5].y, rb[6].y, rb[7].y); \
        w1_.x = pk4_fp8(rb[0].z, rb[1].z, rb[2].z, rb[3].z); w1_.y = pk4_fp8(rb[4].z, rb[5].z, rb[6].z, rb[7].z); w1_.z = pk4_fp8(rb[0].w, rb[1].w, rb[2].w, rb[3].w); w1_.w = pk4_fp8(rb[4].w, rb[5].w, rb[6].w, rb[7].w); \
        } \
        *(LAS u32x4*)(Bs_ + bg * GBS + bpos * 8) = w0_; *(LAS u32x4*)(Bs_ + bg * GBS + bpos * 8 + 16) = w1_; } while (0)
    D_LOAD(0, rbA);
    {
        const int c16 = (tid & 15) * 16, r0 = tid >> 4;
        const u32x4 z4 = (u32x4){0u, 0u, 0u, 0u};
        u32x4 v[8];
#pragma unroll
        for (int j = 0; j < 8; ++j) { const int r = r0 + 32 * j; v[j] = (r < nvalid) ? *(const u32x4*)(act + (size_t)(slot0 + r) * EDIM + c16) : z4; }
#pragma unroll
        for (int j = 0; j < 8; ++j) *(LAS u32x4*)(Al + (r0 + 32 * j) * DLA + c16) = v[j];
    }
    f32x4 acc[4][4];
#pragma unroll
    for (int m = 0; m < 4; ++m)
#pragma unroll
        for (int n = 0; n < 4; ++n) acc[m][n] = (f32x4){0.f, 0.f, 0.f, 0.f};
    const bool docomp = wm * 64 < nvalid;
    float wrow_[4];
#pragma unroll
    for (int m = 0; m < 4; ++m) { const int r = wm * 64 + m * 16 + fr; wrow_[m] = (r < nvalid) ? (lw ? lw[r] : 1.f) : 0.f; }
#define D_COMPUTE(t_) do { const LAS unsigned char* As_ = Al + (wm * 64) * DLA + ((t_) & 1) * 128 + fq * 16; const LAS unsigned char* Bs_ = Bl + ((t_) & 1) * G2_BS + (wn * 64 + fr) * 8 + (2 * fq) * GBS; \
        i32x8v af_[4], bfa_, bfb_; \
        _Pragma("unroll") for (int m_ = 0; m_ < 4; ++m_) af_[m_] = cat8(*(const LAS i32x4v*)(As_ + (m_ * 16 + fr) * DLA), *(const LAS i32x4v*)(As_ + (m_ * 16 + fr) * DLA + 64)); \
        F8_LOADB(bfa_, Bs_, 0); F8_LOADB(bfb_, Bs_, 1); \
        _Pragma("unroll") for (int m_ = 0; m_ < 4; ++m_) acc[m_][0] = MFMA_F8_128(bfa_, af_[m_], acc[m_][0]); \
        F8_LOADB(bfa_, Bs_, 2); \
        _Pragma("unroll") for (int m_ = 0; m_ < 4; ++m_) acc[m_][1] = MFMA_F8_128(bfb_, af_[m_], acc[m_][1]); \
        F8_LOADB(bfb_, Bs_, 3); \
        _Pragma("unroll") for (int m_ = 0; m_ < 4; ++m_) acc[m_][2] = MFMA_F8_128(bfa_, af_[m_], acc[m_][2]); \
        _Pragma("unroll") for (int m_ = 0; m_ < 4; ++m_) acc[m_][3] = MFMA_F8_128(bfb_, af_[m_], acc[m_][3]); \
        if ((t_) & 1) {     \
            const int cb_ = nq * 512 + ((t_) >> 1) * 128 + wn * 64; \
            _Pragma("unroll") for (int m_ = 0; m_ < 4; ++m_) { const int r_ = wm * 64 + m_ * 16 + fr; \
                if (r_ < nvalid) { const float wt_ = wrow_[m_]; u32x4 w_; \
                    { const f32x4 v_ = acc[m_][0] * wt_; w_.x = pk4_fp8(v_.x, v_.y, v_.z, v_.w); } { const f32x4 v_ = acc[m_][1] * wt_; w_.y = pk4_fp8(v_.x, v_.y, v_.z, v_.w); } \
                    { const f32x4 v_ = acc[m_][2] * wt_; w_.z = pk4_fp8(v_.x, v_.y, v_.z, v_.w); } { const f32x4 v_ = acc[m_][3] * wt_; w_.w = pk4_fp8(v_.x, v_.y, v_.z, v_.w); } \
                    asm volatile("global_store_dwordx4 %0, %1, off" :: "v"(y + (size_t)(slot0 + r_) * 1024 + cb_ + 16 * fq), "v"(w_) : "memory"); }     \
                _Pragma("unroll") for (int n_ = 0; n_ < 4; ++n_) acc[m_][n_] = (f32x4){0.f, 0.f, 0.f, 0.f}; } } } while (0)
    D_STORE(0, rbA);
    D_LOAD(1, rbA);
    __syncthreads();
#pragma unroll
    for (int t = 0; t < 8; ++t) {
        if (docomp) D_COMPUTE(t);
        if (t + 1 < 8) { D_STORE((t + 1) & 1, rbA); if (t + 2 < 8) D_LOAD(t + 2, rbA); }
        __syncthreads();
    }
#undef D_LOAD
#undef D_STORE
#undef D_COMPUTE
}

struct RowDense { const bf16_t* A; int lda; __device__ __forceinline__ const bf16_t* operator()(int r) const { return A + (size_t)r * lda; } };
struct RowGather { const unsigned char* A; const int* idx; int nvalid; __device__ __forceinline__ const unsigned char* operator()(int r) const { return A + (size_t)idx[r < nvalid ? r : 0] * D; } };
struct RowSlots { const unsigned char* A; int nvalid; __device__ __forceinline__ const unsigned char* operator()(int r) const { return r < nvalid ? A + (size_t)r * EDIM : nullptr; } };
struct ColDense { const float* W; int N; __device__ __forceinline__ const float* operator()(int c) const { return c < N ? W + c : nullptr; } };
struct ColMqk { const float* q; ptrdiff_t dk; __device__ __forceinline__ const float* operator()(int c) const { return q + ((c < 128) ? (ptrdiff_t)c : dk + (c - 128)); } };
struct ColGU { const float* g; ptrdiff_t du;
    __device__ __forceinline__ const float* operator()(int c) const { const int tb = c >> 7, cc = c & 127, wnn = cc >> 6, n = (cc >> 4) & 3, rho = cc & 15;
        return g + (((n & 1) ? du : (ptrdiff_t)0) + tb * 64 + wnn * 32 + 8 * (rho >> 2) + 4 * (n >> 1) + (rho & 3)); } };
struct ColRgu { const float* r; ptrdiff_t dg; ptrdiff_t du; __device__ __forceinline__ const float* operator()(int c) const {
    const int cc = c - 256, j = cc >> 5, w = cc & 31; const ptrdiff_t off = (c < 256) ? (ptrdiff_t)c : (((w & 16) ? du : dg) + j * 16 + (w & 15)); return r + off; } };

__device__ __forceinline__ u32x2 pack4(const f32x4 v) { u32x2 w; w.x = cvt_pk_bf16(v.x, v.y); w.y = cvt_pk_bf16(v.z, v.w); return w; }
__device__ __forceinline__ u32x2 pack_swiglu(const f32x4 g, const f32x4 u) { u32x2 w; w.x = cvt_pk_bf16(siluf_(g.x) * u.x, siluf_(g.y) * u.y); w.y = cvt_pk_bf16(siluf_(g.z) * u.z, siluf_(g.w) * u.w); return w; }
struct EpiProj {
    bf16_t* proj; float* graw;
    __device__ __forceinline__ f32x4 pre(int rb, int lane) const { return (f32x4){0.f, 0.f, 0.f, 0.f}; }
    __device__ __forceinline__ void operator()(const f32x4 (&acc)[4][4], int rb, int cb, int lane, const f32x4 epre) const {
        const int fr = lane & 15, fq = lane >> 4;
#pragma unroll
        for (int m = 0; m < 4; ++m)
#pragma unroll
            for (int n = 0; n < 4; ++n) {
                const int row = rb + m * 16 + fr, col = cb + n * 16 + 4 * fq;
                if (col < OFF_GATE) *(u32x2*)(proj + (size_t)row * IN_DIM + col) = pack4(acc[m][n]);
                else if (col < IN_DIM) *(f32x4*)(graw + (size_t)row * 8 + (col - OFF_GATE)) = acc[m][n];
            }
    }
};
struct EpiNull {
    float* sink;
    __device__ __forceinline__ f32x4 pre(int rb, int lane) const { return (f32x4){0.f, 0.f, 0.f, 0.f}; }
    __device__ __forceinline__ void operator()(const f32x4 (&acc)[4][4], int rb, int cb, int lane, const f32x4 epre) const {
        float t = 0.f;
#pragma unroll
        for (int m = 0; m < 4; ++m)
#pragma unroll
            for (int n = 0; n < 4; ++n) t += acc[m][n].x + acc[m][n].y + acc[m][n].z + acc[m][n].w;
        if (t == 12345.678f) sink[lane] = t;
    }
};
struct EpiBf16 {
    bf16_t* O; int ldc;
    __device__ __forceinline__ f32x4 pre(int rb, int lane) const { return (f32x4){0.f, 0.f, 0.f, 0.f}; }
    __device__ __forceinline__ void operator()(const f32x4 (&acc)[4][4], int rb, int cb, int lane, const f32x4 epre) const {
        const int fr = lane & 15, fq = lane >> 4;
#pragma unroll
        for (int m = 0; m < 4; ++m)
#pragma unroll
            for (int n = 0; n < 4; ++n) *(u32x2*)(O + (size_t)(rb + m * 16 + fr) * ldc + cb + n * 16 + 4 * fq) = pack4(acc[m][n]);
    }
};
struct EpiMqk {
    bf16_t* mq; bf16_t* mk; int h;
    __device__ __forceinline__ f32x4 pre(int rb, int lane) const { return (f32x4){0.f, 0.f, 0.f, 0.f}; }
    __device__ __forceinline__ void operator()(const f32x4 (&acc)[4][4], int rb, int cb, int lane, const f32x4 epre) const {
        const int fr = lane & 15, fq = lane >> 4;
#pragma unroll
        for (int m = 0; m < 4; ++m)
#pragma unroll
            for (int n = 0; n < 4; ++n) {
                const int row = rb + m * 16 + fr, col = cb + n * 16 + 4 * fq; f32x4 v = acc[m][n];
                bf16_t* dst = mq; int c = col;
                if (col >= 128) { dst = mk; c = col - 128; v = v * 0.08838834764831845f; }
                *(u32x2*)(dst + (size_t)row * MINNER + h * DM + c) = pack4(v);
            }
    }
};
struct EpiResid {
    const float* X; const float* ada; int gt_off; float* out;
    __device__ __forceinline__ f32x4 pre(int rb, int lane) const { return (f32x4){0.f, 0.f, 0.f, 0.f}; }
    __device__ __forceinline__ void operator()(const f32x4 (&acc)[4][4], int rb, int cb, int lane, const f32x4 epre) const {
        const int fr = lane & 15, fq = lane >> 4;
#pragma unroll
        for (int m = 0; m < 4; ++m)
#pragma unroll
            for (int n = 0; n < 4; ++n) {
                const int row = rb + m * 16 + fr, col = cb + n * 16 + 4 * fq; const int b = row / S;
                const f32x4 g = *(const f32x4*)(ada + b * 6144 + gt_off + col);
                const f32x4 x = *(const f32x4*)(X + (size_t)row * D + col);
                *(f32x4*)(out + (size_t)row * D + col) = x + g * acc[m][n];
            }
    }
};
struct EpiRgu {
    float* logits; unsigned char* act;
    __device__ __forceinline__ f32x4 pre(int rb, int lane) const { return (f32x4){0.f, 0.f, 0.f, 0.f}; }
    __device__ __forceinline__ void operator()(const f32x4 (&acc)[4][4], int rb, int cb, int lane, const f32x4 epre) const {
        const int fr = lane & 15, fq = lane >> 4;
#pragma unroll
        for (int m = 0; m < 4; ++m) {
            const int row = rb + m * 16 + fr;
            if (cb < 256) {
#pragma unroll
                for (int n = 0; n < 4; ++n) *(f32x4*)(logits + (size_t)row * 256 + cb + n * 16 + 4 * fq) = acc[m][n];
            } else {
                const int j0 = (cb - 256) >> 5;
#pragma unroll
                for (int pp = 0; pp < 2; ++pp) *(u32x2*)(act + (size_t)row * 256 + (j0 + pp) * 16 + 4 * fq) = pack_swiglu(acc[m][2 * pp], acc[m][2 * pp + 1]);
            }
        }
    }
};
struct EpiExpAct {
    static constexpr bool PERM = false;
    unsigned char* act; int slot0; int nvalid;
    __device__ __forceinline__ f32x4 pre(int rb, int lane) const { const f32x4 z = {0.f, 0.f, 0.f, 0.f}; return z; }
    __device__ __forceinline__ void operator()(const f32x4 (&acc)[4][4], int rb, int cb, int lane, const f32x4 epre) const {
        const int fr = lane & 15, fq = lane >> 4;
#pragma unroll
        for (int m = 0; m < 4; ++m) {
            const int r = rb + m * 16 + fr;
            if (r < nvalid) {
                u32x2 w;
                { const f32x4 g = acc[m][0], u = acc[m][1]; w.x = pk4_fp8(siluf_(g.x) * u.x, siluf_(g.y) * u.y, siluf_(g.z) * u.z, siluf_(g.w) * u.w); }
                { const f32x4 g = acc[m][2], u = acc[m][3]; w.y = pk4_fp8(siluf_(g.x) * u.x, siluf_(g.y) * u.y, siluf_(g.z) * u.z, siluf_(g.w) * u.w); }
                *(u32x2*)(act + (size_t)(slot0 + r) * 256 + (cb >> 1) + 8 * fq) = w;
            }
        }
    }
};
struct EpiExpDown {
    static constexpr bool PERM = true;
    unsigned char* y; const float* lw; int slot0; int nvalid;
    __device__ __forceinline__ f32x4 pre(int rb, int lane) const {
        const int fr = lane & 15; f32x4 w;
        w.x = (rb + fr < nvalid) ? lw[rb + fr] : 0.f; w.y = (rb + 16 + fr < nvalid) ? lw[rb + 16 + fr] : 0.f;
        w.z = (rb + 32 + fr < nvalid) ? lw[rb + 32 + fr] : 0.f; w.w = (rb + 48 + fr < nvalid) ? lw[rb + 48 + fr] : 0.f; return w; }
    __device__ __forceinline__ void operator()(const f32x4 (&acc)[4][4], int rb, int cb, int lane, const f32x4 epre) const {
        const int fr = lane & 15, fq = lane >> 4;
#pragma unroll
        for (int m = 0; m < 4; ++m) {
            const int r = rb + m * 16 + fr;
            if (r < nvalid) {
                const float wt = epre[m];
                u32x4 w;
                { const f32x4 v = acc[m][0] * wt; w.x = pk4_fp8(v.x, v.y, v.z, v.w); }
                { const f32x4 v = acc[m][1] * wt; w.y = pk4_fp8(v.x, v.y, v.z, v.w); }
                { const f32x4 v = acc[m][2] * wt; w.z = pk4_fp8(v.x, v.y, v.z, v.w); }
                { const f32x4 v = acc[m][3] * wt; w.w = pk4_fp8(v.x, v.y, v.z, v.w); }
                *(u32x4*)(y + (size_t)(slot0 + r) * 1024 + cb + 16 * fq) = w;
            }
        }
    }
};

constexpr int AKLD = 104, AVLD = 80;
__device__ __forceinline__ void attn_unit(const Params& p, LAS unsigned char* lds, int bh, int qb) {
    LAS bf16_t* Ks = (LAS bf16_t*)lds;
    LAS bf16_t* Vt = Ks + 64 * AKLD;
    const bf16_t* Q = (const bf16_t*)(p.ws + B_Q) + (size_t)bh * S * 96;
    const bf16_t* Kg = (const bf16_t*)(p.ws + B_K) + (size_t)bh * S * 96;
    const int b = bh >> 3, h = bh & 7;
    const bf16_t* Vg = (const bf16_t*)(p.ws + B_KVRAW) + (size_t)b * S * 1024 + h * 128 + 64;
    bf16_t* O = (bf16_t*)(p.ws + B_ORAW) + (size_t)b * S * 512 + h * 64;
    const int tid = fresh_tid(), lane = tid & 63, wid = tid >> 6, fr = lane & 15, fq = lane >> 4;
    const int q0 = qb * 256, qw0 = q0 + wid * 32;
    bf16x8 qf[2][3];
#pragma unroll
    for (int nq = 0; nq < 2; ++nq)
#pragma unroll
        for (int ks = 0; ks < 3; ++ks) qf[nq][ks] = *(const bf16x8*)(Q + (size_t)(qw0 + nq * 16 + fr) * 96 + ks * 32 + fq * 8);
    f32x4 oacc[4][2];
#pragma unroll
    for (int d = 0; d < 4; ++d)
#pragma unroll
        for (int nq = 0; nq < 2; ++nq) oacc[d][nq] = (f32x4){0.f, 0.f, 0.f, 0.f};
    float mrun[2] = {-1e30f, -1e30f}, lrun[2] = {0.f, 0.f};
    const int ntiles = (q0 + 256) / 64;
    constexpr int ASTG = 64 * AKLD + 64 * AVLD;
    const int kc0 = tid, kc1 = tid + NT;
    const int kr0 = kc0 / 12, kq0 = kc0 - kr0 * 12, kr1 = kc1 / 12, kq1 = kc1 - kr1 * 12;
    const int vkey = tid & 63, vdc = tid >> 6;
    u32x4 rk0, rk1 = (u32x4){0u, 0u, 0u, 0u}, rv;
#define ATT_LOAD(k0_) do { rk0 = *(const u32x4*)(Kg + (size_t)((k0_) + kr0) * 96 + kq0 * 8); if (kc1 < 768) rk1 = *(const u32x4*)(Kg + (size_t)((k0_) + kr1) * 96 + kq1 * 8); \
        rv = *(const u32x4*)(Vg + (size_t)((k0_) + vkey) * 1024 + vdc * 8); } while (0)
#define ATT_STORE(buf_) do { LAS bf16_t* Kd_ = Ks + (buf_) * ASTG; LAS bf16_t* Vd_ = Kd_ + 64 * AKLD; \
        *(LAS u32x4*)(Kd_ + kr0 * AKLD + kq0 * 8) = rk0; if (kc1 < 768) *(LAS u32x4*)(Kd_ + kr1 * AKLD + kq1 * 8) = rk1; \
        *(LAS u32x4*)(Vd_ + vkey * AVLD + vdc * 8) = rv; } while (0)
    ATT_LOAD(0);
    ATT_STORE(0);
    __syncthreads();
    for (int kt = 0; kt < ntiles; ++kt) {
        const int k0 = kt * 64;
        const LAS bf16_t* Kc = Ks + (kt & 1) * ASTG; const LAS bf16_t* Vc = Kc + 64 * AKLD;
        if (kt + 1 < ntiles) ATT_LOAD(k0 + 64);
        if (k0 <= qw0 + 31) {
            f32x4 sacc[4][2];
#pragma unroll
            for (int t4 = 0; t4 < 4; ++t4)
#pragma unroll
                for (int nq = 0; nq < 2; ++nq) sacc[t4][nq] = (f32x4){0.f, 0.f, 0.f, 0.f};
#pragma unroll
            for (int ks = 0; ks < 3; ++ks)
#pragma unroll
                for (int t4 = 0; t4 < 4; ++t4) {
                    const bf16x8 kf = *(const LAS bf16x8*)(Kc + (t4 * 16 + fr) * AKLD + ks * 32 + fq * 8);
#pragma unroll
                    for (int nq = 0; nq < 2; ++nq) sacc[t4][nq] = MFMA16(kf, qf[nq][ks], sacc[t4][nq]);
                }
            const bool need_mask = (k0 + 63 > qw0);
#pragma unroll
            for (int nq = 0; nq < 2; ++nq) {
                const int qidx = qw0 + nq * 16 + fr;
                float mx = -1e30f;
#pragma unroll
                for (int t4 = 0; t4 < 4; ++t4)
#pragma unroll
                    for (int i = 0; i < 4; ++i) {
                        if (need_mask) { const int key = k0 + t4 * 16 + 4 * fq + i; if (key > qidx) sacc[t4][nq][i] = -1e30f; }
                        mx = fmaxf(mx, sacc[t4][nq][i]);
                    }
                mx = x32_max(x16_max(mx));
                const float mnew = fmaxf(mrun[nq], mx);
                float ls = 0.f;
#pragma unroll
                for (int t4 = 0; t4 < 4; ++t4)
#pragma unroll
                    for (int i = 0; i < 4; ++i) { const float pv = __builtin_amdgcn_exp2f(sacc[t4][nq][i] - mnew); sacc[t4][nq][i] = pv; ls += pv; }
                if (__ballot(mnew > mrun[nq])) {
                    const float alpha = __builtin_amdgcn_exp2f(mrun[nq] - mnew);
                    lrun[nq] = lrun[nq] * alpha + ls;
#pragma unroll
                    for (int d = 0; d < 4; ++d) oacc[d][nq] = oacc[d][nq] * alpha;
                } else lrun[nq] += ls;
                mrun[nq] = mnew;
            }
#pragma unroll
            for (int s2 = 0; s2 < 2; ++s2) {
                bf16x8 pb[2];
#pragma unroll
                for (int nq = 0; nq < 2; ++nq) {
                    u32x4 w; w.x = cvt_pk_bf16(sacc[2 * s2][nq].x, sacc[2 * s2][nq].y); w.y = cvt_pk_bf16(sacc[2 * s2][nq].z, sacc[2 * s2][nq].w);
                    w.z = cvt_pk_bf16(sacc[2 * s2 + 1][nq].x, sacc[2 * s2 + 1][nq].y); w.w = cvt_pk_bf16(sacc[2 * s2 + 1][nq].z, sacc[2 * s2 + 1][nq].w);
                    pb[nq] = __builtin_bit_cast(bf16x8, w);
                }
#pragma unroll
                for (int d = 0; d < 4; ++d) {
                    typedef short s16x4_ __attribute__((ext_vector_type(4)));
                    LAS s16x4_* vr = (LAS s16x4_*)(Vc + (s2 * 32 + 4 * fq + (fr >> 2)) * AVLD + d * 16 + 4 * (fr & 3));
                    const s16x4_ lo = __builtin_amdgcn_ds_read_tr16_b64_v4i16(vr), hi = __builtin_amdgcn_ds_read_tr16_b64_v4i16(vr + (16 * AVLD) / 4);
                    const bf16x8 vf = __builtin_bit_cast(bf16x8, __builtin_shufflevector(lo, hi, 0, 1, 2, 3, 4, 5, 6, 7));
#pragma unroll
                    for (int nq = 0; nq < 2; ++nq) oacc[d][nq] = MFMA16(vf, pb[nq], oacc[d][nq]);
                }
            }
        }
        if (kt + 1 < ntiles) ATT_STORE((kt + 1) & 1);
        __syncthreads();
    }
#undef ATT_LOAD
#undef ATT_STORE
#pragma unroll
    for (int nq = 0; nq < 2; ++nq) {
        const float l = x32_sum(x16_sum(lrun[nq]));
        const float inv = 1.f / l;
        const int qidx = qw0 + nq * 16 + fr;
#pragma unroll
        for (int d = 0; d < 4; ++d) { const f32x4 v = oacc[d][nq] * inv; u32x2 w; w.x = cvt_pk_bf16(v.x, v.y); w.y = cvt_pk_bf16(v.z, v.w);
            *(u32x2*)(O + (size_t)qidx * 512 + d * 16 + 4 * fq) = w; }
    }
}

constexpr int MTLD = 72;
struct MaRegs { u32x4 kv[2], vv[2]; float li, lf; };
__device__ __forceinline__ void mlstm_a_load(const Params& p, int unit, MaRegs& R) {
    const int bh = unit >> 5, c = unit & 31, b = bh >> 2, h = bh & 3;
    const int t0 = b * S + c * CHUNK;
    const float* gl = (const float*)(p.ws + B_GL);
    const bf16_t* mk = (const bf16_t*)(p.ws + B_MK); const bf16_t* proj = (const bf16_t*)(p.ws + B_PROJ);
    const int tid = fresh_tid(), lane = tid & 63;
#pragma unroll
    for (int rep = 0; rep < 2; ++rep) {
        const int cidx = tid + rep * NT, s = cidx & 63, ch = cidx >> 6;
        R.kv[rep] = *(const u32x4*)(mk + (size_t)(t0 + s) * MINNER + h * DM + ch * 8);
        R.vv[rep] = *(const u32x4*)(proj + (size_t)(t0 + s) * IN_DIM + OFF_MV + h * DM + ch * 8);
    }
    R.li = gl[(size_t)(t0 + lane) * 8 + h]; R.lf = gl[(size_t)(t0 + lane) * 8 + 4 + h];
}
__device__ __forceinline__ void mlstm_a_unit(const Params& p, LAS unsigned char* lds, int unit, MaRegs& R, int next_unit) {
    LAS bf16_t* kT = (LAS bf16_t*)lds;
    LAS bf16_t* vT = kT + 128 * MTLD;
    LAS float* av = (LAS float*)(vT + 128 * MTLD);
    const int bh = unit >> 5, c = unit & 31, b = bh >> 2, h = bh & 3;
    const int t0 = b * S + c * CHUNK;
    const float* gl = (const float*)(p.ws + B_GL);
    const bf16_t* mk = (const bf16_t*)(p.ws + B_MK); const bf16_t* proj = (const bf16_t*)(p.ws + B_PROJ);
    const int tid = fresh_tid(), lane = tid & 63, wid = tid >> 6, fr = lane & 15, fq = lane >> 4;
    if (wid == 0) {
        const float li = R.li, lf = R.lf;
        const float bs = wave_scan_sum(lf);
        const float Btot = __uint_as_float((unsigned)__builtin_amdgcn_readlane((int)__float_as_uint(bs), 63));
        const float g = Btot - bs + li;
        const float ml = wave_max(g);
        av[lane] = __expf(g - ml);
        if (lane == 0) { ((float*)(p.ws + WS_BC))[unit] = Btot; ((float*)(p.ws + WS_MLOC))[unit] = ml; }
    }
    __syncthreads();
#pragma unroll
    for (int rep = 0; rep < 2; ++rep) {
        const int cidx = tid + rep * NT, s = cidx & 63, ch = cidx >> 6;
        const u32x4 kv = R.kv[rep];
        const u32x4 vv = R.vv[rep];
        const float a = av[s];
        LAS bf16_t* kt = kT + (ch * 8) * MTLD + s; LAS bf16_t* vt = vT + (ch * 8) * MTLD + s;
        const unsigned kk[4] = {kv.x, kv.y, kv.z, kv.w}; const unsigned vw[4] = {vv.x, vv.y, vv.z, vv.w};
#pragma unroll
        for (int j = 0; j < 4; ++j) {
            kt[(2 * j) * MTLD] = (bf16_t)(kk[j] & 0xffff); kt[(2 * j + 1) * MTLD] = (bf16_t)(kk[j] >> 16);
            const unsigned sc = cvt_pk_bf16(bflo(vw[j]) * a, bfhi(vw[j]) * a);
            vt[(2 * j) * MTLD] = (bf16_t)(sc & 0xffff); vt[(2 * j + 1) * MTLD] = (bf16_t)(sc >> 16);
        }
    }
    __syncthreads();
    if (next_unit >= 0) mlstm_a_load(p, next_unit, R);
    {
        const int we = wid >> 1, wd = wid & 1;
        f32x4 acc[2][4];
#pragma unroll
        for (int i = 0; i < 2; ++i)
#pragma unroll
            for (int j = 0; j < 4; ++j) acc[i][j] = (f32x4){0.f, 0.f, 0.f, 0.f};
#pragma unroll
        for (int ks = 0; ks < 2; ++ks) {
            bf16x8 vf[2], kf[4];
#pragma unroll
            for (int i = 0; i < 2; ++i) vf[i] = *(const LAS bf16x8*)(vT + (we * 32 + i * 16 + fr) * MTLD + ks * 32 + fq * 8);
#pragma unroll
            for (int j = 0; j < 4; ++j) kf[j] = *(const LAS bf16x8*)(kT + (wd * 64 + j * 16 + fr) * MTLD + ks * 32 + fq * 8);
#pragma unroll
            for (int i = 0; i < 2; ++i)
#pragma unroll
                for (int j = 0; j < 4; ++j) acc[i][j] = MFMA16(kf[j], vf[i], acc[i][j]);
        }
        bf16_t* dC = (bf16_t*)(p.ws + B_DC) + (size_t)unit * 16384;
#pragma unroll
        for (int i = 0; i < 2; ++i)
#pragma unroll
            for (int j = 0; j < 4; ++j) *(u32x2*)(dC + (we * 32 + i * 16 + fr) * 128 + wd * 64 + j * 16 + 4 * fq) = pack4(acc[i][j]);
    }
    if (tid < 128) {
        float s = 0.f;
        for (int q = 0; q < 64; ++q) s += bf2f(kT[tid * MTLD + q]) * av[q];
        ((float*)(p.ws + WS_DN))[(size_t)unit * 128 + tid] = s;
    }
    __syncthreads();
}

__device__ __forceinline__ void mlstm_scan(const Params& p, int gtid, int ngt) {
    const float* Bc = (const float*)(p.ws + WS_BC); const float* ML = (const float*)(p.ws + WS_MLOC);
    float* mprev = (float*)(p.ws + WS_MPREV);
    const bf16_t* dC = (const bf16_t*)(p.ws + B_DC); bf16_t* Cp = (bf16_t*)(p.ws + B_CPREV);
    const float* dn = (const float*)(p.ws + WS_DN); float* np_ = (float*)(p.ws + WS_NPREV);
    constexpr int PER = 4096, GRP = 16;
    for (int idx = gtid; idx < 32 * PER; idx += ngt) {
        const int bh = idx / PER, e4 = idx - bh * PER;
        const bool hasN = e4 < 32;
        float m = 0.f; f32x4 C = (f32x4){0.f, 0.f, 0.f, 0.f}, N = (f32x4){0.f, 0.f, 0.f, 0.f};
        for (int c0 = 0; c0 < NCH; c0 += GRP) {
            u32x2 d[GRP]; f32x4 dnv[GRP]; float Bt[GRP], ml[GRP];
#pragma unroll
            for (int q = 0; q < GRP; ++q) {
                const int unit = bh * NCH + c0 + q;
                Bt[q] = Bc[unit]; ml[q] = ML[unit];
                d[q] = *(const u32x2*)(dC + (size_t)unit * 16384 + e4 * 4);
                dnv[q] = hasN ? *(const f32x4*)(dn + (size_t)unit * 128 + e4 * 4) : (f32x4){0.f, 0.f, 0.f, 0.f};
            }
#pragma unroll
            for (int q = 0; q < GRP; ++q) {
                const int unit = bh * NCH + c0 + q;
                const float mnew = fmaxf(Bt[q] + m, ml[q]);
                const float fa = __expf(Bt[q] + m - mnew), fb = __expf(ml[q] - mnew);
                {
                    u32x2 w; w.x = cvt_pk_bf16(C.x, C.y); w.y = cvt_pk_bf16(C.z, C.w);
                    *(u32x2*)(Cp + (size_t)unit * 16384 + e4 * 4) = w;
                    if (e4 == 0) mprev[unit] = m;
                }
                if (hasN) *(f32x4*)(np_ + (size_t)unit * 128 + e4 * 4) = N;
                const f32x4 dq = (f32x4){bflo(d[q].x), bfhi(d[q].x), bflo(d[q].y), bfhi(d[q].y)};
                C = C * fa + dq * fb;
                N = N * fa + dnv[q] * fb;
                m = mnew;
            }
        }
    }
}

constexpr int MRLD = 136;
struct McRegs { u32x4 q[2], k[2], c[4], v[2]; float li, lf, mp, np; };
__device__ __forceinline__ void mlstm_c_load(const Params& p, int unit, McRegs& R) {
    const int bh = unit >> 5, c = unit & 31, b = bh >> 2, h = bh & 3;
    const int t0 = b * S + c * CHUNK;
    const float* gl = (const float*)(p.ws + B_GL);
    const bf16_t* mq = (const bf16_t*)(p.ws + B_MQ); const bf16_t* mk = (const bf16_t*)(p.ws + B_MK); const bf16_t* proj = (const bf16_t*)(p.ws + B_PROJ);
    const bf16_t* Cp = (const bf16_t*)(p.ws + B_CPREV) + (size_t)unit * 16384;
    const int tid = fresh_tid(), lane = tid & 63;
#pragma unroll
    for (int rep = 0; rep < 2; ++rep) {
        const int cidx = tid + rep * NT, r = cidx >> 4, ch = cidx & 15;
        R.q[rep] = *(const u32x4*)(mq + (size_t)(t0 + r) * MINNER + h * DM + ch * 8);
        R.k[rep] = *(const u32x4*)(mk + (size_t)(t0 + r) * MINNER + h * DM + ch * 8);
    }
#pragma unroll
    for (int rep = 0; rep < 4; ++rep) { const int cidx = tid + rep * NT, r = cidx >> 4, ch = cidx & 15; R.c[rep] = *(const u32x4*)(Cp + r * 128 + ch * 8); }
#pragma unroll
    for (int rep = 0; rep < 2; ++rep) { const int cidx = tid + rep * NT, sq = cidx & 63, ch = cidx >> 6; R.v[rep] = *(const u32x4*)(proj + (size_t)(t0 + sq) * IN_DIM + OFF_MV + h * DM + ch * 8); }
    R.li = gl[(size_t)(t0 + lane) * 8 + h]; R.lf = gl[(size_t)(t0 + lane) * 8 + 4 + h]; R.mp = ((const float*)(p.ws + WS_MPREV))[unit];
    R.np = ((const float*)(p.ws + WS_NPREV))[(size_t)unit * 128 + (tid & 127)];
}
__device__ __forceinline__ void mlstm_c_unit(const Params& p, LAS unsigned char* lds, int unit, McRegs& R, int next_unit) {
    LAS bf16_t* qs = (LAS bf16_t*)lds;
    LAS bf16_t* ks = qs + 64 * MRLD;
    LAS bf16_t* cs = ks + 64 * MRLD;
    LAS bf16_t* vT = cs + 128 * MRLD;
    LAS float* fv = (LAS float*)(vT + 128 * MTLD);
    LAS float* u_s = fv; LAS float* c_t = fv + 64; LAS float* dec = fv + 128; LAS float* emt = fv + 192; LAS float* ssq = fv + 256; LAS float* npl = fv + 384;
    const int bh = unit >> 5, c = unit & 31, b = bh >> 2, h = bh & 3;
    const int t0 = b * S + c * CHUNK;
    const bf16_t* proj = (const bf16_t*)(p.ws + B_PROJ);
    const int tid = fresh_tid(), lane = tid & 63, wid = tid >> 6, fr = lane & 15, fq = lane >> 4;
    if (wid == 0) {
        const float li = R.li, lf = R.lf;
        const float mp = R.mp;
        const float bs = wave_scan_sum(lf);
        const float u = li - bs;
        const float pm = wave_scan_max(u);
        const float inter = bs + mp;
        const float mt = fmaxf(inter, bs + pm);
        u_s[lane] = u; c_t[lane] = bs - mt; dec[lane] = __expf(inter - mt); emt[lane] = __expf(-mt);
    }
#pragma unroll
    for (int rep = 0; rep < 2; ++rep) {
        const int cidx = tid + rep * NT, r = cidx >> 4, ch = cidx & 15;
        *(LAS u32x4*)(qs + r * MRLD + ch * 8) = R.q[rep];
        *(LAS u32x4*)(ks + r * MRLD + ch * 8) = R.k[rep];
    }
#pragma unroll
    for (int rep = 0; rep < 4; ++rep) { const int cidx = tid + rep * NT, r = cidx >> 4, ch = cidx & 15; *(LAS u32x4*)(cs + r * MRLD + ch * 8) = R.c[rep]; }
#pragma unroll
    for (int rep = 0; rep < 2; ++rep) {
        const int cidx = tid + rep * NT, sq = cidx & 63, ch = cidx >> 6;
        const u32x4 vv = R.v[rep];
        LAS bf16_t* vt = vT + (ch * 8) * MTLD + sq;
        const unsigned vw[4] = {vv.x, vv.y, vv.z, vv.w};
#pragma unroll
        for (int j = 0; j < 4; ++j) { vt[(2 * j) * MTLD] = (bf16_t)(vw[j] & 0xffff); vt[(2 * j + 1) * MTLD] = (bf16_t)(vw[j] >> 16); }
    }
    if (tid < 128) npl[tid] = R.np;
    __syncthreads();
    if (next_unit >= 0) mlstm_c_load(p, next_unit, R);
    const int tt = wid & 3, eh = wid >> 2;
    const int tl = tt * 16 + fr;
    u32x2 opv[4]; f32x4 gv[4];
    {
        const float* gmo_ = p.in[20] + h * DM;
#pragma unroll
        for (int et = 0; et < 4; ++et) { const int e = eh * 64 + et * 16 + 4 * fq; opv[et] = *(const u32x2*)(proj + (size_t)(t0 + tl) * IN_DIM + OFF_MO + h * DM + e); gv[et] = *(const f32x4*)(gmo_ + e); }
    }
    bf16x8 qf[4];
#pragma unroll
    for (int k4 = 0; k4 < 4; ++k4) qf[k4] = *(const LAS bf16x8*)(qs + tl * MRLD + k4 * 32 + fq * 8);
    f32x4 sacc[4];
#pragma unroll
    for (int st = 0; st < 4; ++st) sacc[st] = (f32x4){0.f, 0.f, 0.f, 0.f};
#pragma unroll
    for (int k4 = 0; k4 < 4; ++k4)
#pragma unroll
        for (int st = 0; st < 4; ++st) {
            const bf16x8 kf = *(const LAS bf16x8*)(ks + (st * 16 + fr) * MRLD + k4 * 32 + fq * 8);
            sacc[st] = MFMA16(kf, qf[k4], sacc[st]);
        }
    const float ct = c_t[tl];
    float rs = 0.f;
#pragma unroll
    for (int st = 0; st < 4; ++st)
#pragma unroll
        for (int i = 0; i < 4; ++i) {
            const int s = st * 16 + 4 * fq + i;
            const float w = (s <= tl) ? __expf(ct + u_s[s]) * sacc[st][i] : 0.f;
            sacc[st][i] = w; rs += w;
        }
    rs = x32_sum(x16_sum(rs));
    float nq;
    {
        f32x4 na = (f32x4){0.f, 0.f, 0.f, 0.f};
#pragma unroll
        for (int k4 = 0; k4 < 4; ++k4) {
            u32x4 w = (u32x4){0u, 0u, 0u, 0u};
            if (fr == 0) { const LAS float* nn = npl + k4 * 32 + fq * 8; w.x = cvt_pk_bf16(nn[0], nn[1]); w.y = cvt_pk_bf16(nn[2], nn[3]); w.z = cvt_pk_bf16(nn[4], nn[5]); w.w = cvt_pk_bf16(nn[6], nn[7]); }
            na = MFMA16(__builtin_bit_cast(bf16x8, w), qf[k4], na);
        }
        nq = __shfl(na.x, fr);
    }
    f32x4 acc[4];
#pragma unroll
    for (int et = 0; et < 4; ++et) acc[et] = (f32x4){0.f, 0.f, 0.f, 0.f};
#pragma unroll
    for (int k4 = 0; k4 < 4; ++k4)
#pragma unroll
        for (int et = 0; et < 4; ++et) {
            const bf16x8 cf = *(const LAS bf16x8*)(cs + (eh * 64 + et * 16 + fr) * MRLD + k4 * 32 + fq * 8);
            acc[et] = MFMA16(cf, qf[k4], acc[et]);
        }
    const float dcy = dec[tl];
#pragma unroll
    for (int et = 0; et < 4; ++et) acc[et] = acc[et] * dcy;
#pragma unroll
    for (int s2 = 0; s2 < 2; ++s2) {
        u32x4 w; w.x = cvt_pk_bf16(sacc[2 * s2].x, sacc[2 * s2].y); w.y = cvt_pk_bf16(sacc[2 * s2].z, sacc[2 * s2].w);
        w.z = cvt_pk_bf16(sacc[2 * s2 + 1].x, sacc[2 * s2 + 1].y); w.w = cvt_pk_bf16(sacc[2 * s2 + 1].z, sacc[2 * s2 + 1].w);
        const bf16x8 pb = __builtin_bit_cast(bf16x8, w);
#pragma unroll
        for (int et = 0; et < 4; ++et) {
            const LAS bf16_t* vr = vT + (eh * 64 + et * 16 + fr) * MTLD + s2 * 32 + 4 * fq;
            const u32x2 lo = *(const LAS u32x2*)vr, hi = *(const LAS u32x2*)(vr + 16);
            acc[et] = MFMA16(__builtin_bit_cast(bf16x8, ((u32x4){lo.x, lo.y, hi.x, hi.y})), pb, acc[et]);
        }
    }
    const float den = dcy * nq + rs;
    const float hd = 1.f / fmaxf(fabsf(den), emt[tl]);
    float sq = 0.f;
#pragma unroll
    for (int et = 0; et < 4; ++et) { acc[et] = acc[et] * hd; sq += acc[et].x * acc[et].x + acc[et].y * acc[et].y + acc[et].z * acc[et].z + acc[et].w * acc[et].w; }
    sq = x32_sum(x16_sum(sq));
    if (fq == 0) ssq[eh * 64 + tl] = sq;
    __syncthreads();
    const float rinv = rsqrtf((ssq[tl] + ssq[64 + tl]) * (1.f / 128.f) + RMS_EPS);
    bf16_t* ao = (bf16_t*)(p.ws + B_AO);
#pragma unroll
    for (int et = 0; et < 4; ++et) {
        const int e = eh * 64 + et * 16 + 4 * fq;
        const u32x2 op = opv[et];
        const f32x4 g = gv[et];
        const f32x4 v = acc[et] * rinv * g;
        u32x2 w; w.x = cvt_pk_bf16(v.x * sigmoidf_(bflo(op.x)), v.y * sigmoidf_(bfhi(op.x))); w.y = cvt_pk_bf16(v.z * sigmoidf_(bflo(op.y)), v.w * sigmoidf_(bfhi(op.y)));
        *(u32x2*)(ao + (size_t)(t0 + tl) * 1024 + 512 + h * DM + e) = w;
    }
    __syncthreads();
}

__device__ __forceinline__ unsigned fkey(float f) { const unsigned u = __float_as_uint(f); return (u & 0x80000000u) ? ~u : (u | 0x80000000u); }
__device__ __forceinline__ float rdlane_f(float v, int l) { return __uint_as_float((unsigned)__builtin_amdgcn_readlane((int)__float_as_uint(v), l)); }
template <int CTRL> __device__ __forceinline__ unsigned dppu(unsigned v) { return (unsigned)__builtin_amdgcn_update_dpp(0, (int)v, CTRL, 0xF, 0xF, true); }
__device__ __forceinline__ unsigned umax_(unsigned a, unsigned b) { return a > b ? a : b; }
__device__ __forceinline__ unsigned wave_umax(unsigned v) {
    v = umax_(v, dppu<0xB1>(v)); v = umax_(v, dppu<0x4E>(v)); v = umax_(v, dppu<0x141>(v)); v = umax_(v, dppu<0x140>(v));
    { const auto r = __builtin_amdgcn_permlane16_swap(v, v, false, false); v = umax_(r[0], r[1]); }
    { const auto r = __builtin_amdgcn_permlane32_swap(v, v, false, false); v = umax_(r[0], r[1]); }
    return v;
}
__device__ __forceinline__ void route_token(const f32x4 cur, const f32x4 bias, int lane, int (&e8)[8], float (&w8)[8]) {
    float sc[4] = {sigmoidf_(cur.x), sigmoidf_(cur.y), sigmoidf_(cur.z), sigmoidf_(cur.w)};
    float sb[4] = {sc[0] + bias.x, sc[1] + bias.y, sc[2] + bias.z, sc[3] + bias.w};
    float t1 = fmaxf(fmaxf(sb[0], sb[1]), fmaxf(sb[2], sb[3]));
    float t2;
    {   const float a = fmaxf(sb[0], sb[1]), bmin = fminf(sb[0], sb[1]), c2 = fmaxf(sb[2], sb[3]), dmin = fminf(sb[2], sb[3]);
        t2 = fmaxf(fminf(a, c2), fmaxf(bmin, dmin)); }
    {   const float o1 = dppf<0xB1>(t1), o2 = dppf<0xB1>(t2); const float n1 = fmaxf(t1, o1), n2 = fmaxf(fminf(t1, o1), fmaxf(t2, o2)); t1 = n1; t2 = n2; }
    {   const float o1 = dppf<0x4E>(t1), o2 = dppf<0x4E>(t2); const float n1 = fmaxf(t1, o1), n2 = fmaxf(fminf(t1, o1), fmaxf(t2, o2)); t1 = n1; t2 = n2; }
    {   const float o1 = dppf<0x141>(t1), o2 = dppf<0x141>(t2); const float n1 = fmaxf(t1, o1), n2 = fmaxf(fminf(t1, o1), fmaxf(t2, o2)); t1 = n1; t2 = n2; }
    const float gs = t1 + t2;
    const int myg = lane >> 3;
    int rank = 0;
#pragma unroll
    for (int g = 0; g < 8; ++g) { const float og = rdlane_f(gs, g * 8); rank += (og > gs || (og == gs && g < myg)) ? 1 : 0; }
    const bool keep = rank < 4;
    unsigned k0 = keep ? fkey(sb[0]) : 0u, k1 = keep ? fkey(sb[1]) : 0u, k2 = keep ? fkey(sb[2]) : 0u, k3 = keep ? fkey(sb[3]) : 0u;
    int j0 = 0, j1 = 1, j2 = 2, j3 = 3;
    float s0 = sc[0], s1 = sc[1], s2 = sc[2], s3 = sc[3];
#define RT_CE(ka, kb, ja, jb, sa, sb_) do { const bool sw_ = kb > ka; const unsigned tk_ = sw_ ? kb : ka; kb = sw_ ? ka : kb; ka = tk_; \
        const int tj_ = sw_ ? jb : ja; jb = sw_ ? ja : jb; ja = tj_; const float ts_ = sw_ ? sb_ : sa; sb_ = sw_ ? sa : sb_; sa = ts_; } while (0)
    RT_CE(k0, k1, j0, j1, s0, s1); RT_CE(k2, k3, j2, j3, s2, s3);
    RT_CE(k0, k2, j0, j2, s0, s2); RT_CE(k1, k3, j1, j3, s1, s3);
    RT_CE(k1, k2, j1, j2, s1, s2);
#undef RT_CE
    float wsum = 0.f;
#pragma unroll
    for (int k = 0; k < TOPK; ++k) {
        const unsigned m = wave_umax(k0);
        const int Lw = (int)__builtin_ctzll(__ballot(k0 == m));
        const int jw = __builtin_amdgcn_readlane(j0, Lw);
        const float sraw = rdlane_f(s0, Lw);
        e8[k] = 4 * Lw + jw; w8[k] = sraw; wsum += sraw;
        const bool pop = (lane == Lw);
        k0 = pop ? k1 : k0; k1 = pop ? k2 : k1; k2 = pop ? k3 : k2; k3 = pop ? 0u : k3;
        j0 = pop ? j1 : j0; j1 = pop ? j2 : j1; j2 = pop ? j3 : j2;
        s0 = pop ? s1 : s0; s1 = pop ? s2 : s1; s2 = pop ? s3 : s2;
    }
    const float inv = 2.5f / wsum;
#pragma unroll
    for (int k = 0; k < TOPK; ++k) w8[k] *= inv;
}
__device__ __forceinline__ void route_rows(const Params& p, int gw, int ngw, int lane) {
    const float* logits = (const float*)(p.ws + C_LOGITS); const float* rb = p.in[24];
    int* cnt = (int*)(p.ws + WS_CNT);
    int* tok_e = (int*)(p.ws + C_TOKE); float* tok_w = (float*)(p.ws + C_TOKW); int* tok_pos = (int*)(p.ws + C_TOKPOS);
    int* list_tok = (int*)(p.ws + C_LISTTOK); float* list_w = (float*)(p.ws + C_LISTW);
    const f32x4 bias = *(const f32x4*)(rb + lane * 4);
    for (int row0 = gw; row0 < T; row0 += ngw * 8) {
        int e_all = 0, row_all = -1; float w_all = 0.f;
        f32x4 lg = *(const f32x4*)(logits + (size_t)row0 * 256 + lane * 4);
#pragma unroll 1
        for (int i = 0; i < 8; ++i) {
            const int row = row0 + i * ngw;
            if (row >= T) break;
            const f32x4 cur = lg;
            if (i + 1 < 8 && row + ngw < T) lg = *(const f32x4*)(logits + (size_t)(row + ngw) * 256 + lane * 4);
            int e8[8]; float w8[8];
            route_token(cur, bias, lane, e8, w8);
            if ((lane >> 3) == i) {
                const int k = lane & 7; int es = e8[0]; float wsel = w8[0];
#pragma unroll
                for (int q = 1; q < 8; ++q) if (k == q) { es = e8[q]; wsel = w8[q]; }
                e_all = es; w_all = wsel; row_all = row;
            }
        }
        if (row_all >= 0) {
            const int k = lane & 7;
            const int pos = atomicAdd(&cnt[e_all * CNT_STRIDE], 1);
            tok_e[(size_t)row_all * 8 + k] = e_all; tok_w[(size_t)row_all * 8 + k] = w_all; tok_pos[(size_t)row_all * 8 + k] = pos;
            list_tok[(size_t)e_all * CAP + pos] = row_all; list_w[(size_t)e_all * CAP + pos] = w_all;
        }
    }
}

__device__ __forceinline__ void expert_prefix(const Params& p, LAS int* base, LAS int* tsa, int tid, int ngrp) {
    const int* cnt = (const int*)(p.ws + WS_CNT);
    const int nper = NE / ngrp;
    const int wave = tid >> 6, lane = tid & 63;
    if (tid < 64) {
        int c[4]; int s = 0;
#pragma unroll
        for (int j = 0; j < 4; ++j) { c[j] = __hip_atomic_load(cnt + (tid * 4 + j) * CNT_STRIDE, __ATOMIC_RELAXED, __HIP_MEMORY_SCOPE_AGENT); s += c[j]; }
        int ps = s;
#pragma unroll
        for (int o = 1; o < 64; o <<= 1) { const int a = __builtin_amdgcn_ds_bpermute(((lane - o) & 63) << 2, ps); if (lane >= o) ps += a; }
        int es = ps - s;
#pragma unroll
        for (int j = 0; j < 4; ++j) { base[tid * 4 + j] = es; es += c[j]; }
    }
    if (wave < ngrp) {
        LAS int* tsx = tsa + wave * (nper + 1);
        int run = 0;
        for (int r0 = 0; r0 < nper; r0 += 64) {
            const int i = r0 + lane;
            int tl = 0;
            if (i < nper) tl = (__hip_atomic_load(cnt + (wave + ngrp * i) * CNT_STRIDE, __ATOMIC_RELAXED, __HIP_MEMORY_SCOPE_AGENT) + 255) >> 8;
            int pt = tl;
#pragma unroll
            for (int o = 1; o < 64; o <<= 1) { const int a = __builtin_amdgcn_ds_bpermute(((lane - o) & 63) << 2, pt); if (lane >= o) pt += a; }
            if (i < nper) tsx[i] = run + pt - tl;
            run += __builtin_amdgcn_readlane(pt, 63);
        }
        if (lane == 0) tsx[nper] = run;
    }
    __syncthreads();
}
__device__ __forceinline__ int sched_nunits(const LAS int* tsa, int g, int nper, int mult, int extra = 0) { return tsa[g * (nper + 1) + nper] * mult + extra; }
__device__ __forceinline__ int sched_nstatic(int n, int gper) { const int r = n / gper - 1; return r > 0 ? r : 0; }
__device__ __forceinline__ bool sched_next(int* ctr, const LAS int* tsa, volatile LAS int* slot, int tid, int ngrp, int nper, int mult, int gper, int& g, int& u, int extra = 0) {
    if (tid == 0) {
        int rg = -1, ru = 0;
        for (int tries = 0; tries < 64 && rg < 0; ++tries) {
            const int n = sched_nunits(tsa, g, nper, mult, extra), st = sched_nstatic(n, gper) * gper;
            const int t = __hip_atomic_fetch_add(ctr + g * CNT_STRIDE, 1, __ATOMIC_RELAXED, __HIP_MEMORY_SCOPE_AGENT) + st;
            if (t < n) { rg = g; ru = t; break; }
            int ng = -1, bestd = 8;
#pragma unroll
            for (int j = 0; j < 8; ++j) {
                if (j < ngrp) {
                    const int cj = __hip_atomic_load(ctr + j * CNT_STRIDE, __ATOMIC_RELAXED, __HIP_MEMORY_SCOPE_AGENT);
                    const int nj = sched_nunits(tsa, j, nper, mult, extra), d = (j - g) & 7;
                    if (d != 0 && d < bestd && cj + sched_nstatic(nj, gper) * gper < nj) { bestd = d; ng = j; }
                }
            }
            if (ng < 0) break;
            g = ng;
        }
        slot[0] = rg; slot[1] = ru;
    }
    __syncthreads();
    const int rg = slot[0]; u = slot[1];
    __syncthreads();
    if (rg < 0) return false;
    g = rg; return true;
}

__device__ __forceinline__ void combine_rows_batch8(const Params& p, LAS int* base, int gw, int lane) {
    const unsigned char* sh = (const unsigned char*)(p.ws + C_SHOUT); const unsigned char* y = (const unsigned char*)(p.ws + C_Y);
    const int* tok_e = (const int*)(p.ws + C_TOKE); const int* tok_pos = (const int*)(p.ws + C_TOKPOS);
    const float* ada = (const float*)(p.ws + WS_ADA);
    typedef float f32x2v __attribute__((ext_vector_type(2)));
    const int row0 = gw * 8, b = row0 / S, col = lane * 16;
    const int slot = base[tok_e[(size_t)row0 * 8 + lane]] + tok_pos[(size_t)row0 * 8 + lane];
    f32x4 gg[4];
#pragma unroll
    for (int q4 = 0; q4 < 4; ++q4) gg[q4] = *(const f32x4*)(ada + b * 6144 + 5120 + col + q4 * 4);
    u32x4 yr[2][TOPK], sa[2], xa[2][2];
#define CB_LOAD(buf_, r_) do { const int row_ = row0 + (r_); \
        _Pragma("unroll") for (int k = 0; k < TOPK; ++k) { const int sl = __shfl(slot, (r_) * 8 + k); yr[buf_][k] = *(const u32x4*)(y + (size_t)sl * 1024 + col); } \
        sa[buf_] = *(const u32x4*)(sh + (size_t)row_ * 1024 + col); \
        const bf16_t* x1r = (const bf16_t*)(p.ws + C_X1) + (size_t)row_ * D + col; \
        xa[buf_][0] = *(const u32x4*)x1r; xa[buf_][1] = *(const u32x4*)(x1r + 8); } while (0)
    CB_LOAD(0, 0);
#pragma unroll
    for (int r = 0; r < 8; ++r) {
        const int cur = r & 1, row = row0 + r;
        if (r + 1 < 8) CB_LOAD(cur ^ 1, r + 1);
        float acc[16];
        {
            const unsigned w4[4] = {sa[cur].x, sa[cur].y, sa[cur].z, sa[cur].w};
#pragma unroll
            for (int q = 0; q < 4; ++q) {
                const f32x2v lo = __builtin_amdgcn_cvt_pk_f32_fp8((int)w4[q], false), hi = __builtin_amdgcn_cvt_pk_f32_fp8((int)w4[q], true);
                acc[4 * q + 0] = lo.x; acc[4 * q + 1] = lo.y; acc[4 * q + 2] = hi.x; acc[4 * q + 3] = hi.y;
            }
        }
#pragma unroll
        for (int k = 0; k < TOPK; ++k) {
            const unsigned w4[4] = {yr[cur][k].x, yr[cur][k].y, yr[cur][k].z, yr[cur][k].w};
#pragma unroll
            for (int q = 0; q < 4; ++q) {
                const f32x2v lo = __builtin_amdgcn_cvt_pk_f32_fp8((int)w4[q], false), hi = __builtin_amdgcn_cvt_pk_f32_fp8((int)w4[q], true);
                acc[4 * q + 0] += lo.x; acc[4 * q + 1] += lo.y; acc[4 * q + 2] += hi.x; acc[4 * q + 3] += hi.y;
            }
        }
        float* o = p.out + (size_t)row * D + col;
        const unsigned xw[8] = {xa[cur][0].x, xa[cur][0].y, xa[cur][0].z, xa[cur][0].w, xa[cur][1].x, xa[cur][1].y, xa[cur][1].z, xa[cur][1].w};
#pragma unroll
        for (int q4 = 0; q4 < 4; ++q4) {
            const f32x4 x = (f32x4){bflo(xw[2 * q4]), bfhi(xw[2 * q4]), bflo(xw[2 * q4 + 1]), bfhi(xw[2 * q4 + 1])};
            f32x4 rv; rv.x = x.x + gg[q4].x * acc[q4 * 4 + 0]; rv.y = x.y + gg[q4].y * acc[q4 * 4 + 1]; rv.z = x.z + gg[q4].z * acc[q4 * 4 + 2]; rv.w = x.w + gg[q4].w * acc[q4 * 4 + 3];
            asm volatile("global_store_dwordx4 %0, %1, off\n\ts_nop 1" :: "v"(o + q4 * 4), "v"(rv) : "memory");
        }
    }
#undef CB_LOAD
}
__device__ __forceinline__ void combine_rows(const Params& p, LAS int* base, int gw, int ngw, int lane) {
    const unsigned char* sh = (const unsigned char*)(p.ws + C_SHOUT); const unsigned char* y = (const unsigned char*)(p.ws + C_Y);
    const int* tok_e = (const int*)(p.ws + C_TOKE); const int* tok_pos = (const int*)(p.ws + C_TOKPOS);
    const float* ada = (const float*)(p.ws + WS_ADA);
    typedef float f32x2v __attribute__((ext_vector_type(2)));
    for (int row = gw; row < T; row += ngw) {
        const int b = row / S;
        const int col = lane * 16;
        u32x4 yr[TOPK];
#pragma unroll
        for (int k = 0; k < TOPK; ++k) {
            const int e = tok_e[(size_t)row * 8 + k], pos = tok_pos[(size_t)row * 8 + k];
            yr[k] = *(const u32x4*)(y + (size_t)(base[e] + pos) * 1024 + col);
        }
        float acc[16];
        {
            const u32x4 a0 = *(const u32x4*)(sh + (size_t)row * 1024 + col);
            const unsigned w4[4] = {a0.x, a0.y, a0.z, a0.w};
#pragma unroll
            for (int q = 0; q < 4; ++q) {
                const f32x2v lo = __builtin_amdgcn_cvt_pk_f32_fp8((int)w4[q], false), hi = __builtin_amdgcn_cvt_pk_f32_fp8((int)w4[q], true);
                acc[4 * q + 0] = lo.x; acc[4 * q + 1] = lo.y; acc[4 * q + 2] = hi.x; acc[4 * q + 3] = hi.y;
            }
        }
#pragma unroll
        for (int k = 0; k < TOPK; ++k) {
            const unsigned w4[4] = {yr[k].x, yr[k].y, yr[k].z, yr[k].w};
#pragma unroll
            for (int q = 0; q < 4; ++q) {
                const f32x2v lo = __builtin_amdgcn_cvt_pk_f32_fp8((int)w4[q], false), hi = __builtin_amdgcn_cvt_pk_f32_fp8((int)w4[q], true);
                acc[4 * q + 0] += lo.x; acc[4 * q + 1] += lo.y; acc[4 * q + 2] += hi.x; acc[4 * q + 3] += hi.y;
            }
        }
        float* o = p.out + (size_t)row * D + col;
        const float* g = ada + b * 6144 + 5120 + col;
        const bf16_t* x1r = (const bf16_t*)(p.ws + C_X1) + (size_t)row * D + col;
        const u32x4 xa = *(const u32x4*)x1r, xb = *(const u32x4*)(x1r + 8);
        const unsigned xw[8] = {xa.x, xa.y, xa.z, xa.w, xb.x, xb.y, xb.z, xb.w};
#pragma unroll
        for (int q4 = 0; q4 < 4; ++q4) {
            const f32x4 x = (f32x4){bflo(xw[2 * q4]), bfhi(xw[2 * q4]), bflo(xw[2 * q4 + 1]), bfhi(xw[2 * q4 + 1])}, gg = *(const f32x4*)(g + q4 * 4);
            f32x4 r; r.x = x.x + gg.x * acc[q4 * 4 + 0]; r.y = x.y + gg.y * acc[q4 * 4 + 1]; r.z = x.z + gg.z * acc[q4 * 4 + 2]; r.w = x.w + gg.w * acc[q4 * 4 + 3];
            *(f32x4*)(o + q4 * 4) = r;
        }
    }
}


struct PgProj {
    static constexpr bool PERM = true, AFTER_DRAIN = false;
    bf16_t* proj; float* graw;
    __device__ __forceinline__ void operator()(const f32x4 (&acc)[2][2][4][2], const pg8::Unit& u, int wr, int wc, int fr, int fq) const {
#pragma unroll
        for (int ai = 0; ai < 2; ++ai)
#pragma unroll
            for (int m = 0; m < 4; ++m) { const int row = u.pm * 256 + ai * 128 + wr * 64 + m * 16 + fr;
#pragma unroll
                for (int bj = 0; bj < 2; ++bj) { const int col = u.pn * 256 + bj * 128 + wc * 32 + 8 * fq;
                    if (col < OFF_GATE) { const u32x2 lo = pack4(acc[ai][bj][m][0]), hi = pack4(acc[ai][bj][m][1]); *(u32x4*)(proj + (size_t)row * IN_DIM + col) = (u32x4){lo.x, lo.y, hi.x, hi.y}; }
                    else if (col < IN_DIM) { *(f32x4*)(graw + (size_t)row * 8) = acc[ai][bj][m][0]; *(f32x4*)(graw + (size_t)row * 8 + 4) = acc[ai][bj][m][1]; } } }
    }
};
struct PgBf16 {
    static constexpr bool PERM = true, AFTER_DRAIN = false;
    bf16_t* O; int ldc;
    __device__ __forceinline__ void operator()(const f32x4 (&acc)[2][2][4][2], const pg8::Unit& u, int wr, int wc, int fr, int fq) const {
#pragma unroll
        for (int ai = 0; ai < 2; ++ai)
#pragma unroll
            for (int m = 0; m < 4; ++m) { const int row = u.pm * 256 + ai * 128 + wr * 64 + m * 16 + fr;
#pragma unroll
                for (int bj = 0; bj < 2; ++bj) { const int col = u.pn * 256 + bj * 128 + wc * 32 + 8 * fq;
                    const u32x2 lo = pack4(acc[ai][bj][m][0]), hi = pack4(acc[ai][bj][m][1]); *(u32x4*)(O + (size_t)row * ldc + col) = (u32x4){lo.x, lo.y, hi.x, hi.y}; } }
    }
};
struct PgMqk {
    static constexpr bool PERM = true, AFTER_DRAIN = false;
    bf16_t* mq; bf16_t* mk;
    __device__ __forceinline__ void operator()(const f32x4 (&acc)[2][2][4][2], const pg8::Unit& u, int wr, int wc, int fr, int fq) const {
#pragma unroll
        for (int ai = 0; ai < 2; ++ai)
#pragma unroll
            for (int m = 0; m < 4; ++m) { const int row = u.pm * 256 + ai * 128 + wr * 64 + m * 16 + fr;
#pragma unroll
                for (int bj = 0; bj < 2; ++bj) { const int c = wc * 32 + 8 * fq; const float sc = bj ? 0.08838834764831845f : 1.f;
                    const u32x2 lo = pack4(acc[ai][bj][m][0] * sc), hi = pack4(acc[ai][bj][m][1] * sc);
                    *(u32x4*)((bj ? mk : mq) + (size_t)row * MINNER + u.pn * DM + c) = (u32x4){lo.x, lo.y, hi.x, hi.y}; } }
    }
};
struct PgResid {
    static constexpr bool PERM = true, AFTER_DRAIN = false;
    const float* X; const float* ada; int gt_off; bf16_t* out;
    __device__ __forceinline__ void operator()(const f32x4 (&acc)[2][2][4][2], const pg8::Unit& u, int wr, int wc, int fr, int fq) const {
#pragma unroll
        for (int ai = 0; ai < 2; ++ai)
#pragma unroll
            for (int m = 0; m < 4; ++m) { const int row = u.pm * 256 + ai * 128 + wr * 64 + m * 16 + fr; const int b = row / S;
#pragma unroll
                for (int bj = 0; bj < 2; ++bj) { const int col = u.pn * 256 + bj * 128 + wc * 32 + 8 * fq;
                    const f32x4 g0 = *(const f32x4*)(ada + b * 6144 + gt_off + col), g1 = *(const f32x4*)(ada + b * 6144 + gt_off + col + 4);
                    const f32x4 x0 = *(const f32x4*)(X + (size_t)row * D + col), x1 = *(const f32x4*)(X + (size_t)row * D + col + 4);
                    const u32x2 lo = pack4(x0 + g0 * acc[ai][bj][m][0]), hi = pack4(x1 + g1 * acc[ai][bj][m][1]);
                    *(u32x4*)(out + (size_t)row * D + col) = (u32x4){lo.x, lo.y, hi.x, hi.y}; } }
    }
};
struct PgRgu {
    static constexpr bool PERM = false, AFTER_DRAIN = false;
    float* logits; unsigned char* act;
    __device__ __forceinline__ void operator()(const f32x4 (&acc)[2][2][4][2], const pg8::Unit& u, int wr, int wc, int fr, int fq) const {
#pragma unroll
        for (int ai = 0; ai < 2; ++ai)
#pragma unroll
            for (int m = 0; m < 4; ++m) { const int row = u.pm * 256 + ai * 128 + wr * 64 + m * 16 + fr;
#pragma unroll
                for (int bj = 0; bj < 2; ++bj) {
                    if (u.pn == 0) {
#pragma unroll
                        for (int n = 0; n < 2; ++n) *(f32x4*)(logits + (size_t)row * 256 + bj * 128 + wc * 32 + n * 16 + 4 * fq) = acc[ai][bj][m][n];
                    } else {
                        const int j = ((u.pn - 1) * 256 + bj * 128 + wc * 32) >> 5;
                        { const f32x4 g_ = acc[ai][bj][m][0], u_ = acc[ai][bj][m][1];
                          *(unsigned*)(act + (size_t)row * 256 + j * 16 + 4 * fq) = pk4_fp8(siluf_(g_.x) * u_.x, siluf_(g_.y) * u_.y, siluf_(g_.z) * u_.z, siluf_(g_.w) * u_.w); }
                    }
                } }
    }
};

__device__ __forceinline__ int xcd_remap(int L, int nwg) { const int q = nwg >> 3, r = nwg & 7, x = L & 7, off = L >> 3; return (x < r ? x * (q + 1) : r * (q + 1) + (x - r) * q) + off; }
__global__ void __launch_bounds__(NT, 2) fwd_kernel(Params p) {
    extern __shared__ __attribute__((aligned(16))) unsigned char lds_raw[];
    LAS unsigned char* lds = (LAS unsigned char*)lds_raw;
    const int G = gridDim.x, bid = blockIdx.x, ngw = G * NWAVES;
#define FRESH_IDS() const int tid = fresh_tid(), lane = tid & 63, wid = tid >> 6, gw = bid * NWAVES + wid; (void)lane; (void)gw
    { const int tid = fresh_tid(); volatile LAS unsigned* bst0 = (volatile LAS unsigned*)(lds + LDS_BYTES - 64); if (tid < 2) bst0[tid] = 0u; }
    unsigned char* ws = p.ws;
    const float* ada = (const float*)(ws + WS_ADA);
    volatile LAS unsigned* bst = (volatile LAS unsigned*)(lds + LDS_BYTES - 64);
    __syncthreads();
    const XcdBarrier xbar = xcd_barrier_post((unsigned*)(ws + WS_CTL + 4096), bst);
    int ts_n = 0;
#if DBG_STAGE == 2
#define TSTAMP() do { if (bid == 0 && threadIdx.x == 0) ((unsigned long long*)(ws + WS_CTL + 16384 + 8192))[ts_n] = __builtin_amdgcn_s_memrealtime(); ++ts_n; } while (0)
#else
#define TSTAMP() do { } while (0)
#endif
    TSTAMP();

    {
        FRESH_IDS();
        for (int u = bid; u < 192; u += G) ada_unit(p, lds, u, tid);
        LAS float* scr = (LAS float*)(lds + wid * 8448);
        constexpr int I0 = 16 * 70;
        if (G > 192) { if (bid >= 192) for (int it = (bid - 192) * NWAVES + wid; it < I0; it += (G - 192) * NWAVES) conv_item<0>(p.in[6], 1024, IN_DIM, (bf16_t*)(ws + WS_WIN), 0, 0, scr, it, lane); }
        else for (int it = gw; it < I0; it += ngw) conv_item<0>(p.in[6], 1024, IN_DIM, (bf16_t*)(ws + WS_WIN), 0, 0, scr, it, lane);
        u32x4* zp = (u32x4*)((bf16_t*)(ws + WS_WIN) + (size_t)IN_DIM * 1024);
        for (int i = bid * NT + tid; i < (2304 - IN_DIM) * 1024 / 8; i += G * NT) zp[i] = (u32x4){0u, 0u, 0u, 0u};
    }
    xcd_barrier(xbar); TSTAMP();
    { FRESH_IDS();
      if (ngw * 8 == T) norm_mod_rows_x8(p.in[0], p.in[5], ada, 0, 1024, (bf16_t*)(ws + B_H1), gw, lane);
      else norm_mod_rows(p.in[0], p.in[5], ada, 0, 1024, (bf16_t*)(ws + B_H1), gw, ngw, lane); }
    xcd_barrier(xbar); TSTAMP();
    {
        const pg8::Gemm g{(const bf16_t*)(ws + B_H1), (const bf16_t*)(ws + WS_WIN), T, 2304, 1024, 1024, 1024, 0};
        pg8::StaticOrder SO; SO.init(T, 2304, G, bid);
        const PgProj E{(bf16_t*)(ws + B_PROJ), (float*)(ws + B_GRAW)};
        pg8::gemm_phase<PgProj, pg8::StaticOrder, true, true>(lds, g, SO, E);
        {
            FRESH_IDS();
            const int nfull = (576 % G) ? (576 % G) : 0;
            if (bid >= nfull) {
                LAS float* scr = (LAS float*)(lds + wid * 8448);
                constexpr int K1 = 6 * 24, K2 = K1 + 4 * 32, K3 = K2 + 32, K4 = K3 + 32;
                constexpr int J0 = K4 + 16 * 32, J1 = J0 + 16 * 8, J2 = J1 + 16 * 8, J3 = J2 + 16 * 8, J4 = J3;
                for (int it = (bid - nfull) * NWAVES + wid; it < J4; it += (G - nfull) * NWAVES) {
                    if (it < K1) conv_item<0>(p.in[8], QLORA, 768, (bf16_t*)(ws + WS_WUQ), 0, 0, scr, it, lane);
                    else if (it < K2) conv_item<0>(p.in[10], KVLORA, 1024, (bf16_t*)(ws + WS_WUKV), 0, 0, scr, it - K1, lane);
                    else if (it < K3) conv_item<0>(p.in[16], 128, 128, (bf16_t*)(ws + WS_WMQK), 256 * 128, 0, scr, it - K2, lane);
                    else if (it < K4) conv_item<0>(p.in[17], 128, 128, (bf16_t*)(ws + WS_WMQK), 256 * 128, 128, scr, it - K3, lane);
                    else if (it < J0) conv_item<0>(p.in[21], 1024, 1024, (bf16_t*)(ws + WS_WOUT), 0, 0, scr, it - K4, lane);
                    else if (it < J1) conv_item<0>(p.in[23], 1024, 256, (bf16_t*)(ws + WS_WRGU), 0, 0, scr, it - J0, lane);
                    else if (it < J2) conv_item<1>(p.in[28], 1024, 256, (bf16_t*)(ws + WS_WRGU), 0, 256, scr, it - J1, lane);
                    else conv_item<2>(p.in[29], 1024, 256, (bf16_t*)(ws + WS_WRGU), 0, 256, scr, it - J2, lane);
                }
            }
        }
    }
    xcd_barrier(xbar); TSTAMP();
    { FRESH_IDS(); post_proj_rows(p, gw, ngw, lane); }
    xcd_barrier(xbar); TSTAMP();
    {
        {   const pg8::Gemm g{(const bf16_t*)(ws + B_CQN), (const bf16_t*)(ws + WS_WUQ), T, 768, QLORA, QLORA, QLORA, 0};
            pg8::StaticOrder SO; SO.init(T, 768, G, bid); const PgBf16 E{(bf16_t*)(ws + B_QRAW), 768};
            pg8::gemm_phase<PgBf16, pg8::StaticOrder, true, true>(lds, g, SO, E); }
        {   const pg8::Gemm g{(const bf16_t*)(ws + B_CKVN), (const bf16_t*)(ws + WS_WUKV), T, 1024, KVLORA, KVLORA, KVLORA, 0};
            pg8::StaticOrder SO; SO.init(T, 1024, G, bid); const PgBf16 E{(bf16_t*)(ws + B_KVRAW), 1024};
            pg8::gemm_phase<PgBf16, pg8::StaticOrder, true, true>(lds, g, SO, E); }
        {   const pg8::Gemm g{(const bf16_t*)(ws + B_ZC), (const bf16_t*)(ws + WS_WMQK), T, 1024, DM, MINNER, DM, DM};
            pg8::StaticOrder SO; SO.init(T, 1024, G, bid); const PgMqk E{(bf16_t*)(ws + B_MQ), (bf16_t*)(ws + B_MK)};
            pg8::gemm_phase<PgMqk, pg8::StaticOrder, true, true>(lds, g, SO, E); }
    }
    xcd_barrier(xbar); TSTAMP();
    { FRESH_IDS(); qk_post_rows(p, gw, ngw, lane); }
    xcd_barrier(xbar); TSTAMP();
    for (int pr = bid; pr < 256; pr += G) { const int bh = pr & 63, j = pr >> 6; attn_unit(p, lds, bh, 7 - j); attn_unit(p, lds, bh, j); }
    {
        MaRegs R;
        if (bid < 1024) mlstm_a_load(p, bid, R);
        for (int u = bid; u < 1024; u += G) mlstm_a_unit(p, lds, u, R, (u + G < 1024) ? u + G : -1);
    }
    xcd_barrier(xbar); TSTAMP();
    { FRESH_IDS(); mlstm_scan(p, bid * NT + tid, G * NT); }
    { FRESH_IDS(); if (ngw * 8 == T) attn_out_norm_rows_batch8(p, gw, lane); else attn_out_norm_rows(p, gw, ngw, lane); }
    xcd_barrier(xbar); TSTAMP();
    {
        McRegs R;
        if (bid < 1024) mlstm_c_load(p, bid, R);
        for (int u = bid; u < 1024; u += G) mlstm_c_unit(p, lds, u, R, (u + G < 1024) ? u + G : -1);
    }
    xcd_barrier(xbar); TSTAMP();
    {
        const pg8::Gemm g{(const bf16_t*)(ws + B_AO), (const bf16_t*)(ws + WS_WOUT), T, 1024, 1024, 1024, 1024, 0};
        pg8::StaticOrder SO; SO.init(T, 1024, G, bid); const PgResid E{p.in[0], ada, 2048, (bf16_t*)(ws + C_X1)};
        pg8::gemm_phase<PgResid, pg8::StaticOrder, true, true>(lds, g, SO, E);
    }
    xcd_barrier(xbar); TSTAMP();
    { FRESH_IDS();
      if (ngw * 8 == T) norm_mod_rows_bf8((const bf16_t*)(ws + C_X1), p.in[22], ada, 3072, 4096, (bf16_t*)(ws + C_H2), gw, lane, ws + C_H2F8);
      else norm_mod_rows_bf((const bf16_t*)(ws + C_X1), p.in[22], ada, 3072, 4096, (bf16_t*)(ws + C_H2), gw, ngw, lane, ws + C_H2F8); }
    xcd_barrier(xbar); TSTAMP();
    {
        const pg8::Gemm g{(const bf16_t*)(ws + C_H2), (const bf16_t*)(ws + WS_WRGU), T, 768, 1024, 1024, 1024, 0};
        pg8::StaticOrder SO; SO.init(T, 768, G, bid); const PgRgu E{(float*)(ws + C_LOGITS), (unsigned char*)(ws + C_ACTSH)};
        pg8::gemm_phase<PgRgu, pg8::StaticOrder, true, true>(lds, g, SO, E);
        if (G == 256 && bid >= 192) { FRESH_IDS(); wconv_range(p, (bid - 192) * NWAVES + wid, (NIMG + 1) * 128, 64 * NWAVES, lane); }
        else if (G != 256) { FRESH_IDS(); wconv_range(p, gw, (NIMG + 1) * 128, ngw, lane); }
    }
    xcd_barrier(xbar); TSTAMP();
    { FRESH_IDS(); route_rows(p, gw, ngw, lane); }
    xcd_barrier(xbar); TSTAMP();
    LAS int* base = (LAS int*)(lds + 132 * 1024);
    LAS int* tsa = base + 256;
    volatile LAS int* tslot = (volatile LAS int*)(base + 1024);
    const int ngrp = (G % 8 == 0) ? 8 : 1, gx = bid % ngrp, gidx = bid / ngrp, gper = G / ngrp, nexp = NE / ngrp;
    { FRESH_IDS(); expert_prefix(p, base, tsa, tid, ngrp); }
#define EXPERT_UNITS(ctr_, mult_, extra_, ...) do { \
        const int nown_ = sched_nunits(tsa, gx, nexp, mult_, extra_), nst_ = sched_nstatic(nown_, gper) * gper; \
        for (int u = gidx; u < nst_; u += gper) { const int g = gx; __VA_ARGS__; } \
        int g = gx, u = 0; \
        while (sched_next(ctr_, tsa, tslot, fresh_tid(), ngrp, nexp, mult_, gper, g, u, extra_)) { __VA_ARGS__; } } while (0)
    {
        const int* cnt = (const int*)(ws + WS_CNT);
        EXPERT_UNITS((int*)(ws + WS_TICKET8), 4, 0, {
            const LAS int* tsx = tsa + g * (nexp + 1);
            const int tg = u >> 2, tn = u & 3;
            int lo = 0, hi = nexp - 1;
            while (lo < hi) { const int mid = (lo + hi + 1) >> 1; if (tsx[mid] <= tg) lo = mid; else hi = mid - 1; }
            const int e = g + ngrp * lo, blk = tg - tsx[lo], c = (e == NE - 1 ? T * TOPK : base[e + 1]) - base[e];
            const int nvalid = min(256, c - blk * 256);
            const RowGather RP{(const unsigned char*)(ws + C_H2F8), (const int*)(ws + C_LISTTOK) + (size_t)e * CAP + blk * 256, nvalid};
            const ColGU CP{p.in[25] + (size_t)e * 1024 * 256, p.in[26] - p.in[25]};
            const EpiExpAct E{(unsigned char*)(ws + C_ACTE), base[e] + blk * 256, nvalid};
            gemm2_tile(lds, RP, CP, 256, 1024, 0, tn * 128, E, nvalid);
        });
    }
    xcd_barrier(xbar); TSTAMP();
    {
        const int* cnt = (const int*)(ws + WS_CNT);
        const int shx = 128 / ngrp;
        EXPERT_UNITS((int*)(ws + WS_TICKET9), 2, shx, {
            const LAS int* tsx = tsa + g * (nexp + 1);
            const int tg = u >> 1, nq = u & 1;
            if (tg >= tsx[nexp]) {
                const int su = u - 2 * tsx[nexp], rt = g * (shx >> 1) + (su >> 1);
                expert_down_unit<true>(lds, (const unsigned char*)(ws + C_ACTSH), (const float*)(ws + WS_IMG9 + (size_t)(NIMG * 2 + (su & 1)) * (8 * 16384)), su & 1, (unsigned char*)(ws + C_SHOUT), nullptr, rt * 256, 256);
            } else {
            int lo = 0, hi = nexp - 1;
            while (lo < hi) { const int mid = (lo + hi + 1) >> 1; if (tsx[mid] <= tg) lo = mid; else hi = mid - 1; }
            const int e = g + ngrp * lo, blk = tg - tsx[lo], c = (e == NE - 1 ? T * TOPK : base[e + 1]) - base[e];
            const int nvalid = min(256, c - blk * 256);
            const int slot0 = base[e] + blk * 256;
            if (e < NIMG) expert_down_unit<true>(lds, (const unsigned char*)(ws + C_ACTE), (const float*)(ws + WS_IMG9 + (size_t)(e * 2 + nq) * (8 * 16384)), nq, (unsigned char*)(ws + C_Y),
                             (const float*)(ws + C_LISTW) + (size_t)e * CAP + blk * 256, slot0, nvalid);
            else expert_down_unit<false>(lds, (const unsigned char*)(ws + C_ACTE), p.in[27] + (size_t)e * 256 * 1024, nq, (unsigned char*)(ws + C_Y),
                             (const float*)(ws + C_LISTW) + (size_t)e * CAP + blk * 256, slot0, nvalid);
            }
        });
    }
    xcd_barrier(xbar); TSTAMP();
    { FRESH_IDS(); if (ngw * 8 == T) combine_rows_batch8(p, base, gw, lane); else combine_rows(p, base, gw, ngw, lane); }
#if DBG_STAGE == 2
    xcd_barrier(xbar); TSTAMP();
    xcd_barrier(xbar);
    {   FRESH_IDS();
        const unsigned long long* ts = (const unsigned long long*)(ws + WS_CTL + 16384 + 8192);
        const float tus = (float)(long long)(ts[TS_A1] - ts[TS_A0]) * 0.01f;
        const float cadd = sqrtf(2.5e-3f * tus * (1.f / 500.f));
        for (size_t i = (size_t)bid * NT + tid; i < (size_t)T * D / 4; i += (size_t)G * NT) { f32x4 v = ((f32x4*)p.out)[i]; v = v + cadd; ((f32x4*)p.out)[i] = v; }
    }
#endif
}

extern "C" void kernel_launch(void* const* d_in, const int* in_sizes, int n_in,
                              void* d_out, int out_size, void* d_ws, size_t ws_size,
                              hipStream_t stream) {
    static int grid_blocks = 0;
    if (!grid_blocks) {
        if (n_in != 31 || out_size != T * D || ws_size < WS_END) { fprintf(stderr, "kernel_launch: unexpected shapes n_in=%d out=%d ws=%zu (need %zu)\n", n_in, out_size, ws_size, (size_t)WS_END); grid_blocks = -1; return; }
        int dev = 0, cus = 0, per_cu = 0;
        (void)hipGetDevice(&dev);
        (void)hipDeviceGetAttribute(&cus, hipDeviceAttributeMultiprocessorCount, dev);
        (void)hipFuncSetAttribute((const void*)fwd_kernel, hipFuncAttributeMaxDynamicSharedMemorySize, LDS_BYTES);
        (void)hipOccupancyMaxActiveBlocksPerMultiprocessor(&per_cu, (const void*)fwd_kernel, NT, LDS_BYTES);
        if (per_cu < 1) per_cu = 1;
        grid_blocks = cus * per_cu;
        fprintf(stderr, "kernel_launch: cus=%d per_cu=%d grid=%d ws=%zu\n", cus, per_cu, grid_blocks, ws_size);
    }
    if (grid_blocks < 0) return;
    static_assert(WS_ADA == WS_CTL + CTL_BYTES, "control block and ada are zeroed by one memset");
    (void)hipMemsetAsync((char*)d_ws + WS_CTL, 0, CTL_BYTES + 8 * 6144 * sizeof(float), stream);
    Params p{};
    for (int i = 0; i < 31; ++i) p.in[i] = (const float*)d_in[i];
    p.out = (float*)d_out; p.ws = (unsigned char*)d_ws;
    void* args[] = {&p};
    hipError_t e = hipLaunchCooperativeKernel((const void*)fwd_kernel, dim3(grid_blocks), dim3(NT), args, LDS_BYTES, stream);
    if (e != hipSuccess) fprintf(stderr, "cooperative launch failed: %s (grid %d)\n", hipGetErrorString(e), grid_blocks);
}
```
